# Optimizing an MI355X kernel written in HIP

```python
import jax, jax.numpy as jnp
from jax import lax
import numpy as np

D_MODEL = 1024
BATCH = 8
SEQ = 2048
DEPTH = 1

MEM_LEN = 256
EPS = 1e-6

GLA_HEADS = 4
GLA_DV = D_MODEL // (2 * GLA_HEADS)
GLA_DK = GLA_DV // 2
GLA_LOWRANK = 16
GLA_GATE_NORM = 16.0
GLA_CHUNK = 64
CONV_WIDTH = 4
SB_HEADS = 8
SB_DH = D_MODEL // (2 * SB_HEADS)
SB_BLOCK = 128

GLA_QK_W = GLA_HEADS * GLA_DK
GLA_V_W = GLA_HEADS * GLA_DV
SB_W = SB_HEADS * SB_DH
MIX_W = GLA_V_W + SB_W
CONV_W = 2 * GLA_QK_W + GLA_V_W
IN_COLS = CONV_W + GLA_V_W + GLA_LOWRANK + 3 * SB_W

X_HEADS = 4
X_DH = D_MODEL // X_HEADS

PEER_HEADS = 8
PEER_NKEYS = 128
PEER_N = PEER_NKEYS * PEER_NKEYS
PEER_DKEY = 256
PEER_TOPK = 16
PEER_TOKEN_BLOCK = 128

kernel_name = "hybrid_gla_stickbreak_peer_block"


def rms_norm(x, g):
    xf = x.astype(jnp.float32)
    y = xf * lax.rsqrt(jnp.mean(xf * xf, axis=-1, keepdims=True) + EPS)
    return (y * g.astype(jnp.float32)).astype(x.dtype)


def split_heads(a, n_heads):
    b, t, w = a.shape
    return a.reshape(b, t, n_heads, w // n_heads).transpose(0, 2, 1, 3)


def merge_heads(a):
    b, h, t, d = a.shape
    return a.transpose(0, 2, 1, 3).reshape(b, t, h * d)


def causal_short_conv(x, w):
    kw = w.shape[0]
    t = x.shape[1]
    xp = jnp.pad(x, ((0, 0), (kw - 1, 0), (0, 0)))
    y = sum(xp[:, k:k + t] * w[k] for k in range(kw))
    return jax.nn.silu(y)


def gla_chunked(q, k, v, log_decay):
    dtype = v.dtype
    b, h, t, dk = q.shape
    dv = v.shape[-1]
    c = GLA_CHUNK
    n = t // c

    def to_chunks(a):
        return a.astype(jnp.float32).reshape(b, h, n, c, a.shape[-1]).transpose(2, 0, 1, 3, 4)

    qc, kc, vc, gc = map(to_chunks, (q * dk ** -0.5, k, v, log_decay))
    causal = jnp.tril(jnp.ones((c, c), dtype=bool))

    def step(state, inp):
        qi, ki, vi, gi = inp
        cum = jnp.cumsum(gi, axis=2)
        cum_last = cum[:, :, -1, :]
        o_inter = jnp.einsum('bhcd,bhde->bhce', qi * jnp.exp(cum), state)
        diff = cum[:, :, :, None, :] - cum[:, :, None, :, :]
        decay = jnp.exp(jnp.where(causal[:, :, None], diff, -jnp.inf))
        scores = jnp.einsum('bhid,bhjd,bhijd->bhij', qi, ki, decay)
        o_intra = jnp.einsum('bhij,bhje->bhie', scores, vi)
        k_dec = ki * jnp.exp(cum_last[:, :, None, :] - cum)
        new_state = jnp.exp(cum_last)[..., None] * state + jnp.einsum('bhcd,bhce->bhde', k_dec, vi)
        return new_state, o_inter + o_intra

    s0 = jnp.zeros((b, h, dk, dv), jnp.float32)
    _, out = lax.scan(step, s0, (qc, kc, vc, gc))
    return out.transpose(1, 2, 0, 3, 4).reshape(b, h, t, dv).astype(dtype)


def stick_breaking_attention(q, k, v):
    b, h, t, d = q.shape
    scale = d ** -0.5
    outs = []
    for blk in range(t // SB_BLOCK):
        t0 = blk * SB_BLOCK
        t1 = t0 + SB_BLOCK
        qb, kb, vb = q[:, :, t0:t1], k[:, :, :t1], v[:, :, :t1]
        z = jnp.einsum('bhtd,bhsd->bhts', qb, kb).astype(jnp.float32) * scale
        strict = jnp.arange(t1)[None, :] < jnp.arange(t0, t1)[:, None]
        log_beta = jax.nn.log_sigmoid(z)
        log_one_minus = jnp.where(strict, jax.nn.log_sigmoid(-z), 0.0)
        tail = lax.cumsum(log_one_minus, axis=3, reverse=True) - log_one_minus
        weights = jnp.where(strict, jnp.exp(log_beta + tail), 0.0)
        outs.append(jnp.einsum('bhts,bhsd->bhtd', weights.astype(vb.dtype), vb))
    return jnp.concatenate(outs, axis=2)


def memory_cross_attention(hn, mn, w_q, w_kv, w_o):
    b, t, _ = hn.shape
    m = mn.shape[1]
    q = (hn @ w_q).reshape(b, t, X_HEADS, X_DH)
    k, v = jnp.split(mn @ w_kv, 2, axis=-1)
    k = k.reshape(b, m, X_HEADS, X_DH)
    v = v.reshape(b, m, X_HEADS, X_DH)
    s = jnp.einsum('bthd,bmhd->bhtm', q, k).astype(jnp.float32) * X_DH ** -0.5
    p = jax.nn.softmax(s, axis=-1).astype(v.dtype)
    o = jnp.einsum('bhtm,bmhd->bthd', p, v).reshape(b, t, X_HEADS * X_DH)
    return o @ w_o


def peer_ffn(xn, w_q, sub_keys, u, v):
    b, t, d = xn.shape
    q = (xn @ w_q).reshape(b, t, PEER_HEADS, 2, PEER_DKEY // 2)
    s = jnp.einsum('bthpk,hpnk->bthpn', q, sub_keys).astype(jnp.float32)
    top_s, top_i = lax.top_k(s, PEER_TOPK)
    cand_s = top_s[..., 0, :, None] + top_s[..., 1, None, :]
    cand_i = top_i[..., 0, :, None] * PEER_NKEYS + top_i[..., 1, None, :]
    cand_s = cand_s.reshape(b, t, PEER_HEADS, PEER_TOPK * PEER_TOPK)
    cand_i = cand_i.reshape(b, t, PEER_HEADS, PEER_TOPK * PEER_TOPK)
    best_s, best_pos = lax.top_k(cand_s, PEER_TOPK)
    expert_idx = jnp.take_along_axis(cand_i, best_pos, axis=-1)
    gates = jax.nn.softmax(best_s, axis=-1).astype(xn.dtype)

    hk = PEER_HEADS * PEER_TOPK
    n_blk = (b * t) // PEER_TOKEN_BLOCK
    xf = xn.reshape(n_blk, PEER_TOKEN_BLOCK, d)
    idx = expert_idx.reshape(n_blk, PEER_TOKEN_BLOCK, hk)
    gf = gates.reshape(n_blk, PEER_TOKEN_BLOCK, hk)

    def block(args):
        xb, ib, gb = args
        act = jax.nn.gelu(jnp.einsum('td,ted->te', xb, u[ib]))
        return jnp.einsum('te,ted->td', gb * act, v[ib])

    out = lax.map(block, (xf, idx, gf))
    return out.reshape(b, t, d)


def setup_inputs(seed: int = 0) -> dict:
    key = jax.random.key(seed)
    ks = jax.random.split(key, 21)
    f32 = jnp.float32

    def nrm(k, shape, scale):
        return jax.random.normal(k, shape, f32) * scale

    def gain(k, shape):
        return 1.0 + 0.02 * jax.random.normal(k, shape, f32)

    return {
        "x": nrm(ks[0], (BATCH, SEQ, D_MODEL), 1.0),
        "mem": nrm(ks[1], (BATCH, MEM_LEN, D_MODEL), 1.0),
        "mix_norm_g": gain(ks[2], (DEPTH, D_MODEL)),
        "w_in": nrm(ks[3], (DEPTH, D_MODEL, IN_COLS), D_MODEL ** -0.5),
        "gla_conv_w": nrm(ks[4], (DEPTH, CONV_WIDTH, CONV_W), CONV_WIDTH ** -0.5),
        "gla_gate_w": nrm(ks[5], (DEPTH, GLA_LOWRANK, GLA_QK_W), GLA_LOWRANK ** -0.5),
        "gla_gate_b": nrm(ks[6], (DEPTH, GLA_QK_W), 0.1),
        "gla_out_norm_g": gain(ks[7], (DEPTH, GLA_DV)),
        "sb_out_norm_g": gain(ks[8], (DEPTH, SB_W)),
        "w_out": nrm(ks[9], (DEPTH, MIX_W, D_MODEL), MIX_W ** -0.5),
        "xattn_norm_g": gain(ks[10], (DEPTH, D_MODEL)),
        "mem_norm_g": gain(ks[11], (DEPTH, D_MODEL)),
        "w_xq": nrm(ks[12], (DEPTH, D_MODEL, X_HEADS * X_DH), D_MODEL ** -0.5),
        "w_xkv": nrm(ks[13], (DEPTH, D_MODEL, 2 * X_HEADS * X_DH), D_MODEL ** -0.5),
        "w_xo": nrm(ks[14], (DEPTH, X_HEADS * X_DH, D_MODEL), (X_HEADS * X_DH) ** -0.5),
        "ffn_norm_g": gain(ks[15], (DEPTH, D_MODEL)),
        "peer_w_q": nrm(ks[16], (DEPTH, D_MODEL, PEER_HEADS * PEER_DKEY), D_MODEL ** -0.5),
        "peer_sub_keys": nrm(ks[17], (DEPTH, PEER_HEADS, 2, PEER_NKEYS, PEER_DKEY // 2), (PEER_DKEY // 2) ** -0.5),
        "peer_u": nrm(ks[18], (DEPTH, PEER_N, D_MODEL), D_MODEL ** -0.5),
        "peer_v": nrm(ks[19], (DEPTH, PEER_N, D_MODEL), PEER_HEADS ** -0.5),
        "final_norm_g": gain(ks[20], (D_MODEL,)),
    }


def reference(x, mem, mix_norm_g, w_in, gla_conv_w, gla_gate_w, gla_gate_b, gla_out_norm_g,
              sb_out_norm_g, w_out, xattn_norm_g, mem_norm_g, w_xq, w_xkv, w_xo, ffn_norm_g,
              peer_w_q, peer_sub_keys, peer_u, peer_v, final_norm_g):
    h = x
    c1 = CONV_W
    c2 = c1 + GLA_V_W
    c3 = c2 + GLA_LOWRANK
    c4 = c3 + SB_W
    c5 = c4 + SB_W
    for l in range(DEPTH):
        xn = rms_norm(h, mix_norm_g[l])
        proj = xn @ w_in[l]
        gla_qkv, gla_og, gla_low, sb_q, sb_k, sb_v = jnp.split(proj, [c1, c2, c3, c4, c5], axis=-1)

        gla_qkv = causal_short_conv(gla_qkv, gla_conv_w[l])
        g_q, g_k, g_v = jnp.split(gla_qkv, [GLA_QK_W, 2 * GLA_QK_W], axis=-1)
        log_decay = jax.nn.log_sigmoid((gla_low @ gla_gate_w[l] + gla_gate_b[l]).astype(jnp.float32)) / GLA_GATE_NORM
        o_gla = gla_chunked(split_heads(g_q, GLA_HEADS), split_heads(g_k, GLA_HEADS),
                            split_heads(g_v, GLA_HEADS), split_heads(log_decay, GLA_HEADS))
        o_gla = merge_heads(rms_norm(o_gla, gla_out_norm_g[l])) * jax.nn.silu(gla_og)

        o_sb = stick_breaking_attention(split_heads(sb_q, SB_HEADS), split_heads(sb_k, SB_HEADS),
                                        split_heads(sb_v, SB_HEADS))
        o_sb = rms_norm(merge_heads(o_sb), sb_out_norm_g[l])

        h = h + jnp.concatenate([o_gla, o_sb], axis=-1) @ w_out[l]

        h = h + memory_cross_attention(rms_norm(h, xattn_norm_g[l]), rms_norm(mem, mem_norm_g[l]),
                                       w_xq[l], w_xkv[l], w_xo[l])

        h = h + peer_ffn(rms_norm(h, ffn_norm_g[l]), peer_w_q[l], peer_sub_keys[l], peer_u[l], peer_v[l])
    return rms_norm(h, final_norm_g)
```

```cpp
#include <hip/hip_runtime.h>
#include <cstdio>
#include <cstdint>
namespace pg8 {
#define PG8_LAS __attribute__((address_space(3)))
typedef unsigned short bf16_t;
typedef short bf16x8 __attribute__((ext_vector_type(8)));
typedef float f32x4 __attribute__((ext_vector_type(4)));
typedef unsigned u32x4 __attribute__((ext_vector_type(4)));
constexpr int BM = 256, BK = 64, HALF = 128, HTB = HALF * BK * 2  , STAGE_BYTES = 8 * HTB, NXCD = 8, WGM = 8;

__host__ __device__ __forceinline__ int lds_byte(int r, int c) { const int st = (r >> 4) * 2 + (c >> 5), rr = r & 15, cc = c & 31, ob = rr * 64 + cc * 2; return st * 1024 + (ob ^ (((ob >> 9) & 1) << 5)); }
__host__ __device__ __forceinline__ void stage_rc(int b, int& R, int& C) { const int st = b / 1024, sb = b % 1024, swz = sb ^ (((sb >> 9) & 1) << 5); R = (st >> 1) * 16 + swz / 64; C = (st & 1) * 32 + (swz % 64) / 2; }
__host__ __device__ __forceinline__ int perm32(int rho) { const int n = rho >> 4, i = rho & 15; return 8 * (i >> 2) + 4 * n + (i & 3); }

struct Unit { int pm, pn; size_t aoff, boff; };
struct Gemm { const bf16_t* A; const bf16_t* Bt; int K, lda, ldb; };

struct StaticOrder {
    int nM, nN, nwg, G, c, lda, ldb;
    __host__ __device__ void init(int M, int N, int G_, int c_, int lda_, int ldb_) { nM = M / BM; nN = N / BM; nwg = nM * nN; G = G_; c = c_; lda = lda_; ldb = ldb_; }
    __host__ __device__ bool next(int i, Unit& u) const {
        const long L = (long)i * G + c; if (L >= nwg) return false;
        int wgid = (int)L; { const int q = nwg / NXCD, r = nwg % NXCD, xcd = wgid % NXCD, off = wgid / NXCD; wgid = (xcd < r ? xcd * (q + 1) : r * (q + 1) + (xcd - r) * q) + off; }
        const int nig = WGM * nN, gid = wgid / nig, fm = gid * WGM, gsz = (nM - fm) < WGM ? (nM - fm) : WGM;
        u.pm = fm + ((wgid % nig) % gsz); u.pn = (wgid % nig) / gsz; u.aoff = (size_t)u.pm * BM * lda * 2; u.boff = (size_t)u.pn * BM * ldb * 2; return true;
    }
    __device__ __forceinline__ void a_ready(const Unit&) const {}
    __device__ __forceinline__ void done(const Unit&) const {}
};

__device__ __forceinline__ unsigned cvt_pk_bf16(float lo, float hi) { unsigned r; asm volatile("v_cvt_pk_bf16_f32 %0, %1, %2" : "=v"(r) : "v"(lo), "v"(hi)); return r; }
typedef float f32x2 __attribute__((ext_vector_type(2)));
__device__ __forceinline__ f32x2 gelu_pk(f32x2 v) {
    const f32x2 av = __builtin_elementwise_abs(v), d = av * 0.2316418882f + 1.0f;
    f32x2 t; t.x = __builtin_amdgcn_rcpf(d.x); t.y = __builtin_amdgcn_rcpf(d.y);
    f32x2 q = t * 0.5307027145f + (-0.7265760135f); q = q * t + 0.7107068705f; q = q * t + (-0.142248368f); q = q * t + 0.127414796f; q = q * t;
    const f32x2 s = (v * v) * (-0.72134752044f);
    f32x2 e; e.x = __builtin_amdgcn_exp2f(s.x); e.y = __builtin_amdgcn_exp2f(s.y);
    const f32x2 m = v * (q * e), r = v - m;
    f32x2 o; o.x = v.x < 0.f ? m.x : r.x; o.y = v.y < 0.f ? m.y : r.y; return o;
}

template <int ACT  > struct EpiBf16 {
    static constexpr bool PERM = true, AFTER_DRAIN = false; static_assert(ACT == 0 || ACT == 1, "EpiBf16: ACT is 0 (none) or 1 (gelu_pk)");
    bf16_t* O; int ldc; const float* bias; int split_cols; size_t split_stride; float scale0;
    __device__ __forceinline__ void operator()(const f32x4 (&acc)[2][2][4][2], const Unit& u, int wr, int wc, int fr, int fq) const {
        const int row0 = u.pm * BM + wr * 64 + fr; int colt = u.pn * BM; bf16_t* base = O;
        float sc = 1.f; if (split_cols) { const int t = colt / split_cols; base += (size_t)t * split_stride; colt -= t * split_cols; if (t == 0) sc = scale0; }
        const int col0 = colt + wc * 32 + 8 * fq, bcol0 = u.pn * BM + wc * 32 + 8 * fq;
        f32x4 bv[2][2];
#pragma unroll
        for (int bj = 0; bj < 2; ++bj)
#pragma unroll
            for (int n = 0; n < 2; ++n) bv[bj][n] = bias ? *(const f32x4*)(bias + bcol0 + bj * HALF + 4 * n) : (f32x4){0.f, 0.f, 0.f, 0.f};
#pragma unroll
        for (int ai = 0; ai < 2; ++ai)
#pragma unroll
            for (int m = 0; m < 4; ++m) { bf16_t* rowp = base + (size_t)(row0 + ai * HALF + m * 16) * ldc + col0;
#pragma unroll
                for (int bj = 0; bj < 2; ++bj) { f32x4 v0 = acc[ai][bj][m][0] + bv[bj][0], v1 = acc[ai][bj][m][1] + bv[bj][1];
                    if (ACT == 1) { f32x2 a = gelu_pk((f32x2){v0[0], v0[1]}), b = gelu_pk((f32x2){v0[2], v0[3]}), c = gelu_pk((f32x2){v1[0], v1[1]}), d = gelu_pk((f32x2){v1[2], v1[3]});
                        v0 = (f32x4){a.x, a.y, b.x, b.y}; v1 = (f32x4){c.x, c.y, d.x, d.y}; }
                    v0 = v0 * sc; v1 = v1 * sc; u32x4 w; w.x = cvt_pk_bf16(v0[0], v0[1]); w.y = cvt_pk_bf16(v0[2], v0[3]); w.z = cvt_pk_bf16(v1[0], v1[1]); w.w = cvt_pk_bf16(v1[2], v1[3]);
                    *(u32x4*)(rowp + bj * HALF) = w; } }
    }
};
template <class Epi, class Sched, bool ALIGN_EPI = false, bool SP2 = false>
__device__ __forceinline__ void gemm_phase(PG8_LAS unsigned char* lds, const Gemm g, const Sched& S, const Epi& E) {
    const int tid = threadIdx.x, wid = __builtin_amdgcn_readfirstlane(tid >> 6), lane = tid & 63, wr = wid >> 2, wc = wid & 3, fr = lane & 15, fq = lane >> 4;
    int K = g.K; asm volatile("" : "+s"(K));
    const int nt = K / BK;
    unsigned voffA[2], voffB[2];
#pragma unroll
    for (int i = 0; i < 2; ++i) { int R, C; stage_rc(tid * 16 + i * 8192, R, C); const int Rb = Epi::PERM ? ((R & ~31) + perm32(R & 31)) : R;
        voffA[i] = (unsigned)(R * g.lda + C) * 2u; voffB[i] = (unsigned)(Rb * g.ldb + C) * 2u; }
    const size_t kstep = (size_t)(BK * 2);
    const size_t hA = (size_t)HALF * g.lda * 2, hB = (size_t)HALF * g.ldb * 2;
    const unsigned ldsw = (unsigned)wid * 1024u;
    const int aoff = lds_byte(wr * 64 + fr, fq * 8), boff = lds_byte(wc * 32 + fr, fq * 8);
#define PG8_SA(b, h) (((b) * 2 + (h)) * HTB)
#define PG8_SB(b, h) ((4 + (b) * 2 + (h)) * HTB)
#define PG8_STAGE(bufoff, gbase, voff) do { _Pragma("unroll") for (int _i = 0; _i < 2; ++_i) \
        __builtin_amdgcn_global_load_lds((const unsigned*)((const char*)(gbase) + (voff)[_i]), (PG8_LAS unsigned*)(lds + (bufoff) + ldsw + _i * 8192), 16, 0, 0); } while (0)
#define PG8_LDA(dst, b, h) do { _Pragma("unroll") for (int m = 0; m < 4; ++m) _Pragma("unroll") for (int k = 0; k < 2; ++k) dst[m][k] = *(const PG8_LAS bf16x8*)(lds + PG8_SA(b, h) + aoff + m * 2048 + k * 1024); } while (0)
#define PG8_LDB(dst, b, h) do { _Pragma("unroll") for (int n = 0; n < 2; ++n) _Pragma("unroll") for (int k = 0; k < 2; ++k) dst[n][k] = *(const PG8_LAS bf16x8*)(lds + PG8_SB(b, h) + boff + n * 2048 + k * 1024); } while (0)
#define PG8_MMA(ai, bj, At, Bt) do { __builtin_amdgcn_s_setprio(1); _Pragma("unroll") for (int m = 0; m < 4; ++m) _Pragma("unroll") for (int n = 0; n < 2; ++n) _Pragma("unroll") for (int k = 0; k < 2; ++k) \
        acc[ai][bj][m][n] = __builtin_amdgcn_mfma_f32_16x16x32_bf16(Bt[n][k], At[m][k], acc[ai][bj][m][n], 0, 0, 0); __builtin_amdgcn_s_setprio(0); } while (0)
#define PG8_WAIT_V(n) asm volatile("s_waitcnt vmcnt(" #n ")" ::: "memory")
#define PG8_WAIT_L(n) asm volatile("s_waitcnt lgkmcnt(" #n ")" ::: "memory")
#define PG8_BAR __builtin_amdgcn_s_barrier()
#define PG8_SCHED __builtin_amdgcn_sched_barrier(0)
    Unit cur, nxt; int ui = 0;
    if (!S.next(0, cur)) return;
    f32x4 acc[2][2][4][2];
#pragma unroll
    for (int a = 0; a < 2; ++a)
#pragma unroll
        for (int b = 0; b < 2; ++b)
#pragma unroll
            for (int m = 0; m < 4; ++m)
#pragma unroll
                for (int n = 0; n < 2; ++n) acc[a][b][m][n] = (f32x4){0.f, 0.f, 0.f, 0.f};
    bf16x8 At[4][2], B0[2][2], B1[2][2];
    const char* cA = (const char*)g.A + cur.aoff; const char* cB = (const char*)g.Bt + cur.boff;
    S.a_ready(cur);
    if constexpr (SP2) {
        PG8_STAGE(PG8_SB(0, 0), cB, voffB); PG8_STAGE(PG8_SB(0, 1), cB + hB, voffB); PG8_STAGE(PG8_SA(0, 0), cA, voffA); PG8_STAGE(PG8_SA(0, 1), cA + hA, voffA);
        if (wr == 1) PG8_BAR;
        PG8_WAIT_V(2); PG8_BAR;
        PG8_STAGE(PG8_SB(1, 0), cB + kstep, voffB); PG8_STAGE(PG8_SA(1, 0), cA + kstep, voffA); PG8_STAGE(PG8_SB(1, 1), cB + hB + kstep, voffB);
        PG8_WAIT_V(6); PG8_BAR;
    } else {
        PG8_STAGE(PG8_SB(0, 0), cB, voffB); PG8_STAGE(PG8_SA(0, 0), cA, voffA); PG8_STAGE(PG8_SB(0, 1), cB + hB, voffB); PG8_STAGE(PG8_SA(0, 1), cA + hA, voffA);
        if (wr == 1) PG8_BAR;
        PG8_WAIT_V(4); PG8_BAR;
        PG8_STAGE(PG8_SB(1, 0), cB + kstep, voffB); PG8_STAGE(PG8_SA(1, 0), cA + kstep, voffA); PG8_STAGE(PG8_SB(1, 1), cB + hB + kstep, voffB);
        PG8_WAIT_V(6); PG8_BAR;
    }
    for (;;) {
        const bool has_next = S.next(ui + 1, nxt);
        const char* nA = has_next ? (const char*)g.A + nxt.aoff : cA; const char* nB = has_next ? (const char*)g.Bt + nxt.boff : cB;
        for (int t = 0; t < nt; t += 2) {
            const bool last = (t == nt - 2);
            const char* a1 = cA + (size_t)(t + 1) * kstep;
            const char* a2 = last ? nA : cA + (size_t)(t + 2) * kstep; const char* b2 = last ? nB : cB + (size_t)(t + 2) * kstep;
            const char* a3 = a2 + kstep; const char* b3 = b2 + kstep;
            if (last && has_next) S.a_ready(nxt);
            if constexpr (SP2) {
            PG8_LDB(B0, 0, 0); PG8_LDB(B1, 0, 1); PG8_SCHED; PG8_LDA(At, 0, 0); PG8_STAGE(PG8_SA(1, 1), a1 + hA, voffA);
            PG8_WAIT_V(8); PG8_WAIT_L(0); PG8_BAR; PG8_MMA(0, 0, At, B0); PG8_MMA(0, 1, At, B1); PG8_BAR; PG8_SCHED;
            PG8_LDA(At, 0, 1); PG8_STAGE(PG8_SB(0, 0), b2, voffB); PG8_STAGE(PG8_SB(0, 1), b2 + hB, voffB); PG8_STAGE(PG8_SA(0, 0), a2, voffA);
            PG8_WAIT_V(8); PG8_WAIT_L(0); PG8_BAR; PG8_MMA(1, 0, At, B0); PG8_MMA(1, 1, At, B1); PG8_BAR; PG8_SCHED;
            PG8_LDB(B0, 1, 0); PG8_LDB(B1, 1, 1); PG8_SCHED; PG8_LDA(At, 1, 0); PG8_STAGE(PG8_SA(0, 1), a2 + hA, voffA);
            PG8_WAIT_V(8); PG8_WAIT_L(0); PG8_BAR; PG8_MMA(0, 0, At, B0); PG8_MMA(0, 1, At, B1); PG8_BAR; PG8_SCHED;
            PG8_LDA(At, 1, 1); PG8_STAGE(PG8_SB(1, 0), b3, voffB); PG8_STAGE(PG8_SB(1, 1), b3 + hB, voffB); PG8_STAGE(PG8_SA(1, 0), a3, voffA);
            PG8_WAIT_V(8); PG8_WAIT_L(0); PG8_BAR; PG8_MMA(1, 0, At, B0); PG8_MMA(1, 1, At, B1); PG8_BAR; PG8_SCHED;
            } else {
            PG8_LDB(B0, 0, 0); PG8_SCHED; PG8_LDA(At, 0, 0); PG8_STAGE(PG8_SA(1, 1), a1 + hA, voffA);
            PG8_WAIT_L(8); PG8_BAR; PG8_WAIT_L(0); PG8_MMA(0, 0, At, B0); PG8_BAR; PG8_SCHED;
            PG8_LDB(B1, 0, 1); PG8_STAGE(PG8_SB(0, 0), b2, voffB);
            PG8_BAR; PG8_WAIT_L(0); PG8_MMA(0, 1, At, B1); PG8_BAR;
            PG8_LDA(At, 0, 1); PG8_STAGE(PG8_SA(0, 0), a2, voffA);
            PG8_BAR; PG8_WAIT_L(0); PG8_MMA(1, 0, At, B0); PG8_BAR; PG8_SCHED;
            PG8_STAGE(PG8_SB(0, 1), b2 + hB, voffB);
            PG8_WAIT_V(6); PG8_BAR; PG8_MMA(1, 1, At, B1); PG8_BAR;
            PG8_LDB(B0, 1, 0); PG8_SCHED; PG8_LDA(At, 1, 0); PG8_STAGE(PG8_SA(0, 1), a2 + hA, voffA);
            PG8_WAIT_L(8); PG8_BAR; PG8_WAIT_L(0); PG8_MMA(0, 0, At, B0); PG8_BAR; PG8_SCHED;
            PG8_LDB(B1, 1, 1); PG8_STAGE(PG8_SB(1, 0), b3, voffB);
            PG8_BAR; PG8_WAIT_L(0); PG8_MMA(0, 1, At, B1); PG8_BAR;
            PG8_LDA(At, 1, 1); PG8_STAGE(PG8_SA(1, 0), a3, voffA);
            PG8_BAR; PG8_WAIT_L(0); PG8_MMA(1, 0, At, B0); PG8_BAR; PG8_SCHED;
            PG8_STAGE(PG8_SB(1, 1), b3 + hB, voffB);
            PG8_WAIT_V(6); PG8_BAR; PG8_MMA(1, 1, At, B1); PG8_BAR;
            }
        }
        if constexpr (ALIGN_EPI) { if (wr == 0) PG8_BAR; }
        if constexpr (!Epi::AFTER_DRAIN) { E(acc, cur, wr, wc, fr, fq); S.done(cur); }
        if (!has_next) break;
#pragma unroll
        for (int a = 0; a < 2; ++a)
#pragma unroll
            for (int b = 0; b < 2; ++b)
#pragma unroll
                for (int m = 0; m < 4; ++m)
#pragma unroll
                    for (int n = 0; n < 2; ++n) acc[a][b][m][n] = (f32x4){0.f, 0.f, 0.f, 0.f};
        cur = nxt; cA = nA; cB = nB; ++ui;
        if constexpr (ALIGN_EPI) { if (wr == 1) PG8_BAR; }
    }
    PG8_WAIT_V(0);
    if constexpr (!ALIGN_EPI) { if (wr == 0) PG8_BAR; }
    PG8_BAR;
    if constexpr (Epi::AFTER_DRAIN) { E.fused(acc, cur, wr, wc, fr, fq, lds, wid, lane); S.done(cur); }
#undef PG8_SA
#undef PG8_SB
#undef PG8_STAGE
#undef PG8_LDA
#undef PG8_LDB
#undef PG8_MMA
#undef PG8_WAIT_V
#undef PG8_WAIT_L
#undef PG8_BAR
#undef PG8_SCHED
}
}
namespace pg8 {
struct EpiBf16P {
    static constexpr bool PERM = true, AFTER_DRAIN = false;
    bf16_t* O; int ldc; float sc;
    __device__ __forceinline__ void operator()(const f32x4 (&acc)[2][2][4][2], const Unit& u, int wr, int wc, int fr, int fq) const {
        const int row0 = u.pm * BM + wr * 64 + fr, col0 = u.pn * BM + wc * 32 + 8 * fq;
#pragma unroll
        for (int ai = 0; ai < 2; ++ai)
#pragma unroll
            for (int m = 0; m < 4; ++m) { bf16_t* rowp = O + (size_t)(row0 + ai * HALF + m * 16) * ldc + col0;
#pragma unroll
                for (int bj = 0; bj < 2; ++bj) { const f32x4 v0 = acc[ai][bj][m][0] * sc, v1 = acc[ai][bj][m][1] * sc;
                    u32x4 w; w.x = cvt_pk_bf16(v0[0], v0[1]); w.y = cvt_pk_bf16(v0[2], v0[3]); w.z = cvt_pk_bf16(v1[0], v1[1]); w.w = cvt_pk_bf16(v1[2], v1[3]);
                    *(u32x4*)(rowp + bj * HALF) = w; } }
    }
};
struct EpiF32Res {
    static constexpr bool PERM = false, AFTER_DRAIN = false;
    const float* base; float* out; int ldc;
    __device__ __forceinline__ void operator()(const f32x4 (&acc)[2][2][4][2], const Unit& u, int wr, int wc, int fr, int fq) const {
        const int row0 = u.pm * BM + wr * 64 + fr, col0 = u.pn * BM + wc * 32 + 4 * fq;
#pragma unroll
        for (int ai = 0; ai < 2; ++ai)
#pragma unroll
            for (int m = 0; m < 4; ++m) { const size_t off = (size_t)(row0 + ai * HALF + m * 16) * ldc + col0;
#pragma unroll
                for (int bj = 0; bj < 2; ++bj)
#pragma unroll
                    for (int n = 0; n < 2; ++n) { const f32x4 b = *(const f32x4*)(base + off + bj * HALF + n * 16); *(f32x4*)(out + off + bj * HALF + n * 16) = b + acc[ai][bj][m][n]; } }
    }
};
template <int mode> struct XAttnOrder {
    int G, c;
    __device__ __forceinline__ bool next(int i, Unit& u) const {
        const int L = i * G + c; if (L >= 256) return false;
        u.pm = L >> 2; u.pn = L & 3; const int b = u.pm >> 3;
        u.aoff = ((size_t)u.pm * 256 * 1024 + (size_t)u.pn * 256) * 2;
        u.boff = mode == 0 ? ((size_t)(b * 256) * 2048 + (size_t)u.pn * 256) * 2 : ((size_t)((b * 4 + u.pn) * 256) * 256) * 2;
        return true;
    }
    __device__ __forceinline__ void a_ready(const Unit&) const {}
    __device__ __forceinline__ void done(const Unit&) const {}
};
struct OneUnitOrder {
    int L, nN, lda, ldb;
    __device__ __forceinline__ bool next(int i, Unit& u) const {
        if (i != 0 || L < 0) return false;
        u.pm = L / nN; u.pn = L % nN; u.aoff = (size_t)u.pm * BM * lda * 2; u.boff = (size_t)u.pn * BM * ldb * 2; return true;
    }
    __device__ __forceinline__ void a_ready(const Unit&) const {}
    __device__ __forceinline__ void done(const Unit&) const {}
};
}

constexpr int NWAVES = 8;
constexpr int BATCH = 8, SEQ = 2048, DM = 1024, M = BATCH * SEQ, MEMLEN = 256, MM = BATCH * MEMLEN;
constexpr int INCOLS = 3088;
constexpr int N1 = 3328;
constexpr int PQ = 0, PK = 256, PV = 512, POG = 1024, PSQ = 1536, PSK = 2048, PSV = 2560, PGATE = 3072;
constexpr int PEER_N = 16384;
constexpr float EPS = 1e-6f;

constexpr size_t MiB = 1u << 20;
constexpr size_t WS_CTL = 0, CTL_ZERO_BYTES = 1 * MiB;
constexpr size_t WS_W1T = 1 * MiB;
constexpr size_t WS_WOT = 8 * MiB, WS_WXQT = 10 * MiB, WS_WXOT = 12 * MiB, WS_WXKVT = 14 * MiB, WS_WPQT = 18 * MiB, WS_SUBK = 22 * MiB;
constexpr size_t WS_UB = 24 * MiB, WS_VB = 56 * MiB;
constexpr size_t WS_BUFA = 88 * MiB;
constexpr size_t WS_MN = 120 * MiB;
constexpr size_t WS_KV = 124 * MiB;
constexpr size_t WS_PROJ = 132 * MiB;
constexpr size_t WS_SLOT0 = 132 * MiB, WS_SLOT1 = 164 * MiB, WS_SLOT2 = 196 * MiB, WS_VT = 228 * MiB, WS_END = 236 * MiB;
constexpr int CW_BAR = 4096;
constexpr int CW_SBSS = 32768;

constexpr int RING_BYTES = 131072;
constexpr int LDSCTL_OFF = RING_BYTES, MISC_OFF = LDSCTL_OFF + 320;
constexpr int LDS_BYTES = 147456;

#define GAS __attribute__((address_space(1)))
#define LAS __attribute__((address_space(3)))
typedef unsigned short bf16;
typedef unsigned v4u __attribute__((ext_vector_type(4)));
typedef float f32x4 __attribute__((ext_vector_type(4)));
typedef short bf16x8 __attribute__((ext_vector_type(8)));
typedef GAS unsigned gu32;
typedef GAS unsigned long long gu64;
#define RLX_AGENT __ATOMIC_RELAXED, __HIP_MEMORY_SCOPE_AGENT
#define LDS_WAIT() asm volatile("s_waitcnt lgkmcnt(0)" ::: "memory")
#define VM_WAIT() asm volatile("s_waitcnt vmcnt(0)" ::: "memory")
__device__ __forceinline__ unsigned long long rt() { return __builtin_amdgcn_s_memrealtime(); }
__device__ __forceinline__ unsigned f2bf(float f) { unsigned u = __builtin_bit_cast(unsigned, f); return (u + 0x7fffu + ((u >> 16) & 1u)) >> 16; }
__device__ __forceinline__ unsigned pk2(float lo, float hi) { return f2bf(lo) | (f2bf(hi) << 16); }

#define XB_TMO      128
#define XB_XCNT(j)  (256  + 64 * (j))
#define XB_XSUB(j)  (1280 + 64 * (j))
#define XB_XGEN(j)  (2304 + 64 * (j))
#define XB_TOP      3328
#define XB_TOPGEN   3392
#define XCD_BAR_WORDS 3456
#define XB_SPIN_CAP (1u << 22)

__device__ __forceinline__ unsigned xb_ld(unsigned* p)              { return __hip_atomic_load(p, __ATOMIC_RELAXED, __HIP_MEMORY_SCOPE_AGENT); }
__device__ __forceinline__ unsigned xb_add(unsigned* p, unsigned v) { return __hip_atomic_fetch_add(p, v, __ATOMIC_RELAXED, __HIP_MEMORY_SCOPE_AGENT); }
__device__ __forceinline__ unsigned xb_xcc_id() { return (unsigned)__builtin_amdgcn_s_getreg((3 << 11) | 20) & 0xFu; }
#define XB_SPIN(cond, bar) do { unsigned _sp = 0; while (cond) { __builtin_amdgcn_s_sleep(1); \
    if ((++_sp & 255u) == 0u) { if (xb_ld(&(bar)[XB_TMO])) break; if (_sp > XB_SPIN_CAP) { atomicAdd(&(bar)[XB_TMO], 1u); break; } } } } while (0)

struct XcdBarrier {
    unsigned* bar; unsigned x;
    volatile LAS unsigned* st;
};

__device__ __forceinline__ XcdBarrier xcd_barrier_post(unsigned* bar, volatile LAS unsigned* st) {
    XcdBarrier b; b.bar = bar; b.x = xb_xcc_id(); b.st = st;
    if (threadIdx.x == 0) (void)xb_add(&bar[XB_XCNT(b.x)], 1u);
    return b;
}
__device__ __forceinline__ void xcd_barrier_complete(unsigned* bar, unsigned x, unsigned& nloc, unsigned& nx) {
    const unsigned G = gridDim.x * gridDim.y * gridDim.z;
    unsigned sum, cnt, mine, sp = 0u;
    for (;;) {
        sum = 0u; cnt = 0u; mine = 0u;
#pragma unroll
        for (unsigned j = 0; j < 16; ++j) { const unsigned c = xb_ld(&bar[XB_XCNT(j)]); sum += c; cnt += (c > 0u) ? 1u : 0u; mine = (j == x) ? c : mine; }
        if (sum == G) break;
        __builtin_amdgcn_s_sleep(1);
        if ((++sp & 255u) == 0u) { if (xb_ld(&bar[XB_TMO])) break; if (sp > XB_SPIN_CAP) { atomicAdd(&bar[XB_TMO], 1u); break; } }
    }
    nloc = mine > 0u ? mine : 1u; nx = cnt > 0u ? cnt : 1u;
}

__device__ __forceinline__ void xcd_barrier(const XcdBarrier& b) {
    asm volatile("s_waitcnt vmcnt(0)" ::: "memory");
    __syncthreads();
    if (threadIdx.x == 0) {
        unsigned* bar = b.bar;
        __builtin_amdgcn_s_waitcnt(0);
        unsigned nloc = b.st[0], nx = b.st[1];
        if (nloc == 0u) { xcd_barrier_complete(bar, b.x, nloc, nx); b.st[0] = nloc; b.st[1] = nx; }
        const unsigned old = xb_add(&bar[XB_XSUB(b.x)], 1u);
        const unsigned gen = old / nloc;
        if (old + 1u == (gen + 1u) * nloc) {
            __builtin_amdgcn_fence(__ATOMIC_RELEASE, "agent");
            asm volatile("s_waitcnt vmcnt(0)" ::: "memory");
            const unsigned og = xb_add(&bar[XB_TOP], 1u);
            const unsigned tg = og / nx;
            if (og + 1u == (tg + 1u) * nx) xb_add(&bar[XB_TOPGEN], 1u);
            else XB_SPIN(xb_ld(&bar[XB_TOPGEN]) == tg, bar);
            __builtin_amdgcn_fence(__ATOMIC_ACQUIRE, "agent");
            xb_add(&bar[XB_XGEN(b.x)], 1u);
            asm volatile("s_waitcnt vmcnt(0)" ::: "memory");
        } else {
            XB_SPIN(xb_ld(&bar[XB_XGEN(b.x)]) == gen, bar);
            __builtin_amdgcn_fence(__ATOMIC_ACQUIRE, "agent");
            asm volatile("s_waitcnt vmcnt(0)" ::: "memory");
        }
    }
    __syncthreads();
}

#define DI __device__ __forceinline__
typedef __bf16 bf16x2_t __attribute__((ext_vector_type(2)));
struct Args { const float* in[21]; float* out; unsigned char* ws; int ph_lo, ph_hi; };
struct Frame {
    LAS unsigned char* lds;
    volatile LAS unsigned* MISC;
    gu32* ctl;
    int tid, lane, wave;
    int vcu, G;
    unsigned char* ws; float* out;
};
#define WSP(off) ((bf16*)(F.ws + (off)))
#define F_W1T WSP(WS_W1T)
#define F_WOT WSP(WS_WOT)
#define F_WXQT WSP(WS_WXQT)
#define F_WXOT WSP(WS_WXOT)
#define F_WXKVT WSP(WS_WXKVT)
#define F_WPQT WSP(WS_WPQT)
#define F_SUBK WSP(WS_SUBK)
#define F_UB WSP(WS_UB)
#define F_VB WSP(WS_VB)
#define F_BUFA WSP(WS_BUFA)
#define F_MN WSP(WS_MN)
#define F_KV WSP(WS_KV)
#define F_PROJ WSP(WS_PROJ)
#define F_SLOT0 WSP(WS_SLOT0)
#define F_SLOT1 WSP(WS_SLOT1)
#define F_SLOT2 WSP(WS_SLOT2)
#define F_VT WSP(WS_VT)
DI float bf2f(unsigned v) { return __uint_as_float(v << 16); }
DI float bflo(unsigned w) { return __uint_as_float(w << 16); }
DI float bfhi(unsigned w) { return __uint_as_float(w & 0xffff0000u); }
DI float wave_sum(float v) {
#pragma unroll
    for (int o = 1; o < 64; o <<= 1) v += __shfl_xor(v, o);
    return v;
}
DI float wave_max(float v) {
#pragma unroll
    for (int o = 1; o < 64; o <<= 1) v = fmaxf(v, __shfl_xor(v, o));
    return v;
}
DI float dot2_bf16(unsigned w, unsigned x, float a) { return __builtin_amdgcn_fdot2_f32_bf16(__builtin_bit_cast(bf16x2_t, w), __builtin_bit_cast(bf16x2_t, x), a, false); }
DI float silu_f(float x) { return x / (1.f + __expf(-x)); }
DI float log_sigmoid_f(float z) { return fminf(z, 0.f) - __logf(1.f + __expf(-fabsf(z))); }
DI float gelu_tanh_f(float x) { const float y = 0.7978845608028654f * (x + 0.044715f * x * x * x); const float t = 1.f - 2.f / (1.f + __expf(2.f * y)); return 0.5f * x * (1.f + t); }

DI void p0_transpose_item(const float* W, int ldw, int c0, bf16* WT, int row_off, LAS float* scr, int kb, int nb, int lane) {
    const int k0 = 64 * kb, n0 = 32 * nb;
#pragma unroll 8
    for (int i = 0; i < 32; ++i) { const int kk = 2 * i + (lane >> 5); scr[kk * 33 + (lane & 31)] = W[(size_t)(k0 + kk) * ldw + c0 + n0 + (lane & 31)]; }
    LDS_WAIT(); asm volatile("" ::: "memory");
    const int c = lane & 7;
#pragma unroll
    for (int j = 0; j < 4; ++j) { const int n = (lane >> 3) + 8 * j; const LAS float* s = scr + (8 * c) * 33 + n;
        v4u o; o.x = pk2(s[0 * 33], s[1 * 33]); o.y = pk2(s[2 * 33], s[3 * 33]); o.z = pk2(s[4 * 33], s[5 * 33]); o.w = pk2(s[6 * 33], s[7 * 33]);
        *(GAS v4u*)(WT + (size_t)(row_off + n0 + n) * 1024 + k0 + 8 * c) = o; }
    LDS_WAIT(); asm volatile("" ::: "memory");
}
DI void rms_row_to_bf16(int lane, const float* xrow, const float* g, bf16* orow) {
    const GAS f32x4* xr = (const GAS f32x4*)xrow + lane; const GAS f32x4* gr = (const GAS f32x4*)g + lane;
    f32x4 v[4]; float s = 0.f;
#pragma unroll
    for (int j = 0; j < 4; ++j) { v[j] = xr[64 * j]; s += (v[j].x * v[j].x + v[j].y * v[j].y) + (v[j].z * v[j].z + v[j].w * v[j].w); }
    const float rs = 1.f / sqrtf(wave_sum(s) * (1.f / 1024.f) + EPS);
    GAS unsigned long long* o8 = (GAS unsigned long long*)orow + lane;
#pragma unroll
    for (int j = 0; j < 4; ++j) { const f32x4 gg = gr[64 * j]; const f32x4 y = v[j] * rs * gg; o8[64 * j] = (unsigned long long)pk2(y.x, y.y) | ((unsigned long long)pk2(y.z, y.w) << 32); }
}
DI void p0_prologue(Frame& F, const Args& A) {
    LAS float* scr = (LAS float*)(F.lds + F.wave * 16384);
    const int gw = F.vcu * NWAVES + F.wave, NGW = F.G * NWAVES;
    constexpr int I_IN = 16 * 48, I_SQ = 16 * 32, I_W2 = 16 * 64;
    constexpr int NIT = 2 * I_IN + 3 * I_SQ + 2 * I_W2;
    for (int it = gw; it < NIT; it += NGW) {
        int r = it;
        if (r < I_IN) { p0_transpose_item(A.in[3], INCOLS, 0, F_W1T, 0, scr, r / 48, r % 48, F.lane); continue; } r -= I_IN;
        if (r < I_IN) { p0_transpose_item(A.in[3], INCOLS, 1552, F_W1T, 1536, scr, r / 48, r % 48, F.lane); continue; } r -= I_IN;
        if (r < I_SQ) { p0_transpose_item(A.in[9], 1024, 0, F_WOT, 0, scr, r / 32, r % 32, F.lane); continue; } r -= I_SQ;
        if (r < I_SQ) { p0_transpose_item(A.in[12], 1024, 0, F_WXQT, 0, scr, r / 32, r % 32, F.lane); continue; } r -= I_SQ;
        if (r < I_SQ) { p0_transpose_item(A.in[14], 1024, 0, F_WXOT, 0, scr, r / 32, r % 32, F.lane); continue; } r -= I_SQ;
        if (r < I_W2) { p0_transpose_item(A.in[13], 2048, 0, F_WXKVT, 0, scr, r / 64, r % 64, F.lane); continue; } r -= I_W2;
        p0_transpose_item(A.in[16], 2048, 0, F_WPQT, 0, scr, r / 64, r % 64, F.lane);
    }
    const int gt = gw * 64 + F.lane, NGT = NGW * 64;
    for (int i = gt; i < 256 * 128; i += NGT) {
        const int n = i >> 7, k0 = (i & 127) * 8;
        float gv[16];
#pragma unroll
        for (int r = 0; r < 16; ++r) gv[r] = A.in[5][r * 256 + n];
        float s[8];
#pragma unroll
        for (int j = 0; j < 8; ++j) { const float* wr_ = A.in[3] + (size_t)(k0 + j) * INCOLS + 1536; float a = 0.f;
#pragma unroll
            for (int r = 0; r < 16; ++r) a += wr_[r] * gv[r];
            s[j] = a; }
        v4u o; o.x = pk2(s[0], s[1]); o.y = pk2(s[2], s[3]); o.z = pk2(s[4], s[5]); o.w = pk2(s[6], s[7]);
        *(GAS v4u*)(F_W1T + (size_t)(3072 + n) * 1024 + k0) = o;
    }
    for (int m = gw; m < M; m += NGW) rms_row_to_bf16(F.lane, A.in[0] + (size_t)m * DM, A.in[2], F_BUFA + (size_t)m * DM);
    for (int m = gw; m < MM; m += NGW) rms_row_to_bf16(F.lane, A.in[1] + (size_t)m * DM, A.in[11], F_MN + (size_t)m * DM);
    {
        constexpr int NU = PEER_N * DM / 8;
        for (int i = gt; i < 2 * NU + 32768; i += NGT) {
            const float* src; bf16* dst; int j = i;
            if (j < NU) { src = A.in[18]; dst = F_UB; } else if (j < 2 * NU) { j -= NU; src = A.in[19]; dst = F_VB; } else { j -= 2 * NU; src = A.in[17]; dst = F_SUBK; }
            const f32x4 a = *(const GAS f32x4*)(src + (size_t)j * 8), b = *(const GAS f32x4*)(src + (size_t)j * 8 + 4);
            v4u o; o.x = pk2(a.x, a.y); o.y = pk2(a.z, a.w); o.z = pk2(b.x, b.y); o.w = pk2(b.z, b.w);
            *(GAS v4u*)(dst + (size_t)j * 8) = o;
        }
    }
}

DI void gla_naive_item(Frame& F, const Args& A, float* OGLA, int b, int h, int eg) {
    const int lane = F.lane, e = eg * 8 + F.wave;
    const int cq = PQ + h * 64 + lane, ck = PK + h * 64 + lane, cv = PV + h * 128 + e, cg = PGATE + h * 64 + lane;
    float wq[4], wk[4], wv[4];
#pragma unroll
    for (int k = 0; k < 4; ++k) { wq[k] = A.in[4][k * 1024 + cq]; wk[k] = A.in[4][k * 1024 + ck]; wv[k] = A.in[4][k * 1024 + cv]; }
    const float bias = A.in[6][h * 64 + lane];
    float rq0 = 0.f, rq1 = 0.f, rq2 = 0.f, rk0 = 0.f, rk1 = 0.f, rk2 = 0.f, rv0 = 0.f, rv1 = 0.f, rv2 = 0.f, S = 0.f;
    for (int t0 = 0; t0 < SEQ; t0 += 8) {
        unsigned lq[8], lk[8], lv[8], lg[8];
#pragma unroll
        for (int j = 0; j < 8; ++j) { const bf16* base = F_PROJ + (size_t)(b * SEQ + t0 + j) * N1; lq[j] = base[cq]; lk[j] = base[ck]; lv[j] = base[cv]; lg[j] = base[cg]; }
#pragma unroll
        for (int j = 0; j < 8; ++j) {
            const float xq = bf2f(lq[j]), xk = bf2f(lk[j]), xv = bf2f(lv[j]);
            const float q = silu_f(wq[0] * rq0 + wq[1] * rq1 + wq[2] * rq2 + wq[3] * xq) * 0.125f; rq0 = rq1; rq1 = rq2; rq2 = xq;
            const float k = silu_f(wk[0] * rk0 + wk[1] * rk1 + wk[2] * rk2 + wk[3] * xk); rk0 = rk1; rk1 = rk2; rk2 = xk;
            const float v = silu_f(wv[0] * rv0 + wv[1] * rv1 + wv[2] * rv2 + wv[3] * xv); rv0 = rv1; rv1 = rv2; rv2 = xv;
            const float a = __expf(log_sigmoid_f(bf2f(lg[j]) + bias) * (1.f / 16.f));
            S = a * S + k * v;
            const float o = wave_sum(q * S);
            if (lane == 0) OGLA[(size_t)(b * SEQ + t0 + j) * 512 + h * 128 + e] = o;
        }
    }
}
DI void sb_naive_item(Frame& F, float* OSB, int b, int h, int qb) {
    LAS float* Ks = (LAS float*)F.lds; LAS float* Vs = Ks + 64 * 64;
    const int tid = F.tid, t = qb * 512 + tid; const size_t row = (size_t)b * SEQ + t;
    float q[64], acc[64];
    {
        const GAS v4u* qp = (const GAS v4u*)(F_PROJ + row * N1 + PSQ + h * 64);
#pragma unroll
        for (int c = 0; c < 8; ++c) { const v4u w = qp[c]; q[8 * c + 0] = bflo(w.x) * 0.125f; q[8 * c + 1] = bfhi(w.x) * 0.125f; q[8 * c + 2] = bflo(w.y) * 0.125f; q[8 * c + 3] = bfhi(w.y) * 0.125f;
            q[8 * c + 4] = bflo(w.z) * 0.125f; q[8 * c + 5] = bfhi(w.z) * 0.125f; q[8 * c + 6] = bflo(w.w) * 0.125f; q[8 * c + 7] = bfhi(w.w) * 0.125f; }
    }
#pragma unroll
    for (int d = 0; d < 64; ++d) acc[d] = 0.f;
    float carry = 0.f;
    for (int kt = qb * 8 + 7; kt >= 0; --kt) {
        __syncthreads();
        {
            const int key = tid >> 3, ch = tid & 7; const size_t krow = (size_t)b * SEQ + kt * 64 + key;
            const v4u kw = *(const GAS v4u*)(F_PROJ + krow * N1 + PSK + h * 64 + ch * 8), vw = *(const GAS v4u*)(F_PROJ + krow * N1 + PSV + h * 64 + ch * 8);
            LAS f32x4* kd = (LAS f32x4*)(Ks + key * 64 + ch * 8); LAS f32x4* vd = (LAS f32x4*)(Vs + key * 64 + ch * 8);
            kd[0] = (f32x4){bflo(kw.x), bfhi(kw.x), bflo(kw.y), bfhi(kw.y)}; kd[1] = (f32x4){bflo(kw.z), bfhi(kw.z), bflo(kw.w), bfhi(kw.w)};
            vd[0] = (f32x4){bflo(vw.x), bfhi(vw.x), bflo(vw.y), bfhi(vw.y)}; vd[1] = (f32x4){bflo(vw.z), bfhi(vw.z), bflo(vw.w), bfhi(vw.w)};
        }
        __syncthreads();
        for (int j = 63; j >= 0; --j) {
            const int s = kt * 64 + j;
            if (s < t) {
                const LAS f32x4* kr = (const LAS f32x4*)(Ks + j * 64); const LAS f32x4* vr = (const LAS f32x4*)(Vs + j * 64);
                float z0 = 0.f, z1 = 0.f, z2 = 0.f, z3 = 0.f;
#pragma unroll
                for (int c = 0; c < 16; ++c) { const f32x4 kk = kr[c]; z0 += q[4 * c] * kk.x; z1 += q[4 * c + 1] * kk.y; z2 += q[4 * c + 2] * kk.z; z3 += q[4 * c + 3] * kk.w; }
                const float z = (z0 + z1) + (z2 + z3);
                const float lb = log_sigmoid_f(z);
                const float w = __expf(lb + carry);
                carry += lb - z;
#pragma unroll
                for (int c = 0; c < 16; ++c) { const f32x4 vv = vr[c]; acc[4 * c] += w * vv.x; acc[4 * c + 1] += w * vv.y; acc[4 * c + 2] += w * vv.z; acc[4 * c + 3] += w * vv.w; }
            }
        }
    }
    GAS f32x4* op = (GAS f32x4*)(OSB + row * 512 + h * 64);
#pragma unroll
    for (int c = 0; c < 16; ++c) op[c] = (f32x4){acc[4 * c], acc[4 * c + 1], acc[4 * c + 2], acc[4 * c + 3]};
}
DI void mix_row(Frame& F, const Args& A, const float* OGLA, const float* OSB, size_t row) {
    const int lane = F.lane;
    const f32x4 a0 = *(const GAS f32x4*)(OGLA + row * 512 + 8 * lane), a1 = *(const GAS f32x4*)(OGLA + row * 512 + 8 * lane + 4);
    float s = (a0.x * a0.x + a0.y * a0.y) + (a0.z * a0.z + a0.w * a0.w) + (a1.x * a1.x + a1.y * a1.y) + (a1.z * a1.z + a1.w * a1.w);
    s += __shfl_xor(s, 1); s += __shfl_xor(s, 2); s += __shfl_xor(s, 4); s += __shfl_xor(s, 8);
    const float rs = 1.f / sqrtf(s * (1.f / 128.f) + EPS);
    const int e0 = (8 * lane) & 127;
    const f32x4 g0 = *(const GAS f32x4*)(A.in[7] + e0), g1 = *(const GAS f32x4*)(A.in[7] + e0 + 4);
    const v4u ogw = *(const GAS v4u*)(F_PROJ + row * N1 + POG + 8 * lane);
    v4u o;
    o.x = pk2(a0.x * rs * g0.x * silu_f(bflo(ogw.x)), a0.y * rs * g0.y * silu_f(bfhi(ogw.x)));
    o.y = pk2(a0.z * rs * g0.z * silu_f(bflo(ogw.y)), a0.w * rs * g0.w * silu_f(bfhi(ogw.y)));
    o.z = pk2(a1.x * rs * g1.x * silu_f(bflo(ogw.z)), a1.y * rs * g1.y * silu_f(bfhi(ogw.z)));
    o.w = pk2(a1.z * rs * g1.z * silu_f(bflo(ogw.w)), a1.w * rs * g1.w * silu_f(bfhi(ogw.w)));
    *(GAS v4u*)(F_BUFA + row * 1024 + 8 * lane) = o;
    const f32x4 b0 = *(const GAS f32x4*)(OSB + row * 512 + 8 * lane), b1 = *(const GAS f32x4*)(OSB + row * 512 + 8 * lane + 4);
    float s2 = (b0.x * b0.x + b0.y * b0.y) + (b0.z * b0.z + b0.w * b0.w) + (b1.x * b1.x + b1.y * b1.y) + (b1.z * b1.z + b1.w * b1.w);
    const float rs2 = 1.f / sqrtf(wave_sum(s2) * (1.f / 512.f) + EPS);
    const f32x4 h0 = *(const GAS f32x4*)(A.in[8] + 8 * lane), h1 = *(const GAS f32x4*)(A.in[8] + 8 * lane + 4);
    v4u p;
    p.x = pk2(b0.x * rs2 * h0.x, b0.y * rs2 * h0.y); p.y = pk2(b0.z * rs2 * h0.z, b0.w * rs2 * h0.w);
    p.z = pk2(b1.x * rs2 * h1.x, b1.y * rs2 * h1.y); p.w = pk2(b1.z * rs2 * h1.z, b1.w * rs2 * h1.w);
    *(GAS v4u*)(F_BUFA + row * 1024 + 512 + 8 * lane) = p;
}
DI void xsoftmax_row(Frame& F, bf16* S, size_t rh) {
    unsigned long long* p = (unsigned long long*)(S + rh * 256) + F.lane;
    const unsigned long long w = *p; const unsigned lo = (unsigned)w, hi = (unsigned)(w >> 32);
    const float sc = 0.0625f;
    float a = bflo(lo) * sc, b = bfhi(lo) * sc, c = bflo(hi) * sc, d = bfhi(hi) * sc;
    const float mx = wave_max(fmaxf(fmaxf(a, b), fmaxf(c, d)));
    a = __expf(a - mx); b = __expf(b - mx); c = __expf(c - mx); d = __expf(d - mx);
    const float inv = 1.f / wave_sum((a + b) + (c + d));
    *p = (unsigned long long)pk2(a * inv, b * inv) | ((unsigned long long)pk2(c * inv, d * inv) << 32);
}
DI float topk_round2(float& c0, float& c1) {
    const float w = wave_max(fmaxf(c0, c1));
    if (c0 == w) c0 = -INFINITY; if (c1 == w) c1 = -INFINITY;
    return w;
}
DI void peer_topk_item(Frame& F, const bf16* PQb, int* IDX, float* GATE, size_t row, int h) {
    const int lane = F.lane;
    float mylist[2];
#pragma unroll
    for (int p = 0; p < 2; ++p) {
        LAS unsigned* qs = (LAS unsigned*)(F.lds + F.wave * 1024);
        qs[lane] = *(const GAS unsigned*)(PQb + row * 2048 + (h * 2 + p) * 128 + 2 * lane);
        LDS_WAIT(); asm volatile("" ::: "memory");
        const bf16* kbase = F_SUBK + (size_t)((h * 2 + p) * 128) * 128;
        float s0 = 0.f, s1 = 0.f;
        const GAS v4u* k0p = (const GAS v4u*)(kbase + (size_t)lane * 128); const GAS v4u* k1p = (const GAS v4u*)(kbase + (size_t)(lane + 64) * 128);
#pragma unroll
        for (int c = 0; c < 16; ++c) {
            const v4u a = k0p[c], b = k1p[c];
            const v4u qq = *(const LAS v4u*)(qs + 4 * c); const unsigned q0 = qq.x, q1 = qq.y, q2 = qq.z, q3 = qq.w;
            s0 += bflo(a.x) * bflo(q0) + bfhi(a.x) * bfhi(q0) + bflo(a.y) * bflo(q1) + bfhi(a.y) * bfhi(q1) + bflo(a.z) * bflo(q2) + bfhi(a.z) * bfhi(q2) + bflo(a.w) * bflo(q3) + bfhi(a.w) * bfhi(q3);
            s1 += bflo(b.x) * bflo(q0) + bfhi(b.x) * bfhi(q0) + bflo(b.y) * bflo(q1) + bfhi(b.y) * bfhi(q1) + bflo(b.z) * bflo(q2) + bfhi(b.z) * bfhi(q2) + bflo(b.w) * bflo(q3) + bfhi(b.w) * bfhi(q3);
        }
        float c0 = __uint_as_float((__float_as_uint(s0) & ~0x7fu) | (unsigned)lane), c1 = __uint_as_float((__float_as_uint(s1) & ~0x7fu) | (unsigned)(lane + 64));
        float mine = 0.f;
#pragma unroll
        for (int r = 0; r < 16; ++r) { const float w = topk_round2(c0, c1); if (lane == r) mine = w; }
        mylist[p] = mine;
        LDS_WAIT(); asm volatile("" ::: "memory");
    }
    const float va = __uint_as_float(__float_as_uint(__shfl(mylist[0], lane >> 2)) & ~0x7fu);
    float cand[4];
#pragma unroll
    for (int j = 0; j < 4; ++j) { const int bb = 4 * (lane & 3) + j; const float vb = __uint_as_float(__float_as_uint(__shfl(mylist[1], bb)) & ~0x7fu);
        cand[j] = __uint_as_float((__float_as_uint(va + vb) & ~0xffu) | (unsigned)((lane >> 2) * 16 + bb)); }
    float best = 0.f, top = 0.f;
#pragma unroll
    for (int r = 0; r < 16; ++r) {
        const float w = wave_max(fmaxf(fmaxf(cand[0], cand[1]), fmaxf(cand[2], cand[3])));
#pragma unroll
        for (int j = 0; j < 4; ++j) if (cand[j] == w) cand[j] = -INFINITY;
        if (lane == r) best = w; if (r == 0) top = w;
    }
    const unsigned bu = __float_as_uint(best); const int ca = (bu >> 4) & 15, cb = bu & 15;
    const int i1 = (int)(__float_as_uint(__shfl(mylist[0], ca)) & 0x7fu), i2 = (int)(__float_as_uint(__shfl(mylist[1], cb)) & 0x7fu);
    const float sc = __uint_as_float(bu & ~0xffu), tp = __uint_as_float(__float_as_uint(top) & ~0xffu);
    const float ex = lane < 16 ? __expf(sc - tp) : 0.f;
    const float inv = 1.f / wave_sum(ex);
    if (lane < 16) { IDX[row * 128 + h * 16 + lane] = i1 * 128 + i2; GATE[row * 128 + h * 16 + lane] = ex * inv; }
}
DI void peer_gather_row(Frame& F, const Args& A, const bf16* XN2, const int* IDX, const float* GATE, size_t row) {
    const int lane = F.lane;
    const v4u xa = *(const GAS v4u*)(XN2 + row * 1024 + 8 * lane), xb = *(const GAS v4u*)(XN2 + row * 1024 + 512 + 8 * lane);
    const int id0 = IDX[row * 128 + lane], id1 = IDX[row * 128 + 64 + lane];
    const float g0 = GATE[row * 128 + lane], g1 = GATE[row * 128 + 64 + lane];
    float acc[16];
#pragma unroll
    for (int i = 0; i < 16; ++i) acc[i] = 0.f;
#define PEER_DOT2(w, x, a) dot2_bf16((w), (x), (a))
    for (int half = 0; half < 2; ++half) {
        const int idv = half ? id1 : id0; const float gv = half ? g1 : g0;
        for (int e0 = 0; e0 < 64; e0 += 4) {
            v4u ua[4], ub[4], va[4], vb[4]; float gt[4];
#pragma unroll
            for (int j = 0; j < 4; ++j) {
                const int id = __builtin_amdgcn_readlane(idv, e0 + j); gt[j] = __uint_as_float(__builtin_amdgcn_readlane(__float_as_uint(gv), e0 + j));
                const bf16* up = F_UB + (size_t)id * 1024; const bf16* vp = F_VB + (size_t)id * 1024;
                ua[j] = *(const GAS v4u*)(up + 8 * lane); ub[j] = *(const GAS v4u*)(up + 512 + 8 * lane);
                va[j] = *(const GAS v4u*)(vp + 8 * lane); vb[j] = *(const GAS v4u*)(vp + 512 + 8 * lane);
            }
#pragma unroll
            for (int j = 0; j < 4; ++j) {
                float d0 = 0.f, d1 = 0.f;
                d0 = PEER_DOT2(ua[j].x, xa.x, d0); d1 = PEER_DOT2(ua[j].y, xa.y, d1); d0 = PEER_DOT2(ua[j].z, xa.z, d0); d1 = PEER_DOT2(ua[j].w, xa.w, d1);
                d0 = PEER_DOT2(ub[j].x, xb.x, d0); d1 = PEER_DOT2(ub[j].y, xb.y, d1); d0 = PEER_DOT2(ub[j].z, xb.z, d0); d1 = PEER_DOT2(ub[j].w, xb.w, d1);
                const float a = wave_sum(d0 + d1);
                const float cf = gt[j] * gelu_tanh_f(a);
                acc[0] += cf * bflo(va[j].x); acc[1] += cf * bfhi(va[j].x); acc[2] += cf * bflo(va[j].y); acc[3] += cf * bfhi(va[j].y);
                acc[4] += cf * bflo(va[j].z); acc[5] += cf * bfhi(va[j].z); acc[6] += cf * bflo(va[j].w); acc[7] += cf * bfhi(va[j].w);
                acc[8] += cf * bflo(vb[j].x); acc[9] += cf * bfhi(vb[j].x); acc[10] += cf * bflo(vb[j].y); acc[11] += cf * bfhi(vb[j].y);
                acc[12] += cf * bflo(vb[j].z); acc[13] += cf * bfhi(vb[j].z); acc[14] += cf * bflo(vb[j].w); acc[15] += cf * bfhi(vb[j].w);
            }
        }
    }
#undef PEER_DOT2
    float* hp = F.out + row * 1024;
    f32x4 y[4]; const int c0 = 8 * lane, c1 = 512 + 8 * lane;
    y[0] = *(const GAS f32x4*)(hp + c0); y[1] = *(const GAS f32x4*)(hp + c0 + 4); y[2] = *(const GAS f32x4*)(hp + c1); y[3] = *(const GAS f32x4*)(hp + c1 + 4);
    float ss = 0.f;
#pragma unroll
    for (int i = 0; i < 4; ++i) { y[i].x += acc[4 * i]; y[i].y += acc[4 * i + 1]; y[i].z += acc[4 * i + 2]; y[i].w += acc[4 * i + 3]; ss += (y[i].x * y[i].x + y[i].y * y[i].y) + (y[i].z * y[i].z + y[i].w * y[i].w); }
    const float rs = 1.f / sqrtf(wave_sum(ss) * (1.f / 1024.f) + EPS);
    const f32x4 g0v = *(const GAS f32x4*)(A.in[20] + c0), g1v = *(const GAS f32x4*)(A.in[20] + c0 + 4), g2v = *(const GAS f32x4*)(A.in[20] + c1), g3v = *(const GAS f32x4*)(A.in[20] + c1 + 4);
    *(GAS f32x4*)(hp + c0) = y[0] * rs * g0v; *(GAS f32x4*)(hp + c0 + 4) = y[1] * rs * g1v; *(GAS f32x4*)(hp + c1) = y[2] * rs * g2v; *(GAS f32x4*)(hp + c1 + 4) = y[3] * rs * g3v;
}

__global__ void __launch_bounds__(NWAVES * 64, 2) fwd_kernel(Args args) {
    extern __shared__ __attribute__((aligned(16))) unsigned char lds[];
    Frame F;
    F.lds = (LAS unsigned char*)lds;
    F.MISC = (volatile LAS unsigned*)(F.lds + MISC_OFF);
    F.tid = threadIdx.x; F.lane = F.tid & 63; F.wave = __builtin_amdgcn_readfirstlane(F.tid >> 6);
    F.G = gridDim.x; { const int bx = blockIdx.x; F.vcu = (F.G % 8 == 0) ? (bx % 8) * (F.G / 8) + bx / 8 : bx; }
    unsigned char* ws = args.ws;
    F.ctl = (gu32*)(ws + WS_CTL);
    F.out = args.out; F.ws = ws;
    for (int u = F.tid; u < (LDS_BYTES - LDSCTL_OFF) / 4; u += NWAVES * 64) ((LAS unsigned*)(F.lds + LDSCTL_OFF))[u] = 0u;
    __syncthreads();
    XcdBarrier bar = xcd_barrier_post((unsigned*)(F.ctl + CW_BAR), F.MISC + 8);
    const int lo = args.ph_lo, hi = args.ph_hi;
#ifndef PH_MASK
#define PH_MASK 0x7fff
#endif
#define IN(k) (((PH_MASK >> (k)) & 1) && lo <= (k) && (k) < hi)
#define SEAM(k) do { if (IN(k) && IN((k) + 1)) xcd_barrier(bar); } while (0)
    const int gw = F.vcu * NWAVES + F.wave, NGW = F.G * NWAVES;
#define OGLA (F.out)
#define OSB (F.out + (size_t)M * 512)
#define IDX ((int*)F_BUFA)
#define GATE ((float*)(F_BUFA) + (size_t)M * 128)

    if (IN(0)) { p0_prologue(F, args); } SEAM(0);
    if (IN(1)) {
        { pg8::Gemm g{F_BUFA, F_W1T, 1024, 1024, 1024}; pg8::StaticOrder S; S.init(M, N1, F.G, (int)blockIdx.x, 1024, 1024);
          pg8::EpiBf16P E{F_PROJ, N1, 1.f};
          pg8::gemm_phase<pg8::EpiBf16P, pg8::StaticOrder, true, true>(F.lds, g, S, E); }
        { pg8::Gemm g{F_MN, F_WXKVT, 1024, 1024, 1024}; const int c = (int)blockIdx.x; pg8::OneUnitOrder S{(c >= 64 && c < 128) ? c - 64 : -1, 8, 1024, 1024};
          pg8::EpiBf16P E{F_KV, 2048, 1.f};
          pg8::gemm_phase<pg8::EpiBf16P, pg8::OneUnitOrder, true, true>(F.lds, g, S, E); }
    } SEAM(1);
    if (IN(2)) {
        for (int it = F.vcu; it < 256; it += F.G) { const int qb = 3 - (it & 3), bh = it >> 2; sb_naive_item(F, OSB, bh >> 3, bh & 7, qb); }
        __syncthreads();
        for (int it = F.vcu; it < 512; it += F.G) gla_naive_item(F, args, OGLA, it >> 6, (it >> 4) & 3, it & 15);
    } SEAM(2);
    if (IN(3)) { for (int m = gw; m < M; m += NGW) mix_row(F, args, OGLA, OSB, (size_t)m); } SEAM(3);
    if (IN(4)) { pg8::Gemm g{F_BUFA, F_WOT, 1024, 1024, 1024}; pg8::StaticOrder S; S.init(M, 1024, F.G, (int)blockIdx.x, 1024, 1024);
        pg8::EpiF32Res E{args.in[0], F.out, 1024};
        pg8::gemm_phase<pg8::EpiF32Res, pg8::StaticOrder, true, true>(F.lds, g, S, E); } SEAM(4);
    if (IN(5)) {
        for (int m = gw; m < M; m += NGW) rms_row_to_bf16(F.lane, F.out + (size_t)m * DM, args.in[10], F_SLOT0 + (size_t)m * DM);
        const int gt = gw * 64 + F.lane, NGT = NGW * 64;
        for (int i = gt; i < 8 * 4 * 256 * 32; i += NGT) { const int mc = i & 31, d = (i >> 5) & 255, h = (i >> 13) & 3, b = i >> 15;
            unsigned short v[8];
#pragma unroll
            for (int j = 0; j < 8; ++j) v[j] = F_KV[(size_t)(b * 256 + mc * 8 + j) * 2048 + 1024 + h * 256 + d];
            v4u o; o.x = v[0] | ((unsigned)v[1] << 16); o.y = v[2] | ((unsigned)v[3] << 16); o.z = v[4] | ((unsigned)v[5] << 16); o.w = v[6] | ((unsigned)v[7] << 16);
            *(GAS v4u*)(F_VT + (size_t)((b * 4 + h) * 256 + d) * 256 + mc * 8) = o; }
    } SEAM(5);
    if (IN(6)) { pg8::Gemm g{F_SLOT0, F_WXQT, 1024, 1024, 1024}; pg8::StaticOrder S; S.init(M, 1024, F.G, (int)blockIdx.x, 1024, 1024);
        pg8::EpiBf16P E{F_SLOT2, 1024, 1.f};
        pg8::gemm_phase<pg8::EpiBf16P, pg8::StaticOrder, true, true>(F.lds, g, S, E); } SEAM(6);
    if (IN(7)) { pg8::Gemm g{F_SLOT2, F_KV, 256, 1024, 2048}; pg8::XAttnOrder<0> S{F.G, (int)blockIdx.x};
        pg8::EpiBf16P E{F_SLOT1, 1024, 1.f};
        pg8::gemm_phase<pg8::EpiBf16P, pg8::XAttnOrder<0>, true, true>(F.lds, g, S, E); } SEAM(7);
    if (IN(8)) { for (int r = gw; r < M * 4; r += NGW) xsoftmax_row(F, F_SLOT1, (size_t)r); } SEAM(8);
    if (IN(9)) { pg8::Gemm g{F_SLOT1, F_VT, 256, 1024, 256}; pg8::XAttnOrder<1> S{F.G, (int)blockIdx.x};
        pg8::EpiBf16P E{F_SLOT0, 1024, 1.f};
        pg8::gemm_phase<pg8::EpiBf16P, pg8::XAttnOrder<1>, true, true>(F.lds, g, S, E); } SEAM(9);
    if (IN(10)) { pg8::Gemm g{F_SLOT0, F_WXOT, 1024, 1024, 1024}; pg8::StaticOrder S; S.init(M, 1024, F.G, (int)blockIdx.x, 1024, 1024);
        pg8::EpiF32Res E{F.out, F.out, 1024};
        pg8::gemm_phase<pg8::EpiF32Res, pg8::StaticOrder, true, true>(F.lds, g, S, E); } SEAM(10);
    if (IN(11)) { for (int m = gw; m < M; m += NGW) rms_row_to_bf16(F.lane, F.out + (size_t)m * DM, args.in[15], F_SLOT2 + (size_t)m * DM); } SEAM(11);
    if (IN(12)) { pg8::Gemm g{F_SLOT2, F_WPQT, 1024, 1024, 1024}; pg8::StaticOrder S; S.init(M, 2048, F.G, (int)blockIdx.x, 1024, 1024);
        pg8::EpiBf16P E{F_SLOT0, 2048, 1.f};
        pg8::gemm_phase<pg8::EpiBf16P, pg8::StaticOrder, true, true>(F.lds, g, S, E); } SEAM(12);
    if (IN(13)) { for (int r = gw; r < M * 8; r += NGW) peer_topk_item(F, F_SLOT0, IDX, GATE, (size_t)(r >> 3), r & 7); } SEAM(13);
    if (IN(14)) { for (int m = gw; m < M; m += NGW) peer_gather_row(F, args, F_SLOT2, IDX, GATE, (size_t)m); }
#undef IN
#undef SEAM
}

constexpr int NPHASES = 15;
#ifndef MK_PER_PHASE
#define MK_PER_PHASE 0
#endif
extern "C" void kernel_launch(void* const* d_in, const int* in_sizes, int n_in, void* d_out, int out_size, void* d_ws, size_t ws_size, hipStream_t stream) {
    static int grid = 0;
    if (grid == 0) {
        if (n_in != 21 || out_size != M * DM || ws_size < WS_END) { fprintf(stderr, "kernel_launch: unexpected shapes (n_in %d out %d ws %zu)\n", n_in, out_size, ws_size); grid = -1; return; }
        int dev = 0, cus = 0, per_cu = 0;
        if (hipGetDevice(&dev) != hipSuccess || hipDeviceGetAttribute(&cus, hipDeviceAttributeMultiprocessorCount, dev) != hipSuccess) { grid = -1; return; }
        if (hipFuncSetAttribute((const void*)fwd_kernel, hipFuncAttributeMaxDynamicSharedMemorySize, LDS_BYTES) != hipSuccess) { fprintf(stderr, "kernel_launch: hipFuncSetAttribute failed\n"); grid = -1; return; }
        if (hipOccupancyMaxActiveBlocksPerMultiprocessor(&per_cu, (const void*)fwd_kernel, NWAVES * 64, LDS_BYTES) != hipSuccess || per_cu < 1) { fprintf(stderr, "kernel_launch: occupancy query says %d\n", per_cu); }
        (void)hipGetLastError();
        grid = cus;
    }
    if (grid < 0) return;
    (void)hipMemsetAsync((char*)d_ws + WS_CTL, 0, CTL_ZERO_BYTES, stream);
    Args a{};
    for (int i = 0; i < 21; ++i) a.in[i] = (const float*)d_in[i];
    a.out = (float*)d_out; a.ws = (unsigned char*)d_ws;
#if MK_PER_PHASE
    for (int p = 0; p < NPHASES; ++p) { a.ph_lo = p; a.ph_hi = p + 1; hipLaunchKernelGGL(fwd_kernel, dim3(grid), dim3(NWAVES * 64), LDS_BYTES, stream, a); }
#else
    a.ph_lo = 0; a.ph_hi = NPHASES;
    hipLaunchKernelGGL(fwd_kernel, dim3(grid), dim3(NWAVES * 64), LDS_BYTES, stream, a);
#endif
}
```

```cpp
#include <hip/hip_runtime.h>
#include <cstdio>
#include <cstdint>
namespace pg8 {
#define PG8_LAS __attribute__((address_space(3)))
typedef unsigned short bf16_t;
typedef short bf16x8 __attribute__((ext_vector_type(8)));
typedef float f32x4 __attribute__((ext_vector_type(4)));
typedef unsigned u32x4 __attribute__((ext_vector_type(4)));
constexpr int BM = 256, BK = 64, HALF = 128, HTB = HALF * BK * 2  , STAGE_BYTES = 8 * HTB, NXCD = 8, WGM = 8;

__host__ __device__ __forceinline__ int lds_byte(int r, int c) { const int st = (r >> 4) * 2 + (c >> 5), rr = r & 15, cc = c & 31, ob = rr * 64 + cc * 2; return st * 1024 + (ob ^ (((ob >> 9) & 1) << 5)); }
__host__ __device__ __forceinline__ void stage_rc(int b, int& R, int& C) { const int st = b / 1024, sb = b % 1024, swz = sb ^ (((sb >> 9) & 1) << 5); R = (st >> 1) * 16 + swz / 64; C = (st & 1) * 32 + (swz % 64) / 2; }
__host__ __device__ __forceinline__ int perm32(int rho) { const int n = rho >> 4, i = rho & 15; return 8 * (i >> 2) + 4 * n + (i & 3); }

struct Unit { int pm, pn; size_t aoff, boff; };
struct Gemm { const bf16_t* A; const bf16_t* Bt; int K, lda, ldb; };

struct StaticOrder {
    int nM, nN, nwg, G, c, lda, ldb;
    __host__ __device__ void init(int M, int N, int G_, int c_, int lda_, int ldb_) { nM = M / BM; nN = N / BM; nwg = nM * nN; G = G_; c = c_; lda = lda_; ldb = ldb_; }
    __host__ __device__ bool next(int i, Unit& u) const {
        const long L = (long)i * G + c; if (L >= nwg) return false;
        int wgid = (int)L; { const int q = nwg / NXCD, r = nwg % NXCD, xcd = wgid % NXCD, off = wgid / NXCD; wgid = (xcd < r ? xcd * (q + 1) : r * (q + 1) + (xcd - r) * q) + off; }
        const int nig = WGM * nN, gid = wgid / nig, fm = gid * WGM, gsz = (nM - fm) < WGM ? (nM - fm) : WGM;
        u.pm = fm + ((wgid % nig) % gsz); u.pn = (wgid % nig) / gsz; u.aoff = (size_t)u.pm * BM * lda * 2; u.boff = (size_t)u.pn * BM * ldb * 2; return true;
    }
    __device__ __forceinline__ void a_ready(const Unit&) const {}
    __device__ __forceinline__ void done(const Unit&) const {}
};

__device__ __forceinline__ unsigned cvt_pk_bf16(float lo, float hi) { unsigned r; asm volatile("v_cvt_pk_bf16_f32 %0, %1, %2" : "=v"(r) : "v"(lo), "v"(hi)); return r; }
typedef float f32x2 __attribute__((ext_vector_type(2)));
__device__ __forceinline__ f32x2 gelu_pk(f32x2 v) {
    const f32x2 av = __builtin_elementwise_abs(v), d = av * 0.2316418882f + 1.0f;
    f32x2 t; t.x = __builtin_amdgcn_rcpf(d.x); t.y = __builtin_amdgcn_rcpf(d.y);
    f32x2 q = t * 0.5307027145f + (-0.7265760135f); q = q * t + 0.7107068705f; q = q * t + (-0.142248368f); q = q * t + 0.127414796f; q = q * t;
    const f32x2 s = (v * v) * (-0.72134752044f);
    f32x2 e; e.x = __builtin_amdgcn_exp2f(s.x); e.y = __builtin_amdgcn_exp2f(s.y);
    const f32x2 m = v * (q * e), r = v - m;
    f32x2 o; o.x = v.x < 0.f ? m.x : r.x; o.y = v.y < 0.f ? m.y : r.y; return o;
}

template <int ACT  > struct EpiBf16 {
    static constexpr bool PERM = true, AFTER_DRAIN = false; static_assert(ACT == 0 || ACT == 1, "EpiBf16: ACT is 0 (none) or 1 (gelu_pk)");
    bf16_t* O; int ldc; const float* bias; int split_cols; size_t split_stride; float scale0;
    __device__ __forceinline__ void operator()(const f32x4 (&acc)[2][2][4][2], const Unit& u, int wr, int wc, int fr, int fq) const {
        const int row0 = u.pm * BM + wr * 64 + fr; int colt = u.pn * BM; bf16_t* base = O;
        float sc = 1.f; if (split_cols) { const int t = colt / split_cols; base += (size_t)t * split_stride; colt -= t * split_cols; if (t == 0) sc = scale0; }
        const int col0 = colt + wc * 32 + 8 * fq, bcol0 = u.pn * BM + wc * 32 + 8 * fq;
        f32x4 bv[2][2];
#pragma unroll
        for (int bj = 0; bj < 2; ++bj)
#pragma unroll
            for (int n = 0; n < 2; ++n) bv[bj][n] = bias ? *(const f32x4*)(bias + bcol0 + bj * HALF + 4 * n) : (f32x4){0.f, 0.f, 0.f, 0.f};
#pragma unroll
        for (int ai = 0; ai < 2; ++ai)
#pragma unroll
            for (int m = 0; m < 4; ++m) { bf16_t* rowp = base + (size_t)(row0 + ai * HALF + m * 16) * ldc + col0;
#pragma unroll
                for (int bj = 0; bj < 2; ++bj) { f32x4 v0 = acc[ai][bj][m][0] + bv[bj][0], v1 = acc[ai][bj][m][1] + bv[bj][1];
                    if (ACT == 1) { f32x2 a = gelu_pk((f32x2){v0[0], v0[1]}), b = gelu_pk((f32x2){v0[2], v0[3]}), c = gelu_pk((f32x2){v1[0], v1[1]}), d = gelu_pk((f32x2){v1[2], v1[3]});
                        v0 = (f32x4){a.x, a.y, b.x, b.y}; v1 = (f32x4){c.x, c.y, d.x, d.y}; }
                    v0 = v0 * sc; v1 = v1 * sc; u32x4 w; w.x = cvt_pk_bf16(v0[0], v0[1]); w.y = cvt_pk_bf16(v0[2], v0[3]); w.z = cvt_pk_bf16(v1[0], v1[1]); w.w = cvt_pk_bf16(v1[2], v1[3]);
                    *(u32x4*)(rowp + bj * HALF) = w; } }
    }
};
template <class Epi, class Sched, bool ALIGN_EPI = false, bool SP2 = false>
__device__ __forceinline__ void gemm_phase(PG8_LAS unsigned char* lds, const Gemm g, const Sched& S, const Epi& E) {
    const int tid = threadIdx.x, wid = __builtin_amdgcn_readfirstlane(tid >> 6), lane = tid & 63, wr = wid >> 2, wc = wid & 3, fr = lane & 15, fq = lane >> 4;
    int K = g.K; asm volatile("" : "+s"(K));
    const int nt = K / BK;
    unsigned voffA[2], voffB[2];
#pragma unroll
    for (int i = 0; i < 2; ++i) { int R, C; stage_rc(tid * 16 + i * 8192, R, C); const int Rb = Epi::PERM ? ((R & ~31) + perm32(R & 31)) : R;
        voffA[i] = (unsigned)(R * g.lda + C) * 2u; voffB[i] = (unsigned)(Rb * g.ldb + C) * 2u; }
    const size_t kstep = (size_t)(BK * 2);
    const size_t hA = (size_t)HALF * g.lda * 2, hB = (size_t)HALF * g.ldb * 2;
    const unsigned ldsw = (unsigned)wid * 1024u;
    const int aoff = lds_byte(wr * 64 + fr, fq * 8), boff = lds_byte(wc * 32 + fr, fq * 8);
#define PG8_SA(b, h) (((b) * 2 + (h)) * HTB)
#define PG8_SB(b, h) ((4 + (b) * 2 + (h)) * HTB)
#define PG8_STAGE(bufoff, gbase, voff) do { _Pragma("unroll") for (int _i = 0; _i < 2; ++_i) \
        __builtin_amdgcn_global_load_lds((const unsigned*)((const char*)(gbase) + (voff)[_i]), (PG8_LAS unsigned*)(lds + (bufoff) + ldsw + _i * 8192), 16, 0, 0); } while (0)
#define PG8_LDA(dst, b, h) do { _Pragma("unroll") for (int m = 0; m < 4; ++m) _Pragma("unroll") for (int k = 0; k < 2; ++k) dst[m][k] = *(const PG8_LAS bf16x8*)(lds + PG8_SA(b, h) + aoff + m * 2048 + k * 1024); } while (0)
#define PG8_LDB(dst, b, h) do { _Pragma("unroll") for (int n = 0; n < 2; ++n) _Pragma("unroll") for (int k = 0; k < 2; ++k) dst[n][k] = *(const PG8_LAS bf16x8*)(lds + PG8_SB(b, h) + boff + n * 2048 + k * 1024); } while (0)
#define PG8_MMA(ai, bj, At, Bt) do { __builtin_amdgcn_s_setprio(1); _Pragma("unroll") for (int m = 0; m < 4; ++m) _Pragma("unroll") for (int n = 0; n < 2; ++n) _Pragma("unroll") for (int k = 0; k < 2; ++k) \
        acc[ai][bj][m][n] = __builtin_amdgcn_mfma_f32_16x16x32_bf16(Bt[n][k], At[m][k], acc[ai][bj][m][n], 0, 0, 0); __builtin_amdgcn_s_setprio(0); } while (0)
#define PG8_WAIT_V(n) asm volatile("s_waitcnt vmcnt(" #n ")" ::: "memory")
#define PG8_WAIT_L(n) asm volatile("s_waitcnt lgkmcnt(" #n ")" ::: "memory")
#define PG8_BAR __builtin_amdgcn_s_barrier()
#define PG8_SCHED __builtin_amdgcn_sched_barrier(0)
    Unit cur, nxt; int ui = 0;
    if (!S.next(0, cur)) return;
    f32x4 acc[2][2][4][2];
#pragma unroll
    for (int a = 0; a < 2; ++a)
#pragma unroll
        for (int b = 0; b < 2; ++b)
#pragma unroll
            for (int m = 0; m < 4; ++m)
#pragma unroll
                for (int n = 0; n < 2; ++n) acc[a][b][m][n] = (f32x4){0.f, 0.f, 0.f, 0.f};
    bf16x8 At[4][2], B0[2][2], B1[2][2];
    const char* cA = (const char*)g.A + cur.aoff; const char* cB = (const char*)g.Bt + cur.boff;
    S.a_ready(cur);
    if constexpr (SP2) {
        PG8_STAGE(PG8_SB(0, 0), cB, voffB); PG8_STAGE(PG8_SB(0, 1), cB + hB, voffB); PG8_STAGE(PG8_SA(0, 0), cA, voffA); PG8_STAGE(PG8_SA(0, 1), cA + hA, voffA);
        if (wr == 1) PG8_BAR;
        PG8_WAIT_V(2); PG8_BAR;
        PG8_STAGE(PG8_SB(1, 0), cB + kstep, voffB); PG8_STAGE(PG8_SA(1, 0), cA + kstep, voffA); PG8_STAGE(PG8_SB(1, 1), cB + hB + kstep, voffB);
        PG8_WAIT_V(6); PG8_BAR;
    } else {
        PG8_STAGE(PG8_SB(0, 0), cB, voffB); PG8_STAGE(PG8_SA(0, 0), cA, voffA); PG8_STAGE(PG8_SB(0, 1), cB + hB, voffB); PG8_STAGE(PG8_SA(0, 1), cA + hA, voffA);
        if (wr == 1) PG8_BAR;
        PG8_WAIT_V(4); PG8_BAR;
        PG8_STAGE(PG8_SB(1, 0), cB + kstep, voffB); PG8_STAGE(PG8_SA(1, 0), cA + kstep, voffA); PG8_STAGE(PG8_SB(1, 1), cB + hB + kstep, voffB);
        PG8_WAIT_V(6); PG8_BAR;
    }
    for (;;) {
        const bool has_next = S.next(ui + 1, nxt);
        const char* nA = has_next ? (const char*)g.A + nxt.aoff : cA; const char* nB = has_next ? (const char*)g.Bt + nxt.boff : cB;
        for (int t = 0; t < nt; t += 2) {
            const bool last = (t == nt - 2);
            const char* a1 = cA + (size_t)(t + 1) * kstep;
            const char* a2 = last ? nA : cA + (size_t)(t + 2) * kstep; const char* b2 = last ? nB : cB + (size_t)(t + 2) * kstep;
            const char* a3 = a2 + kstep; const char* b3 = b2 + kstep;
            if (last && has_next) S.a_ready(nxt);
            if constexpr (SP2) {
            PG8_LDB(B0, 0, 0); PG8_LDB(B1, 0, 1); PG8_SCHED; PG8_LDA(At, 0, 0); PG8_STAGE(PG8_SA(1, 1), a1 + hA, voffA);
            PG8_WAIT_V(8); PG8_WAIT_L(0); PG8_BAR; PG8_MMA(0, 0, At, B0); PG8_MMA(0, 1, At, B1); PG8_BAR; PG8_SCHED;
            PG8_LDA(At, 0, 1); PG8_STAGE(PG8_SB(0, 0), b2, voffB); PG8_STAGE(PG8_SB(0, 1), b2 + hB, voffB); PG8_STAGE(PG8_SA(0, 0), a2, voffA);
            PG8_WAIT_V(8); PG8_WAIT_L(0); PG8_BAR; PG8_MMA(1, 0, At, B0); PG8_MMA(1, 1, At, B1); PG8_BAR; PG8_SCHED;
            PG8_LDB(B0, 1, 0); PG8_LDB(B1, 1, 1); PG8_SCHED; PG8_LDA(At, 1, 0); PG8_STAGE(PG8_SA(0, 1), a2 + hA, voffA);
            PG8_WAIT_V(8); PG8_WAIT_L(0); PG8_BAR; PG8_MMA(0, 0, At, B0); PG8_MMA(0, 1, At, B1); PG8_BAR; PG8_SCHED;
            PG8_LDA(At, 1, 1); PG8_STAGE(PG8_SB(1, 0), b3, voffB); PG8_STAGE(PG8_SB(1, 1), b3 + hB, voffB); PG8_STAGE(PG8_SA(1, 0), a3, voffA);
            PG8_WAIT_V(8); PG8_WAIT_L(0); PG8_BAR; PG8_MMA(1, 0, At, B0); PG8_MMA(1, 1, At, B1); PG8_BAR; PG8_SCHED;
            } else {
            PG8_LDB(B0, 0, 0); PG8_SCHED; PG8_LDA(At, 0, 0); PG8_STAGE(PG8_SA(1, 1), a1 + hA, voffA);
            PG8_WAIT_L(8); PG8_BAR; PG8_WAIT_L(0); PG8_MMA(0, 0, At, B0); PG8_BAR; PG8_SCHED;
            PG8_LDB(B1, 0, 1); PG8_STAGE(PG8_SB(0, 0), b2, voffB);
            PG8_BAR; PG8_WAIT_L(0); PG8_MMA(0, 1, At, B1); PG8_BAR;
            PG8_LDA(At, 0, 1); PG8_STAGE(PG8_SA(0, 0), a2, voffA);
            PG8_BAR; PG8_WAIT_L(0); PG8_MMA(1, 0, At, B0); PG8_BAR; PG8_SCHED;
            PG8_STAGE(PG8_SB(0, 1), b2 + hB, voffB);
            PG8_WAIT_V(6); PG8_BAR; PG8_MMA(1, 1, At, B1); PG8_BAR;
            PG8_LDB(B0, 1, 0); PG8_SCHED; PG8_LDA(At, 1, 0); PG8_STAGE(PG8_SA(0, 1), a2 + hA, voffA);
            PG8_WAIT_L(8); PG8_BAR; PG8_WAIT_L(0); PG8_MMA(0, 0, At, B0); PG8_BAR; PG8_SCHED;
            PG8_LDB(B1, 1, 1); PG8_STAGE(PG8_SB(1, 0), b3, voffB);
            PG8_BAR; PG8_WAIT_L(0); PG8_MMA(0, 1, At, B1); PG8_BAR;
            PG8_LDA(At, 1, 1); PG8_STAGE(PG8_SA(1, 0), a3, voffA);
            PG8_BAR; PG8_WAIT_L(0); PG8_MMA(1, 0, At, B0); PG8_BAR; PG8_SCHED;
            PG8_STAGE(PG8_SB(1, 1), b3 + hB, voffB);
            PG8_WAIT_V(6); PG8_BAR; PG8_MMA(1, 1, At, B1); PG8_BAR;
            }
        }
        if constexpr (ALIGN_EPI) { if (wr == 0) PG8_BAR; }
        if constexpr (!Epi::AFTER_DRAIN) { E(acc, cur, wr, wc, fr, fq); S.done(cur); }
        if (!has_next) break;
#pragma unroll
        for (int a = 0; a < 2; ++a)
#pragma unroll
            for (int b = 0; b < 2; ++b)
#pragma unroll
                for (int m = 0; m < 4; ++m)
#pragma unroll
                    for (int n = 0; n < 2; ++n) acc[a][b][m][n] = (f32x4){0.f, 0.f, 0.f, 0.f};
        cur = nxt; cA = nA; cB = nB; ++ui;
        if constexpr (ALIGN_EPI) { if (wr == 1) PG8_BAR; }
    }
    PG8_WAIT_V(0);
    if constexpr (!ALIGN_EPI) { if (wr == 0) PG8_BAR; }
    PG8_BAR;
    if constexpr (Epi::AFTER_DRAIN) { E.fused(acc, cur, wr, wc, fr, fq, lds, wid, lane); S.done(cur); }
#undef PG8_SA
#undef PG8_SB
#undef PG8_STAGE
#undef PG8_LDA
#undef PG8_LDB
#undef PG8_MMA
#undef PG8_WAIT_V
#undef PG8_WAIT_L
#undef PG8_BAR
#undef PG8_SCHED
}
}
namespace pg8 {
struct EpiBf16P {
    static constexpr bool PERM = true, AFTER_DRAIN = false;
    bf16_t* O; int ldc; float sc;
    __device__ __forceinline__ void operator()(const f32x4 (&acc)[2][2][4][2], const Unit& u, int wr, int wc, int fr, int fq) const {
        const int row0 = u.pm * BM + wr * 64 + fr, col0 = u.pn * BM + wc * 32 + 8 * fq;
#pragma unroll
        for (int ai = 0; ai < 2; ++ai)
#pragma unroll
            for (int m = 0; m < 4; ++m) { bf16_t* rowp = O + (size_t)(row0 + ai * HALF + m * 16) * ldc + col0;
#pragma unroll
                for (int bj = 0; bj < 2; ++bj) { const f32x4 v0 = acc[ai][bj][m][0] * sc, v1 = acc[ai][bj][m][1] * sc;
                    u32x4 w; w.x = cvt_pk_bf16(v0[0], v0[1]); w.y = cvt_pk_bf16(v0[2], v0[3]); w.z = cvt_pk_bf16(v1[0], v1[1]); w.w = cvt_pk_bf16(v1[2], v1[3]);
                    *(u32x4*)(rowp + bj * HALF) = w; } }
    }
};
struct EpiF32Res {
    static constexpr bool PERM = false, AFTER_DRAIN = false;
    const float* base; float* out; int ldc;
    __device__ __forceinline__ void operator()(const f32x4 (&acc)[2][2][4][2], const Unit& u, int wr, int wc, int fr, int fq) const {
        const int row0 = u.pm * BM + wr * 64 + fr, col0 = u.pn * BM + wc * 32 + 4 * fq;
#pragma unroll
        for (int ai = 0; ai < 2; ++ai)
#pragma unroll
            for (int m = 0; m < 4; ++m) { const size_t off = (size_t)(row0 + ai * HALF + m * 16) * ldc + col0;
#pragma unroll
                for (int bj = 0; bj < 2; ++bj)
#pragma unroll
                    for (int n = 0; n < 2; ++n) { const f32x4 b = *(const f32x4*)(base + off + bj * HALF + n * 16); *(f32x4*)(out + off + bj * HALF + n * 16) = b + acc[ai][bj][m][n]; } }
    }
};
template <int mode> struct XAttnOrder {
    int G, c;
    __device__ __forceinline__ bool next(int i, Unit& u) const {
        const int L = i * G + c; if (L >= 256) return false;
        u.pm = L >> 2; u.pn = L & 3; const int b = u.pm >> 3;
        u.aoff = ((size_t)u.pm * 256 * 1024 + (size_t)u.pn * 256) * 2;
        u.boff = mode == 0 ? ((size_t)(b * 256) * 2048 + (size_t)u.pn * 256) * 2 : ((size_t)((b * 4 + u.pn) * 256) * 256) * 2;
        return true;
    }
    __device__ __forceinline__ void a_ready(const Unit&) const {}
    __device__ __forceinline__ void done(const Unit&) const {}
};
struct OneUnitOrder {
    int L, nN, lda, ldb;
    __device__ __forceinline__ bool next(int i, Unit& u) const {
        if (i != 0 || L < 0) return false;
        u.pm = L / nN; u.pn = L % nN; u.aoff = (size_t)u.pm * BM * lda * 2; u.boff = (size_t)u.pn * BM * ldb * 2; return true;
    }
    __device__ __forceinline__ void a_ready(const Unit&) const {}
    __device__ __forceinline__ void done(const Unit&) const {}
};
}

constexpr int NWAVES = 8;
constexpr int BATCH = 8, SEQ = 2048, DM = 1024, M = BATCH * SEQ, MEMLEN = 256, MM = BATCH * MEMLEN;
constexpr int INCOLS = 3088;
constexpr int N1 = 3328;
constexpr int PQ = 0, PK = 256, PV = 512, POG = 1024, PSQ = 1536, PSK = 2048, PSV = 2560, PGATE = 3072;
constexpr int PEER_N = 16384;
constexpr float EPS = 1e-6f;

constexpr size_t MiB = 1u << 20;
constexpr size_t WS_CTL = 0, CTL_ZERO_BYTES = 1 * MiB;
constexpr size_t WS_W1T = 1 * MiB;
constexpr size_t WS_WOT = 8 * MiB, WS_WXQT = 10 * MiB, WS_WXOT = 12 * MiB, WS_WXKVT = 14 * MiB, WS_WPQT = 18 * MiB, WS_SUBK = 22 * MiB;
constexpr size_t WS_UB = 24 * MiB, WS_VB = 56 * MiB;
constexpr size_t WS_BUFA = 88 * MiB;
constexpr size_t WS_MN = 120 * MiB;
constexpr size_t WS_KV = 124 * MiB;
constexpr size_t WS_PROJ = 132 * MiB;
constexpr size_t WS_SLOT0 = 132 * MiB, WS_SLOT1 = 164 * MiB, WS_SLOT2 = 196 * MiB, WS_VT = 228 * MiB, WS_END = 236 * MiB;
constexpr int CW_BAR = 4096;
constexpr int CW_SBSS = 32768;

constexpr int RING_BYTES = 131072;
constexpr int LDSCTL_OFF = RING_BYTES, MISC_OFF = LDSCTL_OFF + 320;
constexpr int LDS_BYTES = 147456;

#define GAS __attribute__((address_space(1)))
#define LAS __attribute__((address_space(3)))
typedef unsigned short bf16;
typedef unsigned v4u __attribute__((ext_vector_type(4)));
typedef float f32x4 __attribute__((ext_vector_type(4)));
typedef short bf16x8 __attribute__((ext_vector_type(8)));
typedef GAS unsigned gu32;
typedef GAS unsigned long long gu64;
#define RLX_AGENT __ATOMIC_RELAXED, __HIP_MEMORY_SCOPE_AGENT
#define LDS_WAIT() asm volatile("s_waitcnt lgkmcnt(0)" ::: "memory")
#define VM_WAIT() asm volatile("s_waitcnt vmcnt(0)" ::: "memory")
__device__ __forceinline__ unsigned long long rt() { return __builtin_amdgcn_s_memrealtime(); }
__device__ __forceinline__ unsigned f2bf(float f) { unsigned u = __builtin_bit_cast(unsigned, f); return (u + 0x7fffu + ((u >> 16) & 1u)) >> 16; }
__device__ __forceinline__ unsigned pk2(float lo, float hi) { return f2bf(lo) | (f2bf(hi) << 16); }

#define XB_TMO      128
#define XB_XCNT(j)  (256  + 64 * (j))
#define XB_XSUB(j)  (1280 + 64 * (j))
#define XB_XGEN(j)  (2304 + 64 * (j))
#define XB_TOP      3328
#define XB_TOPGEN   3392
#define XCD_BAR_WORDS 3456
#define XB_SPIN_CAP (1u << 22)

__device__ __forceinline__ unsigned xb_ld(unsigned* p)              { return __hip_atomic_load(p, __ATOMIC_RELAXED, __HIP_MEMORY_SCOPE_AGENT); }
__device__ __forceinline__ unsigned xb_add(unsigned* p, unsigned v) { return __hip_atomic_fetch_add(p, v, __ATOMIC_RELAXED, __HIP_MEMORY_SCOPE_AGENT); }
__device__ __forceinline__ unsigned xb_xcc_id() { return (unsigned)__builtin_amdgcn_s_getreg((3 << 11) | 20) & 0xFu; }
#define XB_SPIN(cond, bar) do { unsigned _sp = 0; while (cond) { __builtin_amdgcn_s_sleep(1); \
    if ((++_sp & 255u) == 0u) { if (xb_ld(&(bar)[XB_TMO])) break; if (_sp > XB_SPIN_CAP) { atomicAdd(&(bar)[XB_TMO], 1u); break; } } } } while (0)

struct XcdBarrier {
    unsigned* bar; unsigned x;
    volatile LAS unsigned* st;
};

__device__ __forceinline__ XcdBarrier xcd_barrier_post(unsigned* bar, volatile LAS unsigned* st) {
    XcdBarrier b; b.bar = bar; b.x = xb_xcc_id(); b.st = st;
    if (threadIdx.x == 0) (void)xb_add(&bar[XB_XCNT(b.x)], 1u);
    return b;
}
__device__ __forceinline__ void xcd_barrier_complete(unsigned* bar, unsigned x, unsigned& nloc, unsigned& nx) {
    const unsigned G = gridDim.x * gridDim.y * gridDim.z;
    unsigned sum, cnt, mine, sp = 0u;
    for (;;) {
        sum = 0u; cnt = 0u; mine = 0u;
#pragma unroll
        for (unsigned j = 0; j < 16; ++j) { const unsigned c = xb_ld(&bar[XB_XCNT(j)]); sum += c; cnt += (c > 0u) ? 1u : 0u; mine = (j == x) ? c : mine; }
        if (sum == G) break;
        __builtin_amdgcn_s_sleep(1);
        if ((++sp & 255u) == 0u) { if (xb_ld(&bar[XB_TMO])) break; if (sp > XB_SPIN_CAP) { atomicAdd(&bar[XB_TMO], 1u); break; } }
    }
    nloc = mine > 0u ? mine : 1u; nx = cnt > 0u ? cnt : 1u;
}

__device__ __forceinline__ void xcd_barrier(const XcdBarrier& b) {
    asm volatile("s_waitcnt vmcnt(0)" ::: "memory");
    __syncthreads();
    if (threadIdx.x == 0) {
        unsigned* bar = b.bar;
        __builtin_amdgcn_s_waitcnt(0);
        unsigned nloc = b.st[0], nx = b.st[1];
        if (nloc == 0u) { xcd_barrier_complete(bar, b.x, nloc, nx); b.st[0] = nloc; b.st[1] = nx; }
        const unsigned old = xb_add(&bar[XB_XSUB(b.x)], 1u);
        const unsigned gen = old / nloc;
        if (old + 1u == (gen + 1u) * nloc) {
            __builtin_amdgcn_fence(__ATOMIC_RELEASE, "agent");
            asm volatile("s_waitcnt vmcnt(0)" ::: "memory");
            const unsigned og = xb_add(&bar[XB_TOP], 1u);
            const unsigned tg = og / nx;
            if (og + 1u == (tg + 1u) * nx) xb_add(&bar[XB_TOPGEN], 1u);
            else XB_SPIN(xb_ld(&bar[XB_TOPGEN]) == tg, bar);
            __builtin_amdgcn_fence(__ATOMIC_ACQUIRE, "agent");
            xb_add(&bar[XB_XGEN(b.x)], 1u);
            asm volatile("s_waitcnt vmcnt(0)" ::: "memory");
        } else {
            XB_SPIN(xb_ld(&bar[XB_XGEN(b.x)]) == gen, bar);
            __builtin_amdgcn_fence(__ATOMIC_ACQUIRE, "agent");
            asm volatile("s_waitcnt vmcnt(0)" ::: "memory");
        }
    }
    __syncthreads();
}

#define DI __device__ __forceinline__
typedef __bf16 bf16x2_t __attribute__((ext_vector_type(2)));
struct Args { const float* in[21]; float* out; unsigned char* ws; int ph_lo, ph_hi; };
struct Frame {
    LAS unsigned char* lds;
    volatile LAS unsigned* MISC;
    gu32* ctl;
    int tid, lane, wave;
    int vcu, G;
    unsigned char* ws; float* out;
};
#define WSP(off) ((bf16*)(F.ws + (off)))
#define F_W1T WSP(WS_W1T)
#define F_WOT WSP(WS_WOT)
#define F_WXQT WSP(WS_WXQT)
#define F_WXOT WSP(WS_WXOT)
#define F_WXKVT WSP(WS_WXKVT)
#define F_WPQT WSP(WS_WPQT)
#define F_SUBK WSP(WS_SUBK)
#define F_UB WSP(WS_UB)
#define F_VB WSP(WS_VB)
#define F_BUFA WSP(WS_BUFA)
#define F_MN WSP(WS_MN)
#define F_KV WSP(WS_KV)
#define F_PROJ WSP(WS_PROJ)
#define F_SLOT0 WSP(WS_SLOT0)
#define F_SLOT1 WSP(WS_SLOT1)
#define F_SLOT2 WSP(WS_SLOT2)
#define F_VT WSP(WS_VT)
DI float bf2f(unsigned v) { return __uint_as_float(v << 16); }
DI float bflo(unsigned w) { return __uint_as_float(w << 16); }
DI float bfhi(unsigned w) { return __uint_as_float(w & 0xffff0000u); }
DI float wave_sum(float v) {
#pragma unroll
    for (int o = 1; o < 64; o <<= 1) v += __shfl_xor(v, o);
    return v;
}
DI float wave_max(float v) {
#pragma unroll
    for (int o = 1; o < 64; o <<= 1) v = fmaxf(v, __shfl_xor(v, o));
    return v;
}
DI float dot2_bf16(unsigned w, unsigned x, float a) { return __builtin_amdgcn_fdot2_f32_bf16(__builtin_bit_cast(bf16x2_t, w), __builtin_bit_cast(bf16x2_t, x), a, false); }
DI float silu_f(float x) { return x / (1.f + __expf(-x)); }
DI float log_sigmoid_f(float z) { return fminf(z, 0.f) - __logf(1.f + __expf(-fabsf(z))); }
DI float gelu_tanh_f(float x) { const float y = 0.7978845608028654f * (x + 0.044715f * x * x * x); const float t = 1.f - 2.f / (1.f + __expf(2.f * y)); return 0.5f * x * (1.f + t); }

DI void p0_transpose_item(const float* W, int ldw, int c0, bf16* WT, int row_off, LAS float* scr, int kb, int nb, int lane) {
    const int k0 = 64 * kb, n0 = 32 * nb;
#pragma unroll 8
    for (int i = 0; i < 32; ++i) { const int kk = 2 * i + (lane >> 5); scr[kk * 33 + (lane & 31)] = W[(size_t)(k0 + kk) * ldw + c0 + n0 + (lane & 31)]; }
    LDS_WAIT(); asm volatile("" ::: "memory");
    const int c = lane & 7;
#pragma unroll
    for (int j = 0; j < 4; ++j) { const int n = (lane >> 3) + 8 * j; const LAS float* s = scr + (8 * c) * 33 + n;
        v4u o; o.x = pk2(s[0 * 33], s[1 * 33]); o.y = pk2(s[2 * 33], s[3 * 33]); o.z = pk2(s[4 * 33], s[5 * 33]); o.w = pk2(s[6 * 33], s[7 * 33]);
        *(GAS v4u*)(WT + (size_t)(row_off + n0 + n) * 1024 + k0 + 8 * c) = o; }
    LDS_WAIT(); asm volatile("" ::: "memory");
}
DI void rms_row_to_bf16(int lane, const float* xrow, const float* g, bf16* orow) {
    const GAS f32x4* xr = (const GAS f32x4*)xrow + lane; const GAS f32x4* gr = (const GAS f32x4*)g + lane;
    f32x4 v[4]; float s = 0.f;
#pragma unroll
    for (int j = 0; j < 4; ++j) { v[j] = xr[64 * j]; s += (v[j].x * v[j].x + v[j].y * v[j].y) + (v[j].z * v[j].z + v[j].w * v[j].w); }
    const float rs = 1.f / sqrtf(wave_sum(s) * (1.f / 1024.f) + EPS);
    GAS unsigned long long* o8 = (GAS unsigned long long*)orow + lane;
#pragma unroll
    for (int j = 0; j < 4; ++j) { const f32x4 gg = gr[64 * j]; const f32x4 y = v[j] * rs * gg; o8[64 * j] = (unsigned long long)pk2(y.x, y.y) | ((unsigned long long)pk2(y.z, y.w) << 32); }
}
DI void p0_prologue(Frame& F, const Args& A) {
    LAS float* scr = (LAS float*)(F.lds + F.wave * 16384);
    const int gw = F.vcu * NWAVES + F.wave, NGW = F.G * NWAVES;
    constexpr int I_IN = 16 * 48, I_SQ = 16 * 32, I_W2 = 16 * 64;
    constexpr int NIT = 2 * I_IN + 3 * I_SQ + 2 * I_W2;
    for (int it = gw; it < NIT; it += NGW) {
        int r = it;
        if (r < I_IN) { p0_transpose_item(A.in[3], INCOLS, 0, F_W1T, 0, scr, r / 48, r % 48, F.lane); continue; } r -= I_IN;
        if (r < I_IN) { p0_transpose_item(A.in[3], INCOLS, 1552, F_W1T, 1536, scr, r / 48, r % 48, F.lane); continue; } r -= I_IN;
        if (r < I_SQ) { p0_transpose_item(A.in[9], 1024, 0, F_WOT, 0, scr, r / 32, r % 32, F.lane); continue; } r -= I_SQ;
        if (r < I_SQ) { p0_transpose_item(A.in[12], 1024, 0, F_WXQT, 0, scr, r / 32, r % 32, F.lane); continue; } r -= I_SQ;
        if (r < I_SQ) { p0_transpose_item(A.in[14], 1024, 0, F_WXOT, 0, scr, r / 32, r % 32, F.lane); continue; } r -= I_SQ;
        if (r < I_W2) { p0_transpose_item(A.in[13], 2048, 0, F_WXKVT, 0, scr, r / 64, r % 64, F.lane); continue; } r -= I_W2;
        p0_transpose_item(A.in[16], 2048, 0, F_WPQT, 0, scr, r / 64, r % 64, F.lane);
    }
    const int gt = gw * 64 + F.lane, NGT = NGW * 64;
    for (int i = gt; i < 256 * 128; i += NGT) {
        const int n = i >> 7, k0 = (i & 127) * 8;
        float gv[16];
#pragma unroll
        for (int r = 0; r < 16; ++r) gv[r] = A.in[5][r * 256 + n];
        float s[8];
#pragma unroll
        for (int j = 0; j < 8; ++j) { const float* wr_ = A.in[3] + (size_t)(k0 + j) * INCOLS + 1536; float a = 0.f;
#pragma unroll
            for (int r = 0; r < 16; ++r) a += wr_[r] * gv[r];
            s[j] = a; }
        v4u o; o.x = pk2(s[0], s[1]); o.y = pk2(s[2], s[3]); o.z = pk2(s[4], s[5]); o.w = pk2(s[6], s[7]);
        *(GAS v4u*)(F_W1T + (size_t)(3072 + n) * 1024 + k0) = o;
    }
    for (int m = gw; m < M; m += NGW) rms_row_to_bf16(F.lane, A.in[0] + (size_t)m * DM, A.in[2], F_BUFA + (size_t)m * DM);
    for (int m = gw; m < MM; m += NGW) rms_row_to_bf16(F.lane, A.in[1] + (size_t)m * DM, A.in[11], F_MN + (size_t)m * DM);
    {
        constexpr int NU = PEER_N * DM / 8;
        for (int i = gt; i < 2 * NU + 32768; i += NGT) {
            const float* src; bf16* dst; int j = i;
            if (j < NU) { src = A.in[18]; dst = F_UB; } else if (j < 2 * NU) { j -= NU; src = A.in[19]; dst = F_VB; } else { j -= 2 * NU; src = A.in[17]; dst = F_SUBK; }
            const f32x4 a = *(const GAS f32x4*)(src + (size_t)j * 8), b = *(const GAS f32x4*)(src + (size_t)j * 8 + 4);
            v4u o; o.x = pk2(a.x, a.y); o.y = pk2(a.z, a.w); o.z = pk2(b.x, b.y); o.w = pk2(b.z, b.w);
            *(GAS v4u*)(dst + (size_t)j * 8) = o;
        }
    }
}

DI void gla_naive_item(Frame& F, const Args& A, float* OGLA, int b, int h, int eg) {
    const int lane = F.lane, e = eg * 8 + F.wave;
    const int cq = PQ + h * 64 + lane, ck = PK + h * 64 + lane, cv = PV + h * 128 + e, cg = PGATE + h * 64 + lane;
    float wq[4], wk[4], wv[4];
#pragma unroll
    for (int k = 0; k < 4; ++k) { wq[k] = A.in[4][k * 1024 + cq]; wk[k] = A.in[4][k * 1024 + ck]; wv[k] = A.in[4][k * 1024 + cv]; }
    const float bias = A.in[6][h * 64 + lane];
    float rq0 = 0.f, rq1 = 0.f, rq2 = 0.f, rk0 = 0.f, rk1 = 0.f, rk2 = 0.f, rv0 = 0.f, rv1 = 0.f, rv2 = 0.f, S = 0.f;
    for (int t0 = 0; t0 < SEQ; t0 += 8) {
        unsigned lq[8], lk[8], lv[8], lg[8];
#pragma unroll
        for (int j = 0; j < 8; ++j) { const bf16* base = F_PROJ + (size_t)(b * SEQ + t0 + j) * N1; lq[j] = base[cq]; lk[j] = base[ck]; lv[j] = base[cv]; lg[j] = base[cg]; }
#pragma unroll
        for (int j = 0; j < 8; ++j) {
            const float xq = bf2f(lq[j]), xk = bf2f(lk[j]), xv = bf2f(lv[j]);
            const float q = silu_f(wq[0] * rq0 + wq[1] * rq1 + wq[2] * rq2 + wq[3] * xq) * 0.125f; rq0 = rq1; rq1 = rq2; rq2 = xq;
            const float k = silu_f(wk[0] * rk0 + wk[1] * rk1 + wk[2] * rk2 + wk[3] * xk); rk0 = rk1; rk1 = rk2; rk2 = xk;
            const float v = silu_f(wv[0] * rv0 + wv[1] * rv1 + wv[2] * rv2 + wv[3] * xv); rv0 = rv1; rv1 = rv2; rv2 = xv;
            const float a = __expf(log_sigmoid_f(bf2f(lg[j]) + bias) * (1.f / 16.f));
            S = a * S + k * v;
            const float o = wave_sum(q * S);
            if (lane == 0) OGLA[(size_t)(b * SEQ + t0 + j) * 512 + h * 128 + e] = o;
        }
    }
}
DI void sb_naive_item(Frame& F, float* OSB, int b, int h, int qb) {
    LAS float* Ks = (LAS float*)F.lds; LAS float* Vs = Ks + 64 * 64;
    const int tid = F.tid, t = qb * 512 + tid; const size_t row = (size_t)b * SEQ + t;
    float q[64], acc[64];
    {
        const GAS v4u* qp = (const GAS v4u*)(F_PROJ + row * N1 + PSQ + h * 64);
#pragma unroll
        for (int c = 0; c < 8; ++c) { const v4u w = qp[c]; q[8 * c + 0] = bflo(w.x) * 0.125f; q[8 * c + 1] = bfhi(w.x) * 0.125f; q[8 * c + 2] = bflo(w.y) * 0.125f; q[8 * c + 3] = bfhi(w.y) * 0.125f;
            q[8 * c + 4] = bflo(w.z) * 0.125f; q[8 * c + 5] = bfhi(w.z) * 0.125f; q[8 * c + 6] = bflo(w.w) * 0.125f; q[8 * c + 7] = bfhi(w.w) * 0.125f; }
    }
#pragma unroll
    for (int d = 0; d < 64; ++d) acc[d] = 0.f;
    float carry = 0.f;
    for (int kt = qb * 8 + 7; kt >= 0; --kt) {
        __syncthreads();
        {
            const int key = tid >> 3, ch = tid & 7; const size_t krow = (size_t)b * SEQ + kt * 64 + key;
            const v4u kw = *(const GAS v4u*)(F_PROJ + krow * N1 + PSK + h * 64 + ch * 8), vw = *(const GAS v4u*)(F_PROJ + krow * N1 + PSV + h * 64 + ch * 8);
            LAS f32x4* kd = (LAS f32x4*)(Ks + key * 64 + ch * 8); LAS f32x4* vd = (LAS f32x4*)(Vs + key * 64 + ch * 8);
            kd[0] = (f32x4){bflo(kw.x), bfhi(kw.x), bflo(kw.y), bfhi(kw.y)}; kd[1] = (f32x4){bflo(kw.z), bfhi(kw.z), bflo(kw.w), bfhi(kw.w)};
            vd[0] = (f32x4){bflo(vw.x), bfhi(vw.x), bflo(vw.y), bfhi(vw.y)}; vd[1] = (f32x4){bflo(vw.z), bfhi(vw.z), bflo(vw.w), bfhi(vw.w)};
        }
        __syncthreads();
        for (int j = 63; j >= 0; --j) {
            const int s = kt * 64 + j;
            if (s < t) {
                const LAS f32x4* kr = (const LAS f32x4*)(Ks + j * 64); const LAS f32x4* vr = (const LAS f32x4*)(Vs + j * 64);
                float z0 = 0.f, z1 = 0.f, z2 = 0.f, z3 = 0.f;
#pragma unroll
                for (int c = 0; c < 16; ++c) { const f32x4 kk = kr[c]; z0 += q[4 * c] * kk.x; z1 += q[4 * c + 1] * kk.y; z2 += q[4 * c + 2] * kk.z; z3 += q[4 * c + 3] * kk.w; }
                const float z = (z0 + z1) + (z2 + z3);
                const float lb = log_sigmoid_f(z);
                const float w = __expf(lb + carry);
                carry += lb - z;
#pragma unroll
                for (int c = 0; c < 16; ++c) { const f32x4 vv = vr[c]; acc[4 * c] += w * vv.x; acc[4 * c + 1] += w * vv.y; acc[4 * c + 2] += w * vv.z; acc[4 * c + 3] += w * vv.w; }
            }
        }
    }
    GAS f32x4* op = (GAS f32x4*)(OSB + row * 512 + h * 64);
#pragma unroll
    for (int c = 0; c < 16; ++c) op[c] = (f32x4){acc[4 * c], acc[4 * c + 1], acc[4 * c + 2], acc[4 * c + 3]};
}
typedef float f32x16 __attribute__((ext_vector_type(16)));
typedef short s16x4 __attribute__((ext_vector_type(4)));
DI s16x4 lds_tr16(const LAS unsigned char* p) { return __builtin_bit_cast(s16x4, __builtin_amdgcn_ds_read_tr16_b64_v4i16((LAS s16x4*)p)); }
DI unsigned cvtpk_bf16(float lo, float hi) { typedef float f2 __attribute__((ext_vector_type(2))); f2 v = {lo, hi}; bf16x2_t b = __builtin_convertvector(v, bf16x2_t); return __builtin_bit_cast(unsigned, b); }
constexpr float SB_C2 = 0.125f * 1.4426950408889634f;
template <bool MASKED> DI void sb_weights(f32x16& P0, f32x16& P1, float& carry, int hi, int qrel2) {
    float T[8], cs[8];
#pragma unroll
    for (int pi = 0; pi < 2; ++pi) {
        f32x16& P = pi ? P1 : P0;
#pragma unroll
        for (int g = 0; g < 4; ++g) {
            float lbv[4], l1v[4];
#pragma unroll
            for (int i = 0; i < 4; ++i) {
                const float z2 = P[4 * g + i] * SB_C2;
                const float sp = __builtin_amdgcn_logf(1.f + __builtin_amdgcn_exp2f(-fabsf(z2)));
                float lb = fminf(z2, 0.f) - sp, l1 = lb - z2;
                if (MASKED) { const bool valid = (32 * pi + 8 * g + 4 * hi + i) < qrel2; lb = valid ? lb : -INFINITY; l1 = valid ? l1 : 0.f; }
                lbv[i] = lb; l1v[i] = l1;
            }
            const float a = l1v[3], b = a + l1v[2], c = b + l1v[1];
            cs[4 * pi + g] = c + l1v[0];
            P[4 * g + 3] = lbv[3]; P[4 * g + 2] = lbv[2] + a; P[4 * g + 1] = lbv[1] + b; P[4 * g + 0] = lbv[0] + c;
        }
    }
#pragma unroll
    for (int k = 0; k < 8; ++k) { auto rr = __builtin_amdgcn_permlane32_swap(__float_as_uint(cs[k]), __float_as_uint(cs[k]), false, false); T[k] = __uint_as_float(rr[0]) + __uint_as_float(rr[1]); }
    const float m0 = hi ? 0.f : 1.f;
    float run = carry;
#pragma unroll
    for (int k = 7; k >= 0; --k) {
        const float E = run + m0 * (T[k] - cs[k]);
        f32x16& P = (k >> 2) ? P1 : P0; const int g = k & 3;
#pragma unroll
        for (int i = 0; i < 4; ++i) P[4 * g + i] = __builtin_amdgcn_exp2f(P[4 * g + i] + E);
        run += T[k];
    }
    carry = run;
}
DI void sb_unit(Frame& F, float* OSB, int b, int h, int qb) {
    const int tid = F.tid, lane = F.lane, wid = F.wave, r32 = lane & 31, hi = lane >> 5;
    const int q0 = qb * 256; const size_t rowbase = (size_t)b * SEQ;
    const bf16* Kg = F_PROJ + rowbase * N1 + PSK + h * 64;
    const bf16* Vg = F_PROJ + rowbase * N1 + PSV + h * 64;
    bf16x8 qr[4];
    { const bf16* Qw = F_PROJ + (rowbase + q0 + wid * 32 + r32) * N1 + PSQ + h * 64;
#pragma unroll
      for (int ks = 0; ks < 4; ++ks) qr[ks] = *(const GAS bf16x8*)(Qw + ks * 16 + hi * 8); }
    const bf16* ksrc = Kg + (size_t)(tid >> 3) * N1 + (tid & 7) * 8;
    const bf16* vsrc = Vg + (size_t)(16 * (wid & 3) + (lane >> 2)) * N1 + (wid >> 2) * 32 + (lane & 3) * 8;
    const int kdst = (tid & 7) * 1024 + (tid >> 3) * 16, vdst = 8192 + wid * 1024 + lane * 16;
    const int kfr = hi * 1024 + r32 * 16;
    const int vfr = 8192 + ((lane >> 4) & 1) * 32 + (lane & 3) * 8 + (4 * hi + ((lane & 15) >> 2)) * 64;
    f32x16 o0 = {}, o1 = {};
    float carry = 0.f;
    const int ktmax = (q0 >> 6) + 3;
    v4u kreg = *(const GAS v4u*)(ksrc + (size_t)ktmax * 64 * N1), vreg = *(const GAS v4u*)(vsrc + (size_t)ktmax * 64 * N1);
    __syncthreads();
    *(LAS v4u*)(F.lds + kdst) = kreg; *(LAS v4u*)(F.lds + vdst) = vreg;
    __syncthreads();
    int cur = 0;
    const int wrow0 = q0 + wid * 32;
    for (int kt = ktmax; kt >= 0; --kt) {
        if (kt > 0) { kreg = *(const GAS v4u*)(ksrc + (size_t)(kt - 1) * 64 * N1); vreg = *(const GAS v4u*)(vsrc + (size_t)(kt - 1) * 64 * N1); }
        const int k0 = kt * 64;
        if (k0 <= wrow0 + 30) {
            const LAS unsigned char* Kb = F.lds + cur * 16384;
            f32x16 P0 = {}, P1 = {};
#pragma unroll
            for (int ks = 0; ks < 4; ++ks) {
                const bf16x8 a0 = *(const LAS bf16x8*)(Kb + kfr + ks * 2048), a1 = *(const LAS bf16x8*)(Kb + kfr + ks * 2048 + 512);
                P0 = __builtin_amdgcn_mfma_f32_32x32x16_bf16(a0, qr[ks], P0, 0, 0, 0);
                P1 = __builtin_amdgcn_mfma_f32_32x32x16_bf16(a1, qr[ks], P1, 0, 0, 0);
            }
            if (k0 + 63 >= wrow0) sb_weights<true>(P0, P1, carry, hi, wrow0 + r32 - k0);
            else sb_weights<false>(P0, P1, carry, hi, 0);
#pragma unroll
            for (int s = 0; s < 4; ++s) {
                const f32x16& P = (s >> 1) ? P1 : P0; const int rb = (s & 1) * 8;
                v4u pw; pw.x = cvtpk_bf16(P[rb + 0], P[rb + 1]); pw.y = cvtpk_bf16(P[rb + 2], P[rb + 3]); pw.z = cvtpk_bf16(P[rb + 4], P[rb + 5]); pw.w = cvtpk_bf16(P[rb + 6], P[rb + 7]);
                const bf16x8 pa = __builtin_bit_cast(bf16x8, pw);
                const LAS unsigned char* vp = Kb + vfr + s * 1024;
                const s16x4 l0 = lds_tr16(vp), h0 = lds_tr16(vp + 512), l1 = lds_tr16(vp + 4096), h1 = lds_tr16(vp + 4096 + 512);
                const bf16x8 v0 = {l0[0], l0[1], l0[2], l0[3], h0[0], h0[1], h0[2], h0[3]}, v1 = {l1[0], l1[1], l1[2], l1[3], h1[0], h1[1], h1[2], h1[3]};
                o0 = __builtin_amdgcn_mfma_f32_32x32x16_bf16(pa, v0, o0, 0, 0, 0);
                o1 = __builtin_amdgcn_mfma_f32_32x32x16_bf16(pa, v1, o1, 0, 0, 0);
            }
        }
        if (kt > 0) { *(LAS v4u*)(F.lds + (cur ^ 1) * 16384 + kdst) = kreg; *(LAS v4u*)(F.lds + (cur ^ 1) * 16384 + vdst) = vreg; }
        __syncthreads();
        cur ^= 1;
    }
    float* op = OSB + (rowbase + wrow0) * 512 + h * 64 + r32;
#pragma unroll
    for (int r = 0; r < 16; ++r) { const int qrow = (r & 3) + 8 * (r >> 2) + 4 * hi; op[(size_t)qrow * 512] = o0[r]; op[(size_t)qrow * 512 + 32] = o1[r]; }
}
constexpr int GL_QT = 0, GL_KT = 8192, GL_KD = 16384, GL_V = 28672, GL_ST = 49152, GL_SEG = 69632, GL_RED = 71680, GL_KDP = 192, GL_VP = 320;
constexpr int CW_DECAY = 65536;
template <bool ACC> DI bf16x8 tr_frag(const LAS unsigned char* base, int PB, int x0, int k0, int lane) {
    const int hi = lane >> 5, rr = (lane & 15) >> 2, col = x0 + 16 * ((lane >> 4) & 1) + 4 * (lane & 3);
    const int r0 = ACC ? (k0 + 4 * hi + rr) : (k0 + 8 * hi + rr), r1 = ACC ? (r0 + 8) : (r0 + 4);
    const s16x4 a = lds_tr16(base + r0 * PB + col * 2), b = lds_tr16(base + r1 * PB + col * 2);
    return (bf16x8){a[0], a[1], a[2], a[3], b[0], b[1], b[2], b[3]};
}
template <int MODE> DI void gla_prep(Frame& F, const Args& A, int b, int h, int n) {
    const int tid = F.tid, d = tid & 63, seg = tid >> 6;
    const float* cw = A.in[4];
    const size_t row0 = (size_t)b * SEQ + 64 * n;
    {
        const int cq = PQ + h * 64 + d, ck = PK + h * 64 + d, cg = PGATE + h * 64 + d;
        float wq[4], wk[4];
#pragma unroll
        for (int k = 0; k < 4; ++k) { wq[k] = cw[k * 1024 + cq]; wk[k] = cw[k * 1024 + ck]; }
        const float bias = A.in[6][h * 64 + d];
        float rq[11], rk[11], gl[8];
#pragma unroll
        for (int i = 0; i < 11; ++i) { const int t = 64 * n + 8 * seg - 3 + i; const bool ok = t >= 0; const bf16* p = F_PROJ + (row0 + 8 * seg - 3 + i) * N1;
            rq[i] = ok ? bf2f(p[cq]) : 0.f; rk[i] = ok ? bf2f(p[ck]) : 0.f; if (i >= 3) gl[i - 3] = log_sigmoid_f(bf2f(p[cg]) + bias) * (1.f / 16.f); }
        float c = 0.f;
#pragma unroll
        for (int j = 0; j < 8; ++j) { c += gl[j]; gl[j] = c; }
        LAS float* SEG = (LAS float*)(F.lds + GL_SEG);
        SEG[seg * 64 + d] = c;
        __syncthreads();
        float pre = 0.f, tot = 0.f;
#pragma unroll
        for (int s = 0; s < 8; ++s) { const float v = SEG[s * 64 + d]; pre += (s < seg) ? v : 0.f; tot += v; }
#pragma unroll
        for (int j = 0; j < 8; ++j) {
            const int tok = 8 * seg + j; const float cum = pre + gl[j];
            const float qc = silu_f(wq[0] * rq[j] + wq[1] * rq[j + 1] + wq[2] * rq[j + 2] + wq[3] * rq[j + 3]);
            const float kc = silu_f(wk[0] * rk[j] + wk[1] * rk[j + 1] + wk[2] * rk[j + 2] + wk[3] * rk[j + 3]);
            if (MODE == 0) { *(LAS bf16*)(F.lds + GL_KD + tok * GL_KDP + d * 2) = (bf16)f2bf(kc * __expf(tot - cum)); }
            else { const int off = (d >> 3) * 1024 + tok * 16 + (d & 7) * 2;
                *(LAS bf16*)(F.lds + GL_QT + off) = (bf16)f2bf(qc * 0.125f * __expf(cum)); *(LAS bf16*)(F.lds + GL_KT + off) = (bf16)f2bf(kc * __expf(-cum)); }
        }
        if (MODE == 0 && seg == 0) ((float*)(F.ctl + CW_DECAY))[((size_t)(b * 4 + h) * 32 + n) * 64 + d] = __expf(tot);
    }
    {
        const int e = tid & 127, s4 = tid >> 7, cv = PV + h * 128 + e;
        float wv[4];
#pragma unroll
        for (int k = 0; k < 4; ++k) wv[k] = cw[k * 1024 + cv];
        float rv[19];
#pragma unroll
        for (int i = 0; i < 19; ++i) { const int t = 64 * n + 16 * s4 - 3 + i; rv[i] = t >= 0 ? bf2f(F_PROJ[(row0 + 16 * s4 - 3 + i) * N1 + cv]) : 0.f; }
#pragma unroll
        for (int j = 0; j < 16; ++j) *(LAS bf16*)(F.lds + GL_V + (16 * s4 + j) * GL_VP + e * 2) = (bf16)f2bf(silu_f(wv[0] * rv[j] + wv[1] * rv[j + 1] + wv[2] * rv[j + 2] + wv[3] * rv[j + 3]));
    }
}
DI void gla_local_unit(Frame& F, const Args& A, float* STW, int b, int h, int n) {
    __syncthreads();
    gla_prep<0>(F, A, b, h, n);
    __syncthreads();
    const int lane = F.lane, wid = F.wave, dt = wid & 1, et = wid >> 1, r32 = lane & 31, hi = lane >> 5;
    f32x16 acc = {};
#pragma unroll
    for (int ks = 0; ks < 4; ++ks) {
        const bf16x8 af = tr_frag<false>(F.lds + GL_KD, GL_KDP, 32 * dt, 16 * ks, lane), bfr = tr_frag<false>(F.lds + GL_V, GL_VP, 32 * et, 16 * ks, lane);
        acc = __builtin_amdgcn_mfma_f32_32x32x16_bf16(af, bfr, acc, 0, 0, 0);
    }
    float* o = STW + (((size_t)(b * 4 + h) * 32 + n) * 64 + 32 * dt) * 128 + 32 * et + r32;
#pragma unroll
    for (int r = 0; r < 16; ++r) o[(size_t)((r & 3) + 8 * (r >> 2) + 4 * hi) * 128] = acc[r];
}
DI void gla_out_unit(Frame& F, const Args& A, const float* STW, int b, int h, int n) {
    __syncthreads();
    gla_prep<1>(F, A, b, h, n);
    {
        const float* sp = STW + ((size_t)(b * 4 + h) * 32 + n) * 64 * 128;
#pragma unroll
        for (int i = 0; i < 4; ++i) { const int idx = (F.tid + i * 512) * 4, dd = idx >> 7, ee = idx & 127; const f32x4 v = *(const GAS f32x4*)(sp + idx);
            *(LAS unsigned long long*)(F.lds + GL_ST + dd * GL_VP + ee * 2) = (unsigned long long)pk2(v.x, v.y) | ((unsigned long long)pk2(v.z, v.w) << 32); }
    }
    __syncthreads();
    const int lane = F.lane, wid = F.wave, it = wid & 1, et = wid >> 1, r32 = lane & 31, hi = lane >> 5;
    f32x16 acc = {};
    bf16x8 qf[4];
#pragma unroll
    for (int ks = 0; ks < 4; ++ks) qf[ks] = *(const LAS bf16x8*)(F.lds + GL_QT + (2 * ks + hi) * 1024 + (32 * it + r32) * 16);
#pragma unroll
    for (int ks = 0; ks < 4; ++ks) acc = __builtin_amdgcn_mfma_f32_32x32x16_bf16(tr_frag<false>(F.lds + GL_ST, GL_VP, 32 * et, 16 * ks, lane), qf[ks], acc, 0, 0, 0);
    for (int jt = 0; jt <= it; ++jt) {
        f32x16 S = {};
#pragma unroll
        for (int ks = 0; ks < 4; ++ks) S = __builtin_amdgcn_mfma_f32_32x32x16_bf16(*(const LAS bf16x8*)(F.lds + GL_KT + (2 * ks + hi) * 1024 + (32 * jt + r32) * 16), qf[ks], S, 0, 0, 0);
        if (jt == it) {
#pragma unroll
            for (int r = 0; r < 16; ++r) S[r] = ((r & 3) + 8 * (r >> 2) + 4 * hi) <= r32 ? S[r] : 0.f;
        }
#pragma unroll
        for (int s = 0; s < 2; ++s) {
            v4u pw; pw.x = cvtpk_bf16(S[8 * s + 0], S[8 * s + 1]); pw.y = cvtpk_bf16(S[8 * s + 2], S[8 * s + 3]); pw.z = cvtpk_bf16(S[8 * s + 4], S[8 * s + 5]); pw.w = cvtpk_bf16(S[8 * s + 6], S[8 * s + 7]);
            acc = __builtin_amdgcn_mfma_f32_32x32x16_bf16(tr_frag<true>(F.lds + GL_V, GL_VP, 32 * et, 32 * jt + 16 * s, lane), __builtin_bit_cast(bf16x8, pw), acc, 0, 0, 0);
        }
    }
    float ss = 0.f;
#pragma unroll
    for (int r = 0; r < 16; ++r) ss += acc[r] * acc[r];
    { auto rr = __builtin_amdgcn_permlane32_swap(__float_as_uint(ss), __float_as_uint(ss), false, false); ss = __uint_as_float(rr[0]) + __uint_as_float(rr[1]); }
    LAS float* RED = (LAS float*)(F.lds + GL_RED);
    if (hi == 0) RED[wid * 32 + r32] = ss;
    __syncthreads();
    const float tot = RED[(it + 0) * 32 + r32] + RED[(it + 2) * 32 + r32] + RED[(it + 4) * 32 + r32] + RED[(it + 6) * 32 + r32];
    const float rs = 1.f / sqrtf(tot * (1.f / 128.f) + EPS);
    const size_t row = (size_t)b * SEQ + 64 * n + 32 * it + r32;
    const float* gg = A.in[7];
#pragma unroll
    for (int g = 0; g < 4; ++g) {
        const int e0 = 32 * et + 8 * g + 4 * hi;
        const unsigned long long ogw = *(const GAS unsigned long long*)(F_PROJ + row * N1 + POG + h * 128 + e0);
        const unsigned lo = (unsigned)ogw, hi2 = (unsigned)(ogw >> 32);
        const f32x4 gv = *(const GAS f32x4*)(gg + e0);
        const float y0 = acc[4 * g + 0] * rs * gv.x * silu_f(bflo(lo)), y1 = acc[4 * g + 1] * rs * gv.y * silu_f(bfhi(lo)), y2 = acc[4 * g + 2] * rs * gv.z * silu_f(bflo(hi2)), y3 = acc[4 * g + 3] * rs * gv.w * silu_f(bfhi(hi2));
        *(GAS unsigned long long*)(F_BUFA + row * 1024 + h * 128 + e0) = (unsigned long long)pk2(y0, y1) | ((unsigned long long)pk2(y2, y3) << 32);
    }
}
DI void mix_row(Frame& F, const Args& A, const float* OGLA, const float* OSB, size_t row) {
    const int lane = F.lane;
    const f32x4 a0 = *(const GAS f32x4*)(OGLA + row * 512 + 8 * lane), a1 = *(const GAS f32x4*)(OGLA + row * 512 + 8 * lane + 4);
    float s = (a0.x * a0.x + a0.y * a0.y) + (a0.z * a0.z + a0.w * a0.w) + (a1.x * a1.x + a1.y * a1.y) + (a1.z * a1.z + a1.w * a1.w);
    s += __shfl_xor(s, 1); s += __shfl_xor(s, 2); s += __shfl_xor(s, 4); s += __shfl_xor(s, 8);
    const float rs = 1.f / sqrtf(s * (1.f / 128.f) + EPS);
    const int e0 = (8 * lane) & 127;
    const f32x4 g0 = *(const GAS f32x4*)(A.in[7] + e0), g1 = *(const GAS f32x4*)(A.in[7] + e0 + 4);
    const v4u ogw = *(const GAS v4u*)(F_PROJ + row * N1 + POG + 8 * lane);
    v4u o;
    o.x = pk2(a0.x * rs * g0.x * silu_f(bflo(ogw.x)), a0.y * rs * g0.y * silu_f(bfhi(ogw.x)));
    o.y = pk2(a0.z * rs * g0.z * silu_f(bflo(ogw.y)), a0.w * rs * g0.w * silu_f(bfhi(ogw.y)));
    o.z = pk2(a1.x * rs * g1.x * silu_f(bflo(ogw.z)), a1.y * rs * g1.y * silu_f(bfhi(ogw.z)));
    o.w = pk2(a1.z * rs * g1.z * silu_f(bflo(ogw.w)), a1.w * rs * g1.w * silu_f(bfhi(ogw.w)));
    *(GAS v4u*)(F_BUFA + row * 1024 + 8 * lane) = o;
    const f32x4 b0 = *(const GAS f32x4*)(OSB + row * 512 + 8 * lane), b1 = *(const GAS f32x4*)(OSB + row * 512 + 8 * lane + 4);
    float s2 = (b0.x * b0.x + b0.y * b0.y) + (b0.z * b0.z + b0.w * b0.w) + (b1.x * b1.x + b1.y * b1.y) + (b1.z * b1.z + b1.w * b1.w);
    const float rs2 = 1.f / sqrtf(wave_sum(s2) * (1.f / 512.f) + EPS);
    const f32x4 h0 = *(const GAS f32x4*)(A.in[8] + 8 * lane), h1 = *(const GAS f32x4*)(A.in[8] + 8 * lane + 4);
    v4u p;
    p.x = pk2(b0.x * rs2 * h0.x, b0.y * rs2 * h0.y); p.y = pk2(b0.z * rs2 * h0.z, b0.w * rs2 * h0.w);
    p.z = pk2(b1.x * rs2 * h1.x, b1.y * rs2 * h1.y); p.w = pk2(b1.z * rs2 * h1.z, b1.w * rs2 * h1.w);
    *(GAS v4u*)(F_BUFA + row * 1024 + 512 + 8 * lane) = p;
}
DI void mix_row_sb(Frame& F, const Args& A, const float* OSB, size_t row) {
    const int lane = F.lane;
    const f32x4 b0 = *(const GAS f32x4*)(OSB + row * 512 + 8 * lane), b1 = *(const GAS f32x4*)(OSB + row * 512 + 8 * lane + 4);
    float s2 = (b0.x * b0.x + b0.y * b0.y) + (b0.z * b0.z + b0.w * b0.w) + (b1.x * b1.x + b1.y * b1.y) + (b1.z * b1.z + b1.w * b1.w);
    const float rs2 = 1.f / sqrtf(wave_sum(s2) * (1.f / 512.f) + EPS);
    const f32x4 h0 = *(const GAS f32x4*)(A.in[8] + 8 * lane), h1 = *(const GAS f32x4*)(A.in[8] + 8 * lane + 4);
    v4u p;
    p.x = pk2(b0.x * rs2 * h0.x, b0.y * rs2 * h0.y); p.y = pk2(b0.z * rs2 * h0.z, b0.w * rs2 * h0.w);
    p.z = pk2(b1.x * rs2 * h1.x, b1.y * rs2 * h1.y); p.w = pk2(b1.z * rs2 * h1.z, b1.w * rs2 * h1.w);
    *(GAS v4u*)(F_BUFA + row * 1024 + 512 + 8 * lane) = p;
}
DI void gla_scan(Frame& F, float* STW) {
    const int gt = (F.vcu * NWAVES + F.wave) * 64 + F.lane, NGT = F.G * NWAVES * 64;
    const float* dec = (const float*)(F.ctl + CW_DECAY);
    for (int idx = gt; idx < 32 * 8192; idx += NGT) {
        const int bh = idx >> 13, de = idx & 8191, d = de >> 7;
        float* p = STW + (size_t)bh * 32 * 8192 + de; const float* dp = dec + (size_t)bh * 32 * 64 + d;
        float tmp[32], dc[32];
#pragma unroll
        for (int n = 0; n < 32; ++n) { tmp[n] = p[(size_t)n * 8192]; dc[n] = dp[n * 64]; }
        float st = 0.f;
#pragma unroll
        for (int n = 0; n < 32; ++n) { p[(size_t)n * 8192] = st; st = dc[n] * st + tmp[n]; }
    }
}
DI void xsoftmax_row(Frame& F, bf16* S, size_t rh) {
    unsigned long long* p = (unsigned long long*)(S + rh * 256) + F.lane;
    const unsigned long long w = *p; const unsigned lo = (unsigned)w, hi = (unsigned)(w >> 32);
    const float sc = 0.0625f;
    float a = bflo(lo) * sc, b = bfhi(lo) * sc, c = bflo(hi) * sc, d = bfhi(hi) * sc;
    const float mx = wave_max(fmaxf(fmaxf(a, b), fmaxf(c, d)));
    a = __expf(a - mx); b = __expf(b - mx); c = __expf(c - mx); d = __expf(d - mx);
    const float inv = 1.f / wave_sum((a + b) + (c + d));
    *p = (unsigned long long)pk2(a * inv, b * inv) | ((unsigned long long)pk2(c * inv, d * inv) << 32);
}
DI float topk_round2(float& c0, float& c1) {
    const float w = wave_max(fmaxf(c0, c1));
    if (c0 == w) c0 = -INFINITY; if (c1 == w) c1 = -INFINITY;
    return w;
}
DI void peer_topk_item(Frame& F, const bf16* PQb, int* IDX, float* GATE, size_t row, int h) {
    const int lane = F.lane;
    float mylist[2];
#pragma unroll
    for (int p = 0; p < 2; ++p) {
        LAS unsigned* qs = (LAS unsigned*)(F.lds + F.wave * 1024);
        qs[lane] = *(const GAS unsigned*)(PQb + row * 2048 + (h * 2 + p) * 128 + 2 * lane);
        LDS_WAIT(); asm volatile("" ::: "memory");
        const bf16* kbase = F_SUBK + (size_t)((h * 2 + p) * 128) * 128;
        float s0 = 0.f, s1 = 0.f;
        const GAS v4u* k0p = (const GAS v4u*)(kbase + (size_t)lane * 128); const GAS v4u* k1p = (const GAS v4u*)(kbase + (size_t)(lane + 64) * 128);
#pragma unroll
        for (int c = 0; c < 16; ++c) {
            const v4u a = k0p[c], b = k1p[c];
            const v4u qq = *(const LAS v4u*)(qs + 4 * c); const unsigned q0 = qq.x, q1 = qq.y, q2 = qq.z, q3 = qq.w;
            s0 += bflo(a.x) * bflo(q0) + bfhi(a.x) * bfhi(q0) + bflo(a.y) * bflo(q1) + bfhi(a.y) * bfhi(q1) + bflo(a.z) * bflo(q2) + bfhi(a.z) * bfhi(q2) + bflo(a.w) * bflo(q3) + bfhi(a.w) * bfhi(q3);
            s1 += bflo(b.x) * bflo(q0) + bfhi(b.x) * bfhi(q0) + bflo(b.y) * bflo(q1) + bfhi(b.y) * bfhi(q1) + bflo(b.z) * bflo(q2) + bfhi(b.z) * bfhi(q2) + bflo(b.w) * bflo(q3) + bfhi(b.w) * bfhi(q3);
        }
        float c0 = __uint_as_float((__float_as_uint(s0) & ~0x7fu) | (unsigned)lane), c1 = __uint_as_float((__float_as_uint(s1) & ~0x7fu) | (unsigned)(lane + 64));
        float mine = 0.f;
#pragma unroll
        for (int r = 0; r < 16; ++r) { const float w = topk_round2(c0, c1); if (lane == r) mine = w; }
        mylist[p] = mine;
        LDS_WAIT(); asm volatile("" ::: "memory");
    }
    const float va = __uint_as_float(__float_as_uint(__shfl(mylist[0], lane >> 2)) & ~0x7fu);
    float cand[4];
#pragma unroll
    for (int j = 0; j < 4; ++j) { const int bb = 4 * (lane & 3) + j; const float vb = __uint_as_float(__float_as_uint(__shfl(mylist[1], bb)) & ~0x7fu);
        cand[j] = __uint_as_float((__float_as_uint(va + vb) & ~0xffu) | (unsigned)((lane >> 2) * 16 + bb)); }
    float best = 0.f, top = 0.f;
#pragma unroll
    for (int r = 0; r < 16; ++r) {
        const float w = wave_max(fmaxf(fmaxf(cand[0], cand[1]), fmaxf(cand[2], cand[3])));
#pragma unroll
        for (int j = 0; j < 4; ++j) if (cand[j] == w) cand[j] = -INFINITY;
        if (lane == r) best = w; if (r == 0) top = w;
    }
    const unsigned bu = __float_as_uint(best); const int ca = (bu >> 4) & 15, cb = bu & 15;
    const int i1 = (int)(__float_as_uint(__shfl(mylist[0], ca)) & 0x7fu), i2 = (int)(__float_as_uint(__shfl(mylist[1], cb)) & 0x7fu);
    const float sc = __uint_as_float(bu & ~0xffu), tp = __uint_as_float(__float_as_uint(top) & ~0xffu);
    const float ex = lane < 16 ? __expf(sc - tp) : 0.f;
    const float inv = 1.f / wave_sum(ex);
    if (lane < 16) { IDX[row * 128 + h * 16 + lane] = i1 * 128 + i2; GATE[row * 128 + h * 16 + lane] = ex * inv; }
}
DI float vmaxf(float a, float b) { float r; asm("v_max_f32_e32 %0, %1, %2" : "=v"(r) : "v"(a), "v"(b)); return r; }
DI float vminf(float a, float b) { float r; asm("v_min_f32_e32 %0, %1, %2" : "=v"(r) : "v"(a), "v"(b)); return r; }
DI void ins16(float (&L)[16], float x) {
#pragma unroll
    for (int i = 0; i < 16; ++i) { const float h = vmaxf(L[i], x); x = vminf(L[i], x); L[i] = h; }
}
DI void peer_topk_mfma(Frame& F, const bf16* PQb, int* IDX, float* GATE) {
    const int tid = F.tid, lane = F.lane, wid = F.wave, r32 = lane & 31, hi = lane >> 5, h = F.vcu & 7;
    __syncthreads();
    for (int i = tid; i < 2 * 128 * 16; i += 512) { const int p = i >> 11, key = (i >> 4) & 127, c = i & 15;
        *(LAS v4u*)(F.lds + p * 32768 + c * 2048 + key * 16) = *(const GAS v4u*)(F_SUBK + (size_t)((h * 2 + p) * 128 + key) * 128 + c * 8); }
    __syncthreads();
    LAS unsigned* scr = (LAS unsigned*)(F.lds + 65536 + wid * 8192) + lane;
    for (int g = (F.vcu >> 3) * 8 + wid; g < 512; g += (F.G >> 3) * 8) {
        const size_t token = (size_t)32 * g + r32;
        float LA[16], LB[16];
#pragma unroll
        for (int p = 0; p < 2; ++p) {
            float (&L)[16] = p ? LB : LA;
#pragma unroll
            for (int i = 0; i < 16; ++i) L[i] = -INFINITY;
            bf16x8 qf[8];
#pragma unroll
            for (int ks = 0; ks < 8; ++ks) qf[ks] = *(const GAS bf16x8*)(PQb + token * 2048 + (h * 2 + p) * 128 + 16 * ks + 8 * hi);
#pragma unroll
            for (int rt = 0; rt < 4; ++rt) {
                f32x16 S = {};
#pragma unroll
                for (int ks = 0; ks < 8; ++ks) S = __builtin_amdgcn_mfma_f32_32x32x16_bf16(*(const LAS bf16x8*)(F.lds + p * 32768 + (2 * ks + hi) * 2048 + (32 * rt + r32) * 16), qf[ks], S, 0, 0, 0);
#pragma unroll
                for (int r = 0; r < 16; ++r) { const unsigned key = (unsigned)(32 * rt + (r & 3) + 8 * (r >> 2)) + 4u * (unsigned)hi;
                    ins16(L, __uint_as_float((__float_as_uint(S[r]) & ~0x7fu) | key)); }
            }
            float PL[16];
#pragma unroll
            for (int i = 0; i < 16; ++i) { auto rr = __builtin_amdgcn_permlane32_swap(__float_as_uint(L[i]), __float_as_uint(L[i]), false, false); PL[i] = __uint_as_float(hi ? rr[0] : rr[1]); }
#pragma unroll
            for (int i = 0; i < 16; ++i) ins16(L, PL[i]);
        }
        float C[16];
#pragma unroll
        for (int i = 0; i < 16; ++i) C[i] = -INFINITY;
#pragma unroll
        for (int a = 0; a < 16; ++a) {
            const float va = __uint_as_float(__float_as_uint(LA[a]) & ~0x7fu);
#pragma unroll
            for (int b = 0; b < 16; ++b) if ((a + 1) * (b + 1) <= 16) {
                const float vb = __uint_as_float(__float_as_uint(LB[b]) & ~0x7fu);
                ins16(C, __uint_as_float((__float_as_uint(va + vb) & ~0xffu) | (unsigned)(a * 16 + b)));
            }
        }
#pragma unroll
        for (int i = 0; i < 16; ++i) { scr[i * 64] = __float_as_uint(LA[i]) & 0x7fu; scr[(16 + i) * 64] = __float_as_uint(LB[i]) & 0x7fu; }
        LDS_WAIT(); asm volatile("" ::: "memory");
        const float top = __uint_as_float(__float_as_uint(C[0]) & ~0xffu);
        float ex[16]; int ei[16]; float sum = 0.f;
#pragma unroll
        for (int r = 0; r < 16; ++r) { const unsigned cu = __float_as_uint(C[r]); ex[r] = __expf(__uint_as_float(cu & ~0xffu) - top); sum += ex[r];
            ei[r] = (int)(scr[((cu >> 4) & 15) * 64] * 128u + scr[(16 + (cu & 15)) * 64]); }
        const float inv = 1.f / sum;
        v4u io0, io1; f32x4 go0, go1;
        io0.x = hi ? ei[8] : ei[0]; io0.y = hi ? ei[9] : ei[1]; io0.z = hi ? ei[10] : ei[2]; io0.w = hi ? ei[11] : ei[3];
        io1.x = hi ? ei[12] : ei[4]; io1.y = hi ? ei[13] : ei[5]; io1.z = hi ? ei[14] : ei[6]; io1.w = hi ? ei[15] : ei[7];
        go0.x = (hi ? ex[8] : ex[0]) * inv; go0.y = (hi ? ex[9] : ex[1]) * inv; go0.z = (hi ? ex[10] : ex[2]) * inv; go0.w = (hi ? ex[11] : ex[3]) * inv;
        go1.x = (hi ? ex[12] : ex[4]) * inv; go1.y = (hi ? ex[13] : ex[5]) * inv; go1.z = (hi ? ex[14] : ex[6]) * inv; go1.w = (hi ? ex[15] : ex[7]) * inv;
        int* ip = IDX + token * 128 + h * 16 + 8 * hi; float* gp = GATE + token * 128 + h * 16 + 8 * hi;
        *(GAS v4u*)ip = io0; *(GAS v4u*)(ip + 4) = io1; *(GAS f32x4*)gp = go0; *(GAS f32x4*)(gp + 4) = go1;
        LDS_WAIT(); asm volatile("" ::: "memory");
    }
}
DI void peer_gather_row(Frame& F, const Args& A, const bf16* XN2, const int* IDX, const float* GATE, size_t row) {
    const int lane = F.lane;
    const v4u xa = *(const GAS v4u*)(XN2 + row * 1024 + 8 * lane), xb = *(const GAS v4u*)(XN2 + row * 1024 + 512 + 8 * lane);
    const int id0 = IDX[row * 128 + lane], id1 = IDX[row * 128 + 64 + lane];
    const float g0 = GATE[row * 128 + lane], g1 = GATE[row * 128 + 64 + lane];
    float acc[16];
#pragma unroll
    for (int i = 0; i < 16; ++i) acc[i] = 0.f;
#define PEER_DOT2(w, x, a) dot2_bf16((w), (x), (a))
    for (int half = 0; half < 2; ++half) {
        const int idv = half ? id1 : id0; const float gv = half ? g1 : g0;
        for (int e0 = 0; e0 < 64; e0 += 4) {
            v4u ua[4], ub[4], va[4], vb[4]; float gt[4];
#pragma unroll
            for (int j = 0; j < 4; ++j) {
                const int id = __builtin_amdgcn_readlane(idv, e0 + j); gt[j] = __uint_as_float(__builtin_amdgcn_readlane(__float_as_uint(gv), e0 + j));
                const bf16* up = F_UB + (size_t)id * 1024; const bf16* vp = F_VB + (size_t)id * 1024;
                ua[j] = *(const GAS v4u*)(up + 8 * lane); ub[j] = *(const GAS v4u*)(up + 512 + 8 * lane);
                va[j] = *(const GAS v4u*)(vp + 8 * lane); vb[j] = *(const GAS v4u*)(vp + 512 + 8 * lane);
            }
#pragma unroll
            for (int j = 0; j < 4; ++j) {
                float d0 = 0.f, d1 = 0.f;
                d0 = PEER_DOT2(ua[j].x, xa.x, d0); d1 = PEER_DOT2(ua[j].y, xa.y, d1); d0 = PEER_DOT2(ua[j].z, xa.z, d0); d1 = PEER_DOT2(ua[j].w, xa.w, d1);
                d0 = PEER_DOT2(ub[j].x, xb.x, d0); d1 = PEER_DOT2(ub[j].y, xb.y, d1); d0 = PEER_DOT2(ub[j].z, xb.z, d0); d1 = PEER_DOT2(ub[j].w, xb.w, d1);
                const float a = wave_sum(d0 + d1);
                const float cf = gt[j] * gelu_tanh_f(a);
                acc[0] += cf * bflo(va[j].x); acc[1] += cf * bfhi(va[j].x); acc[2] += cf * bflo(va[j].y); acc[3] += cf * bfhi(va[j].y);
                acc[4] += cf * bflo(va[j].z); acc[5] += cf * bfhi(va[j].z); acc[6] += cf * bflo(va[j].w); acc[7] += cf * bfhi(va[j].w);
                acc[8] += cf * bflo(vb[j].x); acc[9] += cf * bfhi(vb[j].x); acc[10] += cf * bflo(vb[j].y); acc[11] += cf * bfhi(vb[j].y);
                acc[12] += cf * bflo(vb[j].z); acc[13] += cf * bfhi(vb[j].z); acc[14] += cf * bflo(vb[j].w); acc[15] += cf * bfhi(vb[j].w);
            }
        }
    }
#undef PEER_DOT2
    float* hp = F.out + row * 1024;
    f32x4 y[4]; const int c0 = 8 * lane, c1 = 512 + 8 * lane;
    y[0] = *(const GAS f32x4*)(hp + c0); y[1] = *(const GAS f32x4*)(hp + c0 + 4); y[2] = *(const GAS f32x4*)(hp + c1); y[3] = *(const GAS f32x4*)(hp + c1 + 4);
    float ss = 0.f;
#pragma unroll
    for (int i = 0; i < 4; ++i) { y[i].x += acc[4 * i]; y[i].y += acc[4 * i + 1]; y[i].z += acc[4 * i + 2]; y[i].w += acc[4 * i + 3]; ss += (y[i].x * y[i].x + y[i].y * y[i].y) + (y[i].z * y[i].z + y[i].w * y[i].w); }
    const float rs = 1.f / sqrtf(wave_sum(ss) * (1.f / 1024.f) + EPS);
    const f32x4 g0v = *(const GAS f32x4*)(A.in[20] + c0), g1v = *(const GAS f32x4*)(A.in[20] + c0 + 4), g2v = *(const GAS f32x4*)(A.in[20] + c1), g3v = *(const GAS f32x4*)(A.in[20] + c1 + 4);
    *(GAS f32x4*)(hp + c0) = y[0] * rs * g0v; *(GAS f32x4*)(hp + c0 + 4) = y[1] * rs * g1v; *(GAS f32x4*)(hp + c1) = y[2] * rs * g2v; *(GAS f32x4*)(hp + c1 + 4) = y[3] * rs * g3v;
}

__global__ void __launch_bounds__(NWAVES * 64, 2) fwd_kernel(Args args) {
    extern __shared__ __attribute__((aligned(16))) unsigned char lds[];
    Frame F;
    F.lds = (LAS unsigned char*)lds;
    F.MISC = (volatile LAS unsigned*)(F.lds + MISC_OFF);
    F.tid = threadIdx.x; F.lane = F.tid & 63; F.wave = __builtin_amdgcn_readfirstlane(F.tid >> 6);
    F.G = gridDim.x; { const int bx = blockIdx.x; F.vcu = (F.G % 8 == 0) ? (bx % 8) * (F.G / 8) + bx / 8 : bx; }
    unsigned char* ws = args.ws;
    F.ctl = (gu32*)(ws + WS_CTL);
    F.out = args.out; F.ws = ws;
    for (int u = F.tid; u < (LDS_BYTES - LDSCTL_OFF) / 4; u += NWAVES * 64) ((LAS unsigned*)(F.lds + LDSCTL_OFF))[u] = 0u;
    __syncthreads();
    XcdBarrier bar = xcd_barrier_post((unsigned*)(F.ctl + CW_BAR), F.MISC + 8);
    const int lo = args.ph_lo, hi = args.ph_hi;
#ifndef PH_MASK
#define PH_MASK 0xffff
#endif
#define IN(k) (((PH_MASK >> (k)) & 1) && lo <= (k) && (k) < hi)
#define SEAM(k) do { if (IN(k) && IN((k) + 1)) xcd_barrier(bar); } while (0)
    const int gw = F.vcu * NWAVES + F.wave, NGW = F.G * NWAVES;
#define STW (F.out)
#define OSB (F.out + (size_t)M * 512)
#define IDX ((int*)F_BUFA)
#define GATE ((float*)(F_BUFA) + (size_t)M * 128)

    if (IN(0)) { p0_prologue(F, args); } SEAM(0);
    if (IN(1)) {
        { pg8::Gemm g{F_BUFA, F_W1T, 1024, 1024, 1024}; pg8::StaticOrder S; S.init(M, N1, F.G, (int)blockIdx.x, 1024, 1024);
          pg8::EpiBf16P E{F_PROJ, N1, 1.f};
          pg8::gemm_phase<pg8::EpiBf16P, pg8::StaticOrder, true, true>(F.lds, g, S, E); }
        { pg8::Gemm g{F_MN, F_WXKVT, 1024, 1024, 1024}; const int c = (int)blockIdx.x; pg8::OneUnitOrder S{(c >= 64 && c < 128) ? c - 64 : -1, 8, 1024, 1024};
          pg8::EpiBf16P E{F_KV, 2048, 1.f};
          pg8::gemm_phase<pg8::EpiBf16P, pg8::OneUnitOrder, true, true>(F.lds, g, S, E); }
    } SEAM(1);
    if (IN(2)) {
        for (int it = F.vcu; it < 256; it += F.G) { const int bh = it >> 2, s = it & 3; sb_unit(F, OSB, bh >> 3, bh & 7, 7 - s); sb_unit(F, OSB, bh >> 3, bh & 7, s); }
        for (int it = F.vcu; it < 1024; it += F.G) { const int bh = it >> 5; gla_local_unit(F, args, STW, bh >> 2, bh & 3, it & 31); }
    } SEAM(2);
    if (IN(3)) { gla_scan(F, STW); } SEAM(3);
    if (IN(4)) {
        for (int it = F.vcu; it < 1024; it += F.G) { const int bh = it >> 5; gla_out_unit(F, args, STW, bh >> 2, bh & 3, it & 31); }
        for (int m = gw; m < M; m += NGW) mix_row_sb(F, args, OSB, (size_t)m);
    } SEAM(4);
    if (IN(5)) { pg8::Gemm g{F_BUFA, F_WOT, 1024, 1024, 1024}; pg8::StaticOrder S; S.init(M, 1024, F.G, (int)blockIdx.x, 1024, 1024);
        pg8::EpiF32Res E{args.in[0], F.out, 1024};
        pg8::gemm_phase<pg8::EpiF32Res, pg8::StaticOrder, true, true>(F.lds, g, S, E); } SEAM(5);
    if (IN(6)) {
        for (int m = gw; m < M; m += NGW) rms_row_to_bf16(F.lane, F.out + (size_t)m * DM, args.in[10], F_SLOT0 + (size_t)m * DM);
        const int gt = gw * 64 + F.lane, NGT = NGW * 64;
        for (int i = gt; i < 8 * 4 * 256 * 32; i += NGT) { const int mc = i & 31, d = (i >> 5) & 255, h = (i >> 13) & 3, b = i >> 15;
            unsigned short v[8];
#pragma unroll
            for (int j = 0; j < 8; ++j) v[j] = F_KV[(size_t)(b * 256 + mc * 8 + j) * 2048 + 1024 + h * 256 + d];
            v4u o; o.x = v[0] | ((unsigned)v[1] << 16); o.y = v[2] | ((unsigned)v[3] << 16); o.z = v[4] | ((unsigned)v[5] << 16); o.w = v[6] | ((unsigned)v[7] << 16);
            *(GAS v4u*)(F_VT + (size_t)((b * 4 + h) * 256 + d) * 256 + mc * 8) = o; }
    } SEAM(6);
    if (IN(7)) { pg8::Gemm g{F_SLOT0, F_WXQT, 1024, 1024, 1024}; pg8::StaticOrder S; S.init(M, 1024, F.G, (int)blockIdx.x, 1024, 1024);
        pg8::EpiBf16P E{F_SLOT2, 1024, 1.f};
        pg8::gemm_phase<pg8::EpiBf16P, pg8::StaticOrder, true, true>(F.lds, g, S, E); } SEAM(7);
    if (IN(8)) { pg8::Gemm g{F_SLOT2, F_KV, 256, 1024, 2048}; pg8::XAttnOrder<0> S{F.G, (int)blockIdx.x};
        pg8::EpiBf16P E{F_SLOT1, 1024, 1.f};
        pg8::gemm_phase<pg8::EpiBf16P, pg8::XAttnOrder<0>, true, true>(F.lds, g, S, E); } SEAM(8);
    if (IN(9)) { for (int r = gw; r < M * 4; r += NGW) xsoftmax_row(F, F_SLOT1, (size_t)r); } SEAM(9);
    if (IN(10)) { pg8::Gemm g{F_SLOT1, F_VT, 256, 1024, 256}; pg8::XAttnOrder<1> S{F.G, (int)blockIdx.x};
        pg8::EpiBf16P E{F_SLOT0, 1024, 1.f};
        pg8::gemm_phase<pg8::EpiBf16P, pg8::XAttnOrder<1>, true, true>(F.lds, g, S, E); } SEAM(10);
    if (IN(11)) { pg8::Gemm g{F_SLOT0, F_WXOT, 1024, 1024, 1024}; pg8::StaticOrder S; S.init(M, 1024, F.G, (int)blockIdx.x, 1024, 1024);
        pg8::EpiF32Res E{F.out, F.out, 1024};
        pg8::gemm_phase<pg8::EpiF32Res, pg8::StaticOrder, true, true>(F.lds, g, S, E); } SEAM(11);
    if (IN(12)) { for (int m = gw; m < M; m += NGW) rms_row_to_bf16(F.lane, F.out + (size_t)m * DM, args.in[15], F_SLOT2 + (size_t)m * DM); } SEAM(12);
    if (IN(13)) { pg8::Gemm g{F_SLOT2, F_WPQT, 1024, 1024, 1024}; pg8::StaticOrder S; S.init(M, 2048, F.G, (int)blockIdx.x, 1024, 1024);
        pg8::EpiBf16P E{F_SLOT0, 2048, 1.f};
        pg8::gemm_phase<pg8::EpiBf16P, pg8::StaticOrder, true, true>(F.lds, g, S, E); } SEAM(13);
    if (IN(14)) { peer_topk_mfma(F, F_SLOT0, IDX, GATE); } SEAM(14);
    if (IN(15)) { for (int m = gw; m < M; m += NGW) peer_gather_row(F, args, F_SLOT2, IDX, GATE, (size_t)m); }
#undef IN
#undef SEAM
}

constexpr int NPHASES = 16;
#ifndef MK_PER_PHASE
#define MK_PER_PHASE 0
#endif
extern "C" void kernel_launch(void* const* d_in, const int* in_sizes, int n_in, void* d_out, int out_size, void* d_ws, size_t ws_size, hipStream_t stream) {
    static int grid = 0;
    if (grid == 0) {
        if (n_in != 21 || out_size != M * DM || ws_size < WS_END) { fprintf(stderr, "kernel_launch: unexpected shapes (n_in %d out %d ws %zu)\n", n_in, out_size, ws_size); grid = -1; return; }
        int dev = 0, cus = 0, per_cu = 0;
        if (hipGetDevice(&dev) != hipSuccess || hipDeviceGetAttribute(&cus, hipDeviceAttributeMultiprocessorCount, dev) != hipSuccess) { grid = -1; return; }
        if (hipFuncSetAttribute((const void*)fwd_kernel, hipFuncAttributeMaxDynamicSharedMemorySize, LDS_BYTES) != hipSuccess) { fprintf(stderr, "kernel_launch: hipFuncSetAttribute failed\n"); grid = -1; return; }
        if (hipOccupancyMaxActiveBlocksPerMultiprocessor(&per_cu, (const void*)fwd_kernel, NWAVES * 64, LDS_BYTES) != hipSuccess || per_cu < 1) { fprintf(stderr, "kernel_launch: occupancy query says %d\n", per_cu); }
        (void)hipGetLastError();
        grid = cus;
    }
    if (grid < 0) return;
    (void)hipMemsetAsync((char*)d_ws + WS_CTL, 0, CTL_ZERO_BYTES, stream);
    Args a{};
    for (int i = 0; i < 21; ++i) a.in[i] = (const float*)d_in[i];
    a.out = (float*)d_out; a.ws = (unsigned char*)d_ws;
#if MK_PER_PHASE
    for (int p = 0; p < NPHASES; ++p) { a.ph_lo = p; a.ph_hi = p + 1; hipLaunchKernelGGL(fwd_kernel, dim3(grid), dim3(NWAVES * 64), LDS_BYTES, stream, a); }
#else
    a.ph_lo = 0; a.ph_hi = NPHASES;
    hipLaunchKernelGGL(fwd_kernel, dim3(grid), dim3(NWAVES * 64), LDS_BYTES, stream, a);
#endif
}
```

```cpp
#include <hip/hip_runtime.h>
#include <cstdio>
#include <cstdint>
namespace pg8 {
#define PG8_LAS __attribute__((address_space(3)))
typedef unsigned short bf16_t;
typedef short bf16x8 __attribute__((ext_vector_type(8)));
typedef float f32x4 __attribute__((ext_vector_type(4)));
typedef unsigned u32x4 __attribute__((ext_vector_type(4)));
constexpr int BM = 256, BK = 64, HALF = 128, HTB = HALF * BK * 2  , STAGE_BYTES = 8 * HTB, NXCD = 8, WGM = 8;

__host__ __device__ __forceinline__ int lds_byte(int r, int c) { const int st = (r >> 4) * 2 + (c >> 5), rr = r & 15, cc = c & 31, ob = rr * 64 + cc * 2; return st * 1024 + (ob ^ (((ob >> 9) & 1) << 5)); }
__host__ __device__ __forceinline__ void stage_rc(int b, int& R, int& C) { const int st = b / 1024, sb = b % 1024, swz = sb ^ (((sb >> 9) & 1) << 5); R = (st >> 1) * 16 + swz / 64; C = (st & 1) * 32 + (swz % 64) / 2; }
__host__ __device__ __forceinline__ int perm32(int rho) { const int n = rho >> 4, i = rho & 15; return 8 * (i >> 2) + 4 * n + (i & 3); }

struct Unit { int pm, pn; size_t aoff, boff; };
struct Gemm { const bf16_t* A; const bf16_t* Bt; int K, lda, ldb; };

struct StaticOrder {
    int nM, nN, nwg, G, c, lda, ldb;
    __host__ __device__ void init(int M, int N, int G_, int c_, int lda_, int ldb_) { nM = M / BM; nN = N / BM; nwg = nM * nN; G = G_; c = c_; lda = lda_; ldb = ldb_; }
    __host__ __device__ bool next(int i, Unit& u) const {
        const long L = (long)i * G + c; if (L >= nwg) return false;
        int wgid = (int)L; { const int q = nwg / NXCD, r = nwg % NXCD, xcd = wgid % NXCD, off = wgid / NXCD; wgid = (xcd < r ? xcd * (q + 1) : r * (q + 1) + (xcd - r) * q) + off; }
        const int nig = WGM * nN, gid = wgid / nig, fm = gid * WGM, gsz = (nM - fm) < WGM ? (nM - fm) : WGM;
        u.pm = fm + ((wgid % nig) % gsz); u.pn = (wgid % nig) / gsz; u.aoff = (size_t)u.pm * BM * lda * 2; u.boff = (size_t)u.pn * BM * ldb * 2; return true;
    }
    __device__ __forceinline__ void a_ready(const Unit&) const {}
    __device__ __forceinline__ void done(const Unit&) const {}
};

__device__ __forceinline__ unsigned cvt_pk_bf16(float lo, float hi) { unsigned r; asm volatile("v_cvt_pk_bf16_f32 %0, %1, %2" : "=v"(r) : "v"(lo), "v"(hi)); return r; }
typedef float f32x2 __attribute__((ext_vector_type(2)));
__device__ __forceinline__ f32x2 gelu_pk(f32x2 v) {
    const f32x2 av = __builtin_elementwise_abs(v), d = av * 0.2316418882f + 1.0f;
    f32x2 t; t.x = __builtin_amdgcn_rcpf(d.x); t.y = __builtin_amdgcn_rcpf(d.y);
    f32x2 q = t * 0.5307027145f + (-0.7265760135f); q = q * t + 0.7107068705f; q = q * t + (-0.142248368f); q = q * t + 0.127414796f; q = q * t;
    const f32x2 s = (v * v) * (-0.72134752044f);
    f32x2 e; e.x = __builtin_amdgcn_exp2f(s.x); e.y = __builtin_amdgcn_exp2f(s.y);
    const f32x2 m = v * (q * e), r = v - m;
    f32x2 o; o.x = v.x < 0.f ? m.x : r.x; o.y = v.y < 0.f ? m.y : r.y; return o;
}

template <int ACT  > struct EpiBf16 {
    static constexpr bool PERM = true, AFTER_DRAIN = false; static_assert(ACT == 0 || ACT == 1, "EpiBf16: ACT is 0 (none) or 1 (gelu_pk)");
    bf16_t* O; int ldc; const float* bias; int split_cols; size_t split_stride; float scale0;
    __device__ __forceinline__ void operator()(const f32x4 (&acc)[2][2][4][2], const Unit& u, int wr, int wc, int fr, int fq) const {
        const int row0 = u.pm * BM + wr * 64 + fr; int colt = u.pn * BM; bf16_t* base = O;
        float sc = 1.f; if (split_cols) { const int t = colt / split_cols; base += (size_t)t * split_stride; colt -= t * split_cols; if (t == 0) sc = scale0; }
        const int col0 = colt + wc * 32 + 8 * fq, bcol0 = u.pn * BM + wc * 32 + 8 * fq;
        f32x4 bv[2][2];
#pragma unroll
        for (int bj = 0; bj < 2; ++bj)
#pragma unroll
            for (int n = 0; n < 2; ++n) bv[bj][n] = bias ? *(const f32x4*)(bias + bcol0 + bj * HALF + 4 * n) : (f32x4){0.f, 0.f, 0.f, 0.f};
#pragma unroll
        for (int ai = 0; ai < 2; ++ai)
#pragma unroll
            for (int m = 0; m < 4; ++m) { bf16_t* rowp = base + (size_t)(row0 + ai * HALF + m * 16) * ldc + col0;
#pragma unroll
                for (int bj = 0; bj < 2; ++bj) { f32x4 v0 = acc[ai][bj][m][0] + bv[bj][0], v1 = acc[ai][bj][m][1] + bv[bj][1];
                    if (ACT == 1) { f32x2 a = gelu_pk((f32x2){v0[0], v0[1]}), b = gelu_pk((f32x2){v0[2], v0[3]}), c = gelu_pk((f32x2){v1[0], v1[1]}), d = gelu_pk((f32x2){v1[2], v1[3]});
                        v0 = (f32x4){a.x, a.y, b.x, b.y}; v1 = (f32x4){c.x, c.y, d.x, d.y}; }
                    v0 = v0 * sc; v1 = v1 * sc; u32x4 w; w.x = cvt_pk_bf16(v0[0], v0[1]); w.y = cvt_pk_bf16(v0[2], v0[3]); w.z = cvt_pk_bf16(v1[0], v1[1]); w.w = cvt_pk_bf16(v1[2], v1[3]);
                    *(u32x4*)(rowp + bj * HALF) = w; } }
    }
};
template <class Epi, class Sched, bool ALIGN_EPI = false, bool SP2 = false>
__device__ __forceinline__ void gemm_phase(PG8_LAS unsigned char* lds, const Gemm g, const Sched& S, const Epi& E) {
    const int tid = threadIdx.x, wid = __builtin_amdgcn_readfirstlane(tid >> 6), lane = tid & 63, wr = wid >> 2, wc = wid & 3, fr = lane & 15, fq = lane >> 4;
    int K = g.K; asm volatile("" : "+s"(K));
    const int nt = K / BK;
    unsigned voffA[2], voffB[2];
#pragma unroll
    for (int i = 0; i < 2; ++i) { int R, C; stage_rc(tid * 16 + i * 8192, R, C); const int Rb = Epi::PERM ? ((R & ~31) + perm32(R & 31)) : R;
        voffA[i] = (unsigned)(R * g.lda + C) * 2u; voffB[i] = (unsigned)(Rb * g.ldb + C) * 2u; }
    const size_t kstep = (size_t)(BK * 2);
    const size_t hA = (size_t)HALF * g.lda * 2, hB = (size_t)HALF * g.ldb * 2;
    const unsigned ldsw = (unsigned)wid * 1024u;
    const int aoff = lds_byte(wr * 64 + fr, fq * 8), boff = lds_byte(wc * 32 + fr, fq * 8);
#define PG8_SA(b, h) (((b) * 2 + (h)) * HTB)
#define PG8_SB(b, h) ((4 + (b) * 2 + (h)) * HTB)
#define PG8_STAGE(bufoff, gbase, voff) do { _Pragma("unroll") for (int _i = 0; _i < 2; ++_i) \
        __builtin_amdgcn_global_load_lds((const unsigned*)((const char*)(gbase) + (voff)[_i]), (PG8_LAS unsigned*)(lds + (bufoff) + ldsw + _i * 8192), 16, 0, 0); } while (0)
#define PG8_LDA(dst, b, h) do { _Pragma("unroll") for (int m = 0; m < 4; ++m) _Pragma("unroll") for (int k = 0; k < 2; ++k) dst[m][k] = *(const PG8_LAS bf16x8*)(lds + PG8_SA(b, h) + aoff + m * 2048 + k * 1024); } while (0)
#define PG8_LDB(dst, b, h) do { _Pragma("unroll") for (int n = 0; n < 2; ++n) _Pragma("unroll") for (int k = 0; k < 2; ++k) dst[n][k] = *(const PG8_LAS bf16x8*)(lds + PG8_SB(b, h) + boff + n * 2048 + k * 1024); } while (0)
#define PG8_MMA(ai, bj, At, Bt) do { __builtin_amdgcn_s_setprio(1); _Pragma("unroll") for (int m = 0; m < 4; ++m) _Pragma("unroll") for (int n = 0; n < 2; ++n) _Pragma("unroll") for (int k = 0; k < 2; ++k) \
        acc[ai][bj][m][n] = __builtin_amdgcn_mfma_f32_16x16x32_bf16(Bt[n][k], At[m][k], acc[ai][bj][m][n], 0, 0, 0); __builtin_amdgcn_s_setprio(0); } while (0)
#define PG8_WAIT_V(n) asm volatile("s_waitcnt vmcnt(" #n ")" ::: "memory")
#define PG8_WAIT_L(n) asm volatile("s_waitcnt lgkmcnt(" #n ")" ::: "memory")
#define PG8_BAR __builtin_amdgcn_s_barrier()
#define PG8_SCHED __builtin_amdgcn_sched_barrier(0)
    Unit cur, nxt; int ui = 0;
    if (!S.next(0, cur)) return;
    f32x4 acc[2][2][4][2];
#pragma unroll
    for (int a = 0; a < 2; ++a)
#pragma unroll
        for (int b = 0; b < 2; ++b)
#pragma unroll
            for (int m = 0; m < 4; ++m)
#pragma unroll
                for (int n = 0; n < 2; ++n) acc[a][b][m][n] = (f32x4){0.f, 0.f, 0.f, 0.f};
    bf16x8 At[4][2], B0[2][2], B1[2][2];
    const char* cA = (const char*)g.A + cur.aoff; const char* cB = (const char*)g.Bt + cur.boff;
    S.a_ready(cur);
    if constexpr (SP2) {
        PG8_STAGE(PG8_SB(0, 0), cB, voffB); PG8_STAGE(PG8_SB(0, 1), cB + hB, voffB); PG8_STAGE(PG8_SA(0, 0), cA, voffA); PG8_STAGE(PG8_SA(0, 1), cA + hA, voffA);
        if (wr == 1) PG8_BAR;
        PG8_WAIT_V(2); PG8_BAR;
        PG8_STAGE(PG8_SB(1, 0), cB + kstep, voffB); PG8_STAGE(PG8_SA(1, 0), cA + kstep, voffA); PG8_STAGE(PG8_SB(1, 1), cB + hB + kstep, voffB);
        PG8_WAIT_V(6); PG8_BAR;
    } else {
        PG8_STAGE(PG8_SB(0, 0), cB, voffB); PG8_STAGE(PG8_SA(0, 0), cA, voffA); PG8_STAGE(PG8_SB(0, 1), cB + hB, voffB); PG8_STAGE(PG8_SA(0, 1), cA + hA, voffA);
        if (wr == 1) PG8_BAR;
        PG8_WAIT_V(4); PG8_BAR;
        PG8_STAGE(PG8_SB(1, 0), cB + kstep, voffB); PG8_STAGE(PG8_SA(1, 0), cA + kstep, voffA); PG8_STAGE(PG8_SB(1, 1), cB + hB + kstep, voffB);
        PG8_WAIT_V(6); PG8_BAR;
    }
    for (;;) {
        const bool has_next = S.next(ui + 1, nxt);
        const char* nA = has_next ? (const char*)g.A + nxt.aoff : cA; const char* nB = has_next ? (const char*)g.Bt + nxt.boff : cB;
        for (int t = 0; t < nt; t += 2) {
            const bool last = (t == nt - 2);
            const char* a1 = cA + (size_t)(t + 1) * kstep;
            const char* a2 = last ? nA : cA + (size_t)(t + 2) * kstep; const char* b2 = last ? nB : cB + (size_t)(t + 2) * kstep;
            const char* a3 = a2 + kstep; const char* b3 = b2 + kstep;
            if (last && has_next) S.a_ready(nxt);
            if constexpr (SP2) {
            PG8_LDB(B0, 0, 0); PG8_LDB(B1, 0, 1); PG8_SCHED; PG8_LDA(At, 0, 0); PG8_STAGE(PG8_SA(1, 1), a1 + hA, voffA);
            PG8_WAIT_V(8); PG8_WAIT_L(0); PG8_BAR; PG8_MMA(0, 0, At, B0); PG8_MMA(0, 1, At, B1); PG8_BAR; PG8_SCHED;
            PG8_LDA(At, 0, 1); PG8_STAGE(PG8_SB(0, 0), b2, voffB); PG8_STAGE(PG8_SB(0, 1), b2 + hB, voffB); PG8_STAGE(PG8_SA(0, 0), a2, voffA);
            PG8_WAIT_V(8); PG8_WAIT_L(0); PG8_BAR; PG8_MMA(1, 0, At, B0); PG8_MMA(1, 1, At, B1); PG8_BAR; PG8_SCHED;
            PG8_LDB(B0, 1, 0); PG8_LDB(B1, 1, 1); PG8_SCHED; PG8_LDA(At, 1, 0); PG8_STAGE(PG8_SA(0, 1), a2 + hA, voffA);
            PG8_WAIT_V(8); PG8_WAIT_L(0); PG8_BAR; PG8_MMA(0, 0, At, B0); PG8_MMA(0, 1, At, B1); PG8_BAR; PG8_SCHED;
            PG8_LDA(At, 1, 1); PG8_STAGE(PG8_SB(1, 0), b3, voffB); PG8_STAGE(PG8_SB(1, 1), b3 + hB, voffB); PG8_STAGE(PG8_SA(1, 0), a3, voffA);
            PG8_WAIT_V(8); PG8_WAIT_L(0); PG8_BAR; PG8_MMA(1, 0, At, B0); PG8_MMA(1, 1, At, B1); PG8_BAR; PG8_SCHED;
            } else {
            PG8_LDB(B0, 0, 0); PG8_SCHED; PG8_LDA(At, 0, 0); PG8_STAGE(PG8_SA(1, 1), a1 + hA, voffA);
            PG8_WAIT_L(8); PG8_BAR; PG8_WAIT_L(0); PG8_MMA(0, 0, At, B0); PG8_BAR; PG8_SCHED;
            PG8_LDB(B1, 0, 1); PG8_STAGE(PG8_SB(0, 0), b2, voffB);
            PG8_BAR; PG8_WAIT_L(0); PG8_MMA(0, 1, At, B1); PG8_BAR;
            PG8_LDA(At, 0, 1); PG8_STAGE(PG8_SA(0, 0), a2, voffA);
            PG8_BAR; PG8_WAIT_L(0); PG8_MMA(1, 0, At, B0); PG8_BAR; PG8_SCHED;
            PG8_STAGE(PG8_SB(0, 1), b2 + hB, voffB);
            PG8_WAIT_V(6); PG8_BAR; PG8_MMA(1, 1, At, B1); PG8_BAR;
            PG8_LDB(B0, 1, 0); PG8_SCHED; PG8_LDA(At, 1, 0); PG8_STAGE(PG8_SA(0, 1), a2 + hA, voffA);
            PG8_WAIT_L(8); PG8_BAR; PG8_WAIT_L(0); PG8_MMA(0, 0, At, B0); PG8_BAR; PG8_SCHED;
            PG8_LDB(B1, 1, 1); PG8_STAGE(PG8_SB(1, 0), b3, voffB);
            PG8_BAR; PG8_WAIT_L(0); PG8_MMA(0, 1, At, B1); PG8_BAR;
            PG8_LDA(At, 1, 1); PG8_STAGE(PG8_SA(1, 0), a3, voffA);
            PG8_BAR; PG8_WAIT_L(0); PG8_MMA(1, 0, At, B0); PG8_BAR; PG8_SCHED;
            PG8_STAGE(PG8_SB(1, 1), b3 + hB, voffB);
            PG8_WAIT_V(6); PG8_BAR; PG8_MMA(1, 1, At, B1); PG8_BAR;
            }
        }
        if constexpr (ALIGN_EPI) { if (wr == 0) PG8_BAR; }
        if constexpr (!Epi::AFTER_DRAIN) { E(acc, cur, wr, wc, fr, fq); S.done(cur); }
        if (!has_next) break;
#pragma unroll
        for (int a = 0; a < 2; ++a)
#pragma unroll
            for (int b = 0; b < 2; ++b)
#pragma unroll
                for (int m = 0; m < 4; ++m)
#pragma unroll
                    for (int n = 0; n < 2; ++n) acc[a][b][m][n] = (f32x4){0.f, 0.f, 0.f, 0.f};
        cur = nxt; cA = nA; cB = nB; ++ui;
        if constexpr (ALIGN_EPI) { if (wr == 1) PG8_BAR; }
    }
    PG8_WAIT_V(0);
    if constexpr (!ALIGN_EPI) { if (wr == 0) PG8_BAR; }
    PG8_BAR;
    if constexpr (Epi::AFTER_DRAIN) { E.fused(acc, cur, wr, wc, fr, fq, lds, wid, lane); S.done(cur); }
#undef PG8_SA
#undef PG8_SB
#undef PG8_STAGE
#undef PG8_LDA
#undef PG8_LDB
#undef PG8_MMA
#undef PG8_WAIT_V
#undef PG8_WAIT_L
#undef PG8_BAR
#undef PG8_SCHED
}
}
namespace pg8 {
struct EpiBf16P {
    static constexpr bool PERM = true, AFTER_DRAIN = false;
    bf16_t* O; int ldc; float sc;
    __device__ __forceinline__ void operator()(const f32x4 (&acc)[2][2][4][2], const Unit& u, int wr, int wc, int fr, int fq) const {
        const int row0 = u.pm * BM + wr * 64 + fr, col0 = u.pn * BM + wc * 32 + 8 * fq;
#pragma unroll
        for (int ai = 0; ai < 2; ++ai)
#pragma unroll
            for (int m = 0; m < 4; ++m) { bf16_t* rowp = O + (size_t)(row0 + ai * HALF + m * 16) * ldc + col0;
#pragma unroll
                for (int bj = 0; bj < 2; ++bj) { const f32x4 v0 = acc[ai][bj][m][0] * sc, v1 = acc[ai][bj][m][1] * sc;
                    u32x4 w; w.x = cvt_pk_bf16(v0[0], v0[1]); w.y = cvt_pk_bf16(v0[2], v0[3]); w.z = cvt_pk_bf16(v1[0], v1[1]); w.w = cvt_pk_bf16(v1[2], v1[3]);
                    *(u32x4*)(rowp + bj * HALF) = w; } }
    }
};
struct EpiF32Res {
    static constexpr bool PERM = false, AFTER_DRAIN = false;
    const float* base; float* out; int ldc;
    __device__ __forceinline__ void operator()(const f32x4 (&acc)[2][2][4][2], const Unit& u, int wr, int wc, int fr, int fq) const {
        const int row0 = u.pm * BM + wr * 64 + fr, col0 = u.pn * BM + wc * 32 + 4 * fq;
#pragma unroll
        for (int ai = 0; ai < 2; ++ai)
#pragma unroll
            for (int m = 0; m < 4; ++m) { const size_t off = (size_t)(row0 + ai * HALF + m * 16) * ldc + col0;
#pragma unroll
                for (int bj = 0; bj < 2; ++bj)
#pragma unroll
                    for (int n = 0; n < 2; ++n) { const f32x4 b = *(const f32x4*)(base + off + bj * HALF + n * 16); *(f32x4*)(out + off + bj * HALF + n * 16) = b + acc[ai][bj][m][n]; } }
    }
};
template <int mode> struct XAttnOrder {
    int G, c;
    __device__ __forceinline__ bool next(int i, Unit& u) const {
        const int L = i * G + c; if (L >= 256) return false;
        u.pm = L >> 2; u.pn = L & 3; const int b = u.pm >> 3;
        u.aoff = ((size_t)u.pm * 256 * 1024 + (size_t)u.pn * 256) * 2;
        u.boff = mode == 0 ? ((size_t)(b * 256) * 2048 + (size_t)u.pn * 256) * 2 : ((size_t)((b * 4 + u.pn) * 256) * 256) * 2;
        return true;
    }
    __device__ __forceinline__ void a_ready(const Unit&) const {}
    __device__ __forceinline__ void done(const Unit&) const {}
};
struct OneUnitOrder {
    int L, nN, lda, ldb;
    __device__ __forceinline__ bool next(int i, Unit& u) const {
        if (i != 0 || L < 0) return false;
        u.pm = L / nN; u.pn = L % nN; u.aoff = (size_t)u.pm * BM * lda * 2; u.boff = (size_t)u.pn * BM * ldb * 2; return true;
    }
    __device__ __forceinline__ void a_ready(const Unit&) const {}
    __device__ __forceinline__ void done(const Unit&) const {}
};
}

constexpr int NWAVES = 8;
constexpr int BATCH = 8, SEQ = 2048, DM = 1024, M = BATCH * SEQ, MEMLEN = 256, MM = BATCH * MEMLEN;
constexpr int INCOLS = 3088;
constexpr int N1 = 3328;
constexpr int PQ = 0, PK = 256, PV = 512, POG = 1024, PSQ = 1536, PSK = 2048, PSV = 2560, PGATE = 3072;
constexpr int PEER_N = 16384;
constexpr float EPS = 1e-6f;

constexpr size_t MiB = 1u << 20;
constexpr size_t WS_CTL = 0, CTL_ZERO_BYTES = 1 * MiB;
constexpr size_t WS_W1T = 1 * MiB;
constexpr size_t WS_WOT = 8 * MiB, WS_WXQT = 10 * MiB, WS_WXOT = 12 * MiB, WS_WXKVT = 14 * MiB, WS_WPQT = 18 * MiB, WS_SUBK = 22 * MiB;
constexpr size_t WS_UB = 24 * MiB, WS_VB = 56 * MiB;
constexpr size_t WS_BUFA = 88 * MiB;
constexpr size_t WS_MN = 120 * MiB;
constexpr size_t WS_KV = 124 * MiB;
constexpr size_t WS_PROJ = 132 * MiB;
constexpr size_t WS_SLOT0 = 132 * MiB, WS_SLOT1 = 164 * MiB, WS_SLOT2 = 196 * MiB, WS_VT = 228 * MiB, WS_END = 236 * MiB;
constexpr int CW_BAR = 4096;
constexpr int CW_SBSS = 32768;

constexpr int RING_BYTES = 131072;
constexpr int LDSCTL_OFF = RING_BYTES, MISC_OFF = LDSCTL_OFF + 320;
constexpr int LDS_BYTES = 147456;

#define GAS __attribute__((address_space(1)))
#define LAS __attribute__((address_space(3)))
typedef unsigned short bf16;
typedef unsigned v4u __attribute__((ext_vector_type(4)));
typedef float f32x4 __attribute__((ext_vector_type(4)));
typedef short bf16x8 __attribute__((ext_vector_type(8)));
typedef GAS unsigned gu32;
typedef GAS unsigned long long gu64;
#define RLX_AGENT __ATOMIC_RELAXED, __HIP_MEMORY_SCOPE_AGENT
#define LDS_WAIT() asm volatile("s_waitcnt lgkmcnt(0)" ::: "memory")
#define VM_WAIT() asm volatile("s_waitcnt vmcnt(0)" ::: "memory")
__device__ __forceinline__ unsigned long long rt() { return __builtin_amdgcn_s_memrealtime(); }
__device__ __forceinline__ unsigned f2bf(float f) { unsigned u = __builtin_bit_cast(unsigned, f); return (u + 0x7fffu + ((u >> 16) & 1u)) >> 16; }
__device__ __forceinline__ unsigned pk2(float lo, float hi) { return f2bf(lo) | (f2bf(hi) << 16); }

#define XB_TMO      128
#define XB_XCNT(j)  (256  + 64 * (j))
#define XB_XSUB(j)  (1280 + 64 * (j))
#define XB_XGEN(j)  (2304 + 64 * (j))
#define XB_TOP      3328
#define XB_TOPGEN   3392
#define XCD_BAR_WORDS 3456
#define XB_SPIN_CAP (1u << 22)

__device__ __forceinline__ unsigned xb_ld(unsigned* p)              { return __hip_atomic_load(p, __ATOMIC_RELAXED, __HIP_MEMORY_SCOPE_AGENT); }
__device__ __forceinline__ unsigned xb_add(unsigned* p, unsigned v) { return __hip_atomic_fetch_add(p, v, __ATOMIC_RELAXED, __HIP_MEMORY_SCOPE_AGENT); }
__device__ __forceinline__ unsigned xb_xcc_id() { return (unsigned)__builtin_amdgcn_s_getreg((3 << 11) | 20) & 0xFu; }
#define XB_SPIN(cond, bar) do { unsigned _sp = 0; while (cond) { __builtin_amdgcn_s_sleep(1); \
    if ((++_sp & 255u) == 0u) { if (xb_ld(&(bar)[XB_TMO])) break; if (_sp > XB_SPIN_CAP) { atomicAdd(&(bar)[XB_TMO], 1u); break; } } } } while (0)

struct XcdBarrier {
    unsigned* bar; unsigned x;
    volatile LAS unsigned* st;
};

__device__ __forceinline__ XcdBarrier xcd_barrier_post(unsigned* bar, volatile LAS unsigned* st) {
    XcdBarrier b; b.bar = bar; b.x = xb_xcc_id(); b.st = st;
    if (threadIdx.x == 0) (void)xb_add(&bar[XB_XCNT(b.x)], 1u);
    return b;
}
__device__ __forceinline__ void xcd_barrier_complete(unsigned* bar, unsigned x, unsigned& nloc, unsigned& nx) {
    const unsigned G = gridDim.x * gridDim.y * gridDim.z;
    unsigned sum, cnt, mine, sp = 0u;
    for (;;) {
        sum = 0u; cnt = 0u; mine = 0u;
#pragma unroll
        for (unsigned j = 0; j < 16; ++j) { const unsigned c = xb_ld(&bar[XB_XCNT(j)]); sum += c; cnt += (c > 0u) ? 1u : 0u; mine = (j == x) ? c : mine; }
        if (sum == G) break;
        __builtin_amdgcn_s_sleep(1);
        if ((++sp & 255u) == 0u) { if (xb_ld(&bar[XB_TMO])) break; if (sp > XB_SPIN_CAP) { atomicAdd(&bar[XB_TMO], 1u); break; } }
    }
    nloc = mine > 0u ? mine : 1u; nx = cnt > 0u ? cnt : 1u;
}

__device__ __forceinline__ void xcd_barrier(const XcdBarrier& b) {
    asm volatile("s_waitcnt vmcnt(0)" ::: "memory");
    __syncthreads();
    if (threadIdx.x == 0) {
        unsigned* bar = b.bar;
        __builtin_amdgcn_s_waitcnt(0);
        unsigned nloc = b.st[0], nx = b.st[1];
        if (nloc == 0u) { xcd_barrier_complete(bar, b.x, nloc, nx); b.st[0] = nloc; b.st[1] = nx; }
        const unsigned old = xb_add(&bar[XB_XSUB(b.x)], 1u);
        const unsigned gen = old / nloc;
        if (old + 1u == (gen + 1u) * nloc) {
            __builtin_amdgcn_fence(__ATOMIC_RELEASE, "agent");
            asm volatile("s_waitcnt vmcnt(0)" ::: "memory");
            const unsigned og = xb_add(&bar[XB_TOP], 1u);
            const unsigned tg = og / nx;
            if (og + 1u == (tg + 1u) * nx) xb_add(&bar[XB_TOPGEN], 1u);
            else XB_SPIN(xb_ld(&bar[XB_TOPGEN]) == tg, bar);
            __builtin_amdgcn_fence(__ATOMIC_ACQUIRE, "agent");
            xb_add(&bar[XB_XGEN(b.x)], 1u);
            asm volatile("s_waitcnt vmcnt(0)" ::: "memory");
        } else {
            XB_SPIN(xb_ld(&bar[XB_XGEN(b.x)]) == gen, bar);
            __builtin_amdgcn_fence(__ATOMIC_ACQUIRE, "agent");
            asm volatile("s_waitcnt vmcnt(0)" ::: "memory");
        }
    }
    __syncthreads();
}

#define DI __device__ __forceinline__
typedef __bf16 bf16x2_t __attribute__((ext_vector_type(2)));
struct Args { const float* in[21]; float* out; unsigned char* ws; int ph_lo, ph_hi, li, pad; };
struct Frame {
    LAS unsigned char* lds;
    volatile LAS unsigned* MISC;
    gu32* ctl;
    int tid, lane, wave;
    int vcu, G;
    unsigned char* ws; float* out;
};
#define WSP(off) ((bf16*)(F.ws + (off)))
#define F_W1T WSP(WS_W1T)
#define F_WOT WSP(WS_WOT)
#define F_WXQT WSP(WS_WXQT)
#define F_WXOT WSP(WS_WXOT)
#define F_WXKVT WSP(WS_WXKVT)
#define F_WPQT WSP(WS_WPQT)
#define F_SUBK WSP(WS_SUBK)
#define F_UB WSP(WS_UB)
#define F_VB WSP(WS_VB)
#define F_BUFA WSP(WS_BUFA)
#define F_MN WSP(WS_MN)
#define F_KV WSP(WS_KV)
#define F_PROJ WSP(WS_PROJ)
#define F_SLOT0 WSP(WS_SLOT0)
#define F_SLOT1 WSP(WS_SLOT1)
#define F_SLOT2 WSP(WS_SLOT2)
#define F_VT WSP(WS_VT)
DI float bf2f(unsigned v) { return __uint_as_float(v << 16); }
DI float bflo(unsigned w) { return __uint_as_float(w << 16); }
DI float bfhi(unsigned w) { return __uint_as_float(w & 0xffff0000u); }
DI float wave_sum(float v) {
#pragma unroll
    for (int o = 1; o < 64; o <<= 1) v += __shfl_xor(v, o);
    return v;
}
DI float wave_max(float v) {
#pragma unroll
    for (int o = 1; o < 64; o <<= 1) v = fmaxf(v, __shfl_xor(v, o));
    return v;
}
DI float dot2_bf16(unsigned w, unsigned x, float a) { return __builtin_amdgcn_fdot2_f32_bf16(__builtin_bit_cast(bf16x2_t, w), __builtin_bit_cast(bf16x2_t, x), a, false); }
DI float silu_f(float x) { return x / (1.f + __expf(-x)); }
DI float log_sigmoid_f(float z) { return fminf(z, 0.f) - __logf(1.f + __expf(-fabsf(z))); }
DI float gelu_tanh_f(float x) { const float y = 0.7978845608028654f * (x + 0.044715f * x * x * x); const float t = 1.f - 2.f / (1.f + __expf(2.f * y)); return 0.5f * x * (1.f + t); }

DI void p0_transpose_item(const float* W, int ldw, int c0, bf16* WT, int row_off, LAS float* scr, int kb, int nb, int lane) {
    const int k0 = 64 * kb, n0 = 32 * nb;
#pragma unroll 8
    for (int i = 0; i < 32; ++i) { const int kk = 2 * i + (lane >> 5); scr[kk * 33 + (lane & 31)] = W[(size_t)(k0 + kk) * ldw + c0 + n0 + (lane & 31)]; }
    LDS_WAIT(); asm volatile("" ::: "memory");
    const int c = lane & 7;
#pragma unroll
    for (int j = 0; j < 4; ++j) { const int n = (lane >> 3) + 8 * j; const LAS float* s = scr + (8 * c) * 33 + n;
        v4u o; o.x = pk2(s[0 * 33], s[1 * 33]); o.y = pk2(s[2 * 33], s[3 * 33]); o.z = pk2(s[4 * 33], s[5 * 33]); o.w = pk2(s[6 * 33], s[7 * 33]);
        *(GAS v4u*)(WT + (size_t)(row_off + n0 + n) * 1024 + k0 + 8 * c) = o; }
    LDS_WAIT(); asm volatile("" ::: "memory");
}
DI void rms_row_to_bf16(int lane, const float* xrow, const float* g, bf16* orow) {
    const GAS f32x4* xr = (const GAS f32x4*)xrow + lane; const GAS f32x4* gr = (const GAS f32x4*)g + lane;
    f32x4 v[4]; float s = 0.f;
#pragma unroll
    for (int j = 0; j < 4; ++j) { v[j] = xr[64 * j]; s += (v[j].x * v[j].x + v[j].y * v[j].y) + (v[j].z * v[j].z + v[j].w * v[j].w); }
    const float rs = 1.f / sqrtf(wave_sum(s) * (1.f / 1024.f) + EPS);
    GAS unsigned long long* o8 = (GAS unsigned long long*)orow + lane;
#pragma unroll
    for (int j = 0; j < 4; ++j) { const f32x4 gg = gr[64 * j]; const f32x4 y = v[j] * rs * gg; o8[64 * j] = (unsigned long long)pk2(y.x, y.y) | ((unsigned long long)pk2(y.z, y.w) << 32); }
}
typedef float f32x2 __attribute__((ext_vector_type(2)));
constexpr size_t WS_U8 = 24 * MiB, WS_V8 = 40 * MiB, WS_X8 = 56 * MiB, WS_SU = 72 * MiB, WS_SX = 72 * MiB + 65536;
template <int CTRL> DI int dpp_i(int v) { return __builtin_amdgcn_update_dpp(0, v, CTRL, 0xf, 0xf, false); }
DI void quant_row_i8(int lane, const float* src, unsigned char* dst, float* scale_out) {
    f32x4 v[4]; float m = 0.f;
#pragma unroll
    for (int j = 0; j < 4; ++j) { v[j] = *(const GAS f32x4*)(src + 16 * lane + 4 * j); m = fmaxf(m, fmaxf(fmaxf(fabsf(v[j].x), fabsf(v[j].y)), fmaxf(fabsf(v[j].z), fabsf(v[j].w)))); }
    m = wave_max(m);
    const float sc = m > 0.f ? m * (1.f / 127.f) : 1.f, inv = 1.f / sc;
    v4u o;
#pragma unroll
    for (int j = 0; j < 4; ++j) { const int a = (int)rintf(v[j].x * inv), b = (int)rintf(v[j].y * inv), c = (int)rintf(v[j].z * inv), d = (int)rintf(v[j].w * inv);
        o[j] = (unsigned)(a & 255) | ((unsigned)(b & 255) << 8) | ((unsigned)(c & 255) << 16) | ((unsigned)(d & 255) << 24); }
    *(GAS v4u*)(dst + 16 * lane) = o;
    if (lane == 0) *scale_out = sc;
}
DI void quant_row_fp8(int lane, const float* src, unsigned char* dst) {
    v4u o;
#pragma unroll
    for (int j = 0; j < 4; ++j) { const f32x4 v = *(const GAS f32x4*)(src + 16 * lane + 4 * j) * 64.f;
        int pk = __builtin_amdgcn_cvt_pk_fp8_f32(v.x, v.y, 0, false); pk = __builtin_amdgcn_cvt_pk_fp8_f32(v.z, v.w, pk, true); o[j] = (unsigned)pk; }
    *(GAS v4u*)(dst + 16 * lane) = o;
}
DI void rms_row_to_bf16_i8(int lane, const float* xrow, const float* g, bf16* orow, unsigned char* qrow, float* sx) {
    const GAS f32x4* xr = (const GAS f32x4*)xrow + lane; const GAS f32x4* gr = (const GAS f32x4*)g + lane;
    f32x4 v[4]; float s = 0.f;
#pragma unroll
    for (int j = 0; j < 4; ++j) { v[j] = xr[64 * j]; s += (v[j].x * v[j].x + v[j].y * v[j].y) + (v[j].z * v[j].z + v[j].w * v[j].w); }
    const float rs = 1.f / sqrtf(wave_sum(s) * (1.f / 1024.f) + EPS);
    GAS unsigned long long* o8 = (GAS unsigned long long*)orow + lane; float m = 0.f;
#pragma unroll
    for (int j = 0; j < 4; ++j) { const f32x4 gg = gr[64 * j]; v[j] = v[j] * rs * gg; o8[64 * j] = (unsigned long long)pk2(v[j].x, v[j].y) | ((unsigned long long)pk2(v[j].z, v[j].w) << 32);
        m = fmaxf(m, fmaxf(fmaxf(fabsf(v[j].x), fabsf(v[j].y)), fmaxf(fabsf(v[j].z), fabsf(v[j].w)))); }
    m = wave_max(m);
    const float sc = m > 0.f ? m * (1.f / 127.f) : 1.f, inv = 1.f / sc;
#pragma unroll
    for (int j = 0; j < 4; ++j) { const int a = (int)rintf(v[j].x * inv), b = (int)rintf(v[j].y * inv), c = (int)rintf(v[j].z * inv), d = (int)rintf(v[j].w * inv);
        *(GAS unsigned*)(qrow + 4 * lane + 256 * j) = (unsigned)(a & 255) | ((unsigned)(b & 255) << 8) | ((unsigned)(c & 255) << 16) | ((unsigned)(d & 255) << 24); }
    if (lane == 0) *sx = sc;
}
DI void p0_prologue(Frame& F, const Args& A) {
    LAS float* scr = (LAS float*)(F.lds + F.wave * 16384);
    const int gw = F.vcu * NWAVES + F.wave, NGW = F.G * NWAVES;
    constexpr int I_IN = 16 * 48, I_SQ = 16 * 32, I_W2 = 16 * 64;
    constexpr int NIT = 2 * I_IN + 3 * I_SQ + 2 * I_W2;
    for (int it = gw; it < NIT; it += NGW) {
        int r = it;
        if (r < I_IN) { p0_transpose_item(A.in[3], INCOLS, 0, F_W1T, 0, scr, r / 48, r % 48, F.lane); continue; } r -= I_IN;
        if (r < I_IN) { p0_transpose_item(A.in[3], INCOLS, 1552, F_W1T, 1536, scr, r / 48, r % 48, F.lane); continue; } r -= I_IN;
        if (r < I_SQ) { p0_transpose_item(A.in[9], 1024, 0, F_WOT, 0, scr, r / 32, r % 32, F.lane); continue; } r -= I_SQ;
        if (r < I_SQ) { p0_transpose_item(A.in[12], 1024, 0, F_WXQT, 0, scr, r / 32, r % 32, F.lane); continue; } r -= I_SQ;
        if (r < I_SQ) { p0_transpose_item(A.in[14], 1024, 0, F_WXOT, 0, scr, r / 32, r % 32, F.lane); continue; } r -= I_SQ;
        if (r < I_W2) { p0_transpose_item(A.in[13], 2048, 0, F_WXKVT, 0, scr, r / 64, r % 64, F.lane); continue; } r -= I_W2;
        p0_transpose_item(A.in[16], 2048, 0, F_WPQT, 0, scr, r / 64, r % 64, F.lane);
    }
    const int gt = gw * 64 + F.lane, NGT = NGW * 64;
    for (int i = gt; i < 256 * 128; i += NGT) {
        const int n = i >> 7, k0 = (i & 127) * 8;
        float gv[16];
#pragma unroll
        for (int r = 0; r < 16; ++r) gv[r] = A.in[5][r * 256 + n];
        float s[8];
#pragma unroll
        for (int j = 0; j < 8; ++j) { const float* wr_ = A.in[3] + (size_t)(k0 + j) * INCOLS + 1536; float a = 0.f;
#pragma unroll
            for (int r = 0; r < 16; ++r) a += wr_[r] * gv[r];
            s[j] = a; }
        v4u o; o.x = pk2(s[0], s[1]); o.y = pk2(s[2], s[3]); o.z = pk2(s[4], s[5]); o.w = pk2(s[6], s[7]);
        *(GAS v4u*)(F_W1T + (size_t)(3072 + n) * 1024 + k0) = o;
    }
    for (int m = gw; m < M; m += NGW) rms_row_to_bf16(F.lane, A.in[0] + (size_t)m * DM, A.in[2], F_BUFA + (size_t)m * DM);
    for (int m = gw; m < MM; m += NGW) rms_row_to_bf16(F.lane, A.in[1] + (size_t)m * DM, A.in[11], F_MN + (size_t)m * DM);
    for (int i = gt; i < 32768; i += NGT) {
        const f32x4 a = *(const GAS f32x4*)(A.in[17] + (size_t)i * 8), b = *(const GAS f32x4*)(A.in[17] + (size_t)i * 8 + 4);
        v4u o; o.x = pk2(a.x, a.y); o.y = pk2(a.z, a.w); o.z = pk2(b.x, b.y); o.w = pk2(b.z, b.w);
        *(GAS v4u*)(F_SUBK + (size_t)i * 8) = o;
    }
    for (int m = gw; m < PEER_N; m += NGW) {
        quant_row_i8(F.lane, A.in[18] + (size_t)m * DM, F.ws + WS_U8 + (size_t)m * 1024, (float*)(F.ws + WS_SU) + m);
        quant_row_fp8(F.lane, A.in[19] + (size_t)m * DM, F.ws + WS_V8 + (size_t)m * 1024);
    }
}

DI void gla_naive_item(Frame& F, const Args& A, float* OGLA, int b, int h, int eg) {
    const int lane = F.lane, e = eg * 8 + F.wave;
    const int cq = PQ + h * 64 + lane, ck = PK + h * 64 + lane, cv = PV + h * 128 + e, cg = PGATE + h * 64 + lane;
    float wq[4], wk[4], wv[4];
#pragma unroll
    for (int k = 0; k < 4; ++k) { wq[k] = A.in[4][k * 1024 + cq]; wk[k] = A.in[4][k * 1024 + ck]; wv[k] = A.in[4][k * 1024 + cv]; }
    const float bias = A.in[6][h * 64 + lane];
    float rq0 = 0.f, rq1 = 0.f, rq2 = 0.f, rk0 = 0.f, rk1 = 0.f, rk2 = 0.f, rv0 = 0.f, rv1 = 0.f, rv2 = 0.f, S = 0.f;
    for (int t0 = 0; t0 < SEQ; t0 += 8) {
        unsigned lq[8], lk[8], lv[8], lg[8];
#pragma unroll
        for (int j = 0; j < 8; ++j) { const bf16* base = F_PROJ + (size_t)(b * SEQ + t0 + j) * N1; lq[j] = base[cq]; lk[j] = base[ck]; lv[j] = base[cv]; lg[j] = base[cg]; }
#pragma unroll
        for (int j = 0; j < 8; ++j) {
            const float xq = bf2f(lq[j]), xk = bf2f(lk[j]), xv = bf2f(lv[j]);
            const float q = silu_f(wq[0] * rq0 + wq[1] * rq1 + wq[2] * rq2 + wq[3] * xq) * 0.125f; rq0 = rq1; rq1 = rq2; rq2 = xq;
            const float k = silu_f(wk[0] * rk0 + wk[1] * rk1 + wk[2] * rk2 + wk[3] * xk); rk0 = rk1; rk1 = rk2; rk2 = xk;
            const float v = silu_f(wv[0] * rv0 + wv[1] * rv1 + wv[2] * rv2 + wv[3] * xv); rv0 = rv1; rv1 = rv2; rv2 = xv;
            const float a = __expf(log_sigmoid_f(bf2f(lg[j]) + bias) * (1.f / 16.f));
            S = a * S + k * v;
            const float o = wave_sum(q * S);
            if (lane == 0) OGLA[(size_t)(b * SEQ + t0 + j) * 512 + h * 128 + e] = o;
        }
    }
}
DI void sb_naive_item(Frame& F, float* OSB, int b, int h, int qb) {
    LAS float* Ks = (LAS float*)F.lds; LAS float* Vs = Ks + 64 * 64;
    const int tid = F.tid, t = qb * 512 + tid; const size_t row = (size_t)b * SEQ + t;
    float q[64], acc[64];
    {
        const GAS v4u* qp = (const GAS v4u*)(F_PROJ + row * N1 + PSQ + h * 64);
#pragma unroll
        for (int c = 0; c < 8; ++c) { const v4u w = qp[c]; q[8 * c + 0] = bflo(w.x) * 0.125f; q[8 * c + 1] = bfhi(w.x) * 0.125f; q[8 * c + 2] = bflo(w.y) * 0.125f; q[8 * c + 3] = bfhi(w.y) * 0.125f;
            q[8 * c + 4] = bflo(w.z) * 0.125f; q[8 * c + 5] = bfhi(w.z) * 0.125f; q[8 * c + 6] = bflo(w.w) * 0.125f; q[8 * c + 7] = bfhi(w.w) * 0.125f; }
    }
#pragma unroll
    for (int d = 0; d < 64; ++d) acc[d] = 0.f;
    float carry = 0.f;
    for (int kt = qb * 8 + 7; kt >= 0; --kt) {
        __syncthreads();
        {
            const int key = tid >> 3, ch = tid & 7; const size_t krow = (size_t)b * SEQ + kt * 64 + key;
            const v4u kw = *(const GAS v4u*)(F_PROJ + krow * N1 + PSK + h * 64 + ch * 8), vw = *(const GAS v4u*)(F_PROJ + krow * N1 + PSV + h * 64 + ch * 8);
            LAS f32x4* kd = (LAS f32x4*)(Ks + key * 64 + ch * 8); LAS f32x4* vd = (LAS f32x4*)(Vs + key * 64 + ch * 8);
            kd[0] = (f32x4){bflo(kw.x), bfhi(kw.x), bflo(kw.y), bfhi(kw.y)}; kd[1] = (f32x4){bflo(kw.z), bfhi(kw.z), bflo(kw.w), bfhi(kw.w)};
            vd[0] = (f32x4){bflo(vw.x), bfhi(vw.x), bflo(vw.y), bfhi(vw.y)}; vd[1] = (f32x4){bflo(vw.z), bfhi(vw.z), bflo(vw.w), bfhi(vw.w)};
        }
        __syncthreads();
        for (int j = 63; j >= 0; --j) {
            const int s = kt * 64 + j;
            if (s < t) {
                const LAS f32x4* kr = (const LAS f32x4*)(Ks + j * 64); const LAS f32x4* vr = (const LAS f32x4*)(Vs + j * 64);
                float z0 = 0.f, z1 = 0.f, z2 = 0.f, z3 = 0.f;
#pragma unroll
                for (int c = 0; c < 16; ++c) { const f32x4 kk = kr[c]; z0 += q[4 * c] * kk.x; z1 += q[4 * c + 1] * kk.y; z2 += q[4 * c + 2] * kk.z; z3 += q[4 * c + 3] * kk.w; }
                const float z = (z0 + z1) + (z2 + z3);
                const float lb = log_sigmoid_f(z);
                const float w = __expf(lb + carry);
                carry += lb - z;
#pragma unroll
                for (int c = 0; c < 16; ++c) { const f32x4 vv = vr[c]; acc[4 * c] += w * vv.x; acc[4 * c + 1] += w * vv.y; acc[4 * c + 2] += w * vv.z; acc[4 * c + 3] += w * vv.w; }
            }
        }
    }
    GAS f32x4* op = (GAS f32x4*)(OSB + row * 512 + h * 64);
#pragma unroll
    for (int c = 0; c < 16; ++c) op[c] = (f32x4){acc[4 * c], acc[4 * c + 1], acc[4 * c + 2], acc[4 * c + 3]};
}
typedef float f32x16 __attribute__((ext_vector_type(16)));
typedef short s16x4 __attribute__((ext_vector_type(4)));
DI s16x4 lds_tr16(const LAS unsigned char* p) { return __builtin_bit_cast(s16x4, __builtin_amdgcn_ds_read_tr16_b64_v4i16((LAS s16x4*)p)); }
DI unsigned cvtpk_bf16(float lo, float hi) { typedef float f2 __attribute__((ext_vector_type(2))); f2 v = {lo, hi}; bf16x2_t b = __builtin_convertvector(v, bf16x2_t); return __builtin_bit_cast(unsigned, b); }
constexpr float SB_C2 = 0.125f * 1.4426950408889634f;
template <bool MASKED> DI void sb_weights(f32x16& P0, f32x16& P1, float& carry, int hi, int qrel2) {
    float T[8], cs[8];
#pragma unroll
    for (int pi = 0; pi < 2; ++pi) {
        f32x16& P = pi ? P1 : P0;
#pragma unroll
        for (int g = 0; g < 4; ++g) {
            float lbv[4], l1v[4];
#pragma unroll
            for (int i = 0; i < 4; ++i) {
                const float z2 = P[4 * g + i] * SB_C2;
                const float sp = __builtin_amdgcn_logf(1.f + __builtin_amdgcn_exp2f(-fabsf(z2)));
                float lb = fminf(z2, 0.f) - sp, l1 = lb - z2;
                if (MASKED) { const bool valid = (32 * pi + 8 * g + 4 * hi + i) < qrel2; lb = valid ? lb : -INFINITY; l1 = valid ? l1 : 0.f; }
                lbv[i] = lb; l1v[i] = l1;
            }
            const float a = l1v[3], b = a + l1v[2], c = b + l1v[1];
            cs[4 * pi + g] = c + l1v[0];
            P[4 * g + 3] = lbv[3]; P[4 * g + 2] = lbv[2] + a; P[4 * g + 1] = lbv[1] + b; P[4 * g + 0] = lbv[0] + c;
        }
    }
#pragma unroll
    for (int k = 0; k < 8; ++k) { auto rr = __builtin_amdgcn_permlane32_swap(__float_as_uint(cs[k]), __float_as_uint(cs[k]), false, false); T[k] = __uint_as_float(rr[0]) + __uint_as_float(rr[1]); }
    const float m0 = hi ? 0.f : 1.f;
    float run = carry;
#pragma unroll
    for (int k = 7; k >= 0; --k) {
        const float E = run + m0 * (T[k] - cs[k]);
        f32x16& P = (k >> 2) ? P1 : P0; const int g = k & 3;
#pragma unroll
        for (int i = 0; i < 4; ++i) P[4 * g + i] = __builtin_amdgcn_exp2f(P[4 * g + i] + E);
        run += T[k];
    }
    carry = run;
}
DI void sb_unit(Frame& F, float* OSB, int b, int h, int qb) {
    const int tid = F.tid, lane = F.lane, wid = F.wave, r32 = lane & 31, hi = lane >> 5;
    const int q0 = qb * 256; const size_t rowbase = (size_t)b * SEQ;
    const bf16* Kg = F_PROJ + rowbase * N1 + PSK + h * 64;
    const bf16* Vg = F_PROJ + rowbase * N1 + PSV + h * 64;
    bf16x8 qr[4];
    { const bf16* Qw = F_PROJ + (rowbase + q0 + wid * 32 + r32) * N1 + PSQ + h * 64;
#pragma unroll
      for (int ks = 0; ks < 4; ++ks) qr[ks] = *(const GAS bf16x8*)(Qw + ks * 16 + hi * 8); }
    const bf16* ksrc = Kg + (size_t)(tid >> 3) * N1 + (tid & 7) * 8;
    const bf16* vsrc = Vg + (size_t)(16 * (wid & 3) + (lane >> 2)) * N1 + (wid >> 2) * 32 + (lane & 3) * 8;
    const int kdst = (tid & 7) * 1024 + (tid >> 3) * 16, vdst = 8192 + wid * 1024 + lane * 16;
    const int kfr = hi * 1024 + r32 * 16;
    const int vfr = 8192 + ((lane >> 4) & 1) * 32 + (lane & 3) * 8 + (4 * hi + ((lane & 15) >> 2)) * 64;
    f32x16 o0 = {}, o1 = {};
    float carry = 0.f;
    const int ktmax = (q0 >> 6) + 3;
    v4u kreg = *(const GAS v4u*)(ksrc + (size_t)ktmax * 64 * N1), vreg = *(const GAS v4u*)(vsrc + (size_t)ktmax * 64 * N1);
    __syncthreads();
    *(LAS v4u*)(F.lds + kdst) = kreg; *(LAS v4u*)(F.lds + vdst) = vreg;
    __syncthreads();
    int cur = 0;
    const int wrow0 = q0 + wid * 32;
    bool wdone = false;
    LAS unsigned* flags = (LAS unsigned*)(F.lds + 32768);
    for (int kt = ktmax; kt >= 0; --kt) {
        if (kt > 0) { kreg = *(const GAS v4u*)(ksrc + (size_t)(kt - 1) * 64 * N1); vreg = *(const GAS v4u*)(vsrc + (size_t)(kt - 1) * 64 * N1); }
        const int k0 = kt * 64;
        if (!wdone && k0 <= wrow0 + 30) {
            const LAS unsigned char* Kb = F.lds + cur * 16384;
            f32x16 P0 = {}, P1 = {};
#pragma unroll
            for (int ks = 0; ks < 4; ++ks) {
                const bf16x8 a0 = *(const LAS bf16x8*)(Kb + kfr + ks * 2048), a1 = *(const LAS bf16x8*)(Kb + kfr + ks * 2048 + 512);
                P0 = __builtin_amdgcn_mfma_f32_32x32x16_bf16(a0, qr[ks], P0, 0, 0, 0);
                P1 = __builtin_amdgcn_mfma_f32_32x32x16_bf16(a1, qr[ks], P1, 0, 0, 0);
            }
            if (k0 + 63 >= wrow0) sb_weights<true>(P0, P1, carry, hi, wrow0 + r32 - k0);
            else sb_weights<false>(P0, P1, carry, hi, 0);
#pragma unroll
            for (int s = 0; s < 4; ++s) {
                const f32x16& P = (s >> 1) ? P1 : P0; const int rb = (s & 1) * 8;
                v4u pw; pw.x = cvtpk_bf16(P[rb + 0], P[rb + 1]); pw.y = cvtpk_bf16(P[rb + 2], P[rb + 3]); pw.z = cvtpk_bf16(P[rb + 4], P[rb + 5]); pw.w = cvtpk_bf16(P[rb + 6], P[rb + 7]);
                const bf16x8 pa = __builtin_bit_cast(bf16x8, pw);
                const LAS unsigned char* vp = Kb + vfr + s * 1024;
                const s16x4 l0 = lds_tr16(vp), h0 = lds_tr16(vp + 512), l1 = lds_tr16(vp + 4096), h1 = lds_tr16(vp + 4096 + 512);
                const bf16x8 v0 = {l0[0], l0[1], l0[2], l0[3], h0[0], h0[1], h0[2], h0[3]}, v1 = {l1[0], l1[1], l1[2], l1[3], h1[0], h1[1], h1[2], h1[3]};
                o0 = __builtin_amdgcn_mfma_f32_32x32x16_bf16(pa, v0, o0, 0, 0, 0);
                o1 = __builtin_amdgcn_mfma_f32_32x32x16_bf16(pa, v1, o1, 0, 0, 0);
            }
            wdone = __all(carry < -160.f);
        }
        if (lane == 0) flags[(kt & 1) * 8 + wid] = wdone ? 1u : 0u;
        if (kt > 0) { *(LAS v4u*)(F.lds + (cur ^ 1) * 16384 + kdst) = kreg; *(LAS v4u*)(F.lds + (cur ^ 1) * 16384 + vdst) = vreg; }
        __syncthreads();
        cur ^= 1;
        { const v4u f0 = *(const LAS v4u*)(flags + (kt & 1) * 8), f1 = *(const LAS v4u*)(flags + (kt & 1) * 8 + 4);
          if ((f0.x & f0.y & f0.z & f0.w & f1.x & f1.y & f1.z & f1.w) != 0u) break; }
    }
    float* op = OSB + (rowbase + wrow0) * 512 + h * 64 + r32;
#pragma unroll
    for (int r = 0; r < 16; ++r) { const int qrow = (r & 3) + 8 * (r >> 2) + 4 * hi; op[(size_t)qrow * 512] = o0[r]; op[(size_t)qrow * 512 + 32] = o1[r]; }
}
constexpr int GL_QT = 0, GL_KT = 8192, GL_KD = 16384, GL_V = 28672, GL_ST = 49152, GL_SEG = 69632, GL_RED = 71680, GL_KDP = 192, GL_VP = 320;
constexpr int CW_DECAY = 65536;
template <bool ACC> DI bf16x8 tr_frag(const LAS unsigned char* base, int PB, int x0, int k0, int lane) {
    const int hi = lane >> 5, rr = (lane & 15) >> 2, col = x0 + 16 * ((lane >> 4) & 1) + 4 * (lane & 3);
    const int r0 = ACC ? (k0 + 4 * hi + rr) : (k0 + 8 * hi + rr), r1 = ACC ? (r0 + 8) : (r0 + 4);
    const s16x4 a = lds_tr16(base + r0 * PB + col * 2), b = lds_tr16(base + r1 * PB + col * 2);
    return (bf16x8){a[0], a[1], a[2], a[3], b[0], b[1], b[2], b[3]};
}
template <int MODE> DI void gla_prep(Frame& F, const Args& A, int b, int h, int n) {
    const int tid = F.tid, d = tid & 63, seg = tid >> 6;
    const float* cw = A.in[4];
    const size_t row0 = (size_t)b * SEQ + 64 * n;
    {
        const int cq = PQ + h * 64 + d, ck = PK + h * 64 + d, cg = PGATE + h * 64 + d;
        float wq[4], wk[4];
#pragma unroll
        for (int k = 0; k < 4; ++k) { wq[k] = cw[k * 1024 + cq]; wk[k] = cw[k * 1024 + ck]; }
        const float bias = A.in[6][h * 64 + d];
        float rq[11], rk[11], gl[8];
#pragma unroll
        for (int i = 0; i < 11; ++i) { const int t = 64 * n + 8 * seg - 3 + i; const bool ok = t >= 0; const bf16* p = F_PROJ + (row0 + 8 * seg - 3 + i) * N1;
            rq[i] = ok ? bf2f(p[cq]) : 0.f; rk[i] = ok ? bf2f(p[ck]) : 0.f; if (i >= 3) gl[i - 3] = log_sigmoid_f(bf2f(p[cg]) + bias) * (1.f / 16.f); }
        float c = 0.f;
#pragma unroll
        for (int j = 0; j < 8; ++j) { c += gl[j]; gl[j] = c; }
        LAS float* SEG = (LAS float*)(F.lds + GL_SEG);
        SEG[seg * 64 + d] = c;
        __syncthreads();
        float pre = 0.f, tot = 0.f;
#pragma unroll
        for (int s = 0; s < 8; ++s) { const float v = SEG[s * 64 + d]; pre += (s < seg) ? v : 0.f; tot += v; }
#pragma unroll
        for (int j = 0; j < 8; ++j) {
            const int tok = 8 * seg + j; const float cum = pre + gl[j];
            const float qc = silu_f(wq[0] * rq[j] + wq[1] * rq[j + 1] + wq[2] * rq[j + 2] + wq[3] * rq[j + 3]);
            const float kc = silu_f(wk[0] * rk[j] + wk[1] * rk[j + 1] + wk[2] * rk[j + 2] + wk[3] * rk[j + 3]);
            if (MODE == 0) { *(LAS bf16*)(F.lds + GL_KD + tok * GL_KDP + d * 2) = (bf16)f2bf(kc * __expf(tot - cum)); }
            else { const int off = (d >> 3) * 1024 + tok * 16 + (d & 7) * 2;
                *(LAS bf16*)(F.lds + GL_QT + off) = (bf16)f2bf(qc * 0.125f * __expf(cum)); *(LAS bf16*)(F.lds + GL_KT + off) = (bf16)f2bf(kc * __expf(-cum)); }
        }
        if (MODE == 0 && seg == 0) ((float*)(F.ctl + CW_DECAY))[((size_t)(b * 4 + h) * 32 + n) * 64 + d] = __expf(tot);
    }
    {
        const int e = tid & 127, s4 = tid >> 7, cv = PV + h * 128 + e;
        float wv[4];
#pragma unroll
        for (int k = 0; k < 4; ++k) wv[k] = cw[k * 1024 + cv];
        float rv[19];
#pragma unroll
        for (int i = 0; i < 19; ++i) { const int t = 64 * n + 16 * s4 - 3 + i; rv[i] = t >= 0 ? bf2f(F_PROJ[(row0 + 16 * s4 - 3 + i) * N1 + cv]) : 0.f; }
#pragma unroll
        for (int j = 0; j < 16; ++j) *(LAS bf16*)(F.lds + GL_V + (16 * s4 + j) * GL_VP + e * 2) = (bf16)f2bf(silu_f(wv[0] * rv[j] + wv[1] * rv[j + 1] + wv[2] * rv[j + 2] + wv[3] * rv[j + 3]));
    }
}
DI void gla_local_unit(Frame& F, const Args& A, float* STW, int b, int h, int n) {
    __syncthreads();
    gla_prep<0>(F, A, b, h, n);
    __syncthreads();
    const int lane = F.lane, wid = F.wave, dt = wid & 1, et = wid >> 1, r32 = lane & 31, hi = lane >> 5;
    f32x16 acc = {};
#pragma unroll
    for (int ks = 0; ks < 4; ++ks) {
        const bf16x8 af = tr_frag<false>(F.lds + GL_KD, GL_KDP, 32 * dt, 16 * ks, lane), bfr = tr_frag<false>(F.lds + GL_V, GL_VP, 32 * et, 16 * ks, lane);
        acc = __builtin_amdgcn_mfma_f32_32x32x16_bf16(af, bfr, acc, 0, 0, 0);
    }
    float* o = STW + (((size_t)(b * 4 + h) * 32 + n) * 64 + 32 * dt) * 128 + 32 * et + r32;
#pragma unroll
    for (int r = 0; r < 16; ++r) o[(size_t)((r & 3) + 8 * (r >> 2) + 4 * hi) * 128] = acc[r];
}
DI void gla_out_unit(Frame& F, const Args& A, const float* STW, int b, int h, int n) {
    __syncthreads();
    gla_prep<1>(F, A, b, h, n);
    {
        const float* sp = STW + ((size_t)(b * 4 + h) * 32 + n) * 64 * 128;
#pragma unroll
        for (int i = 0; i < 4; ++i) { const int idx = (F.tid + i * 512) * 4, dd = idx >> 7, ee = idx & 127; const f32x4 v = *(const GAS f32x4*)(sp + idx);
            *(LAS unsigned long long*)(F.lds + GL_ST + dd * GL_VP + ee * 2) = (unsigned long long)pk2(v.x, v.y) | ((unsigned long long)pk2(v.z, v.w) << 32); }
    }
    __syncthreads();
    const int lane = F.lane, wid = F.wave, it = wid & 1, et = wid >> 1, r32 = lane & 31, hi = lane >> 5;
    f32x16 acc = {};
    bf16x8 qf[4];
#pragma unroll
    for (int ks = 0; ks < 4; ++ks) qf[ks] = *(const LAS bf16x8*)(F.lds + GL_QT + (2 * ks + hi) * 1024 + (32 * it + r32) * 16);
#pragma unroll
    for (int ks = 0; ks < 4; ++ks) acc = __builtin_amdgcn_mfma_f32_32x32x16_bf16(tr_frag<false>(F.lds + GL_ST, GL_VP, 32 * et, 16 * ks, lane), qf[ks], acc, 0, 0, 0);
    for (int jt = 0; jt <= it; ++jt) {
        f32x16 S = {};
#pragma unroll
        for (int ks = 0; ks < 4; ++ks) S = __builtin_amdgcn_mfma_f32_32x32x16_bf16(*(const LAS bf16x8*)(F.lds + GL_KT + (2 * ks + hi) * 1024 + (32 * jt + r32) * 16), qf[ks], S, 0, 0, 0);
        if (jt == it) {
#pragma unroll
            for (int r = 0; r < 16; ++r) S[r] = ((r & 3) + 8 * (r >> 2) + 4 * hi) <= r32 ? S[r] : 0.f;
        }
#pragma unroll
        for (int s = 0; s < 2; ++s) {
            v4u pw; pw.x = cvtpk_bf16(S[8 * s + 0], S[8 * s + 1]); pw.y = cvtpk_bf16(S[8 * s + 2], S[8 * s + 3]); pw.z = cvtpk_bf16(S[8 * s + 4], S[8 * s + 5]); pw.w = cvtpk_bf16(S[8 * s + 6], S[8 * s + 7]);
            acc = __builtin_amdgcn_mfma_f32_32x32x16_bf16(tr_frag<true>(F.lds + GL_V, GL_VP, 32 * et, 32 * jt + 16 * s, lane), __builtin_bit_cast(bf16x8, pw), acc, 0, 0, 0);
        }
    }
    float ss = 0.f;
#pragma unroll
    for (int r = 0; r < 16; ++r) ss += acc[r] * acc[r];
    { auto rr = __builtin_amdgcn_permlane32_swap(__float_as_uint(ss), __float_as_uint(ss), false, false); ss = __uint_as_float(rr[0]) + __uint_as_float(rr[1]); }
    LAS float* RED = (LAS float*)(F.lds + GL_RED);
    if (hi == 0) RED[wid * 32 + r32] = ss;
    __syncthreads();
    const float tot = RED[(it + 0) * 32 + r32] + RED[(it + 2) * 32 + r32] + RED[(it + 4) * 32 + r32] + RED[(it + 6) * 32 + r32];
    const float rs = 1.f / sqrtf(tot * (1.f / 128.f) + EPS);
    const size_t row = (size_t)b * SEQ + 64 * n + 32 * it + r32;
    const float* gg = A.in[7];
#pragma unroll
    for (int g = 0; g < 4; ++g) {
        const int e0 = 32 * et + 8 * g + 4 * hi;
        const unsigned long long ogw = *(const GAS unsigned long long*)(F_PROJ + row * N1 + POG + h * 128 + e0);
        const unsigned lo = (unsigned)ogw, hi2 = (unsigned)(ogw >> 32);
        const f32x4 gv = *(const GAS f32x4*)(gg + e0);
        const float y0 = acc[4 * g + 0] * rs * gv.x * silu_f(bflo(lo)), y1 = acc[4 * g + 1] * rs * gv.y * silu_f(bfhi(lo)), y2 = acc[4 * g + 2] * rs * gv.z * silu_f(bflo(hi2)), y3 = acc[4 * g + 3] * rs * gv.w * silu_f(bfhi(hi2));
        *(GAS unsigned long long*)(F_BUFA + row * 1024 + h * 128 + e0) = (unsigned long long)pk2(y0, y1) | ((unsigned long long)pk2(y2, y3) << 32);
    }
}
DI void mix_row(Frame& F, const Args& A, const float* OGLA, const float* OSB, size_t row) {
    const int lane = F.lane;
    const f32x4 a0 = *(const GAS f32x4*)(OGLA + row * 512 + 8 * lane), a1 = *(const GAS f32x4*)(OGLA + row * 512 + 8 * lane + 4);
    float s = (a0.x * a0.x + a0.y * a0.y) + (a0.z * a0.z + a0.w * a0.w) + (a1.x * a1.x + a1.y * a1.y) + (a1.z * a1.z + a1.w * a1.w);
    s += __shfl_xor(s, 1); s += __shfl_xor(s, 2); s += __shfl_xor(s, 4); s += __shfl_xor(s, 8);
    const float rs = 1.f / sqrtf(s * (1.f / 128.f) + EPS);
    const int e0 = (8 * lane) & 127;
    const f32x4 g0 = *(const GAS f32x4*)(A.in[7] + e0), g1 = *(const GAS f32x4*)(A.in[7] + e0 + 4);
    const v4u ogw = *(const GAS v4u*)(F_PROJ + row * N1 + POG + 8 * lane);
    v4u o;
    o.x = pk2(a0.x * rs * g0.x * silu_f(bflo(ogw.x)), a0.y * rs * g0.y * silu_f(bfhi(ogw.x)));
    o.y = pk2(a0.z * rs * g0.z * silu_f(bflo(ogw.y)), a0.w * rs * g0.w * silu_f(bfhi(ogw.y)));
    o.z = pk2(a1.x * rs * g1.x * silu_f(bflo(ogw.z)), a1.y * rs * g1.y * silu_f(bfhi(ogw.z)));
    o.w = pk2(a1.z * rs * g1.z * silu_f(bflo(ogw.w)), a1.w * rs * g1.w * silu_f(bfhi(ogw.w)));
    *(GAS v4u*)(F_BUFA + row * 1024 + 8 * lane) = o;
    const f32x4 b0 = *(const GAS f32x4*)(OSB + row * 512 + 8 * lane), b1 = *(const GAS f32x4*)(OSB + row * 512 + 8 * lane + 4);
    float s2 = (b0.x * b0.x + b0.y * b0.y) + (b0.z * b0.z + b0.w * b0.w) + (b1.x * b1.x + b1.y * b1.y) + (b1.z * b1.z + b1.w * b1.w);
    const float rs2 = 1.f / sqrtf(wave_sum(s2) * (1.f / 512.f) + EPS);
    const f32x4 h0 = *(const GAS f32x4*)(A.in[8] + 8 * lane), h1 = *(const GAS f32x4*)(A.in[8] + 8 * lane + 4);
    v4u p;
    p.x = pk2(b0.x * rs2 * h0.x, b0.y * rs2 * h0.y); p.y = pk2(b0.z * rs2 * h0.z, b0.w * rs2 * h0.w);
    p.z = pk2(b1.x * rs2 * h1.x, b1.y * rs2 * h1.y); p.w = pk2(b1.z * rs2 * h1.z, b1.w * rs2 * h1.w);
    *(GAS v4u*)(F_BUFA + row * 1024 + 512 + 8 * lane) = p;
}
DI void mix_row_sb(Frame& F, const Args& A, const float* OSB, size_t row) {
    const int lane = F.lane;
    const f32x4 b0 = *(const GAS f32x4*)(OSB + row * 512 + 8 * lane), b1 = *(const GAS f32x4*)(OSB + row * 512 + 8 * lane + 4);
    float s2 = (b0.x * b0.x + b0.y * b0.y) + (b0.z * b0.z + b0.w * b0.w) + (b1.x * b1.x + b1.y * b1.y) + (b1.z * b1.z + b1.w * b1.w);
    const float rs2 = 1.f / sqrtf(wave_sum(s2) * (1.f / 512.f) + EPS);
    const f32x4 h0 = *(const GAS f32x4*)(A.in[8] + 8 * lane), h1 = *(const GAS f32x4*)(A.in[8] + 8 * lane + 4);
    v4u p;
    p.x = pk2(b0.x * rs2 * h0.x, b0.y * rs2 * h0.y); p.y = pk2(b0.z * rs2 * h0.z, b0.w * rs2 * h0.w);
    p.z = pk2(b1.x * rs2 * h1.x, b1.y * rs2 * h1.y); p.w = pk2(b1.z * rs2 * h1.z, b1.w * rs2 * h1.w);
    *(GAS v4u*)(F_BUFA + row * 1024 + 512 + 8 * lane) = p;
}
DI void gla_scan(Frame& F, float* STW) {
    const int gt = (F.vcu * NWAVES + F.wave) * 64 + F.lane, NGT = F.G * NWAVES * 64;
    const float* dec = (const float*)(F.ctl + CW_DECAY);
    for (int idx = gt; idx < 32 * 8192; idx += NGT) {
        const int bh = idx >> 13, de = idx & 8191, d = de >> 7;
        float* p = STW + (size_t)bh * 32 * 8192 + de; const float* dp = dec + (size_t)bh * 32 * 64 + d;
        float tmp[32], dc[32];
#pragma unroll
        for (int n = 0; n < 32; ++n) { tmp[n] = p[(size_t)n * 8192]; dc[n] = dp[n * 64]; }
        float st = 0.f;
#pragma unroll
        for (int n = 0; n < 32; ++n) { p[(size_t)n * 8192] = st; st = dc[n] * st + tmp[n]; }
    }
}
DI void xsoftmax_row(Frame& F, bf16* S, size_t rh) {
    unsigned long long* p = (unsigned long long*)(S + rh * 256) + F.lane;
    const unsigned long long w = *p; const unsigned lo = (unsigned)w, hi = (unsigned)(w >> 32);
    const float sc = 0.0625f;
    float a = bflo(lo) * sc, b = bfhi(lo) * sc, c = bflo(hi) * sc, d = bfhi(hi) * sc;
    const float mx = wave_max(fmaxf(fmaxf(a, b), fmaxf(c, d)));
    a = __expf(a - mx); b = __expf(b - mx); c = __expf(c - mx); d = __expf(d - mx);
    const float inv = 1.f / wave_sum((a + b) + (c + d));
    *p = (unsigned long long)pk2(a * inv, b * inv) | ((unsigned long long)pk2(c * inv, d * inv) << 32);
}
DI float topk_round2(float& c0, float& c1) {
    const float w = wave_max(fmaxf(c0, c1));
    if (c0 == w) c0 = -INFINITY; if (c1 == w) c1 = -INFINITY;
    return w;
}
DI void peer_topk_item(Frame& F, const bf16* PQb, int* IDX, float* GATE, size_t row, int h) {
    const int lane = F.lane;
    float mylist[2];
#pragma unroll
    for (int p = 0; p < 2; ++p) {
        LAS unsigned* qs = (LAS unsigned*)(F.lds + F.wave * 1024);
        qs[lane] = *(const GAS unsigned*)(PQb + row * 2048 + (h * 2 + p) * 128 + 2 * lane);
        LDS_WAIT(); asm volatile("" ::: "memory");
        const bf16* kbase = F_SUBK + (size_t)((h * 2 + p) * 128) * 128;
        float s0 = 0.f, s1 = 0.f;
        const GAS v4u* k0p = (const GAS v4u*)(kbase + (size_t)lane * 128); const GAS v4u* k1p = (const GAS v4u*)(kbase + (size_t)(lane + 64) * 128);
#pragma unroll
        for (int c = 0; c < 16; ++c) {
            const v4u a = k0p[c], b = k1p[c];
            const v4u qq = *(const LAS v4u*)(qs + 4 * c); const unsigned q0 = qq.x, q1 = qq.y, q2 = qq.z, q3 = qq.w;
            s0 += bflo(a.x) * bflo(q0) + bfhi(a.x) * bfhi(q0) + bflo(a.y) * bflo(q1) + bfhi(a.y) * bfhi(q1) + bflo(a.z) * bflo(q2) + bfhi(a.z) * bfhi(q2) + bflo(a.w) * bflo(q3) + bfhi(a.w) * bfhi(q3);
            s1 += bflo(b.x) * bflo(q0) + bfhi(b.x) * bfhi(q0) + bflo(b.y) * bflo(q1) + bfhi(b.y) * bfhi(q1) + bflo(b.z) * bflo(q2) + bfhi(b.z) * bfhi(q2) + bflo(b.w) * bflo(q3) + bfhi(b.w) * bfhi(q3);
        }
        float c0 = __uint_as_float((__float_as_uint(s0) & ~0x7fu) | (unsigned)lane), c1 = __uint_as_float((__float_as_uint(s1) & ~0x7fu) | (unsigned)(lane + 64));
        float mine = 0.f;
#pragma unroll
        for (int r = 0; r < 16; ++r) { const float w = topk_round2(c0, c1); if (lane == r) mine = w; }
        mylist[p] = mine;
        LDS_WAIT(); asm volatile("" ::: "memory");
    }
    const float va = __uint_as_float(__float_as_uint(__shfl(mylist[0], lane >> 2)) & ~0x7fu);
    float cand[4];
#pragma unroll
    for (int j = 0; j < 4; ++j) { const int bb = 4 * (lane & 3) + j; const float vb = __uint_as_float(__float_as_uint(__shfl(mylist[1], bb)) & ~0x7fu);
        cand[j] = __uint_as_float((__float_as_uint(va + vb) & ~0xffu) | (unsigned)((lane >> 2) * 16 + bb)); }
    float best = 0.f, top = 0.f;
#pragma unroll
    for (int r = 0; r < 16; ++r) {
        const float w = wave_max(fmaxf(fmaxf(cand[0], cand[1]), fmaxf(cand[2], cand[3])));
#pragma unroll
        for (int j = 0; j < 4; ++j) if (cand[j] == w) cand[j] = -INFINITY;
        if (lane == r) best = w; if (r == 0) top = w;
    }
    const unsigned bu = __float_as_uint(best); const int ca = (bu >> 4) & 15, cb = bu & 15;
    const int i1 = (int)(__float_as_uint(__shfl(mylist[0], ca)) & 0x7fu), i2 = (int)(__float_as_uint(__shfl(mylist[1], cb)) & 0x7fu);
    const float sc = __uint_as_float(bu & ~0xffu), tp = __uint_as_float(__float_as_uint(top) & ~0xffu);
    const float ex = lane < 16 ? __expf(sc - tp) : 0.f;
    const float inv = 1.f / wave_sum(ex);
    if (lane < 16) { IDX[row * 128 + h * 16 + lane] = i1 * 128 + i2; GATE[row * 128 + h * 16 + lane] = ex * inv; }
}
DI float vmaxf(float a, float b) { float r; asm("v_max_f32_e32 %0, %1, %2" : "=v"(r) : "v"(a), "v"(b)); return r; }
DI float vminf(float a, float b) { float r; asm("v_min_f32_e32 %0, %1, %2" : "=v"(r) : "v"(a), "v"(b)); return r; }
DI void ins16(float (&L)[16], float x) {
#pragma unroll
    for (int i = 0; i < 16; ++i) { const float h = vmaxf(L[i], x); x = vminf(L[i], x); L[i] = h; }
}
DI void peer_topk_mfma(Frame& F, const bf16* PQb, int* IDX, float* GATE) {
    const int tid = F.tid, lane = F.lane, wid = F.wave, r32 = lane & 31, hi = lane >> 5, h = F.vcu & 7;
    __syncthreads();
    for (int i = tid; i < 2 * 128 * 16; i += 512) { const int p = i >> 11, key = (i >> 4) & 127, c = i & 15;
        *(LAS v4u*)(F.lds + p * 32768 + c * 2048 + key * 16) = *(const GAS v4u*)(F_SUBK + (size_t)((h * 2 + p) * 128 + key) * 128 + c * 8); }
    __syncthreads();
    LAS unsigned* scr = (LAS unsigned*)(F.lds + 65536 + wid * 8192) + lane;
    for (int g = (F.vcu >> 3) * 8 + wid; g < 512; g += (F.G >> 3) * 8) {
        const size_t token = (size_t)32 * g + r32;
        float LA[16], LB[16];
#pragma unroll
        for (int p = 0; p < 2; ++p) {
            float (&L)[16] = p ? LB : LA;
#pragma unroll
            for (int i = 0; i < 16; ++i) L[i] = -INFINITY;
            bf16x8 qf[8];
#pragma unroll
            for (int ks = 0; ks < 8; ++ks) qf[ks] = *(const GAS bf16x8*)(PQb + token * 2048 + (h * 2 + p) * 128 + 16 * ks + 8 * hi);
#pragma unroll
            for (int rt = 0; rt < 4; ++rt) {
                f32x16 S = {};
#pragma unroll
                for (int ks = 0; ks < 8; ++ks) S = __builtin_amdgcn_mfma_f32_32x32x16_bf16(*(const LAS bf16x8*)(F.lds + p * 32768 + (2 * ks + hi) * 2048 + (32 * rt + r32) * 16), qf[ks], S, 0, 0, 0);
#pragma unroll
                for (int r = 0; r < 16; ++r) { const unsigned key = (unsigned)(32 * rt + (r & 3) + 8 * (r >> 2)) + 4u * (unsigned)hi;
                    ins16(L, __uint_as_float((__float_as_uint(S[r]) & ~0x7fu) | key)); }
            }
            float PL[16];
#pragma unroll
            for (int i = 0; i < 16; ++i) { auto rr = __builtin_amdgcn_permlane32_swap(__float_as_uint(L[i]), __float_as_uint(L[i]), false, false); PL[i] = __uint_as_float(hi ? rr[0] : rr[1]); }
#pragma unroll
            for (int i = 0; i < 16; ++i) ins16(L, PL[i]);
        }
        float C[16];
#pragma unroll
        for (int i = 0; i < 16; ++i) C[i] = -INFINITY;
#pragma unroll
        for (int a = 0; a < 16; ++a) {
            const float va = __uint_as_float(__float_as_uint(LA[a]) & ~0x7fu);
#pragma unroll
            for (int b = 0; b < 16; ++b) if ((a + 1) * (b + 1) <= 16) {
                const float vb = __uint_as_float(__float_as_uint(LB[b]) & ~0x7fu);
                ins16(C, __uint_as_float((__float_as_uint(va + vb) & ~0xffu) | (unsigned)(a * 16 + b)));
            }
        }
#pragma unroll
        for (int i = 0; i < 16; ++i) { scr[i * 64] = __float_as_uint(LA[i]) & 0x7fu; scr[(16 + i) * 64] = __float_as_uint(LB[i]) & 0x7fu; }
        LDS_WAIT(); asm volatile("" ::: "memory");
        const float top = __uint_as_float(__float_as_uint(C[0]) & ~0xffu);
        float ex[16]; int ei[16]; float sum = 0.f;
#pragma unroll
        for (int r = 0; r < 16; ++r) { const unsigned cu = __float_as_uint(C[r]); ex[r] = __expf(__uint_as_float(cu & ~0xffu) - top); sum += ex[r];
            ei[r] = (int)(scr[((cu >> 4) & 15) * 64] * 128u + scr[(16 + (cu & 15)) * 64]); }
        const float inv = 1.f / sum;
        v4u io0, io1; f32x4 go0, go1;
        io0.x = hi ? ei[8] : ei[0]; io0.y = hi ? ei[9] : ei[1]; io0.z = hi ? ei[10] : ei[2]; io0.w = hi ? ei[11] : ei[3];
        io1.x = hi ? ei[12] : ei[4]; io1.y = hi ? ei[13] : ei[5]; io1.z = hi ? ei[14] : ei[6]; io1.w = hi ? ei[15] : ei[7];
        go0.x = (hi ? ex[8] : ex[0]) * inv; go0.y = (hi ? ex[9] : ex[1]) * inv; go0.z = (hi ? ex[10] : ex[2]) * inv; go0.w = (hi ? ex[11] : ex[3]) * inv;
        go1.x = (hi ? ex[12] : ex[4]) * inv; go1.y = (hi ? ex[13] : ex[5]) * inv; go1.z = (hi ? ex[14] : ex[6]) * inv; go1.w = (hi ? ex[15] : ex[7]) * inv;
        int* ip = IDX + token * 128 + h * 16 + 8 * hi; float* gp = GATE + token * 128 + h * 16 + 8 * hi;
        *(GAS v4u*)ip = io0; *(GAS v4u*)(ip + 4) = io1; *(GAS f32x4*)gp = go0; *(GAS f32x4*)(gp + 4) = go1;
        LDS_WAIT(); asm volatile("" ::: "memory");
    }
}
DI void peer_gather_row(Frame& F, const Args& A, const bf16* XN2, const int* IDX, const float* GATE, size_t row) {
    const int lane = F.lane;
    const v4u xa = *(const GAS v4u*)(XN2 + row * 1024 + 8 * lane), xb = *(const GAS v4u*)(XN2 + row * 1024 + 512 + 8 * lane);
    const int id0 = IDX[row * 128 + lane], id1 = IDX[row * 128 + 64 + lane];
    const float g0 = GATE[row * 128 + lane], g1 = GATE[row * 128 + 64 + lane];
    float acc[16];
#pragma unroll
    for (int i = 0; i < 16; ++i) acc[i] = 0.f;
#define PEER_DOT2(w, x, a) dot2_bf16((w), (x), (a))
    for (int half = 0; half < 2; ++half) {
        const int idv = half ? id1 : id0; const float gv = half ? g1 : g0;
        for (int e0 = 0; e0 < 64; e0 += 4) {
            v4u ua[4], ub[4], va[4], vb[4]; float gt[4];
#pragma unroll
            for (int j = 0; j < 4; ++j) {
                const int id = __builtin_amdgcn_readlane(idv, e0 + j); gt[j] = __uint_as_float(__builtin_amdgcn_readlane(__float_as_uint(gv), e0 + j));
                const bf16* up = F_UB + (size_t)id * 1024; const bf16* vp = F_VB + (size_t)id * 1024;
                ua[j] = *(const GAS v4u*)(up + 8 * lane); ub[j] = *(const GAS v4u*)(up + 512 + 8 * lane);
                va[j] = *(const GAS v4u*)(vp + 8 * lane); vb[j] = *(const GAS v4u*)(vp + 512 + 8 * lane);
            }
#pragma unroll
            for (int j = 0; j < 4; ++j) {
                float d0 = 0.f, d1 = 0.f;
                d0 = PEER_DOT2(ua[j].x, xa.x, d0); d1 = PEER_DOT2(ua[j].y, xa.y, d1); d0 = PEER_DOT2(ua[j].z, xa.z, d0); d1 = PEER_DOT2(ua[j].w, xa.w, d1);
                d0 = PEER_DOT2(ub[j].x, xb.x, d0); d1 = PEER_DOT2(ub[j].y, xb.y, d1); d0 = PEER_DOT2(ub[j].z, xb.z, d0); d1 = PEER_DOT2(ub[j].w, xb.w, d1);
                const float a = wave_sum(d0 + d1);
                const float cf = gt[j] * gelu_tanh_f(a);
                acc[0] += cf * bflo(va[j].x); acc[1] += cf * bfhi(va[j].x); acc[2] += cf * bflo(va[j].y); acc[3] += cf * bfhi(va[j].y);
                acc[4] += cf * bflo(va[j].z); acc[5] += cf * bfhi(va[j].z); acc[6] += cf * bflo(va[j].w); acc[7] += cf * bfhi(va[j].w);
                acc[8] += cf * bflo(vb[j].x); acc[9] += cf * bfhi(vb[j].x); acc[10] += cf * bflo(vb[j].y); acc[11] += cf * bfhi(vb[j].y);
                acc[12] += cf * bflo(vb[j].z); acc[13] += cf * bfhi(vb[j].z); acc[14] += cf * bflo(vb[j].w); acc[15] += cf * bfhi(vb[j].w);
            }
        }
    }
#undef PEER_DOT2
    float* hp = F.out + row * 1024;
    f32x4 y[4]; const int c0 = 8 * lane, c1 = 512 + 8 * lane;
    y[0] = *(const GAS f32x4*)(hp + c0); y[1] = *(const GAS f32x4*)(hp + c0 + 4); y[2] = *(const GAS f32x4*)(hp + c1); y[3] = *(const GAS f32x4*)(hp + c1 + 4);
    float ss = 0.f;
#pragma unroll
    for (int i = 0; i < 4; ++i) { y[i].x += acc[4 * i]; y[i].y += acc[4 * i + 1]; y[i].z += acc[4 * i + 2]; y[i].w += acc[4 * i + 3]; ss += (y[i].x * y[i].x + y[i].y * y[i].y) + (y[i].z * y[i].z + y[i].w * y[i].w); }
    const float rs = 1.f / sqrtf(wave_sum(ss) * (1.f / 1024.f) + EPS);
    const f32x4 g0v = *(const GAS f32x4*)(A.in[20] + c0), g1v = *(const GAS f32x4*)(A.in[20] + c0 + 4), g2v = *(const GAS f32x4*)(A.in[20] + c1), g3v = *(const GAS f32x4*)(A.in[20] + c1 + 4);
    *(GAS f32x4*)(hp + c0) = y[0] * rs * g0v; *(GAS f32x4*)(hp + c0 + 4) = y[1] * rs * g1v; *(GAS f32x4*)(hp + c1) = y[2] * rs * g2v; *(GAS f32x4*)(hp + c1 + 4) = y[3] * rs * g3v;
}
template <int TPW> DI void peer_gather_sweep(Frame& F, const Args& A, const int* IDX, const float* GATE, size_t tok0) {
    const int lane = F.lane;
    const unsigned char* U8 = F.ws + WS_U8; const unsigned char* V8 = F.ws + WS_V8; const unsigned char* X8 = F.ws + WS_X8;
    const float* SU = (const float*)(F.ws + WS_SU); const float* SX = (const float*)(F.ws + WS_SX);
    f32x2 acc[TPW][8]; v4u xq[TPW]; int idlo[TPW], idhi[TPW]; float glo[TPW], ghi[TPW], sxv[TPW];
#pragma unroll
    for (int tl = 0; tl < TPW; ++tl) {
        const size_t t = tok0 + tl;
#pragma unroll
        for (int i = 0; i < 8; ++i) acc[tl][i] = (f32x2){0.f, 0.f};
        xq[tl] = *(const GAS v4u*)(X8 + t * 1024 + 16 * lane);
        idlo[tl] = IDX[t * 128 + lane]; idhi[tl] = IDX[t * 128 + 64 + lane]; glo[tl] = GATE[t * 128 + lane]; ghi[tl] = GATE[t * 128 + 64 + lane];
        sxv[tl] = SX[t] * (1.f / 64.f);
    }
    const int l3 = lane & 3; const bool b0 = lane & 1, b1 = lane & 2;
    for (int s = 0; s < 32; ++s) {
#pragma unroll
        for (int tl = 0; tl < TPW; ++tl) {
            unsigned long long mlo = __ballot((idlo[tl] >> 9) == s), mhi = __ballot((idhi[tl] >> 9) == s);
            while (mlo | mhi) {
                int id[4]; float g[4];
#pragma unroll
                for (int j = 0; j < 4; ++j) {
                    if (mlo) { const int e = __builtin_ctzll(mlo); mlo &= mlo - 1; id[j] = __builtin_amdgcn_readlane(idlo[tl], e); g[j] = __uint_as_float(__builtin_amdgcn_readlane(__float_as_uint(glo[tl]), e)); }
                    else if (mhi) { const int e = __builtin_ctzll(mhi); mhi &= mhi - 1; id[j] = __builtin_amdgcn_readlane(idhi[tl], e); g[j] = __uint_as_float(__builtin_amdgcn_readlane(__float_as_uint(ghi[tl]), e)); }
                    else { id[j] = id[0]; g[j] = 0.f; }
                }
                v4u uu[4], vv[4]; float su[4]; int p[4];
#pragma unroll
                for (int j = 0; j < 4; ++j) { uu[j] = *(const GAS v4u*)(U8 + (size_t)id[j] * 1024 + 16 * lane); vv[j] = *(const GAS v4u*)(V8 + (size_t)id[j] * 1024 + 16 * lane); su[j] = SU[id[j]]; }
#pragma unroll
                for (int j = 0; j < 4; ++j) { int d = __builtin_amdgcn_sdot4((int)uu[j].x, (int)xq[tl].x, 0, false); d = __builtin_amdgcn_sdot4((int)uu[j].y, (int)xq[tl].y, d, false);
                    d = __builtin_amdgcn_sdot4((int)uu[j].z, (int)xq[tl].z, d, false); p[j] = __builtin_amdgcn_sdot4((int)uu[j].w, (int)xq[tl].w, d, false); }
                const int kA = b0 ? p[1] : p[0], sA = b0 ? p[0] : p[1], kB = b0 ? p[3] : p[2], sB = b0 ? p[2] : p[3];
                const int qA = kA + dpp_i<0xB1>(sA), qB = kB + dpp_i<0xB1>(sB);
                const int kk = b1 ? qB : qA, ss = b1 ? qA : qB;
                int r = kk + dpp_i<0x4E>(ss);
                r += dpp_i<0x124>(r); r += dpp_i<0x128>(r);
                r += __shfl_xor(r, 16); r += __shfl_xor(r, 32);
                const float sus = l3 == 0 ? su[0] : l3 == 1 ? su[1] : l3 == 2 ? su[2] : su[3];
                const float gs = l3 == 0 ? g[0] : l3 == 1 ? g[1] : l3 == 2 ? g[2] : g[3];
                const float a = (float)r * sus * (sxv[tl] * 64.f);
                const float cfl = gs * gelu_tanh_f(a) * (1.f / 64.f);
#pragma unroll
                for (int j = 0; j < 4; ++j) {
                    const float cf = __uint_as_float(__builtin_amdgcn_readlane(__float_as_uint(cfl), j)); const f32x2 c2 = {cf, cf};
#pragma unroll
                    for (int w = 0; w < 4; ++w) { acc[tl][2 * w] = __builtin_amdgcn_cvt_pk_f32_fp8((int)vv[j][w], false) * c2 + acc[tl][2 * w]; acc[tl][2 * w + 1] = __builtin_amdgcn_cvt_pk_f32_fp8((int)vv[j][w], true) * c2 + acc[tl][2 * w + 1]; }
                }
            }
        }
    }
#pragma unroll
    for (int tl = 0; tl < TPW; ++tl) {
        float* hp = F.out + (tok0 + tl) * 1024 + 16 * lane;
        f32x4 y[4]; float ssq = 0.f;
#pragma unroll
        for (int i = 0; i < 4; ++i) { y[i] = *(const GAS f32x4*)(hp + 4 * i); y[i].x += acc[tl][2 * i].x; y[i].y += acc[tl][2 * i].y; y[i].z += acc[tl][2 * i + 1].x; y[i].w += acc[tl][2 * i + 1].y;
            ssq += (y[i].x * y[i].x + y[i].y * y[i].y) + (y[i].z * y[i].z + y[i].w * y[i].w); }
        const float rs = 1.f / sqrtf(wave_sum(ssq) * (1.f / 1024.f) + EPS);
#pragma unroll
        for (int i = 0; i < 4; ++i) { const f32x4 gv = *(const GAS f32x4*)(A.in[20] + 16 * lane + 4 * i); *(GAS f32x4*)(hp + 4 * i) = y[i] * rs * gv; }
    }
}
constexpr int GL3_LIST = 0, GL3_X = 65536;
struct G3Buf { v4u uu[4], vv[4], xx[4]; };
template <int TPW> DI void g3_issue(G3Buf& B, v4u& E, const LAS unsigned char* list, const LAS unsigned char* xl, const unsigned char* U8, const unsigned char* V8, int b, int lane) {
    E = *(const LAS v4u*)(list + (4 * b + (lane & 3)) * 16);
#pragma unroll
    for (int j = 0; j < 4; ++j) {
        const unsigned w = (unsigned)__builtin_amdgcn_readlane((int)E.x, j); const unsigned id = w & 0xffffu, tl = w >> 16;
        B.uu[j] = *(const GAS v4u*)(U8 + (size_t)id * 1024 + 16 * lane); B.vv[j] = *(const GAS v4u*)(V8 + (size_t)id * 1024 + 16 * lane);
        B.xx[j] = *(const LAS v4u*)(xl + tl * 1024 + 16 * lane);
    }
}
template <int TPW> DI void g3_compute(f32x2 (&acc)[TPW][8], const G3Buf& B, const v4u& E, int lane) {
    int p[4];
#pragma unroll
    for (int j = 0; j < 4; ++j) { int d = __builtin_amdgcn_sdot4((int)B.uu[j].x, (int)B.xx[j].x, 0, false); d = __builtin_amdgcn_sdot4((int)B.uu[j].y, (int)B.xx[j].y, d, false);
        d = __builtin_amdgcn_sdot4((int)B.uu[j].z, (int)B.xx[j].z, d, false); p[j] = __builtin_amdgcn_sdot4((int)B.uu[j].w, (int)B.xx[j].w, d, false); }
    const bool b0 = lane & 1, b1 = lane & 2;
    const int kA = b0 ? p[1] : p[0], sA = b0 ? p[0] : p[1], kB = b0 ? p[3] : p[2], sB = b0 ? p[2] : p[3];
    const int qA = kA + dpp_i<0xB1>(sA), qB = kB + dpp_i<0xB1>(sB);
    const int kk = b1 ? qB : qA, ss = b1 ? qA : qB;
    int r = kk + dpp_i<0x4E>(ss);
    r += dpp_i<0x124>(r); r += dpp_i<0x128>(r);
    r += __shfl_xor(r, 16); r += __shfl_xor(r, 32);
    const float a = (float)r * __uint_as_float(E.z);
    const float cfl = __uint_as_float(E.y) * gelu_tanh_f(a);
#pragma unroll
    for (int j = 0; j < 4; ++j) {
        const float cf = __uint_as_float(__builtin_amdgcn_readlane(__float_as_uint(cfl), j)); const f32x2 c2 = {cf, cf};
        const unsigned tl = (unsigned)__builtin_amdgcn_readlane((int)E.x, j) >> 16;
#pragma unroll
        for (int t = 0; t < TPW; ++t) if (tl == (unsigned)t) { asm volatile("; acc case %0" :: "n"(t));
#pragma unroll
            for (int w = 0; w < 4; ++w) { acc[t][2 * w] = __builtin_amdgcn_cvt_pk_f32_fp8((int)B.vv[j][w], false) * c2 + acc[t][2 * w]; acc[t][2 * w + 1] = __builtin_amdgcn_cvt_pk_f32_fp8((int)B.vv[j][w], true) * c2 + acc[t][2 * w + 1]; }
            asm volatile("; acc case %0 end" :: "n"(t));
        }
    }
}
template <int TPW> DI void peer_gather_sweep3(Frame& F, const Args& A, const int* IDX, const float* GATE, size_t tok0) {
    const int lane = F.lane, wid = F.wave;
    const unsigned char* U8 = F.ws + WS_U8; const unsigned char* V8 = F.ws + WS_V8; const unsigned char* X8 = F.ws + WS_X8;
    const float* SU = (const float*)(F.ws + WS_SU); const float* SX = (const float*)(F.ws + WS_SX);
    LAS unsigned char* list = F.lds + GL3_LIST + wid * (TPW * 2048); LAS unsigned char* xl = F.lds + GL3_X + wid * (TPW * 1024);
    {
        int idlo[TPW], idhi[TPW]; float glo[TPW], ghi[TPW], slo[TPW], shi[TPW];
#pragma unroll
        for (int tl = 0; tl < TPW; ++tl) { const size_t t = tok0 + tl;
            *(LAS v4u*)(xl + tl * 1024 + 16 * lane) = *(const GAS v4u*)(X8 + t * 1024 + 16 * lane);
            idlo[tl] = IDX[t * 128 + lane]; idhi[tl] = IDX[t * 128 + 64 + lane]; const float sx = SX[t];
            glo[tl] = GATE[t * 128 + lane] * (1.f / 64.f); ghi[tl] = GATE[t * 128 + 64 + lane] * (1.f / 64.f);
            slo[tl] = SU[idlo[tl]] * sx; shi[tl] = SU[idhi[tl]] * sx; }
        int base = 0;
        for (int s = 0; s < 32; ++s) {
#pragma unroll
            for (int tl = 0; tl < TPW; ++tl) {
                { const bool m = (idlo[tl] >> 9) == s; const unsigned long long mk = __ballot(m); const int pos = base + (int)__builtin_amdgcn_mbcnt_hi((unsigned)(mk >> 32), __builtin_amdgcn_mbcnt_lo((unsigned)mk, 0u));
                  if (m) *(LAS v4u*)(list + pos * 16) = (v4u){(unsigned)idlo[tl] | ((unsigned)tl << 16), __float_as_uint(glo[tl]), __float_as_uint(slo[tl]), 0u};
                  base += __builtin_popcountll(mk); }
                { const bool m = (idhi[tl] >> 9) == s; const unsigned long long mk = __ballot(m); const int pos = base + (int)__builtin_amdgcn_mbcnt_hi((unsigned)(mk >> 32), __builtin_amdgcn_mbcnt_lo((unsigned)mk, 0u));
                  if (m) *(LAS v4u*)(list + pos * 16) = (v4u){(unsigned)idhi[tl] | ((unsigned)tl << 16), __float_as_uint(ghi[tl]), __float_as_uint(shi[tl]), 0u};
                  base += __builtin_popcountll(mk); }
            }
        }
    }
    LDS_WAIT(); asm volatile("" ::: "memory");
    f32x2 acc[TPW][8];
#pragma unroll
    for (int tl = 0; tl < TPW; ++tl)
#pragma unroll
        for (int i = 0; i < 8; ++i) acc[tl][i] = (f32x2){0.f, 0.f};
    constexpr int NB = TPW * 32;
    G3Buf BA, BB; v4u EA, EB;
    g3_issue<TPW>(BA, EA, list, xl, U8, V8, 0, lane);
    for (int b = 0; b < NB; b += 2) {
        g3_issue<TPW>(BB, EB, list, xl, U8, V8, b + 1, lane);
        g3_compute<TPW>(acc, BA, EA, lane);
        g3_issue<TPW>(BA, EA, list, xl, U8, V8, (b + 2 < NB) ? b + 2 : NB - 1, lane);
        g3_compute<TPW>(acc, BB, EB, lane);
    }
#pragma unroll
    for (int tl = 0; tl < TPW; ++tl) {
        float* hp = F.out + (tok0 + tl) * 1024 + 16 * lane;
        f32x4 y[4]; float ssq = 0.f;
#pragma unroll
        for (int i = 0; i < 4; ++i) { y[i] = *(const GAS f32x4*)(hp + 4 * i); y[i].x += acc[tl][2 * i].x; y[i].y += acc[tl][2 * i].y; y[i].z += acc[tl][2 * i + 1].x; y[i].w += acc[tl][2 * i + 1].y;
            ssq += (y[i].x * y[i].x + y[i].y * y[i].y) + (y[i].z * y[i].z + y[i].w * y[i].w); }
        const float rs = 1.f / sqrtf(wave_sum(ssq) * (1.f / 1024.f) + EPS);
#pragma unroll
        for (int i = 0; i < 4; ++i) { const f32x4 gv = *(const GAS f32x4*)(A.in[20] + 16 * lane + 4 * i); *(GAS f32x4*)(hp + 4 * i) = y[i] * rs * gv; }
    }
    LDS_WAIT(); asm volatile("" ::: "memory");
}
constexpr int G5_NSH = 16, G5_SHIFT = 10;
struct G5Buf { v4u uu[4], vv[4]; };
DI void g5_issue(G5Buf& B, v4u& E, const LAS unsigned char* tlist, const unsigned char* U8, const unsigned char* V8, int k, int lane) {
    E = *(const LAS v4u*)(tlist + (4 * k + (lane & 3)) * 16);
#pragma unroll
    for (int j = 0; j < 4; ++j) {
        const unsigned id = (unsigned)__builtin_amdgcn_readlane((int)E.x, j);
        B.uu[j] = *(const GAS v4u*)(U8 + (size_t)id * 1024 + 16 * lane); B.vv[j] = *(const GAS v4u*)(V8 + (size_t)id * 1024 + 16 * lane);
    }
}
DI void g5_compute(f32x2 (&acc)[8], const v4u& xx, const G5Buf& B, const v4u& E, int lane) {
    int p[4];
#pragma unroll
    for (int j = 0; j < 4; ++j) { int d = __builtin_amdgcn_sdot4((int)B.uu[j].x, (int)xx.x, 0, false); d = __builtin_amdgcn_sdot4((int)B.uu[j].y, (int)xx.y, d, false);
        d = __builtin_amdgcn_sdot4((int)B.uu[j].z, (int)xx.z, d, false); p[j] = __builtin_amdgcn_sdot4((int)B.uu[j].w, (int)xx.w, d, false); }
    const bool b0 = lane & 1, b1 = lane & 2;
    const int kA = b0 ? p[1] : p[0], sA = b0 ? p[0] : p[1], kB = b0 ? p[3] : p[2], sB = b0 ? p[2] : p[3];
    const int qA = kA + dpp_i<0xB1>(sA), qB = kB + dpp_i<0xB1>(sB);
    const int kk = b1 ? qB : qA, ss = b1 ? qA : qB;
    int r = kk + dpp_i<0x4E>(ss);
    r += dpp_i<0x124>(r); r += dpp_i<0x128>(r);
    r += __shfl_xor(r, 16); r += __shfl_xor(r, 32);
    const float a = (float)r * __uint_as_float(E.z);
    const float y = 0.7978845608028654f * (a + 0.044715f * a * a * a);
    const float th = 1.f - 2.f * __builtin_amdgcn_rcpf(1.f + __expf(2.f * y));
    const float cfl = __uint_as_float(E.y) * 0.5f * a * (1.f + th);
#pragma unroll
    for (int j = 0; j < 4; ++j) { const float cf = __uint_as_float(__builtin_amdgcn_readlane(__float_as_uint(cfl), j)); const f32x2 c2 = {cf, cf};
#pragma unroll
        for (int w = 0; w < 4; ++w) { acc[2 * w] = __builtin_amdgcn_cvt_pk_f32_fp8((int)B.vv[j][w], false) * c2 + acc[2 * w]; acc[2 * w + 1] = __builtin_amdgcn_cvt_pk_f32_fp8((int)B.vv[j][w], true) * c2 + acc[2 * w + 1]; } }
}
DI void peer_gather_sweep5(Frame& F, const Args& A, const int* IDX, const float* GATE, size_t tok0) {
    constexpr int TPW = 4;
    const int lane = F.lane, wid = F.wave;
    const unsigned char* U8 = F.ws + WS_U8; const unsigned char* V8 = F.ws + WS_V8; const unsigned char* X8 = F.ws + WS_X8;
    const float* SU = (const float*)(F.ws + WS_SU); const float* SX = (const float*)(F.ws + WS_SX);
    LAS unsigned char* list = F.lds + wid * (TPW * 2048);
    v4u xq[TPW];
#pragma unroll
    for (int tl = 0; tl < TPW; ++tl) {
        const size_t t = tok0 + tl;
        xq[tl] = *(const GAS v4u*)(X8 + t * 1024 + 16 * lane);
        const int idlo = IDX[t * 128 + lane], idhi = IDX[t * 128 + 64 + lane]; const float sx = SX[t];
        const float glo = GATE[t * 128 + lane] * (1.f / 64.f), ghi = GATE[t * 128 + 64 + lane] * (1.f / 64.f);
        const float slo = SU[idlo] * sx, shi = SU[idhi] * sx;
        LAS unsigned char* tl_list = list + tl * 2048;
        int base = 0;
        for (int s = 0; s < G5_NSH; ++s) {
            { const bool m = (idlo >> G5_SHIFT) == s; const unsigned long long mk = __ballot(m); const int pos = base + (int)__builtin_amdgcn_mbcnt_hi((unsigned)(mk >> 32), __builtin_amdgcn_mbcnt_lo((unsigned)mk, 0u));
              if (m) *(LAS v4u*)(tl_list + pos * 16) = (v4u){(unsigned)idlo, __float_as_uint(glo), __float_as_uint(slo), 0u};
              base += __builtin_popcountll(mk); }
            { const bool m = (idhi >> G5_SHIFT) == s; const unsigned long long mk = __ballot(m); const int pos = base + (int)__builtin_amdgcn_mbcnt_hi((unsigned)(mk >> 32), __builtin_amdgcn_mbcnt_lo((unsigned)mk, 0u));
              if (m) *(LAS v4u*)(tl_list + pos * 16) = (v4u){(unsigned)idhi, __float_as_uint(ghi), __float_as_uint(shi), 0u};
              base += __builtin_popcountll(mk); }
        }
    }
    LDS_WAIT(); asm volatile("" ::: "memory");
    f32x2 acc[TPW][8];
#pragma unroll
    for (int tl = 0; tl < TPW; ++tl)
#pragma unroll
        for (int i = 0; i < 8; ++i) acc[tl][i] = (f32x2){0.f, 0.f};
    G5Buf BA, BB; v4u EA, EB;
    g5_issue(BA, EA, list, U8, V8, 0, lane);
    for (int k = 0; k < 32; ++k) {
        g5_issue(BB, EB, list + 2048, U8, V8, k, lane);      g5_compute(acc[0], xq[0], BA, EA, lane);
        g5_issue(BA, EA, list + 4096, U8, V8, k, lane);      g5_compute(acc[1], xq[1], BB, EB, lane);
        g5_issue(BB, EB, list + 6144, U8, V8, k, lane);      g5_compute(acc[2], xq[2], BA, EA, lane);
        g5_issue(BA, EA, list, U8, V8, k < 31 ? k + 1 : 31, lane);   g5_compute(acc[3], xq[3], BB, EB, lane);
    }
#pragma unroll
    for (int tl = 0; tl < TPW; ++tl) {
        float* hp = F.out + (tok0 + tl) * 1024 + 16 * lane;
        f32x4 y[4]; float ssq = 0.f;
#pragma unroll
        for (int i = 0; i < 4; ++i) { y[i] = *(const GAS f32x4*)(hp + 4 * i); y[i].x += acc[tl][2 * i].x; y[i].y += acc[tl][2 * i].y; y[i].z += acc[tl][2 * i + 1].x; y[i].w += acc[tl][2 * i + 1].y;
            ssq += (y[i].x * y[i].x + y[i].y * y[i].y) + (y[i].z * y[i].z + y[i].w * y[i].w); }
        const float rs = 1.f / sqrtf(wave_sum(ssq) * (1.f / 1024.f) + EPS);
#pragma unroll
        for (int i = 0; i < 4; ++i) { const f32x4 gv = *(const GAS f32x4*)(A.in[20] + 16 * lane + 4 * i); *(GAS f32x4*)(hp + 4 * i) = y[i] * rs * gv; }
    }
    LDS_WAIT(); asm volatile("" ::: "memory");
}
constexpr int G6_NSH = 16, G6_SHIFT = 10, G6_TPW = 8;
DI void g6_issue(v4u (&R)[4], v4u& E, const LAS unsigned char* tlist, const unsigned char* TAB, int k, int lane) {
    E = *(const LAS v4u*)(tlist + (4 * k + (lane & 3)) * 16);
#pragma unroll
    for (int j = 0; j < 4; ++j) { const unsigned id = (unsigned)__builtin_amdgcn_readlane((int)E.x, j); R[j] = *(const GAS v4u*)(TAB + (size_t)id * 1024 + 16 * lane); }
}
DI void g6_dot(const v4u& xx, const v4u (&U)[4], const v4u& E, LAS unsigned char* tlist, int k, int lane) {
    int p[4];
#pragma unroll
    for (int j = 0; j < 4; ++j) { int d = __builtin_amdgcn_sdot4((int)U[j].x, (int)xx.x, 0, false); d = __builtin_amdgcn_sdot4((int)U[j].y, (int)xx.y, d, false);
        d = __builtin_amdgcn_sdot4((int)U[j].z, (int)xx.z, d, false); p[j] = __builtin_amdgcn_sdot4((int)U[j].w, (int)xx.w, d, false); }
    const bool b0 = lane & 1, b1 = lane & 2;
    const int kA = b0 ? p[1] : p[0], sA = b0 ? p[0] : p[1], kB = b0 ? p[3] : p[2], sB = b0 ? p[2] : p[3];
    const int qA = kA + dpp_i<0xB1>(sA), qB = kB + dpp_i<0xB1>(sB);
    const int kk = b1 ? qB : qA, ss = b1 ? qA : qB;
    int r = kk + dpp_i<0x4E>(ss);
    r += dpp_i<0x124>(r); r += dpp_i<0x128>(r);
    r += __shfl_xor(r, 16); r += __shfl_xor(r, 32);
    const float a = (float)r * __uint_as_float(E.z);
    const float y = 0.7978845608028654f * (a + 0.044715f * a * a * a);
    const float th = 1.f - 2.f * __builtin_amdgcn_rcpf(1.f + __expf(2.f * y));
    const float cfl = __uint_as_float(E.y) * 0.5f * a * (1.f + th);
    if (lane < 4) *(LAS float*)(tlist + (4 * k + lane) * 16 + 4) = cfl;
}
DI void g6_fma(f32x2 (&acc)[8], const v4u (&V)[4], const v4u& E, int lane) {
#pragma unroll
    for (int j = 0; j < 4; ++j) { const float cf = __uint_as_float(__builtin_amdgcn_readlane((int)E.y, j));
#pragma unroll
        for (int w = 0; w < 4; ++w) {
            asm("v_fmac_f32_e32 %0, %1, %2" : "+v"(acc[2 * w].x) : "s"(cf), "v"(__builtin_amdgcn_cvt_f32_fp8((int)V[j][w], 0)));
            asm("v_fmac_f32_e32 %0, %1, %2" : "+v"(acc[2 * w].y) : "s"(cf), "v"(__builtin_amdgcn_cvt_f32_fp8((int)V[j][w], 1)));
            asm("v_fmac_f32_e32 %0, %1, %2" : "+v"(acc[2 * w + 1].x) : "s"(cf), "v"(__builtin_amdgcn_cvt_f32_fp8((int)V[j][w], 2)));
            asm("v_fmac_f32_e32 %0, %1, %2" : "+v"(acc[2 * w + 1].y) : "s"(cf), "v"(__builtin_amdgcn_cvt_f32_fp8((int)V[j][w], 3))); } }
}
DI void peer_gather_wave6(Frame& F, const Args& A, const int* IDX, const float* GATE, size_t tok0) {
    constexpr int TPW = G6_TPW;
    const int lane = F.lane, wid = F.wave;
    const unsigned char* U8 = F.ws + WS_U8; const unsigned char* V8 = F.ws + WS_V8; const unsigned char* X8 = F.ws + WS_X8;
    const float* SU = (const float*)(F.ws + WS_SU); const float* SX = (const float*)(F.ws + WS_SX);
    LAS unsigned char* list = F.lds + wid * (TPW * 2048);
    v4u xq[TPW];
#pragma unroll
    for (int tl = 0; tl < TPW; ++tl) {
        const size_t t = tok0 + tl;
        xq[tl] = *(const GAS v4u*)(X8 + t * 1024 + 16 * lane);
        const int idlo = IDX[t * 128 + lane], idhi = IDX[t * 128 + 64 + lane]; const float sx = SX[t];
        const float glo = GATE[t * 128 + lane] * (1.f / 64.f), ghi = GATE[t * 128 + 64 + lane] * (1.f / 64.f);
        const float slo = SU[idlo] * sx, shi = SU[idhi] * sx;
        LAS unsigned char* tl_list = list + tl * 2048;
        int base = 0;
        for (int s = 0; s < G6_NSH; ++s) {
            { const bool m = (idlo >> G6_SHIFT) == s; const unsigned long long mk = __ballot(m); const int pos = base + (int)__builtin_amdgcn_mbcnt_hi((unsigned)(mk >> 32), __builtin_amdgcn_mbcnt_lo((unsigned)mk, 0u));
              if (m) *(LAS v4u*)(tl_list + pos * 16) = (v4u){(unsigned)idlo, __float_as_uint(glo), __float_as_uint(slo), 0u};
              base += __builtin_popcountll(mk); }
            { const bool m = (idhi >> G6_SHIFT) == s; const unsigned long long mk = __ballot(m); const int pos = base + (int)__builtin_amdgcn_mbcnt_hi((unsigned)(mk >> 32), __builtin_amdgcn_mbcnt_lo((unsigned)mk, 0u));
              if (m) *(LAS v4u*)(tl_list + pos * 16) = (v4u){(unsigned)idhi, __float_as_uint(ghi), __float_as_uint(shi), 0u};
              base += __builtin_popcountll(mk); }
        }
    }
    LDS_WAIT(); asm volatile("" ::: "memory");
#define G6_SB __builtin_amdgcn_sched_barrier(0)
    {
        v4u RA[4], RB[4]; v4u EA, EB;
        g6_issue(RA, EA, list, U8, 0, lane);
        for (int k = 0; k < 32; ++k) {
#define G6_P1(RI, EI, tn, kn, RC, EC, tc) do { g6_issue(RI, EI, list + (tn) * 2048, U8, kn, lane); G6_SB; g6_dot(xq[tc], RC, EC, list + (tc) * 2048, k, lane); G6_SB; } while (0)
            G6_P1(RB, EB, 1, k, RA, EA, 0); G6_P1(RA, EA, 2, k, RB, EB, 1); G6_P1(RB, EB, 3, k, RA, EA, 2); G6_P1(RA, EA, 4, k, RB, EB, 3);
            G6_P1(RB, EB, 5, k, RA, EA, 4); G6_P1(RA, EA, 6, k, RB, EB, 5); G6_P1(RB, EB, 7, k, RA, EA, 6); G6_P1(RA, EA, 0, (k < 31 ? k + 1 : 31), RB, EB, 7);
#undef G6_P1
        }
    }
    LDS_WAIT(); asm volatile("" ::: "memory");
    f32x2 acc[TPW][8];
#pragma unroll
    for (int tl = 0; tl < TPW; ++tl)
#pragma unroll
        for (int i = 0; i < 8; ++i) acc[tl][i] = (f32x2){0.f, 0.f};
    {
        v4u RA[4], RB[4]; v4u EA, EB;
        g6_issue(RA, EA, list, V8, 0, lane);
        for (int k = 0; k < 32; ++k) {
#define G6_P2(RI, EI, tn, kn, RC, EC, tc) do { g6_issue(RI, EI, list + (tn) * 2048, V8, kn, lane); G6_SB; g6_fma(acc[tc], RC, EC, lane); G6_SB; } while (0)
            G6_P2(RB, EB, 1, k, RA, EA, 0); G6_P2(RA, EA, 2, k, RB, EB, 1); G6_P2(RB, EB, 3, k, RA, EA, 2); G6_P2(RA, EA, 4, k, RB, EB, 3);
            G6_P2(RB, EB, 5, k, RA, EA, 4); G6_P2(RA, EA, 6, k, RB, EB, 5); G6_P2(RB, EB, 7, k, RA, EA, 6); G6_P2(RA, EA, 0, (k < 31 ? k + 1 : 31), RB, EB, 7);
#undef G6_P2
        }
    }
#undef G6_SB
#pragma unroll
    for (int tl = 0; tl < TPW; ++tl) {
        float* hp = F.out + (tok0 + tl) * 1024 + 16 * lane;
        f32x4 y[4]; float ssq = 0.f;
#pragma unroll
        for (int i = 0; i < 4; ++i) { y[i] = *(const GAS f32x4*)(hp + 4 * i); y[i].x += acc[tl][2 * i].x; y[i].y += acc[tl][2 * i].y; y[i].z += acc[tl][2 * i + 1].x; y[i].w += acc[tl][2 * i + 1].y;
            ssq += (y[i].x * y[i].x + y[i].y * y[i].y) + (y[i].z * y[i].z + y[i].w * y[i].w); }
        const float rs = 1.f / sqrtf(wave_sum(ssq) * (1.f / 1024.f) + EPS);
#pragma unroll
        for (int i = 0; i < 4; ++i) { const f32x4 gv = *(const GAS f32x4*)(A.in[20] + 16 * lane + 4 * i); *(GAS f32x4*)(hp + 4 * i) = y[i] * rs * gv; }
    }
    LDS_WAIT(); asm volatile("" ::: "memory");
}

__global__ void __launch_bounds__(NWAVES * 64, 2) fwd_kernel(Args args) {
    extern __shared__ __attribute__((aligned(16))) unsigned char lds[];
    Frame F;
    F.lds = (LAS unsigned char*)lds;
    F.MISC = (volatile LAS unsigned*)(F.lds + MISC_OFF);
    F.tid = threadIdx.x; F.lane = F.tid & 63; F.wave = __builtin_amdgcn_readfirstlane(F.tid >> 6);
    F.G = gridDim.x; { const int bx = blockIdx.x; F.vcu = (F.G % 8 == 0) ? (bx % 8) * (F.G / 8) + bx / 8 : bx; }
    unsigned char* ws = args.ws;
    F.ctl = (gu32*)(ws + WS_CTL);
    F.out = args.out; F.ws = ws;
    for (int u = F.tid; u < (LDS_BYTES - LDSCTL_OFF) / 4; u += NWAVES * 64) ((LAS unsigned*)(F.lds + LDSCTL_OFF))[u] = 0u;
    __syncthreads();
    XcdBarrier bar = xcd_barrier_post((unsigned*)(F.ctl + CW_BAR) + args.li * XCD_BAR_WORDS, F.MISC + 8);
    const int lo = args.ph_lo, hi = args.ph_hi;
#ifndef PH_MASK
#define PH_MASK 0xffff
#endif
#define IN(k) (((PH_MASK >> (k)) & 1) && lo <= (k) && (k) < hi)
#define SEAM(k) do { if (IN(k) && IN((k) + 1)) xcd_barrier(bar); } while (0)
    const int gw = F.vcu * NWAVES + F.wave, NGW = F.G * NWAVES;
#define STW (F.out)
#define OSB (F.out + (size_t)M * 512)
#define IDX ((int*)F_BUFA)
#define GATE ((float*)(F_BUFA) + (size_t)M * 128)

    if (IN(0)) { p0_prologue(F, args); } SEAM(0);
    if (IN(1)) {
        { pg8::Gemm g{F_BUFA, F_W1T, 1024, 1024, 1024}; pg8::StaticOrder S; S.init(M, N1, F.G, (int)blockIdx.x, 1024, 1024);
          pg8::EpiBf16P E{F_PROJ, N1, 1.f};
          pg8::gemm_phase<pg8::EpiBf16P, pg8::StaticOrder, true, true>(F.lds, g, S, E); }
        { pg8::Gemm g{F_MN, F_WXKVT, 1024, 1024, 1024}; const int c = (int)blockIdx.x; pg8::OneUnitOrder S{(c >= 64 && c < 128) ? c - 64 : -1, 8, 1024, 1024};
          pg8::EpiBf16P E{F_KV, 2048, 1.f};
          pg8::gemm_phase<pg8::EpiBf16P, pg8::OneUnitOrder, true, true>(F.lds, g, S, E); }
    } SEAM(1);
    if (IN(2)) {
        for (int it = F.vcu; it < 256; it += F.G) { const int bh = it >> 2, s = it & 3; sb_unit(F, OSB, bh >> 3, bh & 7, 7 - s); sb_unit(F, OSB, bh >> 3, bh & 7, s); }
        for (int it = F.vcu; it < 1024; it += F.G) { const int bh = it >> 5; gla_local_unit(F, args, STW, bh >> 2, bh & 3, it & 31); }
    } SEAM(2);
    if (IN(3)) { gla_scan(F, STW); } SEAM(3);
    if (IN(4)) {
        for (int it = F.vcu; it < 1024; it += F.G) { const int bh = it >> 5; gla_out_unit(F, args, STW, bh >> 2, bh & 3, it & 31); }
        for (int m = gw; m < M; m += NGW) mix_row_sb(F, args, OSB, (size_t)m);
    } SEAM(4);
    if (IN(5)) { pg8::Gemm g{F_BUFA, F_WOT, 1024, 1024, 1024}; pg8::StaticOrder S; S.init(M, 1024, F.G, (int)blockIdx.x, 1024, 1024);
        pg8::EpiF32Res E{args.in[0], F.out, 1024};
        pg8::gemm_phase<pg8::EpiF32Res, pg8::StaticOrder, true, true>(F.lds, g, S, E); } SEAM(5);
    if (IN(6)) {
        for (int m = gw; m < M; m += NGW) rms_row_to_bf16(F.lane, F.out + (size_t)m * DM, args.in[10], F_SLOT0 + (size_t)m * DM);
        const int gt = gw * 64 + F.lane, NGT = NGW * 64;
        for (int i = gt; i < 8 * 4 * 256 * 32; i += NGT) { const int mc = i & 31, d = (i >> 5) & 255, h = (i >> 13) & 3, b = i >> 15;
            unsigned short v[8];
#pragma unroll
            for (int j = 0; j < 8; ++j) v[j] = F_KV[(size_t)(b * 256 + mc * 8 + j) * 2048 + 1024 + h * 256 + d];
            v4u o; o.x = v[0] | ((unsigned)v[1] << 16); o.y = v[2] | ((unsigned)v[3] << 16); o.z = v[4] | ((unsigned)v[5] << 16); o.w = v[6] | ((unsigned)v[7] << 16);
            *(GAS v4u*)(F_VT + (size_t)((b * 4 + h) * 256 + d) * 256 + mc * 8) = o; }
    } SEAM(6);
    if (IN(7)) { pg8::Gemm g{F_SLOT0, F_WXQT, 1024, 1024, 1024}; pg8::StaticOrder S; S.init(M, 1024, F.G, (int)blockIdx.x, 1024, 1024);
        pg8::EpiBf16P E{F_SLOT2, 1024, 1.f};
        pg8::gemm_phase<pg8::EpiBf16P, pg8::StaticOrder, true, true>(F.lds, g, S, E); } SEAM(7);
    if (IN(8)) { pg8::Gemm g{F_SLOT2, F_KV, 256, 1024, 2048}; pg8::XAttnOrder<0> S{F.G, (int)blockIdx.x};
        pg8::EpiBf16P E{F_SLOT1, 1024, 1.f};
        pg8::gemm_phase<pg8::EpiBf16P, pg8::XAttnOrder<0>, true, true>(F.lds, g, S, E); } SEAM(8);
    if (IN(9)) { for (int r = gw; r < M * 4; r += NGW) xsoftmax_row(F, F_SLOT1, (size_t)r); } SEAM(9);
    if (IN(10)) { pg8::Gemm g{F_SLOT1, F_VT, 256, 1024, 256}; pg8::XAttnOrder<1> S{F.G, (int)blockIdx.x};
        pg8::EpiBf16P E{F_SLOT0, 1024, 1.f};
        pg8::gemm_phase<pg8::EpiBf16P, pg8::XAttnOrder<1>, true, true>(F.lds, g, S, E); } SEAM(10);
    if (IN(11)) { pg8::Gemm g{F_SLOT0, F_WXOT, 1024, 1024, 1024}; pg8::StaticOrder S; S.init(M, 1024, F.G, (int)blockIdx.x, 1024, 1024);
        pg8::EpiF32Res E{F.out, F.out, 1024};
        pg8::gemm_phase<pg8::EpiF32Res, pg8::StaticOrder, true, true>(F.lds, g, S, E); } SEAM(11);
    if (IN(12)) { for (int m = gw; m < M; m += NGW) rms_row_to_bf16_i8(F.lane, F.out + (size_t)m * DM, args.in[15], F_SLOT2 + (size_t)m * DM, F.ws + WS_X8 + (size_t)m * 1024, (float*)(F.ws + WS_SX) + m); } SEAM(12);
    if (IN(13)) { pg8::Gemm g{F_SLOT2, F_WPQT, 1024, 1024, 1024}; pg8::StaticOrder S; S.init(M, 2048, F.G, (int)blockIdx.x, 1024, 1024);
        pg8::EpiBf16P E{F_SLOT0, 2048, 1.f};
        pg8::gemm_phase<pg8::EpiBf16P, pg8::StaticOrder, true, true>(F.lds, g, S, E); } SEAM(13);
    if (IN(14)) { peer_topk_mfma(F, F_SLOT0, IDX, GATE); } SEAM(14);
    if (IN(15)) { peer_gather_wave6(F, args, IDX, GATE, (size_t)F.vcu * 64 + F.wave * 8); }
#undef IN
#undef SEAM
}

constexpr int NPHASES = 16;
#ifndef MK_PER_PHASE
#define MK_PER_PHASE 0
#endif
extern "C" void kernel_launch(void* const* d_in, const int* in_sizes, int n_in, void* d_out, int out_size, void* d_ws, size_t ws_size, hipStream_t stream) {
    static int grid = 0;
    if (grid == 0) {
        if (n_in != 21 || out_size != M * DM || ws_size < WS_END) { fprintf(stderr, "kernel_launch: unexpected shapes (n_in %d out %d ws %zu)\n", n_in, out_size, ws_size); grid = -1; return; }
        int dev = 0, cus = 0, per_cu = 0;
        if (hipGetDevice(&dev) != hipSuccess || hipDeviceGetAttribute(&cus, hipDeviceAttributeMultiprocessorCount, dev) != hipSuccess) { grid = -1; return; }
        if (hipFuncSetAttribute((const void*)fwd_kernel, hipFuncAttributeMaxDynamicSharedMemorySize, LDS_BYTES) != hipSuccess) { fprintf(stderr, "kernel_launch: hipFuncSetAttribute failed\n"); grid = -1; return; }
        if (hipOccupancyMaxActiveBlocksPerMultiprocessor(&per_cu, (const void*)fwd_kernel, NWAVES * 64, LDS_BYTES) != hipSuccess || per_cu < 1) { fprintf(stderr, "kernel_launch: occupancy query says %d\n", per_cu); }
        (void)hipGetLastError();
        grid = cus;
    }
    if (grid < 0) return;
    (void)hipMemsetAsync((char*)d_ws + WS_CTL, 0, CTL_ZERO_BYTES, stream);
    Args a{};
    for (int i = 0; i < 21; ++i) a.in[i] = (const float*)d_in[i];
    a.out = (float*)d_out; a.ws = (unsigned char*)d_ws;
#if MK_PER_PHASE
    for (int p = 0; p < NPHASES; ++p) { a.ph_lo = p; a.ph_hi = p + 1; a.li = 0; hipLaunchKernelGGL(fwd_kernel, dim3(grid), dim3(NWAVES * 64), LDS_BYTES, stream, a); }
#elif defined(PROF_DUP_LO)
    a.ph_lo = 0; a.ph_hi = PROF_DUP_HI + 1; a.li = 0; hipLaunchKernelGGL(fwd_kernel, dim3(grid), dim3(NWAVES * 64), LDS_BYTES, stream, a);
    a.ph_lo = PROF_DUP_LO; a.ph_hi = NPHASES; a.li = 1; hipLaunchKernelGGL(fwd_kernel, dim3(grid), dim3(NWAVES * 64), LDS_BYTES, stream, a);
#elif defined(PROF_SPLIT)
    a.ph_lo = 0; a.ph_hi = PROF_SPLIT; a.li = 0; hipLaunchKernelGGL(fwd_kernel, dim3(grid), dim3(NWAVES * 64), LDS_BYTES, stream, a);
    a.ph_lo = PROF_SPLIT; a.ph_hi = NPHASES; a.li = 1; hipLaunchKernelGGL(fwd_kernel, dim3(grid), dim3(NWAVES * 64), LDS_BYTES, stream, a);
#else
    a.ph_lo = 0; a.ph_hi = NPHASES; a.li = 0;
    hipLaunchKernelGGL(fwd_kernel, dim3(grid), dim3(NWAVES * 64), LDS_BYTES, stream, a);
#endif
}
```

```cpp
#include <hip/hip_runtime.h>
#include <cstdio>
#include <cstdint>
namespace pg8 {
#define PG8_LAS __attribute__((address_space(3)))
typedef unsigned short bf16_t;
typedef short bf16x8 __attribute__((ext_vector_type(8)));
typedef float f32x4 __attribute__((ext_vector_type(4)));
typedef unsigned u32x4 __attribute__((ext_vector_type(4)));
constexpr int BM = 256, BK = 64, HALF = 128, HTB = HALF * BK * 2  , STAGE_BYTES = 8 * HTB, NXCD = 8, WGM = 8;

__host__ __device__ __forceinline__ int lds_byte(int r, int c) { const int st = (r >> 4) * 2 + (c >> 5), rr = r & 15, cc = c & 31, ob = rr * 64 + cc * 2; return st * 1024 + (ob ^ (((ob >> 9) & 1) << 5)); }
__host__ __device__ __forceinline__ void stage_rc(int b, int& R, int& C) { const int st = b / 1024, sb = b % 1024, swz = sb ^ (((sb >> 9) & 1) << 5); R = (st >> 1) * 16 + swz / 64; C = (st & 1) * 32 + (swz % 64) / 2; }
__host__ __device__ __forceinline__ int perm32(int rho) { const int n = rho >> 4, i = rho & 15; return 8 * (i >> 2) + 4 * n + (i & 3); }

struct Unit { int pm, pn; size_t aoff, boff; };
struct Gemm { const bf16_t* A; const bf16_t* Bt; int K, lda, ldb; };

struct StaticOrder {
    int nM, nN, nwg, G, c, lda, ldb;
    __host__ __device__ void init(int M, int N, int G_, int c_, int lda_, int ldb_) { nM = M / BM; nN = N / BM; nwg = nM * nN; G = G_; c = c_; lda = lda_; ldb = ldb_; }
    __host__ __device__ bool next(int i, Unit& u) const {
        const long L = (long)i * G + c; if (L >= nwg) return false;
        int wgid = (int)L; { const int q = nwg / NXCD, r = nwg % NXCD, xcd = wgid % NXCD, off = wgid / NXCD; wgid = (xcd < r ? xcd * (q + 1) : r * (q + 1) + (xcd - r) * q) + off; }
        const int nig = WGM * nN, gid = wgid / nig, fm = gid * WGM, gsz = (nM - fm) < WGM ? (nM - fm) : WGM;
        u.pm = fm + ((wgid % nig) % gsz); u.pn = (wgid % nig) / gsz; u.aoff = (size_t)u.pm * BM * lda * 2; u.boff = (size_t)u.pn * BM * ldb * 2; return true;
    }
    __device__ __forceinline__ void a_ready(const Unit&) const {}
    __device__ __forceinline__ void done(const Unit&) const {}
};

__device__ __forceinline__ unsigned cvt_pk_bf16(float lo, float hi) { unsigned r; asm volatile("v_cvt_pk_bf16_f32 %0, %1, %2" : "=v"(r) : "v"(lo), "v"(hi)); return r; }
typedef float f32x2 __attribute__((ext_vector_type(2)));
__device__ __forceinline__ f32x2 gelu_pk(f32x2 v) {
    const f32x2 av = __builtin_elementwise_abs(v), d = av * 0.2316418882f + 1.0f;
    f32x2 t; t.x = __builtin_amdgcn_rcpf(d.x); t.y = __builtin_amdgcn_rcpf(d.y);
    f32x2 q = t * 0.5307027145f + (-0.7265760135f); q = q * t + 0.7107068705f; q = q * t + (-0.142248368f); q = q * t + 0.127414796f; q = q * t;
    const f32x2 s = (v * v) * (-0.72134752044f);
    f32x2 e; e.x = __builtin_amdgcn_exp2f(s.x); e.y = __builtin_amdgcn_exp2f(s.y);
    const f32x2 m = v * (q * e), r = v - m;
    f32x2 o; o.x = v.x < 0.f ? m.x : r.x; o.y = v.y < 0.f ? m.y : r.y; return o;
}

template <int ACT  > struct EpiBf16 {
    static constexpr bool PERM = true, AFTER_DRAIN = false; static_assert(ACT == 0 || ACT == 1, "EpiBf16: ACT is 0 (none) or 1 (gelu_pk)");
    bf16_t* O; int ldc; const float* bias; int split_cols; size_t split_stride; float scale0;
    __device__ __forceinline__ void operator()(const f32x4 (&acc)[2][2][4][2], const Unit& u, int wr, int wc, int fr, int fq) const {
        const int row0 = u.pm * BM + wr * 64 + fr; int colt = u.pn * BM; bf16_t* base = O;
        float sc = 1.f; if (split_cols) { const int t = colt / split_cols; base += (size_t)t * split_stride; colt -= t * split_cols; if (t == 0) sc = scale0; }
        const int col0 = colt + wc * 32 + 8 * fq, bcol0 = u.pn * BM + wc * 32 + 8 * fq;
        f32x4 bv[2][2];
#pragma unroll
        for (int bj = 0; bj < 2; ++bj)
#pragma unroll
            for (int n = 0; n < 2; ++n) bv[bj][n] = bias ? *(const f32x4*)(bias + bcol0 + bj * HALF + 4 * n) : (f32x4){0.f, 0.f, 0.f, 0.f};
#pragma unroll
        for (int ai = 0; ai < 2; ++ai)
#pragma unroll
            for (int m = 0; m < 4; ++m) { bf16_t* rowp = base + (size_t)(row0 + ai * HALF + m * 16) * ldc + col0;
#pragma unroll
                for (int bj = 0; bj < 2; ++bj) { f32x4 v0 = acc[ai][bj][m][0] + bv[bj][0], v1 = acc[ai][bj][m][1] + bv[bj][1];
                    if (ACT == 1) { f32x2 a = gelu_pk((f32x2){v0[0], v0[1]}), b = gelu_pk((f32x2){v0[2], v0[3]}), c = gelu_pk((f32x2){v1[0], v1[1]}), d = gelu_pk((f32x2){v1[2], v1[3]});
                        v0 = (f32x4){a.x, a.y, b.x, b.y}; v1 = (f32x4){c.x, c.y, d.x, d.y}; }
                    v0 = v0 * sc; v1 = v1 * sc; u32x4 w; w.x = cvt_pk_bf16(v0[0], v0[1]); w.y = cvt_pk_bf16(v0[2], v0[3]); w.z = cvt_pk_bf16(v1[0], v1[1]); w.w = cvt_pk_bf16(v1[2], v1[3]);
                    *(u32x4*)(rowp + bj * HALF) = w; } }
    }
};
template <class Epi, class Sched, bool ALIGN_EPI = false, bool SP2 = false>
__device__ __forceinline__ void gemm_phase(PG8_LAS unsigned char* lds, const Gemm g, const Sched& S, const Epi& E) {
    const int tid = threadIdx.x, wid = __builtin_amdgcn_readfirstlane(tid >> 6), lane = tid & 63, wr = wid >> 2, wc = wid & 3, fr = lane & 15, fq = lane >> 4;
    int K = g.K; asm volatile("" : "+s"(K));
    const int nt = K / BK;
    unsigned voffA[2], voffB[2];
#pragma unroll
    for (int i = 0; i < 2; ++i) { int R, C; stage_rc(tid * 16 + i * 8192, R, C); const int Rb = Epi::PERM ? ((R & ~31) + perm32(R & 31)) : R;
        voffA[i] = (unsigned)(R * g.lda + C) * 2u; voffB[i] = (unsigned)(Rb * g.ldb + C) * 2u; }
    const size_t kstep = (size_t)(BK * 2);
    const size_t hA = (size_t)HALF * g.lda * 2, hB = (size_t)HALF * g.ldb * 2;
    const unsigned ldsw = (unsigned)wid * 1024u;
    const int aoff = lds_byte(wr * 64 + fr, fq * 8), boff = lds_byte(wc * 32 + fr, fq * 8);
#define PG8_SA(b, h) (((b) * 2 + (h)) * HTB)
#define PG8_SB(b, h) ((4 + (b) * 2 + (h)) * HTB)
#define PG8_STAGE(bufoff, gbase, voff) do { _Pragma("unroll") for (int _i = 0; _i < 2; ++_i) \
        __builtin_amdgcn_global_load_lds((const unsigned*)((const char*)(gbase) + (voff)[_i]), (PG8_LAS unsigned*)(lds + (bufoff) + ldsw + _i * 8192), 16, 0, 0); } while (0)
#define PG8_LDA(dst, b, h) do { _Pragma("unroll") for (int m = 0; m < 4; ++m) _Pragma("unroll") for (int k = 0; k < 2; ++k) dst[m][k] = *(const PG8_LAS bf16x8*)(lds + PG8_SA(b, h) + aoff + m * 2048 + k * 1024); } while (0)
#define PG8_LDB(dst, b, h) do { _Pragma("unroll") for (int n = 0; n < 2; ++n) _Pragma("unroll") for (int k = 0; k < 2; ++k) dst[n][k] = *(const PG8_LAS bf16x8*)(lds + PG8_SB(b, h) + boff + n * 2048 + k * 1024); } while (0)
#define PG8_MMA(ai, bj, At, Bt) do { __builtin_amdgcn_s_setprio(1); _Pragma("unroll") for (int m = 0; m < 4; ++m) _Pragma("unroll") for (int n = 0; n < 2; ++n) _Pragma("unroll") for (int k = 0; k < 2; ++k) \
        acc[ai][bj][m][n] = __builtin_amdgcn_mfma_f32_16x16x32_bf16(Bt[n][k], At[m][k], acc[ai][bj][m][n], 0, 0, 0); __builtin_amdgcn_s_setprio(0); } while (0)
#define PG8_WAIT_V(n) asm volatile("s_waitcnt vmcnt(" #n ")" ::: "memory")
#define PG8_WAIT_L(n) asm volatile("s_waitcnt lgkmcnt(" #n ")" ::: "memory")
#define PG8_BAR __builtin_amdgcn_s_barrier()
#define PG8_SCHED __builtin_amdgcn_sched_barrier(0)
    Unit cur, nxt; int ui = 0;
    if (!S.next(0, cur)) return;
    f32x4 acc[2][2][4][2];
#pragma unroll
    for (int a = 0; a < 2; ++a)
#pragma unroll
        for (int b = 0; b < 2; ++b)
#pragma unroll
            for (int m = 0; m < 4; ++m)
#pragma unroll
                for (int n = 0; n < 2; ++n) acc[a][b][m][n] = (f32x4){0.f, 0.f, 0.f, 0.f};
    bf16x8 At[4][2], B0[2][2], B1[2][2];
    const char* cA = (const char*)g.A + cur.aoff; const char* cB = (const char*)g.Bt + cur.boff;
    S.a_ready(cur);
    if constexpr (SP2) {
        PG8_STAGE(PG8_SB(0, 0), cB, voffB); PG8_STAGE(PG8_SB(0, 1), cB + hB, voffB); PG8_STAGE(PG8_SA(0, 0), cA, voffA); PG8_STAGE(PG8_SA(0, 1), cA + hA, voffA);
        if (wr == 1) PG8_BAR;
        PG8_WAIT_V(2); PG8_BAR;
        PG8_STAGE(PG8_SB(1, 0), cB + kstep, voffB); PG8_STAGE(PG8_SA(1, 0), cA + kstep, voffA); PG8_STAGE(PG8_SB(1, 1), cB + hB + kstep, voffB);
        PG8_WAIT_V(6); PG8_BAR;
    } else {
        PG8_STAGE(PG8_SB(0, 0), cB, voffB); PG8_STAGE(PG8_SA(0, 0), cA, voffA); PG8_STAGE(PG8_SB(0, 1), cB + hB, voffB); PG8_STAGE(PG8_SA(0, 1), cA + hA, voffA);
        if (wr == 1) PG8_BAR;
        PG8_WAIT_V(4); PG8_BAR;
        PG8_STAGE(PG8_SB(1, 0), cB + kstep, voffB); PG8_STAGE(PG8_SA(1, 0), cA + kstep, voffA); PG8_STAGE(PG8_SB(1, 1), cB + hB + kstep, voffB);
        PG8_WAIT_V(6); PG8_BAR;
    }
    for (;;) {
        const bool has_next = S.next(ui + 1, nxt);
        const char* nA = has_next ? (const char*)g.A + nxt.aoff : cA; const char* nB = has_next ? (const char*)g.Bt + nxt.boff : cB;
        for (int t = 0; t < nt; t += 2) {
            const bool last = (t == nt - 2);
            const char* a1 = cA + (size_t)(t + 1) * kstep;
            const char* a2 = last ? nA : cA + (size_t)(t + 2) * kstep; const char* b2 = last ? nB : cB + (size_t)(t + 2) * kstep;
            const char* a3 = a2 + kstep; const char* b3 = b2 + kstep;
            if (last && has_next) S.a_ready(nxt);
            if constexpr (SP2) {
            PG8_LDB(B0, 0, 0); PG8_LDB(B1, 0, 1); PG8_SCHED; PG8_LDA(At, 0, 0); PG8_STAGE(PG8_SA(1, 1), a1 + hA, voffA);
            PG8_WAIT_V(8); PG8_WAIT_L(0); PG8_BAR; PG8_MMA(0, 0, At, B0); PG8_MMA(0, 1, At, B1); PG8_BAR; PG8_SCHED;
            PG8_LDA(At, 0, 1); PG8_STAGE(PG8_SB(0, 0), b2, voffB); PG8_STAGE(PG8_SB(0, 1), b2 + hB, voffB); PG8_STAGE(PG8_SA(0, 0), a2, voffA);
            PG8_WAIT_V(8); PG8_WAIT_L(0); PG8_BAR; PG8_MMA(1, 0, At, B0); PG8_MMA(1, 1, At, B1); PG8_BAR; PG8_SCHED;
            PG8_LDB(B0, 1, 0); PG8_LDB(B1, 1, 1); PG8_SCHED; PG8_LDA(At, 1, 0); PG8_STAGE(PG8_SA(0, 1), a2 + hA, voffA);
            PG8_WAIT_V(8); PG8_WAIT_L(0); PG8_BAR; PG8_MMA(0, 0, At, B0); PG8_MMA(0, 1, At, B1); PG8_BAR; PG8_SCHED;
            PG8_LDA(At, 1, 1); PG8_STAGE(PG8_SB(1, 0), b3, voffB); PG8_STAGE(PG8_SB(1, 1), b3 + hB, voffB); PG8_STAGE(PG8_SA(1, 0), a3, voffA);
            PG8_WAIT_V(8); PG8_WAIT_L(0); PG8_BAR; PG8_MMA(1, 0, At, B0); PG8_MMA(1, 1, At, B1); PG8_BAR; PG8_SCHED;
            } else {
            PG8_LDB(B0, 0, 0); PG8_SCHED; PG8_LDA(At, 0, 0); PG8_STAGE(PG8_SA(1, 1), a1 + hA, voffA);
            PG8_WAIT_L(8); PG8_BAR; PG8_WAIT_L(0); PG8_MMA(0, 0, At, B0); PG8_BAR; PG8_SCHED;
            PG8_LDB(B1, 0, 1); PG8_STAGE(PG8_SB(0, 0), b2, voffB);
            PG8_BAR; PG8_WAIT_L(0); PG8_MMA(0, 1, At, B1); PG8_BAR;
            PG8_LDA(At, 0, 1); PG8_STAGE(PG8_SA(0, 0), a2, voffA);
            PG8_BAR; PG8_WAIT_L(0); PG8_MMA(1, 0, At, B0); PG8_BAR; PG8_SCHED;
            PG8_STAGE(PG8_SB(0, 1), b2 + hB, voffB);
            PG8_WAIT_V(6); PG8_BAR; PG8_MMA(1, 1, At, B1); PG8_BAR;
            PG8_LDB(B0, 1, 0); PG8_SCHED; PG8_LDA(At, 1, 0); PG8_STAGE(PG8_SA(0, 1), a2 + hA, voffA);
            PG8_WAIT_L(8); PG8_BAR; PG8_WAIT_L(0); PG8_MMA(0, 0, At, B0); PG8_BAR; PG8_SCHED;
            PG8_LDB(B1, 1, 1); PG8_STAGE(PG8_SB(1, 0), b3, voffB);
            PG8_BAR; PG8_WAIT_L(0); PG8_MMA(0, 1, At, B1); PG8_BAR;
            PG8_LDA(At, 1, 1); PG8_STAGE(PG8_SA(1, 0), a3, voffA);
            PG8_BAR; PG8_WAIT_L(0); PG8_MMA(1, 0, At, B0); PG8_BAR; PG8_SCHED;
            PG8_STAGE(PG8_SB(1, 1), b3 + hB, voffB);
            PG8_WAIT_V(6); PG8_BAR; PG8_MMA(1, 1, At, B1); PG8_BAR;
            }
        }
        if constexpr (ALIGN_EPI) { if (wr == 0) PG8_BAR; }
        if constexpr (!Epi::AFTER_DRAIN) { E(acc, cur, wr, wc, fr, fq); S.done(cur); }
        if (!has_next) break;
#pragma unroll
        for (int a = 0; a < 2; ++a)
#pragma unroll
            for (int b = 0; b < 2; ++b)
#pragma unroll
                for (int m = 0; m < 4; ++m)
#pragma unroll
                    for (int n = 0; n < 2; ++n) acc[a][b][m][n] = (f32x4){0.f, 0.f, 0.f, 0.f};
        cur = nxt; cA = nA; cB = nB; ++ui;
        if constexpr (ALIGN_EPI) { if (wr == 1) PG8_BAR; }
    }
    PG8_WAIT_V(0);
    if constexpr (!ALIGN_EPI) { if (wr == 0) PG8_BAR; }
    PG8_BAR;
    if constexpr (Epi::AFTER_DRAIN) { E.fused(acc, cur, wr, wc, fr, fq, lds, wid, lane); S.done(cur); }
#undef PG8_SA
#undef PG8_SB
#undef PG8_STAGE
#undef PG8_LDA
#undef PG8_LDB
#undef PG8_MMA
#undef PG8_WAIT_V
#undef PG8_WAIT_L
#undef PG8_BAR
#undef PG8_SCHED
}
}
namespace pg8 {
struct EpiBf16P {
    static constexpr bool PERM = true, AFTER_DRAIN = false;
    bf16_t* O; int ldc; float sc;
    __device__ __forceinline__ void operator()(const f32x4 (&acc)[2][2][4][2], const Unit& u, int wr, int wc, int fr, int fq) const {
        const int row0 = u.pm * BM + wr * 64 + fr, col0 = u.pn * BM + wc * 32 + 8 * fq;
#pragma unroll
        for (int ai = 0; ai < 2; ++ai)
#pragma unroll
            for (int m = 0; m < 4; ++m) { bf16_t* rowp = O + (size_t)(row0 + ai * HALF + m * 16) * ldc + col0;
#pragma unroll
                for (int bj = 0; bj < 2; ++bj) { const f32x4 v0 = acc[ai][bj][m][0] * sc, v1 = acc[ai][bj][m][1] * sc;
                    u32x4 w; w.x = cvt_pk_bf16(v0[0], v0[1]); w.y = cvt_pk_bf16(v0[2], v0[3]); w.z = cvt_pk_bf16(v1[0], v1[1]); w.w = cvt_pk_bf16(v1[2], v1[3]);
                    *(u32x4*)(rowp + bj * HALF) = w; } }
    }
};
struct EpiF32Res {
    static constexpr bool PERM = false, AFTER_DRAIN = false;
    const float* base; float* out; int ldc;
    __device__ __forceinline__ void operator()(const f32x4 (&acc)[2][2][4][2], const Unit& u, int wr, int wc, int fr, int fq) const {
        const int row0 = u.pm * BM + wr * 64 + fr, col0 = u.pn * BM + wc * 32 + 4 * fq;
#pragma unroll
        for (int ai = 0; ai < 2; ++ai)
#pragma unroll
            for (int m = 0; m < 4; ++m) { const size_t off = (size_t)(row0 + ai * HALF + m * 16) * ldc + col0;
#pragma unroll
                for (int bj = 0; bj < 2; ++bj)
#pragma unroll
                    for (int n = 0; n < 2; ++n) { const f32x4 b = *(const f32x4*)(base + off + bj * HALF + n * 16); *(f32x4*)(out + off + bj * HALF + n * 16) = b + acc[ai][bj][m][n]; } }
    }
};
template <int mode> struct XAttnOrder {
    int G, c;
    __device__ __forceinline__ bool next(int i, Unit& u) const {
        const int L = i * G + c; if (L >= 256) return false;
        u.pm = L >> 2; u.pn = L & 3; const int b = u.pm >> 3;
        u.aoff = ((size_t)u.pm * 256 * 1024 + (size_t)u.pn * 256) * 2;
        u.boff = mode == 0 ? ((size_t)(b * 256) * 2048 + (size_t)u.pn * 256) * 2 : ((size_t)((b * 4 + u.pn) * 256) * 256) * 2;
        return true;
    }
    __device__ __forceinline__ void a_ready(const Unit&) const {}
    __device__ __forceinline__ void done(const Unit&) const {}
};
struct OneUnitOrder {
    int L, nN, lda, ldb;
    __device__ __forceinline__ bool next(int i, Unit& u) const {
        if (i != 0 || L < 0) return false;
        u.pm = L / nN; u.pn = L % nN; u.aoff = (size_t)u.pm * BM * lda * 2; u.boff = (size_t)u.pn * BM * ldb * 2; return true;
    }
    __device__ __forceinline__ void a_ready(const Unit&) const {}
    __device__ __forceinline__ void done(const Unit&) const {}
};
}

namespace pg8 {
struct EpiResRms {
    static constexpr bool PERM = false, AFTER_DRAIN = true;
    const float* base; float* out; bf16_t* hn; const float* g; int ldc; unsigned* xbuf; unsigned* cnt; float eps;
    __device__ __forceinline__ void fused(f32x4 (&acc)[2][2][4][2], const Unit& u, int wr, int wc, int fr, int fq, PG8_LAS unsigned char* lds, int wid, int lane) const {
        PG8_LAS float* P = (PG8_LAS float*)lds;
        PG8_LAS float* S = (PG8_LAS float*)(lds + 8192);
        const int col0 = u.pn * BM + wc * 32 + 4 * fq;
#pragma unroll
        for (int ai = 0; ai < 2; ++ai)
#pragma unroll
            for (int m = 0; m < 4; ++m) { const size_t off = (size_t)(u.pm * BM + ai * HALF + wr * 64 + m * 16 + fr) * ldc + col0; float s = 0.f;
#pragma unroll
                for (int bj = 0; bj < 2; ++bj)
#pragma unroll
                    for (int n = 0; n < 2; ++n) { const f32x4 b = *(const f32x4*)(base + off + bj * HALF + n * 16); f32x4 x = acc[ai][bj][m][n] + b; acc[ai][bj][m][n] = x; s += (x[0] * x[0] + x[1] * x[1]) + (x[2] * x[2] + x[3] * x[3]); }
                s += __shfl_xor(s, 16); s += __shfl_xor(s, 32);
                if (fq == 0) P[(ai * HALF + wr * 64 + m * 16 + fr) * 4 + wc] = s;
                if (m & 1) asm volatile("" ::: "memory"); }
        asm volatile("s_waitcnt lgkmcnt(0)" ::: "memory"); __builtin_amdgcn_s_barrier(); asm volatile("" ::: "memory");
        const int row = wid * 32 + (lane & 31);
        if (lane < 32) { const float t = (P[row * 4 + 0] + P[row * 4 + 1]) + (P[row * 4 + 2] + P[row * 4 + 3]);
            __hip_atomic_store(xbuf + (size_t)(u.pm * BM + row) * 4 + u.pn, __float_as_uint(t), __ATOMIC_RELAXED, __HIP_MEMORY_SCOPE_AGENT); }
        asm volatile("s_waitcnt vmcnt(0)" ::: "memory");
        if (lane == 0) __hip_atomic_fetch_add(cnt + 64 * u.pm, 1u, __ATOMIC_RELAXED, __HIP_MEMORY_SCOPE_AGENT);
        if (wid == 0) {
            const unsigned long long t0 = __builtin_amdgcn_s_memrealtime();
            while ((unsigned)__builtin_amdgcn_readfirstlane(__hip_atomic_load(cnt + 64 * u.pm, __ATOMIC_RELAXED, __HIP_MEMORY_SCOPE_AGENT)) < 32u) {
                if (__builtin_amdgcn_s_memrealtime() - t0 > 2000000ull) break;
                __builtin_amdgcn_s_sleep(2); }
            __builtin_amdgcn_fence(__ATOMIC_ACQUIRE, "agent");
        }
        asm volatile("s_waitcnt vmcnt(0) lgkmcnt(0)" ::: "memory"); __builtin_amdgcn_s_barrier(); asm volatile("" ::: "memory");
        if (lane < 32) { const unsigned* sl = xbuf + (size_t)(u.pm * BM + row) * 4; float t = 0.f;
#pragma unroll
            for (int q = 0; q < 4; ++q) t += __uint_as_float(__hip_atomic_load(sl + q, __ATOMIC_RELAXED, __HIP_MEMORY_SCOPE_AGENT));
            S[row] = 1.0f / sqrtf(t * (1.0f / 1024.0f) + eps); }
        asm volatile("s_waitcnt lgkmcnt(0)" ::: "memory"); __builtin_amdgcn_s_barrier(); asm volatile("" ::: "memory");
        f32x4 gv[2][2];
#pragma unroll
        for (int bj = 0; bj < 2; ++bj)
#pragma unroll
            for (int n = 0; n < 2; ++n) gv[bj][n] = *(const f32x4*)(g + col0 + bj * HALF + n * 16);
#pragma unroll
        for (int ai = 0; ai < 2; ++ai)
#pragma unroll
            for (int m = 0; m < 4; ++m) { const int r = ai * HALF + wr * 64 + m * 16 + fr; const float rs = S[r]; const size_t off = (size_t)(u.pm * BM + r) * ldc + col0;
#pragma unroll
                for (int bj = 0; bj < 2; ++bj)
#pragma unroll
                    for (int n = 0; n < 2; ++n) { const f32x4 x = acc[ai][bj][m][n]; *(f32x4*)(out + off + bj * HALF + n * 16) = x;
                        const f32x4 y = x * rs * gv[bj][n]; typedef unsigned u32x2v __attribute__((ext_vector_type(2))); u32x2v w; w.x = cvt_pk_bf16(y[0], y[1]); w.y = cvt_pk_bf16(y[2], y[3]);
                        *(u32x2v*)(hn + off + bj * HALF + n * 16) = w; }
                asm volatile("" ::: "memory"); }
    }
};
}

namespace pg8 {
struct EpiResSS {
    static constexpr bool PERM = false, AFTER_DRAIN = false;
    const float* base; float* out; bf16_t* hb; float* ss; int ldc;
    __device__ __forceinline__ void operator()(const f32x4 (&acc)[2][2][4][2], const Unit& u, int wr, int wc, int fr, int fq) const {
        const int row0 = u.pm * BM + wr * 64 + fr, col0 = u.pn * BM + wc * 32 + 4 * fq;
#pragma unroll
        for (int ai = 0; ai < 2; ++ai)
#pragma unroll
            for (int m = 0; m < 4; ++m) { const int row = row0 + ai * HALF + m * 16; const size_t off = (size_t)row * ldc + col0; float s = 0.f;
#pragma unroll
                for (int bj = 0; bj < 2; ++bj)
#pragma unroll
                    for (int n = 0; n < 2; ++n) { const f32x4 x = *(const f32x4*)(base + off + bj * HALF + n * 16) + acc[ai][bj][m][n]; *(f32x4*)(out + off + bj * HALF + n * 16) = x;
                        typedef unsigned u32x2v __attribute__((ext_vector_type(2))); u32x2v w; w.x = cvt_pk_bf16(x[0], x[1]); w.y = cvt_pk_bf16(x[2], x[3]); *(u32x2v*)(hb + off + bj * HALF + n * 16) = w;
                        s += (x[0] * x[0] + x[1] * x[1]) + (x[2] * x[2] + x[3] * x[3]); }
                s += __shfl_xor(s, 16); s += __shfl_xor(s, 32);
                if (fq == 0) ss[(size_t)row * 16 + u.pn * 4 + wc] = s; }
    }
};
struct EpiBf16RowScale {
    static constexpr bool PERM = true, AFTER_DRAIN = false;
    bf16_t* O; int ldc; const float* ss; float eps;
    __device__ __forceinline__ void operator()(const f32x4 (&acc)[2][2][4][2], const Unit& u, int wr, int wc, int fr, int fq) const {
        const int row0 = u.pm * BM + wr * 64 + fr, col0 = u.pn * BM + wc * 32 + 8 * fq;
#pragma unroll
        for (int ai = 0; ai < 2; ++ai)
#pragma unroll
            for (int m = 0; m < 4; ++m) { const int row = row0 + ai * HALF + m * 16; const f32x4* sp = (const f32x4*)(ss + (size_t)row * 16);
                const f32x4 a = sp[0], b = sp[1], c = sp[2], d = sp[3];
                const float t = ((a[0] + a[1]) + (a[2] + a[3])) + ((b[0] + b[1]) + (b[2] + b[3])) + ((c[0] + c[1]) + (c[2] + c[3])) + ((d[0] + d[1]) + (d[2] + d[3]));
                const float rs = 1.0f / sqrtf(t * (1.0f / 1024.0f) + eps);
                bf16_t* rowp = O + (size_t)row * ldc + col0;
#pragma unroll
                for (int bj = 0; bj < 2; ++bj) { const f32x4 v0 = acc[ai][bj][m][0] * rs, v1 = acc[ai][bj][m][1] * rs;
                    u32x4 w; w.x = cvt_pk_bf16(v0[0], v0[1]); w.y = cvt_pk_bf16(v0[2], v0[3]); w.z = cvt_pk_bf16(v1[0], v1[1]); w.w = cvt_pk_bf16(v1[2], v1[3]);
                    *(u32x4*)(rowp + bj * HALF) = w; } }
    }
};
}

namespace pg8 {
template <bool BASE_BF16> struct EpiResB {
    static constexpr bool PERM = true, AFTER_DRAIN = false;
    const void* base; bf16_t* hb; float* ss; int ldc;
    __device__ __forceinline__ void operator()(const f32x4 (&acc)[2][2][4][2], const Unit& u, int wr, int wc, int fr, int fq) const {
        const int row0 = u.pm * BM + wr * 64 + fr, col0 = u.pn * BM + wc * 32 + 8 * fq;
#pragma unroll
        for (int ai = 0; ai < 2; ++ai)
#pragma unroll
            for (int m = 0; m < 4; ++m) { const int row = row0 + ai * HALF + m * 16; const size_t off = (size_t)row * ldc + col0; float s = 0.f;
#pragma unroll
                for (int bj = 0; bj < 2; ++bj) { f32x4 b0, b1;
                    if (BASE_BF16) { const u32x4 w = *(const u32x4*)((const bf16_t*)base + off + bj * HALF);
                        b0 = (f32x4){__uint_as_float(w.x << 16), __uint_as_float(w.x & 0xffff0000u), __uint_as_float(w.y << 16), __uint_as_float(w.y & 0xffff0000u)};
                        b1 = (f32x4){__uint_as_float(w.z << 16), __uint_as_float(w.z & 0xffff0000u), __uint_as_float(w.w << 16), __uint_as_float(w.w & 0xffff0000u)}; }
                    else { b0 = *(const f32x4*)((const float*)base + off + bj * HALF); b1 = *(const f32x4*)((const float*)base + off + bj * HALF + 4); }
                    const f32x4 x0 = b0 + acc[ai][bj][m][0], x1 = b1 + acc[ai][bj][m][1];
                    u32x4 w; w.x = cvt_pk_bf16(x0[0], x0[1]); w.y = cvt_pk_bf16(x0[2], x0[3]); w.z = cvt_pk_bf16(x1[0], x1[1]); w.w = cvt_pk_bf16(x1[2], x1[3]);
                    *(u32x4*)(hb + off + bj * HALF) = w;
                    s += ((x0[0] * x0[0] + x0[1] * x0[1]) + (x0[2] * x0[2] + x0[3] * x0[3])) + ((x1[0] * x1[0] + x1[1] * x1[1]) + (x1[2] * x1[2] + x1[3] * x1[3])); }
                s += __shfl_xor(s, 16); s += __shfl_xor(s, 32);
                if (fq == 0) ss[(size_t)row * 16 + u.pn * 4 + wc] = s; }
    }
};
}

constexpr int NWAVES = 8;
constexpr int BATCH = 8, SEQ = 2048, DM = 1024, M = BATCH * SEQ, MEMLEN = 256, MM = BATCH * MEMLEN;
constexpr int INCOLS = 3088;
constexpr int N1 = 3328;
constexpr int PQ = 0, PK = 256, PV = 512, POG = 1024, PSQ = 1536, PSK = 2048, PSV = 2560, PGATE = 3072;
constexpr int PEER_N = 16384;
constexpr float EPS = 1e-6f;

constexpr size_t MiB = 1u << 20;
constexpr size_t WS_CTL = 0, CTL_ZERO_BYTES = 1 * MiB;
constexpr size_t WS_W1T = 1 * MiB;
constexpr size_t WS_WOT = 8 * MiB, WS_WXQT = 10 * MiB, WS_WXOT = 12 * MiB, WS_WXKVT = 14 * MiB, WS_WPQT = 18 * MiB, WS_SUBK = 22 * MiB;
constexpr size_t WS_UB = 24 * MiB, WS_VB = 56 * MiB;
constexpr size_t WS_BUFA = 88 * MiB;
constexpr size_t WS_MN = 120 * MiB;
constexpr size_t WS_KV = 124 * MiB;
constexpr size_t WS_PROJ = 132 * MiB;
constexpr size_t WS_SLOT0 = 132 * MiB, WS_SLOT1 = 164 * MiB, WS_SLOT2 = 196 * MiB, WS_VT = 76 * MiB, WS_END = 236 * MiB;
constexpr int CW_BAR = 4096;
constexpr int CW_SBSS = 32768;

constexpr int RING_BYTES = 131072;
constexpr int LDSCTL_OFF = RING_BYTES, MISC_OFF = LDSCTL_OFF + 320;
constexpr int LDS_BYTES = 147456;

#define GAS __attribute__((address_space(1)))
#define LAS __attribute__((address_space(3)))
typedef unsigned short bf16;
typedef unsigned v4u __attribute__((ext_vector_type(4)));
typedef float f32x4 __attribute__((ext_vector_type(4)));
typedef short bf16x8 __attribute__((ext_vector_type(8)));
typedef GAS unsigned gu32;
typedef GAS unsigned long long gu64;
#define RLX_AGENT __ATOMIC_RELAXED, __HIP_MEMORY_SCOPE_AGENT
#define LDS_WAIT() asm volatile("s_waitcnt lgkmcnt(0)" ::: "memory")
#define VM_WAIT() asm volatile("s_waitcnt vmcnt(0)" ::: "memory")
__device__ __forceinline__ unsigned long long rt() { return __builtin_amdgcn_s_memrealtime(); }
__device__ __forceinline__ unsigned f2bf(float f) { unsigned u = __builtin_bit_cast(unsigned, f); return (u + 0x7fffu + ((u >> 16) & 1u)) >> 16; }
__device__ __forceinline__ unsigned pk2(float lo, float hi) { return f2bf(lo) | (f2bf(hi) << 16); }

#define XB_TMO      128
#define XB_XCNT(j)  (256  + 64 * (j))
#define XB_XSUB(j)  (1280 + 64 * (j))
#define XB_XGEN(j)  (2304 + 64 * (j))
#define XB_TOP      3328
#define XB_TOPGEN   3392
#define XCD_BAR_WORDS 3456
#define XB_SPIN_CAP (1u << 22)

__device__ __forceinline__ unsigned xb_ld(unsigned* p)              { return __hip_atomic_load(p, __ATOMIC_RELAXED, __HIP_MEMORY_SCOPE_AGENT); }
__device__ __forceinline__ unsigned xb_add(unsigned* p, unsigned v) { return __hip_atomic_fetch_add(p, v, __ATOMIC_RELAXED, __HIP_MEMORY_SCOPE_AGENT); }
__device__ __forceinline__ unsigned xb_xcc_id() { return (unsigned)__builtin_amdgcn_s_getreg((3 << 11) | 20) & 0xFu; }
#define XB_SPIN(cond, bar) do { unsigned _sp = 0; while (cond) { __builtin_amdgcn_s_sleep(1); \
    if ((++_sp & 255u) == 0u) { if (xb_ld(&(bar)[XB_TMO])) break; if (_sp > XB_SPIN_CAP) { atomicAdd(&(bar)[XB_TMO], 1u); break; } } } } while (0)

struct XcdBarrier {
    unsigned* bar; unsigned x;
    volatile LAS unsigned* st;
};

__device__ __forceinline__ XcdBarrier xcd_barrier_post(unsigned* bar, volatile LAS unsigned* st) {
    XcdBarrier b; b.bar = bar; b.x = xb_xcc_id(); b.st = st;
    if (threadIdx.x == 0) (void)xb_add(&bar[XB_XCNT(b.x)], 1u);
    return b;
}
__device__ __forceinline__ void xcd_barrier_complete(unsigned* bar, unsigned x, unsigned& nloc, unsigned& nx) {
    const unsigned G = gridDim.x * gridDim.y * gridDim.z;
    unsigned sum, cnt, mine, sp = 0u;
    for (;;) {
        sum = 0u; cnt = 0u; mine = 0u;
#pragma unroll
        for (unsigned j = 0; j < 16; ++j) { const unsigned c = xb_ld(&bar[XB_XCNT(j)]); sum += c; cnt += (c > 0u) ? 1u : 0u; mine = (j == x) ? c : mine; }
        if (sum == G) break;
        __builtin_amdgcn_s_sleep(1);
        if ((++sp & 255u) == 0u) { if (xb_ld(&bar[XB_TMO])) break; if (sp > XB_SPIN_CAP) { atomicAdd(&bar[XB_TMO], 1u); break; } }
    }
    nloc = mine > 0u ? mine : 1u; nx = cnt > 0u ? cnt : 1u;
}

__device__ __forceinline__ void xcd_barrier(const XcdBarrier& b) {
    asm volatile("s_waitcnt vmcnt(0)" ::: "memory");
    __syncthreads();
    if (threadIdx.x == 0) {
        unsigned* bar = b.bar;
        __builtin_amdgcn_s_waitcnt(0);
        unsigned nloc = b.st[0], nx = b.st[1];
        if (nloc == 0u) { xcd_barrier_complete(bar, b.x, nloc, nx); b.st[0] = nloc; b.st[1] = nx; }
        const unsigned old = xb_add(&bar[XB_XSUB(b.x)], 1u);
        const unsigned gen = old / nloc;
        if (old + 1u == (gen + 1u) * nloc) {
            __builtin_amdgcn_fence(__ATOMIC_RELEASE, "agent");
            asm volatile("s_waitcnt vmcnt(0)" ::: "memory");
            const unsigned og = xb_add(&bar[XB_TOP], 1u);
            const unsigned tg = og / nx;
            if (og + 1u == (tg + 1u) * nx) xb_add(&bar[XB_TOPGEN], 1u);
            else XB_SPIN(xb_ld(&bar[XB_TOPGEN]) == tg, bar);
            __builtin_amdgcn_fence(__ATOMIC_ACQUIRE, "agent");
            xb_add(&bar[XB_XGEN(b.x)], 1u);
            asm volatile("s_waitcnt vmcnt(0)" ::: "memory");
        } else {
            XB_SPIN(xb_ld(&bar[XB_XGEN(b.x)]) == gen, bar);
            __builtin_amdgcn_fence(__ATOMIC_ACQUIRE, "agent");
            asm volatile("s_waitcnt vmcnt(0)" ::: "memory");
        }
    }
    __syncthreads();
}

#define DI __device__ __forceinline__
typedef __bf16 bf16x2_t __attribute__((ext_vector_type(2)));
struct Args { const float* in[21]; float* out; unsigned char* ws; int ph_lo, ph_hi, li, pad; };
struct Frame {
    LAS unsigned char* lds;
    volatile LAS unsigned* MISC;
    gu32* ctl;
    int tid, lane, wave;
    int vcu, G;
    unsigned char* ws; float* out;
};
#define WSP(off) ((bf16*)(F.ws + (off)))
#define F_W1T WSP(WS_W1T)
#define F_WOT WSP(WS_WOT)
#define F_WXQT WSP(WS_WXQT)
#define F_WXOT WSP(WS_WXOT)
#define F_WXKVT WSP(WS_WXKVT)
#define F_WPQT WSP(WS_WPQT)
#define F_SUBK WSP(WS_SUBK)
#define F_UB WSP(WS_UB)
#define F_VB WSP(WS_VB)
#define F_BUFA WSP(WS_BUFA)
#define F_MN WSP(WS_MN)
#define F_KV WSP(WS_KV)
#define F_PROJ WSP(WS_PROJ)
#define F_SLOT0 WSP(WS_SLOT0)
#define F_SLOT1 WSP(WS_SLOT1)
#define F_SLOT2 WSP(WS_SLOT2)
#define F_VT WSP(WS_VT)
DI float bf2f(unsigned v) { return __uint_as_float(v << 16); }
DI float bflo(unsigned w) { return __uint_as_float(w << 16); }
DI float bfhi(unsigned w) { return __uint_as_float(w & 0xffff0000u); }
DI float wave_sum(float v) {
#pragma unroll
    for (int o = 1; o < 64; o <<= 1) v += __shfl_xor(v, o);
    return v;
}
DI float wave_max(float v) {
#pragma unroll
    for (int o = 1; o < 64; o <<= 1) v = fmaxf(v, __shfl_xor(v, o));
    return v;
}
DI float dot2_bf16(unsigned w, unsigned x, float a) { return __builtin_amdgcn_fdot2_f32_bf16(__builtin_bit_cast(bf16x2_t, w), __builtin_bit_cast(bf16x2_t, x), a, false); }
DI float silu_f(float x) { return x * __builtin_amdgcn_rcpf(1.f + __expf(-x)); }
DI float log_sigmoid_f(float z) { return fminf(z, 0.f) - __logf(1.f + __expf(-fabsf(z))); }
DI float gelu_tanh_f(float x) { const float y = 0.7978845608028654f * (x + 0.044715f * x * x * x); const float t = 1.f - 2.f / (1.f + __expf(2.f * y)); return 0.5f * x * (1.f + t); }

DI void p0_transpose_item(const float* W, int ldw, int c0, bf16* WT, int row_off, LAS float* scr, int kb, int nb, int lane, const float* kgain = nullptr) {
    const int k0 = 64 * kb, n0 = 32 * nb;
#pragma unroll 8
    for (int i = 0; i < 32; ++i) { const int kk = 2 * i + (lane >> 5); scr[kk * 33 + (lane & 31)] = W[(size_t)(k0 + kk) * ldw + c0 + n0 + (lane & 31)] * (kgain ? kgain[k0 + kk] : 1.f); }
    LDS_WAIT(); asm volatile("" ::: "memory");
    const int c = lane & 7;
#pragma unroll
    for (int j = 0; j < 4; ++j) { const int n = (lane >> 3) + 8 * j; const LAS float* s = scr + (8 * c) * 33 + n;
        v4u o; o.x = pk2(s[0 * 33], s[1 * 33]); o.y = pk2(s[2 * 33], s[3 * 33]); o.z = pk2(s[4 * 33], s[5 * 33]); o.w = pk2(s[6 * 33], s[7 * 33]);
        *(GAS v4u*)(WT + (size_t)(row_off + n0 + n) * 1024 + k0 + 8 * c) = o; }
    LDS_WAIT(); asm volatile("" ::: "memory");
}
DI void rms_row_to_bf16(int lane, const float* xrow, const float* g, bf16* orow) {
    const GAS f32x4* xr = (const GAS f32x4*)xrow + lane; const GAS f32x4* gr = (const GAS f32x4*)g + lane;
    f32x4 v[4]; float s = 0.f;
#pragma unroll
    for (int j = 0; j < 4; ++j) { v[j] = xr[64 * j]; s += (v[j].x * v[j].x + v[j].y * v[j].y) + (v[j].z * v[j].z + v[j].w * v[j].w); }
    const float rs = 1.f / sqrtf(wave_sum(s) * (1.f / 1024.f) + EPS);
    GAS unsigned long long* o8 = (GAS unsigned long long*)orow + lane;
#pragma unroll
    for (int j = 0; j < 4; ++j) { const f32x4 gg = gr[64 * j]; const f32x4 y = v[j] * rs * gg; o8[64 * j] = (unsigned long long)pk2(y.x, y.y) | ((unsigned long long)pk2(y.z, y.w) << 32); }
}
typedef float f32x2 __attribute__((ext_vector_type(2)));
constexpr size_t WS_U8 = 24 * MiB, WS_V8 = 40 * MiB, WS_X8 = 56 * MiB, WS_SU = 72 * MiB, WS_SX = 72 * MiB + 65536;
template <int CTRL> DI int dpp_i(int v) { return __builtin_amdgcn_update_dpp(0, v, CTRL, 0xf, 0xf, false); }
DI void quant_row_i8(int lane, const float* src, unsigned char* dst, float* scale_out) {
    f32x4 v[4]; float m = 0.f;
#pragma unroll
    for (int j = 0; j < 4; ++j) { v[j] = *(const GAS f32x4*)(src + 16 * lane + 4 * j); m = fmaxf(m, fmaxf(fmaxf(fabsf(v[j].x), fabsf(v[j].y)), fmaxf(fabsf(v[j].z), fabsf(v[j].w)))); }
    m = wave_max(m);
    const float sc = m > 0.f ? m * (1.f / 127.f) : 1.f, inv = 1.f / sc;
    v4u o;
#pragma unroll
    for (int j = 0; j < 4; ++j) { const int a = (int)rintf(v[j].x * inv), b = (int)rintf(v[j].y * inv), c = (int)rintf(v[j].z * inv), d = (int)rintf(v[j].w * inv);
        o[j] = (unsigned)(a & 255) | ((unsigned)(b & 255) << 8) | ((unsigned)(c & 255) << 16) | ((unsigned)(d & 255) << 24); }
    *(GAS v4u*)(dst + 16 * lane) = o;
    if (lane == 0) *scale_out = sc;
}
DI void quant_row_fp8(int lane, const float* src, unsigned char* dst) {
    v4u o;
#pragma unroll
    for (int j = 0; j < 4; ++j) { const f32x4 v = *(const GAS f32x4*)(src + 16 * lane + 4 * j) * 64.f;
        int pk = __builtin_amdgcn_cvt_pk_fp8_f32(v.x, v.y, 0, false); pk = __builtin_amdgcn_cvt_pk_fp8_f32(v.z, v.w, pk, true); o[j] = (unsigned)pk; }
    *(GAS v4u*)(dst + 16 * lane) = o;
}
DI void rms_row_to_bf16_i8(int lane, const float* xrow, const float* g, bf16* orow, unsigned char* qrow, float* sx) {
    const GAS f32x4* xr = (const GAS f32x4*)xrow + lane; const GAS f32x4* gr = (const GAS f32x4*)g + lane;
    f32x4 v[4]; float s = 0.f;
#pragma unroll
    for (int j = 0; j < 4; ++j) { v[j] = xr[64 * j]; s += (v[j].x * v[j].x + v[j].y * v[j].y) + (v[j].z * v[j].z + v[j].w * v[j].w); }
    const float rs = 1.f / sqrtf(wave_sum(s) * (1.f / 1024.f) + EPS);
    GAS unsigned long long* o8 = (GAS unsigned long long*)orow + lane; float m = 0.f;
#pragma unroll
    for (int j = 0; j < 4; ++j) { const f32x4 gg = gr[64 * j]; v[j] = v[j] * rs * gg; o8[64 * j] = (unsigned long long)pk2(v[j].x, v[j].y) | ((unsigned long long)pk2(v[j].z, v[j].w) << 32);
        m = fmaxf(m, fmaxf(fmaxf(fabsf(v[j].x), fabsf(v[j].y)), fmaxf(fabsf(v[j].z), fabsf(v[j].w)))); }
    m = wave_max(m);
    const float sc = m > 0.f ? m * (1.f / 127.f) : 1.f, inv = 1.f / sc;
#pragma unroll
    for (int j = 0; j < 4; ++j) { const int a = (int)rintf(v[j].x * inv), b = (int)rintf(v[j].y * inv), c = (int)rintf(v[j].z * inv), d = (int)rintf(v[j].w * inv);
        *(GAS unsigned*)(qrow + 4 * lane + 256 * j) = (unsigned)(a & 255) | ((unsigned)(b & 255) << 8) | ((unsigned)(c & 255) << 16) | ((unsigned)(d & 255) << 24); }
    if (lane == 0) *sx = sc;
}
DI void p0_prologue(Frame& F, const Args& A) {
    LAS float* scr = (LAS float*)(F.lds + F.wave * 16384);
    const int gw = F.vcu * NWAVES + F.wave, NGW = F.G * NWAVES;
    constexpr int I_IN = 16 * 48, I_W2 = 16 * 64;
    constexpr int NIT = 2 * I_IN + I_W2;
    for (int it = gw; it < NIT; it += NGW) {
        int r = it;
        if (r < I_IN) { p0_transpose_item(A.in[3], INCOLS, 0, F_W1T, 0, scr, r / 48, r % 48, F.lane); continue; } r -= I_IN;
        if (r < I_IN) { p0_transpose_item(A.in[3], INCOLS, 1552, F_W1T, 1536, scr, r / 48, r % 48, F.lane); continue; } r -= I_IN;
        p0_transpose_item(A.in[13], 2048, 0, F_WXKVT, 0, scr, r / 64, r % 64, F.lane);
    }
    const int gt = gw * 64 + F.lane, NGT = NGW * 64;
    for (int i = gt; i < 256 * 128; i += NGT) {
        const int n = i >> 7, k0 = (i & 127) * 8;
        float gv[16];
#pragma unroll
        for (int r = 0; r < 16; ++r) gv[r] = A.in[5][r * 256 + n];
        float s[8];
#pragma unroll
        for (int j = 0; j < 8; ++j) { const float* wr_ = A.in[3] + (size_t)(k0 + j) * INCOLS + 1536; float a = 0.f;
#pragma unroll
            for (int r = 0; r < 16; ++r) a += wr_[r] * gv[r];
            s[j] = a; }
        v4u o; o.x = pk2(s[0], s[1]); o.y = pk2(s[2], s[3]); o.z = pk2(s[4], s[5]); o.w = pk2(s[6], s[7]);
        *(GAS v4u*)(F_W1T + (size_t)(3072 + n) * 1024 + k0) = o;
    }
    for (int m = gw; m < M; m += NGW) rms_row_to_bf16(F.lane, A.in[0] + (size_t)m * DM, A.in[2], F_BUFA + (size_t)m * DM);
    for (int m = gw; m < MM; m += NGW) rms_row_to_bf16(F.lane, A.in[1] + (size_t)m * DM, A.in[11], F_MN + (size_t)m * DM);
}
DI void p0_late(Frame& F, const Args& A, int widx, int nw) {
    LAS float* scr = (LAS float*)(F.lds + F.wave * 16384);
    constexpr int I_SQ = 16 * 32, I_W2 = 16 * 64;
    for (int it = widx; it < 3 * I_SQ + I_W2; it += nw) {
        int r = it;
        if (r < I_SQ) { p0_transpose_item(A.in[9], 1024, 0, F_WOT, 0, scr, r / 32, r % 32, F.lane); continue; } r -= I_SQ;
        if (r < I_SQ) { p0_transpose_item(A.in[12], 1024, 0, F_WXQT, 0, scr, r / 32, r % 32, F.lane, A.in[10]); continue; } r -= I_SQ;
        if (r < I_SQ) { p0_transpose_item(A.in[14], 1024, 0, F_WXOT, 0, scr, r / 32, r % 32, F.lane); continue; } r -= I_SQ;
        p0_transpose_item(A.in[16], 2048, 0, F_WPQT, 0, scr, r / 64, r % 64, F.lane, A.in[15]);
    }
    for (int i = widx * 64 + F.lane; i < 32768; i += nw * 64) {
        const f32x4 a = *(const GAS f32x4*)(A.in[17] + (size_t)i * 8), b = *(const GAS f32x4*)(A.in[17] + (size_t)i * 8 + 4);
        v4u o; o.x = pk2(a.x, a.y); o.y = pk2(a.z, a.w); o.z = pk2(b.x, b.y); o.w = pk2(b.z, b.w);
        *(GAS v4u*)(F_SUBK + (size_t)i * 8) = o;
    }
    for (int m = widx; m < PEER_N; m += nw) {
        quant_row_i8(F.lane, A.in[18] + (size_t)m * DM, F.ws + WS_U8 + (size_t)m * 1024, (float*)(F.ws + WS_SU) + m);
        quant_row_fp8(F.lane, A.in[19] + (size_t)m * DM, F.ws + WS_V8 + (size_t)m * 1024);
    }
}

DI void gla_naive_item(Frame& F, const Args& A, float* OGLA, int b, int h, int eg) {
    const int lane = F.lane, e = eg * 8 + F.wave;
    const int cq = PQ + h * 64 + lane, ck = PK + h * 64 + lane, cv = PV + h * 128 + e, cg = PGATE + h * 64 + lane;
    float wq[4], wk[4], wv[4];
#pragma unroll
    for (int k = 0; k < 4; ++k) { wq[k] = A.in[4][k * 1024 + cq]; wk[k] = A.in[4][k * 1024 + ck]; wv[k] = A.in[4][k * 1024 + cv]; }
    const float bias = A.in[6][h * 64 + lane];
    float rq0 = 0.f, rq1 = 0.f, rq2 = 0.f, rk0 = 0.f, rk1 = 0.f, rk2 = 0.f, rv0 = 0.f, rv1 = 0.f, rv2 = 0.f, S = 0.f;
    for (int t0 = 0; t0 < SEQ; t0 += 8) {
        unsigned lq[8], lk[8], lv[8], lg[8];
#pragma unroll
        for (int j = 0; j < 8; ++j) { const bf16* base = F_PROJ + (size_t)(b * SEQ + t0 + j) * N1; lq[j] = base[cq]; lk[j] = base[ck]; lv[j] = base[cv]; lg[j] = base[cg]; }
#pragma unroll
        for (int j = 0; j < 8; ++j) {
            const float xq = bf2f(lq[j]), xk = bf2f(lk[j]), xv = bf2f(lv[j]);
            const float q = silu_f(wq[0] * rq0 + wq[1] * rq1 + wq[2] * rq2 + wq[3] * xq) * 0.125f; rq0 = rq1; rq1 = rq2; rq2 = xq;
            const float k = silu_f(wk[0] * rk0 + wk[1] * rk1 + wk[2] * rk2 + wk[3] * xk); rk0 = rk1; rk1 = rk2; rk2 = xk;
            const float v = silu_f(wv[0] * rv0 + wv[1] * rv1 + wv[2] * rv2 + wv[3] * xv); rv0 = rv1; rv1 = rv2; rv2 = xv;
            const float a = __expf(log_sigmoid_f(bf2f(lg[j]) + bias) * (1.f / 16.f));
            S = a * S + k * v;
            const float o = wave_sum(q * S);
            if (lane == 0) OGLA[(size_t)(b * SEQ + t0 + j) * 512 + h * 128 + e] = o;
        }
    }
}
DI void sb_naive_item(Frame& F, float* OSB, int b, int h, int qb) {
    LAS float* Ks = (LAS float*)F.lds; LAS float* Vs = Ks + 64 * 64;
    const int tid = F.tid, t = qb * 512 + tid; const size_t row = (size_t)b * SEQ + t;
    float q[64], acc[64];
    {
        const GAS v4u* qp = (const GAS v4u*)(F_PROJ + row * N1 + PSQ + h * 64);
#pragma unroll
        for (int c = 0; c < 8; ++c) { const v4u w = qp[c]; q[8 * c + 0] = bflo(w.x) * 0.125f; q[8 * c + 1] = bfhi(w.x) * 0.125f; q[8 * c + 2] = bflo(w.y) * 0.125f; q[8 * c + 3] = bfhi(w.y) * 0.125f;
            q[8 * c + 4] = bflo(w.z) * 0.125f; q[8 * c + 5] = bfhi(w.z) * 0.125f; q[8 * c + 6] = bflo(w.w) * 0.125f; q[8 * c + 7] = bfhi(w.w) * 0.125f; }
    }
#pragma unroll
    for (int d = 0; d < 64; ++d) acc[d] = 0.f;
    float carry = 0.f;
    for (int kt = qb * 8 + 7; kt >= 0; --kt) {
        __syncthreads();
        {
            const int key = tid >> 3, ch = tid & 7; const size_t krow = (size_t)b * SEQ + kt * 64 + key;
            const v4u kw = *(const GAS v4u*)(F_PROJ + krow * N1 + PSK + h * 64 + ch * 8), vw = *(const GAS v4u*)(F_PROJ + krow * N1 + PSV + h * 64 + ch * 8);
            LAS f32x4* kd = (LAS f32x4*)(Ks + key * 64 + ch * 8); LAS f32x4* vd = (LAS f32x4*)(Vs + key * 64 + ch * 8);
            kd[0] = (f32x4){bflo(kw.x), bfhi(kw.x), bflo(kw.y), bfhi(kw.y)}; kd[1] = (f32x4){bflo(kw.z), bfhi(kw.z), bflo(kw.w), bfhi(kw.w)};
            vd[0] = (f32x4){bflo(vw.x), bfhi(vw.x), bflo(vw.y), bfhi(vw.y)}; vd[1] = (f32x4){bflo(vw.z), bfhi(vw.z), bflo(vw.w), bfhi(vw.w)};
        }
        __syncthreads();
        for (int j = 63; j >= 0; --j) {
            const int s = kt * 64 + j;
            if (s < t) {
                const LAS f32x4* kr = (const LAS f32x4*)(Ks + j * 64); const LAS f32x4* vr = (const LAS f32x4*)(Vs + j * 64);
                float z0 = 0.f, z1 = 0.f, z2 = 0.f, z3 = 0.f;
#pragma unroll
                for (int c = 0; c < 16; ++c) { const f32x4 kk = kr[c]; z0 += q[4 * c] * kk.x; z1 += q[4 * c + 1] * kk.y; z2 += q[4 * c + 2] * kk.z; z3 += q[4 * c + 3] * kk.w; }
                const float z = (z0 + z1) + (z2 + z3);
                const float lb = log_sigmoid_f(z);
                const float w = __expf(lb + carry);
                carry += lb - z;
#pragma unroll
                for (int c = 0; c < 16; ++c) { const f32x4 vv = vr[c]; acc[4 * c] += w * vv.x; acc[4 * c + 1] += w * vv.y; acc[4 * c + 2] += w * vv.z; acc[4 * c + 3] += w * vv.w; }
            }
        }
    }
    GAS f32x4* op = (GAS f32x4*)(OSB + row * 512 + h * 64);
#pragma unroll
    for (int c = 0; c < 16; ++c) op[c] = (f32x4){acc[4 * c], acc[4 * c + 1], acc[4 * c + 2], acc[4 * c + 3]};
}
typedef float f32x16 __attribute__((ext_vector_type(16)));
typedef short s16x4 __attribute__((ext_vector_type(4)));
DI s16x4 lds_tr16(const LAS unsigned char* p) { return __builtin_bit_cast(s16x4, __builtin_amdgcn_ds_read_tr16_b64_v4i16((LAS s16x4*)p)); }
DI unsigned cvtpk_bf16(float lo, float hi) { typedef float f2 __attribute__((ext_vector_type(2))); f2 v = {lo, hi}; bf16x2_t b = __builtin_convertvector(v, bf16x2_t); return __builtin_bit_cast(unsigned, b); }
constexpr float SB_C2 = 0.125f * 1.4426950408889634f;
template <bool MASKED> DI void sb_weights(f32x16& P0, f32x16& P1, float& carry, int hi, int qrel2) {
    float T[8], cs[8];
#pragma unroll
    for (int pi = 0; pi < 2; ++pi) {
        f32x16& P = pi ? P1 : P0;
#pragma unroll
        for (int g = 0; g < 4; ++g) {
            float lbv[4], l1v[4];
#pragma unroll
            for (int i = 0; i < 4; ++i) {
                const float z2 = P[4 * g + i] * SB_C2;
                const float sp = __builtin_amdgcn_logf(1.f + __builtin_amdgcn_exp2f(-fabsf(z2)));
                float lb = fminf(z2, 0.f) - sp, l1 = lb - z2;
                if (MASKED) { const bool valid = (32 * pi + 8 * g + 4 * hi + i) < qrel2; lb = valid ? lb : -INFINITY; l1 = valid ? l1 : 0.f; }
                lbv[i] = lb; l1v[i] = l1;
            }
            const float a = l1v[3], b = a + l1v[2], c = b + l1v[1];
            cs[4 * pi + g] = c + l1v[0];
            P[4 * g + 3] = lbv[3]; P[4 * g + 2] = lbv[2] + a; P[4 * g + 1] = lbv[1] + b; P[4 * g + 0] = lbv[0] + c;
        }
    }
#pragma unroll
    for (int k = 0; k < 8; ++k) { auto rr = __builtin_amdgcn_permlane32_swap(__float_as_uint(cs[k]), __float_as_uint(cs[k]), false, false); T[k] = __uint_as_float(rr[0]) + __uint_as_float(rr[1]); }
    const float m0 = hi ? 0.f : 1.f;
    float run = carry;
#pragma unroll
    for (int k = 7; k >= 0; --k) {
        const float E = run + m0 * (T[k] - cs[k]);
        f32x16& P = (k >> 2) ? P1 : P0; const int g = k & 3;
#pragma unroll
        for (int i = 0; i < 4; ++i) P[4 * g + i] = __builtin_amdgcn_exp2f(P[4 * g + i] + E);
        run += T[k];
    }
    carry = run;
}
DI void sb_unit(Frame& F, float* OSB, int b, int h, int qb) {
    const int tid = F.tid, lane = F.lane, wid = F.wave, r32 = lane & 31, hi = lane >> 5;
    const int q0 = qb * 256; const size_t rowbase = (size_t)b * SEQ;
    const bf16* Kg = F_PROJ + rowbase * N1 + PSK + h * 64;
    const bf16* Vg = F_PROJ + rowbase * N1 + PSV + h * 64;
    bf16x8 qr[4];
    { const bf16* Qw = F_PROJ + (rowbase + q0 + wid * 32 + r32) * N1 + PSQ + h * 64;
#pragma unroll
      for (int ks = 0; ks < 4; ++ks) qr[ks] = *(const GAS bf16x8*)(Qw + ks * 16 + hi * 8); }
    const bf16* ksrc = Kg + (size_t)(tid >> 3) * N1 + (tid & 7) * 8;
    const bf16* vsrc = Vg + (size_t)(16 * (wid & 3) + (lane >> 2)) * N1 + (wid >> 2) * 32 + (lane & 3) * 8;
    const int kdst = (tid & 7) * 1024 + (tid >> 3) * 16, vdst = 8192 + wid * 1024 + lane * 16;
    const int kfr = hi * 1024 + r32 * 16;
    const int vfr = 8192 + ((lane >> 4) & 1) * 32 + (lane & 3) * 8 + (4 * hi + ((lane & 15) >> 2)) * 64;
    f32x16 o0 = {}, o1 = {};
    float carry = 0.f;
    const int ktmax = (q0 >> 6) + 3;
    v4u kreg = *(const GAS v4u*)(ksrc + (size_t)ktmax * 64 * N1), vreg = *(const GAS v4u*)(vsrc + (size_t)ktmax * 64 * N1);
    __syncthreads();
    *(LAS v4u*)(F.lds + kdst) = kreg; *(LAS v4u*)(F.lds + vdst) = vreg;
    __syncthreads();
    int cur = 0;
    const int wrow0 = q0 + wid * 32;
    bool wdone = false;
    LAS unsigned* flags = (LAS unsigned*)(F.lds + 32768);
    for (int kt = ktmax; kt >= 0; --kt) {
        if (kt > 0) { kreg = *(const GAS v4u*)(ksrc + (size_t)(kt - 1) * 64 * N1); vreg = *(const GAS v4u*)(vsrc + (size_t)(kt - 1) * 64 * N1); }
        const int k0 = kt * 64;
        if (!wdone && k0 <= wrow0 + 30) {
            const LAS unsigned char* Kb = F.lds + cur * 16384;
            f32x16 P0 = {}, P1 = {};
#pragma unroll
            for (int ks = 0; ks < 4; ++ks) {
                const bf16x8 a0 = *(const LAS bf16x8*)(Kb + kfr + ks * 2048), a1 = *(const LAS bf16x8*)(Kb + kfr + ks * 2048 + 512);
                P0 = __builtin_amdgcn_mfma_f32_32x32x16_bf16(a0, qr[ks], P0, 0, 0, 0);
                P1 = __builtin_amdgcn_mfma_f32_32x32x16_bf16(a1, qr[ks], P1, 0, 0, 0);
            }
            if (k0 + 63 >= wrow0) sb_weights<true>(P0, P1, carry, hi, wrow0 + r32 - k0);
            else sb_weights<false>(P0, P1, carry, hi, 0);
#pragma unroll
            for (int s = 0; s < 4; ++s) {
                const f32x16& P = (s >> 1) ? P1 : P0; const int rb = (s & 1) * 8;
                v4u pw; pw.x = cvtpk_bf16(P[rb + 0], P[rb + 1]); pw.y = cvtpk_bf16(P[rb + 2], P[rb + 3]); pw.z = cvtpk_bf16(P[rb + 4], P[rb + 5]); pw.w = cvtpk_bf16(P[rb + 6], P[rb + 7]);
                const bf16x8 pa = __builtin_bit_cast(bf16x8, pw);
                const LAS unsigned char* vp = Kb + vfr + s * 1024;
                const s16x4 l0 = lds_tr16(vp), h0 = lds_tr16(vp + 512), l1 = lds_tr16(vp + 4096), h1 = lds_tr16(vp + 4096 + 512);
                const bf16x8 v0 = {l0[0], l0[1], l0[2], l0[3], h0[0], h0[1], h0[2], h0[3]}, v1 = {l1[0], l1[1], l1[2], l1[3], h1[0], h1[1], h1[2], h1[3]};
                o0 = __builtin_amdgcn_mfma_f32_32x32x16_bf16(pa, v0, o0, 0, 0, 0);
                o1 = __builtin_amdgcn_mfma_f32_32x32x16_bf16(pa, v1, o1, 0, 0, 0);
            }
            wdone = __all(carry < -160.f);
        }
        if (lane == 0) flags[(kt & 1) * 8 + wid] = wdone ? 1u : 0u;
        if (kt > 0) { *(LAS v4u*)(F.lds + (cur ^ 1) * 16384 + kdst) = kreg; *(LAS v4u*)(F.lds + (cur ^ 1) * 16384 + vdst) = vreg; }
        __syncthreads();
        cur ^= 1;
        { const v4u f0 = *(const LAS v4u*)(flags + (kt & 1) * 8), f1 = *(const LAS v4u*)(flags + (kt & 1) * 8 + 4);
          if ((f0.x & f0.y & f0.z & f0.w & f1.x & f1.y & f1.z & f1.w) != 0u) break; }
    }
    float* op = OSB + (rowbase + wrow0) * 512 + h * 64 + r32;
#pragma unroll
    for (int r = 0; r < 16; ++r) { const int qrow = (r & 3) + 8 * (r >> 2) + 4 * hi; op[(size_t)qrow * 512] = o0[r]; op[(size_t)qrow * 512 + 32] = o1[r]; }
}
constexpr int GL_QT = 0, GL_KT = 8192, GL_KD = 16384, GL_V = 28672, GL_ST = 49152, GL_SEG = 69632, GL_RED = 71680, GL_KDP = 192, GL_VP = 320;
constexpr int CW_DECAY = 65536;
template <bool ACC> DI bf16x8 tr_frag(const LAS unsigned char* base, int PB, int x0, int k0, int lane) {
    const int hi = lane >> 5, rr = (lane & 15) >> 2, col = x0 + 16 * ((lane >> 4) & 1) + 4 * (lane & 3);
    const int r0 = ACC ? (k0 + 4 * hi + rr) : (k0 + 8 * hi + rr), r1 = ACC ? (r0 + 8) : (r0 + 4);
    const s16x4 a = lds_tr16(base + r0 * PB + col * 2), b = lds_tr16(base + r1 * PB + col * 2);
    return (bf16x8){a[0], a[1], a[2], a[3], b[0], b[1], b[2], b[3]};
}
constexpr int GL_RQ = 73728, GL_RK = 82432, GL_RG = 91136, GL_RV = 99328;
template <int MODE> DI void gla_prep(Frame& F, const Args& A, int b, int h, int n) {
    const int tid = F.tid, d = tid & 63, seg = tid >> 6;
    const float* cw = A.in[4];
    const size_t row0 = (size_t)b * SEQ + 64 * n;
    float wq[4], wk[4], wv[4];
#pragma unroll
    for (int k = 0; k < 4; ++k) { wq[k] = cw[k * 1024 + PQ + h * 64 + d]; wk[k] = cw[k * 1024 + PK + h * 64 + d]; wv[k] = cw[k * 1024 + PV + h * 128 + (tid & 127)]; }
    const float bias = A.in[6][h * 64 + d];
    {
        v4u w[6]; int lo_[6];
#pragma unroll
        for (int i = 0; i < 6; ++i) {
            const int c = tid + 512 * i;
            const int reg = (c >= 536) + (c >= 1072) + (c >= 1584);
            const int cc = c - (reg == 1 ? 536 : reg == 2 ? 1072 : reg == 3 ? 1584 : 0);
            const int rr = reg == 3 ? (cc >> 4) : (cc >> 3), ch = reg == 3 ? (cc & 15) : (cc & 7);
            const int r = rr + (reg == 2 ? 3 : 0);
            const int col = (reg == 0 ? PQ + h * 64 : reg == 1 ? PK + h * 64 : reg == 2 ? PGATE + h * 64 : PV + h * 128) + ch * 8;
            lo_[i] = (reg == 0 ? GL_RQ : reg == 1 ? GL_RK : reg == 2 ? GL_RG : GL_RV) + rr * (reg == 3 ? 256 : 128) + ch * 16;
            const bool ok = (c < 2656) && (64 * n - 3 + r >= 0);
            w[i] = (v4u){0u, 0u, 0u, 0u};
            if (ok) w[i] = *(const GAS v4u*)(F_PROJ + (row0 - 3 + r) * N1 + col);
            if (c >= 2656) lo_[i] = -1;
        }
#pragma unroll
        for (int i = 0; i < 6; ++i) if (lo_[i] >= 0) *(LAS v4u*)(F.lds + lo_[i]) = w[i];
    }
    __syncthreads();
    {
        float rq[11], rk[11], gl[8];
#pragma unroll
        for (int i = 0; i < 11; ++i) { rq[i] = bf2f(*(const LAS bf16*)(F.lds + GL_RQ + (8 * seg + i) * 128 + d * 2)); rk[i] = bf2f(*(const LAS bf16*)(F.lds + GL_RK + (8 * seg + i) * 128 + d * 2)); }
#pragma unroll
        for (int j = 0; j < 8; ++j) gl[j] = log_sigmoid_f(bf2f(*(const LAS bf16*)(F.lds + GL_RG + (8 * seg + j) * 128 + d * 2)) + bias) * (1.f / 16.f);
        float c = 0.f;
#pragma unroll
        for (int j = 0; j < 8; ++j) { c += gl[j]; gl[j] = c; }
        LAS float* SEG = (LAS float*)(F.lds + GL_SEG);
        SEG[seg * 64 + d] = c;
        __syncthreads();
        float pre = 0.f, tot = 0.f;
#pragma unroll
        for (int s = 0; s < 8; ++s) { const float v = SEG[s * 64 + d]; pre += (s < seg) ? v : 0.f; tot += v; }
#pragma unroll
        for (int j = 0; j < 8; ++j) {
            const int tok = 8 * seg + j; const float cum = pre + gl[j];
            const float qc = silu_f(wq[0] * rq[j] + wq[1] * rq[j + 1] + wq[2] * rq[j + 2] + wq[3] * rq[j + 3]);
            const float kc = silu_f(wk[0] * rk[j] + wk[1] * rk[j + 1] + wk[2] * rk[j + 2] + wk[3] * rk[j + 3]);
            if (MODE == 0) { *(LAS bf16*)(F.lds + GL_KD + tok * GL_KDP + d * 2) = (bf16)f2bf(kc * __expf(tot - cum)); }
            else { const int off = (d >> 3) * 1024 + tok * 16 + (d & 7) * 2;
                *(LAS bf16*)(F.lds + GL_QT + off) = (bf16)f2bf(qc * 0.125f * __expf(cum)); *(LAS bf16*)(F.lds + GL_KT + off) = (bf16)f2bf(kc * __expf(-cum)); }
        }
        if (MODE == 0 && seg == 0) ((float*)(F.ctl + CW_DECAY))[((size_t)(b * 4 + h) * 32 + n) * 64 + d] = __expf(tot);
    }
    {
        const int e = tid & 127, s4 = tid >> 7;
        float rv[19];
#pragma unroll
        for (int i = 0; i < 19; ++i) rv[i] = bf2f(*(const LAS bf16*)(F.lds + GL_RV + (16 * s4 + i) * 256 + e * 2));
#pragma unroll
        for (int j = 0; j < 16; ++j) *(LAS bf16*)(F.lds + GL_V + (16 * s4 + j) * GL_VP + e * 2) = (bf16)f2bf(silu_f(wv[0] * rv[j] + wv[1] * rv[j + 1] + wv[2] * rv[j + 2] + wv[3] * rv[j + 3]));
    }
}
DI void gla_local_unit(Frame& F, const Args& A, float* STW, int b, int h, int n) {
    __syncthreads();
    gla_prep<0>(F, A, b, h, n);
    __syncthreads();
    const int lane = F.lane, wid = F.wave, dt = wid & 1, et = wid >> 1, r32 = lane & 31, hi = lane >> 5;
    f32x16 acc = {};
#pragma unroll
    for (int ks = 0; ks < 4; ++ks) {
        const bf16x8 af = tr_frag<false>(F.lds + GL_KD, GL_KDP, 32 * dt, 16 * ks, lane), bfr = tr_frag<false>(F.lds + GL_V, GL_VP, 32 * et, 16 * ks, lane);
        acc = __builtin_amdgcn_mfma_f32_32x32x16_bf16(af, bfr, acc, 0, 0, 0);
    }
    float* o = STW + (((size_t)(b * 4 + h) * 32 + n) * 64 + 32 * dt) * 128 + 32 * et + r32;
#pragma unroll
    for (int r = 0; r < 16; ++r) o[(size_t)((r & 3) + 8 * (r >> 2) + 4 * hi) * 128] = acc[r];
}
DI void gla_out_unit(Frame& F, const Args& A, const float* STW, int b, int h, int n) {
    f32x4 stv[4];
    { const float* sp = STW + ((size_t)(b * 4 + h) * 32 + n) * 64 * 128;
#pragma unroll
      for (int i = 0; i < 4; ++i) stv[i] = *(const GAS f32x4*)(sp + (F.tid + i * 512) * 4); }
    __syncthreads();
    gla_prep<1>(F, A, b, h, n);
#pragma unroll
    for (int i = 0; i < 4; ++i) { const int idx = (F.tid + i * 512) * 4, dd = idx >> 7, ee = idx & 127;
        *(LAS unsigned long long*)(F.lds + GL_ST + dd * GL_VP + ee * 2) = (unsigned long long)pk2(stv[i].x, stv[i].y) | ((unsigned long long)pk2(stv[i].z, stv[i].w) << 32); }
    __syncthreads();
    const int lane = F.lane, wid = F.wave, it = wid & 1, et = wid >> 1, r32 = lane & 31, hi = lane >> 5;
    f32x16 acc = {};
    bf16x8 qf[4];
#pragma unroll
    for (int ks = 0; ks < 4; ++ks) qf[ks] = *(const LAS bf16x8*)(F.lds + GL_QT + (2 * ks + hi) * 1024 + (32 * it + r32) * 16);
#pragma unroll
    for (int ks = 0; ks < 4; ++ks) acc = __builtin_amdgcn_mfma_f32_32x32x16_bf16(tr_frag<false>(F.lds + GL_ST, GL_VP, 32 * et, 16 * ks, lane), qf[ks], acc, 0, 0, 0);
    for (int jt = 0; jt <= it; ++jt) {
        f32x16 S = {};
#pragma unroll
        for (int ks = 0; ks < 4; ++ks) S = __builtin_amdgcn_mfma_f32_32x32x16_bf16(*(const LAS bf16x8*)(F.lds + GL_KT + (2 * ks + hi) * 1024 + (32 * jt + r32) * 16), qf[ks], S, 0, 0, 0);
        if (jt == it) {
#pragma unroll
            for (int r = 0; r < 16; ++r) S[r] = ((r & 3) + 8 * (r >> 2) + 4 * hi) <= r32 ? S[r] : 0.f;
        }
#pragma unroll
        for (int s = 0; s < 2; ++s) {
            v4u pw; pw.x = cvtpk_bf16(S[8 * s + 0], S[8 * s + 1]); pw.y = cvtpk_bf16(S[8 * s + 2], S[8 * s + 3]); pw.z = cvtpk_bf16(S[8 * s + 4], S[8 * s + 5]); pw.w = cvtpk_bf16(S[8 * s + 6], S[8 * s + 7]);
            acc = __builtin_amdgcn_mfma_f32_32x32x16_bf16(tr_frag<true>(F.lds + GL_V, GL_VP, 32 * et, 32 * jt + 16 * s, lane), __builtin_bit_cast(bf16x8, pw), acc, 0, 0, 0);
        }
    }
    float ss = 0.f;
#pragma unroll
    for (int r = 0; r < 16; ++r) ss += acc[r] * acc[r];
    { auto rr = __builtin_amdgcn_permlane32_swap(__float_as_uint(ss), __float_as_uint(ss), false, false); ss = __uint_as_float(rr[0]) + __uint_as_float(rr[1]); }
    LAS float* RED = (LAS float*)(F.lds + GL_RED);
    if (hi == 0) RED[wid * 32 + r32] = ss;
    __syncthreads();
    const float tot = RED[(it + 0) * 32 + r32] + RED[(it + 2) * 32 + r32] + RED[(it + 4) * 32 + r32] + RED[(it + 6) * 32 + r32];
    const float rs = 1.f / sqrtf(tot * (1.f / 128.f) + EPS);
    const size_t row = (size_t)b * SEQ + 64 * n + 32 * it + r32;
    const float* gg = A.in[7];
#pragma unroll
    for (int g = 0; g < 4; ++g) {
        const int e0 = 32 * et + 8 * g + 4 * hi;
        const unsigned long long ogw = *(const GAS unsigned long long*)(F_PROJ + row * N1 + POG + h * 128 + e0);
        const unsigned lo = (unsigned)ogw, hi2 = (unsigned)(ogw >> 32);
        const f32x4 gv = *(const GAS f32x4*)(gg + e0);
        const float y0 = acc[4 * g + 0] * rs * gv.x * silu_f(bflo(lo)), y1 = acc[4 * g + 1] * rs * gv.y * silu_f(bfhi(lo)), y2 = acc[4 * g + 2] * rs * gv.z * silu_f(bflo(hi2)), y3 = acc[4 * g + 3] * rs * gv.w * silu_f(bfhi(hi2));
        *(GAS unsigned long long*)(F_BUFA + row * 1024 + h * 128 + e0) = (unsigned long long)pk2(y0, y1) | ((unsigned long long)pk2(y2, y3) << 32);
    }
}
DI void xattn_unit(Frame& F, const bf16* Q, bf16* O, int b, int h, int qb) {
    const int tid = F.tid, lane = F.lane, wid = F.wave, r32 = lane & 31, hi = lane >> 5;
    const bf16* Kg = F_KV + (size_t)(b * 256) * 2048 + h * 256;
    const bf16* Vg = Kg + 1024;
    const size_t row = (size_t)b * SEQ + qb * 256 + wid * 32 + r32;
    __syncthreads();
    {
        const bf16* kp = Kg + (size_t)(tid >> 5) * 2048 + (tid & 31) * 8; LAS unsigned char* kl = F.lds + (tid & 31) * 4096 + (tid >> 5) * 16;
#pragma unroll 4
        for (int i = 0; i < 16; ++i) { *(LAS v4u*)(kl) = *(const GAS v4u*)(kp); kp += 16 * 2048; kl += 256; }
    }
    bf16x8 qf[16];
#pragma unroll
    for (int ks = 0; ks < 16; ++ks) qf[ks] = *(const GAS bf16x8*)(Q + row * 1024 + h * 256 + 16 * ks + 8 * hi);
    __syncthreads();
    f32x16 S[8];
#pragma unroll
    for (int mt = 0; mt < 8; ++mt) { S[mt] = (f32x16){};
#pragma unroll
        for (int k4 = 0; k4 < 4; ++k4) {
#pragma unroll
            for (int kk = 0; kk < 4; ++kk) { const int ks = 4 * k4 + kk; S[mt] = __builtin_amdgcn_mfma_f32_32x32x16_bf16(*(const LAS bf16x8*)(F.lds + (2 * ks + hi) * 4096 + (32 * mt + r32) * 16), qf[ks], S[mt], 0, 0, 0); }
            __builtin_amdgcn_sched_barrier(0); } }
    float mx = -INFINITY;
#pragma unroll
    for (int mt = 0; mt < 8; ++mt)
#pragma unroll
        for (int r = 0; r < 16; ++r) mx = fmaxf(mx, S[mt][r]);
    { auto rr = __builtin_amdgcn_permlane32_swap(__float_as_uint(mx), __float_as_uint(mx), false, false); mx = fmaxf(__uint_as_float(rr[0]), __uint_as_float(rr[1])); }
    const float c2 = 0.0625f * 1.4426950408889634f; const float mb = mx * c2;
    float sum = 0.f;
#pragma unroll
    for (int mt = 0; mt < 8; ++mt)
#pragma unroll
        for (int r = 0; r < 16; ++r) { const float p = __builtin_amdgcn_exp2f(S[mt][r] * c2 - mb); S[mt][r] = p; sum += p; }
    { auto rr = __builtin_amdgcn_permlane32_swap(__float_as_uint(sum), __float_as_uint(sum), false, false); sum = __uint_as_float(rr[0]) + __uint_as_float(rr[1]); }
    const float linv = 1.f / sum;
    v4u pa[16];
#pragma unroll
    for (int mt = 0; mt < 8; ++mt)
#pragma unroll
        for (int s = 0; s < 2; ++s) { v4u pw; pw.x = cvtpk_bf16(S[mt][8 * s + 0] * linv, S[mt][8 * s + 1] * linv); pw.y = cvtpk_bf16(S[mt][8 * s + 2] * linv, S[mt][8 * s + 3] * linv);
            pw.z = cvtpk_bf16(S[mt][8 * s + 4] * linv, S[mt][8 * s + 5] * linv); pw.w = cvtpk_bf16(S[mt][8 * s + 6] * linv, S[mt][8 * s + 7] * linv); pa[2 * mt + s] = pw; }
    __syncthreads();
    {
        const int c = tid & 31, m0 = tid >> 5;
        const bf16* vp = Vg + (size_t)m0 * 2048 + c * 8; LAS unsigned char* vl = F.lds + (c >> 2) * 16384 + m0 * 64 + (c & 3) * 16;
#pragma unroll 4
        for (int i = 0; i < 16; ++i) { *(LAS v4u*)(vl) = *(const GAS v4u*)(vp); vp += 16 * 2048; vl += 1024; }
    }
    __syncthreads();
    const int vfr = ((lane >> 4) & 1) * 32 + (lane & 3) * 8 + (4 * hi + ((lane & 15) >> 2)) * 64;
    unsigned opk[4][16];
#pragma unroll
    for (int dp = 0; dp < 4; ++dp) {
        f32x16 a0 = {}, a1 = {};
#pragma unroll
        for (int s = 0; s < 16; ++s) {
            const LAS unsigned char* vp0 = F.lds + (2 * dp) * 16384 + s * 1024 + vfr; const LAS unsigned char* vp1 = vp0 + 16384;
            const s16x4 l0 = lds_tr16(vp0), h0 = lds_tr16(vp0 + 512), l1 = lds_tr16(vp1), h1 = lds_tr16(vp1 + 512);
            const bf16x8 v0 = {l0[0], l0[1], l0[2], l0[3], h0[0], h0[1], h0[2], h0[3]}, v1 = {l1[0], l1[1], l1[2], l1[3], h1[0], h1[1], h1[2], h1[3]};
            a0 = __builtin_amdgcn_mfma_f32_32x32x16_bf16(__builtin_bit_cast(bf16x8, pa[s]), v0, a0, 0, 0, 0);
            a1 = __builtin_amdgcn_mfma_f32_32x32x16_bf16(__builtin_bit_cast(bf16x8, pa[s]), v1, a1, 0, 0, 0);
            if ((s & 3) == 3) __builtin_amdgcn_sched_barrier(0);
        }
#pragma unroll
        for (int r = 0; r < 16; ++r) opk[dp][r] = cvtpk_bf16(a0[r], a1[r]);
        __builtin_amdgcn_sched_barrier(0);
    }
    __syncthreads();
    LAS bf16* stg = (LAS bf16*)(F.lds + wid * 16384);
#pragma unroll
    for (int dp = 0; dp < 4; ++dp)
#pragma unroll
        for (int r = 0; r < 16; ++r) { const int rr = (r & 3) + 8 * (r >> 2) + 4 * hi; stg[rr * 256 + dp * 64 + r32] = (bf16)(opk[dp][r] & 0xffffu); stg[rr * 256 + dp * 64 + 32 + r32] = (bf16)(opk[dp][r] >> 16); }
    LDS_WAIT(); asm volatile("" ::: "memory");
    bf16* Ow = O + ((size_t)b * SEQ + qb * 256 + wid * 32) * 1024 + h * 256;
    {
        bf16* op = Ow + (size_t)(lane >> 5) * 1024 + (lane & 31) * 8; const LAS bf16* sp = stg + (lane >> 5) * 256 + (lane & 31) * 8;
#pragma unroll 4
        for (int i = 0; i < 16; ++i) { *(GAS v4u*)(op) = *(const LAS v4u*)(sp); op += 2 * 1024; sp += 2 * 256; }
    }
    LDS_WAIT(); asm volatile("" ::: "memory");
}
DI void mix_row(Frame& F, const Args& A, const float* OGLA, const float* OSB, size_t row) {
    const int lane = F.lane;
    const f32x4 a0 = *(const GAS f32x4*)(OGLA + row * 512 + 8 * lane), a1 = *(const GAS f32x4*)(OGLA + row * 512 + 8 * lane + 4);
    float s = (a0.x * a0.x + a0.y * a0.y) + (a0.z * a0.z + a0.w * a0.w) + (a1.x * a1.x + a1.y * a1.y) + (a1.z * a1.z + a1.w * a1.w);
    s += __shfl_xor(s, 1); s += __shfl_xor(s, 2); s += __shfl_xor(s, 4); s += __shfl_xor(s, 8);
    const float rs = 1.f / sqrtf(s * (1.f / 128.f) + EPS);
    const int e0 = (8 * lane) & 127;
    const f32x4 g0 = *(const GAS f32x4*)(A.in[7] + e0), g1 = *(const GAS f32x4*)(A.in[7] + e0 + 4);
    const v4u ogw = *(const GAS v4u*)(F_PROJ + row * N1 + POG + 8 * lane);
    v4u o;
    o.x = pk2(a0.x * rs * g0.x * silu_f(bflo(ogw.x)), a0.y * rs * g0.y * silu_f(bfhi(ogw.x)));
    o.y = pk2(a0.z * rs * g0.z * silu_f(bflo(ogw.y)), a0.w * rs * g0.w * silu_f(bfhi(ogw.y)));
    o.z = pk2(a1.x * rs * g1.x * silu_f(bflo(ogw.z)), a1.y * rs * g1.y * silu_f(bfhi(ogw.z)));
    o.w = pk2(a1.z * rs * g1.z * silu_f(bflo(ogw.w)), a1.w * rs * g1.w * silu_f(bfhi(ogw.w)));
    *(GAS v4u*)(F_BUFA + row * 1024 + 8 * lane) = o;
    const f32x4 b0 = *(const GAS f32x4*)(OSB + row * 512 + 8 * lane), b1 = *(const GAS f32x4*)(OSB + row * 512 + 8 * lane + 4);
    float s2 = (b0.x * b0.x + b0.y * b0.y) + (b0.z * b0.z + b0.w * b0.w) + (b1.x * b1.x + b1.y * b1.y) + (b1.z * b1.z + b1.w * b1.w);
    const float rs2 = 1.f / sqrtf(wave_sum(s2) * (1.f / 512.f) + EPS);
    const f32x4 h0 = *(const GAS f32x4*)(A.in[8] + 8 * lane), h1 = *(const GAS f32x4*)(A.in[8] + 8 * lane + 4);
    v4u p;
    p.x = pk2(b0.x * rs2 * h0.x, b0.y * rs2 * h0.y); p.y = pk2(b0.z * rs2 * h0.z, b0.w * rs2 * h0.w);
    p.z = pk2(b1.x * rs2 * h1.x, b1.y * rs2 * h1.y); p.w = pk2(b1.z * rs2 * h1.z, b1.w * rs2 * h1.w);
    *(GAS v4u*)(F_BUFA + row * 1024 + 512 + 8 * lane) = p;
}
DI void mix_row_sb(Frame& F, const Args& A, const float* OSB, size_t row) {
    const int lane = F.lane;
    const f32x4 b0 = *(const GAS f32x4*)(OSB + row * 512 + 8 * lane), b1 = *(const GAS f32x4*)(OSB + row * 512 + 8 * lane + 4);
    float s2 = (b0.x * b0.x + b0.y * b0.y) + (b0.z * b0.z + b0.w * b0.w) + (b1.x * b1.x + b1.y * b1.y) + (b1.z * b1.z + b1.w * b1.w);
    const float rs2 = 1.f / sqrtf(wave_sum(s2) * (1.f / 512.f) + EPS);
    const f32x4 h0 = *(const GAS f32x4*)(A.in[8] + 8 * lane), h1 = *(const GAS f32x4*)(A.in[8] + 8 * lane + 4);
    v4u p;
    p.x = pk2(b0.x * rs2 * h0.x, b0.y * rs2 * h0.y); p.y = pk2(b0.z * rs2 * h0.z, b0.w * rs2 * h0.w);
    p.z = pk2(b1.x * rs2 * h1.x, b1.y * rs2 * h1.y); p.w = pk2(b1.z * rs2 * h1.z, b1.w * rs2 * h1.w);
    *(GAS v4u*)(F_BUFA + row * 1024 + 512 + 8 * lane) = p;
}
DI void gla_scan(Frame& F, float* STW) {
    const int gt = (F.vcu * NWAVES + F.wave) * 64 + F.lane, NGT = F.G * NWAVES * 64;
    const float* dec = (const float*)(F.ctl + CW_DECAY);
    for (int idx = gt; idx < 32 * 8192; idx += NGT) {
        const int bh = idx >> 13, de = idx & 8191, d = de >> 7;
        float* p = STW + (size_t)bh * 32 * 8192 + de; const float* dp = dec + (size_t)bh * 32 * 64 + d;
        float tmp[32], dc[32];
#pragma unroll
        for (int n = 0; n < 32; ++n) { tmp[n] = p[(size_t)n * 8192]; dc[n] = dp[n * 64]; }
        float st = 0.f;
#pragma unroll
        for (int n = 0; n < 32; ++n) { p[(size_t)n * 8192] = st; st = dc[n] * st + tmp[n]; }
    }
}
DI void xsoftmax_row(Frame& F, bf16* S, size_t rh) {
    unsigned long long* p = (unsigned long long*)(S + rh * 256) + F.lane;
    const unsigned long long w = *p; const unsigned lo = (unsigned)w, hi = (unsigned)(w >> 32);
    const float sc = 0.0625f;
    float a = bflo(lo) * sc, b = bfhi(lo) * sc, c = bflo(hi) * sc, d = bfhi(hi) * sc;
    const float mx = wave_max(fmaxf(fmaxf(a, b), fmaxf(c, d)));
    a = __expf(a - mx); b = __expf(b - mx); c = __expf(c - mx); d = __expf(d - mx);
    const float inv = 1.f / wave_sum((a + b) + (c + d));
    *p = (unsigned long long)pk2(a * inv, b * inv) | ((unsigned long long)pk2(c * inv, d * inv) << 32);
}
DI float topk_round2(float& c0, float& c1) {
    const float w = wave_max(fmaxf(c0, c1));
    if (c0 == w) c0 = -INFINITY; if (c1 == w) c1 = -INFINITY;
    return w;
}
DI void peer_topk_item(Frame& F, const bf16* PQb, int* IDX, float* GATE, size_t row, int h) {
    const int lane = F.lane;
    float mylist[2];
#pragma unroll
    for (int p = 0; p < 2; ++p) {
        LAS unsigned* qs = (LAS unsigned*)(F.lds + F.wave * 1024);
        qs[lane] = *(const GAS unsigned*)(PQb + row * 2048 + (h * 2 + p) * 128 + 2 * lane);
        LDS_WAIT(); asm volatile("" ::: "memory");
        const bf16* kbase = F_SUBK + (size_t)((h * 2 + p) * 128) * 128;
        float s0 = 0.f, s1 = 0.f;
        const GAS v4u* k0p = (const GAS v4u*)(kbase + (size_t)lane * 128); const GAS v4u* k1p = (const GAS v4u*)(kbase + (size_t)(lane + 64) * 128);
#pragma unroll
        for (int c = 0; c < 16; ++c) {
            const v4u a = k0p[c], b = k1p[c];
            const v4u qq = *(const LAS v4u*)(qs + 4 * c); const unsigned q0 = qq.x, q1 = qq.y, q2 = qq.z, q3 = qq.w;
            s0 += bflo(a.x) * bflo(q0) + bfhi(a.x) * bfhi(q0) + bflo(a.y) * bflo(q1) + bfhi(a.y) * bfhi(q1) + bflo(a.z) * bflo(q2) + bfhi(a.z) * bfhi(q2) + bflo(a.w) * bflo(q3) + bfhi(a.w) * bfhi(q3);
            s1 += bflo(b.x) * bflo(q0) + bfhi(b.x) * bfhi(q0) + bflo(b.y) * bflo(q1) + bfhi(b.y) * bfhi(q1) + bflo(b.z) * bflo(q2) + bfhi(b.z) * bfhi(q2) + bflo(b.w) * bflo(q3) + bfhi(b.w) * bfhi(q3);
        }
        float c0 = __uint_as_float((__float_as_uint(s0) & ~0x7fu) | (unsigned)lane), c1 = __uint_as_float((__float_as_uint(s1) & ~0x7fu) | (unsigned)(lane + 64));
        float mine = 0.f;
#pragma unroll
        for (int r = 0; r < 16; ++r) { const float w = topk_round2(c0, c1); if (lane == r) mine = w; }
        mylist[p] = mine;
        LDS_WAIT(); asm volatile("" ::: "memory");
    }
    const float va = __uint_as_float(__float_as_uint(__shfl(mylist[0], lane >> 2)) & ~0x7fu);
    float cand[4];
#pragma unroll
    for (int j = 0; j < 4; ++j) { const int bb = 4 * (lane & 3) + j; const float vb = __uint_as_float(__float_as_uint(__shfl(mylist[1], bb)) & ~0x7fu);
        cand[j] = __uint_as_float((__float_as_uint(va + vb) & ~0xffu) | (unsigned)((lane >> 2) * 16 + bb)); }
    float best = 0.f, top = 0.f;
#pragma unroll
    for (int r = 0; r < 16; ++r) {
        const float w = wave_max(fmaxf(fmaxf(cand[0], cand[1]), fmaxf(cand[2], cand[3])));
#pragma unroll
        for (int j = 0; j < 4; ++j) if (cand[j] == w) cand[j] = -INFINITY;
        if (lane == r) best = w; if (r == 0) top = w;
    }
    const unsigned bu = __float_as_uint(best); const int ca = (bu >> 4) & 15, cb = bu & 15;
    const int i1 = (int)(__float_as_uint(__shfl(mylist[0], ca)) & 0x7fu), i2 = (int)(__float_as_uint(__shfl(mylist[1], cb)) & 0x7fu);
    const float sc = __uint_as_float(bu & ~0xffu), tp = __uint_as_float(__float_as_uint(top) & ~0xffu);
    const float ex = lane < 16 ? __expf(sc - tp) : 0.f;
    const float inv = 1.f / wave_sum(ex);
    if (lane < 16) { IDX[row * 128 + h * 16 + lane] = i1 * 128 + i2; GATE[row * 128 + h * 16 + lane] = ex * inv; }
}
DI float vmaxf(float a, float b) { float r; asm("v_max_f32_e32 %0, %1, %2" : "=v"(r) : "v"(a), "v"(b)); return r; }
DI float vminf(float a, float b) { float r; asm("v_min_f32_e32 %0, %1, %2" : "=v"(r) : "v"(a), "v"(b)); return r; }
DI void ins16(float (&L)[16], float x) {
#pragma unroll
    for (int i = 0; i < 16; ++i) { const float h = vmaxf(L[i], x); x = vminf(L[i], x); L[i] = h; }
}
DI void peer_topk_mfma(Frame& F, const bf16* PQb, int* IDX, float* GATE) {
    const int tid = F.tid, lane = F.lane, wid = F.wave, r32 = lane & 31, hi = lane >> 5, h = F.vcu & 7;
    __syncthreads();
    for (int i = tid; i < 2 * 128 * 16; i += 512) { const int p = i >> 11, key = (i >> 4) & 127, c = i & 15;
        *(LAS v4u*)(F.lds + p * 32768 + c * 2048 + key * 16) = *(const GAS v4u*)(F_SUBK + (size_t)((h * 2 + p) * 128 + key) * 128 + c * 8); }
    __syncthreads();
    LAS unsigned* scr = (LAS unsigned*)(F.lds + 65536 + wid * 8192) + lane;
    for (int g = (F.vcu >> 3) * 8 + wid; g < 512; g += (F.G >> 3) * 8) {
        const size_t token = (size_t)32 * g + r32;
        float LA[16], LB[16];
#pragma unroll
        for (int p = 0; p < 2; ++p) {
            float (&L)[16] = p ? LB : LA;
#pragma unroll
            for (int i = 0; i < 16; ++i) L[i] = -INFINITY;
            bf16x8 qf[8];
#pragma unroll
            for (int ks = 0; ks < 8; ++ks) qf[ks] = *(const GAS bf16x8*)(PQb + token * 2048 + (h * 2 + p) * 128 + 16 * ks + 8 * hi);
#pragma unroll
            for (int rt = 0; rt < 4; ++rt) {
                f32x16 S = {};
#pragma unroll
                for (int ks = 0; ks < 8; ++ks) S = __builtin_amdgcn_mfma_f32_32x32x16_bf16(*(const LAS bf16x8*)(F.lds + p * 32768 + (2 * ks + hi) * 2048 + (32 * rt + r32) * 16), qf[ks], S, 0, 0, 0);
#pragma unroll
                for (int r = 0; r < 16; ++r) { const unsigned key = (unsigned)(32 * rt + (r & 3) + 8 * (r >> 2)) + 4u * (unsigned)hi;
                    ins16(L, __uint_as_float((__float_as_uint(S[r]) & ~0x7fu) | key)); }
            }
            float PL[16];
#pragma unroll
            for (int i = 0; i < 16; ++i) { auto rr = __builtin_amdgcn_permlane32_swap(__float_as_uint(L[i]), __float_as_uint(L[i]), false, false); PL[i] = __uint_as_float(hi ? rr[0] : rr[1]); }
#pragma unroll
            for (int i = 0; i < 16; ++i) ins16(L, PL[i]);
        }
        float C[16];
#pragma unroll
        for (int i = 0; i < 16; ++i) C[i] = -INFINITY;
#pragma unroll
        for (int a = 0; a < 16; ++a) {
            const float va = __uint_as_float(__float_as_uint(LA[a]) & ~0x7fu);
#pragma unroll
            for (int b = 0; b < 16; ++b) if ((a + 1) * (b + 1) <= 16) {
                const float vb = __uint_as_float(__float_as_uint(LB[b]) & ~0x7fu);
                ins16(C, __uint_as_float((__float_as_uint(va + vb) & ~0xffu) | (unsigned)(a * 16 + b)));
            }
        }
#pragma unroll
        for (int i = 0; i < 16; ++i) { scr[i * 64] = __float_as_uint(LA[i]) & 0x7fu; scr[(16 + i) * 64] = __float_as_uint(LB[i]) & 0x7fu; }
        LDS_WAIT(); asm volatile("" ::: "memory");
        const float top = __uint_as_float(__float_as_uint(C[0]) & ~0xffu);
        float ex[16]; int ei[16]; float sum = 0.f;
#pragma unroll
        for (int r = 0; r < 16; ++r) { const unsigned cu = __float_as_uint(C[r]); ex[r] = __expf(__uint_as_float(cu & ~0xffu) - top); sum += ex[r];
            ei[r] = (int)(scr[((cu >> 4) & 15) * 64] * 128u + scr[(16 + (cu & 15)) * 64]); }
        const float inv = 1.f / sum;
        v4u io0, io1; f32x4 go0, go1;
        io0.x = hi ? ei[8] : ei[0]; io0.y = hi ? ei[9] : ei[1]; io0.z = hi ? ei[10] : ei[2]; io0.w = hi ? ei[11] : ei[3];
        io1.x = hi ? ei[12] : ei[4]; io1.y = hi ? ei[13] : ei[5]; io1.z = hi ? ei[14] : ei[6]; io1.w = hi ? ei[15] : ei[7];
        go0.x = (hi ? ex[8] : ex[0]) * inv; go0.y = (hi ? ex[9] : ex[1]) * inv; go0.z = (hi ? ex[10] : ex[2]) * inv; go0.w = (hi ? ex[11] : ex[3]) * inv;
        go1.x = (hi ? ex[12] : ex[4]) * inv; go1.y = (hi ? ex[13] : ex[5]) * inv; go1.z = (hi ? ex[14] : ex[6]) * inv; go1.w = (hi ? ex[15] : ex[7]) * inv;
        int* ip = IDX + token * 128 + h * 16 + 8 * hi; float* gp = GATE + token * 128 + h * 16 + 8 * hi;
        *(GAS v4u*)ip = io0; *(GAS v4u*)(ip + 4) = io1; *(GAS f32x4*)gp = go0; *(GAS f32x4*)(gp + 4) = go1;
        LDS_WAIT(); asm volatile("" ::: "memory");
    }
}
#define CE(a, b) do { const float h_ = vmaxf(a, b); const float l_ = vminf(a, b); a = h_; b = l_; } while (0)
DI void sort16_desc(float (&v)[16]) { CE(v[0],v[1]); CE(v[2],v[3]); CE(v[0],v[2]); CE(v[1],v[3]); CE(v[1],v[2]); CE(v[4],v[5]); CE(v[6],v[7]); CE(v[4],v[6]); CE(v[5],v[7]); CE(v[5],v[6]); CE(v[0],v[4]); CE(v[2],v[6]); CE(v[2],v[4]); CE(v[1],v[5]); CE(v[3],v[7]); CE(v[3],v[5]); CE(v[1],v[2]); CE(v[3],v[4]); CE(v[5],v[6]); CE(v[8],v[9]); CE(v[10],v[11]); CE(v[8],v[10]); CE(v[9],v[11]); CE(v[9],v[10]); CE(v[12],v[13]); CE(v[14],v[15]); CE(v[12],v[14]); CE(v[13],v[15]); CE(v[13],v[14]); CE(v[8],v[12]); CE(v[10],v[14]); CE(v[10],v[12]); CE(v[9],v[13]); CE(v[11],v[15]); CE(v[11],v[13]); CE(v[9],v[10]); CE(v[11],v[12]); CE(v[13],v[14]); CE(v[0],v[8]); CE(v[4],v[12]); CE(v[4],v[8]); CE(v[2],v[10]); CE(v[6],v[14]); CE(v[6],v[10]); CE(v[2],v[4]); CE(v[6],v[8]); CE(v[10],v[12]); CE(v[1],v[9]); CE(v[5],v[13]); CE(v[5],v[9]); CE(v[3],v[11]); CE(v[7],v[15]); CE(v[7],v[11]); CE(v[3],v[5]); CE(v[7],v[9]); CE(v[11],v[13]); CE(v[1],v[2]); CE(v[3],v[4]); CE(v[5],v[6]); CE(v[7],v[8]); CE(v[9],v[10]); CE(v[11],v[12]); CE(v[13],v[14]); }
DI void bmerge16_desc(float (&v)[16]) { CE(v[0],v[8]); CE(v[1],v[9]); CE(v[2],v[10]); CE(v[3],v[11]); CE(v[4],v[12]); CE(v[5],v[13]); CE(v[6],v[14]); CE(v[7],v[15]); CE(v[0],v[4]); CE(v[1],v[5]); CE(v[2],v[6]); CE(v[3],v[7]); CE(v[8],v[12]); CE(v[9],v[13]); CE(v[10],v[14]); CE(v[11],v[15]); CE(v[0],v[2]); CE(v[1],v[3]); CE(v[4],v[6]); CE(v[5],v[7]); CE(v[8],v[10]); CE(v[9],v[11]); CE(v[12],v[14]); CE(v[13],v[15]); CE(v[0],v[1]); CE(v[2],v[3]); CE(v[4],v[5]); CE(v[6],v[7]); CE(v[8],v[9]); CE(v[10],v[11]); CE(v[12],v[13]); CE(v[14],v[15]); }
#undef CE
template <int NV> DI void merge_top16(float (&L)[16], const float (&N)[NV]) {
#pragma unroll
    for (int i = 16 - NV; i < 16; ++i) L[i] = vmaxf(L[i], N[15 - i]);
    bmerge16_desc(L);
}
DI float pack_cand(float s, int id) { return __uint_as_float((__float_as_uint(s) & ~0xffu) | (unsigned)(255 - id)); }
DI void peer_topk_mfma2(Frame& F, const bf16* PQb, int* IDX, float* GATE) {
    const int tid = F.tid, lane = F.lane, wid = F.wave, r32 = lane & 31, hi = lane >> 5, h = F.vcu & 7;
    __syncthreads();
    for (int i = tid; i < 2 * 128 * 16; i += 512) { const int p = i >> 11, key = (i >> 4) & 127, c = i & 15;
        *(LAS v4u*)(F.lds + p * 32768 + c * 2048 + key * 16) = *(const GAS v4u*)(F_SUBK + (size_t)((h * 2 + p) * 128 + key) * 128 + c * 8); }
    __syncthreads();
    LAS unsigned* scr = (LAS unsigned*)(F.lds + 65536 + wid * 8192) + lane;
    for (int g = (F.vcu >> 3) * 8 + wid; g < 512; g += (F.G >> 3) * 8) {
        const size_t token = (size_t)32 * g + r32;
        float LA[16], LB[16];
#pragma unroll
        for (int p = 0; p < 2; ++p) {
            float (&L)[16] = p ? LB : LA;
            bf16x8 qf[8];
#pragma unroll
            for (int ks = 0; ks < 8; ++ks) qf[ks] = *(const GAS bf16x8*)(PQb + token * 2048 + (h * 2 + p) * 128 + 16 * ks + 8 * hi);
#pragma unroll
            for (int rt = 0; rt < 4; ++rt) {
                f32x16 S = {};
#pragma unroll
                for (int ks = 0; ks < 8; ++ks) S = __builtin_amdgcn_mfma_f32_32x32x16_bf16(*(const LAS bf16x8*)(F.lds + p * 32768 + (2 * ks + hi) * 2048 + (32 * rt + r32) * 16), qf[ks], S, 0, 0, 0);
                float v[16];
#pragma unroll
                for (int r = 0; r < 16; ++r) { const unsigned key = (unsigned)(32 * rt + (r & 3) + 8 * (r >> 2)) + 4u * (unsigned)hi; v[r] = __uint_as_float((__float_as_uint(S[r]) & ~0x7fu) | key); }
                sort16_desc(v);
                if (rt == 0) {
#pragma unroll
                    for (int i = 0; i < 16; ++i) L[i] = v[i];
                } else merge_top16<16>(L, v);
            }
            float PL[16];
#pragma unroll
            for (int i = 0; i < 16; ++i) { auto rr = __builtin_amdgcn_permlane32_swap(__float_as_uint(L[i]), __float_as_uint(L[i]), false, false); PL[i] = __uint_as_float(hi ? rr[0] : rr[1]); }
            merge_top16<16>(L, PL);
        }
#pragma unroll
        for (int i = 0; i < 16; ++i) { scr[i * 64] = __float_as_uint(LA[i]) & 0x7fu; scr[(16 + i) * 64] = __float_as_uint(LB[i]) & 0x7fu; }
        float VA[16], VB[16];
#pragma unroll
        for (int i = 0; i < 16; ++i) { VA[i] = __uint_as_float(__float_as_uint(LA[i]) & ~0x7fu); VB[i] = __uint_as_float(__float_as_uint(LB[i]) & ~0x7fu); }
        float C[16];
#pragma unroll
        for (int b = 0; b < 16; ++b) C[b] = pack_cand(VA[0] + VB[b], b);
        { float R[8];
#pragma unroll
          for (int b = 0; b < 8; ++b) R[b] = pack_cand(VA[1] + VB[b], 16 + b);
          merge_top16<8>(C, R); }
        { float R[5];
#pragma unroll
          for (int b = 0; b < 5; ++b) R[b] = pack_cand(VA[2] + VB[b], 32 + b);
          merge_top16<5>(C, R); }
        { float R[4];
#pragma unroll
          for (int b = 0; b < 4; ++b) R[b] = pack_cand(VA[3] + VB[b], 48 + b);
          merge_top16<4>(C, R); }
        { float R[3];
#pragma unroll
          for (int b = 0; b < 3; ++b) R[b] = pack_cand(VA[4] + VB[b], 64 + b);
          merge_top16<3>(C, R); }
        { float R[11];
#pragma unroll
          for (int i = 0; i < 11; ++i) R[i] = pack_cand(VA[5 + i] + VB[0], (5 + i) * 16);
          merge_top16<11>(C, R); }
        { float R[3];
#pragma unroll
          for (int i = 0; i < 3; ++i) R[i] = pack_cand(VA[5 + i] + VB[1], (5 + i) * 16 + 1);
          merge_top16<3>(C, R); }
        LDS_WAIT(); asm volatile("" ::: "memory");
        const float top = __uint_as_float(__float_as_uint(C[0]) & ~0xffu);
        float ex[16]; int ei[16]; float sum = 0.f;
#pragma unroll
        for (int r = 0; r < 16; ++r) { const unsigned cu = __float_as_uint(C[r]), id = 255u - (cu & 0xffu); ex[r] = __expf(__uint_as_float(cu & ~0xffu) - top); sum += ex[r];
            ei[r] = (int)(scr[(id >> 4) * 64] * 128u + scr[(16 + (id & 15)) * 64]); }
        const float inv = 1.f / sum;
        v4u io0, io1; f32x4 go0, go1;
        io0.x = hi ? ei[8] : ei[0]; io0.y = hi ? ei[9] : ei[1]; io0.z = hi ? ei[10] : ei[2]; io0.w = hi ? ei[11] : ei[3];
        io1.x = hi ? ei[12] : ei[4]; io1.y = hi ? ei[13] : ei[5]; io1.z = hi ? ei[14] : ei[6]; io1.w = hi ? ei[15] : ei[7];
        go0.x = (hi ? ex[8] : ex[0]) * inv; go0.y = (hi ? ex[9] : ex[1]) * inv; go0.z = (hi ? ex[10] : ex[2]) * inv; go0.w = (hi ? ex[11] : ex[3]) * inv;
        go1.x = (hi ? ex[12] : ex[4]) * inv; go1.y = (hi ? ex[13] : ex[5]) * inv; go1.z = (hi ? ex[14] : ex[6]) * inv; go1.w = (hi ? ex[15] : ex[7]) * inv;
        int* ip = IDX + token * 128 + h * 16 + 8 * hi; float* gp = GATE + token * 128 + h * 16 + 8 * hi;
        *(GAS v4u*)ip = io0; *(GAS v4u*)(ip + 4) = io1; *(GAS f32x4*)gp = go0; *(GAS f32x4*)(gp + 4) = go1;
        LDS_WAIT(); asm volatile("" ::: "memory");
    }
}
DI void peer_gather_row(Frame& F, const Args& A, const bf16* XN2, const int* IDX, const float* GATE, size_t row) {
    const int lane = F.lane;
    const v4u xa = *(const GAS v4u*)(XN2 + row * 1024 + 8 * lane), xb = *(const GAS v4u*)(XN2 + row * 1024 + 512 + 8 * lane);
    const int id0 = IDX[row * 128 + lane], id1 = IDX[row * 128 + 64 + lane];
    const float g0 = GATE[row * 128 + lane], g1 = GATE[row * 128 + 64 + lane];
    float acc[16];
#pragma unroll
    for (int i = 0; i < 16; ++i) acc[i] = 0.f;
#define PEER_DOT2(w, x, a) dot2_bf16((w), (x), (a))
    for (int half = 0; half < 2; ++half) {
        const int idv = half ? id1 : id0; const float gv = half ? g1 : g0;
        for (int e0 = 0; e0 < 64; e0 += 4) {
            v4u ua[4], ub[4], va[4], vb[4]; float gt[4];
#pragma unroll
            for (int j = 0; j < 4; ++j) {
                const int id = __builtin_amdgcn_readlane(idv, e0 + j); gt[j] = __uint_as_float(__builtin_amdgcn_readlane(__float_as_uint(gv), e0 + j));
                const bf16* up = F_UB + (size_t)id * 1024; const bf16* vp = F_VB + (size_t)id * 1024;
                ua[j] = *(const GAS v4u*)(up + 8 * lane); ub[j] = *(const GAS v4u*)(up + 512 + 8 * lane);
                va[j] = *(const GAS v4u*)(vp + 8 * lane); vb[j] = *(const GAS v4u*)(vp + 512 + 8 * lane);
            }
#pragma unroll
            for (int j = 0; j < 4; ++j) {
                float d0 = 0.f, d1 = 0.f;
                d0 = PEER_DOT2(ua[j].x, xa.x, d0); d1 = PEER_DOT2(ua[j].y, xa.y, d1); d0 = PEER_DOT2(ua[j].z, xa.z, d0); d1 = PEER_DOT2(ua[j].w, xa.w, d1);
                d0 = PEER_DOT2(ub[j].x, xb.x, d0); d1 = PEER_DOT2(ub[j].y, xb.y, d1); d0 = PEER_DOT2(ub[j].z, xb.z, d0); d1 = PEER_DOT2(ub[j].w, xb.w, d1);
                const float a = wave_sum(d0 + d1);
                const float cf = gt[j] * gelu_tanh_f(a);
                acc[0] += cf * bflo(va[j].x); acc[1] += cf * bfhi(va[j].x); acc[2] += cf * bflo(va[j].y); acc[3] += cf * bfhi(va[j].y);
                acc[4] += cf * bflo(va[j].z); acc[5] += cf * bfhi(va[j].z); acc[6] += cf * bflo(va[j].w); acc[7] += cf * bfhi(va[j].w);
                acc[8] += cf * bflo(vb[j].x); acc[9] += cf * bfhi(vb[j].x); acc[10] += cf * bflo(vb[j].y); acc[11] += cf * bfhi(vb[j].y);
                acc[12] += cf * bflo(vb[j].z); acc[13] += cf * bfhi(vb[j].z); acc[14] += cf * bflo(vb[j].w); acc[15] += cf * bfhi(vb[j].w);
            }
        }
    }
#undef PEER_DOT2
    float* hp = F.out + row * 1024;
    f32x4 y[4]; const int c0 = 8 * lane, c1 = 512 + 8 * lane;
    y[0] = *(const GAS f32x4*)(hp + c0); y[1] = *(const GAS f32x4*)(hp + c0 + 4); y[2] = *(const GAS f32x4*)(hp + c1); y[3] = *(const GAS f32x4*)(hp + c1 + 4);
    float ss = 0.f;
#pragma unroll
    for (int i = 0; i < 4; ++i) { y[i].x += acc[4 * i]; y[i].y += acc[4 * i + 1]; y[i].z += acc[4 * i + 2]; y[i].w += acc[4 * i + 3]; ss += (y[i].x * y[i].x + y[i].y * y[i].y) + (y[i].z * y[i].z + y[i].w * y[i].w); }
    const float rs = 1.f / sqrtf(wave_sum(ss) * (1.f / 1024.f) + EPS);
    const f32x4 g0v = *(const GAS f32x4*)(A.in[20] + c0), g1v = *(const GAS f32x4*)(A.in[20] + c0 + 4), g2v = *(const GAS f32x4*)(A.in[20] + c1), g3v = *(const GAS f32x4*)(A.in[20] + c1 + 4);
    *(GAS f32x4*)(hp + c0) = y[0] * rs * g0v; *(GAS f32x4*)(hp + c0 + 4) = y[1] * rs * g1v; *(GAS f32x4*)(hp + c1) = y[2] * rs * g2v; *(GAS f32x4*)(hp + c1 + 4) = y[3] * rs * g3v;
}
template <int TPW> DI void peer_gather_sweep(Frame& F, const Args& A, const int* IDX, const float* GATE, size_t tok0) {
    const int lane = F.lane;
    const unsigned char* U8 = F.ws + WS_U8; const unsigned char* V8 = F.ws + WS_V8; const unsigned char* X8 = F.ws + WS_X8;
    const float* SU = (const float*)(F.ws + WS_SU); const float* SX = (const float*)(F.ws + WS_SX);
    f32x2 acc[TPW][8]; v4u xq[TPW]; int idlo[TPW], idhi[TPW]; float glo[TPW], ghi[TPW], sxv[TPW];
#pragma unroll
    for (int tl = 0; tl < TPW; ++tl) {
        const size_t t = tok0 + tl;
#pragma unroll
        for (int i = 0; i < 8; ++i) acc[tl][i] = (f32x2){0.f, 0.f};
        xq[tl] = *(const GAS v4u*)(X8 + t * 1024 + 16 * lane);
        idlo[tl] = IDX[t * 128 + lane]; idhi[tl] = IDX[t * 128 + 64 + lane]; glo[tl] = GATE[t * 128 + lane]; ghi[tl] = GATE[t * 128 + 64 + lane];
        sxv[tl] = SX[t] * (1.f / 64.f);
    }
    const int l3 = lane & 3; const bool b0 = lane & 1, b1 = lane & 2;
    for (int s = 0; s < 32; ++s) {
#pragma unroll
        for (int tl = 0; tl < TPW; ++tl) {
            unsigned long long mlo = __ballot((idlo[tl] >> 9) == s), mhi = __ballot((idhi[tl] >> 9) == s);
            while (mlo | mhi) {
                int id[4]; float g[4];
#pragma unroll
                for (int j = 0; j < 4; ++j) {
                    if (mlo) { const int e = __builtin_ctzll(mlo); mlo &= mlo - 1; id[j] = __builtin_amdgcn_readlane(idlo[tl], e); g[j] = __uint_as_float(__builtin_amdgcn_readlane(__float_as_uint(glo[tl]), e)); }
                    else if (mhi) { const int e = __builtin_ctzll(mhi); mhi &= mhi - 1; id[j] = __builtin_amdgcn_readlane(idhi[tl], e); g[j] = __uint_as_float(__builtin_amdgcn_readlane(__float_as_uint(ghi[tl]), e)); }
                    else { id[j] = id[0]; g[j] = 0.f; }
                }
                v4u uu[4], vv[4]; float su[4]; int p[4];
#pragma unroll
                for (int j = 0; j < 4; ++j) { uu[j] = *(const GAS v4u*)(U8 + (size_t)id[j] * 1024 + 16 * lane); vv[j] = *(const GAS v4u*)(V8 + (size_t)id[j] * 1024 + 16 * lane); su[j] = SU[id[j]]; }
#pragma unroll
                for (int j = 0; j < 4; ++j) { int d = __builtin_amdgcn_sdot4((int)uu[j].x, (int)xq[tl].x, 0, false); d = __builtin_amdgcn_sdot4((int)uu[j].y, (int)xq[tl].y, d, false);
                    d = __builtin_amdgcn_sdot4((int)uu[j].z, (int)xq[tl].z, d, false); p[j] = __builtin_amdgcn_sdot4((int)uu[j].w, (int)xq[tl].w, d, false); }
                const int kA = b0 ? p[1] : p[0], sA = b0 ? p[0] : p[1], kB = b0 ? p[3] : p[2], sB = b0 ? p[2] : p[3];
                const int qA = kA + dpp_i<0xB1>(sA), qB = kB + dpp_i<0xB1>(sB);
                const int kk = b1 ? qB : qA, ss = b1 ? qA : qB;
                int r = kk + dpp_i<0x4E>(ss);
                r += dpp_i<0x124>(r); r += dpp_i<0x128>(r);
                r += __shfl_xor(r, 16); r += __shfl_xor(r, 32);
                const float sus = l3 == 0 ? su[0] : l3 == 1 ? su[1] : l3 == 2 ? su[2] : su[3];
                const float gs = l3 == 0 ? g[0] : l3 == 1 ? g[1] : l3 == 2 ? g[2] : g[3];
                const float a = (float)r * sus * (sxv[tl] * 64.f);
                const float cfl = gs * gelu_tanh_f(a) * (1.f / 64.f);
#pragma unroll
                for (int j = 0; j < 4; ++j) {
                    const float cf = __uint_as_float(__builtin_amdgcn_readlane(__float_as_uint(cfl), j)); const f32x2 c2 = {cf, cf};
#pragma unroll
                    for (int w = 0; w < 4; ++w) { acc[tl][2 * w] = __builtin_amdgcn_cvt_pk_f32_fp8((int)vv[j][w], false) * c2 + acc[tl][2 * w]; acc[tl][2 * w + 1] = __builtin_amdgcn_cvt_pk_f32_fp8((int)vv[j][w], true) * c2 + acc[tl][2 * w + 1]; }
                }
            }
        }
    }
#pragma unroll
    for (int tl = 0; tl < TPW; ++tl) {
        float* hp = F.out + (tok0 + tl) * 1024 + 16 * lane;
        f32x4 y[4]; float ssq = 0.f;
#pragma unroll
        for (int i = 0; i < 4; ++i) { y[i] = *(const GAS f32x4*)(hp + 4 * i); y[i].x += acc[tl][2 * i].x; y[i].y += acc[tl][2 * i].y; y[i].z += acc[tl][2 * i + 1].x; y[i].w += acc[tl][2 * i + 1].y;
            ssq += (y[i].x * y[i].x + y[i].y * y[i].y) + (y[i].z * y[i].z + y[i].w * y[i].w); }
        const float rs = 1.f / sqrtf(wave_sum(ssq) * (1.f / 1024.f) + EPS);
#pragma unroll
        for (int i = 0; i < 4; ++i) { const f32x4 gv = *(const GAS f32x4*)(A.in[20] + 16 * lane + 4 * i); *(GAS f32x4*)(hp + 4 * i) = y[i] * rs * gv; }
    }
}
constexpr int GL3_LIST = 0, GL3_X = 65536;
struct G3Buf { v4u uu[4], vv[4], xx[4]; };
template <int TPW> DI void g3_issue(G3Buf& B, v4u& E, const LAS unsigned char* list, const LAS unsigned char* xl, const unsigned char* U8, const unsigned char* V8, int b, int lane) {
    E = *(const LAS v4u*)(list + (4 * b + (lane & 3)) * 16);
#pragma unroll
    for (int j = 0; j < 4; ++j) {
        const unsigned w = (unsigned)__builtin_amdgcn_readlane((int)E.x, j); const unsigned id = w & 0xffffu, tl = w >> 16;
        B.uu[j] = *(const GAS v4u*)(U8 + (size_t)id * 1024 + 16 * lane); B.vv[j] = *(const GAS v4u*)(V8 + (size_t)id * 1024 + 16 * lane);
        B.xx[j] = *(const LAS v4u*)(xl + tl * 1024 + 16 * lane);
    }
}
template <int TPW> DI void g3_compute(f32x2 (&acc)[TPW][8], const G3Buf& B, const v4u& E, int lane) {
    int p[4];
#pragma unroll
    for (int j = 0; j < 4; ++j) { int d = __builtin_amdgcn_sdot4((int)B.uu[j].x, (int)B.xx[j].x, 0, false); d = __builtin_amdgcn_sdot4((int)B.uu[j].y, (int)B.xx[j].y, d, false);
        d = __builtin_amdgcn_sdot4((int)B.uu[j].z, (int)B.xx[j].z, d, false); p[j] = __builtin_amdgcn_sdot4((int)B.uu[j].w, (int)B.xx[j].w, d, false); }
    const bool b0 = lane & 1, b1 = lane & 2;
    const int kA = b0 ? p[1] : p[0], sA = b0 ? p[0] : p[1], kB = b0 ? p[3] : p[2], sB = b0 ? p[2] : p[3];
    const int qA = kA + dpp_i<0xB1>(sA), qB = kB + dpp_i<0xB1>(sB);
    const int kk = b1 ? qB : qA, ss = b1 ? qA : qB;
    int r = kk + dpp_i<0x4E>(ss);
    r += dpp_i<0x124>(r); r += dpp_i<0x128>(r);
    r += __shfl_xor(r, 16); r += __shfl_xor(r, 32);
    const float a = (float)r * __uint_as_float(E.z);
    const float cfl = __uint_as_float(E.y) * gelu_tanh_f(a);
#pragma unroll
    for (int j = 0; j < 4; ++j) {
        const float cf = __uint_as_float(__builtin_amdgcn_readlane(__float_as_uint(cfl), j)); const f32x2 c2 = {cf, cf};
        const unsigned tl = (unsigned)__builtin_amdgcn_readlane((int)E.x, j) >> 16;
#pragma unroll
        for (int t = 0; t < TPW; ++t) if (tl == (unsigned)t) { asm volatile("; acc case %0" :: "n"(t));
#pragma unroll
            for (int w = 0; w < 4; ++w) { acc[t][2 * w] = __builtin_amdgcn_cvt_pk_f32_fp8((int)B.vv[j][w], false) * c2 + acc[t][2 * w]; acc[t][2 * w + 1] = __builtin_amdgcn_cvt_pk_f32_fp8((int)B.vv[j][w], true) * c2 + acc[t][2 * w + 1]; }
            asm volatile("; acc case %0 end" :: "n"(t));
        }
    }
}
template <int TPW> DI void peer_gather_sweep3(Frame& F, const Args& A, const int* IDX, const float* GATE, size_t tok0) {
    const int lane = F.lane, wid = F.wave;
    const unsigned char* U8 = F.ws + WS_U8; const unsigned char* V8 = F.ws + WS_V8; const unsigned char* X8 = F.ws + WS_X8;
    const float* SU = (const float*)(F.ws + WS_SU); const float* SX = (const float*)(F.ws + WS_SX);
    LAS unsigned char* list = F.lds + GL3_LIST + wid * (TPW * 2048); LAS unsigned char* xl = F.lds + GL3_X + wid * (TPW * 1024);
    {
        int idlo[TPW], idhi[TPW]; float glo[TPW], ghi[TPW], slo[TPW], shi[TPW];
#pragma unroll
        for (int tl = 0; tl < TPW; ++tl) { const size_t t = tok0 + tl;
            *(LAS v4u*)(xl + tl * 1024 + 16 * lane) = *(const GAS v4u*)(X8 + t * 1024 + 16 * lane);
            idlo[tl] = IDX[t * 128 + lane]; idhi[tl] = IDX[t * 128 + 64 + lane]; const float sx = SX[t];
            glo[tl] = GATE[t * 128 + lane] * (1.f / 64.f); ghi[tl] = GATE[t * 128 + 64 + lane] * (1.f / 64.f);
            slo[tl] = SU[idlo[tl]] * sx; shi[tl] = SU[idhi[tl]] * sx; }
        int base = 0;
        for (int s = 0; s < 32; ++s) {
#pragma unroll
            for (int tl = 0; tl < TPW; ++tl) {
                { const bool m = (idlo[tl] >> 9) == s; const unsigned long long mk = __ballot(m); const int pos = base + (int)__builtin_amdgcn_mbcnt_hi((unsigned)(mk >> 32), __builtin_amdgcn_mbcnt_lo((unsigned)mk, 0u));
                  if (m) *(LAS v4u*)(list + pos * 16) = (v4u){(unsigned)idlo[tl] | ((unsigned)tl << 16), __float_as_uint(glo[tl]), __float_as_uint(slo[tl]), 0u};
                  base += __builtin_popcountll(mk); }
                { const bool m = (idhi[tl] >> 9) == s; const unsigned long long mk = __ballot(m); const int pos = base + (int)__builtin_amdgcn_mbcnt_hi((unsigned)(mk >> 32), __builtin_amdgcn_mbcnt_lo((unsigned)mk, 0u));
                  if (m) *(LAS v4u*)(list + pos * 16) = (v4u){(unsigned)idhi[tl] | ((unsigned)tl << 16), __float_as_uint(ghi[tl]), __float_as_uint(shi[tl]), 0u};
                  base += __builtin_popcountll(mk); }
            }
        }
    }
    LDS_WAIT(); asm volatile("" ::: "memory");
    f32x2 acc[TPW][8];
#pragma unroll
    for (int tl = 0; tl < TPW; ++tl)
#pragma unroll
        for (int i = 0; i < 8; ++i) acc[tl][i] = (f32x2){0.f, 0.f};
    constexpr int NB = TPW * 32;
    G3Buf BA, BB; v4u EA, EB;
    g3_issue<TPW>(BA, EA, list, xl, U8, V8, 0, lane);
    for (int b = 0; b < NB; b += 2) {
        g3_issue<TPW>(BB, EB, list, xl, U8, V8, b + 1, lane);
        g3_compute<TPW>(acc, BA, EA, lane);
        g3_issue<TPW>(BA, EA, list, xl, U8, V8, (b + 2 < NB) ? b + 2 : NB - 1, lane);
        g3_compute<TPW>(acc, BB, EB, lane);
    }
#pragma unroll
    for (int tl = 0; tl < TPW; ++tl) {
        float* hp = F.out + (tok0 + tl) * 1024 + 16 * lane;
        f32x4 y[4]; float ssq = 0.f;
#pragma unroll
        for (int i = 0; i < 4; ++i) { y[i] = *(const GAS f32x4*)(hp + 4 * i); y[i].x += acc[tl][2 * i].x; y[i].y += acc[tl][2 * i].y; y[i].z += acc[tl][2 * i + 1].x; y[i].w += acc[tl][2 * i + 1].y;
            ssq += (y[i].x * y[i].x + y[i].y * y[i].y) + (y[i].z * y[i].z + y[i].w * y[i].w); }
        const float rs = 1.f / sqrtf(wave_sum(ssq) * (1.f / 1024.f) + EPS);
#pragma unroll
        for (int i = 0; i < 4; ++i) { const f32x4 gv = *(const GAS f32x4*)(A.in[20] + 16 * lane + 4 * i); *(GAS f32x4*)(hp + 4 * i) = y[i] * rs * gv; }
    }
    LDS_WAIT(); asm volatile("" ::: "memory");
}
constexpr int G5_NSH = 16, G5_SHIFT = 10;
struct G5Buf { v4u uu[4], vv[4]; };
DI void g5_issue(G5Buf& B, v4u& E, const LAS unsigned char* tlist, const unsigned char* U8, const unsigned char* V8, int k, int lane) {
    E = *(const LAS v4u*)(tlist + (4 * k + (lane & 3)) * 16);
#pragma unroll
    for (int j = 0; j < 4; ++j) {
        const unsigned id = (unsigned)__builtin_amdgcn_readlane((int)E.x, j);
        B.uu[j] = *(const GAS v4u*)(U8 + (size_t)id * 1024 + 16 * lane); B.vv[j] = *(const GAS v4u*)(V8 + (size_t)id * 1024 + 16 * lane);
    }
}
DI void g5_compute(f32x2 (&acc)[8], const v4u& xx, const G5Buf& B, const v4u& E, int lane) {
    int p[4];
#pragma unroll
    for (int j = 0; j < 4; ++j) { int d = __builtin_amdgcn_sdot4((int)B.uu[j].x, (int)xx.x, 0, false); d = __builtin_amdgcn_sdot4((int)B.uu[j].y, (int)xx.y, d, false);
        d = __builtin_amdgcn_sdot4((int)B.uu[j].z, (int)xx.z, d, false); p[j] = __builtin_amdgcn_sdot4((int)B.uu[j].w, (int)xx.w, d, false); }
    const bool b0 = lane & 1, b1 = lane & 2;
    const int kA = b0 ? p[1] : p[0], sA = b0 ? p[0] : p[1], kB = b0 ? p[3] : p[2], sB = b0 ? p[2] : p[3];
    const int qA = kA + dpp_i<0xB1>(sA), qB = kB + dpp_i<0xB1>(sB);
    const int kk = b1 ? qB : qA, ss = b1 ? qA : qB;
    int r = kk + dpp_i<0x4E>(ss);
    r += dpp_i<0x124>(r); r += dpp_i<0x128>(r);
    r += __shfl_xor(r, 16); r += __shfl_xor(r, 32);
    const float a = (float)r * __uint_as_float(E.z);
    const float y = 0.7978845608028654f * (a + 0.044715f * a * a * a);
    const float th = 1.f - 2.f * __builtin_amdgcn_rcpf(1.f + __expf(2.f * y));
    const float cfl = __uint_as_float(E.y) * 0.5f * a * (1.f + th);
#pragma unroll
    for (int j = 0; j < 4; ++j) { const float cf = __uint_as_float(__builtin_amdgcn_readlane(__float_as_uint(cfl), j)); const f32x2 c2 = {cf, cf};
#pragma unroll
        for (int w = 0; w < 4; ++w) { acc[2 * w] = __builtin_amdgcn_cvt_pk_f32_fp8((int)B.vv[j][w], false) * c2 + acc[2 * w]; acc[2 * w + 1] = __builtin_amdgcn_cvt_pk_f32_fp8((int)B.vv[j][w], true) * c2 + acc[2 * w + 1]; } }
}
DI void peer_gather_sweep5(Frame& F, const Args& A, const int* IDX, const float* GATE, size_t tok0) {
    constexpr int TPW = 4;
    const int lane = F.lane, wid = F.wave;
    const unsigned char* U8 = F.ws + WS_U8; const unsigned char* V8 = F.ws + WS_V8; const unsigned char* X8 = F.ws + WS_X8;
    const float* SU = (const float*)(F.ws + WS_SU); const float* SX = (const float*)(F.ws + WS_SX);
    LAS unsigned char* list = F.lds + wid * (TPW * 2048);
    v4u xq[TPW];
#pragma unroll
    for (int tl = 0; tl < TPW; ++tl) {
        const size_t t = tok0 + tl;
        xq[tl] = *(const GAS v4u*)(X8 + t * 1024 + 16 * lane);
        const int idlo = IDX[t * 128 + lane], idhi = IDX[t * 128 + 64 + lane]; const float sx = SX[t];
        const float glo = GATE[t * 128 + lane] * (1.f / 64.f), ghi = GATE[t * 128 + 64 + lane] * (1.f / 64.f);
        const float slo = SU[idlo] * sx, shi = SU[idhi] * sx;
        LAS unsigned char* tl_list = list + tl * 2048;
        int base = 0;
        for (int s = 0; s < G5_NSH; ++s) {
            { const bool m = (idlo >> G5_SHIFT) == s; const unsigned long long mk = __ballot(m); const int pos = base + (int)__builtin_amdgcn_mbcnt_hi((unsigned)(mk >> 32), __builtin_amdgcn_mbcnt_lo((unsigned)mk, 0u));
              if (m) *(LAS v4u*)(tl_list + pos * 16) = (v4u){(unsigned)idlo, __float_as_uint(glo), __float_as_uint(slo), 0u};
              base += __builtin_popcountll(mk); }
            { const bool m = (idhi >> G5_SHIFT) == s; const unsigned long long mk = __ballot(m); const int pos = base + (int)__builtin_amdgcn_mbcnt_hi((unsigned)(mk >> 32), __builtin_amdgcn_mbcnt_lo((unsigned)mk, 0u));
              if (m) *(LAS v4u*)(tl_list + pos * 16) = (v4u){(unsigned)idhi, __float_as_uint(ghi), __float_as_uint(shi), 0u};
              base += __builtin_popcountll(mk); }
        }
    }
    LDS_WAIT(); asm volatile("" ::: "memory");
    f32x2 acc[TPW][8];
#pragma unroll
    for (int tl = 0; tl < TPW; ++tl)
#pragma unroll
        for (int i = 0; i < 8; ++i) acc[tl][i] = (f32x2){0.f, 0.f};
    G5Buf BA, BB; v4u EA, EB;
    g5_issue(BA, EA, list, U8, V8, 0, lane);
    for (int k = 0; k < 32; ++k) {
        g5_issue(BB, EB, list + 2048, U8, V8, k, lane);      g5_compute(acc[0], xq[0], BA, EA, lane);
        g5_issue(BA, EA, list + 4096, U8, V8, k, lane);      g5_compute(acc[1], xq[1], BB, EB, lane);
        g5_issue(BB, EB, list + 6144, U8, V8, k, lane);      g5_compute(acc[2], xq[2], BA, EA, lane);
        g5_issue(BA, EA, list, U8, V8, k < 31 ? k + 1 : 31, lane);   g5_compute(acc[3], xq[3], BB, EB, lane);
    }
#pragma unroll
    for (int tl = 0; tl < TPW; ++tl) {
        float* hp = F.out + (tok0 + tl) * 1024 + 16 * lane;
        f32x4 y[4]; float ssq = 0.f;
#pragma unroll
        for (int i = 0; i < 4; ++i) { y[i] = *(const GAS f32x4*)(hp + 4 * i); y[i].x += acc[tl][2 * i].x; y[i].y += acc[tl][2 * i].y; y[i].z += acc[tl][2 * i + 1].x; y[i].w += acc[tl][2 * i + 1].y;
            ssq += (y[i].x * y[i].x + y[i].y * y[i].y) + (y[i].z * y[i].z + y[i].w * y[i].w); }
        const float rs = 1.f / sqrtf(wave_sum(ssq) * (1.f / 1024.f) + EPS);
#pragma unroll
        for (int i = 0; i < 4; ++i) { const f32x4 gv = *(const GAS f32x4*)(A.in[20] + 16 * lane + 4 * i); *(GAS f32x4*)(hp + 4 * i) = y[i] * rs * gv; }
    }
    LDS_WAIT(); asm volatile("" ::: "memory");
}
constexpr int G6_NSH = 16, G6_SHIFT = 10, G6_TPW = 8;
DI void g6_issue(v4u (&R)[4], v4u& E, const LAS unsigned char* tlist, const unsigned char* TAB, int k, int lane) {
    E = *(const LAS v4u*)(tlist + (4 * k + (lane & 3)) * 16);
#pragma unroll
    for (int j = 0; j < 4; ++j) { const unsigned id = (unsigned)__builtin_amdgcn_readlane((int)E.x, j); R[j] = *(const GAS v4u*)(TAB + (size_t)id * 1024 + 16 * lane); }
}
DI void g6_dot(const v4u& xx, const v4u (&U)[4], const v4u& E, LAS unsigned char* tlist, int k, int lane) {
    int p[4];
#pragma unroll
    for (int j = 0; j < 4; ++j) { int d = __builtin_amdgcn_sdot4((int)U[j].x, (int)xx.x, 0, false); d = __builtin_amdgcn_sdot4((int)U[j].y, (int)xx.y, d, false);
        d = __builtin_amdgcn_sdot4((int)U[j].z, (int)xx.z, d, false); p[j] = __builtin_amdgcn_sdot4((int)U[j].w, (int)xx.w, d, false); }
    const bool b0 = lane & 1, b1 = lane & 2;
    const int kA = b0 ? p[1] : p[0], sA = b0 ? p[0] : p[1], kB = b0 ? p[3] : p[2], sB = b0 ? p[2] : p[3];
    const int qA = kA + dpp_i<0xB1>(sA), qB = kB + dpp_i<0xB1>(sB);
    const int kk = b1 ? qB : qA, ss = b1 ? qA : qB;
    int r = kk + dpp_i<0x4E>(ss);
    r += dpp_i<0x124>(r); r += dpp_i<0x128>(r);
    r += __shfl_xor(r, 16); r += __shfl_xor(r, 32);
    const float a = (float)r * __uint_as_float(E.z);
    const float y = 0.7978845608028654f * (a + 0.044715f * a * a * a);
    const float th = 1.f - 2.f * __builtin_amdgcn_rcpf(1.f + __expf(2.f * y));
    const float cfl = __uint_as_float(E.y) * 0.5f * a * (1.f + th);
    if (lane < 4) *(LAS float*)(tlist + (4 * k + lane) * 16 + 4) = cfl;
}
typedef _Float16 h2_t __attribute__((ext_vector_type(2)));
DI void g6_fma(h2_t (&acc)[8], const v4u (&V)[4], const v4u& E, int lane) {
#pragma unroll
    for (int j = 0; j < 4; ++j) { const float cf = __uint_as_float(__builtin_amdgcn_readlane((int)E.y, j)); const _Float16 ch = (_Float16)cf; const h2_t c2 = {ch, ch};
#pragma unroll
        for (int w = 0; w < 4; ++w) {
            acc[2 * w] = __builtin_elementwise_fma(__builtin_bit_cast(h2_t, __builtin_amdgcn_cvt_scalef32_pk_f16_fp8(V[j][w], 1.0f, false)), c2, acc[2 * w]);
            acc[2 * w + 1] = __builtin_elementwise_fma(__builtin_bit_cast(h2_t, __builtin_amdgcn_cvt_scalef32_pk_f16_fp8(V[j][w], 1.0f, true)), c2, acc[2 * w + 1]); } }
}
DI void peer_gather_wave6(Frame& F, const Args& A, const bf16* XN2, const float* SS2, const int* IDX, const float* GATE, size_t tok0) {
    constexpr int TPW = G6_TPW;
    const int lane = F.lane, wid = F.wave;
    const unsigned char* U8 = F.ws + WS_U8; const unsigned char* V8 = F.ws + WS_V8;
    const float* SU = (const float*)(F.ws + WS_SU);
    LAS unsigned char* list = F.lds + wid * (TPW * 2048);
    v4u xq[TPW];
#pragma unroll
    for (int tl = 0; tl < TPW; ++tl) {
        const size_t t = tok0 + tl;
        float sx;
        {
            const v4u h0 = *(const GAS v4u*)(XN2 + t * 1024 + 16 * lane), h1 = *(const GAS v4u*)(XN2 + t * 1024 + 16 * lane + 8);
            float xv[16];
#pragma unroll
            for (int i = 0; i < 4; ++i) { xv[2 * i] = bflo(h0[i]); xv[2 * i + 1] = bfhi(h0[i]); xv[8 + 2 * i] = bflo(h1[i]); xv[8 + 2 * i + 1] = bfhi(h1[i]); }
            {
                const f32x4* sp = (const f32x4*)(SS2 + t * 16); const f32x4 a = sp[0], b = sp[1], c = sp[2], d = sp[3];
                const float tt = ((a[0] + a[1]) + (a[2] + a[3])) + ((b[0] + b[1]) + (b[2] + b[3])) + ((c[0] + c[1]) + (c[2] + c[3])) + ((d[0] + d[1]) + (d[2] + d[3]));
                const float rs = 1.0f / sqrtf(tt * (1.0f / 1024.0f) + EPS);
#pragma unroll
                for (int i = 0; i < 4; ++i) { const f32x4 gv = *(const GAS f32x4*)(A.in[15] + 16 * lane + 4 * i); xv[4 * i] *= rs * gv.x; xv[4 * i + 1] *= rs * gv.y; xv[4 * i + 2] *= rs * gv.z; xv[4 * i + 3] *= rs * gv.w; }
            }
            float mx = 0.f;
#pragma unroll
            for (int i = 0; i < 16; ++i) mx = fmaxf(mx, fabsf(xv[i]));
            mx = wave_max(mx); sx = mx > 0.f ? mx * (1.f / 127.f) : 1.f; const float inv = 1.f / sx;
#pragma unroll
            for (int i = 0; i < 4; ++i) { const int a = (int)rintf(xv[4 * i] * inv), b = (int)rintf(xv[4 * i + 1] * inv), c = (int)rintf(xv[4 * i + 2] * inv), d = (int)rintf(xv[4 * i + 3] * inv);
                xq[tl][i] = (unsigned)(a & 255) | ((unsigned)(b & 255) << 8) | ((unsigned)(c & 255) << 16) | ((unsigned)(d & 255) << 24); }
        }
        const int idlo = IDX[t * 128 + lane], idhi = IDX[t * 128 + 64 + lane];
        const float glo = GATE[t * 128 + lane], ghi = GATE[t * 128 + 64 + lane];
        const float slo = SU[idlo] * sx, shi = SU[idhi] * sx;
        LAS unsigned char* tl_list = list + tl * 2048;
        int base = 0;
        for (int s = 0; s < G6_NSH; ++s) {
            { const bool m = (idlo >> G6_SHIFT) == s; const unsigned long long mk = __ballot(m); const int pos = base + (int)__builtin_amdgcn_mbcnt_hi((unsigned)(mk >> 32), __builtin_amdgcn_mbcnt_lo((unsigned)mk, 0u));
              if (m) *(LAS v4u*)(tl_list + pos * 16) = (v4u){(unsigned)idlo, __float_as_uint(glo), __float_as_uint(slo), 0u};
              base += __builtin_popcountll(mk); }
            { const bool m = (idhi >> G6_SHIFT) == s; const unsigned long long mk = __ballot(m); const int pos = base + (int)__builtin_amdgcn_mbcnt_hi((unsigned)(mk >> 32), __builtin_amdgcn_mbcnt_lo((unsigned)mk, 0u));
              if (m) *(LAS v4u*)(tl_list + pos * 16) = (v4u){(unsigned)idhi, __float_as_uint(ghi), __float_as_uint(shi), 0u};
              base += __builtin_popcountll(mk); }
        }
    }
    LDS_WAIT(); asm volatile("" ::: "memory");
#define G6_SB __builtin_amdgcn_sched_barrier(0)
    {
        v4u RA[4], RB[4]; v4u EA, EB;
        g6_issue(RA, EA, list, U8, 0, lane);
        for (int k = 0; k < 32; ++k) {
#define G6_P1(RI, EI, tn, kn, RC, EC, tc) do { g6_issue(RI, EI, list + (tn) * 2048, U8, kn, lane); G6_SB; g6_dot(xq[tc], RC, EC, list + (tc) * 2048, k, lane); G6_SB; } while (0)
            G6_P1(RB, EB, 1, k, RA, EA, 0); G6_P1(RA, EA, 2, k, RB, EB, 1); G6_P1(RB, EB, 3, k, RA, EA, 2); G6_P1(RA, EA, 4, k, RB, EB, 3);
            G6_P1(RB, EB, 5, k, RA, EA, 4); G6_P1(RA, EA, 6, k, RB, EB, 5); G6_P1(RB, EB, 7, k, RA, EA, 6); G6_P1(RA, EA, 0, (k < 31 ? k + 1 : 31), RB, EB, 7);
#undef G6_P1
        }
    }
    LDS_WAIT(); asm volatile("" ::: "memory");
    h2_t acc[TPW][8];
#pragma unroll
    for (int tl = 0; tl < TPW; ++tl)
#pragma unroll
        for (int i = 0; i < 8; ++i) acc[tl][i] = (h2_t){(_Float16)0.f, (_Float16)0.f};
    {
        v4u RA[4], RB[4]; v4u EA, EB;
        g6_issue(RA, EA, list, V8, 0, lane);
        for (int k = 0; k < 32; ++k) {
#define G6_P2(RI, EI, tn, kn, RC, EC, tc) do { g6_issue(RI, EI, list + (tn) * 2048, V8, kn, lane); G6_SB; g6_fma(acc[tc], RC, EC, lane); G6_SB; } while (0)
            G6_P2(RB, EB, 1, k, RA, EA, 0); G6_P2(RA, EA, 2, k, RB, EB, 1); G6_P2(RB, EB, 3, k, RA, EA, 2); G6_P2(RA, EA, 4, k, RB, EB, 3);
            G6_P2(RB, EB, 5, k, RA, EA, 4); G6_P2(RA, EA, 6, k, RB, EB, 5); G6_P2(RB, EB, 7, k, RA, EA, 6); G6_P2(RA, EA, 0, (k < 31 ? k + 1 : 31), RB, EB, 7);
#undef G6_P2
        }
    }
#undef G6_SB
#pragma unroll
    for (int tl = 0; tl < TPW; ++tl) {
        float* hp = F.out + (tok0 + tl) * 1024 + 16 * lane;
        const v4u r0 = *(const GAS v4u*)(XN2 + (tok0 + tl) * 1024 + 16 * lane), r1 = *(const GAS v4u*)(XN2 + (tok0 + tl) * 1024 + 16 * lane + 8);
        f32x4 y[4]; float ssq = 0.f;
        y[0] = (f32x4){bflo(r0.x), bfhi(r0.x), bflo(r0.y), bfhi(r0.y)}; y[1] = (f32x4){bflo(r0.z), bfhi(r0.z), bflo(r0.w), bfhi(r0.w)};
        y[2] = (f32x4){bflo(r1.x), bfhi(r1.x), bflo(r1.y), bfhi(r1.y)}; y[3] = (f32x4){bflo(r1.z), bfhi(r1.z), bflo(r1.w), bfhi(r1.w)};
#pragma unroll
        for (int i = 0; i < 4; ++i) { y[i].x += (float)acc[tl][2 * i].x * (1.f / 64.f); y[i].y += (float)acc[tl][2 * i].y * (1.f / 64.f); y[i].z += (float)acc[tl][2 * i + 1].x * (1.f / 64.f); y[i].w += (float)acc[tl][2 * i + 1].y * (1.f / 64.f);
            ssq += (y[i].x * y[i].x + y[i].y * y[i].y) + (y[i].z * y[i].z + y[i].w * y[i].w); }
        const float rs = 1.f / sqrtf(wave_sum(ssq) * (1.f / 1024.f) + EPS);
#pragma unroll
        for (int i = 0; i < 4; ++i) { const f32x4 gv = *(const GAS f32x4*)(A.in[20] + 16 * lane + 4 * i); *(GAS f32x4*)(hp + 4 * i) = y[i] * rs * gv; }
    }
    LDS_WAIT(); asm volatile("" ::: "memory");
}

constexpr size_t WS_XBUF = 73 * MiB;
constexpr int CW_SEAM = 16384, SEAM_BANK = 8192;
__global__ void __launch_bounds__(NWAVES * 64, 2) fwd_kernel(Args args) {
    extern __shared__ __attribute__((aligned(16))) unsigned char lds[];
    Frame F;
    F.lds = (LAS unsigned char*)lds;
    F.MISC = (volatile LAS unsigned*)(F.lds + MISC_OFF);
    F.tid = threadIdx.x; F.lane = F.tid & 63; F.wave = __builtin_amdgcn_readfirstlane(F.tid >> 6);
    F.G = gridDim.x; { const int bx = blockIdx.x; F.vcu = (F.G % 8 == 0) ? (bx % 8) * (F.G / 8) + bx / 8 : bx; }
    unsigned char* ws = args.ws;
    F.ctl = (gu32*)(ws + WS_CTL);
    F.out = args.out; F.ws = ws;
    for (int u = F.tid; u < (LDS_BYTES - LDSCTL_OFF) / 4; u += NWAVES * 64) ((LAS unsigned*)(F.lds + LDSCTL_OFF))[u] = 0u;
    __syncthreads();
    XcdBarrier bar = xcd_barrier_post((unsigned*)(F.ctl + CW_BAR) + args.li * XCD_BAR_WORDS, F.MISC + 8);
    const int lo = args.ph_lo, hi = args.ph_hi;
#ifndef PH_MASK
#define PH_MASK 0xffff
#endif
#define IN(k) (((PH_MASK >> (k)) & 1) && lo <= (k) && (k) < hi)
#define SEAM(k) do { if (IN(k) && IN((k) + 1)) xcd_barrier(bar); } while (0)
    const int gw = F.vcu * NWAVES + F.wave, NGW = F.G * NWAVES;
#define STW (F.out)
#define OSB (F.out + (size_t)M * 512)
#define IDX ((int*)F_BUFA)
#define GATE ((float*)(F_BUFA) + (size_t)M * 128)

    if (IN(0)) { p0_prologue(F, args); } SEAM(0);
    if (IN(1)) {
        { pg8::Gemm g{F_BUFA, F_W1T, 1024, 1024, 1024}; pg8::StaticOrder S; S.init(M, N1, F.G, (int)blockIdx.x, 1024, 1024);
          pg8::EpiBf16P E{F_PROJ, N1, 1.f};
          pg8::gemm_phase<pg8::EpiBf16P, pg8::StaticOrder, true, true>(F.lds, g, S, E); }
        { pg8::Gemm g{F_MN, F_WXKVT, 1024, 1024, 1024}; const int c = (int)blockIdx.x; pg8::OneUnitOrder S{(c >= 64 && c < 128) ? c - 64 : -1, 8, 1024, 1024};
          pg8::EpiBf16P E{F_KV, 2048, 1.f};
          pg8::gemm_phase<pg8::EpiBf16P, pg8::OneUnitOrder, true, true>(F.lds, g, S, E); }
        if (F.G == 256) { if ((int)blockIdx.x >= 128) { __syncthreads(); p0_late(F, args, ((int)blockIdx.x - 128) * NWAVES + F.wave, 128 * NWAVES); } }
        else { __syncthreads(); p0_late(F, args, gw, NGW); }
    } SEAM(1);
    if (IN(2)) {
        for (int it = F.vcu; it < 256; it += F.G) { const int bh = it >> 2, s = it & 3; sb_unit(F, OSB, bh >> 3, bh & 7, 7 - s); sb_unit(F, OSB, bh >> 3, bh & 7, s); }
        for (int it = F.vcu; it < 1024; it += F.G) { const int bh = it >> 5; gla_local_unit(F, args, STW, bh >> 2, bh & 3, it & 31); }
    } SEAM(2);
    if (IN(3)) { gla_scan(F, STW);
    } SEAM(3);
    if (IN(4)) {
        for (int it = F.vcu; it < 1024; it += F.G) { const int bh = it >> 5; gla_out_unit(F, args, STW, bh >> 2, bh & 3, it & 31); }
        for (int m = gw; m < M; m += NGW) mix_row_sb(F, args, OSB, (size_t)m);
    } SEAM(4);
    if (IN(5)) { pg8::Gemm g{F_BUFA, F_WOT, 1024, 1024, 1024}; pg8::StaticOrder S; S.init(M, 1024, F.G, (int)blockIdx.x, 1024, 1024);
        pg8::EpiResB<false> E{args.in[0], F_SLOT1, (float*)(ws + WS_XBUF), 1024};
        pg8::gemm_phase<pg8::EpiResB<false>, pg8::StaticOrder, true, true>(F.lds, g, S, E); } SEAM(5);
    if (IN(6)) { pg8::Gemm g{F_SLOT1, F_WXQT, 1024, 1024, 1024}; pg8::StaticOrder S; S.init(M, 1024, F.G, (int)blockIdx.x, 1024, 1024);
        pg8::EpiBf16RowScale E{F_SLOT2, 1024, (const float*)(ws + WS_XBUF), EPS};
        pg8::gemm_phase<pg8::EpiBf16RowScale, pg8::StaticOrder, true, true>(F.lds, g, S, E); } SEAM(6);
    if (IN(7)) { for (int it = F.vcu; it < 256; it += F.G) xattn_unit(F, F_SLOT2, F_SLOT0, it >> 5, (it >> 3) & 3, it & 7); } SEAM(7);
    if (IN(8)) { pg8::Gemm g{F_SLOT0, F_WXOT, 1024, 1024, 1024}; pg8::StaticOrder S; S.init(M, 1024, F.G, (int)blockIdx.x, 1024, 1024);
        pg8::EpiResB<true> E{F_SLOT1, F_SLOT2, (float*)(ws + WS_XBUF + MiB), 1024};
        pg8::gemm_phase<pg8::EpiResB<true>, pg8::StaticOrder, true, true>(F.lds, g, S, E); } SEAM(8);
    if (IN(9)) { pg8::Gemm g{F_SLOT2, F_WPQT, 1024, 1024, 1024}; pg8::StaticOrder S; S.init(M, 2048, F.G, (int)blockIdx.x, 1024, 1024);
        pg8::EpiBf16RowScale E{F_SLOT0, 2048, (const float*)(ws + WS_XBUF + MiB), EPS};
        pg8::gemm_phase<pg8::EpiBf16RowScale, pg8::StaticOrder, true, true>(F.lds, g, S, E); } SEAM(9);
    if (IN(10)) { peer_topk_mfma2(F, F_SLOT0, IDX, GATE); } SEAM(10);
    if (IN(11)) { peer_gather_wave6(F, args, F_SLOT2, (const float*)(ws + WS_XBUF + MiB), IDX, GATE, (size_t)F.vcu * 64 + F.wave * 8); }
#undef IN
#undef SEAM
}

constexpr int NPHASES = 12;
extern "C" void kernel_launch(void* const* d_in, const int* in_sizes, int n_in, void* d_out, int out_size, void* d_ws, size_t ws_size, hipStream_t stream) {
    static int grid = 0;
    if (grid == 0) {
        if (n_in != 21 || out_size != M * DM || ws_size < WS_END) { fprintf(stderr, "kernel_launch: unexpected shapes (n_in %d out %d ws %zu)\n", n_in, out_size, ws_size); grid = -1; return; }
        int dev = 0, cus = 0, per_cu = 0;
        if (hipGetDevice(&dev) != hipSuccess || hipDeviceGetAttribute(&cus, hipDeviceAttributeMultiprocessorCount, dev) != hipSuccess) { grid = -1; return; }
        if (hipFuncSetAttribute((const void*)fwd_kernel, hipFuncAttributeMaxDynamicSharedMemorySize, LDS_BYTES) != hipSuccess) { fprintf(stderr, "kernel_launch: hipFuncSetAttribute failed\n"); grid = -1; return; }
        if (hipOccupancyMaxActiveBlocksPerMultiprocessor(&per_cu, (const void*)fwd_kernel, NWAVES * 64, LDS_BYTES) != hipSuccess || per_cu < 1) { fprintf(stderr, "kernel_launch: occupancy query says %d\n", per_cu); }
        (void)hipGetLastError();
        grid = cus;
    }
    if (grid < 0) return;
    (void)hipMemsetAsync((char*)d_ws + WS_CTL, 0, CTL_ZERO_BYTES, stream);
    Args a{};
    for (int i = 0; i < 21; ++i) a.in[i] = (const float*)d_in[i];
    a.out = (float*)d_out; a.ws = (unsigned char*)d_ws;
#if defined(PROF_DUP_LO)
    a.ph_lo = 0; a.ph_hi = PROF_DUP_HI + 1; a.li = 0; hipLaunchKernelGGL(fwd_kernel, dim3(grid), dim3(NWAVES * 64), LDS_BYTES, stream, a);
    a.ph_lo = PROF_DUP_LO; a.ph_hi = NPHASES; a.li = 1; hipLaunchKernelGGL(fwd_kernel, dim3(grid), dim3(NWAVES * 64), LDS_BYTES, stream, a);
#elif defined(PROF_SPLIT)
    a.ph_lo = 0; a.ph_hi = PROF_SPLIT; a.li = 0; hipLaunchKernelGGL(fwd_kernel, dim3(grid), dim3(NWAVES * 64), LDS_BYTES, stream, a);
    a.ph_lo = PROF_SPLIT; a.ph_hi = NPHASES; a.li = 1; hipLaunchKernelGGL(fwd_kernel, dim3(grid), dim3(NWAVES * 64), LDS_BYTES, stream, a);
#else
    a.ph_lo = 0; a.ph_hi = NPHASES; a.li = 0;
    hipLaunchKernelGGL(fwd_kernel, dim3(grid), dim3(NWAVES * 64), LDS_BYTES, stream, a);
#endif
}
```

```cpp
#include <hip/hip_runtime.h>
#include <cstdio>
#include <cstdint>
namespace pg8 {
#define PG8_LAS __attribute__((address_space(3)))
typedef unsigned short bf16_t;
typedef short bf16x8 __attribute__((ext_vector_type(8)));
typedef float f32x4 __attribute__((ext_vector_type(4)));
typedef unsigned u32x4 __attribute__((ext_vector_type(4)));
constexpr int BM = 256, BK = 64, HALF = 128, HTB = HALF * BK * 2  , STAGE_BYTES = 8 * HTB, NXCD = 8, WGM = 8;

__host__ __device__ __forceinline__ int lds_byte(int r, int c) { const int st = (r >> 4) * 2 + (c >> 5), rr = r & 15, cc = c & 31, ob = rr * 64 + cc * 2; return st * 1024 + (ob ^ (((ob >> 9) & 1) << 5)); }
__host__ __device__ __forceinline__ void stage_rc(int b, int& R, int& C) { const int st = b / 1024, sb = b % 1024, swz = sb ^ (((sb >> 9) & 1) << 5); R = (st >> 1) * 16 + swz / 64; C = (st & 1) * 32 + (swz % 64) / 2; }
__host__ __device__ __forceinline__ int perm32(int rho) { const int n = rho >> 4, i = rho & 15; return 8 * (i >> 2) + 4 * n + (i & 3); }

struct Unit { int pm, pn; size_t aoff, boff; };
struct Gemm { const bf16_t* A; const bf16_t* Bt; int K, lda, ldb; };

struct StaticOrder {
    int nM, nN, nwg, G, c, lda, ldb;
    __host__ __device__ void init(int M, int N, int G_, int c_, int lda_, int ldb_) { nM = M / BM; nN = N / BM; nwg = nM * nN; G = G_; c = c_; lda = lda_; ldb = ldb_; }
    __host__ __device__ bool next(int i, Unit& u) const {
        const long L = (long)i * G + c; if (L >= nwg) return false;
        int wgid = (int)L; { const int q = nwg / NXCD, r = nwg % NXCD, xcd = wgid % NXCD, off = wgid / NXCD; wgid = (xcd < r ? xcd * (q + 1) : r * (q + 1) + (xcd - r) * q) + off; }
        const int nig = WGM * nN, gid = wgid / nig, fm = gid * WGM, gsz = (nM - fm) < WGM ? (nM - fm) : WGM;
        u.pm = fm + ((wgid % nig) % gsz); u.pn = (wgid % nig) / gsz; u.aoff = (size_t)u.pm * BM * lda * 2; u.boff = (size_t)u.pn * BM * ldb * 2; return true;
    }
    __device__ __forceinline__ void a_ready(const Unit&) const {}
    __device__ __forceinline__ void done(const Unit&) const {}
};

__device__ __forceinline__ unsigned cvt_pk_bf16(float lo, float hi) { unsigned r; asm volatile("v_cvt_pk_bf16_f32 %0, %1, %2" : "=v"(r) : "v"(lo), "v"(hi)); return r; }
typedef float f32x2 __attribute__((ext_vector_type(2)));
__device__ __forceinline__ f32x2 gelu_pk(f32x2 v) {
    const f32x2 av = __builtin_elementwise_abs(v), d = av * 0.2316418882f + 1.0f;
    f32x2 t; t.x = __builtin_amdgcn_rcpf(d.x); t.y = __builtin_amdgcn_rcpf(d.y);
    f32x2 q = t * 0.5307027145f + (-0.7265760135f); q = q * t + 0.7107068705f; q = q * t + (-0.142248368f); q = q * t + 0.127414796f; q = q * t;
    const f32x2 s = (v * v) * (-0.72134752044f);
    f32x2 e; e.x = __builtin_amdgcn_exp2f(s.x); e.y = __builtin_amdgcn_exp2f(s.y);
    const f32x2 m = v * (q * e), r = v - m;
    f32x2 o; o.x = v.x < 0.f ? m.x : r.x; o.y = v.y < 0.f ? m.y : r.y; return o;
}

template <int ACT  > struct EpiBf16 {
    static constexpr bool PERM = true, AFTER_DRAIN = false; static_assert(ACT == 0 || ACT == 1, "EpiBf16: ACT is 0 (none) or 1 (gelu_pk)");
    bf16_t* O; int ldc; const float* bias; int split_cols; size_t split_stride; float scale0;
    __device__ __forceinline__ void operator()(const f32x4 (&acc)[2][2][4][2], const Unit& u, int wr, int wc, int fr, int fq) const {
        const int row0 = u.pm * BM + wr * 64 + fr; int colt = u.pn * BM; bf16_t* base = O;
        float sc = 1.f; if (split_cols) { const int t = colt / split_cols; base += (size_t)t * split_stride; colt -= t * split_cols; if (t == 0) sc = scale0; }
        const int col0 = colt + wc * 32 + 8 * fq, bcol0 = u.pn * BM + wc * 32 + 8 * fq;
        f32x4 bv[2][2];
#pragma unroll
        for (int bj = 0; bj < 2; ++bj)
#pragma unroll
            for (int n = 0; n < 2; ++n) bv[bj][n] = bias ? *(const f32x4*)(bias + bcol0 + bj * HALF + 4 * n) : (f32x4){0.f, 0.f, 0.f, 0.f};
#pragma unroll
        for (int ai = 0; ai < 2; ++ai)
#pragma unroll
            for (int m = 0; m < 4; ++m) { bf16_t* rowp = base + (size_t)(row0 + ai * HALF + m * 16) * ldc + col0;
#pragma unroll
                for (int bj = 0; bj < 2; ++bj) { f32x4 v0 = acc[ai][bj][m][0] + bv[bj][0], v1 = acc[ai][bj][m][1] + bv[bj][1];
                    if (ACT == 1) { f32x2 a = gelu_pk((f32x2){v0[0], v0[1]}), b = gelu_pk((f32x2){v0[2], v0[3]}), c = gelu_pk((f32x2){v1[0], v1[1]}), d = gelu_pk((f32x2){v1[2], v1[3]});
                        v0 = (f32x4){a.x, a.y, b.x, b.y}; v1 = (f32x4){c.x, c.y, d.x, d.y}; }
                    v0 = v0 * sc; v1 = v1 * sc; u32x4 w; w.x = cvt_pk_bf16(v0[0], v0[1]); w.y = cvt_pk_bf16(v0[2], v0[3]); w.z = cvt_pk_bf16(v1[0], v1[1]); w.w = cvt_pk_bf16(v1[2], v1[3]);
                    *(u32x4*)(rowp + bj * HALF) = w; } }
    }
};
template <class Epi, class Sched, bool ALIGN_EPI = false, bool SP2 = false>
__device__ __forceinline__ void gemm_phase(PG8_LAS unsigned char* lds, const Gemm g, const Sched& S, const Epi& E) {
    const int tid = threadIdx.x, wid = __builtin_amdgcn_readfirstlane(tid >> 6), lane = tid & 63, wr = wid >> 2, wc = wid & 3, fr = lane & 15, fq = lane >> 4;
    int K = g.K; asm volatile("" : "+s"(K));
    const int nt = K / BK;
    unsigned voffA[2], voffB[2];
#pragma unroll
    for (int i = 0; i < 2; ++i) { int R, C; stage_rc(tid * 16 + i * 8192, R, C); const int Rb = Epi::PERM ? ((R & ~31) + perm32(R & 31)) : R;
        voffA[i] = (unsigned)(R * g.lda + C) * 2u; voffB[i] = (unsigned)(Rb * g.ldb + C) * 2u; }
    const size_t kstep = (size_t)(BK * 2);
    const size_t hA = (size_t)HALF * g.lda * 2, hB = (size_t)HALF * g.ldb * 2;
    const unsigned ldsw = (unsigned)wid * 1024u;
    const int aoff = lds_byte(wr * 64 + fr, fq * 8), boff = lds_byte(wc * 32 + fr, fq * 8);
#define PG8_SA(b, h) (((b) * 2 + (h)) * HTB)
#define PG8_SB(b, h) ((4 + (b) * 2 + (h)) * HTB)
#define PG8_STAGE(bufoff, gbase, voff) do { _Pragma("unroll") for (int _i = 0; _i < 2; ++_i) \
        __builtin_amdgcn_global_load_lds((const unsigned*)((const char*)(gbase) + (voff)[_i]), (PG8_LAS unsigned*)(lds + (bufoff) + ldsw + _i * 8192), 16, 0, 0); } while (0)
#define PG8_LDA(dst, b, h) do { _Pragma("unroll") for (int m = 0; m < 4; ++m) _Pragma("unroll") for (int k = 0; k < 2; ++k) dst[m][k] = *(const PG8_LAS bf16x8*)(lds + PG8_SA(b, h) + aoff + m * 2048 + k * 1024); } while (0)
#define PG8_LDB(dst, b, h) do { _Pragma("unroll") for (int n = 0; n < 2; ++n) _Pragma("unroll") for (int k = 0; k < 2; ++k) dst[n][k] = *(const PG8_LAS bf16x8*)(lds + PG8_SB(b, h) + boff + n * 2048 + k * 1024); } while (0)
#define PG8_MMA(ai, bj, At, Bt) do { __builtin_amdgcn_s_setprio(1); _Pragma("unroll") for (int m = 0; m < 4; ++m) _Pragma("unroll") for (int n = 0; n < 2; ++n) _Pragma("unroll") for (int k = 0; k < 2; ++k) \
        acc[ai][bj][m][n] = __builtin_amdgcn_mfma_f32_16x16x32_bf16(Bt[n][k], At[m][k], acc[ai][bj][m][n], 0, 0, 0); __builtin_amdgcn_s_setprio(0); } while (0)
#define PG8_WAIT_V(n) asm volatile("s_waitcnt vmcnt(" #n ")" ::: "memory")
#define PG8_WAIT_L(n) asm volatile("s_waitcnt lgkmcnt(" #n ")" ::: "memory")
#define PG8_BAR __builtin_amdgcn_s_barrier()
#define PG8_SCHED __builtin_amdgcn_sched_barrier(0)
    Unit cur, nxt; int ui = 0;
    if (!S.next(0, cur)) return;
    f32x4 acc[2][2][4][2];
#pragma unroll
    for (int a = 0; a < 2; ++a)
#pragma unroll
        for (int b = 0; b < 2; ++b)
#pragma unroll
            for (int m = 0; m < 4; ++m)
#pragma unroll
                for (int n = 0; n < 2; ++n) acc[a][b][m][n] = (f32x4){0.f, 0.f, 0.f, 0.f};
    bf16x8 At[4][2], B0[2][2], B1[2][2];
    const char* cA = (const char*)g.A + cur.aoff; const char* cB = (const char*)g.Bt + cur.boff;
    S.a_ready(cur);
    if constexpr (SP2) {
        PG8_STAGE(PG8_SB(0, 0), cB, voffB); PG8_STAGE(PG8_SB(0, 1), cB + hB, voffB); PG8_STAGE(PG8_SA(0, 0), cA, voffA); PG8_STAGE(PG8_SA(0, 1), cA + hA, voffA);
        if (wr == 1) PG8_BAR;
        PG8_WAIT_V(2); PG8_BAR;
        PG8_STAGE(PG8_SB(1, 0), cB + kstep, voffB); PG8_STAGE(PG8_SA(1, 0), cA + kstep, voffA); PG8_STAGE(PG8_SB(1, 1), cB + hB + kstep, voffB);
        PG8_WAIT_V(6); PG8_BAR;
    } else {
        PG8_STAGE(PG8_SB(0, 0), cB, voffB); PG8_STAGE(PG8_SA(0, 0), cA, voffA); PG8_STAGE(PG8_SB(0, 1), cB + hB, voffB); PG8_STAGE(PG8_SA(0, 1), cA + hA, voffA);
        if (wr == 1) PG8_BAR;
        PG8_WAIT_V(4); PG8_BAR;
        PG8_STAGE(PG8_SB(1, 0), cB + kstep, voffB); PG8_STAGE(PG8_SA(1, 0), cA + kstep, voffA); PG8_STAGE(PG8_SB(1, 1), cB + hB + kstep, voffB);
        PG8_WAIT_V(6); PG8_BAR;
    }
    for (;;) {
        const bool has_next = S.next(ui + 1, nxt);
        const char* nA = has_next ? (const char*)g.A + nxt.aoff : cA; const char* nB = has_next ? (const char*)g.Bt + nxt.boff : cB;
        for (int t = 0; t < nt; t += 2) {
            const bool last = (t == nt - 2);
            const char* a1 = cA + (size_t)(t + 1) * kstep;
            const char* a2 = last ? nA : cA + (size_t)(t + 2) * kstep; const char* b2 = last ? nB : cB + (size_t)(t + 2) * kstep;
            const char* a3 = a2 + kstep; const char* b3 = b2 + kstep;
            if (last && has_next) S.a_ready(nxt);
            if constexpr (SP2) {
            PG8_LDB(B0, 0, 0); PG8_LDB(B1, 0, 1); PG8_SCHED; PG8_LDA(At, 0, 0); PG8_STAGE(PG8_SA(1, 1), a1 + hA, voffA);
            PG8_WAIT_V(8); PG8_WAIT_L(0); PG8_BAR; PG8_MMA(0, 0, At, B0); PG8_MMA(0, 1, At, B1); PG8_BAR; PG8_SCHED;
            PG8_LDA(At, 0, 1); PG8_STAGE(PG8_SB(0, 0), b2, voffB); PG8_STAGE(PG8_SB(0, 1), b2 + hB, voffB); PG8_STAGE(PG8_SA(0, 0), a2, voffA);
            PG8_WAIT_V(8); PG8_WAIT_L(0); PG8_BAR; PG8_MMA(1, 0, At, B0); PG8_MMA(1, 1, At, B1); PG8_BAR; PG8_SCHED;
            PG8_LDB(B0, 1, 0); PG8_LDB(B1, 1, 1); PG8_SCHED; PG8_LDA(At, 1, 0); PG8_STAGE(PG8_SA(0, 1), a2 + hA, voffA);
            PG8_WAIT_V(8); PG8_WAIT_L(0); PG8_BAR; PG8_MMA(0, 0, At, B0); PG8_MMA(0, 1, At, B1); PG8_BAR; PG8_SCHED;
            PG8_LDA(At, 1, 1); PG8_STAGE(PG8_SB(1, 0), b3, voffB); PG8_STAGE(PG8_SB(1, 1), b3 + hB, voffB); PG8_STAGE(PG8_SA(1, 0), a3, voffA);
            PG8_WAIT_V(8); PG8_WAIT_L(0); PG8_BAR; PG8_MMA(1, 0, At, B0); PG8_MMA(1, 1, At, B1); PG8_BAR; PG8_SCHED;
            } else {
            PG8_LDB(B0, 0, 0); PG8_SCHED; PG8_LDA(At, 0, 0); PG8_STAGE(PG8_SA(1, 1), a1 + hA, voffA);
            PG8_WAIT_L(8); PG8_BAR; PG8_WAIT_L(0); PG8_MMA(0, 0, At, B0); PG8_BAR; PG8_SCHED;
            PG8_LDB(B1, 0, 1); PG8_STAGE(PG8_SB(0, 0), b2, voffB);
            PG8_BAR; PG8_WAIT_L(0); PG8_MMA(0, 1, At, B1); PG8_BAR;
            PG8_LDA(At, 0, 1); PG8_STAGE(PG8_SA(0, 0), a2, voffA);
            PG8_BAR; PG8_WAIT_L(0); PG8_MMA(1, 0, At, B0); PG8_BAR; PG8_SCHED;
            PG8_STAGE(PG8_SB(0, 1), b2 + hB, voffB);
            PG8_WAIT_V(6); PG8_BAR; PG8_MMA(1, 1, At, B1); PG8_BAR;
            PG8_LDB(B0, 1, 0); PG8_SCHED; PG8_LDA(At, 1, 0); PG8_STAGE(PG8_SA(0, 1), a2 + hA, voffA);
            PG8_WAIT_L(8); PG8_BAR; PG8_WAIT_L(0); PG8_MMA(0, 0, At, B0); PG8_BAR; PG8_SCHED;
            PG8_LDB(B1, 1, 1); PG8_STAGE(PG8_SB(1, 0), b3, voffB);
            PG8_BAR; PG8_WAIT_L(0); PG8_MMA(0, 1, At, B1); PG8_BAR;
            PG8_LDA(At, 1, 1); PG8_STAGE(PG8_SA(1, 0), a3, voffA);
            PG8_BAR; PG8_WAIT_L(0); PG8_MMA(1, 0, At, B0); PG8_BAR; PG8_SCHED;
            PG8_STAGE(PG8_SB(1, 1), b3 + hB, voffB);
            PG8_WAIT_V(6); PG8_BAR; PG8_MMA(1, 1, At, B1); PG8_BAR;
            }
        }
        if constexpr (ALIGN_EPI) { if (wr == 0) PG8_BAR; }
        if constexpr (!Epi::AFTER_DRAIN) { E(acc, cur, wr, wc, fr, fq); S.done(cur); }
        if (!has_next) break;
#pragma unroll
        for (int a = 0; a < 2; ++a)
#pragma unroll
            for (int b = 0; b < 2; ++b)
#pragma unroll
                for (int m = 0; m < 4; ++m)
#pragma unroll
                    for (int n = 0; n < 2; ++n) acc[a][b][m][n] = (f32x4){0.f, 0.f, 0.f, 0.f};
        cur = nxt; cA = nA; cB = nB; ++ui;
        if constexpr (ALIGN_EPI) { if (wr == 1) PG8_BAR; }
    }
    PG8_WAIT_V(0);
    if constexpr (!ALIGN_EPI) { if (wr == 0) PG8_BAR; }
    PG8_BAR;
    if constexpr (Epi::AFTER_DRAIN) { E.fused(acc, cur, wr, wc, fr, fq, lds, wid, lane); S.done(cur); }
#undef PG8_SA
#undef PG8_SB
#undef PG8_STAGE
#undef PG8_LDA
#undef PG8_LDB
#undef PG8_MMA
#undef PG8_WAIT_V
#undef PG8_WAIT_L
#undef PG8_BAR
#undef PG8_SCHED
}
}
namespace pg8 {
struct EpiBf16P {
    static constexpr bool PERM = true, AFTER_DRAIN = false;
    bf16_t* O; int ldc; float sc;
    __device__ __forceinline__ void operator()(const f32x4 (&acc)[2][2][4][2], const Unit& u, int wr, int wc, int fr, int fq) const {
        const int row0 = u.pm * BM + wr * 64 + fr, col0 = u.pn * BM + wc * 32 + 8 * fq;
#pragma unroll
        for (int ai = 0; ai < 2; ++ai)
#pragma unroll
            for (int m = 0; m < 4; ++m) { bf16_t* rowp = O + (size_t)(row0 + ai * HALF + m * 16) * ldc + col0;
#pragma unroll
                for (int bj = 0; bj < 2; ++bj) { const f32x4 v0 = acc[ai][bj][m][0] * sc, v1 = acc[ai][bj][m][1] * sc;
                    u32x4 w; w.x = cvt_pk_bf16(v0[0], v0[1]); w.y = cvt_pk_bf16(v0[2], v0[3]); w.z = cvt_pk_bf16(v1[0], v1[1]); w.w = cvt_pk_bf16(v1[2], v1[3]);
                    *(u32x4*)(rowp + bj * HALF) = w; } }
    }
};
struct EpiF32Res {
    static constexpr bool PERM = false, AFTER_DRAIN = false;
    const float* base; float* out; int ldc;
    __device__ __forceinline__ void operator()(const f32x4 (&acc)[2][2][4][2], const Unit& u, int wr, int wc, int fr, int fq) const {
        const int row0 = u.pm * BM + wr * 64 + fr, col0 = u.pn * BM + wc * 32 + 4 * fq;
#pragma unroll
        for (int ai = 0; ai < 2; ++ai)
#pragma unroll
            for (int m = 0; m < 4; ++m) { const size_t off = (size_t)(row0 + ai * HALF + m * 16) * ldc + col0;
#pragma unroll
                for (int bj = 0; bj < 2; ++bj)
#pragma unroll
                    for (int n = 0; n < 2; ++n) { const f32x4 b = *(const f32x4*)(base + off + bj * HALF + n * 16); *(f32x4*)(out + off + bj * HALF + n * 16) = b + acc[ai][bj][m][n]; } }
    }
};
template <int mode> struct XAttnOrder {
    int G, c;
    __device__ __forceinline__ bool next(int i, Unit& u) const {
        const int L = i * G + c; if (L >= 256) return false;
        u.pm = L >> 2; u.pn = L & 3; const int b = u.pm >> 3;
        u.aoff = ((size_t)u.pm * 256 * 1024 + (size_t)u.pn * 256) * 2;
        u.boff = mode == 0 ? ((size_t)(b * 256) * 2048 + (size_t)u.pn * 256) * 2 : ((size_t)((b * 4 + u.pn) * 256) * 256) * 2;
        return true;
    }
    __device__ __forceinline__ void a_ready(const Unit&) const {}
    __device__ __forceinline__ void done(const Unit&) const {}
};
struct OneUnitOrder {
    int L, nN, lda, ldb;
    __device__ __forceinline__ bool next(int i, Unit& u) const {
        if (i != 0 || L < 0) return false;
        u.pm = L / nN; u.pn = L % nN; u.aoff = (size_t)u.pm * BM * lda * 2; u.boff = (size_t)u.pn * BM * ldb * 2; return true;
    }
    __device__ __forceinline__ void a_ready(const Unit&) const {}
    __device__ __forceinline__ void done(const Unit&) const {}
};
}

namespace pg8 {
struct EpiResRms {
    static constexpr bool PERM = false, AFTER_DRAIN = true;
    const float* base; float* out; bf16_t* hn; const float* g; int ldc; unsigned* xbuf; unsigned* cnt; float eps;
    __device__ __forceinline__ void fused(f32x4 (&acc)[2][2][4][2], const Unit& u, int wr, int wc, int fr, int fq, PG8_LAS unsigned char* lds, int wid, int lane) const {
        PG8_LAS float* P = (PG8_LAS float*)lds;
        PG8_LAS float* S = (PG8_LAS float*)(lds + 8192);
        const int col0 = u.pn * BM + wc * 32 + 4 * fq;
#pragma unroll
        for (int ai = 0; ai < 2; ++ai)
#pragma unroll
            for (int m = 0; m < 4; ++m) { const size_t off = (size_t)(u.pm * BM + ai * HALF + wr * 64 + m * 16 + fr) * ldc + col0; float s = 0.f;
#pragma unroll
                for (int bj = 0; bj < 2; ++bj)
#pragma unroll
                    for (int n = 0; n < 2; ++n) { const f32x4 b = *(const f32x4*)(base + off + bj * HALF + n * 16); f32x4 x = acc[ai][bj][m][n] + b; acc[ai][bj][m][n] = x; s += (x[0] * x[0] + x[1] * x[1]) + (x[2] * x[2] + x[3] * x[3]); }
                s += __shfl_xor(s, 16); s += __shfl_xor(s, 32);
                if (fq == 0) P[(ai * HALF + wr * 64 + m * 16 + fr) * 4 + wc] = s;
                if (m & 1) asm volatile("" ::: "memory"); }
        asm volatile("s_waitcnt lgkmcnt(0)" ::: "memory"); __builtin_amdgcn_s_barrier(); asm volatile("" ::: "memory");
        const int row = wid * 32 + (lane & 31);
        if (lane < 32) { const float t = (P[row * 4 + 0] + P[row * 4 + 1]) + (P[row * 4 + 2] + P[row * 4 + 3]);
            __hip_atomic_store(xbuf + (size_t)(u.pm * BM + row) * 4 + u.pn, __float_as_uint(t), __ATOMIC_RELAXED, __HIP_MEMORY_SCOPE_AGENT); }
        asm volatile("s_waitcnt vmcnt(0)" ::: "memory");
        if (lane == 0) __hip_atomic_fetch_add(cnt + 64 * u.pm, 1u, __ATOMIC_RELAXED, __HIP_MEMORY_SCOPE_AGENT);
        if (wid == 0) {
            const unsigned long long t0 = __builtin_amdgcn_s_memrealtime();
            while ((unsigned)__builtin_amdgcn_readfirstlane(__hip_atomic_load(cnt + 64 * u.pm, __ATOMIC_RELAXED, __HIP_MEMORY_SCOPE_AGENT)) < 32u) {
                if (__builtin_amdgcn_s_memrealtime() - t0 > 2000000ull) break;
                __builtin_amdgcn_s_sleep(2); }
            __builtin_amdgcn_fence(__ATOMIC_ACQUIRE, "agent");
        }
        asm volatile("s_waitcnt vmcnt(0) lgkmcnt(0)" ::: "memory"); __builtin_amdgcn_s_barrier(); asm volatile("" ::: "memory");
        if (lane < 32) { const unsigned* sl = xbuf + (size_t)(u.pm * BM + row) * 4; float t = 0.f;
#pragma unroll
            for (int q = 0; q < 4; ++q) t += __uint_as_float(__hip_atomic_load(sl + q, __ATOMIC_RELAXED, __HIP_MEMORY_SCOPE_AGENT));
            S[row] = 1.0f / sqrtf(t * (1.0f / 1024.0f) + eps); }
        asm volatile("s_waitcnt lgkmcnt(0)" ::: "memory"); __builtin_amdgcn_s_barrier(); asm volatile("" ::: "memory");
        f32x4 gv[2][2];
#pragma unroll
        for (int bj = 0; bj < 2; ++bj)
#pragma unroll
            for (int n = 0; n < 2; ++n) gv[bj][n] = *(const f32x4*)(g + col0 + bj * HALF + n * 16);
#pragma unroll
        for (int ai = 0; ai < 2; ++ai)
#pragma unroll
            for (int m = 0; m < 4; ++m) { const int r = ai * HALF + wr * 64 + m * 16 + fr; const float rs = S[r]; const size_t off = (size_t)(u.pm * BM + r) * ldc + col0;
#pragma unroll
                for (int bj = 0; bj < 2; ++bj)
#pragma unroll
                    for (int n = 0; n < 2; ++n) { const f32x4 x = acc[ai][bj][m][n]; *(f32x4*)(out + off + bj * HALF + n * 16) = x;
                        const f32x4 y = x * rs * gv[bj][n]; typedef unsigned u32x2v __attribute__((ext_vector_type(2))); u32x2v w; w.x = cvt_pk_bf16(y[0], y[1]); w.y = cvt_pk_bf16(y[2], y[3]);
                        *(u32x2v*)(hn + off + bj * HALF + n * 16) = w; }
                asm volatile("" ::: "memory"); }
    }
};
}

namespace pg8 {
struct EpiResSS {
    static constexpr bool PERM = false, AFTER_DRAIN = false;
    const float* base; float* out; bf16_t* hb; float* ss; int ldc;
    __device__ __forceinline__ void operator()(const f32x4 (&acc)[2][2][4][2], const Unit& u, int wr, int wc, int fr, int fq) const {
        const int row0 = u.pm * BM + wr * 64 + fr, col0 = u.pn * BM + wc * 32 + 4 * fq;
#pragma unroll
        for (int ai = 0; ai < 2; ++ai)
#pragma unroll
            for (int m = 0; m < 4; ++m) { const int row = row0 + ai * HALF + m * 16; const size_t off = (size_t)row * ldc + col0; float s = 0.f;
#pragma unroll
                for (int bj = 0; bj < 2; ++bj)
#pragma unroll
                    for (int n = 0; n < 2; ++n) { const f32x4 x = *(const f32x4*)(base + off + bj * HALF + n * 16) + acc[ai][bj][m][n]; *(f32x4*)(out + off + bj * HALF + n * 16) = x;
                        typedef unsigned u32x2v __attribute__((ext_vector_type(2))); u32x2v w; w.x = cvt_pk_bf16(x[0], x[1]); w.y = cvt_pk_bf16(x[2], x[3]); *(u32x2v*)(hb + off + bj * HALF + n * 16) = w;
                        s += (x[0] * x[0] + x[1] * x[1]) + (x[2] * x[2] + x[3] * x[3]); }
                s += __shfl_xor(s, 16); s += __shfl_xor(s, 32);
                if (fq == 0) ss[(size_t)row * 16 + u.pn * 4 + wc] = s; }
    }
};
struct EpiBf16RowScale {
    static constexpr bool PERM = true, AFTER_DRAIN = false;
    bf16_t* O; int ldc; const float* ss; float eps;
    __device__ __forceinline__ void operator()(const f32x4 (&acc)[2][2][4][2], const Unit& u, int wr, int wc, int fr, int fq) const {
        const int row0 = u.pm * BM + wr * 64 + fr, col0 = u.pn * BM + wc * 32 + 8 * fq;
#pragma unroll
        for (int ai = 0; ai < 2; ++ai)
#pragma unroll
            for (int m = 0; m < 4; ++m) { const int row = row0 + ai * HALF + m * 16; const f32x4* sp = (const f32x4*)(ss + (size_t)row * 16);
                const f32x4 a = sp[0], b = sp[1], c = sp[2], d = sp[3];
                const float t = ((a[0] + a[1]) + (a[2] + a[3])) + ((b[0] + b[1]) + (b[2] + b[3])) + ((c[0] + c[1]) + (c[2] + c[3])) + ((d[0] + d[1]) + (d[2] + d[3]));
                const float rs = 1.0f / sqrtf(t * (1.0f / 1024.0f) + eps);
                bf16_t* rowp = O + (size_t)row * ldc + col0;
#pragma unroll
                for (int bj = 0; bj < 2; ++bj) { const f32x4 v0 = acc[ai][bj][m][0] * rs, v1 = acc[ai][bj][m][1] * rs;
                    u32x4 w; w.x = cvt_pk_bf16(v0[0], v0[1]); w.y = cvt_pk_bf16(v0[2], v0[3]); w.z = cvt_pk_bf16(v1[0], v1[1]); w.w = cvt_pk_bf16(v1[2], v1[3]);
                    *(u32x4*)(rowp + bj * HALF) = w; } }
    }
};
}

namespace pg8 {
template <bool BASE_BF16> struct EpiResB {
    static constexpr bool PERM = true, AFTER_DRAIN = false;
    const void* base; bf16_t* hb; float* ss; int ldc;
    __device__ __forceinline__ void operator()(const f32x4 (&acc)[2][2][4][2], const Unit& u, int wr, int wc, int fr, int fq) const {
        const int row0 = u.pm * BM + wr * 64 + fr, col0 = u.pn * BM + wc * 32 + 8 * fq;
#pragma unroll
        for (int ai = 0; ai < 2; ++ai)
#pragma unroll
            for (int m = 0; m < 4; ++m) { const int row = row0 + ai * HALF + m * 16; const size_t off = (size_t)row * ldc + col0; float s = 0.f;
#pragma unroll
                for (int bj = 0; bj < 2; ++bj) { f32x4 b0, b1;
                    if (BASE_BF16) { const u32x4 w = *(const u32x4*)((const bf16_t*)base + off + bj * HALF);
                        b0 = (f32x4){__uint_as_float(w.x << 16), __uint_as_float(w.x & 0xffff0000u), __uint_as_float(w.y << 16), __uint_as_float(w.y & 0xffff0000u)};
                        b1 = (f32x4){__uint_as_float(w.z << 16), __uint_as_float(w.z & 0xffff0000u), __uint_as_float(w.w << 16), __uint_as_float(w.w & 0xffff0000u)}; }
                    else { b0 = *(const f32x4*)((const float*)base + off + bj * HALF); b1 = *(const f32x4*)((const float*)base + off + bj * HALF + 4); }
                    const f32x4 x0 = b0 + acc[ai][bj][m][0], x1 = b1 + acc[ai][bj][m][1];
                    u32x4 w; w.x = cvt_pk_bf16(x0[0], x0[1]); w.y = cvt_pk_bf16(x0[2], x0[3]); w.z = cvt_pk_bf16(x1[0], x1[1]); w.w = cvt_pk_bf16(x1[2], x1[3]);
                    *(u32x4*)(hb + off + bj * HALF) = w;
                    s += ((x0[0] * x0[0] + x0[1] * x0[1]) + (x0[2] * x0[2] + x0[3] * x0[3])) + ((x1[0] * x1[0] + x1[1] * x1[1]) + (x1[2] * x1[2] + x1[3] * x1[3])); }
                s += __shfl_xor(s, 16); s += __shfl_xor(s, 32);
                if (fq == 0) ss[(size_t)row * 16 + u.pn * 4 + wc] = s; }
    }
};
}

constexpr int NWAVES = 8;
constexpr int BATCH = 8, SEQ = 2048, DM = 1024, M = BATCH * SEQ, MEMLEN = 256, MM = BATCH * MEMLEN;
constexpr int INCOLS = 3088;
constexpr int N1 = 3328;
constexpr int PQ = 0, PK = 256, PV = 512, POG = 1024, PSQ = 1536, PSK = 2048, PSV = 2560, PGATE = 3072;
constexpr int PEER_N = 16384;
constexpr float EPS = 1e-6f;

constexpr size_t MiB = 1u << 20;
constexpr size_t WS_CTL = 0, CTL_ZERO_BYTES = 1 * MiB;
constexpr size_t WS_W1T = 1 * MiB;
constexpr size_t WS_WOT = 8 * MiB, WS_WXQT = 10 * MiB, WS_WXOT = 12 * MiB, WS_WXKVT = 14 * MiB, WS_WPQT = 18 * MiB, WS_SUBK = 22 * MiB;
constexpr size_t WS_UB = 24 * MiB, WS_VB = 56 * MiB;
constexpr size_t WS_BUFA = 88 * MiB;
constexpr size_t WS_MN = 120 * MiB;
constexpr size_t WS_KV = 124 * MiB;
constexpr size_t WS_PROJ = 132 * MiB;
constexpr size_t WS_SLOT0 = 132 * MiB, WS_SLOT1 = 164 * MiB, WS_SLOT2 = 196 * MiB, WS_VT = 76 * MiB, WS_END = 236 * MiB;
constexpr int CW_BAR = 4096;
constexpr int CW_SBSS = 32768;

constexpr int RING_BYTES = 131072;
constexpr int LDSCTL_OFF = RING_BYTES, MISC_OFF = LDSCTL_OFF + 320;
constexpr int LDS_BYTES = 147456;

#define GAS __attribute__((address_space(1)))
#define LAS __attribute__((address_space(3)))
typedef unsigned short bf16;
typedef unsigned v4u __attribute__((ext_vector_type(4)));
typedef float f32x4 __attribute__((ext_vector_type(4)));
typedef short bf16x8 __attribute__((ext_vector_type(8)));
typedef GAS unsigned gu32;
typedef GAS unsigned long long gu64;
#define RLX_AGENT __ATOMIC_RELAXED, __HIP_MEMORY_SCOPE_AGENT
#define LDS_WAIT() asm volatile("s_waitcnt lgkmcnt(0)" ::: "memory")
#define VM_WAIT() asm volatile("s_waitcnt vmcnt(0)" ::: "memory")
__device__ __forceinline__ unsigned long long rt() { return __builtin_amdgcn_s_memrealtime(); }
__device__ __forceinline__ unsigned f2bf(float f) { unsigned u = __builtin_bit_cast(unsigned, f); return (u + 0x7fffu + ((u >> 16) & 1u)) >> 16; }
__device__ __forceinline__ unsigned pk2(float lo, float hi) { return f2bf(lo) | (f2bf(hi) << 16); }

#define XB_TMO      128
#define XB_XCNT(j)  (256  + 64 * (j))
#define XB_XSUB(j)  (1280 + 64 * (j))
#define XB_XGEN(j)  (2304 + 64 * (j))
#define XB_TOP      3328
#define XB_TOPGEN   3392
#define XCD_BAR_WORDS 3456
#define XB_SPIN_CAP (1u << 22)

__device__ __forceinline__ unsigned xb_ld(unsigned* p)              { return __hip_atomic_load(p, __ATOMIC_RELAXED, __HIP_MEMORY_SCOPE_AGENT); }
__device__ __forceinline__ unsigned xb_add(unsigned* p, unsigned v) { return __hip_atomic_fetch_add(p, v, __ATOMIC_RELAXED, __HIP_MEMORY_SCOPE_AGENT); }
__device__ __forceinline__ unsigned xb_xcc_id() { return (unsigned)__builtin_amdgcn_s_getreg((3 << 11) | 20) & 0xFu; }
#define XB_SPIN(cond, bar) do { unsigned _sp = 0; while (cond) { __builtin_amdgcn_s_sleep(1); \
    if ((++_sp & 255u) == 0u) { if (xb_ld(&(bar)[XB_TMO])) break; if (_sp > XB_SPIN_CAP) { atomicAdd(&(bar)[XB_TMO], 1u); break; } } } } while (0)

struct XcdBarrier {
    unsigned* bar; unsigned x;
    volatile LAS unsigned* st;
};

__device__ __forceinline__ XcdBarrier xcd_barrier_post(unsigned* bar, volatile LAS unsigned* st) {
    XcdBarrier b; b.bar = bar; b.x = xb_xcc_id(); b.st = st;
    if (threadIdx.x == 0) (void)xb_add(&bar[XB_XCNT(b.x)], 1u);
    return b;
}
__device__ __forceinline__ void xcd_barrier_complete(unsigned* bar, unsigned x, unsigned& nloc, unsigned& nx) {
    const unsigned G = gridDim.x * gridDim.y * gridDim.z;
    unsigned sum, cnt, mine, sp = 0u;
    for (;;) {
        sum = 0u; cnt = 0u; mine = 0u;
#pragma unroll
        for (unsigned j = 0; j < 16; ++j) { const unsigned c = xb_ld(&bar[XB_XCNT(j)]); sum += c; cnt += (c > 0u) ? 1u : 0u; mine = (j == x) ? c : mine; }
        if (sum == G) break;
        __builtin_amdgcn_s_sleep(1);
        if ((++sp & 255u) == 0u) { if (xb_ld(&bar[XB_TMO])) break; if (sp > XB_SPIN_CAP) { atomicAdd(&bar[XB_TMO], 1u); break; } }
    }
    nloc = mine > 0u ? mine : 1u; nx = cnt > 0u ? cnt : 1u;
}

__device__ __forceinline__ void xcd_barrier(const XcdBarrier& b) {
    asm volatile("s_waitcnt vmcnt(0)" ::: "memory");
    __syncthreads();
    if (threadIdx.x == 0) {
        unsigned* bar = b.bar;
        __builtin_amdgcn_s_waitcnt(0);
        unsigned nloc = b.st[0], nx = b.st[1];
        if (nloc == 0u) { xcd_barrier_complete(bar, b.x, nloc, nx); b.st[0] = nloc; b.st[1] = nx; }
        const unsigned old = xb_add(&bar[XB_XSUB(b.x)], 1u);
        const unsigned gen = old / nloc;
        if (old + 1u == (gen + 1u) * nloc) {
            __builtin_amdgcn_fence(__ATOMIC_RELEASE, "agent");
            asm volatile("s_waitcnt vmcnt(0)" ::: "memory");
            const unsigned og = xb_add(&bar[XB_TOP], 1u);
            const unsigned tg = og / nx;
            if (og + 1u == (tg + 1u) * nx) xb_add(&bar[XB_TOPGEN], 1u);
            else XB_SPIN(xb_ld(&bar[XB_TOPGEN]) == tg, bar);
            __builtin_amdgcn_fence(__ATOMIC_ACQUIRE, "agent");
            xb_add(&bar[XB_XGEN(b.x)], 1u);
            asm volatile("s_waitcnt vmcnt(0)" ::: "memory");
        } else {
            XB_SPIN(xb_ld(&bar[XB_XGEN(b.x)]) == gen, bar);
            __builtin_amdgcn_fence(__ATOMIC_ACQUIRE, "agent");
            asm volatile("s_waitcnt vmcnt(0)" ::: "memory");
        }
    }
    __syncthreads();
}

#define DI __device__ __forceinline__
typedef __bf16 bf16x2_t __attribute__((ext_vector_type(2)));
struct Args { const float* in[21]; float* out; unsigned char* ws; int ph_lo, ph_hi, li, pad; };
struct Frame {
    LAS unsigned char* lds;
    volatile LAS unsigned* MISC;
    gu32* ctl;
    int tid, lane, wave;
    int vcu, G;
    unsigned char* ws; float* out;
};
#define WSP(off) ((bf16*)(F.ws + (off)))
#define F_W1T WSP(WS_W1T)
#define F_WOT WSP(WS_WOT)
#define F_WXQT WSP(WS_WXQT)
#define F_WXOT WSP(WS_WXOT)
#define F_WXKVT WSP(WS_WXKVT)
#define F_WPQT WSP(WS_WPQT)
#define F_SUBK WSP(WS_SUBK)
#define F_UB WSP(WS_UB)
#define F_VB WSP(WS_VB)
#define F_BUFA WSP(WS_BUFA)
#define F_MN WSP(WS_MN)
#define F_KV WSP(WS_KV)
#define F_PROJ WSP(WS_PROJ)
#define F_SLOT0 WSP(WS_SLOT0)
#define F_SLOT1 WSP(WS_SLOT1)
#define F_SLOT2 WSP(WS_SLOT2)
#define F_VT WSP(WS_VT)
DI float bf2f(unsigned v) { return __uint_as_float(v << 16); }
DI float bflo(unsigned w) { return __uint_as_float(w << 16); }
DI float bfhi(unsigned w) { return __uint_as_float(w & 0xffff0000u); }
DI float wave_sum(float v) {
#pragma unroll
    for (int o = 1; o < 64; o <<= 1) v += __shfl_xor(v, o);
    return v;
}
DI float wave_max(float v) {
#pragma unroll
    for (int o = 1; o < 64; o <<= 1) v = fmaxf(v, __shfl_xor(v, o));
    return v;
}
DI float dot2_bf16(unsigned w, unsigned x, float a) { return __builtin_amdgcn_fdot2_f32_bf16(__builtin_bit_cast(bf16x2_t, w), __builtin_bit_cast(bf16x2_t, x), a, false); }
DI float silu_f(float x) { return x * __builtin_amdgcn_rcpf(1.f + __expf(-x)); }
DI float log_sigmoid_f(float z) { return fminf(z, 0.f) - __logf(1.f + __expf(-fabsf(z))); }
DI float gelu_tanh_f(float x) { const float y = 0.7978845608028654f * (x + 0.044715f * x * x * x); const float t = 1.f - 2.f / (1.f + __expf(2.f * y)); return 0.5f * x * (1.f + t); }

DI void p0_transpose_item(const float* W, int ldw, int c0, bf16* WT, int row_off, LAS float* scr, int kb, int nb, int lane, const float* kgain = nullptr) {
    const int k0 = 64 * kb, n0 = 32 * nb;
#pragma unroll 8
    for (int i = 0; i < 32; ++i) { const int kk = 2 * i + (lane >> 5); scr[kk * 33 + (lane & 31)] = W[(size_t)(k0 + kk) * ldw + c0 + n0 + (lane & 31)] * (kgain ? kgain[k0 + kk] : 1.f); }
    LDS_WAIT(); asm volatile("" ::: "memory");
    const int c = lane & 7;
#pragma unroll
    for (int j = 0; j < 4; ++j) { const int n = (lane >> 3) + 8 * j; const LAS float* s = scr + (8 * c) * 33 + n;
        v4u o; o.x = pk2(s[0 * 33], s[1 * 33]); o.y = pk2(s[2 * 33], s[3 * 33]); o.z = pk2(s[4 * 33], s[5 * 33]); o.w = pk2(s[6 * 33], s[7 * 33]);
        *(GAS v4u*)(WT + (size_t)(row_off + n0 + n) * 1024 + k0 + 8 * c) = o; }
    LDS_WAIT(); asm volatile("" ::: "memory");
}
DI void rms_row_to_bf16(int lane, const float* xrow, const float* g, bf16* orow) {
    const GAS f32x4* xr = (const GAS f32x4*)xrow + lane; const GAS f32x4* gr = (const GAS f32x4*)g + lane;
    f32x4 v[4]; float s = 0.f;
#pragma unroll
    for (int j = 0; j < 4; ++j) { v[j] = xr[64 * j]; s += (v[j].x * v[j].x + v[j].y * v[j].y) + (v[j].z * v[j].z + v[j].w * v[j].w); }
    const float rs = 1.f / sqrtf(wave_sum(s) * (1.f / 1024.f) + EPS);
    GAS unsigned long long* o8 = (GAS unsigned long long*)orow + lane;
#pragma unroll
    for (int j = 0; j < 4; ++j) { const f32x4 gg = gr[64 * j]; const f32x4 y = v[j] * rs * gg; o8[64 * j] = (unsigned long long)pk2(y.x, y.y) | ((unsigned long long)pk2(y.z, y.w) << 32); }
}
typedef float f32x2 __attribute__((ext_vector_type(2)));
constexpr size_t WS_U8 = 24 * MiB, WS_V8 = 40 * MiB, WS_X8 = 56 * MiB, WS_SU = 72 * MiB, WS_SX = 72 * MiB + 65536, WS_SV = 72 * MiB + 131072;
template <int CTRL> DI int dpp_i(int v) { return __builtin_amdgcn_update_dpp(0, v, CTRL, 0xf, 0xf, false); }
DI void quant_row_i8(int lane, const float* src, unsigned char* dst, float* scale_out) {
    f32x4 v[4]; float m = 0.f;
#pragma unroll
    for (int j = 0; j < 4; ++j) { v[j] = *(const GAS f32x4*)(src + 16 * lane + 4 * j); m = fmaxf(m, fmaxf(fmaxf(fabsf(v[j].x), fabsf(v[j].y)), fmaxf(fabsf(v[j].z), fabsf(v[j].w)))); }
    m = wave_max(m);
    const float sc = m > 0.f ? m * (1.f / 127.f) : 1.f, inv = 1.f / sc;
    v4u o;
#pragma unroll
    for (int j = 0; j < 4; ++j) { const int a = (int)rintf(v[j].x * inv), b = (int)rintf(v[j].y * inv), c = (int)rintf(v[j].z * inv), d = (int)rintf(v[j].w * inv);
        o[j] = (unsigned)(a & 255) | ((unsigned)(b & 255) << 8) | ((unsigned)(c & 255) << 16) | ((unsigned)(d & 255) << 24); }
    *(GAS v4u*)(dst + 16 * lane) = o;
    if (lane == 0) *scale_out = sc;
}
typedef float f32x16v __attribute__((ext_vector_type(16)));
typedef int i32x6v __attribute__((ext_vector_type(6)));
typedef unsigned u32x3v __attribute__((ext_vector_type(3)));
DI unsigned fp6_e2m3(float x) {
    const float m = fminf(fabsf(x), 7.5f);
    const int e = m >= 4.f ? 2 : m >= 2.f ? 1 : 0;
    const int q = (int)rintf(m * (e == 2 ? 2.f : e == 1 ? 4.f : 8.f));
    const unsigned code = e == 0 ? (unsigned)q : (unsigned)((e + 1) * 8 + (q - 8));
    return (x < 0.f ? 32u : 0u) | (code > 31u ? 31u : code);
}
DI void quant_row_fp6(int lane, const float* src, unsigned char* dst, float* sc) {
    float v[16]; float mx = 0.f;
#pragma unroll
    for (int j = 0; j < 4; ++j) { const f32x4 t = *(const GAS f32x4*)(src + 16 * lane + 4 * j);
#pragma unroll
        for (int i = 0; i < 4; ++i) { v[4 * j + i] = t[i]; mx = fmaxf(mx, fabsf(t[i])); } }
    mx = wave_max(mx);
    const float s_ = mx > 0.f ? mx * (1.f / 7.5f) : 1.f, inv = 1.f / s_;
    unsigned long long lo = 0ull; unsigned hi = 0u;
#pragma unroll
    for (int i = 0; i < 16; ++i) { const unsigned long long c = fp6_e2m3(v[i] * inv);
        if (6 * i < 64) lo |= c << (6 * i);
        if (6 * i + 6 > 64) hi |= (unsigned)(6 * i >= 64 ? c << (6 * i - 64) : c >> (64 - 6 * i)); }
    *(GAS u32x3v*)(dst + 12 * lane) = (u32x3v){(unsigned)lo, (unsigned)(lo >> 32), hi};
    if (lane == 0) *sc = s_;
}
DI void rms_row_to_bf16_i8(int lane, const float* xrow, const float* g, bf16* orow, unsigned char* qrow, float* sx) {
    const GAS f32x4* xr = (const GAS f32x4*)xrow + lane; const GAS f32x4* gr = (const GAS f32x4*)g + lane;
    f32x4 v[4]; float s = 0.f;
#pragma unroll
    for (int j = 0; j < 4; ++j) { v[j] = xr[64 * j]; s += (v[j].x * v[j].x + v[j].y * v[j].y) + (v[j].z * v[j].z + v[j].w * v[j].w); }
    const float rs = 1.f / sqrtf(wave_sum(s) * (1.f / 1024.f) + EPS);
    GAS unsigned long long* o8 = (GAS unsigned long long*)orow + lane; float m = 0.f;
#pragma unroll
    for (int j = 0; j < 4; ++j) { const f32x4 gg = gr[64 * j]; v[j] = v[j] * rs * gg; o8[64 * j] = (unsigned long long)pk2(v[j].x, v[j].y) | ((unsigned long long)pk2(v[j].z, v[j].w) << 32);
        m = fmaxf(m, fmaxf(fmaxf(fabsf(v[j].x), fabsf(v[j].y)), fmaxf(fabsf(v[j].z), fabsf(v[j].w)))); }
    m = wave_max(m);
    const float sc = m > 0.f ? m * (1.f / 127.f) : 1.f, inv = 1.f / sc;
#pragma unroll
    for (int j = 0; j < 4; ++j) { const int a = (int)rintf(v[j].x * inv), b = (int)rintf(v[j].y * inv), c = (int)rintf(v[j].z * inv), d = (int)rintf(v[j].w * inv);
        *(GAS unsigned*)(qrow + 4 * lane + 256 * j) = (unsigned)(a & 255) | ((unsigned)(b & 255) << 8) | ((unsigned)(c & 255) << 16) | ((unsigned)(d & 255) << 24); }
    if (lane == 0) *sx = sc;
}
DI void p0_prologue(Frame& F, const Args& A) {
    LAS float* scr = (LAS float*)(F.lds + F.wave * 16384);
    const int gw = F.vcu * NWAVES + F.wave, NGW = F.G * NWAVES;
    constexpr int I_IN = 16 * 48, I_W2 = 16 * 64;
    constexpr int NIT = 2 * I_IN + I_W2;
    for (int it = gw; it < NIT; it += NGW) {
        int r = it;
        if (r < I_IN) { p0_transpose_item(A.in[3], INCOLS, 0, F_W1T, 0, scr, r / 48, r % 48, F.lane); continue; } r -= I_IN;
        if (r < I_IN) { p0_transpose_item(A.in[3], INCOLS, 1552, F_W1T, 1536, scr, r / 48, r % 48, F.lane); continue; } r -= I_IN;
        p0_transpose_item(A.in[13], 2048, 0, F_WXKVT, 0, scr, r / 64, r % 64, F.lane);
    }
    const int gt = gw * 64 + F.lane, NGT = NGW * 64;
    for (int i = gt; i < 256 * 128; i += NGT) {
        const int n = i >> 7, k0 = (i & 127) * 8;
        float gv[16];
#pragma unroll
        for (int r = 0; r < 16; ++r) gv[r] = A.in[5][r * 256 + n];
        float s[8];
#pragma unroll
        for (int j = 0; j < 8; ++j) { const float* wr_ = A.in[3] + (size_t)(k0 + j) * INCOLS + 1536; float a = 0.f;
#pragma unroll
            for (int r = 0; r < 16; ++r) a += wr_[r] * gv[r];
            s[j] = a; }
        v4u o; o.x = pk2(s[0], s[1]); o.y = pk2(s[2], s[3]); o.z = pk2(s[4], s[5]); o.w = pk2(s[6], s[7]);
        *(GAS v4u*)(F_W1T + (size_t)(3072 + n) * 1024 + k0) = o;
    }
    for (int m = gw; m < M; m += NGW) rms_row_to_bf16(F.lane, A.in[0] + (size_t)m * DM, A.in[2], F_BUFA + (size_t)m * DM);
    for (int m = gw; m < MM; m += NGW) rms_row_to_bf16(F.lane, A.in[1] + (size_t)m * DM, A.in[11], F_MN + (size_t)m * DM);
}
DI void p0_late(Frame& F, const Args& A, int widx, int nw) {
    LAS float* scr = (LAS float*)(F.lds + F.wave * 16384);
    constexpr int I_SQ = 16 * 32, I_W2 = 16 * 64;
    for (int it = widx; it < 3 * I_SQ + I_W2; it += nw) {
        int r = it;
        if (r < I_SQ) { p0_transpose_item(A.in[9], 1024, 0, F_WOT, 0, scr, r / 32, r % 32, F.lane); continue; } r -= I_SQ;
        if (r < I_SQ) { p0_transpose_item(A.in[12], 1024, 0, F_WXQT, 0, scr, r / 32, r % 32, F.lane, A.in[10]); continue; } r -= I_SQ;
        if (r < I_SQ) { p0_transpose_item(A.in[14], 1024, 0, F_WXOT, 0, scr, r / 32, r % 32, F.lane); continue; } r -= I_SQ;
        p0_transpose_item(A.in[16], 2048, 0, F_WPQT, 0, scr, r / 64, r % 64, F.lane, A.in[15]);
    }
    for (int i = widx * 64 + F.lane; i < 32768; i += nw * 64) {
        const f32x4 a = *(const GAS f32x4*)(A.in[17] + (size_t)i * 8), b = *(const GAS f32x4*)(A.in[17] + (size_t)i * 8 + 4);
        v4u o; o.x = pk2(a.x, a.y); o.y = pk2(a.z, a.w); o.z = pk2(b.x, b.y); o.w = pk2(b.z, b.w);
        *(GAS v4u*)(F_SUBK + (size_t)i * 8) = o;
    }
    for (int m = 2 * widx; m < PEER_N; m += 2 * nw) {
        quant_row_i8(F.lane, A.in[18] + (size_t)m * DM, F.ws + WS_U8 + (size_t)m * 1024, (float*)(F.ws + WS_SU) + m);
        quant_row_i8(F.lane, A.in[18] + (size_t)(m + 1) * DM, F.ws + WS_U8 + (size_t)(m + 1) * 1024, (float*)(F.ws + WS_SU) + m + 1);
        quant_row_fp6(F.lane, A.in[19] + (size_t)m * DM, F.ws + WS_V8 + (size_t)m * 768, (float*)(F.ws + WS_SV) + m);
        quant_row_fp6(F.lane, A.in[19] + (size_t)(m + 1) * DM, F.ws + WS_V8 + (size_t)(m + 1) * 768, (float*)(F.ws + WS_SV) + m + 1);
    }
}

DI void gla_naive_item(Frame& F, const Args& A, float* OGLA, int b, int h, int eg) {
    const int lane = F.lane, e = eg * 8 + F.wave;
    const int cq = PQ + h * 64 + lane, ck = PK + h * 64 + lane, cv = PV + h * 128 + e, cg = PGATE + h * 64 + lane;
    float wq[4], wk[4], wv[4];
#pragma unroll
    for (int k = 0; k < 4; ++k) { wq[k] = A.in[4][k * 1024 + cq]; wk[k] = A.in[4][k * 1024 + ck]; wv[k] = A.in[4][k * 1024 + cv]; }
    const float bias = A.in[6][h * 64 + lane];
    float rq0 = 0.f, rq1 = 0.f, rq2 = 0.f, rk0 = 0.f, rk1 = 0.f, rk2 = 0.f, rv0 = 0.f, rv1 = 0.f, rv2 = 0.f, S = 0.f;
    for (int t0 = 0; t0 < SEQ; t0 += 8) {
        unsigned lq[8], lk[8], lv[8], lg[8];
#pragma unroll
        for (int j = 0; j < 8; ++j) { const bf16* base = F_PROJ + (size_t)(b * SEQ + t0 + j) * N1; lq[j] = base[cq]; lk[j] = base[ck]; lv[j] = base[cv]; lg[j] = base[cg]; }
#pragma unroll
        for (int j = 0; j < 8; ++j) {
            const float xq = bf2f(lq[j]), xk = bf2f(lk[j]), xv = bf2f(lv[j]);
            const float q = silu_f(wq[0] * rq0 + wq[1] * rq1 + wq[2] * rq2 + wq[3] * xq) * 0.125f; rq0 = rq1; rq1 = rq2; rq2 = xq;
            const float k = silu_f(wk[0] * rk0 + wk[1] * rk1 + wk[2] * rk2 + wk[3] * xk); rk0 = rk1; rk1 = rk2; rk2 = xk;
            const float v = silu_f(wv[0] * rv0 + wv[1] * rv1 + wv[2] * rv2 + wv[3] * xv); rv0 = rv1; rv1 = rv2; rv2 = xv;
            const float a = __expf(log_sigmoid_f(bf2f(lg[j]) + bias) * (1.f / 16.f));
            S = a * S + k * v;
            const float o = wave_sum(q * S);
            if (lane == 0) OGLA[(size_t)(b * SEQ + t0 + j) * 512 + h * 128 + e] = o;
        }
    }
}
DI void sb_naive_item(Frame& F, float* OSB, int b, int h, int qb) {
    LAS float* Ks = (LAS float*)F.lds; LAS float* Vs = Ks + 64 * 64;
    const int tid = F.tid, t = qb * 512 + tid; const size_t row = (size_t)b * SEQ + t;
    float q[64], acc[64];
    {
        const GAS v4u* qp = (const GAS v4u*)(F_PROJ + row * N1 + PSQ + h * 64);
#pragma unroll
        for (int c = 0; c < 8; ++c) { const v4u w = qp[c]; q[8 * c + 0] = bflo(w.x) * 0.125f; q[8 * c + 1] = bfhi(w.x) * 0.125f; q[8 * c + 2] = bflo(w.y) * 0.125f; q[8 * c + 3] = bfhi(w.y) * 0.125f;
            q[8 * c + 4] = bflo(w.z) * 0.125f; q[8 * c + 5] = bfhi(w.z) * 0.125f; q[8 * c + 6] = bflo(w.w) * 0.125f; q[8 * c + 7] = bfhi(w.w) * 0.125f; }
    }
#pragma unroll
    for (int d = 0; d < 64; ++d) acc[d] = 0.f;
    float carry = 0.f;
    for (int kt = qb * 8 + 7; kt >= 0; --kt) {
        __syncthreads();
        {
            const int key = tid >> 3, ch = tid & 7; const size_t krow = (size_t)b * SEQ + kt * 64 + key;
            const v4u kw = *(const GAS v4u*)(F_PROJ + krow * N1 + PSK + h * 64 + ch * 8), vw = *(const GAS v4u*)(F_PROJ + krow * N1 + PSV + h * 64 + ch * 8);
            LAS f32x4* kd = (LAS f32x4*)(Ks + key * 64 + ch * 8); LAS f32x4* vd = (LAS f32x4*)(Vs + key * 64 + ch * 8);
            kd[0] = (f32x4){bflo(kw.x), bfhi(kw.x), bflo(kw.y), bfhi(kw.y)}; kd[1] = (f32x4){bflo(kw.z), bfhi(kw.z), bflo(kw.w), bfhi(kw.w)};
            vd[0] = (f32x4){bflo(vw.x), bfhi(vw.x), bflo(vw.y), bfhi(vw.y)}; vd[1] = (f32x4){bflo(vw.z), bfhi(vw.z), bflo(vw.w), bfhi(vw.w)};
        }
        __syncthreads();
        for (int j = 63; j >= 0; --j) {
            const int s = kt * 64 + j;
            if (s < t) {
                const LAS f32x4* kr = (const LAS f32x4*)(Ks + j * 64); const LAS f32x4* vr = (const LAS f32x4*)(Vs + j * 64);
                float z0 = 0.f, z1 = 0.f, z2 = 0.f, z3 = 0.f;
#pragma unroll
                for (int c = 0; c < 16; ++c) { const f32x4 kk = kr[c]; z0 += q[4 * c] * kk.x; z1 += q[4 * c + 1] * kk.y; z2 += q[4 * c + 2] * kk.z; z3 += q[4 * c + 3] * kk.w; }
                const float z = (z0 + z1) + (z2 + z3);
                const float lb = log_sigmoid_f(z);
                const float w = __expf(lb + carry);
                carry += lb - z;
#pragma unroll
                for (int c = 0; c < 16; ++c) { const f32x4 vv = vr[c]; acc[4 * c] += w * vv.x; acc[4 * c + 1] += w * vv.y; acc[4 * c + 2] += w * vv.z; acc[4 * c + 3] += w * vv.w; }
            }
        }
    }
    GAS f32x4* op = (GAS f32x4*)(OSB + row * 512 + h * 64);
#pragma unroll
    for (int c = 0; c < 16; ++c) op[c] = (f32x4){acc[4 * c], acc[4 * c + 1], acc[4 * c + 2], acc[4 * c + 3]};
}
typedef float f32x16 __attribute__((ext_vector_type(16)));
typedef short s16x4 __attribute__((ext_vector_type(4)));
DI s16x4 lds_tr16(const LAS unsigned char* p) { return __builtin_bit_cast(s16x4, __builtin_amdgcn_ds_read_tr16_b64_v4i16((LAS s16x4*)p)); }
DI unsigned cvtpk_bf16(float lo, float hi) { typedef float f2 __attribute__((ext_vector_type(2))); f2 v = {lo, hi}; bf16x2_t b = __builtin_convertvector(v, bf16x2_t); return __builtin_bit_cast(unsigned, b); }
constexpr float SB_C2 = 0.125f * 1.4426950408889634f;
template <bool MASKED> DI void sb_weights(f32x16& P0, f32x16& P1, float& carry, int hi, int qrel2) {
    float T[8], cs[8];
#pragma unroll
    for (int pi = 0; pi < 2; ++pi) {
        f32x16& P = pi ? P1 : P0;
#pragma unroll
        for (int g = 0; g < 4; ++g) {
            float lbv[4], l1v[4];
#pragma unroll
            for (int i = 0; i < 4; ++i) {
                const float z2 = P[4 * g + i] * SB_C2;
                const float sp = __builtin_amdgcn_logf(1.f + __builtin_amdgcn_exp2f(-fabsf(z2)));
                float lb = fminf(z2, 0.f) - sp, l1 = lb - z2;
                if (MASKED) { const bool valid = (32 * pi + 8 * g + 4 * hi + i) < qrel2; lb = valid ? lb : -INFINITY; l1 = valid ? l1 : 0.f; }
                lbv[i] = lb; l1v[i] = l1;
            }
            const float a = l1v[3], b = a + l1v[2], c = b + l1v[1];
            cs[4 * pi + g] = c + l1v[0];
            P[4 * g + 3] = lbv[3]; P[4 * g + 2] = lbv[2] + a; P[4 * g + 1] = lbv[1] + b; P[4 * g + 0] = lbv[0] + c;
        }
    }
#pragma unroll
    for (int k = 0; k < 8; ++k) { auto rr = __builtin_amdgcn_permlane32_swap(__float_as_uint(cs[k]), __float_as_uint(cs[k]), false, false); T[k] = __uint_as_float(rr[0]) + __uint_as_float(rr[1]); }
    const float m0 = hi ? 0.f : 1.f;
    float run = carry;
#pragma unroll
    for (int k = 7; k >= 0; --k) {
        const float E = run + m0 * (T[k] - cs[k]);
        f32x16& P = (k >> 2) ? P1 : P0; const int g = k & 3;
#pragma unroll
        for (int i = 0; i < 4; ++i) P[4 * g + i] = __builtin_amdgcn_exp2f(P[4 * g + i] + E);
        run += T[k];
    }
    carry = run;
}
DI void sb_unit(Frame& F, float* OSB, int b, int h, int qb) {
    const int tid = F.tid, lane = F.lane, wid = F.wave, r32 = lane & 31, hi = lane >> 5;
    const int q0 = qb * 256; const size_t rowbase = (size_t)b * SEQ;
    const bf16* Kg = F_PROJ + rowbase * N1 + PSK + h * 64;
    const bf16* Vg = F_PROJ + rowbase * N1 + PSV + h * 64;
    bf16x8 qr[4];
    { const bf16* Qw = F_PROJ + (rowbase + q0 + wid * 32 + r32) * N1 + PSQ + h * 64;
#pragma unroll
      for (int ks = 0; ks < 4; ++ks) qr[ks] = *(const GAS bf16x8*)(Qw + ks * 16 + hi * 8); }
    const bf16* ksrc = Kg + (size_t)(tid >> 3) * N1 + (tid & 7) * 8;
    const bf16* vsrc = Vg + (size_t)(16 * (wid & 3) + (lane >> 2)) * N1 + (wid >> 2) * 32 + (lane & 3) * 8;
    const int kdst = (tid & 7) * 1024 + (tid >> 3) * 16, vdst = 8192 + wid * 1024 + lane * 16;
    const int kfr = hi * 1024 + r32 * 16;
    const int vfr = 8192 + ((lane >> 4) & 1) * 32 + (lane & 3) * 8 + (4 * hi + ((lane & 15) >> 2)) * 64;
    f32x16 o0 = {}, o1 = {};
    float carry = 0.f;
    const int ktmax = (q0 >> 6) + 3;
    v4u kreg = *(const GAS v4u*)(ksrc + (size_t)ktmax * 64 * N1), vreg = *(const GAS v4u*)(vsrc + (size_t)ktmax * 64 * N1);
    __syncthreads();
    *(LAS v4u*)(F.lds + kdst) = kreg; *(LAS v4u*)(F.lds + vdst) = vreg;
    __syncthreads();
    int cur = 0;
    const int wrow0 = q0 + wid * 32;
    bool wdone = false;
    LAS unsigned* flags = (LAS unsigned*)(F.lds + 32768);
    for (int kt = ktmax; kt >= 0; --kt) {
        if (kt > 0) { kreg = *(const GAS v4u*)(ksrc + (size_t)(kt - 1) * 64 * N1); vreg = *(const GAS v4u*)(vsrc + (size_t)(kt - 1) * 64 * N1); }
        const int k0 = kt * 64;
        if (!wdone && k0 <= wrow0 + 30) {
            const LAS unsigned char* Kb = F.lds + cur * 16384;
            f32x16 P0 = {}, P1 = {};
#pragma unroll
            for (int ks = 0; ks < 4; ++ks) {
                const bf16x8 a0 = *(const LAS bf16x8*)(Kb + kfr + ks * 2048), a1 = *(const LAS bf16x8*)(Kb + kfr + ks * 2048 + 512);
                P0 = __builtin_amdgcn_mfma_f32_32x32x16_bf16(a0, qr[ks], P0, 0, 0, 0);
                P1 = __builtin_amdgcn_mfma_f32_32x32x16_bf16(a1, qr[ks], P1, 0, 0, 0);
            }
            if (k0 + 63 >= wrow0) sb_weights<true>(P0, P1, carry, hi, wrow0 + r32 - k0);
            else sb_weights<false>(P0, P1, carry, hi, 0);
#pragma unroll
            for (int s = 0; s < 4; ++s) {
                const f32x16& P = (s >> 1) ? P1 : P0; const int rb = (s & 1) * 8;
                v4u pw; pw.x = cvtpk_bf16(P[rb + 0], P[rb + 1]); pw.y = cvtpk_bf16(P[rb + 2], P[rb + 3]); pw.z = cvtpk_bf16(P[rb + 4], P[rb + 5]); pw.w = cvtpk_bf16(P[rb + 6], P[rb + 7]);
                const bf16x8 pa = __builtin_bit_cast(bf16x8, pw);
                const LAS unsigned char* vp = Kb + vfr + s * 1024;
                const s16x4 l0 = lds_tr16(vp), h0 = lds_tr16(vp + 512), l1 = lds_tr16(vp + 4096), h1 = lds_tr16(vp + 4096 + 512);
                const bf16x8 v0 = {l0[0], l0[1], l0[2], l0[3], h0[0], h0[1], h0[2], h0[3]}, v1 = {l1[0], l1[1], l1[2], l1[3], h1[0], h1[1], h1[2], h1[3]};
                o0 = __builtin_amdgcn_mfma_f32_32x32x16_bf16(pa, v0, o0, 0, 0, 0);
                o1 = __builtin_amdgcn_mfma_f32_32x32x16_bf16(pa, v1, o1, 0, 0, 0);
            }
            wdone = __all(carry < -160.f);
        }
        if (lane == 0) flags[(kt & 1) * 8 + wid] = wdone ? 1u : 0u;
        if (kt > 0) { *(LAS v4u*)(F.lds + (cur ^ 1) * 16384 + kdst) = kreg; *(LAS v4u*)(F.lds + (cur ^ 1) * 16384 + vdst) = vreg; }
        __syncthreads();
        cur ^= 1;
        { const v4u f0 = *(const LAS v4u*)(flags + (kt & 1) * 8), f1 = *(const LAS v4u*)(flags + (kt & 1) * 8 + 4);
          if ((f0.x & f0.y & f0.z & f0.w & f1.x & f1.y & f1.z & f1.w) != 0u) break; }
    }
    float* op = OSB + (rowbase + wrow0) * 512 + h * 64 + r32;
#pragma unroll
    for (int r = 0; r < 16; ++r) { const int qrow = (r & 3) + 8 * (r >> 2) + 4 * hi; op[(size_t)qrow * 512] = o0[r]; op[(size_t)qrow * 512 + 32] = o1[r]; }
}
constexpr int GL_QT = 0, GL_KT = 8192, GL_KD = 16384, GL_V = 28672, GL_ST = 49152, GL_SEG = 69632, GL_RED = 71680, GL_KDP = 192, GL_VP = 320;
constexpr int CW_DECAY = 65536;
template <bool ACC> DI bf16x8 tr_frag(const LAS unsigned char* base, int PB, int x0, int k0, int lane) {
    const int hi = lane >> 5, rr = (lane & 15) >> 2, col = x0 + 16 * ((lane >> 4) & 1) + 4 * (lane & 3);
    const int r0 = ACC ? (k0 + 4 * hi + rr) : (k0 + 8 * hi + rr), r1 = ACC ? (r0 + 8) : (r0 + 4);
    const s16x4 a = lds_tr16(base + r0 * PB + col * 2), b = lds_tr16(base + r1 * PB + col * 2);
    return (bf16x8){a[0], a[1], a[2], a[3], b[0], b[1], b[2], b[3]};
}
constexpr int GL_RQ = 73728, GL_RK = 82432, GL_RG = 91136, GL_RV = 99328;
template <int MODE> DI void gla_prep(Frame& F, const Args& A, int b, int h, int n) {
    const int tid = F.tid, d = tid & 63, seg = tid >> 6;
    const float* cw = A.in[4];
    const size_t row0 = (size_t)b * SEQ + 64 * n;
    float wq[4], wk[4], wv[4];
#pragma unroll
    for (int k = 0; k < 4; ++k) { wq[k] = cw[k * 1024 + PQ + h * 64 + d]; wk[k] = cw[k * 1024 + PK + h * 64 + d]; wv[k] = cw[k * 1024 + PV + h * 128 + (tid & 127)]; }
    const float bias = A.in[6][h * 64 + d];
    {
        v4u w[6]; int lo_[6];
#pragma unroll
        for (int i = 0; i < 6; ++i) {
            const int c = tid + 512 * i;
            const int reg = (c >= 536) + (c >= 1072) + (c >= 1584);
            const int cc = c - (reg == 1 ? 536 : reg == 2 ? 1072 : reg == 3 ? 1584 : 0);
            const int rr = reg == 3 ? (cc >> 4) : (cc >> 3), ch = reg == 3 ? (cc & 15) : (cc & 7);
            const int r = rr + (reg == 2 ? 3 : 0);
            const int col = (reg == 0 ? PQ + h * 64 : reg == 1 ? PK + h * 64 : reg == 2 ? PGATE + h * 64 : PV + h * 128) + ch * 8;
            lo_[i] = (reg == 0 ? GL_RQ : reg == 1 ? GL_RK : reg == 2 ? GL_RG : GL_RV) + rr * (reg == 3 ? 256 : 128) + ch * 16;
            const bool ok = (c < 2656) && (64 * n - 3 + r >= 0);
            w[i] = (v4u){0u, 0u, 0u, 0u};
            if (ok) w[i] = *(const GAS v4u*)(F_PROJ + (row0 - 3 + r) * N1 + col);
            if (c >= 2656) lo_[i] = -1;
        }
#pragma unroll
        for (int i = 0; i < 6; ++i) if (lo_[i] >= 0) *(LAS v4u*)(F.lds + lo_[i]) = w[i];
    }
    __syncthreads();
    {
        float rq[11], rk[11], gl[8];
#pragma unroll
        for (int i = 0; i < 11; ++i) { rq[i] = bf2f(*(const LAS bf16*)(F.lds + GL_RQ + (8 * seg + i) * 128 + d * 2)); rk[i] = bf2f(*(const LAS bf16*)(F.lds + GL_RK + (8 * seg + i) * 128 + d * 2)); }
#pragma unroll
        for (int j = 0; j < 8; ++j) gl[j] = log_sigmoid_f(bf2f(*(const LAS bf16*)(F.lds + GL_RG + (8 * seg + j) * 128 + d * 2)) + bias) * (1.f / 16.f);
        float c = 0.f;
#pragma unroll
        for (int j = 0; j < 8; ++j) { c += gl[j]; gl[j] = c; }
        LAS float* SEG = (LAS float*)(F.lds + GL_SEG);
        SEG[seg * 64 + d] = c;
        __syncthreads();
        float pre = 0.f, tot = 0.f;
#pragma unroll
        for (int s = 0; s < 8; ++s) { const float v = SEG[s * 64 + d]; pre += (s < seg) ? v : 0.f; tot += v; }
#pragma unroll
        for (int j = 0; j < 8; ++j) {
            const int tok = 8 * seg + j; const float cum = pre + gl[j];
            const float qc = silu_f(wq[0] * rq[j] + wq[1] * rq[j + 1] + wq[2] * rq[j + 2] + wq[3] * rq[j + 3]);
            const float kc = silu_f(wk[0] * rk[j] + wk[1] * rk[j + 1] + wk[2] * rk[j + 2] + wk[3] * rk[j + 3]);
            if (MODE == 0) { *(LAS bf16*)(F.lds + GL_KD + tok * GL_KDP + d * 2) = (bf16)f2bf(kc * __expf(tot - cum)); }
            else { const int off = (d >> 3) * 1024 + tok * 16 + (d & 7) * 2;
                *(LAS bf16*)(F.lds + GL_QT + off) = (bf16)f2bf(qc * 0.125f * __expf(cum)); *(LAS bf16*)(F.lds + GL_KT + off) = (bf16)f2bf(kc * __expf(-cum)); }
        }
        if (MODE == 0 && seg == 0) ((float*)(F.ctl + CW_DECAY))[((size_t)(b * 4 + h) * 32 + n) * 64 + d] = __expf(tot);
    }
    {
        const int e = tid & 127, s4 = tid >> 7;
        float rv[19];
#pragma unroll
        for (int i = 0; i < 19; ++i) rv[i] = bf2f(*(const LAS bf16*)(F.lds + GL_RV + (16 * s4 + i) * 256 + e * 2));
#pragma unroll
        for (int j = 0; j < 16; ++j) *(LAS bf16*)(F.lds + GL_V + (16 * s4 + j) * GL_VP + e * 2) = (bf16)f2bf(silu_f(wv[0] * rv[j] + wv[1] * rv[j + 1] + wv[2] * rv[j + 2] + wv[3] * rv[j + 3]));
    }
}
DI void gla_local_unit(Frame& F, const Args& A, float* STW, int b, int h, int n) {
    __syncthreads();
    gla_prep<0>(F, A, b, h, n);
    __syncthreads();
    const int lane = F.lane, wid = F.wave, dt = wid & 1, et = wid >> 1, r32 = lane & 31, hi = lane >> 5;
    f32x16 acc = {};
#pragma unroll
    for (int ks = 0; ks < 4; ++ks) {
        const bf16x8 af = tr_frag<false>(F.lds + GL_KD, GL_KDP, 32 * dt, 16 * ks, lane), bfr = tr_frag<false>(F.lds + GL_V, GL_VP, 32 * et, 16 * ks, lane);
        acc = __builtin_amdgcn_mfma_f32_32x32x16_bf16(af, bfr, acc, 0, 0, 0);
    }
    float* o = STW + (((size_t)(b * 4 + h) * 32 + n) * 64 + 32 * dt) * 128 + 32 * et + r32;
#pragma unroll
    for (int r = 0; r < 16; ++r) o[(size_t)((r & 3) + 8 * (r >> 2) + 4 * hi) * 128] = acc[r];
}
DI void gla_out_unit(Frame& F, const Args& A, const float* STW, int b, int h, int n) {
    f32x4 stv[4];
    { const float* sp = STW + ((size_t)(b * 4 + h) * 32 + n) * 64 * 128;
#pragma unroll
      for (int i = 0; i < 4; ++i) stv[i] = *(const GAS f32x4*)(sp + (F.tid + i * 512) * 4); }
    __syncthreads();
    gla_prep<1>(F, A, b, h, n);
#pragma unroll
    for (int i = 0; i < 4; ++i) { const int idx = (F.tid + i * 512) * 4, dd = idx >> 7, ee = idx & 127;
        *(LAS unsigned long long*)(F.lds + GL_ST + dd * GL_VP + ee * 2) = (unsigned long long)pk2(stv[i].x, stv[i].y) | ((unsigned long long)pk2(stv[i].z, stv[i].w) << 32); }
    __syncthreads();
    const int lane = F.lane, wid = F.wave, it = wid & 1, et = wid >> 1, r32 = lane & 31, hi = lane >> 5;
    f32x16 acc = {};
    bf16x8 qf[4];
#pragma unroll
    for (int ks = 0; ks < 4; ++ks) qf[ks] = *(const LAS bf16x8*)(F.lds + GL_QT + (2 * ks + hi) * 1024 + (32 * it + r32) * 16);
#pragma unroll
    for (int ks = 0; ks < 4; ++ks) acc = __builtin_amdgcn_mfma_f32_32x32x16_bf16(tr_frag<false>(F.lds + GL_ST, GL_VP, 32 * et, 16 * ks, lane), qf[ks], acc, 0, 0, 0);
    for (int jt = 0; jt <= it; ++jt) {
        f32x16 S = {};
#pragma unroll
        for (int ks = 0; ks < 4; ++ks) S = __builtin_amdgcn_mfma_f32_32x32x16_bf16(*(const LAS bf16x8*)(F.lds + GL_KT + (2 * ks + hi) * 1024 + (32 * jt + r32) * 16), qf[ks], S, 0, 0, 0);
        if (jt == it) {
#pragma unroll
            for (int r = 0; r < 16; ++r) S[r] = ((r & 3) + 8 * (r >> 2) + 4 * hi) <= r32 ? S[r] : 0.f;
        }
#pragma unroll
        for (int s = 0; s < 2; ++s) {
            v4u pw; pw.x = cvtpk_bf16(S[8 * s + 0], S[8 * s + 1]); pw.y = cvtpk_bf16(S[8 * s + 2], S[8 * s + 3]); pw.z = cvtpk_bf16(S[8 * s + 4], S[8 * s + 5]); pw.w = cvtpk_bf16(S[8 * s + 6], S[8 * s + 7]);
            acc = __builtin_amdgcn_mfma_f32_32x32x16_bf16(tr_frag<true>(F.lds + GL_V, GL_VP, 32 * et, 32 * jt + 16 * s, lane), __builtin_bit_cast(bf16x8, pw), acc, 0, 0, 0);
        }
    }
    float ss = 0.f;
#pragma unroll
    for (int r = 0; r < 16; ++r) ss += acc[r] * acc[r];
    { auto rr = __builtin_amdgcn_permlane32_swap(__float_as_uint(ss), __float_as_uint(ss), false, false); ss = __uint_as_float(rr[0]) + __uint_as_float(rr[1]); }
    LAS float* RED = (LAS float*)(F.lds + GL_RED);
    if (hi == 0) RED[wid * 32 + r32] = ss;
    __syncthreads();
    const float tot = RED[(it + 0) * 32 + r32] + RED[(it + 2) * 32 + r32] + RED[(it + 4) * 32 + r32] + RED[(it + 6) * 32 + r32];
    const float rs = 1.f / sqrtf(tot * (1.f / 128.f) + EPS);
    const size_t row = (size_t)b * SEQ + 64 * n + 32 * it + r32;
    const float* gg = A.in[7];
#pragma unroll
    for (int g = 0; g < 4; ++g) {
        const int e0 = 32 * et + 8 * g + 4 * hi;
        const unsigned long long ogw = *(const GAS unsigned long long*)(F_PROJ + row * N1 + POG + h * 128 + e0);
        const unsigned lo = (unsigned)ogw, hi2 = (unsigned)(ogw >> 32);
        const f32x4 gv = *(const GAS f32x4*)(gg + e0);
        const float y0 = acc[4 * g + 0] * rs * gv.x * silu_f(bflo(lo)), y1 = acc[4 * g + 1] * rs * gv.y * silu_f(bfhi(lo)), y2 = acc[4 * g + 2] * rs * gv.z * silu_f(bflo(hi2)), y3 = acc[4 * g + 3] * rs * gv.w * silu_f(bfhi(hi2));
        *(GAS unsigned long long*)(F_BUFA + row * 1024 + h * 128 + e0) = (unsigned long long)pk2(y0, y1) | ((unsigned long long)pk2(y2, y3) << 32);
    }
}
DI void xattn_unit(Frame& F, const bf16* Q, bf16* O, int b, int h, int qb) {
    const int tid = F.tid, lane = F.lane, wid = F.wave, r32 = lane & 31, hi = lane >> 5;
    const bf16* Kg = F_KV + (size_t)(b * 256) * 2048 + h * 256;
    const bf16* Vg = Kg + 1024;
    const size_t row = (size_t)b * SEQ + qb * 256 + wid * 32 + r32;
    __syncthreads();
    {
        const bf16* kp = Kg + (size_t)(tid >> 5) * 2048 + (tid & 31) * 8; LAS unsigned char* kl = F.lds + (tid & 31) * 4096 + (tid >> 5) * 16;
#pragma unroll 4
        for (int i = 0; i < 16; ++i) { *(LAS v4u*)(kl) = *(const GAS v4u*)(kp); kp += 16 * 2048; kl += 256; }
    }
    bf16x8 qf[16];
#pragma unroll
    for (int ks = 0; ks < 16; ++ks) qf[ks] = *(const GAS bf16x8*)(Q + row * 1024 + h * 256 + 16 * ks + 8 * hi);
    __syncthreads();
    f32x16 S[8];
#pragma unroll
    for (int mt = 0; mt < 8; ++mt) { S[mt] = (f32x16){};
#pragma unroll
        for (int k4 = 0; k4 < 4; ++k4) {
#pragma unroll
            for (int kk = 0; kk < 4; ++kk) { const int ks = 4 * k4 + kk; S[mt] = __builtin_amdgcn_mfma_f32_32x32x16_bf16(*(const LAS bf16x8*)(F.lds + (2 * ks + hi) * 4096 + (32 * mt + r32) * 16), qf[ks], S[mt], 0, 0, 0); }
            __builtin_amdgcn_sched_barrier(0); } }
    float mx = -INFINITY;
#pragma unroll
    for (int mt = 0; mt < 8; ++mt)
#pragma unroll
        for (int r = 0; r < 16; ++r) mx = fmaxf(mx, S[mt][r]);
    { auto rr = __builtin_amdgcn_permlane32_swap(__float_as_uint(mx), __float_as_uint(mx), false, false); mx = fmaxf(__uint_as_float(rr[0]), __uint_as_float(rr[1])); }
    const float c2 = 0.0625f * 1.4426950408889634f; const float mb = mx * c2;
    float sum = 0.f;
#pragma unroll
    for (int mt = 0; mt < 8; ++mt)
#pragma unroll
        for (int r = 0; r < 16; ++r) { const float p = __builtin_amdgcn_exp2f(S[mt][r] * c2 - mb); S[mt][r] = p; sum += p; }
    { auto rr = __builtin_amdgcn_permlane32_swap(__float_as_uint(sum), __float_as_uint(sum), false, false); sum = __uint_as_float(rr[0]) + __uint_as_float(rr[1]); }
    const float linv = 1.f / sum;
    v4u pa[16];
#pragma unroll
    for (int mt = 0; mt < 8; ++mt)
#pragma unroll
        for (int s = 0; s < 2; ++s) { v4u pw; pw.x = cvtpk_bf16(S[mt][8 * s + 0] * linv, S[mt][8 * s + 1] * linv); pw.y = cvtpk_bf16(S[mt][8 * s + 2] * linv, S[mt][8 * s + 3] * linv);
            pw.z = cvtpk_bf16(S[mt][8 * s + 4] * linv, S[mt][8 * s + 5] * linv); pw.w = cvtpk_bf16(S[mt][8 * s + 6] * linv, S[mt][8 * s + 7] * linv); pa[2 * mt + s] = pw; }
    __syncthreads();
    {
        const int c = tid & 31, m0 = tid >> 5;
        const bf16* vp = Vg + (size_t)m0 * 2048 + c * 8; LAS unsigned char* vl = F.lds + (c >> 2) * 16384 + m0 * 64 + (c & 3) * 16;
#pragma unroll 4
        for (int i = 0; i < 16; ++i) { *(LAS v4u*)(vl) = *(const GAS v4u*)(vp); vp += 16 * 2048; vl += 1024; }
    }
    __syncthreads();
    const int vfr = ((lane >> 4) & 1) * 32 + (lane & 3) * 8 + (4 * hi + ((lane & 15) >> 2)) * 64;
    unsigned opk[4][16];
#pragma unroll
    for (int dp = 0; dp < 4; ++dp) {
        f32x16 a0 = {}, a1 = {};
#pragma unroll
        for (int s = 0; s < 16; ++s) {
            const LAS unsigned char* vp0 = F.lds + (2 * dp) * 16384 + s * 1024 + vfr; const LAS unsigned char* vp1 = vp0 + 16384;
            const s16x4 l0 = lds_tr16(vp0), h0 = lds_tr16(vp0 + 512), l1 = lds_tr16(vp1), h1 = lds_tr16(vp1 + 512);
            const bf16x8 v0 = {l0[0], l0[1], l0[2], l0[3], h0[0], h0[1], h0[2], h0[3]}, v1 = {l1[0], l1[1], l1[2], l1[3], h1[0], h1[1], h1[2], h1[3]};
            a0 = __builtin_amdgcn_mfma_f32_32x32x16_bf16(__builtin_bit_cast(bf16x8, pa[s]), v0, a0, 0, 0, 0);
            a1 = __builtin_amdgcn_mfma_f32_32x32x16_bf16(__builtin_bit_cast(bf16x8, pa[s]), v1, a1, 0, 0, 0);
            if ((s & 3) == 3) __builtin_amdgcn_sched_barrier(0);
        }
#pragma unroll
        for (int r = 0; r < 16; ++r) opk[dp][r] = cvtpk_bf16(a0[r], a1[r]);
        __builtin_amdgcn_sched_barrier(0);
    }
    __syncthreads();
    LAS bf16* stg = (LAS bf16*)(F.lds + wid * 16384);
#pragma unroll
    for (int dp = 0; dp < 4; ++dp)
#pragma unroll
        for (int r = 0; r < 16; ++r) { const int rr = (r & 3) + 8 * (r >> 2) + 4 * hi; stg[rr * 256 + dp * 64 + r32] = (bf16)(opk[dp][r] & 0xffffu); stg[rr * 256 + dp * 64 + 32 + r32] = (bf16)(opk[dp][r] >> 16); }
    LDS_WAIT(); asm volatile("" ::: "memory");
    bf16* Ow = O + ((size_t)b * SEQ + qb * 256 + wid * 32) * 1024 + h * 256;
    {
        bf16* op = Ow + (size_t)(lane >> 5) * 1024 + (lane & 31) * 8; const LAS bf16* sp = stg + (lane >> 5) * 256 + (lane & 31) * 8;
#pragma unroll 4
        for (int i = 0; i < 16; ++i) { *(GAS v4u*)(op) = *(const LAS v4u*)(sp); op += 2 * 1024; sp += 2 * 256; }
    }
    LDS_WAIT(); asm volatile("" ::: "memory");
}
DI void mix_row(Frame& F, const Args& A, const float* OGLA, const float* OSB, size_t row) {
    const int lane = F.lane;
    const f32x4 a0 = *(const GAS f32x4*)(OGLA + row * 512 + 8 * lane), a1 = *(const GAS f32x4*)(OGLA + row * 512 + 8 * lane + 4);
    float s = (a0.x * a0.x + a0.y * a0.y) + (a0.z * a0.z + a0.w * a0.w) + (a1.x * a1.x + a1.y * a1.y) + (a1.z * a1.z + a1.w * a1.w);
    s += __shfl_xor(s, 1); s += __shfl_xor(s, 2); s += __shfl_xor(s, 4); s += __shfl_xor(s, 8);
    const float rs = 1.f / sqrtf(s * (1.f / 128.f) + EPS);
    const int e0 = (8 * lane) & 127;
    const f32x4 g0 = *(const GAS f32x4*)(A.in[7] + e0), g1 = *(const GAS f32x4*)(A.in[7] + e0 + 4);
    const v4u ogw = *(const GAS v4u*)(F_PROJ + row * N1 + POG + 8 * lane);
    v4u o;
    o.x = pk2(a0.x * rs * g0.x * silu_f(bflo(ogw.x)), a0.y * rs * g0.y * silu_f(bfhi(ogw.x)));
    o.y = pk2(a0.z * rs * g0.z * silu_f(bflo(ogw.y)), a0.w * rs * g0.w * silu_f(bfhi(ogw.y)));
    o.z = pk2(a1.x * rs * g1.x * silu_f(bflo(ogw.z)), a1.y * rs * g1.y * silu_f(bfhi(ogw.z)));
    o.w = pk2(a1.z * rs * g1.z * silu_f(bflo(ogw.w)), a1.w * rs * g1.w * silu_f(bfhi(ogw.w)));
    *(GAS v4u*)(F_BUFA + row * 1024 + 8 * lane) = o;
    const f32x4 b0 = *(const GAS f32x4*)(OSB + row * 512 + 8 * lane), b1 = *(const GAS f32x4*)(OSB + row * 512 + 8 * lane + 4);
    float s2 = (b0.x * b0.x + b0.y * b0.y) + (b0.z * b0.z + b0.w * b0.w) + (b1.x * b1.x + b1.y * b1.y) + (b1.z * b1.z + b1.w * b1.w);
    const float rs2 = 1.f / sqrtf(wave_sum(s2) * (1.f / 512.f) + EPS);
    const f32x4 h0 = *(const GAS f32x4*)(A.in[8] + 8 * lane), h1 = *(const GAS f32x4*)(A.in[8] + 8 * lane + 4);
    v4u p;
    p.x = pk2(b0.x * rs2 * h0.x, b0.y * rs2 * h0.y); p.y = pk2(b0.z * rs2 * h0.z, b0.w * rs2 * h0.w);
    p.z = pk2(b1.x * rs2 * h1.x, b1.y * rs2 * h1.y); p.w = pk2(b1.z * rs2 * h1.z, b1.w * rs2 * h1.w);
    *(GAS v4u*)(F_BUFA + row * 1024 + 512 + 8 * lane) = p;
}
DI void mix_row_sb(Frame& F, const Args& A, const float* OSB, size_t row) {
    const int lane = F.lane;
    const f32x4 b0 = *(const GAS f32x4*)(OSB + row * 512 + 8 * lane), b1 = *(const GAS f32x4*)(OSB + row * 512 + 8 * lane + 4);
    float s2 = (b0.x * b0.x + b0.y * b0.y) + (b0.z * b0.z + b0.w * b0.w) + (b1.x * b1.x + b1.y * b1.y) + (b1.z * b1.z + b1.w * b1.w);
    const float rs2 = 1.f / sqrtf(wave_sum(s2) * (1.f / 512.f) + EPS);
    const f32x4 h0 = *(const GAS f32x4*)(A.in[8] + 8 * lane), h1 = *(const GAS f32x4*)(A.in[8] + 8 * lane + 4);
    v4u p;
    p.x = pk2(b0.x * rs2 * h0.x, b0.y * rs2 * h0.y); p.y = pk2(b0.z * rs2 * h0.z, b0.w * rs2 * h0.w);
    p.z = pk2(b1.x * rs2 * h1.x, b1.y * rs2 * h1.y); p.w = pk2(b1.z * rs2 * h1.z, b1.w * rs2 * h1.w);
    *(GAS v4u*)(F_BUFA + row * 1024 + 512 + 8 * lane) = p;
}
DI void gla_scan(Frame& F, float* STW) {
    const int gt = (F.vcu * NWAVES + F.wave) * 64 + F.lane, NGT = F.G * NWAVES * 64;
    const float* dec = (const float*)(F.ctl + CW_DECAY);
    for (int idx = gt; idx < 32 * 8192; idx += NGT) {
        const int bh = idx >> 13, de = idx & 8191, d = de >> 7;
        float* p = STW + (size_t)bh * 32 * 8192 + de; const float* dp = dec + (size_t)bh * 32 * 64 + d;
        float tmp[32], dc[32];
#pragma unroll
        for (int n = 0; n < 32; ++n) { tmp[n] = p[(size_t)n * 8192]; dc[n] = dp[n * 64]; }
        float st = 0.f;
#pragma unroll
        for (int n = 0; n < 32; ++n) { p[(size_t)n * 8192] = st; st = dc[n] * st + tmp[n]; }
    }
}
DI void xsoftmax_row(Frame& F, bf16* S, size_t rh) {
    unsigned long long* p = (unsigned long long*)(S + rh * 256) + F.lane;
    const unsigned long long w = *p; const unsigned lo = (unsigned)w, hi = (unsigned)(w >> 32);
    const float sc = 0.0625f;
    float a = bflo(lo) * sc, b = bfhi(lo) * sc, c = bflo(hi) * sc, d = bfhi(hi) * sc;
    const float mx = wave_max(fmaxf(fmaxf(a, b), fmaxf(c, d)));
    a = __expf(a - mx); b = __expf(b - mx); c = __expf(c - mx); d = __expf(d - mx);
    const float inv = 1.f / wave_sum((a + b) + (c + d));
    *p = (unsigned long long)pk2(a * inv, b * inv) | ((unsigned long long)pk2(c * inv, d * inv) << 32);
}
DI float topk_round2(float& c0, float& c1) {
    const float w = wave_max(fmaxf(c0, c1));
    if (c0 == w) c0 = -INFINITY; if (c1 == w) c1 = -INFINITY;
    return w;
}
DI void peer_topk_item(Frame& F, const bf16* PQb, int* IDX, float* GATE, size_t row, int h) {
    const int lane = F.lane;
    float mylist[2];
#pragma unroll
    for (int p = 0; p < 2; ++p) {
        LAS unsigned* qs = (LAS unsigned*)(F.lds + F.wave * 1024);
        qs[lane] = *(const GAS unsigned*)(PQb + row * 2048 + (h * 2 + p) * 128 + 2 * lane);
        LDS_WAIT(); asm volatile("" ::: "memory");
        const bf16* kbase = F_SUBK + (size_t)((h * 2 + p) * 128) * 128;
        float s0 = 0.f, s1 = 0.f;
        const GAS v4u* k0p = (const GAS v4u*)(kbase + (size_t)lane * 128); const GAS v4u* k1p = (const GAS v4u*)(kbase + (size_t)(lane + 64) * 128);
#pragma unroll
        for (int c = 0; c < 16; ++c) {
            const v4u a = k0p[c], b = k1p[c];
            const v4u qq = *(const LAS v4u*)(qs + 4 * c); const unsigned q0 = qq.x, q1 = qq.y, q2 = qq.z, q3 = qq.w;
            s0 += bflo(a.x) * bflo(q0) + bfhi(a.x) * bfhi(q0) + bflo(a.y) * bflo(q1) + bfhi(a.y) * bfhi(q1) + bflo(a.z) * bflo(q2) + bfhi(a.z) * bfhi(q2) + bflo(a.w) * bflo(q3) + bfhi(a.w) * bfhi(q3);
            s1 += bflo(b.x) * bflo(q0) + bfhi(b.x) * bfhi(q0) + bflo(b.y) * bflo(q1) + bfhi(b.y) * bfhi(q1) + bflo(b.z) * bflo(q2) + bfhi(b.z) * bfhi(q2) + bflo(b.w) * bflo(q3) + bfhi(b.w) * bfhi(q3);
        }
        float c0 = __uint_as_float((__float_as_uint(s0) & ~0x7fu) | (unsigned)lane), c1 = __uint_as_float((__float_as_uint(s1) & ~0x7fu) | (unsigned)(lane + 64));
        float mine = 0.f;
#pragma unroll
        for (int r = 0; r < 16; ++r) { const float w = topk_round2(c0, c1); if (lane == r) mine = w; }
        mylist[p] = mine;
        LDS_WAIT(); asm volatile("" ::: "memory");
    }
    const float va = __uint_as_float(__float_as_uint(__shfl(mylist[0], lane >> 2)) & ~0x7fu);
    float cand[4];
#pragma unroll
    for (int j = 0; j < 4; ++j) { const int bb = 4 * (lane & 3) + j; const float vb = __uint_as_float(__float_as_uint(__shfl(mylist[1], bb)) & ~0x7fu);
        cand[j] = __uint_as_float((__float_as_uint(va + vb) & ~0xffu) | (unsigned)((lane >> 2) * 16 + bb)); }
    float best = 0.f, top = 0.f;
#pragma unroll
    for (int r = 0; r < 16; ++r) {
        const float w = wave_max(fmaxf(fmaxf(cand[0], cand[1]), fmaxf(cand[2], cand[3])));
#pragma unroll
        for (int j = 0; j < 4; ++j) if (cand[j] == w) cand[j] = -INFINITY;
        if (lane == r) best = w; if (r == 0) top = w;
    }
    const unsigned bu = __float_as_uint(best); const int ca = (bu >> 4) & 15, cb = bu & 15;
    const int i1 = (int)(__float_as_uint(__shfl(mylist[0], ca)) & 0x7fu), i2 = (int)(__float_as_uint(__shfl(mylist[1], cb)) & 0x7fu);
    const float sc = __uint_as_float(bu & ~0xffu), tp = __uint_as_float(__float_as_uint(top) & ~0xffu);
    const float ex = lane < 16 ? __expf(sc - tp) : 0.f;
    const float inv = 1.f / wave_sum(ex);
    if (lane < 16) { IDX[row * 128 + h * 16 + lane] = i1 * 128 + i2; GATE[row * 128 + h * 16 + lane] = ex * inv; }
}
DI float vmaxf(float a, float b) { float r; asm("v_max_f32_e32 %0, %1, %2" : "=v"(r) : "v"(a), "v"(b)); return r; }
DI float vminf(float a, float b) { float r; asm("v_min_f32_e32 %0, %1, %2" : "=v"(r) : "v"(a), "v"(b)); return r; }
DI void ins16(float (&L)[16], float x) {
#pragma unroll
    for (int i = 0; i < 16; ++i) { const float h = vmaxf(L[i], x); x = vminf(L[i], x); L[i] = h; }
}
DI void peer_topk_mfma(Frame& F, const bf16* PQb, int* IDX, float* GATE) {
    const int tid = F.tid, lane = F.lane, wid = F.wave, r32 = lane & 31, hi = lane >> 5, h = F.vcu & 7;
    __syncthreads();
    for (int i = tid; i < 2 * 128 * 16; i += 512) { const int p = i >> 11, key = (i >> 4) & 127, c = i & 15;
        *(LAS v4u*)(F.lds + p * 32768 + c * 2048 + key * 16) = *(const GAS v4u*)(F_SUBK + (size_t)((h * 2 + p) * 128 + key) * 128 + c * 8); }
    __syncthreads();
    LAS unsigned* scr = (LAS unsigned*)(F.lds + 65536 + wid * 8192) + lane;
    for (int g = (F.vcu >> 3) * 8 + wid; g < 512; g += (F.G >> 3) * 8) {
        const size_t token = (size_t)32 * g + r32;
        float LA[16], LB[16];
#pragma unroll
        for (int p = 0; p < 2; ++p) {
            float (&L)[16] = p ? LB : LA;
#pragma unroll
            for (int i = 0; i < 16; ++i) L[i] = -INFINITY;
            bf16x8 qf[8];
#pragma unroll
            for (int ks = 0; ks < 8; ++ks) qf[ks] = *(const GAS bf16x8*)(PQb + token * 2048 + (h * 2 + p) * 128 + 16 * ks + 8 * hi);
#pragma unroll
            for (int rt = 0; rt < 4; ++rt) {
                f32x16 S = {};
#pragma unroll
                for (int ks = 0; ks < 8; ++ks) S = __builtin_amdgcn_mfma_f32_32x32x16_bf16(*(const LAS bf16x8*)(F.lds + p * 32768 + (2 * ks + hi) * 2048 + (32 * rt + r32) * 16), qf[ks], S, 0, 0, 0);
#pragma unroll
                for (int r = 0; r < 16; ++r) { const unsigned key = (unsigned)(32 * rt + (r & 3) + 8 * (r >> 2)) + 4u * (unsigned)hi;
                    ins16(L, __uint_as_float((__float_as_uint(S[r]) & ~0x7fu) | key)); }
            }
            float PL[16];
#pragma unroll
            for (int i = 0; i < 16; ++i) { auto rr = __builtin_amdgcn_permlane32_swap(__float_as_uint(L[i]), __float_as_uint(L[i]), false, false); PL[i] = __uint_as_float(hi ? rr[0] : rr[1]); }
#pragma unroll
            for (int i = 0; i < 16; ++i) ins16(L, PL[i]);
        }
        float C[16];
#pragma unroll
        for (int i = 0; i < 16; ++i) C[i] = -INFINITY;
#pragma unroll
        for (int a = 0; a < 16; ++a) {
            const float va = __uint_as_float(__float_as_uint(LA[a]) & ~0x7fu);
#pragma unroll
            for (int b = 0; b < 16; ++b) if ((a + 1) * (b + 1) <= 16) {
                const float vb = __uint_as_float(__float_as_uint(LB[b]) & ~0x7fu);
                ins16(C, __uint_as_float((__float_as_uint(va + vb) & ~0xffu) | (unsigned)(a * 16 + b)));
            }
        }
#pragma unroll
        for (int i = 0; i < 16; ++i) { scr[i * 64] = __float_as_uint(LA[i]) & 0x7fu; scr[(16 + i) * 64] = __float_as_uint(LB[i]) & 0x7fu; }
        LDS_WAIT(); asm volatile("" ::: "memory");
        const float top = __uint_as_float(__float_as_uint(C[0]) & ~0xffu);
        float ex[16]; int ei[16]; float sum = 0.f;
#pragma unroll
        for (int r = 0; r < 16; ++r) { const unsigned cu = __float_as_uint(C[r]); ex[r] = __expf(__uint_as_float(cu & ~0xffu) - top); sum += ex[r];
            ei[r] = (int)(scr[((cu >> 4) & 15) * 64] * 128u + scr[(16 + (cu & 15)) * 64]); }
        const float inv = 1.f / sum;
        v4u io0, io1; f32x4 go0, go1;
        io0.x = hi ? ei[8] : ei[0]; io0.y = hi ? ei[9] : ei[1]; io0.z = hi ? ei[10] : ei[2]; io0.w = hi ? ei[11] : ei[3];
        io1.x = hi ? ei[12] : ei[4]; io1.y = hi ? ei[13] : ei[5]; io1.z = hi ? ei[14] : ei[6]; io1.w = hi ? ei[15] : ei[7];
        go0.x = (hi ? ex[8] : ex[0]) * inv; go0.y = (hi ? ex[9] : ex[1]) * inv; go0.z = (hi ? ex[10] : ex[2]) * inv; go0.w = (hi ? ex[11] : ex[3]) * inv;
        go1.x = (hi ? ex[12] : ex[4]) * inv; go1.y = (hi ? ex[13] : ex[5]) * inv; go1.z = (hi ? ex[14] : ex[6]) * inv; go1.w = (hi ? ex[15] : ex[7]) * inv;
        int* ip = IDX + token * 128 + h * 16 + 8 * hi; float* gp = GATE + token * 128 + h * 16 + 8 * hi;
        *(GAS v4u*)ip = io0; *(GAS v4u*)(ip + 4) = io1; *(GAS f32x4*)gp = go0; *(GAS f32x4*)(gp + 4) = go1;
        LDS_WAIT(); asm volatile("" ::: "memory");
    }
}
#define CE(a, b) do { const float h_ = vmaxf(a, b); const float l_ = vminf(a, b); a = h_; b = l_; } while (0)
DI void sort16_desc(float (&v)[16]) { CE(v[0],v[1]); CE(v[2],v[3]); CE(v[0],v[2]); CE(v[1],v[3]); CE(v[1],v[2]); CE(v[4],v[5]); CE(v[6],v[7]); CE(v[4],v[6]); CE(v[5],v[7]); CE(v[5],v[6]); CE(v[0],v[4]); CE(v[2],v[6]); CE(v[2],v[4]); CE(v[1],v[5]); CE(v[3],v[7]); CE(v[3],v[5]); CE(v[1],v[2]); CE(v[3],v[4]); CE(v[5],v[6]); CE(v[8],v[9]); CE(v[10],v[11]); CE(v[8],v[10]); CE(v[9],v[11]); CE(v[9],v[10]); CE(v[12],v[13]); CE(v[14],v[15]); CE(v[12],v[14]); CE(v[13],v[15]); CE(v[13],v[14]); CE(v[8],v[12]); CE(v[10],v[14]); CE(v[10],v[12]); CE(v[9],v[13]); CE(v[11],v[15]); CE(v[11],v[13]); CE(v[9],v[10]); CE(v[11],v[12]); CE(v[13],v[14]); CE(v[0],v[8]); CE(v[4],v[12]); CE(v[4],v[8]); CE(v[2],v[10]); CE(v[6],v[14]); CE(v[6],v[10]); CE(v[2],v[4]); CE(v[6],v[8]); CE(v[10],v[12]); CE(v[1],v[9]); CE(v[5],v[13]); CE(v[5],v[9]); CE(v[3],v[11]); CE(v[7],v[15]); CE(v[7],v[11]); CE(v[3],v[5]); CE(v[7],v[9]); CE(v[11],v[13]); CE(v[1],v[2]); CE(v[3],v[4]); CE(v[5],v[6]); CE(v[7],v[8]); CE(v[9],v[10]); CE(v[11],v[12]); CE(v[13],v[14]); }
DI void bmerge16_desc(float (&v)[16]) { CE(v[0],v[8]); CE(v[1],v[9]); CE(v[2],v[10]); CE(v[3],v[11]); CE(v[4],v[12]); CE(v[5],v[13]); CE(v[6],v[14]); CE(v[7],v[15]); CE(v[0],v[4]); CE(v[1],v[5]); CE(v[2],v[6]); CE(v[3],v[7]); CE(v[8],v[12]); CE(v[9],v[13]); CE(v[10],v[14]); CE(v[11],v[15]); CE(v[0],v[2]); CE(v[1],v[3]); CE(v[4],v[6]); CE(v[5],v[7]); CE(v[8],v[10]); CE(v[9],v[11]); CE(v[12],v[14]); CE(v[13],v[15]); CE(v[0],v[1]); CE(v[2],v[3]); CE(v[4],v[5]); CE(v[6],v[7]); CE(v[8],v[9]); CE(v[10],v[11]); CE(v[12],v[13]); CE(v[14],v[15]); }
#undef CE
template <int NV> DI void merge_top16(float (&L)[16], const float (&N)[NV]) {
#pragma unroll
    for (int i = 16 - NV; i < 16; ++i) L[i] = vmaxf(L[i], N[15 - i]);
    bmerge16_desc(L);
}
DI float pack_cand(float s, int id) { return __uint_as_float((__float_as_uint(s) & ~0xffu) | (unsigned)(255 - id)); }
DI void peer_topk_mfma2(Frame& F, const bf16* PQb, int* IDX, float* GATE) {
    const int tid = F.tid, lane = F.lane, wid = F.wave, r32 = lane & 31, hi = lane >> 5, h = F.vcu & 7;
    __syncthreads();
    for (int i = tid; i < 2 * 128 * 16; i += 512) { const int p = i >> 11, key = (i >> 4) & 127, c = i & 15;
        *(LAS v4u*)(F.lds + p * 32768 + c * 2048 + key * 16) = *(const GAS v4u*)(F_SUBK + (size_t)((h * 2 + p) * 128 + key) * 128 + c * 8); }
    __syncthreads();
    LAS unsigned* scr = (LAS unsigned*)(F.lds + 65536 + wid * 8192) + lane;
    for (int g = (F.vcu >> 3) * 8 + wid; g < 512; g += (F.G >> 3) * 8) {
        const size_t token = (size_t)32 * g + r32;
        float LA[16], LB[16];
#pragma unroll
        for (int p = 0; p < 2; ++p) {
            float (&L)[16] = p ? LB : LA;
            bf16x8 qf[8];
#pragma unroll
            for (int ks = 0; ks < 8; ++ks) qf[ks] = *(const GAS bf16x8*)(PQb + token * 2048 + (h * 2 + p) * 128 + 16 * ks + 8 * hi);
#pragma unroll
            for (int rt = 0; rt < 4; ++rt) {
                f32x16 S = {};
#pragma unroll
                for (int ks = 0; ks < 8; ++ks) S = __builtin_amdgcn_mfma_f32_32x32x16_bf16(*(const LAS bf16x8*)(F.lds + p * 32768 + (2 * ks + hi) * 2048 + (32 * rt + r32) * 16), qf[ks], S, 0, 0, 0);
                float v[16];
#pragma unroll
                for (int r = 0; r < 16; ++r) { const unsigned key = (unsigned)(32 * rt + (r & 3) + 8 * (r >> 2)) + 4u * (unsigned)hi; v[r] = __uint_as_float((__float_as_uint(S[r]) & ~0x7fu) | key); }
                sort16_desc(v);
                if (rt == 0) {
#pragma unroll
                    for (int i = 0; i < 16; ++i) L[i] = v[i];
                } else merge_top16<16>(L, v);
            }
            float PL[16];
#pragma unroll
            for (int i = 0; i < 16; ++i) { auto rr = __builtin_amdgcn_permlane32_swap(__float_as_uint(L[i]), __float_as_uint(L[i]), false, false); PL[i] = __uint_as_float(hi ? rr[0] : rr[1]); }
            merge_top16<16>(L, PL);
        }
#pragma unroll
        for (int i = 0; i < 16; ++i) { scr[i * 64] = __float_as_uint(LA[i]) & 0x7fu; scr[(16 + i) * 64] = __float_as_uint(LB[i]) & 0x7fu; }
        float VA[16], VB[16];
#pragma unroll
        for (int i = 0; i < 16; ++i) { VA[i] = __uint_as_float(__float_as_uint(LA[i]) & ~0x7fu); VB[i] = __uint_as_float(__float_as_uint(LB[i]) & ~0x7fu); }
        float C[16];
#pragma unroll
        for (int b = 0; b < 16; ++b) C[b] = pack_cand(VA[0] + VB[b], b);
        { float R[8];
#pragma unroll
          for (int b = 0; b < 8; ++b) R[b] = pack_cand(VA[1] + VB[b], 16 + b);
          merge_top16<8>(C, R); }
        { float R[5];
#pragma unroll
          for (int b = 0; b < 5; ++b) R[b] = pack_cand(VA[2] + VB[b], 32 + b);
          merge_top16<5>(C, R); }
        { float R[4];
#pragma unroll
          for (int b = 0; b < 4; ++b) R[b] = pack_cand(VA[3] + VB[b], 48 + b);
          merge_top16<4>(C, R); }
        { float R[3];
#pragma unroll
          for (int b = 0; b < 3; ++b) R[b] = pack_cand(VA[4] + VB[b], 64 + b);
          merge_top16<3>(C, R); }
        { float R[11];
#pragma unroll
          for (int i = 0; i < 11; ++i) R[i] = pack_cand(VA[5 + i] + VB[0], (5 + i) * 16);
          merge_top16<11>(C, R); }
        { float R[3];
#pragma unroll
          for (int i = 0; i < 3; ++i) R[i] = pack_cand(VA[5 + i] + VB[1], (5 + i) * 16 + 1);
          merge_top16<3>(C, R); }
        LDS_WAIT(); asm volatile("" ::: "memory");
        const float top = __uint_as_float(__float_as_uint(C[0]) & ~0xffu);
        float ex[16]; int ei[16]; float sum = 0.f;
#pragma unroll
        for (int r = 0; r < 16; ++r) { const unsigned cu = __float_as_uint(C[r]), id = 255u - (cu & 0xffu); ex[r] = __expf(__uint_as_float(cu & ~0xffu) - top); sum += ex[r];
            ei[r] = (int)(scr[(id >> 4) * 64] * 128u + scr[(16 + (id & 15)) * 64]); }
        const float inv = 1.f / sum;
        v4u io0, io1; f32x4 go0, go1;
        io0.x = hi ? ei[8] : ei[0]; io0.y = hi ? ei[9] : ei[1]; io0.z = hi ? ei[10] : ei[2]; io0.w = hi ? ei[11] : ei[3];
        io1.x = hi ? ei[12] : ei[4]; io1.y = hi ? ei[13] : ei[5]; io1.z = hi ? ei[14] : ei[6]; io1.w = hi ? ei[15] : ei[7];
        go0.x = (hi ? ex[8] : ex[0]) * inv; go0.y = (hi ? ex[9] : ex[1]) * inv; go0.z = (hi ? ex[10] : ex[2]) * inv; go0.w = (hi ? ex[11] : ex[3]) * inv;
        go1.x = (hi ? ex[12] : ex[4]) * inv; go1.y = (hi ? ex[13] : ex[5]) * inv; go1.z = (hi ? ex[14] : ex[6]) * inv; go1.w = (hi ? ex[15] : ex[7]) * inv;
        int* ip = IDX + token * 128 + h * 16 + 8 * hi; float* gp = GATE + token * 128 + h * 16 + 8 * hi;
        *(GAS v4u*)ip = io0; *(GAS v4u*)(ip + 4) = io1; *(GAS f32x4*)gp = go0; *(GAS f32x4*)(gp + 4) = go1;
        LDS_WAIT(); asm volatile("" ::: "memory");
    }
}
DI void peer_gather_row(Frame& F, const Args& A, const bf16* XN2, const int* IDX, const float* GATE, size_t row) {
    const int lane = F.lane;
    const v4u xa = *(const GAS v4u*)(XN2 + row * 1024 + 8 * lane), xb = *(const GAS v4u*)(XN2 + row * 1024 + 512 + 8 * lane);
    const int id0 = IDX[row * 128 + lane], id1 = IDX[row * 128 + 64 + lane];
    const float g0 = GATE[row * 128 + lane], g1 = GATE[row * 128 + 64 + lane];
    float acc[16];
#pragma unroll
    for (int i = 0; i < 16; ++i) acc[i] = 0.f;
#define PEER_DOT2(w, x, a) dot2_bf16((w), (x), (a))
    for (int half = 0; half < 2; ++half) {
        const int idv = half ? id1 : id0; const float gv = half ? g1 : g0;
        for (int e0 = 0; e0 < 64; e0 += 4) {
            v4u ua[4], ub[4], va[4], vb[4]; float gt[4];
#pragma unroll
            for (int j = 0; j < 4; ++j) {
                const int id = __builtin_amdgcn_readlane(idv, e0 + j); gt[j] = __uint_as_float(__builtin_amdgcn_readlane(__float_as_uint(gv), e0 + j));
                const bf16* up = F_UB + (size_t)id * 1024; const bf16* vp = F_VB + (size_t)id * 1024;
                ua[j] = *(const GAS v4u*)(up + 8 * lane); ub[j] = *(const GAS v4u*)(up + 512 + 8 * lane);
                va[j] = *(const GAS v4u*)(vp + 8 * lane); vb[j] = *(const GAS v4u*)(vp + 512 + 8 * lane);
            }
#pragma unroll
            for (int j = 0; j < 4; ++j) {
                float d0 = 0.f, d1 = 0.f;
                d0 = PEER_DOT2(ua[j].x, xa.x, d0); d1 = PEER_DOT2(ua[j].y, xa.y, d1); d0 = PEER_DOT2(ua[j].z, xa.z, d0); d1 = PEER_DOT2(ua[j].w, xa.w, d1);
                d0 = PEER_DOT2(ub[j].x, xb.x, d0); d1 = PEER_DOT2(ub[j].y, xb.y, d1); d0 = PEER_DOT2(ub[j].z, xb.z, d0); d1 = PEER_DOT2(ub[j].w, xb.w, d1);
                const float a = wave_sum(d0 + d1);
                const float cf = gt[j] * gelu_tanh_f(a);
                acc[0] += cf * bflo(va[j].x); acc[1] += cf * bfhi(va[j].x); acc[2] += cf * bflo(va[j].y); acc[3] += cf * bfhi(va[j].y);
                acc[4] += cf * bflo(va[j].z); acc[5] += cf * bfhi(va[j].z); acc[6] += cf * bflo(va[j].w); acc[7] += cf * bfhi(va[j].w);
                acc[8] += cf * bflo(vb[j].x); acc[9] += cf * bfhi(vb[j].x); acc[10] += cf * bflo(vb[j].y); acc[11] += cf * bfhi(vb[j].y);
                acc[12] += cf * bflo(vb[j].z); acc[13] += cf * bfhi(vb[j].z); acc[14] += cf * bflo(vb[j].w); acc[15] += cf * bfhi(vb[j].w);
            }
        }
    }
#undef PEER_DOT2
    float* hp = F.out + row * 1024;
    f32x4 y[4]; const int c0 = 8 * lane, c1 = 512 + 8 * lane;
    y[0] = *(const GAS f32x4*)(hp + c0); y[1] = *(const GAS f32x4*)(hp + c0 + 4); y[2] = *(const GAS f32x4*)(hp + c1); y[3] = *(const GAS f32x4*)(hp + c1 + 4);
    float ss = 0.f;
#pragma unroll
    for (int i = 0; i < 4; ++i) { y[i].x += acc[4 * i]; y[i].y += acc[4 * i + 1]; y[i].z += acc[4 * i + 2]; y[i].w += acc[4 * i + 3]; ss += (y[i].x * y[i].x + y[i].y * y[i].y) + (y[i].z * y[i].z + y[i].w * y[i].w); }
    const float rs = 1.f / sqrtf(wave_sum(ss) * (1.f / 1024.f) + EPS);
    const f32x4 g0v = *(const GAS f32x4*)(A.in[20] + c0), g1v = *(const GAS f32x4*)(A.in[20] + c0 + 4), g2v = *(const GAS f32x4*)(A.in[20] + c1), g3v = *(const GAS f32x4*)(A.in[20] + c1 + 4);
    *(GAS f32x4*)(hp + c0) = y[0] * rs * g0v; *(GAS f32x4*)(hp + c0 + 4) = y[1] * rs * g1v; *(GAS f32x4*)(hp + c1) = y[2] * rs * g2v; *(GAS f32x4*)(hp + c1 + 4) = y[3] * rs * g3v;
}
template <int TPW> DI void peer_gather_sweep(Frame& F, const Args& A, const int* IDX, const float* GATE, size_t tok0) {
    const int lane = F.lane;
    const unsigned char* U8 = F.ws + WS_U8; const unsigned char* V8 = F.ws + WS_V8; const unsigned char* X8 = F.ws + WS_X8;
    const float* SU = (const float*)(F.ws + WS_SU); const float* SX = (const float*)(F.ws + WS_SX);
    f32x2 acc[TPW][8]; v4u xq[TPW]; int idlo[TPW], idhi[TPW]; float glo[TPW], ghi[TPW], sxv[TPW];
#pragma unroll
    for (int tl = 0; tl < TPW; ++tl) {
        const size_t t = tok0 + tl;
#pragma unroll
        for (int i = 0; i < 8; ++i) acc[tl][i] = (f32x2){0.f, 0.f};
        xq[tl] = *(const GAS v4u*)(X8 + t * 1024 + 16 * lane);
        idlo[tl] = IDX[t * 128 + lane]; idhi[tl] = IDX[t * 128 + 64 + lane]; glo[tl] = GATE[t * 128 + lane]; ghi[tl] = GATE[t * 128 + 64 + lane];
        sxv[tl] = SX[t] * (1.f / 64.f);
    }
    const int l3 = lane & 3; const bool b0 = lane & 1, b1 = lane & 2;
    for (int s = 0; s < 32; ++s) {
#pragma unroll
        for (int tl = 0; tl < TPW; ++tl) {
            unsigned long long mlo = __ballot((idlo[tl] >> 9) == s), mhi = __ballot((idhi[tl] >> 9) == s);
            while (mlo | mhi) {
                int id[4]; float g[4];
#pragma unroll
                for (int j = 0; j < 4; ++j) {
                    if (mlo) { const int e = __builtin_ctzll(mlo); mlo &= mlo - 1; id[j] = __builtin_amdgcn_readlane(idlo[tl], e); g[j] = __uint_as_float(__builtin_amdgcn_readlane(__float_as_uint(glo[tl]), e)); }
                    else if (mhi) { const int e = __builtin_ctzll(mhi); mhi &= mhi - 1; id[j] = __builtin_amdgcn_readlane(idhi[tl], e); g[j] = __uint_as_float(__builtin_amdgcn_readlane(__float_as_uint(ghi[tl]), e)); }
                    else { id[j] = id[0]; g[j] = 0.f; }
                }
                v4u uu[4], vv[4]; float su[4]; int p[4];
#pragma unroll
                for (int j = 0; j < 4; ++j) { uu[j] = *(const GAS v4u*)(U8 + (size_t)id[j] * 1024 + 16 * lane); vv[j] = *(const GAS v4u*)(V8 + (size_t)id[j] * 1024 + 16 * lane); su[j] = SU[id[j]]; }
#pragma unroll
                for (int j = 0; j < 4; ++j) { int d = __builtin_amdgcn_sdot4((int)uu[j].x, (int)xq[tl].x, 0, false); d = __builtin_amdgcn_sdot4((int)uu[j].y, (int)xq[tl].y, d, false);
                    d = __builtin_amdgcn_sdot4((int)uu[j].z, (int)xq[tl].z, d, false); p[j] = __builtin_amdgcn_sdot4((int)uu[j].w, (int)xq[tl].w, d, false); }
                const int kA = b0 ? p[1] : p[0], sA = b0 ? p[0] : p[1], kB = b0 ? p[3] : p[2], sB = b0 ? p[2] : p[3];
                const int qA = kA + dpp_i<0xB1>(sA), qB = kB + dpp_i<0xB1>(sB);
                const int kk = b1 ? qB : qA, ss = b1 ? qA : qB;
                int r = kk + dpp_i<0x4E>(ss);
                r += dpp_i<0x124>(r); r += dpp_i<0x128>(r);
                r += __shfl_xor(r, 16); r += __shfl_xor(r, 32);
                const float sus = l3 == 0 ? su[0] : l3 == 1 ? su[1] : l3 == 2 ? su[2] : su[3];
                const float gs = l3 == 0 ? g[0] : l3 == 1 ? g[1] : l3 == 2 ? g[2] : g[3];
                const float a = (float)r * sus * (sxv[tl] * 64.f);
                const float cfl = gs * gelu_tanh_f(a) * (1.f / 64.f);
#pragma unroll
                for (int j = 0; j < 4; ++j) {
                    const float cf = __uint_as_float(__builtin_amdgcn_readlane(__float_as_uint(cfl), j)); const f32x2 c2 = {cf, cf};
#pragma unroll
                    for (int w = 0; w < 4; ++w) { acc[tl][2 * w] = __builtin_amdgcn_cvt_pk_f32_fp8((int)vv[j][w], false) * c2 + acc[tl][2 * w]; acc[tl][2 * w + 1] = __builtin_amdgcn_cvt_pk_f32_fp8((int)vv[j][w], true) * c2 + acc[tl][2 * w + 1]; }
                }
            }
        }
    }
#pragma unroll
    for (int tl = 0; tl < TPW; ++tl) {
        float* hp = F.out + (tok0 + tl) * 1024 + 16 * lane;
        f32x4 y[4]; float ssq = 0.f;
#pragma unroll
        for (int i = 0; i < 4; ++i) { y[i] = *(const GAS f32x4*)(hp + 4 * i); y[i].x += acc[tl][2 * i].x; y[i].y += acc[tl][2 * i].y; y[i].z += acc[tl][2 * i + 1].x; y[i].w += acc[tl][2 * i + 1].y;
            ssq += (y[i].x * y[i].x + y[i].y * y[i].y) + (y[i].z * y[i].z + y[i].w * y[i].w); }
        const float rs = 1.f / sqrtf(wave_sum(ssq) * (1.f / 1024.f) + EPS);
#pragma unroll
        for (int i = 0; i < 4; ++i) { const f32x4 gv = *(const GAS f32x4*)(A.in[20] + 16 * lane + 4 * i); *(GAS f32x4*)(hp + 4 * i) = y[i] * rs * gv; }
    }
}
constexpr int GL3_LIST = 0, GL3_X = 65536;
struct G3Buf { v4u uu[4], vv[4], xx[4]; };
template <int TPW> DI void g3_issue(G3Buf& B, v4u& E, const LAS unsigned char* list, const LAS unsigned char* xl, const unsigned char* U8, const unsigned char* V8, int b, int lane) {
    E = *(const LAS v4u*)(list + (4 * b + (lane & 3)) * 16);
#pragma unroll
    for (int j = 0; j < 4; ++j) {
        const unsigned w = (unsigned)__builtin_amdgcn_readlane((int)E.x, j); const unsigned id = w & 0xffffu, tl = w >> 16;
        B.uu[j] = *(const GAS v4u*)(U8 + (size_t)id * 1024 + 16 * lane); B.vv[j] = *(const GAS v4u*)(V8 + (size_t)id * 1024 + 16 * lane);
        B.xx[j] = *(const LAS v4u*)(xl + tl * 1024 + 16 * lane);
    }
}
template <int TPW> DI void g3_compute(f32x2 (&acc)[TPW][8], const G3Buf& B, const v4u& E, int lane) {
    int p[4];
#pragma unroll
    for (int j = 0; j < 4; ++j) { int d = __builtin_amdgcn_sdot4((int)B.uu[j].x, (int)B.xx[j].x, 0, false); d = __builtin_amdgcn_sdot4((int)B.uu[j].y, (int)B.xx[j].y, d, false);
        d = __builtin_amdgcn_sdot4((int)B.uu[j].z, (int)B.xx[j].z, d, false); p[j] = __builtin_amdgcn_sdot4((int)B.uu[j].w, (int)B.xx[j].w, d, false); }
    const bool b0 = lane & 1, b1 = lane & 2;
    const int kA = b0 ? p[1] : p[0], sA = b0 ? p[0] : p[1], kB = b0 ? p[3] : p[2], sB = b0 ? p[2] : p[3];
    const int qA = kA + dpp_i<0xB1>(sA), qB = kB + dpp_i<0xB1>(sB);
    const int kk = b1 ? qB : qA, ss = b1 ? qA : qB;
    int r = kk + dpp_i<0x4E>(ss);
    r += dpp_i<0x124>(r); r += dpp_i<0x128>(r);
    r += __shfl_xor(r, 16); r += __shfl_xor(r, 32);
    const float a = (float)r * __uint_as_float(E.z);
    const float cfl = __uint_as_float(E.y) * gelu_tanh_f(a);
#pragma unroll
    for (int j = 0; j < 4; ++j) {
        const float cf = __uint_as_float(__builtin_amdgcn_readlane(__float_as_uint(cfl), j)); const f32x2 c2 = {cf, cf};
        const unsigned tl = (unsigned)__builtin_amdgcn_readlane((int)E.x, j) >> 16;
#pragma unroll
        for (int t = 0; t < TPW; ++t) if (tl == (unsigned)t) { asm volatile("; acc case %0" :: "n"(t));
#pragma unroll
            for (int w = 0; w < 4; ++w) { acc[t][2 * w] = __builtin_amdgcn_cvt_pk_f32_fp8((int)B.vv[j][w], false) * c2 + acc[t][2 * w]; acc[t][2 * w + 1] = __builtin_amdgcn_cvt_pk_f32_fp8((int)B.vv[j][w], true) * c2 + acc[t][2 * w + 1]; }
            asm volatile("; acc case %0 end" :: "n"(t));
        }
    }
}
template <int TPW> DI void peer_gather_sweep3(Frame& F, const Args& A, const int* IDX, const float* GATE, size_t tok0) {
    const int lane = F.lane, wid = F.wave;
    const unsigned char* U8 = F.ws + WS_U8; const unsigned char* V8 = F.ws + WS_V8; const unsigned char* X8 = F.ws + WS_X8;
    const float* SU = (const float*)(F.ws + WS_SU); const float* SX = (const float*)(F.ws + WS_SX);
    LAS unsigned char* list = F.lds + GL3_LIST + wid * (TPW * 2048); LAS unsigned char* xl = F.lds + GL3_X + wid * (TPW * 1024);
    {
        int idlo[TPW], idhi[TPW]; float glo[TPW], ghi[TPW], slo[TPW], shi[TPW];
#pragma unroll
        for (int tl = 0; tl < TPW; ++tl) { const size_t t = tok0 + tl;
            *(LAS v4u*)(xl + tl * 1024 + 16 * lane) = *(const GAS v4u*)(X8 + t * 1024 + 16 * lane);
            idlo[tl] = IDX[t * 128 + lane]; idhi[tl] = IDX[t * 128 + 64 + lane]; const float sx = SX[t];
            glo[tl] = GATE[t * 128 + lane] * (1.f / 64.f); ghi[tl] = GATE[t * 128 + 64 + lane] * (1.f / 64.f);
            slo[tl] = SU[idlo[tl]] * sx; shi[tl] = SU[idhi[tl]] * sx; }
        int base = 0;
        for (int s = 0; s < 32; ++s) {
#pragma unroll
            for (int tl = 0; tl < TPW; ++tl) {
                { const bool m = (idlo[tl] >> 9) == s; const unsigned long long mk = __ballot(m); const int pos = base + (int)__builtin_amdgcn_mbcnt_hi((unsigned)(mk >> 32), __builtin_amdgcn_mbcnt_lo((unsigned)mk, 0u));
                  if (m) *(LAS v4u*)(list + pos * 16) = (v4u){(unsigned)idlo[tl] | ((unsigned)tl << 16), __float_as_uint(glo[tl]), __float_as_uint(slo[tl]), 0u};
                  base += __builtin_popcountll(mk); }
                { const bool m = (idhi[tl] >> 9) == s; const unsigned long long mk = __ballot(m); const int pos = base + (int)__builtin_amdgcn_mbcnt_hi((unsigned)(mk >> 32), __builtin_amdgcn_mbcnt_lo((unsigned)mk, 0u));
                  if (m) *(LAS v4u*)(list + pos * 16) = (v4u){(unsigned)idhi[tl] | ((unsigned)tl << 16), __float_as_uint(ghi[tl]), __float_as_uint(shi[tl]), 0u};
                  base += __builtin_popcountll(mk); }
            }
        }
    }
    LDS_WAIT(); asm volatile("" ::: "memory");
    f32x2 acc[TPW][8];
#pragma unroll
    for (int tl = 0; tl < TPW; ++tl)
#pragma unroll
        for (int i = 0; i < 8; ++i) acc[tl][i] = (f32x2){0.f, 0.f};
    constexpr int NB = TPW * 32;
    G3Buf BA, BB; v4u EA, EB;
    g3_issue<TPW>(BA, EA, list, xl, U8, V8, 0, lane);
    for (int b = 0; b < NB; b += 2) {
        g3_issue<TPW>(BB, EB, list, xl, U8, V8, b + 1, lane);
        g3_compute<TPW>(acc, BA, EA, lane);
        g3_issue<TPW>(BA, EA, list, xl, U8, V8, (b + 2 < NB) ? b + 2 : NB - 1, lane);
        g3_compute<TPW>(acc, BB, EB, lane);
    }
#pragma unroll
    for (int tl = 0; tl < TPW; ++tl) {
        float* hp = F.out + (tok0 + tl) * 1024 + 16 * lane;
        f32x4 y[4]; float ssq = 0.f;
#pragma unroll
        for (int i = 0; i < 4; ++i) { y[i] = *(const GAS f32x4*)(hp + 4 * i); y[i].x += acc[tl][2 * i].x; y[i].y += acc[tl][2 * i].y; y[i].z += acc[tl][2 * i + 1].x; y[i].w += acc[tl][2 * i + 1].y;
            ssq += (y[i].x * y[i].x + y[i].y * y[i].y) + (y[i].z * y[i].z + y[i].w * y[i].w); }
        const float rs = 1.f / sqrtf(wave_sum(ssq) * (1.f / 1024.f) + EPS);
#pragma unroll
        for (int i = 0; i < 4; ++i) { const f32x4 gv = *(const GAS f32x4*)(A.in[20] + 16 * lane + 4 * i); *(GAS f32x4*)(hp + 4 * i) = y[i] * rs * gv; }
    }
    LDS_WAIT(); asm volatile("" ::: "memory");
}
constexpr int G5_NSH = 16, G5_SHIFT = 10;
struct G5Buf { v4u uu[4], vv[4]; };
DI void g5_issue(G5Buf& B, v4u& E, const LAS unsigned char* tlist, const unsigned char* U8, const unsigned char* V8, int k, int lane) {
    E = *(const LAS v4u*)(tlist + (4 * k + (lane & 3)) * 16);
#pragma unroll
    for (int j = 0; j < 4; ++j) {
        const unsigned id = (unsigned)__builtin_amdgcn_readlane((int)E.x, j);
        B.uu[j] = *(const GAS v4u*)(U8 + (size_t)id * 1024 + 16 * lane); B.vv[j] = *(const GAS v4u*)(V8 + (size_t)id * 1024 + 16 * lane);
    }
}
DI void g5_compute(f32x2 (&acc)[8], const v4u& xx, const G5Buf& B, const v4u& E, int lane) {
    int p[4];
#pragma unroll
    for (int j = 0; j < 4; ++j) { int d = __builtin_amdgcn_sdot4((int)B.uu[j].x, (int)xx.x, 0, false); d = __builtin_amdgcn_sdot4((int)B.uu[j].y, (int)xx.y, d, false);
        d = __builtin_amdgcn_sdot4((int)B.uu[j].z, (int)xx.z, d, false); p[j] = __builtin_amdgcn_sdot4((int)B.uu[j].w, (int)xx.w, d, false); }
    const bool b0 = lane & 1, b1 = lane & 2;
    const int kA = b0 ? p[1] : p[0], sA = b0 ? p[0] : p[1], kB = b0 ? p[3] : p[2], sB = b0 ? p[2] : p[3];
    const int qA = kA + dpp_i<0xB1>(sA), qB = kB + dpp_i<0xB1>(sB);
    const int kk = b1 ? qB : qA, ss = b1 ? qA : qB;
    int r = kk + dpp_i<0x4E>(ss);
    r += dpp_i<0x124>(r); r += dpp_i<0x128>(r);
    r += __shfl_xor(r, 16); r += __shfl_xor(r, 32);
    const float a = (float)r * __uint_as_float(E.z);
    const float y = 0.7978845608028654f * (a + 0.044715f * a * a * a);
    const float th = 1.f - 2.f * __builtin_amdgcn_rcpf(1.f + __expf(2.f * y));
    const float cfl = __uint_as_float(E.y) * 0.5f * a * (1.f + th);
#pragma unroll
    for (int j = 0; j < 4; ++j) { const float cf = __uint_as_float(__builtin_amdgcn_readlane(__float_as_uint(cfl), j)); const f32x2 c2 = {cf, cf};
#pragma unroll
        for (int w = 0; w < 4; ++w) { acc[2 * w] = __builtin_amdgcn_cvt_pk_f32_fp8((int)B.vv[j][w], false) * c2 + acc[2 * w]; acc[2 * w + 1] = __builtin_amdgcn_cvt_pk_f32_fp8((int)B.vv[j][w], true) * c2 + acc[2 * w + 1]; } }
}
DI void peer_gather_sweep5(Frame& F, const Args& A, const int* IDX, const float* GATE, size_t tok0) {
    constexpr int TPW = 4;
    const int lane = F.lane, wid = F.wave;
    const unsigned char* U8 = F.ws + WS_U8; const unsigned char* V8 = F.ws + WS_V8; const unsigned char* X8 = F.ws + WS_X8;
    const float* SU = (const float*)(F.ws + WS_SU); const float* SX = (const float*)(F.ws + WS_SX);
    LAS unsigned char* list = F.lds + wid * (TPW * 2048);
    v4u xq[TPW];
#pragma unroll
    for (int tl = 0; tl < TPW; ++tl) {
        const size_t t = tok0 + tl;
        xq[tl] = *(const GAS v4u*)(X8 + t * 1024 + 16 * lane);
        const int idlo = IDX[t * 128 + lane], idhi = IDX[t * 128 + 64 + lane]; const float sx = SX[t];
        const float glo = GATE[t * 128 + lane] * (1.f / 64.f), ghi = GATE[t * 128 + 64 + lane] * (1.f / 64.f);
        const float slo = SU[idlo] * sx, shi = SU[idhi] * sx;
        LAS unsigned char* tl_list = list + tl * 2048;
        int base = 0;
        for (int s = 0; s < G5_NSH; ++s) {
            { const bool m = (idlo >> G5_SHIFT) == s; const unsigned long long mk = __ballot(m); const int pos = base + (int)__builtin_amdgcn_mbcnt_hi((unsigned)(mk >> 32), __builtin_amdgcn_mbcnt_lo((unsigned)mk, 0u));
              if (m) *(LAS v4u*)(tl_list + pos * 16) = (v4u){(unsigned)idlo, __float_as_uint(glo), __float_as_uint(slo), 0u};
              base += __builtin_popcountll(mk); }
            { const bool m = (idhi >> G5_SHIFT) == s; const unsigned long long mk = __ballot(m); const int pos = base + (int)__builtin_amdgcn_mbcnt_hi((unsigned)(mk >> 32), __builtin_amdgcn_mbcnt_lo((unsigned)mk, 0u));
              if (m) *(LAS v4u*)(tl_list + pos * 16) = (v4u){(unsigned)idhi, __float_as_uint(ghi), __float_as_uint(shi), 0u};
              base += __builtin_popcountll(mk); }
        }
    }
    LDS_WAIT(); asm volatile("" ::: "memory");
    f32x2 acc[TPW][8];
#pragma unroll
    for (int tl = 0; tl < TPW; ++tl)
#pragma unroll
        for (int i = 0; i < 8; ++i) acc[tl][i] = (f32x2){0.f, 0.f};
    G5Buf BA, BB; v4u EA, EB;
    g5_issue(BA, EA, list, U8, V8, 0, lane);
    for (int k = 0; k < 32; ++k) {
        g5_issue(BB, EB, list + 2048, U8, V8, k, lane);      g5_compute(acc[0], xq[0], BA, EA, lane);
        g5_issue(BA, EA, list + 4096, U8, V8, k, lane);      g5_compute(acc[1], xq[1], BB, EB, lane);
        g5_issue(BB, EB, list + 6144, U8, V8, k, lane);      g5_compute(acc[2], xq[2], BA, EA, lane);
        g5_issue(BA, EA, list, U8, V8, k < 31 ? k + 1 : 31, lane);   g5_compute(acc[3], xq[3], BB, EB, lane);
    }
#pragma unroll
    for (int tl = 0; tl < TPW; ++tl) {
        float* hp = F.out + (tok0 + tl) * 1024 + 16 * lane;
        f32x4 y[4]; float ssq = 0.f;
#pragma unroll
        for (int i = 0; i < 4; ++i) { y[i] = *(const GAS f32x4*)(hp + 4 * i); y[i].x += acc[tl][2 * i].x; y[i].y += acc[tl][2 * i].y; y[i].z += acc[tl][2 * i + 1].x; y[i].w += acc[tl][2 * i + 1].y;
            ssq += (y[i].x * y[i].x + y[i].y * y[i].y) + (y[i].z * y[i].z + y[i].w * y[i].w); }
        const float rs = 1.f / sqrtf(wave_sum(ssq) * (1.f / 1024.f) + EPS);
#pragma unroll
        for (int i = 0; i < 4; ++i) { const f32x4 gv = *(const GAS f32x4*)(A.in[20] + 16 * lane + 4 * i); *(GAS f32x4*)(hp + 4 * i) = y[i] * rs * gv; }
    }
    LDS_WAIT(); asm volatile("" ::: "memory");
}
constexpr int G6_NSH = 16, G6_SHIFT = 10, G6_TPW = 8;
DI void g6_issue(v4u (&R)[4], v4u& E, const LAS unsigned char* tlist, const unsigned char* TAB, int k, int lane) {
    E = *(const LAS v4u*)(tlist + (4 * k + (lane & 3)) * 16);
#pragma unroll
    for (int j = 0; j < 4; ++j) { const unsigned id = (unsigned)__builtin_amdgcn_readlane((int)E.x, j); R[j] = *(const GAS v4u*)(TAB + (size_t)id * 1024 + 16 * lane); }
}
DI void g6_dot(const v4u& xx, const v4u (&U)[4], const v4u& E, LAS unsigned char* tlist, int k, int lane) {
    int p[4];
#pragma unroll
    for (int j = 0; j < 4; ++j) { int d = __builtin_amdgcn_sdot4((int)U[j].x, (int)xx.x, 0, false); d = __builtin_amdgcn_sdot4((int)U[j].y, (int)xx.y, d, false);
        d = __builtin_amdgcn_sdot4((int)U[j].z, (int)xx.z, d, false); p[j] = __builtin_amdgcn_sdot4((int)U[j].w, (int)xx.w, d, false); }
    const bool b0 = lane & 1, b1 = lane & 2;
    const int kA = b0 ? p[1] : p[0], sA = b0 ? p[0] : p[1], kB = b0 ? p[3] : p[2], sB = b0 ? p[2] : p[3];
    const int qA = kA + dpp_i<0xB1>(sA), qB = kB + dpp_i<0xB1>(sB);
    const int kk = b1 ? qB : qA, ss = b1 ? qA : qB;
    int r = kk + dpp_i<0x4E>(ss);
    r += dpp_i<0x124>(r); r += dpp_i<0x128>(r);
    r += __shfl_xor(r, 16); r += __shfl_xor(r, 32);
    const float a = (float)r * __uint_as_float(E.z);
    const float y = 0.7978845608028654f * (a + 0.044715f * a * a * a);
    const float th = 1.f - 2.f * __builtin_amdgcn_rcpf(1.f + __expf(2.f * y));
    const float cfl = __uint_as_float(E.y) * __uint_as_float(E.w) * 0.5f * a * (1.f + th);
    if (lane < 4) *(LAS float*)(tlist + (4 * k + lane) * 16 + 4) = cfl;
}
typedef _Float16 h2_t __attribute__((ext_vector_type(2)));
typedef _Float16 h32_t __attribute__((ext_vector_type(32)));
DI void g6_issue_v(u32x3v (&R)[4], v4u& E, const LAS unsigned char* tlist, const unsigned char* TAB, int k, int lane) {
    E = *(const LAS v4u*)(tlist + (4 * k + (lane & 3)) * 16);
#pragma unroll
    for (int j = 0; j < 4; ++j) { const unsigned id = (unsigned)__builtin_amdgcn_readlane((int)E.x, j); R[j] = *(const GAS u32x3v*)(TAB + (size_t)id * 768 + 12 * lane); }
}
DI void g6_fma(h2_t (&acc)[8], const u32x3v (&V)[4], const v4u& E, int lane) {
#pragma unroll
    for (int jp = 0; jp < 2; ++jp) {
        const i32x6v pk = {(int)V[2 * jp][0], (int)V[2 * jp][1], (int)V[2 * jp][2], (int)V[2 * jp + 1][0], (int)V[2 * jp + 1][1], (int)V[2 * jp + 1][2]};
        const h32_t hv = __builtin_bit_cast(h32_t, __builtin_amdgcn_cvt_scalef32_pk32_f16_fp6(pk, 1.0f));
#pragma unroll
        for (int q = 0; q < 2; ++q) { const float cf = __uint_as_float(__builtin_amdgcn_readlane((int)E.y, 2 * jp + q)); const _Float16 ch = (_Float16)cf; const h2_t c2 = {ch, ch};
#pragma unroll
            for (int w = 0; w < 8; ++w) { const h2_t vv = {hv[16 * q + 2 * w], hv[16 * q + 2 * w + 1]}; acc[w] = __builtin_elementwise_fma(vv, c2, acc[w]); } }
    }
}
DI void peer_gather_wave6(Frame& F, const Args& A, const bf16* XN2, const float* SS2, const int* IDX, const float* GATE, size_t tok0) {
    constexpr int TPW = G6_TPW;
    const int lane = F.lane, wid = F.wave;
    const unsigned char* U8 = F.ws + WS_U8; const unsigned char* V8 = F.ws + WS_V8;
    const float* SU = (const float*)(F.ws + WS_SU); const float* SV = (const float*)(F.ws + WS_SV);
    LAS unsigned char* list = F.lds + wid * (TPW * 2048);
    v4u xq[TPW];
#pragma unroll
    for (int tl = 0; tl < TPW; ++tl) {
        const size_t t = tok0 + tl;
        float sx;
        {
            const v4u h0 = *(const GAS v4u*)(XN2 + t * 1024 + 16 * lane), h1 = *(const GAS v4u*)(XN2 + t * 1024 + 16 * lane + 8);
            float xv[16];
#pragma unroll
            for (int i = 0; i < 4; ++i) { xv[2 * i] = bflo(h0[i]); xv[2 * i + 1] = bfhi(h0[i]); xv[8 + 2 * i] = bflo(h1[i]); xv[8 + 2 * i + 1] = bfhi(h1[i]); }
            {
                const f32x4* sp = (const f32x4*)(SS2 + t * 16); const f32x4 a = sp[0], b = sp[1], c = sp[2], d = sp[3];
                const float tt = ((a[0] + a[1]) + (a[2] + a[3])) + ((b[0] + b[1]) + (b[2] + b[3])) + ((c[0] + c[1]) + (c[2] + c[3])) + ((d[0] + d[1]) + (d[2] + d[3]));
                const float rs = 1.0f / sqrtf(tt * (1.0f / 1024.0f) + EPS);
#pragma unroll
                for (int i = 0; i < 4; ++i) { const f32x4 gv = *(const GAS f32x4*)(A.in[15] + 16 * lane + 4 * i); xv[4 * i] *= rs * gv.x; xv[4 * i + 1] *= rs * gv.y; xv[4 * i + 2] *= rs * gv.z; xv[4 * i + 3] *= rs * gv.w; }
            }
            float mx = 0.f;
#pragma unroll
            for (int i = 0; i < 16; ++i) mx = fmaxf(mx, fabsf(xv[i]));
            mx = wave_max(mx); sx = mx > 0.f ? mx * (1.f / 127.f) : 1.f; const float inv = 1.f / sx;
#pragma unroll
            for (int i = 0; i < 4; ++i) { const int a = (int)rintf(xv[4 * i] * inv), b = (int)rintf(xv[4 * i + 1] * inv), c = (int)rintf(xv[4 * i + 2] * inv), d = (int)rintf(xv[4 * i + 3] * inv);
                xq[tl][i] = (unsigned)(a & 255) | ((unsigned)(b & 255) << 8) | ((unsigned)(c & 255) << 16) | ((unsigned)(d & 255) << 24); }
        }
        const int idlo = IDX[t * 128 + lane], idhi = IDX[t * 128 + 64 + lane];
        const float glo = GATE[t * 128 + lane], ghi = GATE[t * 128 + 64 + lane];
        const float slo = SU[idlo] * sx, shi = SU[idhi] * sx, vlo = SV[idlo], vhi = SV[idhi];
        LAS unsigned char* tl_list = list + tl * 2048;
        int base = 0;
        for (int s = 0; s < G6_NSH; ++s) {
            { const bool m = (idlo >> G6_SHIFT) == s; const unsigned long long mk = __ballot(m); const int pos = base + (int)__builtin_amdgcn_mbcnt_hi((unsigned)(mk >> 32), __builtin_amdgcn_mbcnt_lo((unsigned)mk, 0u));
              if (m) *(LAS v4u*)(tl_list + pos * 16) = (v4u){(unsigned)idlo, __float_as_uint(glo), __float_as_uint(slo), __float_as_uint(vlo)};
              base += __builtin_popcountll(mk); }
            { const bool m = (idhi >> G6_SHIFT) == s; const unsigned long long mk = __ballot(m); const int pos = base + (int)__builtin_amdgcn_mbcnt_hi((unsigned)(mk >> 32), __builtin_amdgcn_mbcnt_lo((unsigned)mk, 0u));
              if (m) *(LAS v4u*)(tl_list + pos * 16) = (v4u){(unsigned)idhi, __float_as_uint(ghi), __float_as_uint(shi), __float_as_uint(vhi)};
              base += __builtin_popcountll(mk); }
        }
    }
    LDS_WAIT(); asm volatile("" ::: "memory");
#define G6_SB __builtin_amdgcn_sched_barrier(0)
    {
        v4u RA[4], RB[4]; v4u EA, EB;
        g6_issue(RA, EA, list, U8, 0, lane);
        for (int k = 0; k < 32; ++k) {
#define G6_P1(RI, EI, tn, kn, RC, EC, tc) do { g6_issue(RI, EI, list + (tn) * 2048, U8, kn, lane); G6_SB; g6_dot(xq[tc], RC, EC, list + (tc) * 2048, k, lane); G6_SB; } while (0)
            G6_P1(RB, EB, 1, k, RA, EA, 0); G6_P1(RA, EA, 2, k, RB, EB, 1); G6_P1(RB, EB, 3, k, RA, EA, 2); G6_P1(RA, EA, 4, k, RB, EB, 3);
            G6_P1(RB, EB, 5, k, RA, EA, 4); G6_P1(RA, EA, 6, k, RB, EB, 5); G6_P1(RB, EB, 7, k, RA, EA, 6); G6_P1(RA, EA, 0, (k < 31 ? k + 1 : 31), RB, EB, 7);
#undef G6_P1
        }
    }
    LDS_WAIT(); asm volatile("" ::: "memory");
    h2_t acc[TPW][8];
#pragma unroll
    for (int tl = 0; tl < TPW; ++tl)
#pragma unroll
        for (int i = 0; i < 8; ++i) acc[tl][i] = (h2_t){(_Float16)0.f, (_Float16)0.f};
    {
        u32x3v RA[4], RB[4]; v4u EA, EB;
        g6_issue_v(RA, EA, list, V8, 0, lane);
        for (int k = 0; k < 32; ++k) {
#define G6_P2(RI, EI, tn, kn, RC, EC, tc) do { g6_issue_v(RI, EI, list + (tn) * 2048, V8, kn, lane); G6_SB; g6_fma(acc[tc], RC, EC, lane); G6_SB; } while (0)
            G6_P2(RB, EB, 1, k, RA, EA, 0); G6_P2(RA, EA, 2, k, RB, EB, 1); G6_P2(RB, EB, 3, k, RA, EA, 2); G6_P2(RA, EA, 4, k, RB, EB, 3);
            G6_P2(RB, EB, 5, k, RA, EA, 4); G6_P2(RA, EA, 6, k, RB, EB, 5); G6_P2(RB, EB, 7, k, RA, EA, 6); G6_P2(RA, EA, 0, (k < 31 ? k + 1 : 31), RB, EB, 7);
#undef G6_P2
        }
    }
#undef G6_SB
#pragma unroll
    for (int tl = 0; tl < TPW; ++tl) {
        float* hp = F.out + (tok0 + tl) * 1024 + 16 * lane;
        const v4u r0 = *(const GAS v4u*)(XN2 + (tok0 + tl) * 1024 + 16 * lane), r1 = *(const GAS v4u*)(XN2 + (tok0 + tl) * 1024 + 16 * lane + 8);
        f32x4 y[4]; float ssq = 0.f;
        y[0] = (f32x4){bflo(r0.x), bfhi(r0.x), bflo(r0.y), bfhi(r0.y)}; y[1] = (f32x4){bflo(r0.z), bfhi(r0.z), bflo(r0.w), bfhi(r0.w)};
        y[2] = (f32x4){bflo(r1.x), bfhi(r1.x), bflo(r1.y), bfhi(r1.y)}; y[3] = (f32x4){bflo(r1.z), bfhi(r1.z), bflo(r1.w), bfhi(r1.w)};
#pragma unroll
        for (int i = 0; i < 4; ++i) { y[i].x += (float)acc[tl][2 * i].x; y[i].y += (float)acc[tl][2 * i].y; y[i].z += (float)acc[tl][2 * i + 1].x; y[i].w += (float)acc[tl][2 * i + 1].y;
            ssq += (y[i].x * y[i].x + y[i].y * y[i].y) + (y[i].z * y[i].z + y[i].w * y[i].w); }
        const float rs = 1.f / sqrtf(wave_sum(ssq) * (1.f / 1024.f) + EPS);
#pragma unroll
        for (int i = 0; i < 4; ++i) { const f32x4 gv = *(const GAS f32x4*)(A.in[20] + 16 * lane + 4 * i); *(GAS f32x4*)(hp + 4 * i) = y[i] * rs * gv; }
    }
    LDS_WAIT(); asm volatile("" ::: "memory");
}

constexpr size_t WS_XBUF = 73 * MiB;
constexpr int CW_SEAM = 16384, SEAM_BANK = 8192;
__global__ void __launch_bounds__(NWAVES * 64, 2) fwd_kernel(Args args) {
    extern __shared__ __attribute__((aligned(16))) unsigned char lds[];
    Frame F;
    F.lds = (LAS unsigned char*)lds;
    F.MISC = (volatile LAS unsigned*)(F.lds + MISC_OFF);
    F.tid = threadIdx.x; F.lane = F.tid & 63; F.wave = __builtin_amdgcn_readfirstlane(F.tid >> 6);
    F.G = gridDim.x; { const int bx = blockIdx.x; F.vcu = (F.G % 8 == 0) ? (bx % 8) * (F.G / 8) + bx / 8 : bx; }
    unsigned char* ws = args.ws;
    F.ctl = (gu32*)(ws + WS_CTL);
    F.out = args.out; F.ws = ws;
    for (int u = F.tid; u < (LDS_BYTES - LDSCTL_OFF) / 4; u += NWAVES * 64) ((LAS unsigned*)(F.lds + LDSCTL_OFF))[u] = 0u;
    __syncthreads();
    XcdBarrier bar = xcd_barrier_post((unsigned*)(F.ctl + CW_BAR) + args.li * XCD_BAR_WORDS, F.MISC + 8);
    const int lo = args.ph_lo, hi = args.ph_hi;
#ifndef PH_MASK
#define PH_MASK 0xffff
#endif
#define IN(k) (((PH_MASK >> (k)) & 1) && lo <= (k) && (k) < hi)
#define SEAM(k) do { if (IN(k) && IN((k) + 1)) xcd_barrier(bar); } while (0)
    const int gw = F.vcu * NWAVES + F.wave, NGW = F.G * NWAVES;
#define STW (F.out)
#define OSB (F.out + (size_t)M * 512)
#define IDX ((int*)F_BUFA)
#define GATE ((float*)(F_BUFA) + (size_t)M * 128)

    if (IN(0)) { p0_prologue(F, args); } SEAM(0);
    if (IN(1)) {
        { pg8::Gemm g{F_BUFA, F_W1T, 1024, 1024, 1024}; pg8::StaticOrder S; S.init(M, N1, F.G, (int)blockIdx.x, 1024, 1024);
          pg8::EpiBf16P E{F_PROJ, N1, 1.f};
          pg8::gemm_phase<pg8::EpiBf16P, pg8::StaticOrder, true, true>(F.lds, g, S, E); }
        { pg8::Gemm g{F_MN, F_WXKVT, 1024, 1024, 1024}; const int c = (int)blockIdx.x; pg8::OneUnitOrder S{(c >= 64 && c < 128) ? c - 64 : -1, 8, 1024, 1024};
          pg8::EpiBf16P E{F_KV, 2048, 1.f};
          pg8::gemm_phase<pg8::EpiBf16P, pg8::OneUnitOrder, true, true>(F.lds, g, S, E); }
        if (F.G == 256) { if ((int)blockIdx.x >= 128) { __syncthreads(); p0_late(F, args, ((int)blockIdx.x - 128) * NWAVES + F.wave, 128 * NWAVES); } }
        else { __syncthreads(); p0_late(F, args, gw, NGW); }
    } SEAM(1);
    if (IN(2)) {
        for (int it = F.vcu; it < 256; it += F.G) { const int bh = it >> 2, s = it & 3; sb_unit(F, OSB, bh >> 3, bh & 7, 7 - s); sb_unit(F, OSB, bh >> 3, bh & 7, s); }
        for (int it = F.vcu; it < 1024; it += F.G) { const int bh = it >> 5; gla_local_unit(F, args, STW, bh >> 2, bh & 3, it & 31); }
    } SEAM(2);
    if (IN(3)) { gla_scan(F, STW);
    } SEAM(3);
    if (IN(4)) {
        for (int it = F.vcu; it < 1024; it += F.G) { const int bh = it >> 5; gla_out_unit(F, args, STW, bh >> 2, bh & 3, it & 31); }
        for (int m = gw; m < M; m += NGW) mix_row_sb(F, args, OSB, (size_t)m);
    } SEAM(4);
    if (IN(5)) { pg8::Gemm g{F_BUFA, F_WOT, 1024, 1024, 1024}; pg8::StaticOrder S; S.init(M, 1024, F.G, (int)blockIdx.x, 1024, 1024);
        pg8::EpiResB<false> E{args.in[0], F_SLOT1, (float*)(ws + WS_XBUF), 1024};
        pg8::gemm_phase<pg8::EpiResB<false>, pg8::StaticOrder, true, true>(F.lds, g, S, E); } SEAM(5);
    if (IN(6)) { pg8::Gemm g{F_SLOT1, F_WXQT, 1024, 1024, 1024}; pg8::StaticOrder S; S.init(M, 1024, F.G, (int)blockIdx.x, 1024, 1024);
        pg8::EpiBf16RowScale E{F_SLOT2, 1024, (const float*)(ws + WS_XBUF), EPS};
        pg8::gemm_phase<pg8::EpiBf16RowScale, pg8::StaticOrder, true, true>(F.lds, g, S, E); } SEAM(6);
    if (IN(7)) { for (int it = F.vcu; it < 256; it += F.G) xattn_unit(F, F_SLOT2, F_SLOT0, it >> 5, (it >> 3) & 3, it & 7); } SEAM(7);
    if (IN(8)) { pg8::Gemm g{F_SLOT0, F_WXOT, 1024, 1024, 1024}; pg8::StaticOrder S; S.init(M, 1024, F.G, (int)blockIdx.x, 1024, 1024);
        pg8::EpiResB<true> E{F_SLOT1, F_SLOT2, (float*)(ws + WS_XBUF + MiB), 1024};
        pg8::gemm_phase<pg8::EpiResB<true>, pg8::StaticOrder, true, true>(F.lds, g, S, E); } SEAM(8);
    if (IN(9)) { pg8::Gemm g{F_SLOT2, F_WPQT, 1024, 1024, 1024}; pg8::StaticOrder S; S.init(M, 2048, F.G, (int)blockIdx.x, 1024, 1024);
        pg8::EpiBf16RowScale E{F_SLOT0, 2048, (const float*)(ws + WS_XBUF + MiB), EPS};
        pg8::gemm_phase<pg8::EpiBf16RowScale, pg8::StaticOrder, true, true>(F.lds, g, S, E); } SEAM(9);
    if (IN(10)) { peer_topk_mfma2(F, F_SLOT0, IDX, GATE); } SEAM(10);
    if (IN(11)) { peer_gather_wave6(F, args, F_SLOT2, (const float*)(ws + WS_XBUF + MiB), IDX, GATE, (size_t)F.vcu * 64 + F.wave * 8); }
#undef IN
#undef SEAM
}

constexpr int NPHASES = 12;
extern "C" void kernel_launch(void* const* d_in, const int* in_sizes, int n_in, void* d_out, int out_size, void* d_ws, size_t ws_size, hipStream_t stream) {
    static int grid = 0;
    if (grid == 0) {
        if (n_in != 21 || out_size != M * DM || ws_size < WS_END) { fprintf(stderr, "kernel_launch: unexpected shapes (n_in %d out %d ws %zu)\n", n_in, out_size, ws_size); grid = -1; return; }
        int dev = 0, cus = 0, per_cu = 0;
        if (hipGetDevice(&dev) != hipSuccess || hipDeviceGetAttribute(&cus, hipDeviceAttributeMultiprocessorCount, dev) != hipSuccess) { grid = -1; return; }
        if (hipFuncSetAttribute((const void*)fwd_kernel, hipFuncAttributeMaxDynamicSharedMemorySize, LDS_BYTES) != hipSuccess) { fprintf(stderr, "kernel_launch: hipFuncSetAttribute failed\n"); grid = -1; return; }
        if (hipOccupancyMaxActiveBlocksPerMultiprocessor(&per_cu, (const void*)fwd_kernel, NWAVES * 64, LDS_BYTES) != hipSuccess || per_cu < 1) { fprintf(stderr, "kernel_launch: occupancy query says %d\n", per_cu); }
        (void)hipGetLastError();
        grid = cus;
    }
    if (grid < 0) return;
    (void)hipMemsetAsync((char*)d_ws + WS_CTL, 0, CTL_ZERO_BYTES, stream);
    Args a{};
    for (int i = 0; i < 21; ++i) a.in[i] = (const float*)d_in[i];
    a.out = (float*)d_out; a.ws = (unsigned char*)d_ws;
#if defined(PROF_DUP_LO)
    a.ph_lo = 0; a.ph_hi = PROF_DUP_HI + 1; a.li = 0; hipLaunchKernelGGL(fwd_kernel, dim3(grid), dim3(NWAVES * 64), LDS_BYTES, stream, a);
    a.ph_lo = PROF_DUP_LO; a.ph_hi = NPHASES; a.li = 1; hipLaunchKernelGGL(fwd_kernel, dim3(grid), dim3(NWAVES * 64), LDS_BYTES, stream, a);
#elif defined(PROF_SPLIT)
    a.ph_lo = 0; a.ph_hi = PROF_SPLIT; a.li = 0; hipLaunchKernelGGL(fwd_kernel, dim3(grid), dim3(NWAVES * 64), LDS_BYTES, stream, a);
    a.ph_lo = PROF_SPLIT; a.ph_hi = NPHASES; a.li = 1; hipLaunchKernelGGL(fwd_kernel, dim3(grid), dim3(NWAVES * 64), LDS_BYTES, stream, a);
#else
    a.ph_lo = 0; a.ph_hi = NPHASES; a.li = 0;
    hipLaunchKernelGGL(fwd_kernel, dim3(grid), dim3(NWAVES * 64), LDS_BYTES, stream, a);
#endif
}
```

```cpp
#include <hip/hip_runtime.h>
#include <cstdio>
#include <cstdint>
namespace pg8 {
#define PG8_LAS __attribute__((address_space(3)))
typedef unsigned short bf16_t;
typedef short bf16x8 __attribute__((ext_vector_type(8)));
typedef float f32x4 __attribute__((ext_vector_type(4)));
typedef unsigned u32x4 __attribute__((ext_vector_type(4)));
constexpr int BM = 256, BK = 64, HALF = 128, HTB = HALF * BK * 2  , STAGE_BYTES = 8 * HTB, NXCD = 8, WGM = 8;

__host__ __device__ __forceinline__ int lds_byte(int r, int c) { const int st = (r >> 4) * 2 + (c >> 5), rr = r & 15, cc = c & 31, ob = rr * 64 + cc * 2; return st * 1024 + (ob ^ (((ob >> 9) & 1) << 5)); }
__host__ __device__ __forceinline__ void stage_rc(int b, int& R, int& C) { const int st = b / 1024, sb = b % 1024, swz = sb ^ (((sb >> 9) & 1) << 5); R = (st >> 1) * 16 + swz / 64; C = (st & 1) * 32 + (swz % 64) / 2; }
__host__ __device__ __forceinline__ int perm32(int rho) { const int n = rho >> 4, i = rho & 15; return 8 * (i >> 2) + 4 * n + (i & 3); }

struct Unit { int pm, pn; size_t aoff, boff; };
struct Gemm { const bf16_t* A; const bf16_t* Bt; int K, lda, ldb; };

struct StaticOrder {
    int nM, nN, nwg, G, c, lda, ldb;
    __host__ __device__ void init(int M, int N, int G_, int c_, int lda_, int ldb_) { nM = M / BM; nN = N / BM; nwg = nM * nN; G = G_; c = c_; lda = lda_; ldb = ldb_; }
    __host__ __device__ bool next(int i, Unit& u) const {
        const long L = (long)i * G + c; if (L >= nwg) return false;
        int wgid = (int)L; { const int q = nwg / NXCD, r = nwg % NXCD, xcd = wgid % NXCD, off = wgid / NXCD; wgid = (xcd < r ? xcd * (q + 1) : r * (q + 1) + (xcd - r) * q) + off; }
        const int nig = WGM * nN, gid = wgid / nig, fm = gid * WGM, gsz = (nM - fm) < WGM ? (nM - fm) : WGM;
        u.pm = fm + ((wgid % nig) % gsz); u.pn = (wgid % nig) / gsz; u.aoff = (size_t)u.pm * BM * lda * 2; u.boff = (size_t)u.pn * BM * ldb * 2; return true;
    }
    __device__ __forceinline__ void a_ready(const Unit&) const {}
    __device__ __forceinline__ void done(const Unit&) const {}
};

__device__ __forceinline__ unsigned cvt_pk_bf16(float lo, float hi) { unsigned r; asm volatile("v_cvt_pk_bf16_f32 %0, %1, %2" : "=v"(r) : "v"(lo), "v"(hi)); return r; }
typedef float f32x2 __attribute__((ext_vector_type(2)));
__device__ __forceinline__ f32x2 gelu_pk(f32x2 v) {
    const f32x2 av = __builtin_elementwise_abs(v), d = av * 0.2316418882f + 1.0f;
    f32x2 t; t.x = __builtin_amdgcn_rcpf(d.x); t.y = __builtin_amdgcn_rcpf(d.y);
    f32x2 q = t * 0.5307027145f + (-0.7265760135f); q = q * t + 0.7107068705f; q = q * t + (-0.142248368f); q = q * t + 0.127414796f; q = q * t;
    const f32x2 s = (v * v) * (-0.72134752044f);
    f32x2 e; e.x = __builtin_amdgcn_exp2f(s.x); e.y = __builtin_amdgcn_exp2f(s.y);
    const f32x2 m = v * (q * e), r = v - m;
    f32x2 o; o.x = v.x < 0.f ? m.x : r.x; o.y = v.y < 0.f ? m.y : r.y; return o;
}

template <int ACT  > struct EpiBf16 {
    static constexpr bool PERM = true, AFTER_DRAIN = false; static_assert(ACT == 0 || ACT == 1, "EpiBf16: ACT is 0 (none) or 1 (gelu_pk)");
    bf16_t* O; int ldc; const float* bias; int split_cols; size_t split_stride; float scale0;
    __device__ __forceinline__ void operator()(const f32x4 (&acc)[2][2][4][2], const Unit& u, int wr, int wc, int fr, int fq) const {
        const int row0 = u.pm * BM + wr * 64 + fr; int colt = u.pn * BM; bf16_t* base = O;
        float sc = 1.f; if (split_cols) { const int t = colt / split_cols; base += (size_t)t * split_stride; colt -= t * split_cols; if (t == 0) sc = scale0; }
        const int col0 = colt + wc * 32 + 8 * fq, bcol0 = u.pn * BM + wc * 32 + 8 * fq;
        f32x4 bv[2][2];
#pragma unroll
        for (int bj = 0; bj < 2; ++bj)
#pragma unroll
            for (int n = 0; n < 2; ++n) bv[bj][n] = bias ? *(const f32x4*)(bias + bcol0 + bj * HALF + 4 * n) : (f32x4){0.f, 0.f, 0.f, 0.f};
#pragma unroll
        for (int ai = 0; ai < 2; ++ai)
#pragma unroll
            for (int m = 0; m < 4; ++m) { bf16_t* rowp = base + (size_t)(row0 + ai * HALF + m * 16) * ldc + col0;
#pragma unroll
                for (int bj = 0; bj < 2; ++bj) { f32x4 v0 = acc[ai][bj][m][0] + bv[bj][0], v1 = acc[ai][bj][m][1] + bv[bj][1];
                    if (ACT == 1) { f32x2 a = gelu_pk((f32x2){v0[0], v0[1]}), b = gelu_pk((f32x2){v0[2], v0[3]}), c = gelu_pk((f32x2){v1[0], v1[1]}), d = gelu_pk((f32x2){v1[2], v1[3]});
                        v0 = (f32x4){a.x, a.y, b.x, b.y}; v1 = (f32x4){c.x, c.y, d.x, d.y}; }
                    v0 = v0 * sc; v1 = v1 * sc; u32x4 w; w.x = cvt_pk_bf16(v0[0], v0[1]); w.y = cvt_pk_bf16(v0[2], v0[3]); w.z = cvt_pk_bf16(v1[0], v1[1]); w.w = cvt_pk_bf16(v1[2], v1[3]);
                    *(u32x4*)(rowp + bj * HALF) = w; } }
    }
};
template <class Epi, class Sched, bool ALIGN_EPI = false, bool SP2 = false>
__device__ __forceinline__ void gemm_phase(PG8_LAS unsigned char* lds, const Gemm g, const Sched& S, const Epi& E) {
    const int tid = threadIdx.x, wid = __builtin_amdgcn_readfirstlane(tid >> 6), lane = tid & 63, wr = wid >> 2, wc = wid & 3, fr = lane & 15, fq = lane >> 4;
    int K = g.K; asm volatile("" : "+s"(K));
    const int nt = K / BK;
    unsigned voffA[2], voffB[2];
#pragma unroll
    for (int i = 0; i < 2; ++i) { int R, C; stage_rc(tid * 16 + i * 8192, R, C); const int Rb = Epi::PERM ? ((R & ~31) + perm32(R & 31)) : R;
        voffA[i] = (unsigned)(R * g.lda + C) * 2u; voffB[i] = (unsigned)(Rb * g.ldb + C) * 2u; }
    const size_t kstep = (size_t)(BK * 2);
    const size_t hA = (size_t)HALF * g.lda * 2, hB = (size_t)HALF * g.ldb * 2;
    const unsigned ldsw = (unsigned)wid * 1024u;
    const int aoff = lds_byte(wr * 64 + fr, fq * 8), boff = lds_byte(wc * 32 + fr, fq * 8);
#define PG8_SA(b, h) (((b) * 2 + (h)) * HTB)
#define PG8_SB(b, h) ((4 + (b) * 2 + (h)) * HTB)
#define PG8_STAGE(bufoff, gbase, voff) do { _Pragma("unroll") for (int _i = 0; _i < 2; ++_i) \
        __builtin_amdgcn_global_load_lds((const unsigned*)((const char*)(gbase) + (voff)[_i]), (PG8_LAS unsigned*)(lds + (bufoff) + ldsw + _i * 8192), 16, 0, 0); } while (0)
#define PG8_LDA(dst, b, h) do { _Pragma("unroll") for (int m = 0; m < 4; ++m) _Pragma("unroll") for (int k = 0; k < 2; ++k) dst[m][k] = *(const PG8_LAS bf16x8*)(lds + PG8_SA(b, h) + aoff + m * 2048 + k * 1024); } while (0)
#define PG8_LDB(dst, b, h) do { _Pragma("unroll") for (int n = 0; n < 2; ++n) _Pragma("unroll") for (int k = 0; k < 2; ++k) dst[n][k] = *(const PG8_LAS bf16x8*)(lds + PG8_SB(b, h) + boff + n * 2048 + k * 1024); } while (0)
#define PG8_MMA(ai, bj, At, Bt) do { __builtin_amdgcn_s_setprio(1); _Pragma("unroll") for (int m = 0; m < 4; ++m) _Pragma("unroll") for (int n = 0; n < 2; ++n) _Pragma("unroll") for (int k = 0; k < 2; ++k) \
        acc[ai][bj][m][n] = __builtin_amdgcn_mfma_f32_16x16x32_bf16(Bt[n][k], At[m][k], acc[ai][bj][m][n], 0, 0, 0); __builtin_amdgcn_s_setprio(0); } while (0)
#define PG8_WAIT_V(n) asm volatile("s_waitcnt vmcnt(" #n ")" ::: "memory")
#define PG8_WAIT_L(n) asm volatile("s_waitcnt lgkmcnt(" #n ")" ::: "memory")
#define PG8_BAR __builtin_amdgcn_s_barrier()
#define PG8_SCHED __builtin_amdgcn_sched_barrier(0)
    Unit cur, nxt; int ui = 0;
    if (!S.next(0, cur)) return;
    f32x4 acc[2][2][4][2];
#pragma unroll
    for (int a = 0; a < 2; ++a)
#pragma unroll
        for (int b = 0; b < 2; ++b)
#pragma unroll
            for (int m = 0; m < 4; ++m)
#pragma unroll
                for (int n = 0; n < 2; ++n) acc[a][b][m][n] = (f32x4){0.f, 0.f, 0.f, 0.f};
    bf16x8 At[4][2], B0[2][2], B1[2][2];
    const char* cA = (const char*)g.A + cur.aoff; const char* cB = (const char*)g.Bt + cur.boff;
    S.a_ready(cur);
    if constexpr (SP2) {
        PG8_STAGE(PG8_SB(0, 0), cB, voffB); PG8_STAGE(PG8_SB(0, 1), cB + hB, voffB); PG8_STAGE(PG8_SA(0, 0), cA, voffA); PG8_STAGE(PG8_SA(0, 1), cA + hA, voffA);
        if (wr == 1) PG8_BAR;
        PG8_WAIT_V(2); PG8_BAR;
        PG8_STAGE(PG8_SB(1, 0), cB + kstep, voffB); PG8_STAGE(PG8_SA(1, 0), cA + kstep, voffA); PG8_STAGE(PG8_SB(1, 1), cB + hB + kstep, voffB);
        PG8_WAIT_V(6); PG8_BAR;
    } else {
        PG8_STAGE(PG8_SB(0, 0), cB, voffB); PG8_STAGE(PG8_SA(0, 0), cA, voffA); PG8_STAGE(PG8_SB(0, 1), cB + hB, voffB); PG8_STAGE(PG8_SA(0, 1), cA + hA, voffA);
        if (wr == 1) PG8_BAR;
        PG8_WAIT_V(4); PG8_BAR;
        PG8_STAGE(PG8_SB(1, 0), cB + kstep, voffB); PG8_STAGE(PG8_SA(1, 0), cA + kstep, voffA); PG8_STAGE(PG8_SB(1, 1), cB + hB + kstep, voffB);
        PG8_WAIT_V(6); PG8_BAR;
    }
    for (;;) {
        const bool has_next = S.next(ui + 1, nxt);
        const char* nA = has_next ? (const char*)g.A + nxt.aoff : cA; const char* nB = has_next ? (const char*)g.Bt + nxt.boff : cB;
        for (int t = 0; t < nt; t += 2) {
            const bool last = (t == nt - 2);
            const char* a1 = cA + (size_t)(t + 1) * kstep;
            const char* a2 = last ? nA : cA + (size_t)(t + 2) * kstep; const char* b2 = last ? nB : cB + (size_t)(t + 2) * kstep;
            const char* a3 = a2 + kstep; const char* b3 = b2 + kstep;
            if (last && has_next) S.a_ready(nxt);
            if constexpr (SP2) {
            PG8_LDB(B0, 0, 0); PG8_LDB(B1, 0, 1); PG8_SCHED; PG8_LDA(At, 0, 0); PG8_STAGE(PG8_SA(1, 1), a1 + hA, voffA);
            PG8_WAIT_V(8); PG8_WAIT_L(0); PG8_BAR; PG8_MMA(0, 0, At, B0); PG8_MMA(0, 1, At, B1); PG8_BAR; PG8_SCHED;
            PG8_LDA(At, 0, 1); PG8_STAGE(PG8_SB(0, 0), b2, voffB); PG8_STAGE(PG8_SB(0, 1), b2 + hB, voffB); PG8_STAGE(PG8_SA(0, 0), a2, voffA);
            PG8_WAIT_V(8); PG8_WAIT_L(0); PG8_BAR; PG8_MMA(1, 0, At, B0); PG8_MMA(1, 1, At, B1); PG8_BAR; PG8_SCHED;
            PG8_LDB(B0, 1, 0); PG8_LDB(B1, 1, 1); PG8_SCHED; PG8_LDA(At, 1, 0); PG8_STAGE(PG8_SA(0, 1), a2 + hA, voffA);
            PG8_WAIT_V(8); PG8_WAIT_L(0); PG8_BAR; PG8_MMA(0, 0, At, B0); PG8_MMA(0, 1, At, B1); PG8_BAR; PG8_SCHED;
            PG8_LDA(At, 1, 1); PG8_STAGE(PG8_SB(1, 0), b3, voffB); PG8_STAGE(PG8_SB(1, 1), b3 + hB, voffB); PG8_STAGE(PG8_SA(1, 0), a3, voffA);
            PG8_WAIT_V(8); PG8_WAIT_L(0); PG8_BAR; PG8_MMA(1, 0, At, B0); PG8_MMA(1, 1, At, B1); PG8_BAR; PG8_SCHED;
            } else {
            PG8_LDB(B0, 0, 0); PG8_SCHED; PG8_LDA(At, 0, 0); PG8_STAGE(PG8_SA(1, 1), a1 + hA, voffA);
            PG8_WAIT_L(8); PG8_BAR; PG8_WAIT_L(0); PG8_MMA(0, 0, At, B0); PG8_BAR; PG8_SCHED;
            PG8_LDB(B1, 0, 1); PG8_STAGE(PG8_SB(0, 0), b2, voffB);
            PG8_BAR; PG8_WAIT_L(0); PG8_MMA(0, 1, At, B1); PG8_BAR;
            PG8_LDA(At, 0, 1); PG8_STAGE(PG8_SA(0, 0), a2, voffA);
            PG8_BAR; PG8_WAIT_L(0); PG8_MMA(1, 0, At, B0); PG8_BAR; PG8_SCHED;
            PG8_STAGE(PG8_SB(0, 1), b2 + hB, voffB);
            PG8_WAIT_V(6); PG8_BAR; PG8_MMA(1, 1, At, B1); PG8_BAR;
            PG8_LDB(B0, 1, 0); PG8_SCHED; PG8_LDA(At, 1, 0); PG8_STAGE(PG8_SA(0, 1), a2 + hA, voffA);
            PG8_WAIT_L(8); PG8_BAR; PG8_WAIT_L(0); PG8_MMA(0, 0, At, B0); PG8_BAR; PG8_SCHED;
            PG8_LDB(B1, 1, 1); PG8_STAGE(PG8_SB(1, 0), b3, voffB);
            PG8_BAR; PG8_WAIT_L(0); PG8_MMA(0, 1, At, B1); PG8_BAR;
            PG8_LDA(At, 1, 1); PG8_STAGE(PG8_SA(1, 0), a3, voffA);
            PG8_BAR; PG8_WAIT_L(0); PG8_MMA(1, 0, At, B0); PG8_BAR; PG8_SCHED;
            PG8_STAGE(PG8_SB(1, 1), b3 + hB, voffB);
            PG8_WAIT_V(6); PG8_BAR; PG8_MMA(1, 1, At, B1); PG8_BAR;
            }
        }
        if constexpr (ALIGN_EPI) { if (wr == 0) PG8_BAR; }
        if constexpr (!Epi::AFTER_DRAIN) { E(acc, cur, wr, wc, fr, fq); S.done(cur); }
        if (!has_next) break;
#pragma unroll
        for (int a = 0; a < 2; ++a)
#pragma unroll
            for (int b = 0; b < 2; ++b)
#pragma unroll
                for (int m = 0; m < 4; ++m)
#pragma unroll
                    for (int n = 0; n < 2; ++n) acc[a][b][m][n] = (f32x4){0.f, 0.f, 0.f, 0.f};
        cur = nxt; cA = nA; cB = nB; ++ui;
        if constexpr (ALIGN_EPI) { if (wr == 1) PG8_BAR; }
    }
    PG8_WAIT_V(0);
    if constexpr (!ALIGN_EPI) { if (wr == 0) PG8_BAR; }
    PG8_BAR;
    if constexpr (Epi::AFTER_DRAIN) { E.fused(acc, cur, wr, wc, fr, fq, lds, wid, lane); S.done(cur); }
#undef PG8_SA
#undef PG8_SB
#undef PG8_STAGE
#undef PG8_LDA
#undef PG8_LDB
#undef PG8_MMA
#undef PG8_WAIT_V
#undef PG8_WAIT_L
#undef PG8_BAR
#undef PG8_SCHED
}
}
namespace pg8 {
struct EpiBf16P {
    static constexpr bool PERM = true, AFTER_DRAIN = false;
    bf16_t* O; int ldc; float sc;
    __device__ __forceinline__ void operator()(const f32x4 (&acc)[2][2][4][2], const Unit& u, int wr, int wc, int fr, int fq) const {
        const int row0 = u.pm * BM + wr * 64 + fr, col0 = u.pn * BM + wc * 32 + 8 * fq;
#pragma unroll
        for (int ai = 0; ai < 2; ++ai)
#pragma unroll
            for (int m = 0; m < 4; ++m) { bf16_t* rowp = O + (size_t)(row0 + ai * HALF + m * 16) * ldc + col0;
#pragma unroll
                for (int bj = 0; bj < 2; ++bj) { const f32x4 v0 = acc[ai][bj][m][0] * sc, v1 = acc[ai][bj][m][1] * sc;
                    u32x4 w; w.x = cvt_pk_bf16(v0[0], v0[1]); w.y = cvt_pk_bf16(v0[2], v0[3]); w.z = cvt_pk_bf16(v1[0], v1[1]); w.w = cvt_pk_bf16(v1[2], v1[3]);
                    *(u32x4*)(rowp + bj * HALF) = w; } }
    }
};
struct EpiF32Res {
    static constexpr bool PERM = false, AFTER_DRAIN = false;
    const float* base; float* out; int ldc;
    __device__ __forceinline__ void operator()(const f32x4 (&acc)[2][2][4][2], const Unit& u, int wr, int wc, int fr, int fq) const {
        const int row0 = u.pm * BM + wr * 64 + fr, col0 = u.pn * BM + wc * 32 + 4 * fq;
#pragma unroll
        for (int ai = 0; ai < 2; ++ai)
#pragma unroll
            for (int m = 0; m < 4; ++m) { const size_t off = (size_t)(row0 + ai * HALF + m * 16) * ldc + col0;
#pragma unroll
                for (int bj = 0; bj < 2; ++bj)
#pragma unroll
                    for (int n = 0; n < 2; ++n) { const f32x4 b = *(const f32x4*)(base + off + bj * HALF + n * 16); *(f32x4*)(out + off + bj * HALF + n * 16) = b + acc[ai][bj][m][n]; } }
    }
};
template <int mode> struct XAttnOrder {
    int G, c;
    __device__ __forceinline__ bool next(int i, Unit& u) const {
        const int L = i * G + c; if (L >= 256) return false;
        u.pm = L >> 2; u.pn = L & 3; const int b = u.pm >> 3;
        u.aoff = ((size_t)u.pm * 256 * 1024 + (size_t)u.pn * 256) * 2;
        u.boff = mode == 0 ? ((size_t)(b * 256) * 2048 + (size_t)u.pn * 256) * 2 : ((size_t)((b * 4 + u.pn) * 256) * 256) * 2;
        return true;
    }
    __device__ __forceinline__ void a_ready(const Unit&) const {}
    __device__ __forceinline__ void done(const Unit&) const {}
};
struct OneUnitOrder {
    int L, nN, lda, ldb;
    __device__ __forceinline__ bool next(int i, Unit& u) const {
        if (i != 0 || L < 0) return false;
        u.pm = L / nN; u.pn = L % nN; u.aoff = (size_t)u.pm * BM * lda * 2; u.boff = (size_t)u.pn * BM * ldb * 2; return true;
    }
    __device__ __forceinline__ void a_ready(const Unit&) const {}
    __device__ __forceinline__ void done(const Unit&) const {}
};
}

namespace pg8 {
struct EpiResRms {
    static constexpr bool PERM = false, AFTER_DRAIN = true;
    const float* base; float* out; bf16_t* hn; const float* g; int ldc; unsigned* xbuf; unsigned* cnt; float eps;
    __device__ __forceinline__ void fused(f32x4 (&acc)[2][2][4][2], const Unit& u, int wr, int wc, int fr, int fq, PG8_LAS unsigned char* lds, int wid, int lane) const {
        PG8_LAS float* P = (PG8_LAS float*)lds;
        PG8_LAS float* S = (PG8_LAS float*)(lds + 8192);
        const int col0 = u.pn * BM + wc * 32 + 4 * fq;
#pragma unroll
        for (int ai = 0; ai < 2; ++ai)
#pragma unroll
            for (int m = 0; m < 4; ++m) { const size_t off = (size_t)(u.pm * BM + ai * HALF + wr * 64 + m * 16 + fr) * ldc + col0; float s = 0.f;
#pragma unroll
                for (int bj = 0; bj < 2; ++bj)
#pragma unroll
                    for (int n = 0; n < 2; ++n) { const f32x4 b = *(const f32x4*)(base + off + bj * HALF + n * 16); f32x4 x = acc[ai][bj][m][n] + b; acc[ai][bj][m][n] = x; s += (x[0] * x[0] + x[1] * x[1]) + (x[2] * x[2] + x[3] * x[3]); }
                s += __shfl_xor(s, 16); s += __shfl_xor(s, 32);
                if (fq == 0) P[(ai * HALF + wr * 64 + m * 16 + fr) * 4 + wc] = s;
                if (m & 1) asm volatile("" ::: "memory"); }
        asm volatile("s_waitcnt lgkmcnt(0)" ::: "memory"); __builtin_amdgcn_s_barrier(); asm volatile("" ::: "memory");
        const int row = wid * 32 + (lane & 31);
        if (lane < 32) { const float t = (P[row * 4 + 0] + P[row * 4 + 1]) + (P[row * 4 + 2] + P[row * 4 + 3]);
            __hip_atomic_store(xbuf + (size_t)(u.pm * BM + row) * 4 + u.pn, __float_as_uint(t), __ATOMIC_RELAXED, __HIP_MEMORY_SCOPE_AGENT); }
        asm volatile("s_waitcnt vmcnt(0)" ::: "memory");
        if (lane == 0) __hip_atomic_fetch_add(cnt + 64 * u.pm, 1u, __ATOMIC_RELAXED, __HIP_MEMORY_SCOPE_AGENT);
        if (wid == 0) {
            const unsigned long long t0 = __builtin_amdgcn_s_memrealtime();
            while ((unsigned)__builtin_amdgcn_readfirstlane(__hip_atomic_load(cnt + 64 * u.pm, __ATOMIC_RELAXED, __HIP_MEMORY_SCOPE_AGENT)) < 32u) {
                if (__builtin_amdgcn_s_memrealtime() - t0 > 2000000ull) break;
                __builtin_amdgcn_s_sleep(2); }
            __builtin_amdgcn_fence(__ATOMIC_ACQUIRE, "agent");
        }
        asm volatile("s_waitcnt vmcnt(0) lgkmcnt(0)" ::: "memory"); __builtin_amdgcn_s_barrier(); asm volatile("" ::: "memory");
        if (lane < 32) { const unsigned* sl = xbuf + (size_t)(u.pm * BM + row) * 4; float t = 0.f;
#pragma unroll
            for (int q = 0; q < 4; ++q) t += __uint_as_float(__hip_atomic_load(sl + q, __ATOMIC_RELAXED, __HIP_MEMORY_SCOPE_AGENT));
            S[row] = 1.0f / sqrtf(t * (1.0f / 1024.0f) + eps); }
        asm volatile("s_waitcnt lgkmcnt(0)" ::: "memory"); __builtin_amdgcn_s_barrier(); asm volatile("" ::: "memory");
        f32x4 gv[2][2];
#pragma unroll
        for (int bj = 0; bj < 2; ++bj)
#pragma unroll
            for (int n = 0; n < 2; ++n) gv[bj][n] = *(const f32x4*)(g + col0 + bj * HALF + n * 16);
#pragma unroll
        for (int ai = 0; ai < 2; ++ai)
#pragma unroll
            for (int m = 0; m < 4; ++m) { const int r = ai * HALF + wr * 64 + m * 16 + fr; const float rs = S[r]; const size_t off = (size_t)(u.pm * BM + r) * ldc + col0;
#pragma unroll
                for (int bj = 0; bj < 2; ++bj)
#pragma unroll
                    for (int n = 0; n < 2; ++n) { const f32x4 x = acc[ai][bj][m][n]; *(f32x4*)(out + off + bj * HALF + n * 16) = x;
                        const f32x4 y = x * rs * gv[bj][n]; typedef unsigned u32x2v __attribute__((ext_vector_type(2))); u32x2v w; w.x = cvt_pk_bf16(y[0], y[1]); w.y = cvt_pk_bf16(y[2], y[3]);
                        *(u32x2v*)(hn + off + bj * HALF + n * 16) = w; }
                asm volatile("" ::: "memory"); }
    }
};
}

namespace pg8 {
struct EpiResSS {
    static constexpr bool PERM = false, AFTER_DRAIN = false;
    const float* base; float* out; bf16_t* hb; float* ss; int ldc;
    __device__ __forceinline__ void operator()(const f32x4 (&acc)[2][2][4][2], const Unit& u, int wr, int wc, int fr, int fq) const {
        const int row0 = u.pm * BM + wr * 64 + fr, col0 = u.pn * BM + wc * 32 + 4 * fq;
#pragma unroll
        for (int ai = 0; ai < 2; ++ai)
#pragma unroll
            for (int m = 0; m < 4; ++m) { const int row = row0 + ai * HALF + m * 16; const size_t off = (size_t)row * ldc + col0; float s = 0.f;
#pragma unroll
                for (int bj = 0; bj < 2; ++bj)
#pragma unroll
                    for (int n = 0; n < 2; ++n) { const f32x4 x = *(const f32x4*)(base + off + bj * HALF + n * 16) + acc[ai][bj][m][n]; *(f32x4*)(out + off + bj * HALF + n * 16) = x;
                        typedef unsigned u32x2v __attribute__((ext_vector_type(2))); u32x2v w; w.x = cvt_pk_bf16(x[0], x[1]); w.y = cvt_pk_bf16(x[2], x[3]); *(u32x2v*)(hb + off + bj * HALF + n * 16) = w;
                        s += (x[0] * x[0] + x[1] * x[1]) + (x[2] * x[2] + x[3] * x[3]); }
                s += __shfl_xor(s, 16); s += __shfl_xor(s, 32);
                if (fq == 0) ss[(size_t)row * 16 + u.pn * 4 + wc] = s; }
    }
};
struct EpiBf16RowScale {
    static constexpr bool PERM = true, AFTER_DRAIN = false;
    bf16_t* O; int ldc; const float* ss; float eps;
    __device__ __forceinline__ void operator()(const f32x4 (&acc)[2][2][4][2], const Unit& u, int wr, int wc, int fr, int fq) const {
        const int row0 = u.pm * BM + wr * 64 + fr, col0 = u.pn * BM + wc * 32 + 8 * fq;
#pragma unroll
        for (int ai = 0; ai < 2; ++ai)
#pragma unroll
            for (int m = 0; m < 4; ++m) { const int row = row0 + ai * HALF + m * 16; const f32x4* sp = (const f32x4*)(ss + (size_t)row * 16);
                const f32x4 a = sp[0], b = sp[1], c = sp[2], d = sp[3];
                const float t = ((a[0] + a[1]) + (a[2] + a[3])) + ((b[0] + b[1]) + (b[2] + b[3])) + ((c[0] + c[1]) + (c[2] + c[3])) + ((d[0] + d[1]) + (d[2] + d[3]));
                const float rs = 1.0f / sqrtf(t * (1.0f / 1024.0f) + eps);
                bf16_t* rowp = O + (size_t)row * ldc + col0;
#pragma unroll
                for (int bj = 0; bj < 2; ++bj) { const f32x4 v0 = acc[ai][bj][m][0] * rs, v1 = acc[ai][bj][m][1] * rs;
                    u32x4 w; w.x = cvt_pk_bf16(v0[0], v0[1]); w.y = cvt_pk_bf16(v0[2], v0[3]); w.z = cvt_pk_bf16(v1[0], v1[1]); w.w = cvt_pk_bf16(v1[2], v1[3]);
                    *(u32x4*)(rowp + bj * HALF) = w; } }
    }
};
}

namespace pg8 {
template <bool BASE_BF16> struct EpiResB {
    static constexpr bool PERM = true, AFTER_DRAIN = false;
    const void* base; bf16_t* hb; float* ss; int ldc;
    __device__ __forceinline__ void operator()(const f32x4 (&acc)[2][2][4][2], const Unit& u, int wr, int wc, int fr, int fq) const {
        const int row0 = u.pm * BM + wr * 64 + fr, col0 = u.pn * BM + wc * 32 + 8 * fq;
#pragma unroll
        for (int ai = 0; ai < 2; ++ai)
#pragma unroll
            for (int m = 0; m < 4; ++m) { const int row = row0 + ai * HALF + m * 16; const size_t off = (size_t)row * ldc + col0; float s = 0.f;
#pragma unroll
                for (int bj = 0; bj < 2; ++bj) { f32x4 b0, b1;
                    if (BASE_BF16) { const u32x4 w = *(const u32x4*)((const bf16_t*)base + off + bj * HALF);
                        b0 = (f32x4){__uint_as_float(w.x << 16), __uint_as_float(w.x & 0xffff0000u), __uint_as_float(w.y << 16), __uint_as_float(w.y & 0xffff0000u)};
                        b1 = (f32x4){__uint_as_float(w.z << 16), __uint_as_float(w.z & 0xffff0000u), __uint_as_float(w.w << 16), __uint_as_float(w.w & 0xffff0000u)}; }
                    else { b0 = *(const f32x4*)((const float*)base + off + bj * HALF); b1 = *(const f32x4*)((const float*)base + off + bj * HALF + 4); }
                    const f32x4 x0 = b0 + acc[ai][bj][m][0], x1 = b1 + acc[ai][bj][m][1];
                    u32x4 w; w.x = cvt_pk_bf16(x0[0], x0[1]); w.y = cvt_pk_bf16(x0[2], x0[3]); w.z = cvt_pk_bf16(x1[0], x1[1]); w.w = cvt_pk_bf16(x1[2], x1[3]);
                    *(u32x4*)(hb + off + bj * HALF) = w;
                    s += ((x0[0] * x0[0] + x0[1] * x0[1]) + (x0[2] * x0[2] + x0[3] * x0[3])) + ((x1[0] * x1[0] + x1[1] * x1[1]) + (x1[2] * x1[2] + x1[3] * x1[3])); }
                s += __shfl_xor(s, 16); s += __shfl_xor(s, 32);
                if (fq == 0) ss[(size_t)row * 16 + u.pn * 4 + wc] = s; }
    }
};
}

constexpr int NWAVES = 8;
constexpr int BATCH = 8, SEQ = 2048, DM = 1024, M = BATCH * SEQ, MEMLEN = 256, MM = BATCH * MEMLEN;
constexpr int INCOLS = 3088;
constexpr int N1 = 3328;
constexpr int PQ = 0, PK = 256, PV = 512, POG = 1024, PSQ = 1536, PSK = 2048, PSV = 2560, PGATE = 3072;
constexpr int PEER_N = 16384;
constexpr float EPS = 1e-6f;

constexpr size_t MiB = 1u << 20;
constexpr size_t WS_CTL = 0, CTL_ZERO_BYTES = 1 * MiB;
constexpr size_t WS_W1T = 1 * MiB;
constexpr size_t WS_WOT = 8 * MiB, WS_WXQT = 10 * MiB, WS_WXOT = 12 * MiB, WS_WXKVT = 14 * MiB, WS_WPQT = 18 * MiB, WS_SUBK = 22 * MiB;
constexpr size_t WS_UB = 24 * MiB, WS_VB = 56 * MiB;
constexpr size_t WS_BUFA = 88 * MiB;
constexpr size_t WS_MN = 120 * MiB;
constexpr size_t WS_KV = 124 * MiB;
constexpr size_t WS_PROJ = 132 * MiB;
constexpr size_t WS_SLOT0 = 132 * MiB, WS_SLOT1 = 164 * MiB, WS_SLOT2 = 196 * MiB, WS_VT = 76 * MiB, WS_END = 236 * MiB;
constexpr int CW_BAR = 4096;
constexpr int CW_SBSS = 32768;

constexpr int RING_BYTES = 131072;
constexpr int LDSCTL_OFF = RING_BYTES, MISC_OFF = LDSCTL_OFF + 320;
constexpr int LDS_BYTES = 147456;

#define GAS __attribute__((address_space(1)))
#define LAS __attribute__((address_space(3)))
typedef unsigned short bf16;
typedef unsigned v4u __attribute__((ext_vector_type(4)));
typedef float f32x4 __attribute__((ext_vector_type(4)));
typedef short bf16x8 __attribute__((ext_vector_type(8)));
typedef GAS unsigned gu32;
typedef GAS unsigned long long gu64;
#define RLX_AGENT __ATOMIC_RELAXED, __HIP_MEMORY_SCOPE_AGENT
#define LDS_WAIT() asm volatile("s_waitcnt lgkmcnt(0)" ::: "memory")
#define VM_WAIT() asm volatile("s_waitcnt vmcnt(0)" ::: "memory")
__device__ __forceinline__ unsigned long long rt() { return __builtin_amdgcn_s_memrealtime(); }
__device__ __forceinline__ unsigned f2bf(float f) { unsigned u = __builtin_bit_cast(unsigned, f); return (u + 0x7fffu + ((u >> 16) & 1u)) >> 16; }
__device__ __forceinline__ unsigned pk2(float lo, float hi) { return f2bf(lo) | (f2bf(hi) << 16); }

#define XB_TMO      128
#define XB_XCNT(j)  (256  + 64 * (j))
#define XB_XSUB(j)  (1280 + 64 * (j))
#define XB_XGEN(j)  (2304 + 64 * (j))
#define XB_TOP      3328
#define XB_TOPGEN   3392
#define XCD_BAR_WORDS 3456
#define XB_SPIN_CAP (1u << 22)

__device__ __forceinline__ unsigned xb_ld(unsigned* p)              { return __hip_atomic_load(p, __ATOMIC_RELAXED, __HIP_MEMORY_SCOPE_AGENT); }
__device__ __forceinline__ unsigned xb_add(unsigned* p, unsigned v) { return __hip_atomic_fetch_add(p, v, __ATOMIC_RELAXED, __HIP_MEMORY_SCOPE_AGENT); }
__device__ __forceinline__ unsigned xb_xcc_id() { return (unsigned)__builtin_amdgcn_s_getreg((3 << 11) | 20) & 0xFu; }
#define XB_SPIN(cond, bar) do { unsigned _sp = 0; while (cond) { __builtin_amdgcn_s_sleep(1); \
    if ((++_sp & 255u) == 0u) { if (xb_ld(&(bar)[XB_TMO])) break; if (_sp > XB_SPIN_CAP) { atomicAdd(&(bar)[XB_TMO], 1u); break; } } } } while (0)

struct XcdBarrier {
    unsigned* bar; unsigned x;
    volatile LAS unsigned* st;
};

__device__ __forceinline__ XcdBarrier xcd_barrier_post(unsigned* bar, volatile LAS unsigned* st) {
    XcdBarrier b; b.bar = bar; b.x = xb_xcc_id(); b.st = st;
    if (threadIdx.x == 0) (void)xb_add(&bar[XB_XCNT(b.x)], 1u);
    return b;
}
__device__ __forceinline__ void xcd_barrier_complete(unsigned* bar, unsigned x, unsigned& nloc, unsigned& nx) {
    const unsigned G = gridDim.x * gridDim.y * gridDim.z;
    unsigned sum, cnt, mine, sp = 0u;
    for (;;) {
        sum = 0u; cnt = 0u; mine = 0u;
#pragma unroll
        for (unsigned j = 0; j < 16; ++j) { const unsigned c = xb_ld(&bar[XB_XCNT(j)]); sum += c; cnt += (c > 0u) ? 1u : 0u; mine = (j == x) ? c : mine; }
        if (sum == G) break;
        __builtin_amdgcn_s_sleep(1);
        if ((++sp & 255u) == 0u) { if (xb_ld(&bar[XB_TMO])) break; if (sp > XB_SPIN_CAP) { atomicAdd(&bar[XB_TMO], 1u); break; } }
    }
    nloc = mine > 0u ? mine : 1u; nx = cnt > 0u ? cnt : 1u;
}

__device__ __forceinline__ void xcd_barrier(const XcdBarrier& b) {
    asm volatile("s_waitcnt vmcnt(0)" ::: "memory");
    __syncthreads();
    if (threadIdx.x == 0) {
        unsigned* bar = b.bar;
        __builtin_amdgcn_s_waitcnt(0);
        unsigned nloc = b.st[0], nx = b.st[1];
        if (nloc == 0u) { xcd_barrier_complete(bar, b.x, nloc, nx); b.st[0] = nloc; b.st[1] = nx; }
        const unsigned old = xb_add(&bar[XB_XSUB(b.x)], 1u);
        const unsigned gen = old / nloc;
        if (old + 1u == (gen + 1u) * nloc) {
            __builtin_amdgcn_fence(__ATOMIC_RELEASE, "agent");
            asm volatile("s_waitcnt vmcnt(0)" ::: "memory");
            const unsigned og = xb_add(&bar[XB_TOP], 1u);
            const unsigned tg = og / nx;
            if (og + 1u == (tg + 1u) * nx) xb_add(&bar[XB_TOPGEN], 1u);
            else XB_SPIN(xb_ld(&bar[XB_TOPGEN]) == tg, bar);
            __builtin_amdgcn_fence(__ATOMIC_ACQUIRE, "agent");
            xb_add(&bar[XB_XGEN(b.x)], 1u);
            asm volatile("s_waitcnt vmcnt(0)" ::: "memory");
        } else {
            XB_SPIN(xb_ld(&bar[XB_XGEN(b.x)]) == gen, bar);
            __builtin_amdgcn_fence(__ATOMIC_ACQUIRE, "agent");
            asm volatile("s_waitcnt vmcnt(0)" ::: "memory");
        }
    }
    __syncthreads();
}

#define DI __device__ __forceinline__
typedef __bf16 bf16x2_t __attribute__((ext_vector_type(2)));
struct Args { const float* in[21]; float* out; unsigned char* ws; int ph_lo, ph_hi, li, pad; };
struct Frame {
    LAS unsigned char* lds;
    volatile LAS unsigned* MISC;
    gu32* ctl;
    int tid, lane, wave;
    int vcu, G;
    unsigned char* ws; float* out;
};
#define WSP(off) ((bf16*)(F.ws + (off)))
#define F_W1T WSP(WS_W1T)
#define F_WOT WSP(WS_WOT)
#define F_WXQT WSP(WS_WXQT)
#define F_WXOT WSP(WS_WXOT)
#define F_WXKVT WSP(WS_WXKVT)
#define F_WPQT WSP(WS_WPQT)
#define F_SUBK WSP(WS_SUBK)
#define F_UB WSP(WS_UB)
#define F_VB WSP(WS_VB)
#define F_BUFA WSP(WS_BUFA)
#define F_MN WSP(WS_MN)
#define F_KV WSP(WS_KV)
#define F_PROJ WSP(WS_PROJ)
#define F_SLOT0 WSP(WS_SLOT0)
#define F_SLOT1 WSP(WS_SLOT1)
#define F_SLOT2 WSP(WS_SLOT2)
#define F_VT WSP(WS_VT)
DI float bf2f(unsigned v) { return __uint_as_float(v << 16); }
DI float bflo(unsigned w) { return __uint_as_float(w << 16); }
DI float bfhi(unsigned w) { return __uint_as_float(w & 0xffff0000u); }
DI float wave_sum(float v) {
#pragma unroll
    for (int o = 1; o < 64; o <<= 1) v += __shfl_xor(v, o);
    return v;
}
DI float wave_max(float v) {
#pragma unroll
    for (int o = 1; o < 64; o <<= 1) v = fmaxf(v, __shfl_xor(v, o));
    return v;
}
DI float dot2_bf16(unsigned w, unsigned x, float a) { return __builtin_amdgcn_fdot2_f32_bf16(__builtin_bit_cast(bf16x2_t, w), __builtin_bit_cast(bf16x2_t, x), a, false); }
DI float silu_f(float x) { return x * __builtin_amdgcn_rcpf(1.f + __expf(-x)); }
DI float log_sigmoid_f(float z) { return fminf(z, 0.f) - __logf(1.f + __expf(-fabsf(z))); }
DI float gelu_tanh_f(float x) { const float y = 0.7978845608028654f * (x + 0.044715f * x * x * x); const float t = 1.f - 2.f / (1.f + __expf(2.f * y)); return 0.5f * x * (1.f + t); }

DI void p0_transpose_item(const float* W, int ldw, int c0, bf16* WT, int row_off, LAS float* scr, int kb, int nb, int lane, const float* kgain = nullptr) {
    const int k0 = 64 * kb, n0 = 32 * nb;
    float tv[32];
#pragma unroll
    for (int i = 0; i < 32; ++i) tv[i] = W[(size_t)(k0 + 2 * i + (lane >> 5)) * ldw + c0 + n0 + (lane & 31)];
    if (kgain) {
#pragma unroll
        for (int i = 0; i < 32; ++i) tv[i] *= kgain[k0 + 2 * i + (lane >> 5)];
    }
#pragma unroll
    for (int i = 0; i < 32; ++i) scr[(2 * i + (lane >> 5)) * 33 + (lane & 31)] = tv[i];
    LDS_WAIT(); asm volatile("" ::: "memory");
    const int c = lane & 7;
#pragma unroll
    for (int j = 0; j < 4; ++j) { const int n = (lane >> 3) + 8 * j; const LAS float* s = scr + (8 * c) * 33 + n;
        v4u o; o.x = pk2(s[0 * 33], s[1 * 33]); o.y = pk2(s[2 * 33], s[3 * 33]); o.z = pk2(s[4 * 33], s[5 * 33]); o.w = pk2(s[6 * 33], s[7 * 33]);
        *(GAS v4u*)(WT + (size_t)(row_off + n0 + n) * 1024 + k0 + 8 * c) = o; }
    LDS_WAIT(); asm volatile("" ::: "memory");
}
DI void rms_row_to_bf16(int lane, const float* xrow, const float* g, bf16* orow) {
    const GAS f32x4* xr = (const GAS f32x4*)xrow + lane; const GAS f32x4* gr = (const GAS f32x4*)g + lane;
    f32x4 v[4]; float s = 0.f;
#pragma unroll
    for (int j = 0; j < 4; ++j) { v[j] = xr[64 * j]; s += (v[j].x * v[j].x + v[j].y * v[j].y) + (v[j].z * v[j].z + v[j].w * v[j].w); }
    const float rs = 1.f / sqrtf(wave_sum(s) * (1.f / 1024.f) + EPS);
    GAS unsigned long long* o8 = (GAS unsigned long long*)orow + lane;
#pragma unroll
    for (int j = 0; j < 4; ++j) { const f32x4 gg = gr[64 * j]; const f32x4 y = v[j] * rs * gg; o8[64 * j] = (unsigned long long)pk2(y.x, y.y) | ((unsigned long long)pk2(y.z, y.w) << 32); }
}
typedef float f32x2 __attribute__((ext_vector_type(2)));
constexpr size_t WS_U8 = 24 * MiB, WS_V8 = 40 * MiB, WS_X8 = 56 * MiB, WS_SU = 72 * MiB, WS_SX = 72 * MiB + 65536, WS_SV = 72 * MiB + 131072;
template <int CTRL> DI int dpp_i(int v) { return __builtin_amdgcn_update_dpp(0, v, CTRL, 0xf, 0xf, false); }
DI void quant_row_i8(int lane, const float* src, unsigned char* dst, float* scale_out) {
    f32x4 v[4]; float m = 0.f;
#pragma unroll
    for (int j = 0; j < 4; ++j) { v[j] = *(const GAS f32x4*)(src + 256 * j + 4 * lane); m = fmaxf(m, fmaxf(fmaxf(fabsf(v[j].x), fabsf(v[j].y)), fmaxf(fabsf(v[j].z), fabsf(v[j].w)))); }
    m = wave_max(m);
    const float sc = m > 0.f ? m * (1.f / 127.f) : 1.f, inv = 1.f / sc;
    v4u o;
#pragma unroll
    for (int j = 0; j < 4; ++j) { const int a = (int)rintf(v[j].x * inv), b = (int)rintf(v[j].y * inv), c = (int)rintf(v[j].z * inv), d = (int)rintf(v[j].w * inv);
        o[j] = (unsigned)(a & 255) | ((unsigned)(b & 255) << 8) | ((unsigned)(c & 255) << 16) | ((unsigned)(d & 255) << 24); }
    *(GAS v4u*)(dst + 16 * lane) = o;
    if (lane == 0) *scale_out = sc;
}
typedef float f32x16v __attribute__((ext_vector_type(16)));
typedef int i32x6v __attribute__((ext_vector_type(6)));
typedef unsigned u32x3v __attribute__((ext_vector_type(3)));
DI unsigned fp6_e2m3(float x) {
    const float m = fminf(fabsf(x), 7.5f);
    const int e = m >= 4.f ? 2 : m >= 2.f ? 1 : 0;
    const int q = (int)rintf(m * (e == 2 ? 2.f : e == 1 ? 4.f : 8.f));
    const unsigned code = e == 0 ? (unsigned)q : (unsigned)((e + 1) * 8 + (q - 8));
    return (x < 0.f ? 32u : 0u) | (code > 31u ? 31u : code);
}
DI void quant_row_fp6(int lane, const float* src, unsigned char* dst, float* sc) {
    float v[16]; float mx = 0.f;
#pragma unroll
    for (int j = 0; j < 4; ++j) { const f32x4 t = *(const GAS f32x4*)(src + 256 * j + 4 * lane);
#pragma unroll
        for (int i = 0; i < 4; ++i) { v[4 * j + i] = t[i]; mx = fmaxf(mx, fabsf(t[i])); } }
    mx = wave_max(mx);
    const float s_ = mx > 0.f ? mx * (1.f / 7.5f) : 1.f, inv = 1.f / s_;
    unsigned long long lo = 0ull; unsigned hi = 0u;
#pragma unroll
    for (int i = 0; i < 16; ++i) { const unsigned long long c = fp6_e2m3(v[i] * inv);
        if (6 * i < 64) lo |= c << (6 * i);
        if (6 * i + 6 > 64) hi |= (unsigned)(6 * i >= 64 ? c << (6 * i - 64) : c >> (64 - 6 * i)); }
    *(GAS u32x3v*)(dst + 12 * lane) = (u32x3v){(unsigned)lo, (unsigned)(lo >> 32), hi};
    if (lane == 0) *sc = s_;
}
DI void rms_row_to_bf16_i8(int lane, const float* xrow, const float* g, bf16* orow, unsigned char* qrow, float* sx) {
    const GAS f32x4* xr = (const GAS f32x4*)xrow + lane; const GAS f32x4* gr = (const GAS f32x4*)g + lane;
    f32x4 v[4]; float s = 0.f;
#pragma unroll
    for (int j = 0; j < 4; ++j) { v[j] = xr[64 * j]; s += (v[j].x * v[j].x + v[j].y * v[j].y) + (v[j].z * v[j].z + v[j].w * v[j].w); }
    const float rs = 1.f / sqrtf(wave_sum(s) * (1.f / 1024.f) + EPS);
    GAS unsigned long long* o8 = (GAS unsigned long long*)orow + lane; float m = 0.f;
#pragma unroll
    for (int j = 0; j < 4; ++j) { const f32x4 gg = gr[64 * j]; v[j] = v[j] * rs * gg; o8[64 * j] = (unsigned long long)pk2(v[j].x, v[j].y) | ((unsigned long long)pk2(v[j].z, v[j].w) << 32);
        m = fmaxf(m, fmaxf(fmaxf(fabsf(v[j].x), fabsf(v[j].y)), fmaxf(fabsf(v[j].z), fabsf(v[j].w)))); }
    m = wave_max(m);
    const float sc = m > 0.f ? m * (1.f / 127.f) : 1.f, inv = 1.f / sc;
#pragma unroll
    for (int j = 0; j < 4; ++j) { const int a = (int)rintf(v[j].x * inv), b = (int)rintf(v[j].y * inv), c = (int)rintf(v[j].z * inv), d = (int)rintf(v[j].w * inv);
        *(GAS unsigned*)(qrow + 4 * lane + 256 * j) = (unsigned)(a & 255) | ((unsigned)(b & 255) << 8) | ((unsigned)(c & 255) << 16) | ((unsigned)(d & 255) << 24); }
    if (lane == 0) *sx = sc;
}
template <int R> DI void rms_rows_to_bf16(int lane, const float* x0, size_t xstride, const float* g, bf16* o0, size_t ostride) {
    f32x4 v[R][4];
#pragma unroll
    for (int r = 0; r < R; ++r)
#pragma unroll
        for (int j = 0; j < 4; ++j) v[r][j] = *((const GAS f32x4*)(x0 + r * xstride) + lane + 64 * j);
    f32x4 gg[4];
#pragma unroll
    for (int j = 0; j < 4; ++j) gg[j] = *((const GAS f32x4*)g + lane + 64 * j);
#pragma unroll
    for (int r = 0; r < R; ++r) { float s = 0.f;
#pragma unroll
        for (int j = 0; j < 4; ++j) s += (v[r][j].x * v[r][j].x + v[r][j].y * v[r][j].y) + (v[r][j].z * v[r][j].z + v[r][j].w * v[r][j].w);
        const float rs = 1.f / sqrtf(wave_sum(s) * (1.f / 1024.f) + EPS);
        GAS unsigned long long* o8 = (GAS unsigned long long*)(o0 + r * ostride) + lane;
#pragma unroll
        for (int j = 0; j < 4; ++j) { const f32x4 y = v[r][j] * rs * gg[j]; o8[64 * j] = (unsigned long long)pk2(y.x, y.y) | ((unsigned long long)pk2(y.z, y.w) << 32); } }
}
DI void p0_prologue(Frame& F, const Args& A) {
    LAS float* scr = (LAS float*)(F.lds + F.wave * 16384);
    const int gw = F.vcu * NWAVES + F.wave, NGW = F.G * NWAVES;
    constexpr int I_IN = 16 * 48, I_W2 = 16 * 64;
    constexpr int NIT = 2 * I_IN + I_W2;
    for (int it = gw; it < NIT; it += NGW) {
        int r = it;
        if (r < I_IN) { p0_transpose_item(A.in[3], INCOLS, 0, F_W1T, 0, scr, r / 48, r % 48, F.lane); continue; } r -= I_IN;
        if (r < I_IN) { p0_transpose_item(A.in[3], INCOLS, 1552, F_W1T, 1536, scr, r / 48, r % 48, F.lane); continue; } r -= I_IN;
        p0_transpose_item(A.in[13], 2048, 0, F_WXKVT, 0, scr, r / 64, r % 64, F.lane);
    }
    const int gt = gw * 64 + F.lane, NGT = NGW * 64;
    for (int i = gt; i < 256 * 128; i += NGT) {
        const int n = i >> 7, k0 = (i & 127) * 8;
        float gv[16];
#pragma unroll
        for (int r = 0; r < 16; ++r) gv[r] = A.in[5][r * 256 + n];
        float s[8];
#pragma unroll
        for (int j = 0; j < 8; ++j) { const float* wr_ = A.in[3] + (size_t)(k0 + j) * INCOLS + 1536; float a = 0.f;
#pragma unroll
            for (int r = 0; r < 16; ++r) a += wr_[r] * gv[r];
            s[j] = a; }
        v4u o; o.x = pk2(s[0], s[1]); o.y = pk2(s[2], s[3]); o.z = pk2(s[4], s[5]); o.w = pk2(s[6], s[7]);
        *(GAS v4u*)(F_W1T + (size_t)(3072 + n) * 1024 + k0) = o;
    }
    for (int m = 4 * gw; m < M; m += 4 * NGW) rms_rows_to_bf16<4>(F.lane, A.in[0] + (size_t)m * DM, DM, A.in[2], F_BUFA + (size_t)m * DM, DM);
    for (int m = gw; m < MM; m += NGW) rms_row_to_bf16(F.lane, A.in[1] + (size_t)m * DM, A.in[11], F_MN + (size_t)m * DM);
}
template <int R> DI void quant_rows_i8(int lane, const float* src, unsigned char* dst, float* scale_out) {
    f32x4 v[R][4];
#pragma unroll
    for (int r = 0; r < R; ++r)
#pragma unroll
        for (int j = 0; j < 4; ++j) v[r][j] = *(const GAS f32x4*)(src + (size_t)r * 1024 + 256 * j + 4 * lane);
#pragma unroll
    for (int r = 0; r < R; ++r) { float m = 0.f;
#pragma unroll
        for (int j = 0; j < 4; ++j) m = fmaxf(m, fmaxf(fmaxf(fabsf(v[r][j].x), fabsf(v[r][j].y)), fmaxf(fabsf(v[r][j].z), fabsf(v[r][j].w))));
        m = wave_max(m);
        const float sc = m > 0.f ? m * (1.f / 127.f) : 1.f, inv = 1.f / sc;
        v4u o;
#pragma unroll
        for (int j = 0; j < 4; ++j) { const int a = (int)rintf(v[r][j].x * inv), b = (int)rintf(v[r][j].y * inv), c = (int)rintf(v[r][j].z * inv), d = (int)rintf(v[r][j].w * inv);
            o[j] = (unsigned)(a & 255) | ((unsigned)(b & 255) << 8) | ((unsigned)(c & 255) << 16) | ((unsigned)(d & 255) << 24); }
        *(GAS v4u*)(dst + (size_t)r * 1024 + 16 * lane) = o;
        if (lane == 0) scale_out[r] = sc; }
}
template <int R> DI void quant_rows_fp6(int lane, const float* src, unsigned char* dst, float* sc) {
    f32x4 t[R][4];
#pragma unroll
    for (int r = 0; r < R; ++r)
#pragma unroll
        for (int j = 0; j < 4; ++j) t[r][j] = *(const GAS f32x4*)(src + (size_t)r * 1024 + 256 * j + 4 * lane);
#pragma unroll
    for (int r = 0; r < R; ++r) { float mx = 0.f;
#pragma unroll
        for (int j = 0; j < 4; ++j) mx = fmaxf(mx, fmaxf(fmaxf(fabsf(t[r][j].x), fabsf(t[r][j].y)), fmaxf(fabsf(t[r][j].z), fabsf(t[r][j].w))));
        mx = wave_max(mx);
        const float s_ = mx > 0.f ? mx * (1.f / 7.5f) : 1.f, inv = 1.f / s_;
        unsigned long long lo = 0ull; unsigned hi = 0u;
#pragma unroll
        for (int i = 0; i < 16; ++i) { const unsigned long long c = fp6_e2m3(t[r][i >> 2][i & 3] * inv);
            if (6 * i < 64) lo |= c << (6 * i);
            if (6 * i + 6 > 64) hi |= (unsigned)(6 * i >= 64 ? c << (6 * i - 64) : c >> (64 - 6 * i)); }
        *(GAS u32x3v*)(dst + (size_t)r * 768 + 12 * lane) = (u32x3v){(unsigned)lo, (unsigned)(lo >> 32), hi};
        if (lane == 0) sc[r] = s_; }
}
DI void p0_late(Frame& F, const Args& A, int widx, int nw) {
    LAS float* scr = (LAS float*)(F.lds + F.wave * 16384);
    constexpr int I_SQ = 16 * 32, I_W2 = 16 * 64;
    for (int it = widx; it < 3 * I_SQ + I_W2; it += nw) {
        int r = it;
        if (r < I_SQ) { p0_transpose_item(A.in[9], 1024, 0, F_WOT, 0, scr, r / 32, r % 32, F.lane); continue; } r -= I_SQ;
        if (r < I_SQ) { p0_transpose_item(A.in[12], 1024, 0, F_WXQT, 0, scr, r / 32, r % 32, F.lane, A.in[10]); continue; } r -= I_SQ;
        if (r < I_SQ) { p0_transpose_item(A.in[14], 1024, 0, F_WXOT, 0, scr, r / 32, r % 32, F.lane); continue; } r -= I_SQ;
        p0_transpose_item(A.in[16], 2048, 0, F_WPQT, 0, scr, r / 64, r % 64, F.lane, A.in[15]);
    }
    for (int i = widx * 64 + F.lane; i < 32768; i += nw * 64) {
        const f32x4 a = *(const GAS f32x4*)(A.in[17] + (size_t)i * 8), b = *(const GAS f32x4*)(A.in[17] + (size_t)i * 8 + 4);
        v4u o; o.x = pk2(a.x, a.y); o.y = pk2(a.z, a.w); o.z = pk2(b.x, b.y); o.w = pk2(b.z, b.w);
        *(GAS v4u*)(F_SUBK + (size_t)i * 8) = o;
    }
    for (int m = 4 * widx; m < PEER_N; m += 4 * nw) quant_rows_i8<4>(F.lane, A.in[18] + (size_t)m * DM, F.ws + WS_U8 + (size_t)m * 1024, (float*)(F.ws + WS_SU) + m);
    for (int m = 4 * widx; m < PEER_N; m += 4 * nw) quant_rows_fp6<4>(F.lane, A.in[19] + (size_t)m * DM, F.ws + WS_V8 + (size_t)m * 768, (float*)(F.ws + WS_SV) + m);
}

DI void gla_naive_item(Frame& F, const Args& A, float* OGLA, int b, int h, int eg) {
    const int lane = F.lane, e = eg * 8 + F.wave;
    const int cq = PQ + h * 64 + lane, ck = PK + h * 64 + lane, cv = PV + h * 128 + e, cg = PGATE + h * 64 + lane;
    float wq[4], wk[4], wv[4];
#pragma unroll
    for (int k = 0; k < 4; ++k) { wq[k] = A.in[4][k * 1024 + cq]; wk[k] = A.in[4][k * 1024 + ck]; wv[k] = A.in[4][k * 1024 + cv]; }
    const float bias = A.in[6][h * 64 + lane];
    float rq0 = 0.f, rq1 = 0.f, rq2 = 0.f, rk0 = 0.f, rk1 = 0.f, rk2 = 0.f, rv0 = 0.f, rv1 = 0.f, rv2 = 0.f, S = 0.f;
    for (int t0 = 0; t0 < SEQ; t0 += 8) {
        unsigned lq[8], lk[8], lv[8], lg[8];
#pragma unroll
        for (int j = 0; j < 8; ++j) { const bf16* base = F_PROJ + (size_t)(b * SEQ + t0 + j) * N1; lq[j] = base[cq]; lk[j] = base[ck]; lv[j] = base[cv]; lg[j] = base[cg]; }
#pragma unroll
        for (int j = 0; j < 8; ++j) {
            const float xq = bf2f(lq[j]), xk = bf2f(lk[j]), xv = bf2f(lv[j]);
            const float q = silu_f(wq[0] * rq0 + wq[1] * rq1 + wq[2] * rq2 + wq[3] * xq) * 0.125f; rq0 = rq1; rq1 = rq2; rq2 = xq;
            const float k = silu_f(wk[0] * rk0 + wk[1] * rk1 + wk[2] * rk2 + wk[3] * xk); rk0 = rk1; rk1 = rk2; rk2 = xk;
            const float v = silu_f(wv[0] * rv0 + wv[1] * rv1 + wv[2] * rv2 + wv[3] * xv); rv0 = rv1; rv1 = rv2; rv2 = xv;
            const float a = __expf(log_sigmoid_f(bf2f(lg[j]) + bias) * (1.f / 16.f));
            S = a * S + k * v;
            const float o = wave_sum(q * S);
            if (lane == 0) OGLA[(size_t)(b * SEQ + t0 + j) * 512 + h * 128 + e] = o;
        }
    }
}
DI void sb_naive_item(Frame& F, float* OSB, int b, int h, int qb) {
    LAS float* Ks = (LAS float*)F.lds; LAS float* Vs = Ks + 64 * 64;
    const int tid = F.tid, t = qb * 512 + tid; const size_t row = (size_t)b * SEQ + t;
    float q[64], acc[64];
    {
        const GAS v4u* qp = (const GAS v4u*)(F_PROJ + row * N1 + PSQ + h * 64);
#pragma unroll
        for (int c = 0; c < 8; ++c) { const v4u w = qp[c]; q[8 * c + 0] = bflo(w.x) * 0.125f; q[8 * c + 1] = bfhi(w.x) * 0.125f; q[8 * c + 2] = bflo(w.y) * 0.125f; q[8 * c + 3] = bfhi(w.y) * 0.125f;
            q[8 * c + 4] = bflo(w.z) * 0.125f; q[8 * c + 5] = bfhi(w.z) * 0.125f; q[8 * c + 6] = bflo(w.w) * 0.125f; q[8 * c + 7] = bfhi(w.w) * 0.125f; }
    }
#pragma unroll
    for (int d = 0; d < 64; ++d) acc[d] = 0.f;
    float carry = 0.f;
    for (int kt = qb * 8 + 7; kt >= 0; --kt) {
        __syncthreads();
        {
            const int key = tid >> 3, ch = tid & 7; const size_t krow = (size_t)b * SEQ + kt * 64 + key;
            const v4u kw = *(const GAS v4u*)(F_PROJ + krow * N1 + PSK + h * 64 + ch * 8), vw = *(const GAS v4u*)(F_PROJ + krow * N1 + PSV + h * 64 + ch * 8);
            LAS f32x4* kd = (LAS f32x4*)(Ks + key * 64 + ch * 8); LAS f32x4* vd = (LAS f32x4*)(Vs + key * 64 + ch * 8);
            kd[0] = (f32x4){bflo(kw.x), bfhi(kw.x), bflo(kw.y), bfhi(kw.y)}; kd[1] = (f32x4){bflo(kw.z), bfhi(kw.z), bflo(kw.w), bfhi(kw.w)};
            vd[0] = (f32x4){bflo(vw.x), bfhi(vw.x), bflo(vw.y), bfhi(vw.y)}; vd[1] = (f32x4){bflo(vw.z), bfhi(vw.z), bflo(vw.w), bfhi(vw.w)};
        }
        __syncthreads();
        for (int j = 63; j >= 0; --j) {
            const int s = kt * 64 + j;
            if (s < t) {
                const LAS f32x4* kr = (const LAS f32x4*)(Ks + j * 64); const LAS f32x4* vr = (const LAS f32x4*)(Vs + j * 64);
                float z0 = 0.f, z1 = 0.f, z2 = 0.f, z3 = 0.f;
#pragma unroll
                for (int c = 0; c < 16; ++c) { const f32x4 kk = kr[c]; z0 += q[4 * c] * kk.x; z1 += q[4 * c + 1] * kk.y; z2 += q[4 * c + 2] * kk.z; z3 += q[4 * c + 3] * kk.w; }
                const float z = (z0 + z1) + (z2 + z3);
                const float lb = log_sigmoid_f(z);
                const float w = __expf(lb + carry);
                carry += lb - z;
#pragma unroll
                for (int c = 0; c < 16; ++c) { const f32x4 vv = vr[c]; acc[4 * c] += w * vv.x; acc[4 * c + 1] += w * vv.y; acc[4 * c + 2] += w * vv.z; acc[4 * c + 3] += w * vv.w; }
            }
        }
    }
    GAS f32x4* op = (GAS f32x4*)(OSB + row * 512 + h * 64);
#pragma unroll
    for (int c = 0; c < 16; ++c) op[c] = (f32x4){acc[4 * c], acc[4 * c + 1], acc[4 * c + 2], acc[4 * c + 3]};
}
typedef float f32x16 __attribute__((ext_vector_type(16)));
typedef short s16x4 __attribute__((ext_vector_type(4)));
DI s16x4 lds_tr16(const LAS unsigned char* p) { return __builtin_bit_cast(s16x4, __builtin_amdgcn_ds_read_tr16_b64_v4i16((LAS s16x4*)p)); }
DI unsigned cvtpk_bf16(float lo, float hi) { typedef float f2 __attribute__((ext_vector_type(2))); f2 v = {lo, hi}; bf16x2_t b = __builtin_convertvector(v, bf16x2_t); return __builtin_bit_cast(unsigned, b); }
constexpr float SB_C2 = 0.125f * 1.4426950408889634f;
template <bool MASKED> DI void sb_weights(f32x16& P0, f32x16& P1, float& carry, int hi, int qrel2) {
    float T[8], cs[8];
#pragma unroll
    for (int pi = 0; pi < 2; ++pi) {
        f32x16& P = pi ? P1 : P0;
#pragma unroll
        for (int g = 0; g < 4; ++g) {
            float lbv[4], l1v[4];
#pragma unroll
            for (int i = 0; i < 4; ++i) {
                const float z2 = P[4 * g + i] * SB_C2;
                const float sp = __builtin_amdgcn_logf(1.f + __builtin_amdgcn_exp2f(-fabsf(z2)));
                float lb = fminf(z2, 0.f) - sp, l1 = lb - z2;
                if (MASKED) { const bool valid = (32 * pi + 8 * g + 4 * hi + i) < qrel2; lb = valid ? lb : -INFINITY; l1 = valid ? l1 : 0.f; }
                lbv[i] = lb; l1v[i] = l1;
            }
            const float a = l1v[3], b = a + l1v[2], c = b + l1v[1];
            cs[4 * pi + g] = c + l1v[0];
            P[4 * g + 3] = lbv[3]; P[4 * g + 2] = lbv[2] + a; P[4 * g + 1] = lbv[1] + b; P[4 * g + 0] = lbv[0] + c;
        }
    }
#pragma unroll
    for (int k = 0; k < 8; ++k) { auto rr = __builtin_amdgcn_permlane32_swap(__float_as_uint(cs[k]), __float_as_uint(cs[k]), false, false); T[k] = __uint_as_float(rr[0]) + __uint_as_float(rr[1]); }
    const float m0 = hi ? 0.f : 1.f;
    float run = carry;
#pragma unroll
    for (int k = 7; k >= 0; --k) {
        const float E = run + m0 * (T[k] - cs[k]);
        f32x16& P = (k >> 2) ? P1 : P0; const int g = k & 3;
#pragma unroll
        for (int i = 0; i < 4; ++i) P[4 * g + i] = __builtin_amdgcn_exp2f(P[4 * g + i] + E);
        run += T[k];
    }
    carry = run;
}
DI void sb_unit(Frame& F, float* OSB, int b, int h, int qb) {
    const int tid = F.tid, lane = F.lane, wid = F.wave, r32 = lane & 31, hi = lane >> 5;
    const int q0 = qb * 256; const size_t rowbase = (size_t)b * SEQ;
    const bf16* Kg = F_PROJ + rowbase * N1 + PSK + h * 64;
    const bf16* Vg = F_PROJ + rowbase * N1 + PSV + h * 64;
    bf16x8 qr[4];
    { const bf16* Qw = F_PROJ + (rowbase + q0 + wid * 32 + r32) * N1 + PSQ + h * 64;
#pragma unroll
      for (int ks = 0; ks < 4; ++ks) qr[ks] = *(const GAS bf16x8*)(Qw + ks * 16 + hi * 8); }
    const bf16* ksrc = Kg + (size_t)(tid >> 3) * N1 + (tid & 7) * 8;
    const bf16* vsrc = Vg + (size_t)(16 * (wid & 3) + (lane >> 2)) * N1 + (wid >> 2) * 32 + (lane & 3) * 8;
    const int kdst = (tid & 7) * 1024 + (tid >> 3) * 16, vdst = 8192 + wid * 1024 + lane * 16;
    const int kfr = hi * 1024 + r32 * 16;
    const int vfr = 8192 + ((lane >> 4) & 1) * 32 + (lane & 3) * 8 + (4 * hi + ((lane & 15) >> 2)) * 64;
    f32x16 o0 = {}, o1 = {};
    float carry = 0.f;
    const int ktmax = (q0 >> 6) + 3;
    v4u kreg = *(const GAS v4u*)(ksrc + (size_t)ktmax * 64 * N1), vreg = *(const GAS v4u*)(vsrc + (size_t)ktmax * 64 * N1);
    __syncthreads();
    *(LAS v4u*)(F.lds + kdst) = kreg; *(LAS v4u*)(F.lds + vdst) = vreg;
    __syncthreads();
    int cur = 0;
    const int wrow0 = q0 + wid * 32;
    bool wdone = false;
    LAS unsigned* flags = (LAS unsigned*)(F.lds + 32768);
    for (int kt = ktmax; kt >= 0; --kt) {
        if (kt > 0) { kreg = *(const GAS v4u*)(ksrc + (size_t)(kt - 1) * 64 * N1); vreg = *(const GAS v4u*)(vsrc + (size_t)(kt - 1) * 64 * N1); }
        const int k0 = kt * 64;
        if (!wdone && k0 <= wrow0 + 30) {
            const LAS unsigned char* Kb = F.lds + cur * 16384;
            f32x16 P0 = {}, P1 = {};
#pragma unroll
            for (int ks = 0; ks < 4; ++ks) {
                const bf16x8 a0 = *(const LAS bf16x8*)(Kb + kfr + ks * 2048), a1 = *(const LAS bf16x8*)(Kb + kfr + ks * 2048 + 512);
                P0 = __builtin_amdgcn_mfma_f32_32x32x16_bf16(a0, qr[ks], P0, 0, 0, 0);
                P1 = __builtin_amdgcn_mfma_f32_32x32x16_bf16(a1, qr[ks], P1, 0, 0, 0);
            }
            if (k0 + 63 >= wrow0) sb_weights<true>(P0, P1, carry, hi, wrow0 + r32 - k0);
            else sb_weights<false>(P0, P1, carry, hi, 0);
#pragma unroll
            for (int s = 0; s < 4; ++s) {
                const f32x16& P = (s >> 1) ? P1 : P0; const int rb = (s & 1) * 8;
                v4u pw; pw.x = cvtpk_bf16(P[rb + 0], P[rb + 1]); pw.y = cvtpk_bf16(P[rb + 2], P[rb + 3]); pw.z = cvtpk_bf16(P[rb + 4], P[rb + 5]); pw.w = cvtpk_bf16(P[rb + 6], P[rb + 7]);
                const bf16x8 pa = __builtin_bit_cast(bf16x8, pw);
                const LAS unsigned char* vp = Kb + vfr + s * 1024;
                const s16x4 l0 = lds_tr16(vp), h0 = lds_tr16(vp + 512), l1 = lds_tr16(vp + 4096), h1 = lds_tr16(vp + 4096 + 512);
                const bf16x8 v0 = {l0[0], l0[1], l0[2], l0[3], h0[0], h0[1], h0[2], h0[3]}, v1 = {l1[0], l1[1], l1[2], l1[3], h1[0], h1[1], h1[2], h1[3]};
                o0 = __builtin_amdgcn_mfma_f32_32x32x16_bf16(pa, v0, o0, 0, 0, 0);
                o1 = __builtin_amdgcn_mfma_f32_32x32x16_bf16(pa, v1, o1, 0, 0, 0);
            }
            wdone = __all(carry < -160.f);
        }
        if (lane == 0) flags[(kt & 1) * 8 + wid] = wdone ? 1u : 0u;
        if (kt > 0) { *(LAS v4u*)(F.lds + (cur ^ 1) * 16384 + kdst) = kreg; *(LAS v4u*)(F.lds + (cur ^ 1) * 16384 + vdst) = vreg; }
        __syncthreads();
        cur ^= 1;
        { const v4u f0 = *(const LAS v4u*)(flags + (kt & 1) * 8), f1 = *(const LAS v4u*)(flags + (kt & 1) * 8 + 4);
          if ((f0.x & f0.y & f0.z & f0.w & f1.x & f1.y & f1.z & f1.w) != 0u) break; }
    }
    float* op = OSB + (rowbase + wrow0) * 512 + h * 64 + r32;
#pragma unroll
    for (int r = 0; r < 16; ++r) { const int qrow = (r & 3) + 8 * (r >> 2) + 4 * hi; op[(size_t)qrow * 512] = o0[r]; op[(size_t)qrow * 512 + 32] = o1[r]; }
}
constexpr int GL_QT = 0, GL_KT = 8192, GL_KD = 16384, GL_V = 28672, GL_ST = 49152, GL_SEG = 69632, GL_RED = 71680, GL_KDP = 192, GL_VP = 320;
constexpr int CW_DECAY = 65536;
template <bool ACC> DI bf16x8 tr_frag(const LAS unsigned char* base, int PB, int x0, int k0, int lane) {
    const int hi = lane >> 5, rr = (lane & 15) >> 2, col = x0 + 16 * ((lane >> 4) & 1) + 4 * (lane & 3);
    const int r0 = ACC ? (k0 + 4 * hi + rr) : (k0 + 8 * hi + rr), r1 = ACC ? (r0 + 8) : (r0 + 4);
    const s16x4 a = lds_tr16(base + r0 * PB + col * 2), b = lds_tr16(base + r1 * PB + col * 2);
    return (bf16x8){a[0], a[1], a[2], a[3], b[0], b[1], b[2], b[3]};
}
constexpr int GL_RQ = 73728, GL_RK = 82432, GL_RG = 91136, GL_RV = 99328;
template <int MODE> DI void gla_prep(Frame& F, const Args& A, int b, int h, int n) {
    const int tid = F.tid, d = tid & 63, seg = tid >> 6;
    const float* cw = A.in[4];
    const size_t row0 = (size_t)b * SEQ + 64 * n;
    float wq[4], wk[4], wv[4];
#pragma unroll
    for (int k = 0; k < 4; ++k) { wq[k] = cw[k * 1024 + PQ + h * 64 + d]; wk[k] = cw[k * 1024 + PK + h * 64 + d]; wv[k] = cw[k * 1024 + PV + h * 128 + (tid & 127)]; }
    const float bias = A.in[6][h * 64 + d];
    {
        v4u w[6]; int lo_[6];
#pragma unroll
        for (int i = 0; i < 6; ++i) {
            const int c = tid + 512 * i;
            const int reg = (c >= 536) + (c >= 1072) + (c >= 1584);
            const int cc = c - (reg == 1 ? 536 : reg == 2 ? 1072 : reg == 3 ? 1584 : 0);
            const int rr = reg == 3 ? (cc >> 4) : (cc >> 3), ch = reg == 3 ? (cc & 15) : (cc & 7);
            const int r = rr + (reg == 2 ? 3 : 0);
            const int col = (reg == 0 ? PQ + h * 64 : reg == 1 ? PK + h * 64 : reg == 2 ? PGATE + h * 64 : PV + h * 128) + ch * 8;
            lo_[i] = (reg == 0 ? GL_RQ : reg == 1 ? GL_RK : reg == 2 ? GL_RG : GL_RV) + rr * (reg == 3 ? 256 : 128) + ch * 16;
            const bool ok = (c < 2656) && (64 * n - 3 + r >= 0);
            w[i] = (v4u){0u, 0u, 0u, 0u};
            if (ok) w[i] = *(const GAS v4u*)(F_PROJ + (row0 - 3 + r) * N1 + col);
            if (c >= 2656) lo_[i] = -1;
        }
#pragma unroll
        for (int i = 0; i < 6; ++i) if (lo_[i] >= 0) *(LAS v4u*)(F.lds + lo_[i]) = w[i];
    }
    __syncthreads();
    {
        float rq[11], rk[11], gl[8];
#pragma unroll
        for (int i = 0; i < 11; ++i) { rq[i] = bf2f(*(const LAS bf16*)(F.lds + GL_RQ + (8 * seg + i) * 128 + d * 2)); rk[i] = bf2f(*(const LAS bf16*)(F.lds + GL_RK + (8 * seg + i) * 128 + d * 2)); }
#pragma unroll
        for (int j = 0; j < 8; ++j) gl[j] = log_sigmoid_f(bf2f(*(const LAS bf16*)(F.lds + GL_RG + (8 * seg + j) * 128 + d * 2)) + bias) * (1.f / 16.f);
        float c = 0.f;
#pragma unroll
        for (int j = 0; j < 8; ++j) { c += gl[j]; gl[j] = c; }
        LAS float* SEG = (LAS float*)(F.lds + GL_SEG);
        SEG[seg * 64 + d] = c;
        __syncthreads();
        float pre = 0.f, tot = 0.f;
#pragma unroll
        for (int s = 0; s < 8; ++s) { const float v = SEG[s * 64 + d]; pre += (s < seg) ? v : 0.f; tot += v; }
#pragma unroll
        for (int j = 0; j < 8; ++j) {
            const int tok = 8 * seg + j; const float cum = pre + gl[j];
            const float qc = silu_f(wq[0] * rq[j] + wq[1] * rq[j + 1] + wq[2] * rq[j + 2] + wq[3] * rq[j + 3]);
            const float kc = silu_f(wk[0] * rk[j] + wk[1] * rk[j + 1] + wk[2] * rk[j + 2] + wk[3] * rk[j + 3]);
            if (MODE == 0) { *(LAS bf16*)(F.lds + GL_KD + tok * GL_KDP + d * 2) = (bf16)f2bf(kc * __expf(tot - cum)); }
            else { const int off = (d >> 3) * 1024 + tok * 16 + (d & 7) * 2;
                *(LAS bf16*)(F.lds + GL_QT + off) = (bf16)f2bf(qc * 0.125f * __expf(cum)); *(LAS bf16*)(F.lds + GL_KT + off) = (bf16)f2bf(kc * __expf(-cum)); }
        }
        if (MODE == 0 && seg == 0) ((float*)(F.ctl + CW_DECAY))[((size_t)(b * 4 + h) * 32 + n) * 64 + d] = __expf(tot);
    }
    {
        const int e = tid & 127, s4 = tid >> 7;
        float rv[19];
#pragma unroll
        for (int i = 0; i < 19; ++i) rv[i] = bf2f(*(const LAS bf16*)(F.lds + GL_RV + (16 * s4 + i) * 256 + e * 2));
#pragma unroll
        for (int j = 0; j < 16; ++j) *(LAS bf16*)(F.lds + GL_V + (16 * s4 + j) * GL_VP + e * 2) = (bf16)f2bf(silu_f(wv[0] * rv[j] + wv[1] * rv[j + 1] + wv[2] * rv[j + 2] + wv[3] * rv[j + 3]));
    }
}
DI void gla_local_unit(Frame& F, const Args& A, bf16* STW, int b, int h, int n) {
    __syncthreads();
    gla_prep<0>(F, A, b, h, n);
    __syncthreads();
    const int lane = F.lane, wid = F.wave, dt = wid & 1, et = wid >> 1, r32 = lane & 31, hi = lane >> 5;
    f32x16 acc = {};
#pragma unroll
    for (int ks = 0; ks < 4; ++ks) {
        const bf16x8 af = tr_frag<false>(F.lds + GL_KD, GL_KDP, 32 * dt, 16 * ks, lane), bfr = tr_frag<false>(F.lds + GL_V, GL_VP, 32 * et, 16 * ks, lane);
        acc = __builtin_amdgcn_mfma_f32_32x32x16_bf16(af, bfr, acc, 0, 0, 0);
    }
    bf16* o = STW + (((size_t)(b * 4 + h) * 32 + n) * 64 + 32 * dt) * 128 + 32 * et + r32;
#pragma unroll
    for (int r = 0; r < 16; ++r) o[(size_t)((r & 3) + 8 * (r >> 2) + 4 * hi) * 128] = (bf16)f2bf(acc[r]);
}
DI void gla_out_unit(Frame& F, const Args& A, const bf16* STW, int b, int h, int n) {
    v4u stv[2];
    { const bf16* sp = STW + ((size_t)(b * 4 + h) * 32 + n) * 64 * 128;
#pragma unroll
      for (int i = 0; i < 2; ++i) stv[i] = *(const GAS v4u*)(sp + (F.tid + i * 512) * 8); }
    __syncthreads();
    gla_prep<1>(F, A, b, h, n);
#pragma unroll
    for (int i = 0; i < 2; ++i) { const int idx = (F.tid + i * 512) * 8, dd = idx >> 7, ee = idx & 127;
        *(LAS v4u*)(F.lds + GL_ST + dd * GL_VP + ee * 2) = stv[i]; }
    __syncthreads();
    const int lane = F.lane, wid = F.wave, it = wid & 1, et = wid >> 1, r32 = lane & 31, hi = lane >> 5;
    f32x16 acc = {};
    bf16x8 qf[4];
#pragma unroll
    for (int ks = 0; ks < 4; ++ks) qf[ks] = *(const LAS bf16x8*)(F.lds + GL_QT + (2 * ks + hi) * 1024 + (32 * it + r32) * 16);
#pragma unroll
    for (int ks = 0; ks < 4; ++ks) acc = __builtin_amdgcn_mfma_f32_32x32x16_bf16(tr_frag<false>(F.lds + GL_ST, GL_VP, 32 * et, 16 * ks, lane), qf[ks], acc, 0, 0, 0);
    for (int jt = 0; jt <= it; ++jt) {
        f32x16 S = {};
#pragma unroll
        for (int ks = 0; ks < 4; ++ks) S = __builtin_amdgcn_mfma_f32_32x32x16_bf16(*(const LAS bf16x8*)(F.lds + GL_KT + (2 * ks + hi) * 1024 + (32 * jt + r32) * 16), qf[ks], S, 0, 0, 0);
        if (jt == it) {
#pragma unroll
            for (int r = 0; r < 16; ++r) S[r] = ((r & 3) + 8 * (r >> 2) + 4 * hi) <= r32 ? S[r] : 0.f;
        }
#pragma unroll
        for (int s = 0; s < 2; ++s) {
            v4u pw; pw.x = cvtpk_bf16(S[8 * s + 0], S[8 * s + 1]); pw.y = cvtpk_bf16(S[8 * s + 2], S[8 * s + 3]); pw.z = cvtpk_bf16(S[8 * s + 4], S[8 * s + 5]); pw.w = cvtpk_bf16(S[8 * s + 6], S[8 * s + 7]);
            acc = __builtin_amdgcn_mfma_f32_32x32x16_bf16(tr_frag<true>(F.lds + GL_V, GL_VP, 32 * et, 32 * jt + 16 * s, lane), __builtin_bit_cast(bf16x8, pw), acc, 0, 0, 0);
        }
    }
    float ss = 0.f;
#pragma unroll
    for (int r = 0; r < 16; ++r) ss += acc[r] * acc[r];
    { auto rr = __builtin_amdgcn_permlane32_swap(__float_as_uint(ss), __float_as_uint(ss), false, false); ss = __uint_as_float(rr[0]) + __uint_as_float(rr[1]); }
    LAS float* RED = (LAS float*)(F.lds + GL_RED);
    if (hi == 0) RED[wid * 32 + r32] = ss;
    __syncthreads();
    const float tot = RED[(it + 0) * 32 + r32] + RED[(it + 2) * 32 + r32] + RED[(it + 4) * 32 + r32] + RED[(it + 6) * 32 + r32];
    const float rs = 1.f / sqrtf(tot * (1.f / 128.f) + EPS);
    const size_t row = (size_t)b * SEQ + 64 * n + 32 * it + r32;
    const float* gg = A.in[7];
#pragma unroll
    for (int g = 0; g < 4; ++g) {
        const int e0 = 32 * et + 8 * g + 4 * hi;
        const unsigned long long ogw = *(const GAS unsigned long long*)(F_PROJ + row * N1 + POG + h * 128 + e0);
        const unsigned lo = (unsigned)ogw, hi2 = (unsigned)(ogw >> 32);
        const f32x4 gv = *(const GAS f32x4*)(gg + e0);
        const float y0 = acc[4 * g + 0] * rs * gv.x * silu_f(bflo(lo)), y1 = acc[4 * g + 1] * rs * gv.y * silu_f(bfhi(lo)), y2 = acc[4 * g + 2] * rs * gv.z * silu_f(bflo(hi2)), y3 = acc[4 * g + 3] * rs * gv.w * silu_f(bfhi(hi2));
        *(GAS unsigned long long*)(F_BUFA + row * 1024 + h * 128 + e0) = (unsigned long long)pk2(y0, y1) | ((unsigned long long)pk2(y2, y3) << 32);
    }
}
DI void xattn_unit(Frame& F, const bf16* Q, bf16* O, int b, int h, int qb) {
    const int tid = F.tid, lane = F.lane, wid = F.wave, r32 = lane & 31, hi = lane >> 5;
    const bf16* Kg = F_KV + (size_t)(b * 256) * 2048 + h * 256;
    const bf16* Vg = Kg + 1024;
    const size_t row = (size_t)b * SEQ + qb * 256 + wid * 32 + r32;
    __syncthreads();
    {
        const bf16* kp = Kg + (size_t)(tid >> 5) * 2048 + (tid & 31) * 8; LAS unsigned char* kl = F.lds + (tid & 31) * 4096 + (tid >> 5) * 16;
#pragma unroll 4
        for (int i = 0; i < 16; ++i) { *(LAS v4u*)(kl) = *(const GAS v4u*)(kp); kp += 16 * 2048; kl += 256; }
    }
    bf16x8 qf[16];
#pragma unroll
    for (int ks = 0; ks < 16; ++ks) qf[ks] = *(const GAS bf16x8*)(Q + row * 1024 + h * 256 + 16 * ks + 8 * hi);
    __syncthreads();
    f32x16 S[8];
#pragma unroll
    for (int mt = 0; mt < 8; ++mt) { S[mt] = (f32x16){};
#pragma unroll
        for (int k4 = 0; k4 < 4; ++k4) {
#pragma unroll
            for (int kk = 0; kk < 4; ++kk) { const int ks = 4 * k4 + kk; S[mt] = __builtin_amdgcn_mfma_f32_32x32x16_bf16(*(const LAS bf16x8*)(F.lds + (2 * ks + hi) * 4096 + (32 * mt + r32) * 16), qf[ks], S[mt], 0, 0, 0); }
            __builtin_amdgcn_sched_barrier(0); } }
    float mx = -INFINITY;
#pragma unroll
    for (int mt = 0; mt < 8; ++mt)
#pragma unroll
        for (int r = 0; r < 16; ++r) mx = fmaxf(mx, S[mt][r]);
    { auto rr = __builtin_amdgcn_permlane32_swap(__float_as_uint(mx), __float_as_uint(mx), false, false); mx = fmaxf(__uint_as_float(rr[0]), __uint_as_float(rr[1])); }
    const float c2 = 0.0625f * 1.4426950408889634f; const float mb = mx * c2;
    float sum = 0.f;
#pragma unroll
    for (int mt = 0; mt < 8; ++mt)
#pragma unroll
        for (int r = 0; r < 16; ++r) { const float p = __builtin_amdgcn_exp2f(S[mt][r] * c2 - mb); S[mt][r] = p; sum += p; }
    { auto rr = __builtin_amdgcn_permlane32_swap(__float_as_uint(sum), __float_as_uint(sum), false, false); sum = __uint_as_float(rr[0]) + __uint_as_float(rr[1]); }
    const float linv = 1.f / sum;
    v4u pa[16];
#pragma unroll
    for (int mt = 0; mt < 8; ++mt)
#pragma unroll
        for (int s = 0; s < 2; ++s) { v4u pw; pw.x = cvtpk_bf16(S[mt][8 * s + 0] * linv, S[mt][8 * s + 1] * linv); pw.y = cvtpk_bf16(S[mt][8 * s + 2] * linv, S[mt][8 * s + 3] * linv);
            pw.z = cvtpk_bf16(S[mt][8 * s + 4] * linv, S[mt][8 * s + 5] * linv); pw.w = cvtpk_bf16(S[mt][8 * s + 6] * linv, S[mt][8 * s + 7] * linv); pa[2 * mt + s] = pw; }
    __syncthreads();
    {
        const int c = tid & 31, m0 = tid >> 5;
        const bf16* vp = Vg + (size_t)m0 * 2048 + c * 8; LAS unsigned char* vl = F.lds + (c >> 2) * 16384 + m0 * 64 + (c & 3) * 16;
#pragma unroll 4
        for (int i = 0; i < 16; ++i) { *(LAS v4u*)(vl) = *(const GAS v4u*)(vp); vp += 16 * 2048; vl += 1024; }
    }
    __syncthreads();
    const int vfr = ((lane >> 4) & 1) * 32 + (lane & 3) * 8 + (4 * hi + ((lane & 15) >> 2)) * 64;
    unsigned opk[4][16];
#pragma unroll
    for (int dp = 0; dp < 4; ++dp) {
        f32x16 a0 = {}, a1 = {};
#pragma unroll
        for (int s = 0; s < 16; ++s) {
            const LAS unsigned char* vp0 = F.lds + (2 * dp) * 16384 + s * 1024 + vfr; const LAS unsigned char* vp1 = vp0 + 16384;
            const s16x4 l0 = lds_tr16(vp0), h0 = lds_tr16(vp0 + 512), l1 = lds_tr16(vp1), h1 = lds_tr16(vp1 + 512);
            const bf16x8 v0 = {l0[0], l0[1], l0[2], l0[3], h0[0], h0[1], h0[2], h0[3]}, v1 = {l1[0], l1[1], l1[2], l1[3], h1[0], h1[1], h1[2], h1[3]};
            a0 = __builtin_amdgcn_mfma_f32_32x32x16_bf16(__builtin_bit_cast(bf16x8, pa[s]), v0, a0, 0, 0, 0);
            a1 = __builtin_amdgcn_mfma_f32_32x32x16_bf16(__builtin_bit_cast(bf16x8, pa[s]), v1, a1, 0, 0, 0);
            if ((s & 3) == 3) __builtin_amdgcn_sched_barrier(0);
        }
#pragma unroll
        for (int r = 0; r < 16; ++r) opk[dp][r] = cvtpk_bf16(a0[r], a1[r]);
        __builtin_amdgcn_sched_barrier(0);
    }
    __syncthreads();
    LAS bf16* stg = (LAS bf16*)(F.lds + wid * 16384);
#pragma unroll
    for (int dp = 0; dp < 4; ++dp)
#pragma unroll
        for (int r = 0; r < 16; ++r) { const int rr = (r & 3) + 8 * (r >> 2) + 4 * hi; stg[rr * 256 + dp * 64 + r32] = (bf16)(opk[dp][r] & 0xffffu); stg[rr * 256 + dp * 64 + 32 + r32] = (bf16)(opk[dp][r] >> 16); }
    LDS_WAIT(); asm volatile("" ::: "memory");
    bf16* Ow = O + ((size_t)b * SEQ + qb * 256 + wid * 32) * 1024 + h * 256;
    {
        bf16* op = Ow + (size_t)(lane >> 5) * 1024 + (lane & 31) * 8; const LAS bf16* sp = stg + (lane >> 5) * 256 + (lane & 31) * 8;
#pragma unroll 4
        for (int i = 0; i < 16; ++i) { *(GAS v4u*)(op) = *(const LAS v4u*)(sp); op += 2 * 1024; sp += 2 * 256; }
    }
    LDS_WAIT(); asm volatile("" ::: "memory");
}
DI void mix_row(Frame& F, const Args& A, const float* OGLA, const float* OSB, size_t row) {
    const int lane = F.lane;
    const f32x4 a0 = *(const GAS f32x4*)(OGLA + row * 512 + 8 * lane), a1 = *(const GAS f32x4*)(OGLA + row * 512 + 8 * lane + 4);
    float s = (a0.x * a0.x + a0.y * a0.y) + (a0.z * a0.z + a0.w * a0.w) + (a1.x * a1.x + a1.y * a1.y) + (a1.z * a1.z + a1.w * a1.w);
    s += __shfl_xor(s, 1); s += __shfl_xor(s, 2); s += __shfl_xor(s, 4); s += __shfl_xor(s, 8);
    const float rs = 1.f / sqrtf(s * (1.f / 128.f) + EPS);
    const int e0 = (8 * lane) & 127;
    const f32x4 g0 = *(const GAS f32x4*)(A.in[7] + e0), g1 = *(const GAS f32x4*)(A.in[7] + e0 + 4);
    const v4u ogw = *(const GAS v4u*)(F_PROJ + row * N1 + POG + 8 * lane);
    v4u o;
    o.x = pk2(a0.x * rs * g0.x * silu_f(bflo(ogw.x)), a0.y * rs * g0.y * silu_f(bfhi(ogw.x)));
    o.y = pk2(a0.z * rs * g0.z * silu_f(bflo(ogw.y)), a0.w * rs * g0.w * silu_f(bfhi(ogw.y)));
    o.z = pk2(a1.x * rs * g1.x * silu_f(bflo(ogw.z)), a1.y * rs * g1.y * silu_f(bfhi(ogw.z)));
    o.w = pk2(a1.z * rs * g1.z * silu_f(bflo(ogw.w)), a1.w * rs * g1.w * silu_f(bfhi(ogw.w)));
    *(GAS v4u*)(F_BUFA + row * 1024 + 8 * lane) = o;
    const f32x4 b0 = *(const GAS f32x4*)(OSB + row * 512 + 8 * lane), b1 = *(const GAS f32x4*)(OSB + row * 512 + 8 * lane + 4);
    float s2 = (b0.x * b0.x + b0.y * b0.y) + (b0.z * b0.z + b0.w * b0.w) + (b1.x * b1.x + b1.y * b1.y) + (b1.z * b1.z + b1.w * b1.w);
    const float rs2 = 1.f / sqrtf(wave_sum(s2) * (1.f / 512.f) + EPS);
    const f32x4 h0 = *(const GAS f32x4*)(A.in[8] + 8 * lane), h1 = *(const GAS f32x4*)(A.in[8] + 8 * lane + 4);
    v4u p;
    p.x = pk2(b0.x * rs2 * h0.x, b0.y * rs2 * h0.y); p.y = pk2(b0.z * rs2 * h0.z, b0.w * rs2 * h0.w);
    p.z = pk2(b1.x * rs2 * h1.x, b1.y * rs2 * h1.y); p.w = pk2(b1.z * rs2 * h1.z, b1.w * rs2 * h1.w);
    *(GAS v4u*)(F_BUFA + row * 1024 + 512 + 8 * lane) = p;
}
DI void mix_row_sb(Frame& F, const Args& A, const float* OSB, size_t row) {
    const int lane = F.lane;
    const f32x4 b0 = *(const GAS f32x4*)(OSB + row * 512 + 8 * lane), b1 = *(const GAS f32x4*)(OSB + row * 512 + 8 * lane + 4);
    float s2 = (b0.x * b0.x + b0.y * b0.y) + (b0.z * b0.z + b0.w * b0.w) + (b1.x * b1.x + b1.y * b1.y) + (b1.z * b1.z + b1.w * b1.w);
    const float rs2 = 1.f / sqrtf(wave_sum(s2) * (1.f / 512.f) + EPS);
    const f32x4 h0 = *(const GAS f32x4*)(A.in[8] + 8 * lane), h1 = *(const GAS f32x4*)(A.in[8] + 8 * lane + 4);
    v4u p;
    p.x = pk2(b0.x * rs2 * h0.x, b0.y * rs2 * h0.y); p.y = pk2(b0.z * rs2 * h0.z, b0.w * rs2 * h0.w);
    p.z = pk2(b1.x * rs2 * h1.x, b1.y * rs2 * h1.y); p.w = pk2(b1.z * rs2 * h1.z, b1.w * rs2 * h1.w);
    *(GAS v4u*)(F_BUFA + row * 1024 + 512 + 8 * lane) = p;
}
DI void gla_scan(Frame& F, bf16* STW) {
    const int gt = (F.vcu * NWAVES + F.wave) * 64 + F.lane, NGT = F.G * NWAVES * 64;
    const float* dec = (const float*)(F.ctl + CW_DECAY);
    for (int idx = gt; idx < 32 * 4096; idx += NGT) {
        const int bh = idx >> 12, de = (idx & 4095) * 2, d = de >> 7;
        unsigned* p = (unsigned*)(STW + (size_t)bh * 32 * 8192 + de); const float* dp = dec + (size_t)bh * 32 * 64 + d;
        unsigned tmp[32]; float dc[32];
#pragma unroll
        for (int n = 0; n < 32; ++n) { tmp[n] = p[(size_t)n * 4096]; dc[n] = dp[n * 64]; }
        float s0 = 0.f, s1 = 0.f;
#pragma unroll
        for (int n = 0; n < 32; ++n) { p[(size_t)n * 4096] = pk2(s0, s1); s0 = dc[n] * s0 + bflo(tmp[n]); s1 = dc[n] * s1 + bfhi(tmp[n]); }
    }
}
DI void xsoftmax_row(Frame& F, bf16* S, size_t rh) {
    unsigned long long* p = (unsigned long long*)(S + rh * 256) + F.lane;
    const unsigned long long w = *p; const unsigned lo = (unsigned)w, hi = (unsigned)(w >> 32);
    const float sc = 0.0625f;
    float a = bflo(lo) * sc, b = bfhi(lo) * sc, c = bflo(hi) * sc, d = bfhi(hi) * sc;
    const float mx = wave_max(fmaxf(fmaxf(a, b), fmaxf(c, d)));
    a = __expf(a - mx); b = __expf(b - mx); c = __expf(c - mx); d = __expf(d - mx);
    const float inv = 1.f / wave_sum((a + b) + (c + d));
    *p = (unsigned long long)pk2(a * inv, b * inv) | ((unsigned long long)pk2(c * inv, d * inv) << 32);
}
DI float topk_round2(float& c0, float& c1) {
    const float w = wave_max(fmaxf(c0, c1));
    if (c0 == w) c0 = -INFINITY; if (c1 == w) c1 = -INFINITY;
    return w;
}
DI void peer_topk_item(Frame& F, const bf16* PQb, int* IDX, float* GATE, size_t row, int h) {
    const int lane = F.lane;
    float mylist[2];
#pragma unroll
    for (int p = 0; p < 2; ++p) {
        LAS unsigned* qs = (LAS unsigned*)(F.lds + F.wave * 1024);
        qs[lane] = *(const GAS unsigned*)(PQb + row * 2048 + (h * 2 + p) * 128 + 2 * lane);
        LDS_WAIT(); asm volatile("" ::: "memory");
        const bf16* kbase = F_SUBK + (size_t)((h * 2 + p) * 128) * 128;
        float s0 = 0.f, s1 = 0.f;
        const GAS v4u* k0p = (const GAS v4u*)(kbase + (size_t)lane * 128); const GAS v4u* k1p = (const GAS v4u*)(kbase + (size_t)(lane + 64) * 128);
#pragma unroll
        for (int c = 0; c < 16; ++c) {
            const v4u a = k0p[c], b = k1p[c];
            const v4u qq = *(const LAS v4u*)(qs + 4 * c); const unsigned q0 = qq.x, q1 = qq.y, q2 = qq.z, q3 = qq.w;
            s0 += bflo(a.x) * bflo(q0) + bfhi(a.x) * bfhi(q0) + bflo(a.y) * bflo(q1) + bfhi(a.y) * bfhi(q1) + bflo(a.z) * bflo(q2) + bfhi(a.z) * bfhi(q2) + bflo(a.w) * bflo(q3) + bfhi(a.w) * bfhi(q3);
            s1 += bflo(b.x) * bflo(q0) + bfhi(b.x) * bfhi(q0) + bflo(b.y) * bflo(q1) + bfhi(b.y) * bfhi(q1) + bflo(b.z) * bflo(q2) + bfhi(b.z) * bfhi(q2) + bflo(b.w) * bflo(q3) + bfhi(b.w) * bfhi(q3);
        }
        float c0 = __uint_as_float((__float_as_uint(s0) & ~0x7fu) | (unsigned)lane), c1 = __uint_as_float((__float_as_uint(s1) & ~0x7fu) | (unsigned)(lane + 64));
        float mine = 0.f;
#pragma unroll
        for (int r = 0; r < 16; ++r) { const float w = topk_round2(c0, c1); if (lane == r) mine = w; }
        mylist[p] = mine;
        LDS_WAIT(); asm volatile("" ::: "memory");
    }
    const float va = __uint_as_float(__float_as_uint(__shfl(mylist[0], lane >> 2)) & ~0x7fu);
    float cand[4];
#pragma unroll
    for (int j = 0; j < 4; ++j) { const int bb = 4 * (lane & 3) + j; const float vb = __uint_as_float(__float_as_uint(__shfl(mylist[1], bb)) & ~0x7fu);
        cand[j] = __uint_as_float((__float_as_uint(va + vb) & ~0xffu) | (unsigned)((lane >> 2) * 16 + bb)); }
    float best = 0.f, top = 0.f;
#pragma unroll
    for (int r = 0; r < 16; ++r) {
        const float w = wave_max(fmaxf(fmaxf(cand[0], cand[1]), fmaxf(cand[2], cand[3])));
#pragma unroll
        for (int j = 0; j < 4; ++j) if (cand[j] == w) cand[j] = -INFINITY;
        if (lane == r) best = w; if (r == 0) top = w;
    }
    const unsigned bu = __float_as_uint(best); const int ca = (bu >> 4) & 15, cb = bu & 15;
    const int i1 = (int)(__float_as_uint(__shfl(mylist[0], ca)) & 0x7fu), i2 = (int)(__float_as_uint(__shfl(mylist[1], cb)) & 0x7fu);
    const float sc = __uint_as_float(bu & ~0xffu), tp = __uint_as_float(__float_as_uint(top) & ~0xffu);
    const float ex = lane < 16 ? __expf(sc - tp) : 0.f;
    const float inv = 1.f / wave_sum(ex);
    if (lane < 16) { IDX[row * 128 + h * 16 + lane] = i1 * 128 + i2; GATE[row * 128 + h * 16 + lane] = ex * inv; }
}
DI float vmaxf(float a, float b) { float r; asm("v_max_f32_e32 %0, %1, %2" : "=v"(r) : "v"(a), "v"(b)); return r; }
DI float vminf(float a, float b) { float r; asm("v_min_f32_e32 %0, %1, %2" : "=v"(r) : "v"(a), "v"(b)); return r; }
DI void ins16(float (&L)[16], float x) {
#pragma unroll
    for (int i = 0; i < 16; ++i) { const float h = vmaxf(L[i], x); x = vminf(L[i], x); L[i] = h; }
}
DI void peer_topk_mfma(Frame& F, const bf16* PQb, int* IDX, float* GATE) {
    const int tid = F.tid, lane = F.lane, wid = F.wave, r32 = lane & 31, hi = lane >> 5, h = F.vcu & 7;
    __syncthreads();
    for (int i = tid; i < 2 * 128 * 16; i += 512) { const int p = i >> 11, key = (i >> 4) & 127, c = i & 15;
        *(LAS v4u*)(F.lds + p * 32768 + c * 2048 + key * 16) = *(const GAS v4u*)(F_SUBK + (size_t)((h * 2 + p) * 128 + key) * 128 + c * 8); }
    __syncthreads();
    LAS unsigned* scr = (LAS unsigned*)(F.lds + 65536 + wid * 8192) + lane;
    for (int g = (F.vcu >> 3) * 8 + wid; g < 512; g += (F.G >> 3) * 8) {
        const size_t token = (size_t)32 * g + r32;
        float LA[16], LB[16];
#pragma unroll
        for (int p = 0; p < 2; ++p) {
            float (&L)[16] = p ? LB : LA;
#pragma unroll
            for (int i = 0; i < 16; ++i) L[i] = -INFINITY;
            bf16x8 qf[8];
#pragma unroll
            for (int ks = 0; ks < 8; ++ks) qf[ks] = *(const GAS bf16x8*)(PQb + token * 2048 + (h * 2 + p) * 128 + 16 * ks + 8 * hi);
#pragma unroll
            for (int rt = 0; rt < 4; ++rt) {
                f32x16 S = {};
#pragma unroll
                for (int ks = 0; ks < 8; ++ks) S = __builtin_amdgcn_mfma_f32_32x32x16_bf16(*(const LAS bf16x8*)(F.lds + p * 32768 + (2 * ks + hi) * 2048 + (32 * rt + r32) * 16), qf[ks], S, 0, 0, 0);
#pragma unroll
                for (int r = 0; r < 16; ++r) { const unsigned key = (unsigned)(32 * rt + (r & 3) + 8 * (r >> 2)) + 4u * (unsigned)hi;
                    ins16(L, __uint_as_float((__float_as_uint(S[r]) & ~0x7fu) | key)); }
            }
            float PL[16];
#pragma unroll
            for (int i = 0; i < 16; ++i) { auto rr = __builtin_amdgcn_permlane32_swap(__float_as_uint(L[i]), __float_as_uint(L[i]), false, false); PL[i] = __uint_as_float(hi ? rr[0] : rr[1]); }
#pragma unroll
            for (int i = 0; i < 16; ++i) ins16(L, PL[i]);
        }
        float C[16];
#pragma unroll
        for (int i = 0; i < 16; ++i) C[i] = -INFINITY;
#pragma unroll
        for (int a = 0; a < 16; ++a) {
            const float va = __uint_as_float(__float_as_uint(LA[a]) & ~0x7fu);
#pragma unroll
            for (int b = 0; b < 16; ++b) if ((a + 1) * (b + 1) <= 16) {
                const float vb = __uint_as_float(__float_as_uint(LB[b]) & ~0x7fu);
                ins16(C, __uint_as_float((__float_as_uint(va + vb) & ~0xffu) | (unsigned)(a * 16 + b)));
            }
        }
#pragma unroll
        for (int i = 0; i < 16; ++i) { scr[i * 64] = __float_as_uint(LA[i]) & 0x7fu; scr[(16 + i) * 64] = __float_as_uint(LB[i]) & 0x7fu; }
        LDS_WAIT(); asm volatile("" ::: "memory");
        const float top = __uint_as_float(__float_as_uint(C[0]) & ~0xffu);
        float ex[16]; int ei[16]; float sum = 0.f;
#pragma unroll
        for (int r = 0; r < 16; ++r) { const unsigned cu = __float_as_uint(C[r]); ex[r] = __expf(__uint_as_float(cu & ~0xffu) - top); sum += ex[r];
            ei[r] = (int)(scr[((cu >> 4) & 15) * 64] * 128u + scr[(16 + (cu & 15)) * 64]); }
        const float inv = 1.f / sum;
        v4u io0, io1; f32x4 go0, go1;
        io0.x = hi ? ei[8] : ei[0]; io0.y = hi ? ei[9] : ei[1]; io0.z = hi ? ei[10] : ei[2]; io0.w = hi ? ei[11] : ei[3];
        io1.x = hi ? ei[12] : ei[4]; io1.y = hi ? ei[13] : ei[5]; io1.z = hi ? ei[14] : ei[6]; io1.w = hi ? ei[15] : ei[7];
        go0.x = (hi ? ex[8] : ex[0]) * inv; go0.y = (hi ? ex[9] : ex[1]) * inv; go0.z = (hi ? ex[10] : ex[2]) * inv; go0.w = (hi ? ex[11] : ex[3]) * inv;
        go1.x = (hi ? ex[12] : ex[4]) * inv; go1.y = (hi ? ex[13] : ex[5]) * inv; go1.z = (hi ? ex[14] : ex[6]) * inv; go1.w = (hi ? ex[15] : ex[7]) * inv;
        int* ip = IDX + token * 128 + h * 16 + 8 * hi; float* gp = GATE + token * 128 + h * 16 + 8 * hi;
        *(GAS v4u*)ip = io0; *(GAS v4u*)(ip + 4) = io1; *(GAS f32x4*)gp = go0; *(GAS f32x4*)(gp + 4) = go1;
        LDS_WAIT(); asm volatile("" ::: "memory");
    }
}
#define CE(a, b) do { const float h_ = vmaxf(a, b); const float l_ = vminf(a, b); a = h_; b = l_; } while (0)
DI void sort16_desc(float (&v)[16]) { const float h0 = vmaxf(v[0], v[1]); const float h1 = vmaxf(v[2], v[3]); const float h2 = vmaxf(v[4], v[5]); const float h3 = vmaxf(v[6], v[7]); const float h4 = vmaxf(v[8], v[9]); const float h5 = vmaxf(v[10], v[11]); const float h6 = vmaxf(v[12], v[13]); const float h7 = vmaxf(v[14], v[15]); v[1] = vminf(v[0], v[1]); v[3] = vminf(v[2], v[3]); v[5] = vminf(v[4], v[5]); v[7] = vminf(v[6], v[7]); v[9] = vminf(v[8], v[9]); v[11] = vminf(v[10], v[11]); v[13] = vminf(v[12], v[13]); v[15] = vminf(v[14], v[15]); v[0] = h0; v[2] = h1; v[4] = h2; v[6] = h3; v[8] = h4; v[10] = h5; v[12] = h6; v[14] = h7; const float h8 = vmaxf(v[0], v[2]); const float h9 = vmaxf(v[1], v[3]); const float h10 = vmaxf(v[4], v[6]); const float h11 = vmaxf(v[5], v[7]); const float h12 = vmaxf(v[8], v[10]); const float h13 = vmaxf(v[9], v[11]); const float h14 = vmaxf(v[12], v[14]); const float h15 = vmaxf(v[13], v[15]); v[2] = vminf(v[0], v[2]); v[3] = vminf(v[1], v[3]); v[6] = vminf(v[4], v[6]); v[7] = vminf(v[5], v[7]); v[10] = vminf(v[8], v[10]); v[11] = vminf(v[9], v[11]); v[14] = vminf(v[12], v[14]); v[15] = vminf(v[13], v[15]); v[0] = h8; v[1] = h9; v[4] = h10; v[5] = h11; v[8] = h12; v[9] = h13; v[12] = h14; v[13] = h15; const float h16 = vmaxf(v[1], v[2]); const float h17 = vmaxf(v[5], v[6]); const float h18 = vmaxf(v[0], v[4]); const float h19 = vmaxf(v[3], v[7]); const float h20 = vmaxf(v[9], v[10]); const float h21 = vmaxf(v[13], v[14]); const float h22 = vmaxf(v[8], v[12]); const float h23 = vmaxf(v[11], v[15]); v[2] = vminf(v[1], v[2]); v[6] = vminf(v[5], v[6]); v[4] = vminf(v[0], v[4]); v[7] = vminf(v[3], v[7]); v[10] = vminf(v[9], v[10]); v[14] = vminf(v[13], v[14]); v[12] = vminf(v[8], v[12]); v[15] = vminf(v[11], v[15]); v[1] = h16; v[5] = h17; v[0] = h18; v[3] = h19; v[9] = h20; v[13] = h21; v[8] = h22; v[11] = h23; const float h24 = vmaxf(v[2], v[6]); const float h25 = vmaxf(v[1], v[5]); const float h26 = vmaxf(v[10], v[14]); const float h27 = vmaxf(v[9], v[13]); const float h28 = vmaxf(v[0], v[8]); const float h29 = vmaxf(v[7], v[15]); v[6] = vminf(v[2], v[6]); v[5] = vminf(v[1], v[5]); v[14] = vminf(v[10], v[14]); v[13] = vminf(v[9], v[13]); v[8] = vminf(v[0], v[8]); v[15] = vminf(v[7], v[15]); v[2] = h24; v[1] = h25; v[10] = h26; v[9] = h27; v[0] = h28; v[7] = h29; const float h30 = vmaxf(v[2], v[4]); const float h31 = vmaxf(v[3], v[5]); const float h32 = vmaxf(v[10], v[12]); const float h33 = vmaxf(v[11], v[13]); v[4] = vminf(v[2], v[4]); v[5] = vminf(v[3], v[5]); v[12] = vminf(v[10], v[12]); v[13] = vminf(v[11], v[13]); v[2] = h30; v[3] = h31; v[10] = h32; v[11] = h33; const float h34 = vmaxf(v[1], v[2]); const float h35 = vmaxf(v[3], v[4]); const float h36 = vmaxf(v[5], v[6]); const float h37 = vmaxf(v[9], v[10]); const float h38 = vmaxf(v[11], v[12]); const float h39 = vmaxf(v[13], v[14]); v[2] = vminf(v[1], v[2]); v[4] = vminf(v[3], v[4]); v[6] = vminf(v[5], v[6]); v[10] = vminf(v[9], v[10]); v[12] = vminf(v[11], v[12]); v[14] = vminf(v[13], v[14]); v[1] = h34; v[3] = h35; v[5] = h36; v[9] = h37; v[11] = h38; v[13] = h39; const float h40 = vmaxf(v[4], v[12]); const float h41 = vmaxf(v[2], v[10]); const float h42 = vmaxf(v[6], v[14]); const float h43 = vmaxf(v[1], v[9]); const float h44 = vmaxf(v[5], v[13]); const float h45 = vmaxf(v[3], v[11]); v[12] = vminf(v[4], v[12]); v[10] = vminf(v[2], v[10]); v[14] = vminf(v[6], v[14]); v[9] = vminf(v[1], v[9]); v[13] = vminf(v[5], v[13]); v[11] = vminf(v[3], v[11]); v[4] = h40; v[2] = h41; v[6] = h42; v[1] = h43; v[5] = h44; v[3] = h45; const float h46 = vmaxf(v[4], v[8]); const float h47 = vmaxf(v[6], v[10]); const float h48 = vmaxf(v[5], v[9]); const float h49 = vmaxf(v[7], v[11]); v[8] = vminf(v[4], v[8]); v[10] = vminf(v[6], v[10]); v[9] = vminf(v[5], v[9]); v[11] = vminf(v[7], v[11]); v[4] = h46; v[6] = h47; v[5] = h48; v[7] = h49; const float h50 = vmaxf(v[2], v[4]); const float h51 = vmaxf(v[6], v[8]); const float h52 = vmaxf(v[10], v[12]); const float h53 = vmaxf(v[3], v[5]); const float h54 = vmaxf(v[7], v[9]); const float h55 = vmaxf(v[11], v[13]); v[4] = vminf(v[2], v[4]); v[8] = vminf(v[6], v[8]); v[12] = vminf(v[10], v[12]); v[5] = vminf(v[3], v[5]); v[9] = vminf(v[7], v[9]); v[13] = vminf(v[11], v[13]); v[2] = h50; v[6] = h51; v[10] = h52; v[3] = h53; v[7] = h54; v[11] = h55; const float h56 = vmaxf(v[1], v[2]); const float h57 = vmaxf(v[3], v[4]); const float h58 = vmaxf(v[5], v[6]); const float h59 = vmaxf(v[7], v[8]); const float h60 = vmaxf(v[9], v[10]); const float h61 = vmaxf(v[11], v[12]); const float h62 = vmaxf(v[13], v[14]); v[2] = vminf(v[1], v[2]); v[4] = vminf(v[3], v[4]); v[6] = vminf(v[5], v[6]); v[8] = vminf(v[7], v[8]); v[10] = vminf(v[9], v[10]); v[12] = vminf(v[11], v[12]); v[14] = vminf(v[13], v[14]); v[1] = h56; v[3] = h57; v[5] = h58; v[7] = h59; v[9] = h60; v[11] = h61; v[13] = h62; }
DI void bmerge16_desc(float (&v)[16]) { const float h0 = vmaxf(v[0], v[8]); const float h1 = vmaxf(v[1], v[9]); const float h2 = vmaxf(v[2], v[10]); const float h3 = vmaxf(v[3], v[11]); const float h4 = vmaxf(v[4], v[12]); const float h5 = vmaxf(v[5], v[13]); const float h6 = vmaxf(v[6], v[14]); const float h7 = vmaxf(v[7], v[15]); v[8] = vminf(v[0], v[8]); v[9] = vminf(v[1], v[9]); v[10] = vminf(v[2], v[10]); v[11] = vminf(v[3], v[11]); v[12] = vminf(v[4], v[12]); v[13] = vminf(v[5], v[13]); v[14] = vminf(v[6], v[14]); v[15] = vminf(v[7], v[15]); v[0] = h0; v[1] = h1; v[2] = h2; v[3] = h3; v[4] = h4; v[5] = h5; v[6] = h6; v[7] = h7; const float h8 = vmaxf(v[0], v[4]); const float h9 = vmaxf(v[1], v[5]); const float h10 = vmaxf(v[2], v[6]); const float h11 = vmaxf(v[3], v[7]); const float h12 = vmaxf(v[8], v[12]); const float h13 = vmaxf(v[9], v[13]); const float h14 = vmaxf(v[10], v[14]); const float h15 = vmaxf(v[11], v[15]); v[4] = vminf(v[0], v[4]); v[5] = vminf(v[1], v[5]); v[6] = vminf(v[2], v[6]); v[7] = vminf(v[3], v[7]); v[12] = vminf(v[8], v[12]); v[13] = vminf(v[9], v[13]); v[14] = vminf(v[10], v[14]); v[15] = vminf(v[11], v[15]); v[0] = h8; v[1] = h9; v[2] = h10; v[3] = h11; v[8] = h12; v[9] = h13; v[10] = h14; v[11] = h15; const float h16 = vmaxf(v[0], v[2]); const float h17 = vmaxf(v[1], v[3]); const float h18 = vmaxf(v[4], v[6]); const float h19 = vmaxf(v[5], v[7]); const float h20 = vmaxf(v[8], v[10]); const float h21 = vmaxf(v[9], v[11]); const float h22 = vmaxf(v[12], v[14]); const float h23 = vmaxf(v[13], v[15]); v[2] = vminf(v[0], v[2]); v[3] = vminf(v[1], v[3]); v[6] = vminf(v[4], v[6]); v[7] = vminf(v[5], v[7]); v[10] = vminf(v[8], v[10]); v[11] = vminf(v[9], v[11]); v[14] = vminf(v[12], v[14]); v[15] = vminf(v[13], v[15]); v[0] = h16; v[1] = h17; v[4] = h18; v[5] = h19; v[8] = h20; v[9] = h21; v[12] = h22; v[13] = h23; const float h24 = vmaxf(v[0], v[1]); const float h25 = vmaxf(v[2], v[3]); const float h26 = vmaxf(v[4], v[5]); const float h27 = vmaxf(v[6], v[7]); const float h28 = vmaxf(v[8], v[9]); const float h29 = vmaxf(v[10], v[11]); const float h30 = vmaxf(v[12], v[13]); const float h31 = vmaxf(v[14], v[15]); v[1] = vminf(v[0], v[1]); v[3] = vminf(v[2], v[3]); v[5] = vminf(v[4], v[5]); v[7] = vminf(v[6], v[7]); v[9] = vminf(v[8], v[9]); v[11] = vminf(v[10], v[11]); v[13] = vminf(v[12], v[13]); v[15] = vminf(v[14], v[15]); v[0] = h24; v[2] = h25; v[4] = h26; v[6] = h27; v[8] = h28; v[10] = h29; v[12] = h30; v[14] = h31; }
#undef CE
template <int NV> DI void merge_top16(float (&L)[16], const float (&N)[NV]) {
#pragma unroll
    for (int i = 16 - NV; i < 16; ++i) L[i] = vmaxf(L[i], N[15 - i]);
    bmerge16_desc(L);
}
DI float pack_cand(float s, int id) { return __uint_as_float((__float_as_uint(s) & ~0xffu) | (unsigned)(255 - id)); }
DI void peer_topk_mfma2(Frame& F, const bf16* PQb, int* IDX, float* GATE) {
    const int tid = F.tid, lane = F.lane, wid = F.wave, r32 = lane & 31, hi = lane >> 5, h = F.vcu & 7;
    __syncthreads();
    {
        v4u kw[8];
#pragma unroll
        for (int j = 0; j < 8; ++j) { const int i = tid + 512 * j, p = i >> 11, key = (i >> 4) & 127, c = i & 15; kw[j] = *(const GAS v4u*)(F_SUBK + (size_t)((h * 2 + p) * 128 + key) * 128 + c * 8); }
#pragma unroll
        for (int j = 0; j < 8; ++j) { const int i = tid + 512 * j, p = i >> 11, key = (i >> 4) & 127, c = i & 15; *(LAS v4u*)(F.lds + p * 32768 + c * 2048 + key * 16) = kw[j]; }
    }
    __syncthreads();
    LAS unsigned* scr = (LAS unsigned*)(F.lds + 65536 + wid * 8192) + lane;
    const int g0 = (F.vcu >> 3) * 8 + wid, gstep = (F.G >> 3) * 8;
    bf16x8 qf[8];
#pragma unroll
    for (int ks = 0; ks < 8; ++ks) qf[ks] = *(const GAS bf16x8*)(PQb + ((size_t)32 * g0 + r32) * 2048 + (h * 2) * 128 + 16 * ks + 8 * hi);
    for (int g = g0; g < 512; g += gstep) {
        const size_t token = (size_t)32 * g + r32;
        float LA[16], LB[16];
#pragma unroll
        for (int p = 0; p < 2; ++p) {
            float (&L)[16] = p ? LB : LA;
            f32x16 S[4];
#pragma unroll
            for (int rt = 0; rt < 4; ++rt) { S[rt] = (f32x16){};
#pragma unroll
                for (int ks = 0; ks < 8; ++ks) S[rt] = __builtin_amdgcn_mfma_f32_32x32x16_bf16(*(const LAS bf16x8*)(F.lds + p * 32768 + (2 * ks + hi) * 2048 + (32 * rt + r32) * 16), qf[ks], S[rt], 0, 0, 0); }
            __builtin_amdgcn_sched_barrier(0);
            {
                const int gn = p ? (g + gstep < 512 ? g + gstep : g) : g; const int pn = p ? 0 : 1;
#pragma unroll
                for (int ks = 0; ks < 8; ++ks) qf[ks] = *(const GAS bf16x8*)(PQb + ((size_t)32 * gn + r32) * 2048 + (h * 2 + pn) * 128 + 16 * ks + 8 * hi);
            }
            __builtin_amdgcn_sched_barrier(0);
#pragma unroll
            for (int rt = 0; rt < 4; ++rt) {
                float v[16];
#pragma unroll
                for (int r = 0; r < 16; ++r) { const unsigned key = (unsigned)(32 * rt + (r & 3) + 8 * (r >> 2)) + 4u * (unsigned)hi; v[r] = __uint_as_float((__float_as_uint(S[rt][r]) & ~0x7fu) | key); }
                sort16_desc(v);
                if (rt == 0) {
#pragma unroll
                    for (int i = 0; i < 16; ++i) L[i] = v[i];
                } else merge_top16<16>(L, v);
            }
            float PL[16];
#pragma unroll
            for (int i = 0; i < 16; ++i) { auto rr = __builtin_amdgcn_permlane32_swap(__float_as_uint(L[i]), __float_as_uint(L[i]), false, false); PL[i] = __uint_as_float(hi ? rr[0] : rr[1]); }
            merge_top16<16>(L, PL);
        }
#pragma unroll
        for (int i = 0; i < 16; ++i) { scr[i * 64] = __float_as_uint(LA[i]) & 0x7fu; scr[(16 + i) * 64] = __float_as_uint(LB[i]) & 0x7fu; }
        float VA[16], VB[16];
#pragma unroll
        for (int i = 0; i < 16; ++i) { VA[i] = __uint_as_float(__float_as_uint(LA[i]) & ~0x7fu); VB[i] = __uint_as_float(__float_as_uint(LB[i]) & ~0x7fu); }
        float C[16];
#pragma unroll
        for (int b = 0; b < 16; ++b) C[b] = pack_cand(VA[0] + VB[b], b);
        { float R[8];
#pragma unroll
          for (int b = 0; b < 8; ++b) R[b] = pack_cand(VA[1] + VB[b], 16 + b);
          merge_top16<8>(C, R); }
        { float R[5];
#pragma unroll
          for (int b = 0; b < 5; ++b) R[b] = pack_cand(VA[2] + VB[b], 32 + b);
          merge_top16<5>(C, R); }
        { float R[4];
#pragma unroll
          for (int b = 0; b < 4; ++b) R[b] = pack_cand(VA[3] + VB[b], 48 + b);
          merge_top16<4>(C, R); }
        { float R[3];
#pragma unroll
          for (int b = 0; b < 3; ++b) R[b] = pack_cand(VA[4] + VB[b], 64 + b);
          merge_top16<3>(C, R); }
        { float R[11];
#pragma unroll
          for (int i = 0; i < 11; ++i) R[i] = pack_cand(VA[5 + i] + VB[0], (5 + i) * 16);
          merge_top16<11>(C, R); }
        { float R[3];
#pragma unroll
          for (int i = 0; i < 3; ++i) R[i] = pack_cand(VA[5 + i] + VB[1], (5 + i) * 16 + 1);
          merge_top16<3>(C, R); }
        LDS_WAIT(); asm volatile("" ::: "memory");
        const float top = __uint_as_float(__float_as_uint(C[0]) & ~0xffu);
        float ex[16]; int ei[16]; float sum = 0.f;
#pragma unroll
        for (int r = 0; r < 16; ++r) { const unsigned cu = __float_as_uint(C[r]), id = 255u - (cu & 0xffu); ex[r] = __expf(__uint_as_float(cu & ~0xffu) - top); sum += ex[r];
            ei[r] = (int)(scr[(id >> 4) * 64] * 128u + scr[(16 + (id & 15)) * 64]); }
        const float inv = 1.f / sum;
        v4u io0, io1; f32x4 go0, go1;
        io0.x = hi ? ei[8] : ei[0]; io0.y = hi ? ei[9] : ei[1]; io0.z = hi ? ei[10] : ei[2]; io0.w = hi ? ei[11] : ei[3];
        io1.x = hi ? ei[12] : ei[4]; io1.y = hi ? ei[13] : ei[5]; io1.z = hi ? ei[14] : ei[6]; io1.w = hi ? ei[15] : ei[7];
        go0.x = (hi ? ex[8] : ex[0]) * inv; go0.y = (hi ? ex[9] : ex[1]) * inv; go0.z = (hi ? ex[10] : ex[2]) * inv; go0.w = (hi ? ex[11] : ex[3]) * inv;
        go1.x = (hi ? ex[12] : ex[4]) * inv; go1.y = (hi ? ex[13] : ex[5]) * inv; go1.z = (hi ? ex[14] : ex[6]) * inv; go1.w = (hi ? ex[15] : ex[7]) * inv;
        int* ip = IDX + token * 128 + h * 16 + 8 * hi; float* gp = GATE + token * 128 + h * 16 + 8 * hi;
        *(GAS v4u*)ip = io0; *(GAS v4u*)(ip + 4) = io1; *(GAS f32x4*)gp = go0; *(GAS f32x4*)(gp + 4) = go1;
        LDS_WAIT(); asm volatile("" ::: "memory");
    }
}
DI void peer_gather_row(Frame& F, const Args& A, const bf16* XN2, const int* IDX, const float* GATE, size_t row) {
    const int lane = F.lane;
    const v4u xa = *(const GAS v4u*)(XN2 + row * 1024 + 8 * lane), xb = *(const GAS v4u*)(XN2 + row * 1024 + 512 + 8 * lane);
    const int id0 = IDX[row * 128 + lane], id1 = IDX[row * 128 + 64 + lane];
    const float g0 = GATE[row * 128 + lane], g1 = GATE[row * 128 + 64 + lane];
    float acc[16];
#pragma unroll
    for (int i = 0; i < 16; ++i) acc[i] = 0.f;
#define PEER_DOT2(w, x, a) dot2_bf16((w), (x), (a))
    for (int half = 0; half < 2; ++half) {
        const int idv = half ? id1 : id0; const float gv = half ? g1 : g0;
        for (int e0 = 0; e0 < 64; e0 += 4) {
            v4u ua[4], ub[4], va[4], vb[4]; float gt[4];
#pragma unroll
            for (int j = 0; j < 4; ++j) {
                const int id = __builtin_amdgcn_readlane(idv, e0 + j); gt[j] = __uint_as_float(__builtin_amdgcn_readlane(__float_as_uint(gv), e0 + j));
                const bf16* up = F_UB + (size_t)id * 1024; const bf16* vp = F_VB + (size_t)id * 1024;
                ua[j] = *(const GAS v4u*)(up + 8 * lane); ub[j] = *(const GAS v4u*)(up + 512 + 8 * lane);
                va[j] = *(const GAS v4u*)(vp + 8 * lane); vb[j] = *(const GAS v4u*)(vp + 512 + 8 * lane);
            }
#pragma unroll
            for (int j = 0; j < 4; ++j) {
                float d0 = 0.f, d1 = 0.f;
                d0 = PEER_DOT2(ua[j].x, xa.x, d0); d1 = PEER_DOT2(ua[j].y, xa.y, d1); d0 = PEER_DOT2(ua[j].z, xa.z, d0); d1 = PEER_DOT2(ua[j].w, xa.w, d1);
                d0 = PEER_DOT2(ub[j].x, xb.x, d0); d1 = PEER_DOT2(ub[j].y, xb.y, d1); d0 = PEER_DOT2(ub[j].z, xb.z, d0); d1 = PEER_DOT2(ub[j].w, xb.w, d1);
                const float a = wave_sum(d0 + d1);
                const float cf = gt[j] * gelu_tanh_f(a);
                acc[0] += cf * bflo(va[j].x); acc[1] += cf * bfhi(va[j].x); acc[2] += cf * bflo(va[j].y); acc[3] += cf * bfhi(va[j].y);
                acc[4] += cf * bflo(va[j].z); acc[5] += cf * bfhi(va[j].z); acc[6] += cf * bflo(va[j].w); acc[7] += cf * bfhi(va[j].w);
                acc[8] += cf * bflo(vb[j].x); acc[9] += cf * bfhi(vb[j].x); acc[10] += cf * bflo(vb[j].y); acc[11] += cf * bfhi(vb[j].y);
                acc[12] += cf * bflo(vb[j].z); acc[13] += cf * bfhi(vb[j].z); acc[14] += cf * bflo(vb[j].w); acc[15] += cf * bfhi(vb[j].w);
            }
        }
    }
#undef PEER_DOT2
    float* hp = F.out + row * 1024;
    f32x4 y[4]; const int c0 = 8 * lane, c1 = 512 + 8 * lane;
    y[0] = *(const GAS f32x4*)(hp + c0); y[1] = *(const GAS f32x4*)(hp + c0 + 4); y[2] = *(const GAS f32x4*)(hp + c1); y[3] = *(const GAS f32x4*)(hp + c1 + 4);
    float ss = 0.f;
#pragma unroll
    for (int i = 0; i < 4; ++i) { y[i].x += acc[4 * i]; y[i].y += acc[4 * i + 1]; y[i].z += acc[4 * i + 2]; y[i].w += acc[4 * i + 3]; ss += (y[i].x * y[i].x + y[i].y * y[i].y) + (y[i].z * y[i].z + y[i].w * y[i].w); }
    const float rs = 1.f / sqrtf(wave_sum(ss) * (1.f / 1024.f) + EPS);
    const f32x4 g0v = *(const GAS f32x4*)(A.in[20] + c0), g1v = *(const GAS f32x4*)(A.in[20] + c0 + 4), g2v = *(const GAS f32x4*)(A.in[20] + c1), g3v = *(const GAS f32x4*)(A.in[20] + c1 + 4);
    *(GAS f32x4*)(hp + c0) = y[0] * rs * g0v; *(GAS f32x4*)(hp + c0 + 4) = y[1] * rs * g1v; *(GAS f32x4*)(hp + c1) = y[2] * rs * g2v; *(GAS f32x4*)(hp + c1 + 4) = y[3] * rs * g3v;
}
template <int TPW> DI void peer_gather_sweep(Frame& F, const Args& A, const int* IDX, const float* GATE, size_t tok0) {
    const int lane = F.lane;
    const unsigned char* U8 = F.ws + WS_U8; const unsigned char* V8 = F.ws + WS_V8; const unsigned char* X8 = F.ws + WS_X8;
    const float* SU = (const float*)(F.ws + WS_SU); const float* SX = (const float*)(F.ws + WS_SX);
    f32x2 acc[TPW][8]; v4u xq[TPW]; int idlo[TPW], idhi[TPW]; float glo[TPW], ghi[TPW], sxv[TPW];
#pragma unroll
    for (int tl = 0; tl < TPW; ++tl) {
        const size_t t = tok0 + tl;
#pragma unroll
        for (int i = 0; i < 8; ++i) acc[tl][i] = (f32x2){0.f, 0.f};
        xq[tl] = *(const GAS v4u*)(X8 + t * 1024 + 16 * lane);
        idlo[tl] = IDX[t * 128 + lane]; idhi[tl] = IDX[t * 128 + 64 + lane]; glo[tl] = GATE[t * 128 + lane]; ghi[tl] = GATE[t * 128 + 64 + lane];
        sxv[tl] = SX[t] * (1.f / 64.f);
    }
    const int l3 = lane & 3; const bool b0 = lane & 1, b1 = lane & 2;
    for (int s = 0; s < 32; ++s) {
#pragma unroll
        for (int tl = 0; tl < TPW; ++tl) {
            unsigned long long mlo = __ballot((idlo[tl] >> 9) == s), mhi = __ballot((idhi[tl] >> 9) == s);
            while (mlo | mhi) {
                int id[4]; float g[4];
#pragma unroll
                for (int j = 0; j < 4; ++j) {
                    if (mlo) { const int e = __builtin_ctzll(mlo); mlo &= mlo - 1; id[j] = __builtin_amdgcn_readlane(idlo[tl], e); g[j] = __uint_as_float(__builtin_amdgcn_readlane(__float_as_uint(glo[tl]), e)); }
                    else if (mhi) { const int e = __builtin_ctzll(mhi); mhi &= mhi - 1; id[j] = __builtin_amdgcn_readlane(idhi[tl], e); g[j] = __uint_as_float(__builtin_amdgcn_readlane(__float_as_uint(ghi[tl]), e)); }
                    else { id[j] = id[0]; g[j] = 0.f; }
                }
                v4u uu[4], vv[4]; float su[4]; int p[4];
#pragma unroll
                for (int j = 0; j < 4; ++j) { uu[j] = *(const GAS v4u*)(U8 + (size_t)id[j] * 1024 + 16 * lane); vv[j] = *(const GAS v4u*)(V8 + (size_t)id[j] * 1024 + 16 * lane); su[j] = SU[id[j]]; }
#pragma unroll
                for (int j = 0; j < 4; ++j) { int d = __builtin_amdgcn_sdot4((int)uu[j].x, (int)xq[tl].x, 0, false); d = __builtin_amdgcn_sdot4((int)uu[j].y, (int)xq[tl].y, d, false);
                    d = __builtin_amdgcn_sdot4((int)uu[j].z, (int)xq[tl].z, d, false); p[j] = __builtin_amdgcn_sdot4((int)uu[j].w, (int)xq[tl].w, d, false); }
                const int kA = b0 ? p[1] : p[0], sA = b0 ? p[0] : p[1], kB = b0 ? p[3] : p[2], sB = b0 ? p[2] : p[3];
                const int qA = kA + dpp_i<0xB1>(sA), qB = kB + dpp_i<0xB1>(sB);
                const int kk = b1 ? qB : qA, ss = b1 ? qA : qB;
                int r = kk + dpp_i<0x4E>(ss);
                r += dpp_i<0x124>(r); r += dpp_i<0x128>(r);
                r += __shfl_xor(r, 16); r += __shfl_xor(r, 32);
                const float sus = l3 == 0 ? su[0] : l3 == 1 ? su[1] : l3 == 2 ? su[2] : su[3];
                const float gs = l3 == 0 ? g[0] : l3 == 1 ? g[1] : l3 == 2 ? g[2] : g[3];
                const float a = (float)r * sus * (sxv[tl] * 64.f);
                const float cfl = gs * gelu_tanh_f(a) * (1.f / 64.f);
#pragma unroll
                for (int j = 0; j < 4; ++j) {
                    const float cf = __uint_as_float(__builtin_amdgcn_readlane(__float_as_uint(cfl), j)); const f32x2 c2 = {cf, cf};
#pragma unroll
                    for (int w = 0; w < 4; ++w) { acc[tl][2 * w] = __builtin_amdgcn_cvt_pk_f32_fp8((int)vv[j][w], false) * c2 + acc[tl][2 * w]; acc[tl][2 * w + 1] = __builtin_amdgcn_cvt_pk_f32_fp8((int)vv[j][w], true) * c2 + acc[tl][2 * w + 1]; }
                }
            }
        }
    }
#pragma unroll
    for (int tl = 0; tl < TPW; ++tl) {
        float* hp = F.out + (tok0 + tl) * 1024 + 16 * lane;
        f32x4 y[4]; float ssq = 0.f;
#pragma unroll
        for (int i = 0; i < 4; ++i) { y[i] = *(const GAS f32x4*)(hp + 4 * i); y[i].x += acc[tl][2 * i].x; y[i].y += acc[tl][2 * i].y; y[i].z += acc[tl][2 * i + 1].x; y[i].w += acc[tl][2 * i + 1].y;
            ssq += (y[i].x * y[i].x + y[i].y * y[i].y) + (y[i].z * y[i].z + y[i].w * y[i].w); }
        const float rs = 1.f / sqrtf(wave_sum(ssq) * (1.f / 1024.f) + EPS);
#pragma unroll
        for (int i = 0; i < 4; ++i) { const f32x4 gv = *(const GAS f32x4*)(A.in[20] + 16 * lane + 4 * i); *(GAS f32x4*)(hp + 4 * i) = y[i] * rs * gv; }
    }
}
constexpr int GL3_LIST = 0, GL3_X = 65536;
struct G3Buf { v4u uu[4], vv[4], xx[4]; };
template <int TPW> DI void g3_issue(G3Buf& B, v4u& E, const LAS unsigned char* list, const LAS unsigned char* xl, const unsigned char* U8, const unsigned char* V8, int b, int lane) {
    E = *(const LAS v4u*)(list + (4 * b + (lane & 3)) * 16);
#pragma unroll
    for (int j = 0; j < 4; ++j) {
        const unsigned w = (unsigned)__builtin_amdgcn_readlane((int)E.x, j); const unsigned id = w & 0xffffu, tl = w >> 16;
        B.uu[j] = *(const GAS v4u*)(U8 + (size_t)id * 1024 + 16 * lane); B.vv[j] = *(const GAS v4u*)(V8 + (size_t)id * 1024 + 16 * lane);
        B.xx[j] = *(const LAS v4u*)(xl + tl * 1024 + 16 * lane);
    }
}
template <int TPW> DI void g3_compute(f32x2 (&acc)[TPW][8], const G3Buf& B, const v4u& E, int lane) {
    int p[4];
#pragma unroll
    for (int j = 0; j < 4; ++j) { int d = __builtin_amdgcn_sdot4((int)B.uu[j].x, (int)B.xx[j].x, 0, false); d = __builtin_amdgcn_sdot4((int)B.uu[j].y, (int)B.xx[j].y, d, false);
        d = __builtin_amdgcn_sdot4((int)B.uu[j].z, (int)B.xx[j].z, d, false); p[j] = __builtin_amdgcn_sdot4((int)B.uu[j].w, (int)B.xx[j].w, d, false); }
    const bool b0 = lane & 1, b1 = lane & 2;
    const int kA = b0 ? p[1] : p[0], sA = b0 ? p[0] : p[1], kB = b0 ? p[3] : p[2], sB = b0 ? p[2] : p[3];
    const int qA = kA + dpp_i<0xB1>(sA), qB = kB + dpp_i<0xB1>(sB);
    const int kk = b1 ? qB : qA, ss = b1 ? qA : qB;
    int r = kk + dpp_i<0x4E>(ss);
    r += dpp_i<0x124>(r); r += dpp_i<0x128>(r);
    r += __shfl_xor(r, 16); r += __shfl_xor(r, 32);
    const float a = (float)r * __uint_as_float(E.z);
    const float cfl = __uint_as_float(E.y) * gelu_tanh_f(a);
#pragma unroll
    for (int j = 0; j < 4; ++j) {
        const float cf = __uint_as_float(__builtin_amdgcn_readlane(__float_as_uint(cfl), j)); const f32x2 c2 = {cf, cf};
        const unsigned tl = (unsigned)__builtin_amdgcn_readlane((int)E.x, j) >> 16;
#pragma unroll
        for (int t = 0; t < TPW; ++t) if (tl == (unsigned)t) { asm volatile("; acc case %0" :: "n"(t));
#pragma unroll
            for (int w = 0; w < 4; ++w) { acc[t][2 * w] = __builtin_amdgcn_cvt_pk_f32_fp8((int)B.vv[j][w], false) * c2 + acc[t][2 * w]; acc[t][2 * w + 1] = __builtin_amdgcn_cvt_pk_f32_fp8((int)B.vv[j][w], true) * c2 + acc[t][2 * w + 1]; }
            asm volatile("; acc case %0 end" :: "n"(t));
        }
    }
}
template <int TPW> DI void peer_gather_sweep3(Frame& F, const Args& A, const int* IDX, const float* GATE, size_t tok0) {
    const int lane = F.lane, wid = F.wave;
    const unsigned char* U8 = F.ws + WS_U8; const unsigned char* V8 = F.ws + WS_V8; const unsigned char* X8 = F.ws + WS_X8;
    const float* SU = (const float*)(F.ws + WS_SU); const float* SX = (const float*)(F.ws + WS_SX);
    LAS unsigned char* list = F.lds + GL3_LIST + wid * (TPW * 2048); LAS unsigned char* xl = F.lds + GL3_X + wid * (TPW * 1024);
    {
        int idlo[TPW], idhi[TPW]; float glo[TPW], ghi[TPW], slo[TPW], shi[TPW];
#pragma unroll
        for (int tl = 0; tl < TPW; ++tl) { const size_t t = tok0 + tl;
            *(LAS v4u*)(xl + tl * 1024 + 16 * lane) = *(const GAS v4u*)(X8 + t * 1024 + 16 * lane);
            idlo[tl] = IDX[t * 128 + lane]; idhi[tl] = IDX[t * 128 + 64 + lane]; const float sx = SX[t];
            glo[tl] = GATE[t * 128 + lane] * (1.f / 64.f); ghi[tl] = GATE[t * 128 + 64 + lane] * (1.f / 64.f);
            slo[tl] = SU[idlo[tl]] * sx; shi[tl] = SU[idhi[tl]] * sx; }
        int base = 0;
        for (int s = 0; s < 32; ++s) {
#pragma unroll
            for (int tl = 0; tl < TPW; ++tl) {
                { const bool m = (idlo[tl] >> 9) == s; const unsigned long long mk = __ballot(m); const int pos = base + (int)__builtin_amdgcn_mbcnt_hi((unsigned)(mk >> 32), __builtin_amdgcn_mbcnt_lo((unsigned)mk, 0u));
                  if (m) *(LAS v4u*)(list + pos * 16) = (v4u){(unsigned)idlo[tl] | ((unsigned)tl << 16), __float_as_uint(glo[tl]), __float_as_uint(slo[tl]), 0u};
                  base += __builtin_popcountll(mk); }
                { const bool m = (idhi[tl] >> 9) == s; const unsigned long long mk = __ballot(m); const int pos = base + (int)__builtin_amdgcn_mbcnt_hi((unsigned)(mk >> 32), __builtin_amdgcn_mbcnt_lo((unsigned)mk, 0u));
                  if (m) *(LAS v4u*)(list + pos * 16) = (v4u){(unsigned)idhi[tl] | ((unsigned)tl << 16), __float_as_uint(ghi[tl]), __float_as_uint(shi[tl]), 0u};
                  base += __builtin_popcountll(mk); }
            }
        }
    }
    LDS_WAIT(); asm volatile("" ::: "memory");
    f32x2 acc[TPW][8];
#pragma unroll
    for (int tl = 0; tl < TPW; ++tl)
#pragma unroll
        for (int i = 0; i < 8; ++i) acc[tl][i] = (f32x2){0.f, 0.f};
    constexpr int NB = TPW * 32;
    G3Buf BA, BB; v4u EA, EB;
    g3_issue<TPW>(BA, EA, list, xl, U8, V8, 0, lane);
    for (int b = 0; b < NB; b += 2) {
        g3_issue<TPW>(BB, EB, list, xl, U8, V8, b + 1, lane);
        g3_compute<TPW>(acc, BA, EA, lane);
        g3_issue<TPW>(BA, EA, list, xl, U8, V8, (b + 2 < NB) ? b + 2 : NB - 1, lane);
        g3_compute<TPW>(acc, BB, EB, lane);
    }
#pragma unroll
    for (int tl = 0; tl < TPW; ++tl) {
        float* hp = F.out + (tok0 + tl) * 1024 + 16 * lane;
        f32x4 y[4]; float ssq = 0.f;
#pragma unroll
        for (int i = 0; i < 4; ++i) { y[i] = *(const GAS f32x4*)(hp + 4 * i); y[i].x += acc[tl][2 * i].x; y[i].y += acc[tl][2 * i].y; y[i].z += acc[tl][2 * i + 1].x; y[i].w += acc[tl][2 * i + 1].y;
            ssq += (y[i].x * y[i].x + y[i].y * y[i].y) + (y[i].z * y[i].z + y[i].w * y[i].w); }
        const float rs = 1.f / sqrtf(wave_sum(ssq) * (1.f / 1024.f) + EPS);
#pragma unroll
        for (int i = 0; i < 4; ++i) { const f32x4 gv = *(const GAS f32x4*)(A.in[20] + 16 * lane + 4 * i); *(GAS f32x4*)(hp + 4 * i) = y[i] * rs * gv; }
    }
    LDS_WAIT(); asm volatile("" ::: "memory");
}
constexpr int G5_NSH = 16, G5_SHIFT = 10;
struct G5Buf { v4u uu[4], vv[4]; };
DI void g5_issue(G5Buf& B, v4u& E, const LAS unsigned char* tlist, const unsigned char* U8, const unsigned char* V8, int k, int lane) {
    E = *(const LAS v4u*)(tlist + (4 * k + (lane & 3)) * 16);
#pragma unroll
    for (int j = 0; j < 4; ++j) {
        const unsigned id = (unsigned)__builtin_amdgcn_readlane((int)E.x, j);
        B.uu[j] = *(const GAS v4u*)(U8 + (size_t)id * 1024 + 16 * lane); B.vv[j] = *(const GAS v4u*)(V8 + (size_t)id * 1024 + 16 * lane);
    }
}
DI void g5_compute(f32x2 (&acc)[8], const v4u& xx, const G5Buf& B, const v4u& E, int lane) {
    int p[4];
#pragma unroll
    for (int j = 0; j < 4; ++j) { int d = __builtin_amdgcn_sdot4((int)B.uu[j].x, (int)xx.x, 0, false); d = __builtin_amdgcn_sdot4((int)B.uu[j].y, (int)xx.y, d, false);
        d = __builtin_amdgcn_sdot4((int)B.uu[j].z, (int)xx.z, d, false); p[j] = __builtin_amdgcn_sdot4((int)B.uu[j].w, (int)xx.w, d, false); }
    const bool b0 = lane & 1, b1 = lane & 2;
    const int kA = b0 ? p[1] : p[0], sA = b0 ? p[0] : p[1], kB = b0 ? p[3] : p[2], sB = b0 ? p[2] : p[3];
    const int qA = kA + dpp_i<0xB1>(sA), qB = kB + dpp_i<0xB1>(sB);
    const int kk = b1 ? qB : qA, ss = b1 ? qA : qB;
    int r = kk + dpp_i<0x4E>(ss);
    r += dpp_i<0x124>(r); r += dpp_i<0x128>(r);
    r += __shfl_xor(r, 16); r += __shfl_xor(r, 32);
    const float a = (float)r * __uint_as_float(E.z);
    const float y = 0.7978845608028654f * (a + 0.044715f * a * a * a);
    const float th = 1.f - 2.f * __builtin_amdgcn_rcpf(1.f + __expf(2.f * y));
    const float cfl = __uint_as_float(E.y) * 0.5f * a * (1.f + th);
#pragma unroll
    for (int j = 0; j < 4; ++j) { const float cf = __uint_as_float(__builtin_amdgcn_readlane(__float_as_uint(cfl), j)); const f32x2 c2 = {cf, cf};
#pragma unroll
        for (int w = 0; w < 4; ++w) { acc[2 * w] = __builtin_amdgcn_cvt_pk_f32_fp8((int)B.vv[j][w], false) * c2 + acc[2 * w]; acc[2 * w + 1] = __builtin_amdgcn_cvt_pk_f32_fp8((int)B.vv[j][w], true) * c2 + acc[2 * w + 1]; } }
}
DI void peer_gather_sweep5(Frame& F, const Args& A, const int* IDX, const float* GATE, size_t tok0) {
    constexpr int TPW = 4;
    const int lane = F.lane, wid = F.wave;
    const unsigned char* U8 = F.ws + WS_U8; const unsigned char* V8 = F.ws + WS_V8; const unsigned char* X8 = F.ws + WS_X8;
    const float* SU = (const float*)(F.ws + WS_SU); const float* SX = (const float*)(F.ws + WS_SX);
    LAS unsigned char* list = F.lds + wid * (TPW * 2048);
    v4u xq[TPW];
#pragma unroll
    for (int tl = 0; tl < TPW; ++tl) {
        const size_t t = tok0 + tl;
        xq[tl] = *(const GAS v4u*)(X8 + t * 1024 + 16 * lane);
        const int idlo = IDX[t * 128 + lane], idhi = IDX[t * 128 + 64 + lane]; const float sx = SX[t];
        const float glo = GATE[t * 128 + lane] * (1.f / 64.f), ghi = GATE[t * 128 + 64 + lane] * (1.f / 64.f);
        const float slo = SU[idlo] * sx, shi = SU[idhi] * sx;
        LAS unsigned char* tl_list = list + tl * 2048;
        int base = 0;
        for (int s = 0; s < G5_NSH; ++s) {
            { const bool m = (idlo >> G5_SHIFT) == s; const unsigned long long mk = __ballot(m); const int pos = base + (int)__builtin_amdgcn_mbcnt_hi((unsigned)(mk >> 32), __builtin_amdgcn_mbcnt_lo((unsigned)mk, 0u));
              if (m) *(LAS v4u*)(tl_list + pos * 16) = (v4u){(unsigned)idlo, __float_as_uint(glo), __float_as_uint(slo), 0u};
              base += __builtin_popcountll(mk); }
            { const bool m = (idhi >> G5_SHIFT) == s; const unsigned long long mk = __ballot(m); const int pos = base + (int)__builtin_amdgcn_mbcnt_hi((unsigned)(mk >> 32), __builtin_amdgcn_mbcnt_lo((unsigned)mk, 0u));
              if (m) *(LAS v4u*)(tl_list + pos * 16) = (v4u){(unsigned)idhi, __float_as_uint(ghi), __float_as_uint(shi), 0u};
              base += __builtin_popcountll(mk); }
        }
    }
    LDS_WAIT(); asm volatile("" ::: "memory");
    f32x2 acc[TPW][8];
#pragma unroll
    for (int tl = 0; tl < TPW; ++tl)
#pragma unroll
        for (int i = 0; i < 8; ++i) acc[tl][i] = (f32x2){0.f, 0.f};
    G5Buf BA, BB; v4u EA, EB;
    g5_issue(BA, EA, list, U8, V8, 0, lane);
    for (int k = 0; k < 32; ++k) {
        g5_issue(BB, EB, list + 2048, U8, V8, k, lane);      g5_compute(acc[0], xq[0], BA, EA, lane);
        g5_issue(BA, EA, list + 4096, U8, V8, k, lane);      g5_compute(acc[1], xq[1], BB, EB, lane);
        g5_issue(BB, EB, list + 6144, U8, V8, k, lane);      g5_compute(acc[2], xq[2], BA, EA, lane);
        g5_issue(BA, EA, list, U8, V8, k < 31 ? k + 1 : 31, lane);   g5_compute(acc[3], xq[3], BB, EB, lane);
    }
#pragma unroll
    for (int tl = 0; tl < TPW; ++tl) {
        float* hp = F.out + (tok0 + tl) * 1024 + 16 * lane;
        f32x4 y[4]; float ssq = 0.f;
#pragma unroll
        for (int i = 0; i < 4; ++i) { y[i] = *(const GAS f32x4*)(hp + 4 * i); y[i].x += acc[tl][2 * i].x; y[i].y += acc[tl][2 * i].y; y[i].z += acc[tl][2 * i + 1].x; y[i].w += acc[tl][2 * i + 1].y;
            ssq += (y[i].x * y[i].x + y[i].y * y[i].y) + (y[i].z * y[i].z + y[i].w * y[i].w); }
        const float rs = 1.f / sqrtf(wave_sum(ssq) * (1.f / 1024.f) + EPS);
#pragma unroll
        for (int i = 0; i < 4; ++i) { const f32x4 gv = *(const GAS f32x4*)(A.in[20] + 16 * lane + 4 * i); *(GAS f32x4*)(hp + 4 * i) = y[i] * rs * gv; }
    }
    LDS_WAIT(); asm volatile("" ::: "memory");
}
constexpr int G6_NSH = 16, G6_SHIFT = 10, G6_TPW = 8;
DI void g6_issue(v4u (&R)[4], v4u& E, const LAS unsigned char* tlist, const unsigned char* TAB, int k, int lane) {
    E = *(const LAS v4u*)(tlist + (4 * k + (lane & 3)) * 16);
#pragma unroll
    for (int j = 0; j < 4; ++j) { const unsigned id = (unsigned)__builtin_amdgcn_readlane((int)E.x, j); R[j] = *(const GAS v4u*)(TAB + (size_t)id * 1024 + 16 * lane); }
}
DI void g6_dot(const v4u& xx, const v4u (&U)[4], const v4u& E, LAS unsigned char* tlist, int k, int lane) {
    int p[4];
#pragma unroll
    for (int j = 0; j < 4; ++j) { int d = __builtin_amdgcn_sdot4((int)U[j].x, (int)xx.x, 0, false); d = __builtin_amdgcn_sdot4((int)U[j].y, (int)xx.y, d, false);
        d = __builtin_amdgcn_sdot4((int)U[j].z, (int)xx.z, d, false); p[j] = __builtin_amdgcn_sdot4((int)U[j].w, (int)xx.w, d, false); }
    const bool b0 = lane & 1, b1 = lane & 2;
    const int kA = b0 ? p[1] : p[0], sA = b0 ? p[0] : p[1], kB = b0 ? p[3] : p[2], sB = b0 ? p[2] : p[3];
    const int qA = kA + dpp_i<0xB1>(sA), qB = kB + dpp_i<0xB1>(sB);
    const int kk = b1 ? qB : qA, ss = b1 ? qA : qB;
    int r = kk + dpp_i<0x4E>(ss);
    r += dpp_i<0x124>(r); r += dpp_i<0x128>(r);
    r += __shfl_xor(r, 16); r += __shfl_xor(r, 32);
    const float a = (float)r * __uint_as_float(E.z);
    const float y = 0.7978845608028654f * (a + 0.044715f * a * a * a);
    const float th = 1.f - 2.f * __builtin_amdgcn_rcpf(1.f + __expf(2.f * y));
    const float cfl = __uint_as_float(E.y) * __uint_as_float(E.w) * 0.5f * a * (1.f + th);
    if (lane < 4) *(LAS float*)(tlist + (4 * k + lane) * 16 + 4) = cfl;
}
typedef _Float16 h2_t __attribute__((ext_vector_type(2)));
typedef _Float16 h32_t __attribute__((ext_vector_type(32)));
DI void g6_issue_v(u32x3v (&R)[4], v4u& E, const LAS unsigned char* tlist, const unsigned char* TAB, int k, int lane) {
    E = *(const LAS v4u*)(tlist + (4 * k + (lane & 3)) * 16);
#pragma unroll
    for (int j = 0; j < 4; ++j) { const unsigned id = (unsigned)__builtin_amdgcn_readlane((int)E.x, j); R[j] = *(const GAS u32x3v*)(TAB + (size_t)id * 768 + 12 * lane); }
}
DI void g6_fma(h2_t (&acc)[8], const u32x3v (&V)[4], const v4u& E, int lane) {
#pragma unroll
    for (int jp = 0; jp < 2; ++jp) {
        const i32x6v pk = {(int)V[2 * jp][0], (int)V[2 * jp][1], (int)V[2 * jp][2], (int)V[2 * jp + 1][0], (int)V[2 * jp + 1][1], (int)V[2 * jp + 1][2]};
        const h32_t hv = __builtin_bit_cast(h32_t, __builtin_amdgcn_cvt_scalef32_pk32_f16_fp6(pk, 1.0f));
#pragma unroll
        for (int q = 0; q < 2; ++q) { const float cf = __uint_as_float(__builtin_amdgcn_readlane((int)E.y, 2 * jp + q)); const _Float16 ch = (_Float16)cf; const h2_t c2 = {ch, ch};
#pragma unroll
            for (int w = 0; w < 8; ++w) { const h2_t vv = {hv[16 * q + 2 * w], hv[16 * q + 2 * w + 1]}; acc[w] = __builtin_elementwise_fma(vv, c2, acc[w]); } }
    }
}
DI void peer_gather_wave6(Frame& F, const Args& A, const bf16* XN2, const float* SS2, const int* IDX, const float* GATE, size_t tok0) {
    constexpr int TPW = G6_TPW;
    const int lane = F.lane, wid = F.wave;
    const unsigned char* U8 = F.ws + WS_U8; const unsigned char* V8 = F.ws + WS_V8;
    const float* SU = (const float*)(F.ws + WS_SU); const float* SV = (const float*)(F.ws + WS_SV);
    LAS unsigned char* list = F.lds + wid * (TPW * 2048);
    v4u xq[TPW];
#pragma unroll
    for (int tl = 0; tl < TPW; ++tl) {
        const size_t t = tok0 + tl;
        float sx;
        {
            float xv[16];
#pragma unroll
            for (int j = 0; j < 4; ++j) { const unsigned long long hw = *(const GAS unsigned long long*)(XN2 + t * 1024 + 256 * j + 4 * lane); const unsigned lo_ = (unsigned)hw, hi_ = (unsigned)(hw >> 32);
                xv[4 * j] = bflo(lo_); xv[4 * j + 1] = bfhi(lo_); xv[4 * j + 2] = bflo(hi_); xv[4 * j + 3] = bfhi(hi_); }
            {
                const f32x4* sp = (const f32x4*)(SS2 + t * 16); const f32x4 a = sp[0], b = sp[1], c = sp[2], d = sp[3];
                const float tt = ((a[0] + a[1]) + (a[2] + a[3])) + ((b[0] + b[1]) + (b[2] + b[3])) + ((c[0] + c[1]) + (c[2] + c[3])) + ((d[0] + d[1]) + (d[2] + d[3]));
                const float rs = 1.0f / sqrtf(tt * (1.0f / 1024.0f) + EPS);
#pragma unroll
                for (int i = 0; i < 4; ++i) { const f32x4 gv = *(const GAS f32x4*)(A.in[15] + 256 * i + 4 * lane); xv[4 * i] *= rs * gv.x; xv[4 * i + 1] *= rs * gv.y; xv[4 * i + 2] *= rs * gv.z; xv[4 * i + 3] *= rs * gv.w; }
            }
            float mx = 0.f;
#pragma unroll
            for (int i = 0; i < 16; ++i) mx = fmaxf(mx, fabsf(xv[i]));
            mx = wave_max(mx); sx = mx > 0.f ? mx * (1.f / 127.f) : 1.f; const float inv = 1.f / sx;
#pragma unroll
            for (int i = 0; i < 4; ++i) { const int a = (int)rintf(xv[4 * i] * inv), b = (int)rintf(xv[4 * i + 1] * inv), c = (int)rintf(xv[4 * i + 2] * inv), d = (int)rintf(xv[4 * i + 3] * inv);
                xq[tl][i] = (unsigned)(a & 255) | ((unsigned)(b & 255) << 8) | ((unsigned)(c & 255) << 16) | ((unsigned)(d & 255) << 24); }
        }
        const int idlo = IDX[t * 128 + lane], idhi = IDX[t * 128 + 64 + lane];
        const float glo = GATE[t * 128 + lane], ghi = GATE[t * 128 + 64 + lane];
        const float slo = SU[idlo] * sx, shi = SU[idhi] * sx, vlo = SV[idlo], vhi = SV[idhi];
        LAS unsigned char* tl_list = list + tl * 2048;
        int base = 0;
        for (int s = 0; s < G6_NSH; ++s) {
            { const bool m = (idlo >> G6_SHIFT) == s; const unsigned long long mk = __ballot(m); const int pos = base + (int)__builtin_amdgcn_mbcnt_hi((unsigned)(mk >> 32), __builtin_amdgcn_mbcnt_lo((unsigned)mk, 0u));
              if (m) *(LAS v4u*)(tl_list + pos * 16) = (v4u){(unsigned)idlo, __float_as_uint(glo), __float_as_uint(slo), __float_as_uint(vlo)};
              base += __builtin_popcountll(mk); }
            { const bool m = (idhi >> G6_SHIFT) == s; const unsigned long long mk = __ballot(m); const int pos = base + (int)__builtin_amdgcn_mbcnt_hi((unsigned)(mk >> 32), __builtin_amdgcn_mbcnt_lo((unsigned)mk, 0u));
              if (m) *(LAS v4u*)(tl_list + pos * 16) = (v4u){(unsigned)idhi, __float_as_uint(ghi), __float_as_uint(shi), __float_as_uint(vhi)};
              base += __builtin_popcountll(mk); }
        }
    }
    LDS_WAIT(); asm volatile("" ::: "memory");
#define G6_SB __builtin_amdgcn_sched_barrier(0)
    {
        v4u RA[4], RB[4]; v4u EA, EB;
        g6_issue(RA, EA, list, U8, 0, lane);
        for (int k = 0; k < 32; ++k) {
#define G6_P1(RI, EI, tn, kn, RC, EC, tc) do { g6_issue(RI, EI, list + (tn) * 2048, U8, kn, lane); G6_SB; g6_dot(xq[tc], RC, EC, list + (tc) * 2048, k, lane); G6_SB; } while (0)
            G6_P1(RB, EB, 1, k, RA, EA, 0); G6_P1(RA, EA, 2, k, RB, EB, 1); G6_P1(RB, EB, 3, k, RA, EA, 2); G6_P1(RA, EA, 4, k, RB, EB, 3);
            G6_P1(RB, EB, 5, k, RA, EA, 4); G6_P1(RA, EA, 6, k, RB, EB, 5); G6_P1(RB, EB, 7, k, RA, EA, 6); G6_P1(RA, EA, 0, (k < 31 ? k + 1 : 31), RB, EB, 7);
#undef G6_P1
        }
    }
    LDS_WAIT(); asm volatile("" ::: "memory");
    h2_t acc[TPW][8];
#pragma unroll
    for (int tl = 0; tl < TPW; ++tl)
#pragma unroll
        for (int i = 0; i < 8; ++i) acc[tl][i] = (h2_t){(_Float16)0.f, (_Float16)0.f};
    {
        u32x3v RA[4], RB[4]; v4u EA, EB;
        g6_issue_v(RA, EA, list, V8, 0, lane);
        for (int k = 0; k < 32; ++k) {
#define G6_P2(RI, EI, tn, kn, RC, EC, tc) do { g6_issue_v(RI, EI, list + (tn) * 2048, V8, kn, lane); G6_SB; g6_fma(acc[tc], RC, EC, lane); G6_SB; } while (0)
            G6_P2(RB, EB, 1, k, RA, EA, 0); G6_P2(RA, EA, 2, k, RB, EB, 1); G6_P2(RB, EB, 3, k, RA, EA, 2); G6_P2(RA, EA, 4, k, RB, EB, 3);
            G6_P2(RB, EB, 5, k, RA, EA, 4); G6_P2(RA, EA, 6, k, RB, EB, 5); G6_P2(RB, EB, 7, k, RA, EA, 6); G6_P2(RA, EA, 0, (k < 31 ? k + 1 : 31), RB, EB, 7);
#undef G6_P2
        }
    }
#undef G6_SB
#pragma unroll
    for (int tl = 0; tl < TPW; ++tl) {
        float* hp = F.out + (tok0 + tl) * 1024 + 4 * lane;
        f32x4 y[4]; float ssq = 0.f;
#pragma unroll
        for (int i = 0; i < 4; ++i) { const unsigned long long hw = *(const GAS unsigned long long*)(XN2 + (tok0 + tl) * 1024 + 256 * i + 4 * lane); const unsigned lo_ = (unsigned)hw, hi_ = (unsigned)(hw >> 32);
            y[i] = (f32x4){bflo(lo_), bfhi(lo_), bflo(hi_), bfhi(hi_)}; }
#pragma unroll
        for (int i = 0; i < 4; ++i) { y[i].x += (float)acc[tl][2 * i].x; y[i].y += (float)acc[tl][2 * i].y; y[i].z += (float)acc[tl][2 * i + 1].x; y[i].w += (float)acc[tl][2 * i + 1].y;
            ssq += (y[i].x * y[i].x + y[i].y * y[i].y) + (y[i].z * y[i].z + y[i].w * y[i].w); }
        const float rs = 1.f / sqrtf(wave_sum(ssq) * (1.f / 1024.f) + EPS);
#pragma unroll
        for (int i = 0; i < 4; ++i) { const f32x4 gv = *(const GAS f32x4*)(A.in[20] + 256 * i + 4 * lane); *(GAS f32x4*)(hp + 256 * i) = y[i] * rs * gv; }
    }
    LDS_WAIT(); asm volatile("" ::: "memory");
}

constexpr size_t WS_XBUF = 73 * MiB;
constexpr int CW_SEAM = 16384, SEAM_BANK = 8192;
__global__ void __launch_bounds__(NWAVES * 64, 2) fwd_kernel(Args args) {
    extern __shared__ __attribute__((aligned(16))) unsigned char lds[];
    Frame F;
    F.lds = (LAS unsigned char*)lds;
    F.MISC = (volatile LAS unsigned*)(F.lds + MISC_OFF);
    F.tid = threadIdx.x; F.lane = F.tid & 63; F.wave = __builtin_amdgcn_readfirstlane(F.tid >> 6);
    F.G = gridDim.x; { const int bx = blockIdx.x; F.vcu = (F.G % 8 == 0) ? (bx % 8) * (F.G / 8) + bx / 8 : bx; }
    unsigned char* ws = args.ws;
    F.ctl = (gu32*)(ws + WS_CTL);
    F.out = args.out; F.ws = ws;
    for (int u = F.tid; u < (LDS_BYTES - LDSCTL_OFF) / 4; u += NWAVES * 64) ((LAS unsigned*)(F.lds + LDSCTL_OFF))[u] = 0u;
    __syncthreads();
    XcdBarrier bar = xcd_barrier_post((unsigned*)(F.ctl + CW_BAR) + args.li * XCD_BAR_WORDS, F.MISC + 8);
    const int lo = args.ph_lo, hi = args.ph_hi;
#ifndef PH_MASK
#define PH_MASK 0xffff
#endif
#define IN(k) (((PH_MASK >> (k)) & 1) && lo <= (k) && (k) < hi)
#define SEAM(k) do { if (IN(k) && IN((k) + 1)) xcd_barrier(bar); } while (0)
    const int gw = F.vcu * NWAVES + F.wave, NGW = F.G * NWAVES;
#define STW ((bf16*)F.out)
#define OSB (F.out + (size_t)M * 512)
#define IDX ((int*)F_BUFA)
#define GATE ((float*)(F_BUFA) + (size_t)M * 128)

    if (IN(0)) { p0_prologue(F, args); __syncthreads(); p0_late(F, args, gw, NGW); } SEAM(0);
    if (IN(1)) {
        { pg8::Gemm g{F_BUFA, F_W1T, 1024, 1024, 1024}; pg8::StaticOrder S; S.init(M, N1, F.G, (int)blockIdx.x, 1024, 1024);
          pg8::EpiBf16P E{F_PROJ, N1, 1.f};
          pg8::gemm_phase<pg8::EpiBf16P, pg8::StaticOrder, true, true>(F.lds, g, S, E); }
        { pg8::Gemm g{F_MN, F_WXKVT, 1024, 1024, 1024}; const int c = (int)blockIdx.x; pg8::OneUnitOrder S{(c >= 64 && c < 128) ? c - 64 : -1, 8, 1024, 1024};
          pg8::EpiBf16P E{F_KV, 2048, 1.f};
          pg8::gemm_phase<pg8::EpiBf16P, pg8::OneUnitOrder, true, true>(F.lds, g, S, E); }
    } SEAM(1);
    if (IN(2)) {
        for (int it = F.vcu; it < 256; it += F.G) { const int bh = it >> 2, s = it & 3; sb_unit(F, OSB, bh >> 3, bh & 7, 7 - s); sb_unit(F, OSB, bh >> 3, bh & 7, s); }
        for (int it = F.vcu; it < 1024; it += F.G) { const int bh = it >> 5; gla_local_unit(F, args, STW, bh >> 2, bh & 3, it & 31); }
    } SEAM(2);
    if (IN(3)) { gla_scan(F, STW);
    } SEAM(3);
    if (IN(4)) {
        for (int it = F.vcu; it < 1024; it += F.G) { const int bh = it >> 5; gla_out_unit(F, args, STW, bh >> 2, bh & 3, it & 31); }
        for (int m = gw; m < M; m += NGW) mix_row_sb(F, args, OSB, (size_t)m);
    } SEAM(4);
    if (IN(5)) { pg8::Gemm g{F_BUFA, F_WOT, 1024, 1024, 1024}; pg8::StaticOrder S; S.init(M, 1024, F.G, (int)blockIdx.x, 1024, 1024);
        pg8::EpiResB<false> E{args.in[0], F_SLOT1, (float*)(ws + WS_XBUF), 1024};
        pg8::gemm_phase<pg8::EpiResB<false>, pg8::StaticOrder, true, true>(F.lds, g, S, E); } SEAM(5);
    if (IN(6)) { pg8::Gemm g{F_SLOT1, F_WXQT, 1024, 1024, 1024}; pg8::StaticOrder S; S.init(M, 1024, F.G, (int)blockIdx.x, 1024, 1024);
        pg8::EpiBf16RowScale E{F_SLOT2, 1024, (const float*)(ws + WS_XBUF), EPS};
        pg8::gemm_phase<pg8::EpiBf16RowScale, pg8::StaticOrder, true, true>(F.lds, g, S, E); } SEAM(6);
    if (IN(7)) { for (int it = F.vcu; it < 256; it += F.G) xattn_unit(F, F_SLOT2, F_SLOT0, it >> 5, (it >> 3) & 3, it & 7); } SEAM(7);
    if (IN(8)) { pg8::Gemm g{F_SLOT0, F_WXOT, 1024, 1024, 1024}; pg8::StaticOrder S; S.init(M, 1024, F.G, (int)blockIdx.x, 1024, 1024);
        pg8::EpiResB<true> E{F_SLOT1, F_SLOT2, (float*)(ws + WS_XBUF + MiB), 1024};
        pg8::gemm_phase<pg8::EpiResB<true>, pg8::StaticOrder, true, true>(F.lds, g, S, E); } SEAM(8);
    if (IN(9)) { pg8::Gemm g{F_SLOT2, F_WPQT, 1024, 1024, 1024}; pg8::StaticOrder S; S.init(M, 2048, F.G, (int)blockIdx.x, 1024, 1024);
        pg8::EpiBf16RowScale E{F_SLOT0, 2048, (const float*)(ws + WS_XBUF + MiB), EPS};
        pg8::gemm_phase<pg8::EpiBf16RowScale, pg8::StaticOrder, true, true>(F.lds, g, S, E); } SEAM(9);
    if (IN(10)) { peer_topk_mfma2(F, F_SLOT0, IDX, GATE); } SEAM(10);
    if (IN(11)) { peer_gather_wave6(F, args, F_SLOT2, (const float*)(ws + WS_XBUF + MiB), IDX, GATE, (size_t)F.vcu * 64 + F.wave * 8); }
#undef IN
#undef SEAM
}

constexpr int NPHASES = 12;
extern "C" void kernel_launch(void* const* d_in, const int* in_sizes, int n_in, void* d_out, int out_size, void* d_ws, size_t ws_size, hipStream_t stream) {
    static int grid = 0;
    if (grid == 0) {
        if (n_in != 21 || out_size != M * DM || ws_size < WS_END) { fprintf(stderr, "kernel_launch: unexpected shapes (n_in %d out %d ws %zu)\n", n_in, out_size, ws_size); grid = -1; return; }
        int dev = 0, cus = 0, per_cu = 0;
        if (hipGetDevice(&dev) != hipSuccess || hipDeviceGetAttribute(&cus, hipDeviceAttributeMultiprocessorCount, dev) != hipSuccess) { grid = -1; return; }
        if (hipFuncSetAttribute((const void*)fwd_kernel, hipFuncAttributeMaxDynamicSharedMemorySize, LDS_BYTES) != hipSuccess) { fprintf(stderr, "kernel_launch: hipFuncSetAttribute failed\n"); grid = -1; return; }
        if (hipOccupancyMaxActiveBlocksPerMultiprocessor(&per_cu, (const void*)fwd_kernel, NWAVES * 64, LDS_BYTES) != hipSuccess || per_cu < 1) { fprintf(stderr, "kernel_launch: occupancy query says %d\n", per_cu); }
        (void)hipGetLastError();
        grid = cus;
    }
    if (grid < 0) return;
    (void)hipMemsetAsync((char*)d_ws + WS_CTL, 0, CTL_ZERO_BYTES, stream);
    Args a{};
    for (int i = 0; i < 21; ++i) a.in[i] = (const float*)d_in[i];
    a.out = (float*)d_out; a.ws = (unsigned char*)d_ws;
#if defined(PROF_DUP_LO)
    a.ph_lo = 0; a.ph_hi = PROF_DUP_HI + 1; a.li = 0; hipLaunchKernelGGL(fwd_kernel, dim3(grid), dim3(NWAVES * 64), LDS_BYTES, stream, a);
    a.ph_lo = PROF_DUP_LO; a.ph_hi = NPHASES; a.li = 1; hipLaunchKernelGGL(fwd_kernel, dim3(grid), dim3(NWAVES * 64), LDS_BYTES, stream, a);
#elif defined(PROF_SPLIT)
    a.ph_lo = 0; a.ph_hi = PROF_SPLIT; a.li = 0; hipLaunchKernelGGL(fwd_kernel, dim3(grid), dim3(NWAVES * 64), LDS_BYTES, stream, a);
    a.ph_lo = PROF_SPLIT; a.ph_hi = NPHASES; a.li = 1; hipLaunchKernelGGL(fwd_kernel, dim3(grid), dim3(NWAVES * 64), LDS_BYTES, stream, a);
#else
    a.ph_lo = 0; a.ph_hi = NPHASES; a.li = 0;
    hipLaunchKernelGGL(fwd_kernel, dim3(grid), dim3(NWAVES * 64), LDS_BYTES, stream, a);
#endif
}
```

```cpp
#include <hip/hip_runtime.h>
#include <cstdio>
#include <cstdint>
namespace pg8 {
#define PG8_LAS __attribute__((address_space(3)))
typedef unsigned short bf16_t;
typedef short bf16x8 __attribute__((ext_vector_type(8)));
typedef float f32x4 __attribute__((ext_vector_type(4)));
typedef unsigned u32x4 __attribute__((ext_vector_type(4)));
constexpr int BM = 256, BK = 64, HALF = 128, HTB = HALF * BK * 2  , STAGE_BYTES = 8 * HTB, NXCD = 8, WGM = 8;

__host__ __device__ __forceinline__ int lds_byte(int r, int c) { const int st = (r >> 4) * 2 + (c >> 5), rr = r & 15, cc = c & 31, ob = rr * 64 + cc * 2; return st * 1024 + (ob ^ (((ob >> 9) & 1) << 5)); }
__host__ __device__ __forceinline__ void stage_rc(int b, int& R, int& C) { const int st = b / 1024, sb = b % 1024, swz = sb ^ (((sb >> 9) & 1) << 5); R = (st >> 1) * 16 + swz / 64; C = (st & 1) * 32 + (swz % 64) / 2; }
__host__ __device__ __forceinline__ int perm32(int rho) { const int n = rho >> 4, i = rho & 15; return 8 * (i >> 2) + 4 * n + (i & 3); }

struct Unit { int pm, pn; size_t aoff, boff; };
struct Gemm { const bf16_t* A; const bf16_t* Bt; int K, lda, ldb; };

struct StaticOrder {
    int nM, nN, nwg, G, c, lda, ldb;
    __host__ __device__ void init(int M, int N, int G_, int c_, int lda_, int ldb_) { nM = M / BM; nN = N / BM; nwg = nM * nN; G = G_; c = c_; lda = lda_; ldb = ldb_; }
    __host__ __device__ bool next(int i, Unit& u) const {
        const long L = (long)i * G + c; if (L >= nwg) return false;
        int wgid = (int)L; { const int q = nwg / NXCD, r = nwg % NXCD, xcd = wgid % NXCD, off = wgid / NXCD; wgid = (xcd < r ? xcd * (q + 1) : r * (q + 1) + (xcd - r) * q) + off; }
        const int nig = WGM * nN, gid = wgid / nig, fm = gid * WGM, gsz = (nM - fm) < WGM ? (nM - fm) : WGM;
        u.pm = fm + ((wgid % nig) % gsz); u.pn = (wgid % nig) / gsz; u.aoff = (size_t)u.pm * BM * lda * 2; u.boff = (size_t)u.pn * BM * ldb * 2; return true;
    }
    __device__ __forceinline__ void a_ready(const Unit&) const {}
    __device__ __forceinline__ void done(const Unit&) const {}
};

__device__ __forceinline__ unsigned cvt_pk_bf16(float lo, float hi) { unsigned r; asm volatile("v_cvt_pk_bf16_f32 %0, %1, %2" : "=v"(r) : "v"(lo), "v"(hi)); return r; }
typedef float f32x2 __attribute__((ext_vector_type(2)));
__device__ __forceinline__ f32x2 gelu_pk(f32x2 v) {
    const f32x2 av = __builtin_elementwise_abs(v), d = av * 0.2316418882f + 1.0f;
    f32x2 t; t.x = __builtin_amdgcn_rcpf(d.x); t.y = __builtin_amdgcn_rcpf(d.y);
    f32x2 q = t * 0.5307027145f + (-0.7265760135f); q = q * t + 0.7107068705f; q = q * t + (-0.142248368f); q = q * t + 0.127414796f; q = q * t;
    const f32x2 s = (v * v) * (-0.72134752044f);
    f32x2 e; e.x = __builtin_amdgcn_exp2f(s.x); e.y = __builtin_amdgcn_exp2f(s.y);
    const f32x2 m = v * (q * e), r = v - m;
    f32x2 o; o.x = v.x < 0.f ? m.x : r.x; o.y = v.y < 0.f ? m.y : r.y; return o;
}

template <int ACT  > struct EpiBf16 {
    static constexpr bool PERM = true, AFTER_DRAIN = false; static_assert(ACT == 0 || ACT == 1, "EpiBf16: ACT is 0 (none) or 1 (gelu_pk)");
    bf16_t* O; int ldc; const float* bias; int split_cols; size_t split_stride; float scale0;
    __device__ __forceinline__ void operator()(const f32x4 (&acc)[2][2][4][2], const Unit& u, int wr, int wc, int fr, int fq) const {
        const int row0 = u.pm * BM + wr * 64 + fr; int colt = u.pn * BM; bf16_t* base = O;
        float sc = 1.f; if (split_cols) { const int t = colt / split_cols; base += (size_t)t * split_stride; colt -= t * split_cols; if (t == 0) sc = scale0; }
        const int col0 = colt + wc * 32 + 8 * fq, bcol0 = u.pn * BM + wc * 32 + 8 * fq;
        f32x4 bv[2][2];
#pragma unroll
        for (int bj = 0; bj < 2; ++bj)
#pragma unroll
            for (int n = 0; n < 2; ++n) bv[bj][n] = bias ? *(const f32x4*)(bias + bcol0 + bj * HALF + 4 * n) : (f32x4){0.f, 0.f, 0.f, 0.f};
#pragma unroll
        for (int ai = 0; ai < 2; ++ai)
#pragma unroll
            for (int m = 0; m < 4; ++m) { bf16_t* rowp = base + (size_t)(row0 + ai * HALF + m * 16) * ldc + col0;
#pragma unroll
                for (int bj = 0; bj < 2; ++bj) { f32x4 v0 = acc[ai][bj][m][0] + bv[bj][0], v1 = acc[ai][bj][m][1] + bv[bj][1];
                    if (ACT == 1) { f32x2 a = gelu_pk((f32x2){v0[0], v0[1]}), b = gelu_pk((f32x2){v0[2], v0[3]}), c = gelu_pk((f32x2){v1[0], v1[1]}), d = gelu_pk((f32x2){v1[2], v1[3]});
                        v0 = (f32x4){a.x, a.y, b.x, b.y}; v1 = (f32x4){c.x, c.y, d.x, d.y}; }
                    v0 = v0 * sc; v1 = v1 * sc; u32x4 w; w.x = cvt_pk_bf16(v0[0], v0[1]); w.y = cvt_pk_bf16(v0[2], v0[3]); w.z = cvt_pk_bf16(v1[0], v1[1]); w.w = cvt_pk_bf16(v1[2], v1[3]);
                    *(u32x4*)(rowp + bj * HALF) = w; } }
    }
};
template <class Epi, class Sched, bool ALIGN_EPI = false, bool SP2 = false>
__device__ __forceinline__ void gemm_phase(PG8_LAS unsigned char* lds, const Gemm g, const Sched& S, const Epi& E) {
    const int tid = threadIdx.x, wid = __builtin_amdgcn_readfirstlane(tid >> 6), lane = tid & 63, wr = wid >> 2, wc = wid & 3, fr = lane & 15, fq = lane >> 4;
    int K = g.K; asm volatile("" : "+s"(K));
    const int nt = K / BK;
    unsigned voffA[2], voffB[2];
#pragma unroll
    for (int i = 0; i < 2; ++i) { int R, C; stage_rc(tid * 16 + i * 8192, R, C); const int Rb = Epi::PERM ? ((R & ~31) + perm32(R & 31)) : R;
        voffA[i] = (unsigned)(R * g.lda + C) * 2u; voffB[i] = (unsigned)(Rb * g.ldb + C) * 2u; }
    const size_t kstep = (size_t)(BK * 2);
    const size_t hA = (size_t)HALF * g.lda * 2, hB = (size_t)HALF * g.ldb * 2;
    const unsigned ldsw = (unsigned)wid * 1024u;
    const int aoff = lds_byte(wr * 64 + fr, fq * 8), boff = lds_byte(wc * 32 + fr, fq * 8);
#define PG8_SA(b, h) (((b) * 2 + (h)) * HTB)
#define PG8_SB(b, h) ((4 + (b) * 2 + (h)) * HTB)
#define PG8_STAGE(bufoff, gbase, voff) do { _Pragma("unroll") for (int _i = 0; _i < 2; ++_i) \
        __builtin_amdgcn_global_load_lds((const unsigned*)((const char*)(gbase) + (voff)[_i]), (PG8_LAS unsigned*)(lds + (bufoff) + ldsw + _i * 8192), 16, 0, 0); } while (0)
#define PG8_LDA(dst, b, h) do { _Pragma("unroll") for (int m = 0; m < 4; ++m) _Pragma("unroll") for (int k = 0; k < 2; ++k) dst[m][k] = *(const PG8_LAS bf16x8*)(lds + PG8_SA(b, h) + aoff + m * 2048 + k * 1024); } while (0)
#define PG8_LDB(dst, b, h) do { _Pragma("unroll") for (int n = 0; n < 2; ++n) _Pragma("unroll") for (int k = 0; k < 2; ++k) dst[n][k] = *(const PG8_LAS bf16x8*)(lds + PG8_SB(b, h) + boff + n * 2048 + k * 1024); } while (0)
#define PG8_MMA(ai, bj, At, Bt) do { __builtin_amdgcn_s_setprio(1); _Pragma("unroll") for (int m = 0; m < 4; ++m) _Pragma("unroll") for (int n = 0; n < 2; ++n) _Pragma("unroll") for (int k = 0; k < 2; ++k) \
        acc[ai][bj][m][n] = __builtin_amdgcn_mfma_f32_16x16x32_bf16(Bt[n][k], At[m][k], acc[ai][bj][m][n], 0, 0, 0); __builtin_amdgcn_s_setprio(0); } while (0)
#define PG8_WAIT_V(n) asm volatile("s_waitcnt vmcnt(" #n ")" ::: "memory")
#define PG8_WAIT_L(n) asm volatile("s_waitcnt lgkmcnt(" #n ")" ::: "memory")
#define PG8_BAR __builtin_amdgcn_s_barrier()
#define PG8_SCHED __builtin_amdgcn_sched_barrier(0)
    Unit cur, nxt; int ui = 0;
    if (!S.next(0, cur)) return;
    f32x4 acc[2][2][4][2];
#pragma unroll
    for (int a = 0; a < 2; ++a)
#pragma unroll
        for (int b = 0; b < 2; ++b)
#pragma unroll
            for (int m = 0; m < 4; ++m)
#pragma unroll
                for (int n = 0; n < 2; ++n) acc[a][b][m][n] = (f32x4){0.f, 0.f, 0.f, 0.f};
    bf16x8 At[4][2], B0[2][2], B1[2][2];
    const char* cA = (const char*)g.A + cur.aoff; const char* cB = (const char*)g.Bt + cur.boff;
    S.a_ready(cur);
    if constexpr (SP2) {
        PG8_STAGE(PG8_SB(0, 0), cB, voffB); PG8_STAGE(PG8_SB(0, 1), cB + hB, voffB); PG8_STAGE(PG8_SA(0, 0), cA, voffA); PG8_STAGE(PG8_SA(0, 1), cA + hA, voffA);
        if (wr == 1) PG8_BAR;
        PG8_WAIT_V(2); PG8_BAR;
        PG8_STAGE(PG8_SB(1, 0), cB + kstep, voffB); PG8_STAGE(PG8_SA(1, 0), cA + kstep, voffA); PG8_STAGE(PG8_SB(1, 1), cB + hB + kstep, voffB);
        PG8_WAIT_V(6); PG8_BAR;
    } else {
        PG8_STAGE(PG8_SB(0, 0), cB, voffB); PG8_STAGE(PG8_SA(0, 0), cA, voffA); PG8_STAGE(PG8_SB(0, 1), cB + hB, voffB); PG8_STAGE(PG8_SA(0, 1), cA + hA, voffA);
        if (wr == 1) PG8_BAR;
        PG8_WAIT_V(4); PG8_BAR;
        PG8_STAGE(PG8_SB(1, 0), cB + kstep, voffB); PG8_STAGE(PG8_SA(1, 0), cA + kstep, voffA); PG8_STAGE(PG8_SB(1, 1), cB + hB + kstep, voffB);
        PG8_WAIT_V(6); PG8_BAR;
    }
    for (;;) {
        const bool has_next = S.next(ui + 1, nxt);
        const char* nA = has_next ? (const char*)g.A + nxt.aoff : cA; const char* nB = has_next ? (const char*)g.Bt + nxt.boff : cB;
        for (int t = 0; t < nt; t += 2) {
            const bool last = (t == nt - 2);
            const char* a1 = cA + (size_t)(t + 1) * kstep;
            const char* a2 = last ? nA : cA + (size_t)(t + 2) * kstep; const char* b2 = last ? nB : cB + (size_t)(t + 2) * kstep;
            const char* a3 = a2 + kstep; const char* b3 = b2 + kstep;
            if (last && has_next) S.a_ready(nxt);
            if constexpr (SP2) {
            PG8_LDB(B0, 0, 0); PG8_LDB(B1, 0, 1); PG8_SCHED; PG8_LDA(At, 0, 0); PG8_STAGE(PG8_SA(1, 1), a1 + hA, voffA);
            PG8_WAIT_V(8); PG8_WAIT_L(0); PG8_BAR; PG8_MMA(0, 0, At, B0); PG8_MMA(0, 1, At, B1); PG8_BAR; PG8_SCHED;
            PG8_LDA(At, 0, 1); PG8_STAGE(PG8_SB(0, 0), b2, voffB); PG8_STAGE(PG8_SB(0, 1), b2 + hB, voffB); PG8_STAGE(PG8_SA(0, 0), a2, voffA);
            PG8_WAIT_V(8); PG8_WAIT_L(0); PG8_BAR; PG8_MMA(1, 0, At, B0); PG8_MMA(1, 1, At, B1); PG8_BAR; PG8_SCHED;
            PG8_LDB(B0, 1, 0); PG8_LDB(B1, 1, 1); PG8_SCHED; PG8_LDA(At, 1, 0); PG8_STAGE(PG8_SA(0, 1), a2 + hA, voffA);
            PG8_WAIT_V(8); PG8_WAIT_L(0); PG8_BAR; PG8_MMA(0, 0, At, B0); PG8_MMA(0, 1, At, B1); PG8_BAR; PG8_SCHED;
            PG8_LDA(At, 1, 1); PG8_STAGE(PG8_SB(1, 0), b3, voffB); PG8_STAGE(PG8_SB(1, 1), b3 + hB, voffB); PG8_STAGE(PG8_SA(1, 0), a3, voffA);
            PG8_WAIT_V(8); PG8_WAIT_L(0); PG8_BAR; PG8_MMA(1, 0, At, B0); PG8_MMA(1, 1, At, B1); PG8_BAR; PG8_SCHED;
            } else {
            PG8_LDB(B0, 0, 0); PG8_SCHED; PG8_LDA(At, 0, 0); PG8_STAGE(PG8_SA(1, 1), a1 + hA, voffA);
            PG8_WAIT_L(8); PG8_BAR; PG8_WAIT_L(0); PG8_MMA(0, 0, At, B0); PG8_BAR; PG8_SCHED;
            PG8_LDB(B1, 0, 1); PG8_STAGE(PG8_SB(0, 0), b2, voffB);
            PG8_BAR; PG8_WAIT_L(0); PG8_MMA(0, 1, At, B1); PG8_BAR;
            PG8_LDA(At, 0, 1); PG8_STAGE(PG8_SA(0, 0), a2, voffA);
            PG8_BAR; PG8_WAIT_L(0); PG8_MMA(1, 0, At, B0); PG8_BAR; PG8_SCHED;
            PG8_STAGE(PG8_SB(0, 1), b2 + hB, voffB);
            PG8_WAIT_V(6); PG8_BAR; PG8_MMA(1, 1, At, B1); PG8_BAR;
            PG8_LDB(B0, 1, 0); PG8_SCHED; PG8_LDA(At, 1, 0); PG8_STAGE(PG8_SA(0, 1), a2 + hA, voffA);
            PG8_WAIT_L(8); PG8_BAR; PG8_WAIT_L(0); PG8_MMA(0, 0, At, B0); PG8_BAR; PG8_SCHED;
            PG8_LDB(B1, 1, 1); PG8_STAGE(PG8_SB(1, 0), b3, voffB);
            PG8_BAR; PG8_WAIT_L(0); PG8_MMA(0, 1, At, B1); PG8_BAR;
            PG8_LDA(At, 1, 1); PG8_STAGE(PG8_SA(1, 0), a3, voffA);
            PG8_BAR; PG8_WAIT_L(0); PG8_MMA(1, 0, At, B0); PG8_BAR; PG8_SCHED;
            PG8_STAGE(PG8_SB(1, 1), b3 + hB, voffB);
            PG8_WAIT_V(6); PG8_BAR; PG8_MMA(1, 1, At, B1); PG8_BAR;
            }
        }
        if constexpr (ALIGN_EPI) { if (wr == 0) PG8_BAR; }
        if constexpr (!Epi::AFTER_DRAIN) { E(acc, cur, wr, wc, fr, fq); S.done(cur); }
        if (!has_next) break;
#pragma unroll
        for (int a = 0; a < 2; ++a)
#pragma unroll
            for (int b = 0; b < 2; ++b)
#pragma unroll
                for (int m = 0; m < 4; ++m)
#pragma unroll
                    for (int n = 0; n < 2; ++n) acc[a][b][m][n] = (f32x4){0.f, 0.f, 0.f, 0.f};
        cur = nxt; cA = nA; cB = nB; ++ui;
        if constexpr (ALIGN_EPI) { if (wr == 1) PG8_BAR; }
    }
    PG8_WAIT_V(0);
    if constexpr (!ALIGN_EPI) { if (wr == 0) PG8_BAR; }
    PG8_BAR;
    if constexpr (Epi::AFTER_DRAIN) { E.fused(acc, cur, wr, wc, fr, fq, lds, wid, lane); S.done(cur); }
#undef PG8_SA
#undef PG8_SB
#undef PG8_STAGE
#undef PG8_LDA
#undef PG8_LDB
#undef PG8_MMA
#undef PG8_WAIT_V
#undef PG8_WAIT_L
#undef PG8_BAR
#undef PG8_SCHED
}
}
namespace pg8 {
struct EpiBf16P {
    static constexpr bool PERM = true, AFTER_DRAIN = false;
    bf16_t* O; int ldc; float sc;
    __device__ __forceinline__ void operator()(const f32x4 (&acc)[2][2][4][2], const Unit& u, int wr, int wc, int fr, int fq) const {
        const int row0 = u.pm * BM + wr * 64 + fr, col0 = u.pn * BM + wc * 32 + 8 * fq;
#pragma unroll
        for (int ai = 0; ai < 2; ++ai)
#pragma unroll
            for (int m = 0; m < 4; ++m) { bf16_t* rowp = O + (size_t)(row0 + ai * HALF + m * 16) * ldc + col0;
#pragma unroll
                for (int bj = 0; bj < 2; ++bj) { const f32x4 v0 = acc[ai][bj][m][0] * sc, v1 = acc[ai][bj][m][1] * sc;
                    u32x4 w; w.x = cvt_pk_bf16(v0[0], v0[1]); w.y = cvt_pk_bf16(v0[2], v0[3]); w.z = cvt_pk_bf16(v1[0], v1[1]); w.w = cvt_pk_bf16(v1[2], v1[3]);
                    *(u32x4*)(rowp + bj * HALF) = w; } }
    }
};
struct EpiF32Res {
    static constexpr bool PERM = false, AFTER_DRAIN = false;
    const float* base; float* out; int ldc;
    __device__ __forceinline__ void operator()(const f32x4 (&acc)[2][2][4][2], const Unit& u, int wr, int wc, int fr, int fq) const {
        const int row0 = u.pm * BM + wr * 64 + fr, col0 = u.pn * BM + wc * 32 + 4 * fq;
#pragma unroll
        for (int ai = 0; ai < 2; ++ai)
#pragma unroll
            for (int m = 0; m < 4; ++m) { const size_t off = (size_t)(row0 + ai * HALF + m * 16) * ldc + col0;
#pragma unroll
                for (int bj = 0; bj < 2; ++bj)
#pragma unroll
                    for (int n = 0; n < 2; ++n) { const f32x4 b = *(const f32x4*)(base + off + bj * HALF + n * 16); *(f32x4*)(out + off + bj * HALF + n * 16) = b + acc[ai][bj][m][n]; } }
    }
};
template <int mode> struct XAttnOrder {
    int G, c;
    __device__ __forceinline__ bool next(int i, Unit& u) const {
        const int L = i * G + c; if (L >= 256) return false;
        u.pm = L >> 2; u.pn = L & 3; const int b = u.pm >> 3;
        u.aoff = ((size_t)u.pm * 256 * 1024 + (size_t)u.pn * 256) * 2;
        u.boff = mode == 0 ? ((size_t)(b * 256) * 2048 + (size_t)u.pn * 256) * 2 : ((size_t)((b * 4 + u.pn) * 256) * 256) * 2;
        return true;
    }
    __device__ __forceinline__ void a_ready(const Unit&) const {}
    __device__ __forceinline__ void done(const Unit&) const {}
};
struct OneUnitOrder {
    int L, nN, lda, ldb;
    __device__ __forceinline__ bool next(int i, Unit& u) const {
        if (i != 0 || L < 0) return false;
        u.pm = L / nN; u.pn = L % nN; u.aoff = (size_t)u.pm * BM * lda * 2; u.boff = (size_t)u.pn * BM * ldb * 2; return true;
    }
    __device__ __forceinline__ void a_ready(const Unit&) const {}
    __device__ __forceinline__ void done(const Unit&) const {}
};
}

namespace pg8 {
struct EpiResRms {
    static constexpr bool PERM = false, AFTER_DRAIN = true;
    const float* base; float* out; bf16_t* hn; const float* g; int ldc; unsigned* xbuf; unsigned* cnt; float eps;
    __device__ __forceinline__ void fused(f32x4 (&acc)[2][2][4][2], const Unit& u, int wr, int wc, int fr, int fq, PG8_LAS unsigned char* lds, int wid, int lane) const {
        PG8_LAS float* P = (PG8_LAS float*)lds;
        PG8_LAS float* S = (PG8_LAS float*)(lds + 8192);
        const int col0 = u.pn * BM + wc * 32 + 4 * fq;
#pragma unroll
        for (int ai = 0; ai < 2; ++ai)
#pragma unroll
            for (int m = 0; m < 4; ++m) { const size_t off = (size_t)(u.pm * BM + ai * HALF + wr * 64 + m * 16 + fr) * ldc + col0; float s = 0.f;
#pragma unroll
                for (int bj = 0; bj < 2; ++bj)
#pragma unroll
                    for (int n = 0; n < 2; ++n) { const f32x4 b = *(const f32x4*)(base + off + bj * HALF + n * 16); f32x4 x = acc[ai][bj][m][n] + b; acc[ai][bj][m][n] = x; s += (x[0] * x[0] + x[1] * x[1]) + (x[2] * x[2] + x[3] * x[3]); }
                s += __shfl_xor(s, 16); s += __shfl_xor(s, 32);
                if (fq == 0) P[(ai * HALF + wr * 64 + m * 16 + fr) * 4 + wc] = s;
                if (m & 1) asm volatile("" ::: "memory"); }
        asm volatile("s_waitcnt lgkmcnt(0)" ::: "memory"); __builtin_amdgcn_s_barrier(); asm volatile("" ::: "memory");
        const int row = wid * 32 + (lane & 31);
        if (lane < 32) { const float t = (P[row * 4 + 0] + P[row * 4 + 1]) + (P[row * 4 + 2] + P[row * 4 + 3]);
            __hip_atomic_store(xbuf + (size_t)(u.pm * BM + row) * 4 + u.pn, __float_as_uint(t), __ATOMIC_RELAXED, __HIP_MEMORY_SCOPE_AGENT); }
        asm volatile("s_waitcnt vmcnt(0)" ::: "memory");
        if (lane == 0) __hip_atomic_fetch_add(cnt + 64 * u.pm, 1u, __ATOMIC_RELAXED, __HIP_MEMORY_SCOPE_AGENT);
        if (wid == 0) {
            const unsigned long long t0 = __builtin_amdgcn_s_memrealtime();
            while ((unsigned)__builtin_amdgcn_readfirstlane(__hip_atomic_load(cnt + 64 * u.pm, __ATOMIC_RELAXED, __HIP_MEMORY_SCOPE_AGENT)) < 32u) {
                if (__builtin_amdgcn_s_memrealtime() - t0 > 2000000ull) break;
                __builtin_amdgcn_s_sleep(2); }
            __builtin_amdgcn_fence(__ATOMIC_ACQUIRE, "agent");
        }
        asm volatile("s_waitcnt vmcnt(0) lgkmcnt(0)" ::: "memory"); __builtin_amdgcn_s_barrier(); asm volatile("" ::: "memory");
        if (lane < 32) { const unsigned* sl = xbuf + (size_t)(u.pm * BM + row) * 4; float t = 0.f;
#pragma unroll
            for (int q = 0; q < 4; ++q) t += __uint_as_float(__hip_atomic_load(sl + q, __ATOMIC_RELAXED, __HIP_MEMORY_SCOPE_AGENT));
            S[row] = 1.0f / sqrtf(t * (1.0f / 1024.0f) + eps); }
        asm volatile("s_waitcnt lgkmcnt(0)" ::: "memory"); __builtin_amdgcn_s_barrier(); asm volatile("" ::: "memory");
        f32x4 gv[2][2];
#pragma unroll
        for (int bj = 0; bj < 2; ++bj)
#pragma unroll
            for (int n = 0; n < 2; ++n) gv[bj][n] = *(const f32x4*)(g + col0 + bj * HALF + n * 16);
#pragma unroll
        for (int ai = 0; ai < 2; ++ai)
#pragma unroll
            for (int m = 0; m < 4; ++m) { const int r = ai * HALF + wr * 64 + m * 16 + fr; const float rs = S[r]; const size_t off = (size_t)(u.pm * BM + r) * ldc + col0;
#pragma unroll
                for (int bj = 0; bj < 2; ++bj)
#pragma unroll
                    for (int n = 0; n < 2; ++n) { const f32x4 x = acc[ai][bj][m][n]; *(f32x4*)(out + off + bj * HALF + n * 16) = x;
                        const f32x4 y = x * rs * gv[bj][n]; typedef unsigned u32x2v __attribute__((ext_vector_type(2))); u32x2v w; w.x = cvt_pk_bf16(y[0], y[1]); w.y = cvt_pk_bf16(y[2], y[3]);
                        *(u32x2v*)(hn + off + bj * HALF + n * 16) = w; }
                asm volatile("" ::: "memory"); }
    }
};
}

namespace pg8 {
struct EpiResSS {
    static constexpr bool PERM = false, AFTER_DRAIN = false;
    const float* base; float* out; bf16_t* hb; float* ss; int ldc;
    __device__ __forceinline__ void operator()(const f32x4 (&acc)[2][2][4][2], const Unit& u, int wr, int wc, int fr, int fq) const {
        const int row0 = u.pm * BM + wr * 64 + fr, col0 = u.pn * BM + wc * 32 + 4 * fq;
#pragma unroll
        for (int ai = 0; ai < 2; ++ai)
#pragma unroll
            for (int m = 0; m < 4; ++m) { const int row = row0 + ai * HALF + m * 16; const size_t off = (size_t)row * ldc + col0; float s = 0.f;
#pragma unroll
                for (int bj = 0; bj < 2; ++bj)
#pragma unroll
                    for (int n = 0; n < 2; ++n) { const f32x4 x = *(const f32x4*)(base + off + bj * HALF + n * 16) + acc[ai][bj][m][n]; *(f32x4*)(out + off + bj * HALF + n * 16) = x;
                        typedef unsigned u32x2v __attribute__((ext_vector_type(2))); u32x2v w; w.x = cvt_pk_bf16(x[0], x[1]); w.y = cvt_pk_bf16(x[2], x[3]); *(u32x2v*)(hb + off + bj * HALF + n * 16) = w;
                        s += (x[0] * x[0] + x[1] * x[1]) + (x[2] * x[2] + x[3] * x[3]); }
                s += __shfl_xor(s, 16); s += __shfl_xor(s, 32);
                if (fq == 0) ss[(size_t)row * 16 + u.pn * 4 + wc] = s; }
    }
};
struct EpiBf16RowScale {
    static constexpr bool PERM = true, AFTER_DRAIN = false;
    bf16_t* O; int ldc; const float* ss; float eps;
    __device__ __forceinline__ void operator()(const f32x4 (&acc)[2][2][4][2], const Unit& u, int wr, int wc, int fr, int fq) const {
        const int row0 = u.pm * BM + wr * 64 + fr, col0 = u.pn * BM + wc * 32 + 8 * fq;
#pragma unroll
        for (int ai = 0; ai < 2; ++ai)
#pragma unroll
            for (int m = 0; m < 4; ++m) { const int row = row0 + ai * HALF + m * 16; const f32x4* sp = (const f32x4*)(ss + (size_t)row * 16);
                const f32x4 a = sp[0], b = sp[1], c = sp[2], d = sp[3];
                const float t = ((a[0] + a[1]) + (a[2] + a[3])) + ((b[0] + b[1]) + (b[2] + b[3])) + ((c[0] + c[1]) + (c[2] + c[3])) + ((d[0] + d[1]) + (d[2] + d[3]));
                const float rs = 1.0f / sqrtf(t * (1.0f / 1024.0f) + eps);
                bf16_t* rowp = O + (size_t)row * ldc + col0;
#pragma unroll
                for (int bj = 0; bj < 2; ++bj) { const f32x4 v0 = acc[ai][bj][m][0] * rs, v1 = acc[ai][bj][m][1] * rs;
                    u32x4 w; w.x = cvt_pk_bf16(v0[0], v0[1]); w.y = cvt_pk_bf16(v0[2], v0[3]); w.z = cvt_pk_bf16(v1[0], v1[1]); w.w = cvt_pk_bf16(v1[2], v1[3]);
                    *(u32x4*)(rowp + bj * HALF) = w; } }
    }
};
}

namespace pg8 {
template <bool BASE_BF16> struct EpiResB {
    static constexpr bool PERM = true, AFTER_DRAIN = false;
    const void* base; bf16_t* hb; float* ss; int ldc;
    __device__ __forceinline__ void operator()(const f32x4 (&acc)[2][2][4][2], const Unit& u, int wr, int wc, int fr, int fq) const {
        const int row0 = u.pm * BM + wr * 64 + fr, col0 = u.pn * BM + wc * 32 + 8 * fq;
#pragma unroll
        for (int ai = 0; ai < 2; ++ai)
#pragma unroll
            for (int m = 0; m < 4; ++m) { const int row = row0 + ai * HALF + m * 16; const size_t off = (size_t)row * ldc + col0; float s = 0.f;
#pragma unroll
                for (int bj = 0; bj < 2; ++bj) { f32x4 b0, b1;
                    if (BASE_BF16) { const u32x4 w = *(const u32x4*)((const bf16_t*)base + off + bj * HALF);
                        b0 = (f32x4){__uint_as_float(w.x << 16), __uint_as_float(w.x & 0xffff0000u), __uint_as_float(w.y << 16), __uint_as_float(w.y & 0xffff0000u)};
                        b1 = (f32x4){__uint_as_float(w.z << 16), __uint_as_float(w.z & 0xffff0000u), __uint_as_float(w.w << 16), __uint_as_float(w.w & 0xffff0000u)}; }
                    else { b0 = *(const f32x4*)((const float*)base + off + bj * HALF); b1 = *(const f32x4*)((const float*)base + off + bj * HALF + 4); }
                    const f32x4 x0 = b0 + acc[ai][bj][m][0], x1 = b1 + acc[ai][bj][m][1];
                    u32x4 w; w.x = cvt_pk_bf16(x0[0], x0[1]); w.y = cvt_pk_bf16(x0[2], x0[3]); w.z = cvt_pk_bf16(x1[0], x1[1]); w.w = cvt_pk_bf16(x1[2], x1[3]);
                    *(u32x4*)(hb + off + bj * HALF) = w;
                    s += ((x0[0] * x0[0] + x0[1] * x0[1]) + (x0[2] * x0[2] + x0[3] * x0[3])) + ((x1[0] * x1[0] + x1[1] * x1[1]) + (x1[2] * x1[2] + x1[3] * x1[3])); }
                s += __shfl_xor(s, 16); s += __shfl_xor(s, 32);
                if (fq == 0) ss[(size_t)row * 16 + u.pn * 4 + wc] = s; }
    }
};
}

constexpr int NWAVES = 8;
constexpr int BATCH = 8, SEQ = 2048, DM = 1024, M = BATCH * SEQ, MEMLEN = 256, MM = BATCH * MEMLEN;
constexpr int INCOLS = 3088;
constexpr int N1 = 3328;
constexpr int PQ = 0, PK = 256, PV = 512, POG = 1024, PSQ = 1536, PSK = 2048, PSV = 2560, PGATE = 3072;
constexpr int PEER_N = 16384;
constexpr float EPS = 1e-6f;

constexpr size_t MiB = 1u << 20;
constexpr size_t WS_CTL = 0, CTL_ZERO_BYTES = 1 * MiB;
constexpr size_t WS_W1T = 1 * MiB;
constexpr size_t WS_WOT = 8 * MiB, WS_WXQT = 10 * MiB, WS_WXOT = 12 * MiB, WS_WXKVT = 14 * MiB, WS_WPQT = 18 * MiB, WS_SUBK = 22 * MiB;
constexpr size_t WS_UB = 24 * MiB, WS_VB = 56 * MiB;
constexpr size_t WS_BUFA = 88 * MiB;
constexpr size_t WS_MN = 120 * MiB;
constexpr size_t WS_KV = 124 * MiB;
constexpr size_t WS_PROJ = 132 * MiB;
constexpr size_t WS_SLOT0 = 132 * MiB, WS_SLOT1 = 164 * MiB, WS_SLOT2 = 196 * MiB, WS_VT = 76 * MiB, WS_END = 236 * MiB;
constexpr int CW_BAR = 4096;
constexpr int CW_SBSS = 32768;

constexpr int RING_BYTES = 131072;
constexpr int LDSCTL_OFF = RING_BYTES, MISC_OFF = LDSCTL_OFF + 320;
constexpr int LDS_BYTES = 147456;

#define GAS __attribute__((address_space(1)))
#define LAS __attribute__((address_space(3)))
typedef unsigned short bf16;
typedef unsigned v4u __attribute__((ext_vector_type(4)));
typedef float f32x4 __attribute__((ext_vector_type(4)));
typedef short bf16x8 __attribute__((ext_vector_type(8)));
typedef GAS unsigned gu32;
typedef GAS unsigned long long gu64;
#define RLX_AGENT __ATOMIC_RELAXED, __HIP_MEMORY_SCOPE_AGENT
#define LDS_WAIT() asm volatile("s_waitcnt lgkmcnt(0)" ::: "memory")
#define VM_WAIT() asm volatile("s_waitcnt vmcnt(0)" ::: "memory")
__device__ __forceinline__ unsigned long long rt() { return __builtin_amdgcn_s_memrealtime(); }
__device__ __forceinline__ unsigned f2bf(float f) { unsigned u = __builtin_bit_cast(unsigned, f); return (u + 0x7fffu + ((u >> 16) & 1u)) >> 16; }
__device__ __forceinline__ unsigned pk2(float lo, float hi) { return f2bf(lo) | (f2bf(hi) << 16); }

#define XB_TMO      128
#define XB_XCNT(j)  (256  + 64 * (j))
#define XB_XSUB(j)  (1280 + 64 * (j))
#define XB_XGEN(j)  (2304 + 64 * (j))
#define XB_TOP      3328
#define XB_TOPGEN   3392
#define XCD_BAR_WORDS 3456
#define XB_SPIN_CAP (1u << 22)

__device__ __forceinline__ unsigned xb_ld(unsigned* p)              { return __hip_atomic_load(p, __ATOMIC_RELAXED, __HIP_MEMORY_SCOPE_AGENT); }
__device__ __forceinline__ unsigned xb_add(unsigned* p, unsigned v) { return __hip_atomic_fetch_add(p, v, __ATOMIC_RELAXED, __HIP_MEMORY_SCOPE_AGENT); }
__device__ __forceinline__ unsigned xb_xcc_id() { return (unsigned)__builtin_amdgcn_s_getreg((3 << 11) | 20) & 0xFu; }
#define XB_SPIN(cond, bar) do { unsigned _sp = 0; while (cond) { __builtin_amdgcn_s_sleep(1); \
    if ((++_sp & 255u) == 0u) { if (xb_ld(&(bar)[XB_TMO])) break; if (_sp > XB_SPIN_CAP) { atomicAdd(&(bar)[XB_TMO], 1u); break; } } } } while (0)

struct XcdBarrier {
    unsigned* bar; unsigned x;
    volatile LAS unsigned* st;
};

__device__ __forceinline__ XcdBarrier xcd_barrier_post(unsigned* bar, volatile LAS unsigned* st) {
    XcdBarrier b; b.bar = bar; b.x = xb_xcc_id(); b.st = st;
    if (threadIdx.x == 0) (void)xb_add(&bar[XB_XCNT(b.x)], 1u);
    return b;
}
__device__ __forceinline__ void xcd_barrier_complete(unsigned* bar, unsigned x, unsigned& nloc, unsigned& nx) {
    const unsigned G = gridDim.x * gridDim.y * gridDim.z;
    unsigned sum, cnt, mine, sp = 0u;
    for (;;) {
        sum = 0u; cnt = 0u; mine = 0u;
#pragma unroll
        for (unsigned j = 0; j < 16; ++j) { const unsigned c = xb_ld(&bar[XB_XCNT(j)]); sum += c; cnt += (c > 0u) ? 1u : 0u; mine = (j == x) ? c : mine; }
        if (sum == G) break;
        __builtin_amdgcn_s_sleep(1);
        if ((++sp & 255u) == 0u) { if (xb_ld(&bar[XB_TMO])) break; if (sp > XB_SPIN_CAP) { atomicAdd(&bar[XB_TMO], 1u); break; } }
    }
    nloc = mine > 0u ? mine : 1u; nx = cnt > 0u ? cnt : 1u;
}

__device__ __forceinline__ void xcd_barrier(const XcdBarrier& b) {
    asm volatile("s_waitcnt vmcnt(0)" ::: "memory");
    __syncthreads();
    if (threadIdx.x == 0) {
        unsigned* bar = b.bar;
        __builtin_amdgcn_s_waitcnt(0);
        unsigned nloc = b.st[0], nx = b.st[1];
        if (nloc == 0u) { xcd_barrier_complete(bar, b.x, nloc, nx); b.st[0] = nloc; b.st[1] = nx; }
        const unsigned old = xb_add(&bar[XB_XSUB(b.x)], 1u);
        const unsigned gen = old / nloc;
        if (old + 1u == (gen + 1u) * nloc) {
            __builtin_amdgcn_fence(__ATOMIC_RELEASE, "agent");
            asm volatile("s_waitcnt vmcnt(0)" ::: "memory");
            const unsigned og = xb_add(&bar[XB_TOP], 1u);
            const unsigned tg = og / nx;
            if (og + 1u == (tg + 1u) * nx) xb_add(&bar[XB_TOPGEN], 1u);
            else XB_SPIN(xb_ld(&bar[XB_TOPGEN]) == tg, bar);
            __builtin_amdgcn_fence(__ATOMIC_ACQUIRE, "agent");
            xb_add(&bar[XB_XGEN(b.x)], 1u);
            asm volatile("s_waitcnt vmcnt(0)" ::: "memory");
        } else {
            XB_SPIN(xb_ld(&bar[XB_XGEN(b.x)]) == gen, bar);
            __builtin_amdgcn_fence(__ATOMIC_ACQUIRE, "agent");
            asm volatile("s_waitcnt vmcnt(0)" ::: "memory");
        }
    }
    __syncthreads();
}

#define DI __device__ __forceinline__
typedef __bf16 bf16x2_t __attribute__((ext_vector_type(2)));
struct Args { const float* in[21]; float* out; unsigned char* ws; int ph_lo, ph_hi, li, pad; };
struct Frame {
    LAS unsigned char* lds;
    volatile LAS unsigned* MISC;
    gu32* ctl;
    int tid, lane, wave;
    int vcu, G;
    unsigned char* ws; float* out;
};
#define WSP(off) ((bf16*)(F.ws + (off)))
#define F_W1T WSP(WS_W1T)
#define F_WOT WSP(WS_WOT)
#define F_WXQT WSP(WS_WXQT)
#define F_WXOT WSP(WS_WXOT)
#define F_WXKVT WSP(WS_WXKVT)
#define F_WPQT WSP(WS_WPQT)
#define F_SUBK WSP(WS_SUBK)
#define F_UB WSP(WS_UB)
#define F_VB WSP(WS_VB)
#define F_BUFA WSP(WS_BUFA)
#define F_MN WSP(WS_MN)
#define F_KV WSP(WS_KV)
#define F_PROJ WSP(WS_PROJ)
#define F_SLOT0 WSP(WS_SLOT0)
#define F_SLOT1 WSP(WS_SLOT1)
#define F_SLOT2 WSP(WS_SLOT2)
#define F_VT WSP(WS_VT)
DI float bf2f(unsigned v) { return __uint_as_float(v << 16); }
DI float bflo(unsigned w) { return __uint_as_float(w << 16); }
DI float bfhi(unsigned w) { return __uint_as_float(w & 0xffff0000u); }
DI float wave_sum(float v) {
#pragma unroll
    for (int o = 1; o < 64; o <<= 1) v += __shfl_xor(v, o);
    return v;
}
DI float wave_max(float v) {
#pragma unroll
    for (int o = 1; o < 64; o <<= 1) v = fmaxf(v, __shfl_xor(v, o));
    return v;
}
DI float dot2_bf16(unsigned w, unsigned x, float a) { return __builtin_amdgcn_fdot2_f32_bf16(__builtin_bit_cast(bf16x2_t, w), __builtin_bit_cast(bf16x2_t, x), a, false); }
DI float silu_f(float x) { return x * __builtin_amdgcn_rcpf(1.f + __expf(-x)); }
DI float log_sigmoid_f(float z) { return fminf(z, 0.f) - __logf(1.f + __expf(-fabsf(z))); }
DI float gelu_tanh_f(float x) { const float y = 0.7978845608028654f * (x + 0.044715f * x * x * x); const float t = 1.f - 2.f / (1.f + __expf(2.f * y)); return 0.5f * x * (1.f + t); }

DI void p0_transpose_item(const float* W, int ldw, int c0, bf16* WT, int row_off, LAS float* scr, int kb, int nb, int lane, const float* kgain = nullptr) {
    const int k0 = 64 * kb, n0 = 32 * nb;
    float tv[32];
#pragma unroll
    for (int i = 0; i < 32; ++i) tv[i] = W[(size_t)(k0 + 2 * i + (lane >> 5)) * ldw + c0 + n0 + (lane & 31)];
    if (kgain) {
#pragma unroll
        for (int i = 0; i < 32; ++i) tv[i] *= kgain[k0 + 2 * i + (lane >> 5)];
    }
#pragma unroll
    for (int i = 0; i < 32; ++i) scr[(2 * i + (lane >> 5)) * 33 + (lane & 31)] = tv[i];
    LDS_WAIT(); asm volatile("" ::: "memory");
    const int c = lane & 7;
#pragma unroll
    for (int j = 0; j < 4; ++j) { const int n = (lane >> 3) + 8 * j; const LAS float* s = scr + (8 * c) * 33 + n;
        v4u o; o.x = pk2(s[0 * 33], s[1 * 33]); o.y = pk2(s[2 * 33], s[3 * 33]); o.z = pk2(s[4 * 33], s[5 * 33]); o.w = pk2(s[6 * 33], s[7 * 33]);
        *(GAS v4u*)(WT + (size_t)(row_off + n0 + n) * 1024 + k0 + 8 * c) = o; }
    LDS_WAIT(); asm volatile("" ::: "memory");
}
DI void rms_row_to_bf16(int lane, const float* xrow, const float* g, bf16* orow) {
    const GAS f32x4* xr = (const GAS f32x4*)xrow + lane; const GAS f32x4* gr = (const GAS f32x4*)g + lane;
    f32x4 v[4]; float s = 0.f;
#pragma unroll
    for (int j = 0; j < 4; ++j) { v[j] = xr[64 * j]; s += (v[j].x * v[j].x + v[j].y * v[j].y) + (v[j].z * v[j].z + v[j].w * v[j].w); }
    const float rs = 1.f / sqrtf(wave_sum(s) * (1.f / 1024.f) + EPS);
    GAS unsigned long long* o8 = (GAS unsigned long long*)orow + lane;
#pragma unroll
    for (int j = 0; j < 4; ++j) { const f32x4 gg = gr[64 * j]; const f32x4 y = v[j] * rs * gg; o8[64 * j] = (unsigned long long)pk2(y.x, y.y) | ((unsigned long long)pk2(y.z, y.w) << 32); }
}
typedef float f32x2 __attribute__((ext_vector_type(2)));
constexpr size_t WS_U8 = 24 * MiB, WS_V8 = 40 * MiB, WS_X8 = 56 * MiB, WS_SU = 72 * MiB, WS_SX = 72 * MiB + 65536, WS_SV = 72 * MiB + 131072;
template <int CTRL> DI int dpp_i(int v) { return __builtin_amdgcn_update_dpp(0, v, CTRL, 0xf, 0xf, false); }
DI void quant_row_i8(int lane, const float* src, unsigned char* dst, float* scale_out) {
    f32x4 v[4]; float m = 0.f;
#pragma unroll
    for (int j = 0; j < 4; ++j) { v[j] = *(const GAS f32x4*)(src + 256 * j + 4 * lane); m = fmaxf(m, fmaxf(fmaxf(fabsf(v[j].x), fabsf(v[j].y)), fmaxf(fabsf(v[j].z), fabsf(v[j].w)))); }
    m = wave_max(m);
    const float sc = m > 0.f ? m * (1.f / 127.f) : 1.f, inv = 1.f / sc;
    v4u o;
#pragma unroll
    for (int j = 0; j < 4; ++j) { const int a = (int)rintf(v[j].x * inv), b = (int)rintf(v[j].y * inv), c = (int)rintf(v[j].z * inv), d = (int)rintf(v[j].w * inv);
        o[j] = (unsigned)(a & 255) | ((unsigned)(b & 255) << 8) | ((unsigned)(c & 255) << 16) | ((unsigned)(d & 255) << 24); }
    *(GAS v4u*)(dst + 16 * lane) = o;
    if (lane == 0) *scale_out = sc;
}
typedef float f32x16v __attribute__((ext_vector_type(16)));
typedef int i32x6v __attribute__((ext_vector_type(6)));
typedef unsigned u32x3v __attribute__((ext_vector_type(3)));
DI unsigned fp6_e2m3(float x) {
    const float m = fminf(fabsf(x), 7.5f);
    const int e = m >= 4.f ? 2 : m >= 2.f ? 1 : 0;
    const int q = (int)rintf(m * (e == 2 ? 2.f : e == 1 ? 4.f : 8.f));
    const unsigned code = e == 0 ? (unsigned)q : (unsigned)((e + 1) * 8 + (q - 8));
    return (x < 0.f ? 32u : 0u) | (code > 31u ? 31u : code);
}
DI void quant_row_fp6(int lane, const float* src, unsigned char* dst, float* sc) {
    float v[16]; float mx = 0.f;
#pragma unroll
    for (int j = 0; j < 4; ++j) { const f32x4 t = *(const GAS f32x4*)(src + 256 * j + 4 * lane);
#pragma unroll
        for (int i = 0; i < 4; ++i) { v[4 * j + i] = t[i]; mx = fmaxf(mx, fabsf(t[i])); } }
    mx = wave_max(mx);
    const float s_ = mx > 0.f ? mx * (1.f / 7.5f) : 1.f, inv = 1.f / s_;
    unsigned long long lo = 0ull; unsigned hi = 0u;
#pragma unroll
    for (int i = 0; i < 16; ++i) { const unsigned long long c = fp6_e2m3(v[i] * inv);
        if (6 * i < 64) lo |= c << (6 * i);
        if (6 * i + 6 > 64) hi |= (unsigned)(6 * i >= 64 ? c << (6 * i - 64) : c >> (64 - 6 * i)); }
    *(GAS u32x3v*)(dst + 12 * lane) = (u32x3v){(unsigned)lo, (unsigned)(lo >> 32), hi};
    if (lane == 0) *sc = s_;
}
DI void rms_row_to_bf16_i8(int lane, const float* xrow, const float* g, bf16* orow, unsigned char* qrow, float* sx) {
    const GAS f32x4* xr = (const GAS f32x4*)xrow + lane; const GAS f32x4* gr = (const GAS f32x4*)g + lane;
    f32x4 v[4]; float s = 0.f;
#pragma unroll
    for (int j = 0; j < 4; ++j) { v[j] = xr[64 * j]; s += (v[j].x * v[j].x + v[j].y * v[j].y) + (v[j].z * v[j].z + v[j].w * v[j].w); }
    const float rs = 1.f / sqrtf(wave_sum(s) * (1.f / 1024.f) + EPS);
    GAS unsigned long long* o8 = (GAS unsigned long long*)orow + lane; float m = 0.f;
#pragma unroll
    for (int j = 0; j < 4; ++j) { const f32x4 gg = gr[64 * j]; v[j] = v[j] * rs * gg; o8[64 * j] = (unsigned long long)pk2(v[j].x, v[j].y) | ((unsigned long long)pk2(v[j].z, v[j].w) << 32);
        m = fmaxf(m, fmaxf(fmaxf(fabsf(v[j].x), fabsf(v[j].y)), fmaxf(fabsf(v[j].z), fabsf(v[j].w)))); }
    m = wave_max(m);
    const float sc = m > 0.f ? m * (1.f / 127.f) : 1.f, inv = 1.f / sc;
#pragma unroll
    for (int j = 0; j < 4; ++j) { const int a = (int)rintf(v[j].x * inv), b = (int)rintf(v[j].y * inv), c = (int)rintf(v[j].z * inv), d = (int)rintf(v[j].w * inv);
        *(GAS unsigned*)(qrow + 4 * lane + 256 * j) = (unsigned)(a & 255) | ((unsigned)(b & 255) << 8) | ((unsigned)(c & 255) << 16) | ((unsigned)(d & 255) << 24); }
    if (lane == 0) *sx = sc;
}
template <int R> DI void rms_rows_to_bf16(int lane, const float* x0, size_t xstride, const float* g, bf16* o0, size_t ostride) {
    f32x4 v[R][4];
#pragma unroll
    for (int r = 0; r < R; ++r)
#pragma unroll
        for (int j = 0; j < 4; ++j) v[r][j] = *((const GAS f32x4*)(x0 + r * xstride) + lane + 64 * j);
    f32x4 gg[4];
#pragma unroll
    for (int j = 0; j < 4; ++j) gg[j] = *((const GAS f32x4*)g + lane + 64 * j);
#pragma unroll
    for (int r = 0; r < R; ++r) { float s = 0.f;
#pragma unroll
        for (int j = 0; j < 4; ++j) s += (v[r][j].x * v[r][j].x + v[r][j].y * v[r][j].y) + (v[r][j].z * v[r][j].z + v[r][j].w * v[r][j].w);
        const float rs = 1.f / sqrtf(wave_sum(s) * (1.f / 1024.f) + EPS);
        GAS unsigned long long* o8 = (GAS unsigned long long*)(o0 + r * ostride) + lane;
#pragma unroll
        for (int j = 0; j < 4; ++j) { const f32x4 y = v[r][j] * rs * gg[j]; o8[64 * j] = (unsigned long long)pk2(y.x, y.y) | ((unsigned long long)pk2(y.z, y.w) << 32); } }
}
DI void p0_prologue(Frame& F, const Args& A) {
    LAS float* scr = (LAS float*)(F.lds + F.wave * 16384);
    const int gw = F.vcu * NWAVES + F.wave, NGW = F.G * NWAVES;
    constexpr int I_IN = 16 * 48, I_W2 = 16 * 64;
    constexpr int NIT = 2 * I_IN + I_W2;
    for (int it = gw; it < NIT; it += NGW) {
        int r = it;
        if (r < I_IN) { p0_transpose_item(A.in[3], INCOLS, 0, F_W1T, 0, scr, r / 48, r % 48, F.lane); continue; } r -= I_IN;
        if (r < I_IN) { p0_transpose_item(A.in[3], INCOLS, 1552, F_W1T, 1536, scr, r / 48, r % 48, F.lane); continue; } r -= I_IN;
        p0_transpose_item(A.in[13], 2048, 0, F_WXKVT, 0, scr, r / 64, r % 64, F.lane);
    }
    const int gt = gw * 64 + F.lane, NGT = NGW * 64;
    for (int i = gt; i < 256 * 128; i += NGT) {
        const int n = i >> 7, k0 = (i & 127) * 8;
        float gv[16];
#pragma unroll
        for (int r = 0; r < 16; ++r) gv[r] = A.in[5][r * 256 + n];
        float s[8];
#pragma unroll
        for (int j = 0; j < 8; ++j) { const float* wr_ = A.in[3] + (size_t)(k0 + j) * INCOLS + 1536; float a = 0.f;
#pragma unroll
            for (int r = 0; r < 16; ++r) a += wr_[r] * gv[r];
            s[j] = a; }
        v4u o; o.x = pk2(s[0], s[1]); o.y = pk2(s[2], s[3]); o.z = pk2(s[4], s[5]); o.w = pk2(s[6], s[7]);
        *(GAS v4u*)(F_W1T + (size_t)(3072 + n) * 1024 + k0) = o;
    }
    for (int m = 4 * gw; m < M; m += 4 * NGW) rms_rows_to_bf16<4>(F.lane, A.in[0] + (size_t)m * DM, DM, A.in[2], F_BUFA + (size_t)m * DM, DM);
    for (int m = gw; m < MM; m += NGW) rms_row_to_bf16(F.lane, A.in[1] + (size_t)m * DM, A.in[11], F_MN + (size_t)m * DM);
}
template <int R> DI void quant_rows_i8(int lane, const float* src, unsigned char* dst, float* scale_out) {
    f32x4 v[R][4];
#pragma unroll
    for (int r = 0; r < R; ++r)
#pragma unroll
        for (int j = 0; j < 4; ++j) v[r][j] = *(const GAS f32x4*)(src + (size_t)r * 1024 + 256 * j + 4 * lane);
#pragma unroll
    for (int r = 0; r < R; ++r) { float m = 0.f;
#pragma unroll
        for (int j = 0; j < 4; ++j) m = fmaxf(m, fmaxf(fmaxf(fabsf(v[r][j].x), fabsf(v[r][j].y)), fmaxf(fabsf(v[r][j].z), fabsf(v[r][j].w))));
        m = wave_max(m);
        const float sc = m > 0.f ? m * (1.f / 127.f) : 1.f, inv = 1.f / sc;
        v4u o;
#pragma unroll
        for (int j = 0; j < 4; ++j) { const int a = (int)rintf(v[r][j].x * inv), b = (int)rintf(v[r][j].y * inv), c = (int)rintf(v[r][j].z * inv), d = (int)rintf(v[r][j].w * inv);
            o[j] = (unsigned)(a & 255) | ((unsigned)(b & 255) << 8) | ((unsigned)(c & 255) << 16) | ((unsigned)(d & 255) << 24); }
        *(GAS v4u*)(dst + (size_t)r * 1024 + 16 * lane) = o;
        if (lane == 0) scale_out[r] = sc; }
}
template <int R> DI void quant_rows_fp6(int lane, const float* src, unsigned char* dst, float* sc) {
    f32x4 t[R][4];
#pragma unroll
    for (int r = 0; r < R; ++r)
#pragma unroll
        for (int j = 0; j < 4; ++j) t[r][j] = *(const GAS f32x4*)(src + (size_t)r * 1024 + 256 * j + 4 * lane);
#pragma unroll
    for (int r = 0; r < R; ++r) { float mx = 0.f;
#pragma unroll
        for (int j = 0; j < 4; ++j) mx = fmaxf(mx, fmaxf(fmaxf(fabsf(t[r][j].x), fabsf(t[r][j].y)), fmaxf(fabsf(t[r][j].z), fabsf(t[r][j].w))));
        mx = wave_max(mx);
        const float s_ = mx > 0.f ? mx * (1.f / 7.5f) : 1.f, inv = 1.f / s_;
        unsigned long long lo = 0ull; unsigned hi = 0u;
#pragma unroll
        for (int i = 0; i < 16; ++i) { const unsigned long long c = fp6_e2m3(t[r][i >> 2][i & 3] * inv);
            if (6 * i < 64) lo |= c << (6 * i);
            if (6 * i + 6 > 64) hi |= (unsigned)(6 * i >= 64 ? c << (6 * i - 64) : c >> (64 - 6 * i)); }
        *(GAS u32x3v*)(dst + (size_t)r * 768 + 12 * lane) = (u32x3v){(unsigned)lo, (unsigned)(lo >> 32), hi};
        if (lane == 0) sc[r] = s_; }
}
DI void p0_late(Frame& F, const Args& A, int widx, int nw) {
    LAS float* scr = (LAS float*)(F.lds + F.wave * 16384);
    constexpr int I_SQ = 16 * 32, I_W2 = 16 * 64;
    for (int it = widx; it < 3 * I_SQ + I_W2; it += nw) {
        int r = it;
        if (r < I_SQ) { p0_transpose_item(A.in[9], 1024, 0, F_WOT, 0, scr, r / 32, r % 32, F.lane); continue; } r -= I_SQ;
        if (r < I_SQ) { p0_transpose_item(A.in[12], 1024, 0, F_WXQT, 0, scr, r / 32, r % 32, F.lane, A.in[10]); continue; } r -= I_SQ;
        if (r < I_SQ) { p0_transpose_item(A.in[14], 1024, 0, F_WXOT, 0, scr, r / 32, r % 32, F.lane); continue; } r -= I_SQ;
        p0_transpose_item(A.in[16], 2048, 0, F_WPQT, 0, scr, r / 64, r % 64, F.lane, A.in[15]);
    }
    for (int i = widx * 64 + F.lane; i < 32768; i += nw * 64) {
        const f32x4 a = *(const GAS f32x4*)(A.in[17] + (size_t)i * 8), b = *(const GAS f32x4*)(A.in[17] + (size_t)i * 8 + 4);
        v4u o; o.x = pk2(a.x, a.y); o.y = pk2(a.z, a.w); o.z = pk2(b.x, b.y); o.w = pk2(b.z, b.w);
        *(GAS v4u*)(F_SUBK + (size_t)i * 8) = o;
    }
    for (int m = 4 * widx; m < PEER_N; m += 4 * nw) quant_rows_i8<4>(F.lane, A.in[18] + (size_t)m * DM, F.ws + WS_U8 + (size_t)m * 1024, (float*)(F.ws + WS_SU) + m);
    for (int m = 4 * widx; m < PEER_N; m += 4 * nw) quant_rows_fp6<4>(F.lane, A.in[19] + (size_t)m * DM, F.ws + WS_V8 + (size_t)m * 768, (float*)(F.ws + WS_SV) + m);
}

DI void gla_naive_item(Frame& F, const Args& A, float* OGLA, int b, int h, int eg) {
    const int lane = F.lane, e = eg * 8 + F.wave;
    const int cq = PQ + h * 64 + lane, ck = PK + h * 64 + lane, cv = PV + h * 128 + e, cg = PGATE + h * 64 + lane;
    float wq[4], wk[4], wv[4];
#pragma unroll
    for (int k = 0; k < 4; ++k) { wq[k] = A.in[4][k * 1024 + cq]; wk[k] = A.in[4][k * 1024 + ck]; wv[k] = A.in[4][k * 1024 + cv]; }
    const float bias = A.in[6][h * 64 + lane];
    float rq0 = 0.f, rq1 = 0.f, rq2 = 0.f, rk0 = 0.f, rk1 = 0.f, rk2 = 0.f, rv0 = 0.f, rv1 = 0.f, rv2 = 0.f, S = 0.f;
    for (int t0 = 0; t0 < SEQ; t0 += 8) {
        unsigned lq[8], lk[8], lv[8], lg[8];
#pragma unroll
        for (int j = 0; j < 8; ++j) { const bf16* base = F_PROJ + (size_t)(b * SEQ + t0 + j) * N1; lq[j] = base[cq]; lk[j] = base[ck]; lv[j] = base[cv]; lg[j] = base[cg]; }
#pragma unroll
        for (int j = 0; j < 8; ++j) {
            const float xq = bf2f(lq[j]), xk = bf2f(lk[j]), xv = bf2f(lv[j]);
            const float q = silu_f(wq[0] * rq0 + wq[1] * rq1 + wq[2] * rq2 + wq[3] * xq) * 0.125f; rq0 = rq1; rq1 = rq2; rq2 = xq;
            const float k = silu_f(wk[0] * rk0 + wk[1] * rk1 + wk[2] * rk2 + wk[3] * xk); rk0 = rk1; rk1 = rk2; rk2 = xk;
            const float v = silu_f(wv[0] * rv0 + wv[1] * rv1 + wv[2] * rv2 + wv[3] * xv); rv0 = rv1; rv1 = rv2; rv2 = xv;
            const float a = __expf(log_sigmoid_f(bf2f(lg[j]) + bias) * (1.f / 16.f));
            S = a * S + k * v;
            const float o = wave_sum(q * S);
            if (lane == 0) OGLA[(size_t)(b * SEQ + t0 + j) * 512 + h * 128 + e] = o;
        }
    }
}
DI void sb_naive_item(Frame& F, float* OSB, int b, int h, int qb) {
    LAS float* Ks = (LAS float*)F.lds; LAS float* Vs = Ks + 64 * 64;
    const int tid = F.tid, t = qb * 512 + tid; const size_t row = (size_t)b * SEQ + t;
    float q[64], acc[64];
    {
        const GAS v4u* qp = (const GAS v4u*)(F_PROJ + row * N1 + PSQ + h * 64);
#pragma unroll
        for (int c = 0; c < 8; ++c) { const v4u w = qp[c]; q[8 * c + 0] = bflo(w.x) * 0.125f; q[8 * c + 1] = bfhi(w.x) * 0.125f; q[8 * c + 2] = bflo(w.y) * 0.125f; q[8 * c + 3] = bfhi(w.y) * 0.125f;
            q[8 * c + 4] = bflo(w.z) * 0.125f; q[8 * c + 5] = bfhi(w.z) * 0.125f; q[8 * c + 6] = bflo(w.w) * 0.125f; q[8 * c + 7] = bfhi(w.w) * 0.125f; }
    }
#pragma unroll
    for (int d = 0; d < 64; ++d) acc[d] = 0.f;
    float carry = 0.f;
    for (int kt = qb * 8 + 7; kt >= 0; --kt) {
        __syncthreads();
        {
            const int key = tid >> 3, ch = tid & 7; const size_t krow = (size_t)b * SEQ + kt * 64 + key;
            const v4u kw = *(const GAS v4u*)(F_PROJ + krow * N1 + PSK + h * 64 + ch * 8), vw = *(const GAS v4u*)(F_PROJ + krow * N1 + PSV + h * 64 + ch * 8);
            LAS f32x4* kd = (LAS f32x4*)(Ks + key * 64 + ch * 8); LAS f32x4* vd = (LAS f32x4*)(Vs + key * 64 + ch * 8);
            kd[0] = (f32x4){bflo(kw.x), bfhi(kw.x), bflo(kw.y), bfhi(kw.y)}; kd[1] = (f32x4){bflo(kw.z), bfhi(kw.z), bflo(kw.w), bfhi(kw.w)};
            vd[0] = (f32x4){bflo(vw.x), bfhi(vw.x), bflo(vw.y), bfhi(vw.y)}; vd[1] = (f32x4){bflo(vw.z), bfhi(vw.z), bflo(vw.w), bfhi(vw.w)};
        }
        __syncthreads();
        for (int j = 63; j >= 0; --j) {
            const int s = kt * 64 + j;
            if (s < t) {
                const LAS f32x4* kr = (const LAS f32x4*)(Ks + j * 64); const LAS f32x4* vr = (const LAS f32x4*)(Vs + j * 64);
                float z0 = 0.f, z1 = 0.f, z2 = 0.f, z3 = 0.f;
#pragma unroll
                for (int c = 0; c < 16; ++c) { const f32x4 kk = kr[c]; z0 += q[4 * c] * kk.x; z1 += q[4 * c + 1] * kk.y; z2 += q[4 * c + 2] * kk.z; z3 += q[4 * c + 3] * kk.w; }
                const float z = (z0 + z1) + (z2 + z3);
                const float lb = log_sigmoid_f(z);
                const float w = __expf(lb + carry);
                carry += lb - z;
#pragma unroll
                for (int c = 0; c < 16; ++c) { const f32x4 vv = vr[c]; acc[4 * c] += w * vv.x; acc[4 * c + 1] += w * vv.y; acc[4 * c + 2] += w * vv.z; acc[4 * c + 3] += w * vv.w; }
            }
        }
    }
    GAS f32x4* op = (GAS f32x4*)(OSB + row * 512 + h * 64);
#pragma unroll
    for (int c = 0; c < 16; ++c) op[c] = (f32x4){acc[4 * c], acc[4 * c + 1], acc[4 * c + 2], acc[4 * c + 3]};
}
typedef float f32x16 __attribute__((ext_vector_type(16)));
typedef short s16x4 __attribute__((ext_vector_type(4)));
DI s16x4 lds_tr16(const LAS unsigned char* p) { return __builtin_bit_cast(s16x4, __builtin_amdgcn_ds_read_tr16_b64_v4i16((LAS s16x4*)p)); }
DI unsigned cvtpk_bf16(float lo, float hi) { typedef float f2 __attribute__((ext_vector_type(2))); f2 v = {lo, hi}; bf16x2_t b = __builtin_convertvector(v, bf16x2_t); return __builtin_bit_cast(unsigned, b); }
constexpr float SB_C2 = 0.125f * 1.4426950408889634f;
template <bool MASKED> DI void sb_weights(f32x16& P0, f32x16& P1, float& carry, int hi, int qrel2) {
    float T[8], cs[8];
#pragma unroll
    for (int pi = 0; pi < 2; ++pi) {
        f32x16& P = pi ? P1 : P0;
#pragma unroll
        for (int g = 0; g < 4; ++g) {
            float lbv[4], l1v[4];
#pragma unroll
            for (int i = 0; i < 4; ++i) {
                const float z2 = P[4 * g + i] * SB_C2;
                const float sp = __builtin_amdgcn_logf(1.f + __builtin_amdgcn_exp2f(-fabsf(z2)));
                float lb = fminf(z2, 0.f) - sp, l1 = lb - z2;
                if (MASKED) { const bool valid = (32 * pi + 8 * g + 4 * hi + i) < qrel2; lb = valid ? lb : -INFINITY; l1 = valid ? l1 : 0.f; }
                lbv[i] = lb; l1v[i] = l1;
            }
            const float a = l1v[3], b = a + l1v[2], c = b + l1v[1];
            cs[4 * pi + g] = c + l1v[0];
            P[4 * g + 3] = lbv[3]; P[4 * g + 2] = lbv[2] + a; P[4 * g + 1] = lbv[1] + b; P[4 * g + 0] = lbv[0] + c;
        }
    }
#pragma unroll
    for (int k = 0; k < 8; ++k) { auto rr = __builtin_amdgcn_permlane32_swap(__float_as_uint(cs[k]), __float_as_uint(cs[k]), false, false); T[k] = __uint_as_float(rr[0]) + __uint_as_float(rr[1]); }
    const float m0 = hi ? 0.f : 1.f;
    float run = carry;
#pragma unroll
    for (int k = 7; k >= 0; --k) {
        const float E = run + m0 * (T[k] - cs[k]);
        f32x16& P = (k >> 2) ? P1 : P0; const int g = k & 3;
#pragma unroll
        for (int i = 0; i < 4; ++i) P[4 * g + i] = __builtin_amdgcn_exp2f(P[4 * g + i] + E);
        run += T[k];
    }
    carry = run;
}
DI void sb_unit(Frame& F, float* OSB, int b, int h, int qb) {
    const int tid = F.tid, lane = F.lane, wid = F.wave, r32 = lane & 31, hi = lane >> 5;
    const int q0 = qb * 256; const size_t rowbase = (size_t)b * SEQ;
    const bf16* Kg = F_PROJ + rowbase * N1 + PSK + h * 64;
    const bf16* Vg = F_PROJ + rowbase * N1 + PSV + h * 64;
    bf16x8 qr[4];
    { const bf16* Qw = F_PROJ + (rowbase + q0 + wid * 32 + r32) * N1 + PSQ + h * 64;
#pragma unroll
      for (int ks = 0; ks < 4; ++ks) qr[ks] = *(const GAS bf16x8*)(Qw + ks * 16 + hi * 8); }
    const bf16* ksrc = Kg + (size_t)(tid >> 3) * N1 + (tid & 7) * 8;
    const bf16* vsrc = Vg + (size_t)(16 * (wid & 3) + (lane >> 2)) * N1 + (wid >> 2) * 32 + (lane & 3) * 8;
    const int kdst = (tid & 7) * 1024 + (tid >> 3) * 16, vdst = 8192 + wid * 1024 + lane * 16;
    const int kfr = hi * 1024 + r32 * 16;
    const int vfr = 8192 + ((lane >> 4) & 1) * 32 + (lane & 3) * 8 + (4 * hi + ((lane & 15) >> 2)) * 64;
    f32x16 o0 = {}, o1 = {};
    float carry = 0.f;
    const int ktmax = (q0 >> 6) + 3;
    v4u kreg = *(const GAS v4u*)(ksrc + (size_t)ktmax * 64 * N1), vreg = *(const GAS v4u*)(vsrc + (size_t)ktmax * 64 * N1);
    __syncthreads();
    *(LAS v4u*)(F.lds + kdst) = kreg; *(LAS v4u*)(F.lds + vdst) = vreg;
    __syncthreads();
    int cur = 0;
    const int wrow0 = q0 + wid * 32;
    bool wdone = false;
    LAS unsigned* flags = (LAS unsigned*)(F.lds + 32768);
    for (int kt = ktmax; kt >= 0; --kt) {
        if (kt > 0) { kreg = *(const GAS v4u*)(ksrc + (size_t)(kt - 1) * 64 * N1); vreg = *(const GAS v4u*)(vsrc + (size_t)(kt - 1) * 64 * N1); }
        const int k0 = kt * 64;
        if (!wdone && k0 <= wrow0 + 30) {
            const LAS unsigned char* Kb = F.lds + cur * 16384;
            f32x16 P0 = {}, P1 = {};
#pragma unroll
            for (int ks = 0; ks < 4; ++ks) {
                const bf16x8 a0 = *(const LAS bf16x8*)(Kb + kfr + ks * 2048), a1 = *(const LAS bf16x8*)(Kb + kfr + ks * 2048 + 512);
                P0 = __builtin_amdgcn_mfma_f32_32x32x16_bf16(a0, qr[ks], P0, 0, 0, 0);
                P1 = __builtin_amdgcn_mfma_f32_32x32x16_bf16(a1, qr[ks], P1, 0, 0, 0);
            }
            if (k0 + 63 >= wrow0) sb_weights<true>(P0, P1, carry, hi, wrow0 + r32 - k0);
            else sb_weights<false>(P0, P1, carry, hi, 0);
#pragma unroll
            for (int s = 0; s < 4; ++s) {
                const f32x16& P = (s >> 1) ? P1 : P0; const int rb = (s & 1) * 8;
                v4u pw; pw.x = cvtpk_bf16(P[rb + 0], P[rb + 1]); pw.y = cvtpk_bf16(P[rb + 2], P[rb + 3]); pw.z = cvtpk_bf16(P[rb + 4], P[rb + 5]); pw.w = cvtpk_bf16(P[rb + 6], P[rb + 7]);
                const bf16x8 pa = __builtin_bit_cast(bf16x8, pw);
                const LAS unsigned char* vp = Kb + vfr + s * 1024;
                const s16x4 l0 = lds_tr16(vp), h0 = lds_tr16(vp + 512), l1 = lds_tr16(vp + 4096), h1 = lds_tr16(vp + 4096 + 512);
                const bf16x8 v0 = {l0[0], l0[1], l0[2], l0[3], h0[0], h0[1], h0[2], h0[3]}, v1 = {l1[0], l1[1], l1[2], l1[3], h1[0], h1[1], h1[2], h1[3]};
                o0 = __builtin_amdgcn_mfma_f32_32x32x16_bf16(pa, v0, o0, 0, 0, 0);
                o1 = __builtin_amdgcn_mfma_f32_32x32x16_bf16(pa, v1, o1, 0, 0, 0);
            }
            wdone = __all(carry < -160.f);
        }
        if (lane == 0) flags[(kt & 1) * 8 + wid] = wdone ? 1u : 0u;
        if (kt > 0) { *(LAS v4u*)(F.lds + (cur ^ 1) * 16384 + kdst) = kreg; *(LAS v4u*)(F.lds + (cur ^ 1) * 16384 + vdst) = vreg; }
        __syncthreads();
        cur ^= 1;
        { const v4u f0 = *(const LAS v4u*)(flags + (kt & 1) * 8), f1 = *(const LAS v4u*)(flags + (kt & 1) * 8 + 4);
          if ((f0.x & f0.y & f0.z & f0.w & f1.x & f1.y & f1.z & f1.w) != 0u) break; }
    }
    float* op = OSB + (rowbase + wrow0) * 512 + h * 64 + r32;
#pragma unroll
    for (int r = 0; r < 16; ++r) { const int qrow = (r & 3) + 8 * (r >> 2) + 4 * hi; op[(size_t)qrow * 512] = o0[r]; op[(size_t)qrow * 512 + 32] = o1[r]; }
}
DI void sb_wave(Frame& F, float* OSB, int b, int h, int rb) {
    const int lane = F.lane, wid = F.wave, r32 = lane & 31, hi = lane >> 5;
    const size_t rowbase = (size_t)b * SEQ; const int wrow0 = rb * 32;
    const bf16* Kg = F_PROJ + rowbase * N1 + PSK + h * 64;
    const bf16* Vg = F_PROJ + rowbase * N1 + PSV + h * 64;
    bf16x8 qr[4];
    { const bf16* Qw = F_PROJ + (rowbase + wrow0 + r32) * N1 + PSQ + h * 64;
#pragma unroll
      for (int ks = 0; ks < 4; ++ks) qr[ks] = *(const GAS bf16x8*)(Qw + ks * 16 + hi * 8); }
    LAS unsigned char* vbuf = F.lds + wid * 16384;
    const int vfr = ((lane >> 4) & 1) * 32 + (lane & 3) * 8 + (4 * hi + ((lane & 15) >> 2)) * 64;
    const unsigned ko0 = (unsigned)(r32 * N1 + hi * 8) * 2u, ko1 = ko0 + 32u * N1 * 2u;
    unsigned vo[4];
#pragma unroll
    for (int i = 0; i < 4; ++i) vo[i] = (unsigned)(((lane >> 2) + 16 * i) * N1 + (lane & 3) * 8) * 2u;
    f32x16 o0 = {}, o1 = {};
    float carry = 0.f;
    int kt = (wrow0 + 30) >> 6;
    bf16x8 kf[8]; v4u vr[8];
#define SBW_LOADK(t) do { const char* kb_ = (const char*)Kg + (size_t)(t) * 64 * N1 * 2; _Pragma("unroll") for (int ks = 0; ks < 4; ++ks) { kf[2 * ks] = *(const GAS bf16x8*)(kb_ + ko0 + ks * 32); kf[2 * ks + 1] = *(const GAS bf16x8*)(kb_ + ko1 + ks * 32); } } while (0)
#define SBW_LOADV(t) do { const char* vb_ = (const char*)Vg + (size_t)(t) * 64 * N1 * 2; _Pragma("unroll") for (int p = 0; p < 8; ++p) vr[p] = *(const GAS v4u*)(vb_ + vo[p & 3] + (p >> 2) * 64); } while (0)
    SBW_LOADK(kt); SBW_LOADV(kt);
    int cur = 0;
    for (;;) {
        const int k0 = kt * 64;
#pragma unroll
        for (int p = 0; p < 8; ++p) *(LAS v4u*)(vbuf + cur * 8192 + p * 1024 + lane * 16) = vr[p];
        f32x16 P0 = {}, P1 = {};
#pragma unroll
        for (int ks = 0; ks < 4; ++ks) { P0 = __builtin_amdgcn_mfma_f32_32x32x16_bf16(kf[2 * ks], qr[ks], P0, 0, 0, 0); P1 = __builtin_amdgcn_mfma_f32_32x32x16_bf16(kf[2 * ks + 1], qr[ks], P1, 0, 0, 0); }
        __builtin_amdgcn_sched_barrier(0);
        if (kt > 0) SBW_LOADV(kt - 1);
        __builtin_amdgcn_sched_barrier(0);
        if (k0 + 63 >= wrow0) sb_weights<true>(P0, P1, carry, hi, wrow0 + r32 - k0);
        else sb_weights<false>(P0, P1, carry, hi, 0);
        __builtin_amdgcn_sched_barrier(0);
        if (kt > 0) SBW_LOADK(kt - 1);
        __builtin_amdgcn_sched_barrier(0);
        LDS_WAIT();
#pragma unroll
        for (int s = 0; s < 4; ++s) {
            const f32x16& P = (s >> 1) ? P1 : P0; const int rbb = (s & 1) * 8;
            v4u pw; pw.x = cvtpk_bf16(P[rbb + 0], P[rbb + 1]); pw.y = cvtpk_bf16(P[rbb + 2], P[rbb + 3]); pw.z = cvtpk_bf16(P[rbb + 4], P[rbb + 5]); pw.w = cvtpk_bf16(P[rbb + 6], P[rbb + 7]);
            const bf16x8 pa = __builtin_bit_cast(bf16x8, pw);
            const LAS unsigned char* vq = vbuf + cur * 8192 + vfr + s * 1024;
            const s16x4 l0 = lds_tr16(vq), h0 = lds_tr16(vq + 512), l1 = lds_tr16(vq + 4096), h1 = lds_tr16(vq + 4096 + 512);
            const bf16x8 v0 = {l0[0], l0[1], l0[2], l0[3], h0[0], h0[1], h0[2], h0[3]}, v1 = {l1[0], l1[1], l1[2], l1[3], h1[0], h1[1], h1[2], h1[3]};
            o0 = __builtin_amdgcn_mfma_f32_32x32x16_bf16(pa, v0, o0, 0, 0, 0);
            o1 = __builtin_amdgcn_mfma_f32_32x32x16_bf16(pa, v1, o1, 0, 0, 0);
        }
        if (kt == 0 || __all(carry < -160.f)) break;
        --kt; cur ^= 1;
    }
#undef SBW_LOADK
#undef SBW_LOADV
    {
        char* ub = (char*)(OSB + (rowbase + wrow0) * 512 + h * 64); const unsigned lo_ = (unsigned)(4 * hi * 512 + r32) * 4u;
#pragma unroll
        for (int r = 0; r < 16; ++r) { char* rp = ub + ((r & 3) + 8 * (r >> 2)) * 2048; *(GAS float*)(rp + lo_) = o0[r]; *(GAS float*)(rp + lo_ + 128) = o1[r]; }
    }
    LDS_WAIT();
}
constexpr int GL_CS = 1040;
constexpr int GL_QT = 0, GL_KT = 8320, GL_KD = 16384, GL_V = 28672, GL_ST = 49152, GL_SEG = 69632, GL_RED = 71680, GL_KDP = 192, GL_VP = 320;
constexpr int CW_DECAY = 65536;
template <bool ACC> DI bf16x8 tr_frag(const LAS unsigned char* base, int PB, int x0, int k0, int lane) {
    const int hi = lane >> 5, rr = (lane & 15) >> 2, col = x0 + 16 * ((lane >> 4) & 1) + 4 * (lane & 3);
    const int r0 = ACC ? (k0 + 4 * hi + rr) : (k0 + 8 * hi + rr), r1 = ACC ? (r0 + 8) : (r0 + 4);
    const s16x4 a = lds_tr16(base + r0 * PB + col * 2), b = lds_tr16(base + r1 * PB + col * 2);
    return (bf16x8){a[0], a[1], a[2], a[3], b[0], b[1], b[2], b[3]};
}
constexpr int GL_RQ = 73728, GL_RK = 82432, GL_RG = 91136, GL_RV = 99328;
DI void gla_stage_load(Frame& F, int b, int h, int n, v4u (&w)[6]) {
    const int tid = F.tid; const size_t row0 = (size_t)b * SEQ + 64 * n;
#pragma unroll
    for (int i = 0; i < 6; ++i) {
        const int c = tid + 512 * i;
        const int reg = (c >= 536) + (c >= 1072) + (c >= 1584);
        const int cc = c - (reg == 1 ? 536 : reg == 2 ? 1072 : reg == 3 ? 1584 : 0);
        const int rr = reg == 3 ? (cc >> 4) : (cc >> 3), ch = reg == 3 ? (cc & 15) : (cc & 7);
        const int r = rr + (reg == 2 ? 3 : 0);
        const int col = (reg == 0 ? PQ + h * 64 : reg == 1 ? PK + h * 64 : reg == 2 ? PGATE + h * 64 : PV + h * 128) + ch * 8;
        const bool ok = (c < 2656) && (64 * n - 3 + r >= 0);
        w[i] = (v4u){0u, 0u, 0u, 0u};
        if (ok) w[i] = *(const GAS v4u*)(F_PROJ + (row0 - 3 + r) * N1 + col);
    }
}
template <int MODE> DI void gla_prep(Frame& F, const Args& A, int b, int h, int n, const v4u (&w)[6]) {
    const int tid = F.tid, d = tid & 63, seg = tid >> 6;
    const float* cw = A.in[4];
    float wq[4], wk[4], wv[4];
#pragma unroll
    for (int k = 0; k < 4; ++k) { wq[k] = cw[k * 1024 + PQ + h * 64 + d]; wk[k] = cw[k * 1024 + PK + h * 64 + d]; wv[k] = cw[k * 1024 + PV + h * 128 + (tid & 127)]; }
    const float bias = A.in[6][h * 64 + d];
#pragma unroll
    for (int i = 0; i < 6; ++i) {
        const int c = tid + 512 * i;
        const int reg = (c >= 536) + (c >= 1072) + (c >= 1584);
        const int cc = c - (reg == 1 ? 536 : reg == 2 ? 1072 : reg == 3 ? 1584 : 0);
        const int rr = reg == 3 ? (cc >> 4) : (cc >> 3), ch = reg == 3 ? (cc & 15) : (cc & 7);
        const int lo_ = (reg == 0 ? GL_RQ : reg == 1 ? GL_RK : reg == 2 ? GL_RG : GL_RV) + rr * (reg == 3 ? 256 : 128) + ch * 16;
        if (c < 2656) *(LAS v4u*)(F.lds + lo_) = w[i];
    }
    __syncthreads();
    {
        float rq[11], rk[11], gl[8];
#pragma unroll
        for (int i = 0; i < 11; ++i) { rq[i] = bf2f(*(const LAS bf16*)(F.lds + GL_RQ + (8 * seg + i) * 128 + d * 2)); rk[i] = bf2f(*(const LAS bf16*)(F.lds + GL_RK + (8 * seg + i) * 128 + d * 2)); }
#pragma unroll
        for (int j = 0; j < 8; ++j) gl[j] = log_sigmoid_f(bf2f(*(const LAS bf16*)(F.lds + GL_RG + (8 * seg + j) * 128 + d * 2)) + bias) * (1.f / 16.f);
        float c = 0.f;
#pragma unroll
        for (int j = 0; j < 8; ++j) { c += gl[j]; gl[j] = c; }
        LAS float* SEG = (LAS float*)(F.lds + GL_SEG);
        SEG[seg * 64 + d] = c;
        __syncthreads();
        float pre = 0.f, tot = 0.f;
#pragma unroll
        for (int s = 0; s < 8; ++s) { const float v = SEG[s * 64 + d]; pre += (s < seg) ? v : 0.f; tot += v; }
#pragma unroll
        for (int j = 0; j < 8; ++j) {
            const int tok = 8 * seg + j; const float cum = pre + gl[j];
            const float qc = silu_f(wq[0] * rq[j] + wq[1] * rq[j + 1] + wq[2] * rq[j + 2] + wq[3] * rq[j + 3]);
            const float kc = silu_f(wk[0] * rk[j] + wk[1] * rk[j + 1] + wk[2] * rk[j + 2] + wk[3] * rk[j + 3]);
            if (MODE == 0) { *(LAS bf16*)(F.lds + GL_KD + tok * GL_KDP + d * 2) = (bf16)f2bf(kc * __expf(tot - cum)); }
            else { const int off = (d >> 3) * GL_CS + tok * 16 + (d & 7) * 2;
                *(LAS bf16*)(F.lds + GL_QT + off) = (bf16)f2bf(qc * 0.125f * __expf(cum)); *(LAS bf16*)(F.lds + GL_KT + off) = (bf16)f2bf(kc * __expf(-cum)); }
        }
        if (MODE == 0 && seg == 0) ((float*)(F.ctl + CW_DECAY))[((size_t)(b * 4 + h) * 32 + n) * 64 + d] = __expf(tot);
    }
    {
        const int e = tid & 127, s4 = tid >> 7;
        float rv[19];
#pragma unroll
        for (int i = 0; i < 19; ++i) rv[i] = bf2f(*(const LAS bf16*)(F.lds + GL_RV + (16 * s4 + i) * 256 + e * 2));
#pragma unroll
        for (int j = 0; j < 16; ++j) *(LAS bf16*)(F.lds + GL_V + (16 * s4 + j) * GL_VP + e * 2) = (bf16)f2bf(silu_f(wv[0] * rv[j] + wv[1] * rv[j + 1] + wv[2] * rv[j + 2] + wv[3] * rv[j + 3]));
    }
}
DI void gla_local_unit(Frame& F, const Args& A, bf16* STW, int b, int h, int n, v4u (&w)[6], int nb, int nh, int nn) {
    __syncthreads();
    gla_prep<0>(F, A, b, h, n, w);
    gla_stage_load(F, nb, nh, nn, w);
    __syncthreads();
    const int lane = F.lane, wid = F.wave, dt = wid & 1, et = wid >> 1, r32 = lane & 31, hi = lane >> 5;
    f32x16 acc = {};
#pragma unroll
    for (int ks = 0; ks < 4; ++ks) {
        const bf16x8 af = tr_frag<false>(F.lds + GL_KD, GL_KDP, 32 * dt, 16 * ks, lane), bfr = tr_frag<false>(F.lds + GL_V, GL_VP, 32 * et, 16 * ks, lane);
        acc = __builtin_amdgcn_mfma_f32_32x32x16_bf16(af, bfr, acc, 0, 0, 0);
    }
    bf16* o = STW + (((size_t)(b * 4 + h) * 32 + n) * 64 + 32 * dt) * 128 + 32 * et + r32;
#pragma unroll
    for (int r = 0; r < 16; ++r) o[(size_t)((r & 3) + 8 * (r >> 2) + 4 * hi) * 128] = (bf16)f2bf(acc[r]);
}
DI void gla_out_unit(Frame& F, const Args& A, const bf16* STW, int b, int h, int n, v4u (&w)[6], int nb, int nh, int nn) {
    v4u stv[2];
    { const bf16* sp = STW + ((size_t)(b * 4 + h) * 32 + n) * 64 * 128;
#pragma unroll
      for (int i = 0; i < 2; ++i) stv[i] = *(const GAS v4u*)(sp + (F.tid + i * 512) * 8); }
    __syncthreads();
    gla_prep<1>(F, A, b, h, n, w);
    gla_stage_load(F, nb, nh, nn, w);
#pragma unroll
    for (int i = 0; i < 2; ++i) { const int idx = (F.tid + i * 512) * 8, dd = idx >> 7, ee = idx & 127;
        *(LAS v4u*)(F.lds + GL_ST + dd * GL_VP + ee * 2) = stv[i]; }
    __syncthreads();
    const int lane = F.lane, wid = F.wave, it = wid & 1, et = wid >> 1, r32 = lane & 31, hi = lane >> 5;
    f32x16 acc = {};
    bf16x8 qf[4];
#pragma unroll
    for (int ks = 0; ks < 4; ++ks) qf[ks] = *(const LAS bf16x8*)(F.lds + GL_QT + (2 * ks + hi) * GL_CS + (32 * it + r32) * 16);
#pragma unroll
    for (int ks = 0; ks < 4; ++ks) acc = __builtin_amdgcn_mfma_f32_32x32x16_bf16(tr_frag<false>(F.lds + GL_ST, GL_VP, 32 * et, 16 * ks, lane), qf[ks], acc, 0, 0, 0);
    for (int jt = 0; jt <= it; ++jt) {
        f32x16 S = {};
#pragma unroll
        for (int ks = 0; ks < 4; ++ks) S = __builtin_amdgcn_mfma_f32_32x32x16_bf16(*(const LAS bf16x8*)(F.lds + GL_KT + (2 * ks + hi) * GL_CS + (32 * jt + r32) * 16), qf[ks], S, 0, 0, 0);
        if (jt == it) {
#pragma unroll
            for (int r = 0; r < 16; ++r) S[r] = ((r & 3) + 8 * (r >> 2) + 4 * hi) <= r32 ? S[r] : 0.f;
        }
#pragma unroll
        for (int s = 0; s < 2; ++s) {
            v4u pw; pw.x = cvtpk_bf16(S[8 * s + 0], S[8 * s + 1]); pw.y = cvtpk_bf16(S[8 * s + 2], S[8 * s + 3]); pw.z = cvtpk_bf16(S[8 * s + 4], S[8 * s + 5]); pw.w = cvtpk_bf16(S[8 * s + 6], S[8 * s + 7]);
            acc = __builtin_amdgcn_mfma_f32_32x32x16_bf16(tr_frag<true>(F.lds + GL_V, GL_VP, 32 * et, 32 * jt + 16 * s, lane), __builtin_bit_cast(bf16x8, pw), acc, 0, 0, 0);
        }
    }
    float ss = 0.f;
#pragma unroll
    for (int r = 0; r < 16; ++r) ss += acc[r] * acc[r];
    { auto rr = __builtin_amdgcn_permlane32_swap(__float_as_uint(ss), __float_as_uint(ss), false, false); ss = __uint_as_float(rr[0]) + __uint_as_float(rr[1]); }
    LAS float* RED = (LAS float*)(F.lds + GL_RED);
    if (hi == 0) RED[wid * 32 + r32] = ss;
    __syncthreads();
    const float tot = RED[(it + 0) * 32 + r32] + RED[(it + 2) * 32 + r32] + RED[(it + 4) * 32 + r32] + RED[(it + 6) * 32 + r32];
    const float rs = 1.f / sqrtf(tot * (1.f / 128.f) + EPS);
    const size_t row = (size_t)b * SEQ + 64 * n + 32 * it + r32;
    const float* gg = A.in[7];
#pragma unroll
    for (int g = 0; g < 4; ++g) {
        const int e0 = 32 * et + 8 * g + 4 * hi;
        const unsigned long long ogw = *(const GAS unsigned long long*)(F_PROJ + row * N1 + POG + h * 128 + e0);
        const unsigned lo = (unsigned)ogw, hi2 = (unsigned)(ogw >> 32);
        const f32x4 gv = *(const GAS f32x4*)(gg + e0);
        const float y0 = acc[4 * g + 0] * rs * gv.x * silu_f(bflo(lo)), y1 = acc[4 * g + 1] * rs * gv.y * silu_f(bfhi(lo)), y2 = acc[4 * g + 2] * rs * gv.z * silu_f(bflo(hi2)), y3 = acc[4 * g + 3] * rs * gv.w * silu_f(bfhi(hi2));
        *(GAS unsigned long long*)(F_BUFA + row * 1024 + h * 128 + e0) = (unsigned long long)pk2(y0, y1) | ((unsigned long long)pk2(y2, y3) << 32);
    }
}
DI void xattn_unit(Frame& F, const bf16* Q, bf16* O, int b, int h, int qb) {
    const int tid = F.tid, lane = F.lane, wid = F.wave, r32 = lane & 31, hi = lane >> 5;
    const bf16* Kg = F_KV + (size_t)(b * 256) * 2048 + h * 256;
    const bf16* Vg = Kg + 1024;
    const size_t row = (size_t)b * SEQ + qb * 256 + wid * 32 + r32;
    __syncthreads();
    {
        const bf16* kp = Kg + (size_t)(tid >> 5) * 2048 + (tid & 31) * 8; LAS unsigned char* kl = F.lds + (tid & 31) * 4096 + (tid >> 5) * 16;
#pragma unroll 4
        for (int i = 0; i < 16; ++i) { *(LAS v4u*)(kl) = *(const GAS v4u*)(kp); kp += 16 * 2048; kl += 256; }
    }
    bf16x8 qf[16];
#pragma unroll
    for (int ks = 0; ks < 16; ++ks) qf[ks] = *(const GAS bf16x8*)(Q + row * 1024 + h * 256 + 16 * ks + 8 * hi);
    __syncthreads();
    f32x16 S[8];
#pragma unroll
    for (int mt = 0; mt < 8; ++mt) { S[mt] = (f32x16){};
#pragma unroll
        for (int k4 = 0; k4 < 4; ++k4) {
#pragma unroll
            for (int kk = 0; kk < 4; ++kk) { const int ks = 4 * k4 + kk; S[mt] = __builtin_amdgcn_mfma_f32_32x32x16_bf16(*(const LAS bf16x8*)(F.lds + (2 * ks + hi) * 4096 + (32 * mt + r32) * 16), qf[ks], S[mt], 0, 0, 0); }
            __builtin_amdgcn_sched_barrier(0); } }
    float mx = -INFINITY;
#pragma unroll
    for (int mt = 0; mt < 8; ++mt)
#pragma unroll
        for (int r = 0; r < 16; ++r) mx = fmaxf(mx, S[mt][r]);
    { auto rr = __builtin_amdgcn_permlane32_swap(__float_as_uint(mx), __float_as_uint(mx), false, false); mx = fmaxf(__uint_as_float(rr[0]), __uint_as_float(rr[1])); }
    const float c2 = 0.0625f * 1.4426950408889634f; const float mb = mx * c2;
    float sum = 0.f;
#pragma unroll
    for (int mt = 0; mt < 8; ++mt)
#pragma unroll
        for (int r = 0; r < 16; ++r) { const float p = __builtin_amdgcn_exp2f(S[mt][r] * c2 - mb); S[mt][r] = p; sum += p; }
    { auto rr = __builtin_amdgcn_permlane32_swap(__float_as_uint(sum), __float_as_uint(sum), false, false); sum = __uint_as_float(rr[0]) + __uint_as_float(rr[1]); }
    const float linv = 1.f / sum;
    v4u pa[16];
#pragma unroll
    for (int mt = 0; mt < 8; ++mt)
#pragma unroll
        for (int s = 0; s < 2; ++s) { v4u pw; pw.x = cvtpk_bf16(S[mt][8 * s + 0] * linv, S[mt][8 * s + 1] * linv); pw.y = cvtpk_bf16(S[mt][8 * s + 2] * linv, S[mt][8 * s + 3] * linv);
            pw.z = cvtpk_bf16(S[mt][8 * s + 4] * linv, S[mt][8 * s + 5] * linv); pw.w = cvtpk_bf16(S[mt][8 * s + 6] * linv, S[mt][8 * s + 7] * linv); pa[2 * mt + s] = pw; }
    __syncthreads();
    {
        const int c = tid & 31, m0 = tid >> 5;
        const bf16* vp = Vg + (size_t)m0 * 2048 + c * 8; LAS unsigned char* vl = F.lds + (c >> 2) * 16384 + m0 * 64 + (c & 3) * 16;
#pragma unroll 4
        for (int i = 0; i < 16; ++i) { *(LAS v4u*)(vl) = *(const GAS v4u*)(vp); vp += 16 * 2048; vl += 1024; }
    }
    __syncthreads();
    const int vfr = ((lane >> 4) & 1) * 32 + (lane & 3) * 8 + (4 * hi + ((lane & 15) >> 2)) * 64;
    unsigned opk[4][16];
#pragma unroll
    for (int dp = 0; dp < 4; ++dp) {
        f32x16 a0 = {}, a1 = {};
#pragma unroll
        for (int s = 0; s < 16; ++s) {
            const LAS unsigned char* vp0 = F.lds + (2 * dp) * 16384 + s * 1024 + vfr; const LAS unsigned char* vp1 = vp0 + 16384;
            const s16x4 l0 = lds_tr16(vp0), h0 = lds_tr16(vp0 + 512), l1 = lds_tr16(vp1), h1 = lds_tr16(vp1 + 512);
            const bf16x8 v0 = {l0[0], l0[1], l0[2], l0[3], h0[0], h0[1], h0[2], h0[3]}, v1 = {l1[0], l1[1], l1[2], l1[3], h1[0], h1[1], h1[2], h1[3]};
            a0 = __builtin_amdgcn_mfma_f32_32x32x16_bf16(__builtin_bit_cast(bf16x8, pa[s]), v0, a0, 0, 0, 0);
            a1 = __builtin_amdgcn_mfma_f32_32x32x16_bf16(__builtin_bit_cast(bf16x8, pa[s]), v1, a1, 0, 0, 0);
            if ((s & 3) == 3) __builtin_amdgcn_sched_barrier(0);
        }
#pragma unroll
        for (int r = 0; r < 16; ++r) opk[dp][r] = cvtpk_bf16(a0[r], a1[r]);
        __builtin_amdgcn_sched_barrier(0);
    }
    __syncthreads();
    LAS bf16* stg = (LAS bf16*)(F.lds + wid * 16384);
#pragma unroll
    for (int dp = 0; dp < 4; ++dp)
#pragma unroll
        for (int r = 0; r < 16; ++r) { const int rr = (r & 3) + 8 * (r >> 2) + 4 * hi; stg[rr * 256 + dp * 64 + r32] = (bf16)(opk[dp][r] & 0xffffu); stg[rr * 256 + dp * 64 + 32 + r32] = (bf16)(opk[dp][r] >> 16); }
    LDS_WAIT(); asm volatile("" ::: "memory");
    bf16* Ow = O + ((size_t)b * SEQ + qb * 256 + wid * 32) * 1024 + h * 256;
    {
        bf16* op = Ow + (size_t)(lane >> 5) * 1024 + (lane & 31) * 8; const LAS bf16* sp = stg + (lane >> 5) * 256 + (lane & 31) * 8;
#pragma unroll 4
        for (int i = 0; i < 16; ++i) { *(GAS v4u*)(op) = *(const LAS v4u*)(sp); op += 2 * 1024; sp += 2 * 256; }
    }
    LDS_WAIT(); asm volatile("" ::: "memory");
}
DI void mix_row(Frame& F, const Args& A, const float* OGLA, const float* OSB, size_t row) {
    const int lane = F.lane;
    const f32x4 a0 = *(const GAS f32x4*)(OGLA + row * 512 + 8 * lane), a1 = *(const GAS f32x4*)(OGLA + row * 512 + 8 * lane + 4);
    float s = (a0.x * a0.x + a0.y * a0.y) + (a0.z * a0.z + a0.w * a0.w) + (a1.x * a1.x + a1.y * a1.y) + (a1.z * a1.z + a1.w * a1.w);
    s += __shfl_xor(s, 1); s += __shfl_xor(s, 2); s += __shfl_xor(s, 4); s += __shfl_xor(s, 8);
    const float rs = 1.f / sqrtf(s * (1.f / 128.f) + EPS);
    const int e0 = (8 * lane) & 127;
    const f32x4 g0 = *(const GAS f32x4*)(A.in[7] + e0), g1 = *(const GAS f32x4*)(A.in[7] + e0 + 4);
    const v4u ogw = *(const GAS v4u*)(F_PROJ + row * N1 + POG + 8 * lane);
    v4u o;
    o.x = pk2(a0.x * rs * g0.x * silu_f(bflo(ogw.x)), a0.y * rs * g0.y * silu_f(bfhi(ogw.x)));
    o.y = pk2(a0.z * rs * g0.z * silu_f(bflo(ogw.y)), a0.w * rs * g0.w * silu_f(bfhi(ogw.y)));
    o.z = pk2(a1.x * rs * g1.x * silu_f(bflo(ogw.z)), a1.y * rs * g1.y * silu_f(bfhi(ogw.z)));
    o.w = pk2(a1.z * rs * g1.z * silu_f(bflo(ogw.w)), a1.w * rs * g1.w * silu_f(bfhi(ogw.w)));
    *(GAS v4u*)(F_BUFA + row * 1024 + 8 * lane) = o;
    const f32x4 b0 = *(const GAS f32x4*)(OSB + row * 512 + 8 * lane), b1 = *(const GAS f32x4*)(OSB + row * 512 + 8 * lane + 4);
    float s2 = (b0.x * b0.x + b0.y * b0.y) + (b0.z * b0.z + b0.w * b0.w) + (b1.x * b1.x + b1.y * b1.y) + (b1.z * b1.z + b1.w * b1.w);
    const float rs2 = 1.f / sqrtf(wave_sum(s2) * (1.f / 512.f) + EPS);
    const f32x4 h0 = *(const GAS f32x4*)(A.in[8] + 8 * lane), h1 = *(const GAS f32x4*)(A.in[8] + 8 * lane + 4);
    v4u p;
    p.x = pk2(b0.x * rs2 * h0.x, b0.y * rs2 * h0.y); p.y = pk2(b0.z * rs2 * h0.z, b0.w * rs2 * h0.w);
    p.z = pk2(b1.x * rs2 * h1.x, b1.y * rs2 * h1.y); p.w = pk2(b1.z * rs2 * h1.z, b1.w * rs2 * h1.w);
    *(GAS v4u*)(F_BUFA + row * 1024 + 512 + 8 * lane) = p;
}
template <int R> DI void mix_rows_sb(Frame& F, const Args& A, const float* OSB, size_t row) {
    const int lane = F.lane;
    f32x4 b0[R], b1[R];
#pragma unroll
    for (int r = 0; r < R; ++r) { b0[r] = *(const GAS f32x4*)(OSB + (row + r) * 512 + 8 * lane); b1[r] = *(const GAS f32x4*)(OSB + (row + r) * 512 + 8 * lane + 4); }
    const f32x4 h0 = *(const GAS f32x4*)(A.in[8] + 8 * lane), h1 = *(const GAS f32x4*)(A.in[8] + 8 * lane + 4);
#pragma unroll
    for (int r = 0; r < R; ++r) {
        const float s2 = (b0[r].x * b0[r].x + b0[r].y * b0[r].y) + (b0[r].z * b0[r].z + b0[r].w * b0[r].w) + (b1[r].x * b1[r].x + b1[r].y * b1[r].y) + (b1[r].z * b1[r].z + b1[r].w * b1[r].w);
        const float rs2 = 1.f / sqrtf(wave_sum(s2) * (1.f / 512.f) + EPS);
        v4u p;
        p.x = pk2(b0[r].x * rs2 * h0.x, b0[r].y * rs2 * h0.y); p.y = pk2(b0[r].z * rs2 * h0.z, b0[r].w * rs2 * h0.w);
        p.z = pk2(b1[r].x * rs2 * h1.x, b1[r].y * rs2 * h1.y); p.w = pk2(b1[r].z * rs2 * h1.z, b1[r].w * rs2 * h1.w);
        *(GAS v4u*)(F_BUFA + (row + r) * 1024 + 512 + 8 * lane) = p; }
}
DI void gla_scan(Frame& F, bf16* STW) {
    const int gt = (F.vcu * NWAVES + F.wave) * 64 + F.lane, NGT = F.G * NWAVES * 64;
    const float* dec = (const float*)(F.ctl + CW_DECAY);
    for (int idx = gt; idx < 32 * 4096; idx += NGT) {
        const int bh = idx >> 12, de = (idx & 4095) * 2, d = de >> 7;
        unsigned* p = (unsigned*)(STW + (size_t)bh * 32 * 8192 + de); const float* dp = dec + (size_t)bh * 32 * 64 + d;
        unsigned tmp[32]; float dc[32];
#pragma unroll
        for (int n = 0; n < 32; ++n) { tmp[n] = p[(size_t)n * 4096]; dc[n] = dp[n * 64]; }
        float s0 = 0.f, s1 = 0.f;
#pragma unroll
        for (int n = 0; n < 32; ++n) { p[(size_t)n * 4096] = pk2(s0, s1); s0 = dc[n] * s0 + bflo(tmp[n]); s1 = dc[n] * s1 + bfhi(tmp[n]); }
    }
}
DI void xsoftmax_row(Frame& F, bf16* S, size_t rh) {
    unsigned long long* p = (unsigned long long*)(S + rh * 256) + F.lane;
    const unsigned long long w = *p; const unsigned lo = (unsigned)w, hi = (unsigned)(w >> 32);
    const float sc = 0.0625f;
    float a = bflo(lo) * sc, b = bfhi(lo) * sc, c = bflo(hi) * sc, d = bfhi(hi) * sc;
    const float mx = wave_max(fmaxf(fmaxf(a, b), fmaxf(c, d)));
    a = __expf(a - mx); b = __expf(b - mx); c = __expf(c - mx); d = __expf(d - mx);
    const float inv = 1.f / wave_sum((a + b) + (c + d));
    *p = (unsigned long long)pk2(a * inv, b * inv) | ((unsigned long long)pk2(c * inv, d * inv) << 32);
}
DI float topk_round2(float& c0, float& c1) {
    const float w = wave_max(fmaxf(c0, c1));
    if (c0 == w) c0 = -INFINITY; if (c1 == w) c1 = -INFINITY;
    return w;
}
DI void peer_topk_item(Frame& F, const bf16* PQb, int* IDX, float* GATE, size_t row, int h) {
    const int lane = F.lane;
    float mylist[2];
#pragma unroll
    for (int p = 0; p < 2; ++p) {
        LAS unsigned* qs = (LAS unsigned*)(F.lds + F.wave * 1024);
        qs[lane] = *(const GAS unsigned*)(PQb + row * 2048 + (h * 2 + p) * 128 + 2 * lane);
        LDS_WAIT(); asm volatile("" ::: "memory");
        const bf16* kbase = F_SUBK + (size_t)((h * 2 + p) * 128) * 128;
        float s0 = 0.f, s1 = 0.f;
        const GAS v4u* k0p = (const GAS v4u*)(kbase + (size_t)lane * 128); const GAS v4u* k1p = (const GAS v4u*)(kbase + (size_t)(lane + 64) * 128);
#pragma unroll
        for (int c = 0; c < 16; ++c) {
            const v4u a = k0p[c], b = k1p[c];
            const v4u qq = *(const LAS v4u*)(qs + 4 * c); const unsigned q0 = qq.x, q1 = qq.y, q2 = qq.z, q3 = qq.w;
            s0 += bflo(a.x) * bflo(q0) + bfhi(a.x) * bfhi(q0) + bflo(a.y) * bflo(q1) + bfhi(a.y) * bfhi(q1) + bflo(a.z) * bflo(q2) + bfhi(a.z) * bfhi(q2) + bflo(a.w) * bflo(q3) + bfhi(a.w) * bfhi(q3);
            s1 += bflo(b.x) * bflo(q0) + bfhi(b.x) * bfhi(q0) + bflo(b.y) * bflo(q1) + bfhi(b.y) * bfhi(q1) + bflo(b.z) * bflo(q2) + bfhi(b.z) * bfhi(q2) + bflo(b.w) * bflo(q3) + bfhi(b.w) * bfhi(q3);
        }
        float c0 = __uint_as_float((__float_as_uint(s0) & ~0x7fu) | (unsigned)lane), c1 = __uint_as_float((__float_as_uint(s1) & ~0x7fu) | (unsigned)(lane + 64));
        float mine = 0.f;
#pragma unroll
        for (int r = 0; r < 16; ++r) { const float w = topk_round2(c0, c1); if (lane == r) mine = w; }
        mylist[p] = mine;
        LDS_WAIT(); asm volatile("" ::: "memory");
    }
    const float va = __uint_as_float(__float_as_uint(__shfl(mylist[0], lane >> 2)) & ~0x7fu);
    float cand[4];
#pragma unroll
    for (int j = 0; j < 4; ++j) { const int bb = 4 * (lane & 3) + j; const float vb = __uint_as_float(__float_as_uint(__shfl(mylist[1], bb)) & ~0x7fu);
        cand[j] = __uint_as_float((__float_as_uint(va + vb) & ~0xffu) | (unsigned)((lane >> 2) * 16 + bb)); }
    float best = 0.f, top = 0.f;
#pragma unroll
    for (int r = 0; r < 16; ++r) {
        const float w = wave_max(fmaxf(fmaxf(cand[0], cand[1]), fmaxf(cand[2], cand[3])));
#pragma unroll
        for (int j = 0; j < 4; ++j) if (cand[j] == w) cand[j] = -INFINITY;
        if (lane == r) best = w; if (r == 0) top = w;
    }
    const unsigned bu = __float_as_uint(best); const int ca = (bu >> 4) & 15, cb = bu & 15;
    const int i1 = (int)(__float_as_uint(__shfl(mylist[0], ca)) & 0x7fu), i2 = (int)(__float_as_uint(__shfl(mylist[1], cb)) & 0x7fu);
    const float sc = __uint_as_float(bu & ~0xffu), tp = __uint_as_float(__float_as_uint(top) & ~0xffu);
    const float ex = lane < 16 ? __expf(sc - tp) : 0.f;
    const float inv = 1.f / wave_sum(ex);
    if (lane < 16) { IDX[row * 128 + h * 16 + lane] = i1 * 128 + i2; GATE[row * 128 + h * 16 + lane] = ex * inv; }
}
DI float vmaxf(float a, float b) { float r; asm("v_max_f32_e32 %0, %1, %2" : "=v"(r) : "v"(a), "v"(b)); return r; }
DI float vminf(float a, float b) { float r; asm("v_min_f32_e32 %0, %1, %2" : "=v"(r) : "v"(a), "v"(b)); return r; }
DI void ins16(float (&L)[16], float x) {
#pragma unroll
    for (int i = 0; i < 16; ++i) { const float h = vmaxf(L[i], x); x = vminf(L[i], x); L[i] = h; }
}
DI void peer_topk_mfma(Frame& F, const bf16* PQb, int* IDX, float* GATE) {
    const int tid = F.tid, lane = F.lane, wid = F.wave, r32 = lane & 31, hi = lane >> 5, h = F.vcu & 7;
    __syncthreads();
    for (int i = tid; i < 2 * 128 * 16; i += 512) { const int p = i >> 11, key = (i >> 4) & 127, c = i & 15;
        *(LAS v4u*)(F.lds + p * 32768 + c * 2048 + key * 16) = *(const GAS v4u*)(F_SUBK + (size_t)((h * 2 + p) * 128 + key) * 128 + c * 8); }
    __syncthreads();
    LAS unsigned* scr = (LAS unsigned*)(F.lds + 65536 + wid * 8192) + lane;
    for (int g = (F.vcu >> 3) * 8 + wid; g < 512; g += (F.G >> 3) * 8) {
        const size_t token = (size_t)32 * g + r32;
        float LA[16], LB[16];
#pragma unroll
        for (int p = 0; p < 2; ++p) {
            float (&L)[16] = p ? LB : LA;
#pragma unroll
            for (int i = 0; i < 16; ++i) L[i] = -INFINITY;
            bf16x8 qf[8];
#pragma unroll
            for (int ks = 0; ks < 8; ++ks) qf[ks] = *(const GAS bf16x8*)(PQb + token * 2048 + (h * 2 + p) * 128 + 16 * ks + 8 * hi);
#pragma unroll
            for (int rt = 0; rt < 4; ++rt) {
                f32x16 S = {};
#pragma unroll
                for (int ks = 0; ks < 8; ++ks) S = __builtin_amdgcn_mfma_f32_32x32x16_bf16(*(const LAS bf16x8*)(F.lds + p * 32768 + (2 * ks + hi) * 2048 + (32 * rt + r32) * 16), qf[ks], S, 0, 0, 0);
#pragma unroll
                for (int r = 0; r < 16; ++r) { const unsigned key = (unsigned)(32 * rt + (r & 3) + 8 * (r >> 2)) + 4u * (unsigned)hi;
                    ins16(L, __uint_as_float((__float_as_uint(S[r]) & ~0x7fu) | key)); }
            }
            float PL[16];
#pragma unroll
            for (int i = 0; i < 16; ++i) { auto rr = __builtin_amdgcn_permlane32_swap(__float_as_uint(L[i]), __float_as_uint(L[i]), false, false); PL[i] = __uint_as_float(hi ? rr[0] : rr[1]); }
#pragma unroll
            for (int i = 0; i < 16; ++i) ins16(L, PL[i]);
        }
        float C[16];
#pragma unroll
        for (int i = 0; i < 16; ++i) C[i] = -INFINITY;
#pragma unroll
        for (int a = 0; a < 16; ++a) {
            const float va = __uint_as_float(__float_as_uint(LA[a]) & ~0x7fu);
#pragma unroll
            for (int b = 0; b < 16; ++b) if ((a + 1) * (b + 1) <= 16) {
                const float vb = __uint_as_float(__float_as_uint(LB[b]) & ~0x7fu);
                ins16(C, __uint_as_float((__float_as_uint(va + vb) & ~0xffu) | (unsigned)(a * 16 + b)));
            }
        }
#pragma unroll
        for (int i = 0; i < 16; ++i) { scr[i * 64] = __float_as_uint(LA[i]) & 0x7fu; scr[(16 + i) * 64] = __float_as_uint(LB[i]) & 0x7fu; }
        LDS_WAIT(); asm volatile("" ::: "memory");
        const float top = __uint_as_float(__float_as_uint(C[0]) & ~0xffu);
        float ex[16]; int ei[16]; float sum = 0.f;
#pragma unroll
        for (int r = 0; r < 16; ++r) { const unsigned cu = __float_as_uint(C[r]); ex[r] = __expf(__uint_as_float(cu & ~0xffu) - top); sum += ex[r];
            ei[r] = (int)(scr[((cu >> 4) & 15) * 64] * 128u + scr[(16 + (cu & 15)) * 64]); }
        const float inv = 1.f / sum;
        v4u io0, io1; f32x4 go0, go1;
        io0.x = hi ? ei[8] : ei[0]; io0.y = hi ? ei[9] : ei[1]; io0.z = hi ? ei[10] : ei[2]; io0.w = hi ? ei[11] : ei[3];
        io1.x = hi ? ei[12] : ei[4]; io1.y = hi ? ei[13] : ei[5]; io1.z = hi ? ei[14] : ei[6]; io1.w = hi ? ei[15] : ei[7];
        go0.x = (hi ? ex[8] : ex[0]) * inv; go0.y = (hi ? ex[9] : ex[1]) * inv; go0.z = (hi ? ex[10] : ex[2]) * inv; go0.w = (hi ? ex[11] : ex[3]) * inv;
        go1.x = (hi ? ex[12] : ex[4]) * inv; go1.y = (hi ? ex[13] : ex[5]) * inv; go1.z = (hi ? ex[14] : ex[6]) * inv; go1.w = (hi ? ex[15] : ex[7]) * inv;
        int* ip = IDX + token * 128 + h * 16 + 8 * hi; float* gp = GATE + token * 128 + h * 16 + 8 * hi;
        *(GAS v4u*)ip = io0; *(GAS v4u*)(ip + 4) = io1; *(GAS f32x4*)gp = go0; *(GAS f32x4*)(gp + 4) = go1;
        LDS_WAIT(); asm volatile("" ::: "memory");
    }
}
#define CE(a, b) do { const float h_ = vmaxf(a, b); const float l_ = vminf(a, b); a = h_; b = l_; } while (0)
DI void sort16_desc(float (&v)[16]) { const float h0 = vmaxf(v[0], v[1]); const float h1 = vmaxf(v[2], v[3]); const float h2 = vmaxf(v[4], v[5]); const float h3 = vmaxf(v[6], v[7]); const float h4 = vmaxf(v[8], v[9]); const float h5 = vmaxf(v[10], v[11]); const float h6 = vmaxf(v[12], v[13]); const float h7 = vmaxf(v[14], v[15]); v[1] = vminf(v[0], v[1]); v[3] = vminf(v[2], v[3]); v[5] = vminf(v[4], v[5]); v[7] = vminf(v[6], v[7]); v[9] = vminf(v[8], v[9]); v[11] = vminf(v[10], v[11]); v[13] = vminf(v[12], v[13]); v[15] = vminf(v[14], v[15]); v[0] = h0; v[2] = h1; v[4] = h2; v[6] = h3; v[8] = h4; v[10] = h5; v[12] = h6; v[14] = h7; const float h8 = vmaxf(v[0], v[2]); const float h9 = vmaxf(v[1], v[3]); const float h10 = vmaxf(v[4], v[6]); const float h11 = vmaxf(v[5], v[7]); const float h12 = vmaxf(v[8], v[10]); const float h13 = vmaxf(v[9], v[11]); const float h14 = vmaxf(v[12], v[14]); const float h15 = vmaxf(v[13], v[15]); v[2] = vminf(v[0], v[2]); v[3] = vminf(v[1], v[3]); v[6] = vminf(v[4], v[6]); v[7] = vminf(v[5], v[7]); v[10] = vminf(v[8], v[10]); v[11] = vminf(v[9], v[11]); v[14] = vminf(v[12], v[14]); v[15] = vminf(v[13], v[15]); v[0] = h8; v[1] = h9; v[4] = h10; v[5] = h11; v[8] = h12; v[9] = h13; v[12] = h14; v[13] = h15; const float h16 = vmaxf(v[1], v[2]); const float h17 = vmaxf(v[5], v[6]); const float h18 = vmaxf(v[0], v[4]); const float h19 = vmaxf(v[3], v[7]); const float h20 = vmaxf(v[9], v[10]); const float h21 = vmaxf(v[13], v[14]); const float h22 = vmaxf(v[8], v[12]); const float h23 = vmaxf(v[11], v[15]); v[2] = vminf(v[1], v[2]); v[6] = vminf(v[5], v[6]); v[4] = vminf(v[0], v[4]); v[7] = vminf(v[3], v[7]); v[10] = vminf(v[9], v[10]); v[14] = vminf(v[13], v[14]); v[12] = vminf(v[8], v[12]); v[15] = vminf(v[11], v[15]); v[1] = h16; v[5] = h17; v[0] = h18; v[3] = h19; v[9] = h20; v[13] = h21; v[8] = h22; v[11] = h23; const float h24 = vmaxf(v[2], v[6]); const float h25 = vmaxf(v[1], v[5]); const float h26 = vmaxf(v[10], v[14]); const float h27 = vmaxf(v[9], v[13]); const float h28 = vmaxf(v[0], v[8]); const float h29 = vmaxf(v[7], v[15]); v[6] = vminf(v[2], v[6]); v[5] = vminf(v[1], v[5]); v[14] = vminf(v[10], v[14]); v[13] = vminf(v[9], v[13]); v[8] = vminf(v[0], v[8]); v[15] = vminf(v[7], v[15]); v[2] = h24; v[1] = h25; v[10] = h26; v[9] = h27; v[0] = h28; v[7] = h29; const float h30 = vmaxf(v[2], v[4]); const float h31 = vmaxf(v[3], v[5]); const float h32 = vmaxf(v[10], v[12]); const float h33 = vmaxf(v[11], v[13]); v[4] = vminf(v[2], v[4]); v[5] = vminf(v[3], v[5]); v[12] = vminf(v[10], v[12]); v[13] = vminf(v[11], v[13]); v[2] = h30; v[3] = h31; v[10] = h32; v[11] = h33; const float h34 = vmaxf(v[1], v[2]); const float h35 = vmaxf(v[3], v[4]); const float h36 = vmaxf(v[5], v[6]); const float h37 = vmaxf(v[9], v[10]); const float h38 = vmaxf(v[11], v[12]); const float h39 = vmaxf(v[13], v[14]); v[2] = vminf(v[1], v[2]); v[4] = vminf(v[3], v[4]); v[6] = vminf(v[5], v[6]); v[10] = vminf(v[9], v[10]); v[12] = vminf(v[11], v[12]); v[14] = vminf(v[13], v[14]); v[1] = h34; v[3] = h35; v[5] = h36; v[9] = h37; v[11] = h38; v[13] = h39; const float h40 = vmaxf(v[4], v[12]); const float h41 = vmaxf(v[2], v[10]); const float h42 = vmaxf(v[6], v[14]); const float h43 = vmaxf(v[1], v[9]); const float h44 = vmaxf(v[5], v[13]); const float h45 = vmaxf(v[3], v[11]); v[12] = vminf(v[4], v[12]); v[10] = vminf(v[2], v[10]); v[14] = vminf(v[6], v[14]); v[9] = vminf(v[1], v[9]); v[13] = vminf(v[5], v[13]); v[11] = vminf(v[3], v[11]); v[4] = h40; v[2] = h41; v[6] = h42; v[1] = h43; v[5] = h44; v[3] = h45; const float h46 = vmaxf(v[4], v[8]); const float h47 = vmaxf(v[6], v[10]); const float h48 = vmaxf(v[5], v[9]); const float h49 = vmaxf(v[7], v[11]); v[8] = vminf(v[4], v[8]); v[10] = vminf(v[6], v[10]); v[9] = vminf(v[5], v[9]); v[11] = vminf(v[7], v[11]); v[4] = h46; v[6] = h47; v[5] = h48; v[7] = h49; const float h50 = vmaxf(v[2], v[4]); const float h51 = vmaxf(v[6], v[8]); const float h52 = vmaxf(v[10], v[12]); const float h53 = vmaxf(v[3], v[5]); const float h54 = vmaxf(v[7], v[9]); const float h55 = vmaxf(v[11], v[13]); v[4] = vminf(v[2], v[4]); v[8] = vminf(v[6], v[8]); v[12] = vminf(v[10], v[12]); v[5] = vminf(v[3], v[5]); v[9] = vminf(v[7], v[9]); v[13] = vminf(v[11], v[13]); v[2] = h50; v[6] = h51; v[10] = h52; v[3] = h53; v[7] = h54; v[11] = h55; const float h56 = vmaxf(v[1], v[2]); const float h57 = vmaxf(v[3], v[4]); const float h58 = vmaxf(v[5], v[6]); const float h59 = vmaxf(v[7], v[8]); const float h60 = vmaxf(v[9], v[10]); const float h61 = vmaxf(v[11], v[12]); const float h62 = vmaxf(v[13], v[14]); v[2] = vminf(v[1], v[2]); v[4] = vminf(v[3], v[4]); v[6] = vminf(v[5], v[6]); v[8] = vminf(v[7], v[8]); v[10] = vminf(v[9], v[10]); v[12] = vminf(v[11], v[12]); v[14] = vminf(v[13], v[14]); v[1] = h56; v[3] = h57; v[5] = h58; v[7] = h59; v[9] = h60; v[11] = h61; v[13] = h62; }
DI void bmerge16_desc(float (&v)[16]) { const float h0 = vmaxf(v[0], v[8]); const float h1 = vmaxf(v[1], v[9]); const float h2 = vmaxf(v[2], v[10]); const float h3 = vmaxf(v[3], v[11]); const float h4 = vmaxf(v[4], v[12]); const float h5 = vmaxf(v[5], v[13]); const float h6 = vmaxf(v[6], v[14]); const float h7 = vmaxf(v[7], v[15]); v[8] = vminf(v[0], v[8]); v[9] = vminf(v[1], v[9]); v[10] = vminf(v[2], v[10]); v[11] = vminf(v[3], v[11]); v[12] = vminf(v[4], v[12]); v[13] = vminf(v[5], v[13]); v[14] = vminf(v[6], v[14]); v[15] = vminf(v[7], v[15]); v[0] = h0; v[1] = h1; v[2] = h2; v[3] = h3; v[4] = h4; v[5] = h5; v[6] = h6; v[7] = h7; const float h8 = vmaxf(v[0], v[4]); const float h9 = vmaxf(v[1], v[5]); const float h10 = vmaxf(v[2], v[6]); const float h11 = vmaxf(v[3], v[7]); const float h12 = vmaxf(v[8], v[12]); const float h13 = vmaxf(v[9], v[13]); const float h14 = vmaxf(v[10], v[14]); const float h15 = vmaxf(v[11], v[15]); v[4] = vminf(v[0], v[4]); v[5] = vminf(v[1], v[5]); v[6] = vminf(v[2], v[6]); v[7] = vminf(v[3], v[7]); v[12] = vminf(v[8], v[12]); v[13] = vminf(v[9], v[13]); v[14] = vminf(v[10], v[14]); v[15] = vminf(v[11], v[15]); v[0] = h8; v[1] = h9; v[2] = h10; v[3] = h11; v[8] = h12; v[9] = h13; v[10] = h14; v[11] = h15; const float h16 = vmaxf(v[0], v[2]); const float h17 = vmaxf(v[1], v[3]); const float h18 = vmaxf(v[4], v[6]); const float h19 = vmaxf(v[5], v[7]); const float h20 = vmaxf(v[8], v[10]); const float h21 = vmaxf(v[9], v[11]); const float h22 = vmaxf(v[12], v[14]); const float h23 = vmaxf(v[13], v[15]); v[2] = vminf(v[0], v[2]); v[3] = vminf(v[1], v[3]); v[6] = vminf(v[4], v[6]); v[7] = vminf(v[5], v[7]); v[10] = vminf(v[8], v[10]); v[11] = vminf(v[9], v[11]); v[14] = vminf(v[12], v[14]); v[15] = vminf(v[13], v[15]); v[0] = h16; v[1] = h17; v[4] = h18; v[5] = h19; v[8] = h20; v[9] = h21; v[12] = h22; v[13] = h23; const float h24 = vmaxf(v[0], v[1]); const float h25 = vmaxf(v[2], v[3]); const float h26 = vmaxf(v[4], v[5]); const float h27 = vmaxf(v[6], v[7]); const float h28 = vmaxf(v[8], v[9]); const float h29 = vmaxf(v[10], v[11]); const float h30 = vmaxf(v[12], v[13]); const float h31 = vmaxf(v[14], v[15]); v[1] = vminf(v[0], v[1]); v[3] = vminf(v[2], v[3]); v[5] = vminf(v[4], v[5]); v[7] = vminf(v[6], v[7]); v[9] = vminf(v[8], v[9]); v[11] = vminf(v[10], v[11]); v[13] = vminf(v[12], v[13]); v[15] = vminf(v[14], v[15]); v[0] = h24; v[2] = h25; v[4] = h26; v[6] = h27; v[8] = h28; v[10] = h29; v[12] = h30; v[14] = h31; }
#undef CE
template <int NV> DI void merge_top16(float (&L)[16], const float (&N)[NV]) {
#pragma unroll
    for (int i = 16 - NV; i < 16; ++i) L[i] = vmaxf(L[i], N[15 - i]);
    bmerge16_desc(L);
}
DI float pack_cand(float s, int id) { return __uint_as_float((__float_as_uint(s) & ~0xffu) | (unsigned)(255 - id)); }
DI void peer_topk_mfma2(Frame& F, const bf16* PQb, int* IDX, float* GATE) {
    const int tid = F.tid, lane = F.lane, wid = F.wave, r32 = lane & 31, hi = lane >> 5, h = F.vcu & 7;
    __syncthreads();
    {
        v4u kw[8];
#pragma unroll
        for (int j = 0; j < 8; ++j) { const int i = tid + 512 * j, p = i >> 11, key = (i >> 4) & 127, c = i & 15; kw[j] = *(const GAS v4u*)(F_SUBK + (size_t)((h * 2 + p) * 128 + key) * 128 + c * 8); }
#pragma unroll
        for (int j = 0; j < 8; ++j) { const int i = tid + 512 * j, p = i >> 11, key = (i >> 4) & 127, c = i & 15; *(LAS v4u*)(F.lds + p * 32768 + c * 2048 + key * 16) = kw[j]; }
    }
    __syncthreads();
    LAS unsigned* scr = (LAS unsigned*)(F.lds + 65536 + wid * 8192) + lane;
    const int g0 = (F.vcu >> 3) * 8 + wid, gstep = (F.G >> 3) * 8;
    bf16x8 qf[8];
#pragma unroll
    for (int ks = 0; ks < 8; ++ks) qf[ks] = *(const GAS bf16x8*)(PQb + ((size_t)32 * g0 + r32) * 2048 + (h * 2) * 128 + 16 * ks + 8 * hi);
    for (int g = g0; g < 512; g += gstep) {
        const size_t token = (size_t)32 * g + r32;
        float LA[16], LB[16];
#pragma unroll
        for (int p = 0; p < 2; ++p) {
            float (&L)[16] = p ? LB : LA;
            f32x16 S[4];
#pragma unroll
            for (int rt = 0; rt < 4; ++rt) { S[rt] = (f32x16){};
#pragma unroll
                for (int ks = 0; ks < 8; ++ks) S[rt] = __builtin_amdgcn_mfma_f32_32x32x16_bf16(*(const LAS bf16x8*)(F.lds + p * 32768 + (2 * ks + hi) * 2048 + (32 * rt + r32) * 16), qf[ks], S[rt], 0, 0, 0); }
            __builtin_amdgcn_sched_barrier(0);
            {
                const int gn = p ? (g + gstep < 512 ? g + gstep : g) : g; const int pn = p ? 0 : 1;
#pragma unroll
                for (int ks = 0; ks < 8; ++ks) qf[ks] = *(const GAS bf16x8*)(PQb + ((size_t)32 * gn + r32) * 2048 + (h * 2 + pn) * 128 + 16 * ks + 8 * hi);
            }
            __builtin_amdgcn_sched_barrier(0);
#pragma unroll
            for (int rt = 0; rt < 4; ++rt) {
                float v[16];
#pragma unroll
                for (int r = 0; r < 16; ++r) { const unsigned key = (unsigned)(32 * rt + (r & 3) + 8 * (r >> 2)) + 4u * (unsigned)hi; v[r] = __uint_as_float((__float_as_uint(S[rt][r]) & ~0x7fu) | key); }
                sort16_desc(v);
                if (rt == 0) {
#pragma unroll
                    for (int i = 0; i < 16; ++i) L[i] = v[i];
                } else merge_top16<16>(L, v);
            }
            float PL[16];
#pragma unroll
            for (int i = 0; i < 16; ++i) { auto rr = __builtin_amdgcn_permlane32_swap(__float_as_uint(L[i]), __float_as_uint(L[i]), false, false); PL[i] = __uint_as_float(hi ? rr[0] : rr[1]); }
            merge_top16<16>(L, PL);
        }
#pragma unroll
        for (int i = 0; i < 16; ++i) { scr[i * 64] = __float_as_uint(LA[i]) & 0x7fu; scr[(16 + i) * 64] = __float_as_uint(LB[i]) & 0x7fu; }
        float VA[16], VB[16];
#pragma unroll
        for (int i = 0; i < 16; ++i) { VA[i] = __uint_as_float(__float_as_uint(LA[i]) & ~0x7fu); VB[i] = __uint_as_float(__float_as_uint(LB[i]) & ~0x7fu); }
        float C[16];
#pragma unroll
        for (int b = 0; b < 16; ++b) C[b] = pack_cand(VA[0] + VB[b], b);
        { float R[8];
#pragma unroll
          for (int b = 0; b < 8; ++b) R[b] = pack_cand(VA[1] + VB[b], 16 + b);
          merge_top16<8>(C, R); }
        { float R[5];
#pragma unroll
          for (int b = 0; b < 5; ++b) R[b] = pack_cand(VA[2] + VB[b], 32 + b);
          merge_top16<5>(C, R); }
        { float R[4];
#pragma unroll
          for (int b = 0; b < 4; ++b) R[b] = pack_cand(VA[3] + VB[b], 48 + b);
          merge_top16<4>(C, R); }
        { float R[3];
#pragma unroll
          for (int b = 0; b < 3; ++b) R[b] = pack_cand(VA[4] + VB[b], 64 + b);
          merge_top16<3>(C, R); }
        { float R[11];
#pragma unroll
          for (int i = 0; i < 11; ++i) R[i] = pack_cand(VA[5 + i] + VB[0], (5 + i) * 16);
          merge_top16<11>(C, R); }
        { float R[3];
#pragma unroll
          for (int i = 0; i < 3; ++i) R[i] = pack_cand(VA[5 + i] + VB[1], (5 + i) * 16 + 1);
          merge_top16<3>(C, R); }
        LDS_WAIT(); asm volatile("" ::: "memory");
        const float top = __uint_as_float(__float_as_uint(C[0]) & ~0xffu);
        float ex[16]; int ei[16]; float sum = 0.f;
#pragma unroll
        for (int r = 0; r < 16; ++r) { const unsigned cu = __float_as_uint(C[r]), id = 255u - (cu & 0xffu); ex[r] = __expf(__uint_as_float(cu & ~0xffu) - top); sum += ex[r];
            ei[r] = (int)(scr[(id >> 4) * 64] * 128u + scr[(16 + (id & 15)) * 64]); }
        const float inv = 1.f / sum;
        v4u io0, io1; f32x4 go0, go1;
        io0.x = hi ? ei[8] : ei[0]; io0.y = hi ? ei[9] : ei[1]; io0.z = hi ? ei[10] : ei[2]; io0.w = hi ? ei[11] : ei[3];
        io1.x = hi ? ei[12] : ei[4]; io1.y = hi ? ei[13] : ei[5]; io1.z = hi ? ei[14] : ei[6]; io1.w = hi ? ei[15] : ei[7];
        go0.x = (hi ? ex[8] : ex[0]) * inv; go0.y = (hi ? ex[9] : ex[1]) * inv; go0.z = (hi ? ex[10] : ex[2]) * inv; go0.w = (hi ? ex[11] : ex[3]) * inv;
        go1.x = (hi ? ex[12] : ex[4]) * inv; go1.y = (hi ? ex[13] : ex[5]) * inv; go1.z = (hi ? ex[14] : ex[6]) * inv; go1.w = (hi ? ex[15] : ex[7]) * inv;
        int* ip = IDX + token * 128 + h * 16 + 8 * hi; float* gp = GATE + token * 128 + h * 16 + 8 * hi;
        *(GAS v4u*)ip = io0; *(GAS v4u*)(ip + 4) = io1; *(GAS f32x4*)gp = go0; *(GAS f32x4*)(gp + 4) = go1;
        LDS_WAIT(); asm volatile("" ::: "memory");
    }
}
DI void peer_gather_row(Frame& F, const Args& A, const bf16* XN2, const int* IDX, const float* GATE, size_t row) {
    const int lane = F.lane;
    const v4u xa = *(const GAS v4u*)(XN2 + row * 1024 + 8 * lane), xb = *(const GAS v4u*)(XN2 + row * 1024 + 512 + 8 * lane);
    const int id0 = IDX[row * 128 + lane], id1 = IDX[row * 128 + 64 + lane];
    const float g0 = GATE[row * 128 + lane], g1 = GATE[row * 128 + 64 + lane];
    float acc[16];
#pragma unroll
    for (int i = 0; i < 16; ++i) acc[i] = 0.f;
#define PEER_DOT2(w, x, a) dot2_bf16((w), (x), (a))
    for (int half = 0; half < 2; ++half) {
        const int idv = half ? id1 : id0; const float gv = half ? g1 : g0;
        for (int e0 = 0; e0 < 64; e0 += 4) {
            v4u ua[4], ub[4], va[4], vb[4]; float gt[4];
#pragma unroll
            for (int j = 0; j < 4; ++j) {
                const int id = __builtin_amdgcn_readlane(idv, e0 + j); gt[j] = __uint_as_float(__builtin_amdgcn_readlane(__float_as_uint(gv), e0 + j));
                const bf16* up = F_UB + (size_t)id * 1024; const bf16* vp = F_VB + (size_t)id * 1024;
                ua[j] = *(const GAS v4u*)(up + 8 * lane); ub[j] = *(const GAS v4u*)(up + 512 + 8 * lane);
                va[j] = *(const GAS v4u*)(vp + 8 * lane); vb[j] = *(const GAS v4u*)(vp + 512 + 8 * lane);
            }
#pragma unroll
            for (int j = 0; j < 4; ++j) {
                float d0 = 0.f, d1 = 0.f;
                d0 = PEER_DOT2(ua[j].x, xa.x, d0); d1 = PEER_DOT2(ua[j].y, xa.y, d1); d0 = PEER_DOT2(ua[j].z, xa.z, d0); d1 = PEER_DOT2(ua[j].w, xa.w, d1);
                d0 = PEER_DOT2(ub[j].x, xb.x, d0); d1 = PEER_DOT2(ub[j].y, xb.y, d1); d0 = PEER_DOT2(ub[j].z, xb.z, d0); d1 = PEER_DOT2(ub[j].w, xb.w, d1);
                const float a = wave_sum(d0 + d1);
                const float cf = gt[j] * gelu_tanh_f(a);
                acc[0] += cf * bflo(va[j].x); acc[1] += cf * bfhi(va[j].x); acc[2] += cf * bflo(va[j].y); acc[3] += cf * bfhi(va[j].y);
                acc[4] += cf * bflo(va[j].z); acc[5] += cf * bfhi(va[j].z); acc[6] += cf * bflo(va[j].w); acc[7] += cf * bfhi(va[j].w);
                acc[8] += cf * bflo(vb[j].x); acc[9] += cf * bfhi(vb[j].x); acc[10] += cf * bflo(vb[j].y); acc[11] += cf * bfhi(vb[j].y);
                acc[12] += cf * bflo(vb[j].z); acc[13] += cf * bfhi(vb[j].z); acc[14] += cf * bflo(vb[j].w); acc[15] += cf * bfhi(vb[j].w);
            }
        }
    }
#undef PEER_DOT2
    float* hp = F.out + row * 1024;
    f32x4 y[4]; const int c0 = 8 * lane, c1 = 512 + 8 * lane;
    y[0] = *(const GAS f32x4*)(hp + c0); y[1] = *(const GAS f32x4*)(hp + c0 + 4); y[2] = *(const GAS f32x4*)(hp + c1); y[3] = *(const GAS f32x4*)(hp + c1 + 4);
    float ss = 0.f;
#pragma unroll
    for (int i = 0; i < 4; ++i) { y[i].x += acc[4 * i]; y[i].y += acc[4 * i + 1]; y[i].z += acc[4 * i + 2]; y[i].w += acc[4 * i + 3]; ss += (y[i].x * y[i].x + y[i].y * y[i].y) + (y[i].z * y[i].z + y[i].w * y[i].w); }
    const float rs = 1.f / sqrtf(wave_sum(ss) * (1.f / 1024.f) + EPS);
    const f32x4 g0v = *(const GAS f32x4*)(A.in[20] + c0), g1v = *(const GAS f32x4*)(A.in[20] + c0 + 4), g2v = *(const GAS f32x4*)(A.in[20] + c1), g3v = *(const GAS f32x4*)(A.in[20] + c1 + 4);
    *(GAS f32x4*)(hp + c0) = y[0] * rs * g0v; *(GAS f32x4*)(hp + c0 + 4) = y[1] * rs * g1v; *(GAS f32x4*)(hp + c1) = y[2] * rs * g2v; *(GAS f32x4*)(hp + c1 + 4) = y[3] * rs * g3v;
}
template <int TPW> DI void peer_gather_sweep(Frame& F, const Args& A, const int* IDX, const float* GATE, size_t tok0) {
    const int lane = F.lane;
    const unsigned char* U8 = F.ws + WS_U8; const unsigned char* V8 = F.ws + WS_V8; const unsigned char* X8 = F.ws + WS_X8;
    const float* SU = (const float*)(F.ws + WS_SU); const float* SX = (const float*)(F.ws + WS_SX);
    f32x2 acc[TPW][8]; v4u xq[TPW]; int idlo[TPW], idhi[TPW]; float glo[TPW], ghi[TPW], sxv[TPW];
#pragma unroll
    for (int tl = 0; tl < TPW; ++tl) {
        const size_t t = tok0 + tl;
#pragma unroll
        for (int i = 0; i < 8; ++i) acc[tl][i] = (f32x2){0.f, 0.f};
        xq[tl] = *(const GAS v4u*)(X8 + t * 1024 + 16 * lane);
        idlo[tl] = IDX[t * 128 + lane]; idhi[tl] = IDX[t * 128 + 64 + lane]; glo[tl] = GATE[t * 128 + lane]; ghi[tl] = GATE[t * 128 + 64 + lane];
        sxv[tl] = SX[t] * (1.f / 64.f);
    }
    const int l3 = lane & 3; const bool b0 = lane & 1, b1 = lane & 2;
    for (int s = 0; s < 32; ++s) {
#pragma unroll
        for (int tl = 0; tl < TPW; ++tl) {
            unsigned long long mlo = __ballot((idlo[tl] >> 9) == s), mhi = __ballot((idhi[tl] >> 9) == s);
            while (mlo | mhi) {
                int id[4]; float g[4];
#pragma unroll
                for (int j = 0; j < 4; ++j) {
                    if (mlo) { const int e = __builtin_ctzll(mlo); mlo &= mlo - 1; id[j] = __builtin_amdgcn_readlane(idlo[tl], e); g[j] = __uint_as_float(__builtin_amdgcn_readlane(__float_as_uint(glo[tl]), e)); }
                    else if (mhi) { const int e = __builtin_ctzll(mhi); mhi &= mhi - 1; id[j] = __builtin_amdgcn_readlane(idhi[tl], e); g[j] = __uint_as_float(__builtin_amdgcn_readlane(__float_as_uint(ghi[tl]), e)); }
                    else { id[j] = id[0]; g[j] = 0.f; }
                }
                v4u uu[4], vv[4]; float su[4]; int p[4];
#pragma unroll
                for (int j = 0; j < 4; ++j) { uu[j] = *(const GAS v4u*)(U8 + (size_t)id[j] * 1024 + 16 * lane); vv[j] = *(const GAS v4u*)(V8 + (size_t)id[j] * 1024 + 16 * lane); su[j] = SU[id[j]]; }
#pragma unroll
                for (int j = 0; j < 4; ++j) { int d = __builtin_amdgcn_sdot4((int)uu[j].x, (int)xq[tl].x, 0, false); d = __builtin_amdgcn_sdot4((int)uu[j].y, (int)xq[tl].y, d, false);
                    d = __builtin_amdgcn_sdot4((int)uu[j].z, (int)xq[tl].z, d, false); p[j] = __builtin_amdgcn_sdot4((int)uu[j].w, (int)xq[tl].w, d, false); }
                const int kA = b0 ? p[1] : p[0], sA = b0 ? p[0] : p[1], kB = b0 ? p[3] : p[2], sB = b0 ? p[2] : p[3];
                const int qA = kA + dpp_i<0xB1>(sA), qB = kB + dpp_i<0xB1>(sB);
                const int kk = b1 ? qB : qA, ss = b1 ? qA : qB;
                int r = kk + dpp_i<0x4E>(ss);
                r += dpp_i<0x124>(r); r += dpp_i<0x128>(r);
                r += __shfl_xor(r, 16); r += __shfl_xor(r, 32);
                const float sus = l3 == 0 ? su[0] : l3 == 1 ? su[1] : l3 == 2 ? su[2] : su[3];
                const float gs = l3 == 0 ? g[0] : l3 == 1 ? g[1] : l3 == 2 ? g[2] : g[3];
                const float a = (float)r * sus * (sxv[tl] * 64.f);
                const float cfl = gs * gelu_tanh_f(a) * (1.f / 64.f);
#pragma unroll
                for (int j = 0; j < 4; ++j) {
                    const float cf = __uint_as_float(__builtin_amdgcn_readlane(__float_as_uint(cfl), j)); const f32x2 c2 = {cf, cf};
#pragma unroll
                    for (int w = 0; w < 4; ++w) { acc[tl][2 * w] = __builtin_amdgcn_cvt_pk_f32_fp8((int)vv[j][w], false) * c2 + acc[tl][2 * w]; acc[tl][2 * w + 1] = __builtin_amdgcn_cvt_pk_f32_fp8((int)vv[j][w], true) * c2 + acc[tl][2 * w + 1]; }
                }
            }
        }
    }
#pragma unroll
    for (int tl = 0; tl < TPW; ++tl) {
        float* hp = F.out + (tok0 + tl) * 1024 + 16 * lane;
        f32x4 y[4]; float ssq = 0.f;
#pragma unroll
        for (int i = 0; i < 4; ++i) { y[i] = *(const GAS f32x4*)(hp + 4 * i); y[i].x += acc[tl][2 * i].x; y[i].y += acc[tl][2 * i].y; y[i].z += acc[tl][2 * i + 1].x; y[i].w += acc[tl][2 * i + 1].y;
            ssq += (y[i].x * y[i].x + y[i].y * y[i].y) + (y[i].z * y[i].z + y[i].w * y[i].w); }
        const float rs = 1.f / sqrtf(wave_sum(ssq) * (1.f / 1024.f) + EPS);
#pragma unroll
        for (int i = 0; i < 4; ++i) { const f32x4 gv = *(const GAS f32x4*)(A.in[20] + 16 * lane + 4 * i); *(GAS f32x4*)(hp + 4 * i) = y[i] * rs * gv; }
    }
}
constexpr int GL3_LIST = 0, GL3_X = 65536;
struct G3Buf { v4u uu[4], vv[4], xx[4]; };
template <int TPW> DI void g3_issue(G3Buf& B, v4u& E, const LAS unsigned char* list, const LAS unsigned char* xl, const unsigned char* U8, const unsigned char* V8, int b, int lane) {
    E = *(const LAS v4u*)(list + (4 * b + (lane & 3)) * 16);
#pragma unroll
    for (int j = 0; j < 4; ++j) {
        const unsigned w = (unsigned)__builtin_amdgcn_readlane((int)E.x, j); const unsigned id = w & 0xffffu, tl = w >> 16;
        B.uu[j] = *(const GAS v4u*)(U8 + (size_t)id * 1024 + 16 * lane); B.vv[j] = *(const GAS v4u*)(V8 + (size_t)id * 1024 + 16 * lane);
        B.xx[j] = *(const LAS v4u*)(xl + tl * 1024 + 16 * lane);
    }
}
template <int TPW> DI void g3_compute(f32x2 (&acc)[TPW][8], const G3Buf& B, const v4u& E, int lane) {
    int p[4];
#pragma unroll
    for (int j = 0; j < 4; ++j) { int d = __builtin_amdgcn_sdot4((int)B.uu[j].x, (int)B.xx[j].x, 0, false); d = __builtin_amdgcn_sdot4((int)B.uu[j].y, (int)B.xx[j].y, d, false);
        d = __builtin_amdgcn_sdot4((int)B.uu[j].z, (int)B.xx[j].z, d, false); p[j] = __builtin_amdgcn_sdot4((int)B.uu[j].w, (int)B.xx[j].w, d, false); }
    const bool b0 = lane & 1, b1 = lane & 2;
    const int kA = b0 ? p[1] : p[0], sA = b0 ? p[0] : p[1], kB = b0 ? p[3] : p[2], sB = b0 ? p[2] : p[3];
    const int qA = kA + dpp_i<0xB1>(sA), qB = kB + dpp_i<0xB1>(sB);
    const int kk = b1 ? qB : qA, ss = b1 ? qA : qB;
    int r = kk + dpp_i<0x4E>(ss);
    r += dpp_i<0x124>(r); r += dpp_i<0x128>(r);
    r += __shfl_xor(r, 16); r += __shfl_xor(r, 32);
    const float a = (float)r * __uint_as_float(E.z);
    const float cfl = __uint_as_float(E.y) * gelu_tanh_f(a);
#pragma unroll
    for (int j = 0; j < 4; ++j) {
        const float cf = __uint_as_float(__builtin_amdgcn_readlane(__float_as_uint(cfl), j)); const f32x2 c2 = {cf, cf};
        const unsigned tl = (unsigned)__builtin_amdgcn_readlane((int)E.x, j) >> 16;
#pragma unroll
        for (int t = 0; t < TPW; ++t) if (tl == (unsigned)t) { asm volatile("; acc case %0" :: "n"(t));
#pragma unroll
            for (int w = 0; w < 4; ++w) { acc[t][2 * w] = __builtin_amdgcn_cvt_pk_f32_fp8((int)B.vv[j][w], false) * c2 + acc[t][2 * w]; acc[t][2 * w + 1] = __builtin_amdgcn_cvt_pk_f32_fp8((int)B.vv[j][w], true) * c2 + acc[t][2 * w + 1]; }
            asm volatile("; acc case %0 end" :: "n"(t));
        }
    }
}
template <int TPW> DI void peer_gather_sweep3(Frame& F, const Args& A, const int* IDX, const float* GATE, size_t tok0) {
    const int lane = F.lane, wid = F.wave;
    const unsigned char* U8 = F.ws + WS_U8; const unsigned char* V8 = F.ws + WS_V8; const unsigned char* X8 = F.ws + WS_X8;
    const float* SU = (const float*)(F.ws + WS_SU); const float* SX = (const float*)(F.ws + WS_SX);
    LAS unsigned char* list = F.lds + GL3_LIST + wid * (TPW * 2048); LAS unsigned char* xl = F.lds + GL3_X + wid * (TPW * 1024);
    {
        int idlo[TPW], idhi[TPW]; float glo[TPW], ghi[TPW], slo[TPW], shi[TPW];
#pragma unroll
        for (int tl = 0; tl < TPW; ++tl) { const size_t t = tok0 + tl;
            *(LAS v4u*)(xl + tl * 1024 + 16 * lane) = *(const GAS v4u*)(X8 + t * 1024 + 16 * lane);
            idlo[tl] = IDX[t * 128 + lane]; idhi[tl] = IDX[t * 128 + 64 + lane]; const float sx = SX[t];
            glo[tl] = GATE[t * 128 + lane] * (1.f / 64.f); ghi[tl] = GATE[t * 128 + 64 + lane] * (1.f / 64.f);
            slo[tl] = SU[idlo[tl]] * sx; shi[tl] = SU[idhi[tl]] * sx; }
        int base = 0;
        for (int s = 0; s < 32; ++s) {
#pragma unroll
            for (int tl = 0; tl < TPW; ++tl) {
                { const bool m = (idlo[tl] >> 9) == s; const unsigned long long mk = __ballot(m); const int pos = base + (int)__builtin_amdgcn_mbcnt_hi((unsigned)(mk >> 32), __builtin_amdgcn_mbcnt_lo((unsigned)mk, 0u));
                  if (m) *(LAS v4u*)(list + pos * 16) = (v4u){(unsigned)idlo[tl] | ((unsigned)tl << 16), __float_as_uint(glo[tl]), __float_as_uint(slo[tl]), 0u};
                  base += __builtin_popcountll(mk); }
                { const bool m = (idhi[tl] >> 9) == s; const unsigned long long mk = __ballot(m); const int pos = base + (int)__builtin_amdgcn_mbcnt_hi((unsigned)(mk >> 32), __builtin_amdgcn_mbcnt_lo((unsigned)mk, 0u));
                  if (m) *(LAS v4u*)(list + pos * 16) = (v4u){(unsigned)idhi[tl] | ((unsigned)tl << 16), __float_as_uint(ghi[tl]), __float_as_uint(shi[tl]), 0u};
                  base += __builtin_popcountll(mk); }
            }
        }
    }
    LDS_WAIT(); asm volatile("" ::: "memory");
    f32x2 acc[TPW][8];
#pragma unroll
    for (int tl = 0; tl < TPW; ++tl)
#pragma unroll
        for (int i = 0; i < 8; ++i) acc[tl][i] = (f32x2){0.f, 0.f};
    constexpr int NB = TPW * 32;
    G3Buf BA, BB; v4u EA, EB;
    g3_issue<TPW>(BA, EA, list, xl, U8, V8, 0, lane);
    for (int b = 0; b < NB; b += 2) {
        g3_issue<TPW>(BB, EB, list, xl, U8, V8, b + 1, lane);
        g3_compute<TPW>(acc, BA, EA, lane);
        g3_issue<TPW>(BA, EA, list, xl, U8, V8, (b + 2 < NB) ? b + 2 : NB - 1, lane);
        g3_compute<TPW>(acc, BB, EB, lane);
    }
#pragma unroll
    for (int tl = 0; tl < TPW; ++tl) {
        float* hp = F.out + (tok0 + tl) * 1024 + 16 * lane;
        f32x4 y[4]; float ssq = 0.f;
#pragma unroll
        for (int i = 0; i < 4; ++i) { y[i] = *(const GAS f32x4*)(hp + 4 * i); y[i].x += acc[tl][2 * i].x; y[i].y += acc[tl][2 * i].y; y[i].z += acc[tl][2 * i + 1].x; y[i].w += acc[tl][2 * i + 1].y;
            ssq += (y[i].x * y[i].x + y[i].y * y[i].y) + (y[i].z * y[i].z + y[i].w * y[i].w); }
        const float rs = 1.f / sqrtf(wave_sum(ssq) * (1.f / 1024.f) + EPS);
#pragma unroll
        for (int i = 0; i < 4; ++i) { const f32x4 gv = *(const GAS f32x4*)(A.in[20] + 16 * lane + 4 * i); *(GAS f32x4*)(hp + 4 * i) = y[i] * rs * gv; }
    }
    LDS_WAIT(); asm volatile("" ::: "memory");
}
constexpr int G5_NSH = 16, G5_SHIFT = 10;
struct G5Buf { v4u uu[4], vv[4]; };
DI void g5_issue(G5Buf& B, v4u& E, const LAS unsigned char* tlist, const unsigned char* U8, const unsigned char* V8, int k, int lane) {
    E = *(const LAS v4u*)(tlist + (4 * k + (lane & 3)) * 16);
#pragma unroll
    for (int j = 0; j < 4; ++j) {
        const unsigned id = (unsigned)__builtin_amdgcn_readlane((int)E.x, j);
        B.uu[j] = *(const GAS v4u*)(U8 + (size_t)id * 1024 + 16 * lane); B.vv[j] = *(const GAS v4u*)(V8 + (size_t)id * 1024 + 16 * lane);
    }
}
DI void g5_compute(f32x2 (&acc)[8], const v4u& xx, const G5Buf& B, const v4u& E, int lane) {
    int p[4];
#pragma unroll
    for (int j = 0; j < 4; ++j) { int d = __builtin_amdgcn_sdot4((int)B.uu[j].x, (int)xx.x, 0, false); d = __builtin_amdgcn_sdot4((int)B.uu[j].y, (int)xx.y, d, false);
        d = __builtin_amdgcn_sdot4((int)B.uu[j].z, (int)xx.z, d, false); p[j] = __builtin_amdgcn_sdot4((int)B.uu[j].w, (int)xx.w, d, false); }
    const bool b0 = lane & 1, b1 = lane & 2;
    const int kA = b0 ? p[1] : p[0], sA = b0 ? p[0] : p[1], kB = b0 ? p[3] : p[2], sB = b0 ? p[2] : p[3];
    const int qA = kA + dpp_i<0xB1>(sA), qB = kB + dpp_i<0xB1>(sB);
    const int kk = b1 ? qB : qA, ss = b1 ? qA : qB;
    int r = kk + dpp_i<0x4E>(ss);
    r += dpp_i<0x124>(r); r += dpp_i<0x128>(r);
    r += __shfl_xor(r, 16); r += __shfl_xor(r, 32);
    const float a = (float)r * __uint_as_float(E.z);
    const float y = 0.7978845608028654f * (a + 0.044715f * a * a * a);
    const float th = 1.f - 2.f * __builtin_amdgcn_rcpf(1.f + __expf(2.f * y));
    const float cfl = __uint_as_float(E.y) * 0.5f * a * (1.f + th);
#pragma unroll
    for (int j = 0; j < 4; ++j) { const float cf = __uint_as_float(__builtin_amdgcn_readlane(__float_as_uint(cfl), j)); const f32x2 c2 = {cf, cf};
#pragma unroll
        for (int w = 0; w < 4; ++w) { acc[2 * w] = __builtin_amdgcn_cvt_pk_f32_fp8((int)B.vv[j][w], false) * c2 + acc[2 * w]; acc[2 * w + 1] = __builtin_amdgcn_cvt_pk_f32_fp8((int)B.vv[j][w], true) * c2 + acc[2 * w + 1]; } }
}
DI void peer_gather_sweep5(Frame& F, const Args& A, const int* IDX, const float* GATE, size_t tok0) {
    constexpr int TPW = 4;
    const int lane = F.lane, wid = F.wave;
    const unsigned char* U8 = F.ws + WS_U8; const unsigned char* V8 = F.ws + WS_V8; const unsigned char* X8 = F.ws + WS_X8;
    const float* SU = (const float*)(F.ws + WS_SU); const float* SX = (const float*)(F.ws + WS_SX);
    LAS unsigned char* list = F.lds + wid * (TPW * 2048);
    v4u xq[TPW];
#pragma unroll
    for (int tl = 0; tl < TPW; ++tl) {
        const size_t t = tok0 + tl;
        xq[tl] = *(const GAS v4u*)(X8 + t * 1024 + 16 * lane);
        const int idlo = IDX[t * 128 + lane], idhi = IDX[t * 128 + 64 + lane]; const float sx = SX[t];
        const float glo = GATE[t * 128 + lane] * (1.f / 64.f), ghi = GATE[t * 128 + 64 + lane] * (1.f / 64.f);
        const float slo = SU[idlo] * sx, shi = SU[idhi] * sx;
        LAS unsigned char* tl_list = list + tl * 2048;
        int base = 0;
        for (int s = 0; s < G5_NSH; ++s) {
            { const bool m = (idlo >> G5_SHIFT) == s; const unsigned long long mk = __ballot(m); const int pos = base + (int)__builtin_amdgcn_mbcnt_hi((unsigned)(mk >> 32), __builtin_amdgcn_mbcnt_lo((unsigned)mk, 0u));
              if (m) *(LAS v4u*)(tl_list + pos * 16) = (v4u){(unsigned)idlo, __float_as_uint(glo), __float_as_uint(slo), 0u};
              base += __builtin_popcountll(mk); }
            { const bool m = (idhi >> G5_SHIFT) == s; const unsigned long long mk = __ballot(m); const int pos = base + (int)__builtin_amdgcn_mbcnt_hi((unsigned)(mk >> 32), __builtin_amdgcn_mbcnt_lo((unsigned)mk, 0u));
              if (m) *(LAS v4u*)(tl_list + pos * 16) = (v4u){(unsigned)idhi, __float_as_uint(ghi), __float_as_uint(shi), 0u};
              base += __builtin_popcountll(mk); }
        }
    }
    LDS_WAIT(); asm volatile("" ::: "memory");
    f32x2 acc[TPW][8];
#pragma unroll
    for (int tl = 0; tl < TPW; ++tl)
#pragma unroll
        for (int i = 0; i < 8; ++i) acc[tl][i] = (f32x2){0.f, 0.f};
    G5Buf BA, BB; v4u EA, EB;
    g5_issue(BA, EA, list, U8, V8, 0, lane);
    for (int k = 0; k < 32; ++k) {
        g5_issue(BB, EB, list + 2048, U8, V8, k, lane);      g5_compute(acc[0], xq[0], BA, EA, lane);
        g5_issue(BA, EA, list + 4096, U8, V8, k, lane);      g5_compute(acc[1], xq[1], BB, EB, lane);
        g5_issue(BB, EB, list + 6144, U8, V8, k, lane);      g5_compute(acc[2], xq[2], BA, EA, lane);
        g5_issue(BA, EA, list, U8, V8, k < 31 ? k + 1 : 31, lane);   g5_compute(acc[3], xq[3], BB, EB, lane);
    }
#pragma unroll
    for (int tl = 0; tl < TPW; ++tl) {
        float* hp = F.out + (tok0 + tl) * 1024 + 16 * lane;
        f32x4 y[4]; float ssq = 0.f;
#pragma unroll
        for (int i = 0; i < 4; ++i) { y[i] = *(const GAS f32x4*)(hp + 4 * i); y[i].x += acc[tl][2 * i].x; y[i].y += acc[tl][2 * i].y; y[i].z += acc[tl][2 * i + 1].x; y[i].w += acc[tl][2 * i + 1].y;
            ssq += (y[i].x * y[i].x + y[i].y * y[i].y) + (y[i].z * y[i].z + y[i].w * y[i].w); }
        const float rs = 1.f / sqrtf(wave_sum(ssq) * (1.f / 1024.f) + EPS);
#pragma unroll
        for (int i = 0; i < 4; ++i) { const f32x4 gv = *(const GAS f32x4*)(A.in[20] + 16 * lane + 4 * i); *(GAS f32x4*)(hp + 4 * i) = y[i] * rs * gv; }
    }
    LDS_WAIT(); asm volatile("" ::: "memory");
}
constexpr int G6_NSH = 16, G6_SHIFT = 10, G6_TPW = 8;
DI void g6_issue(v4u (&R)[4], v4u& E, const LAS unsigned char* tlist, const unsigned char* TAB, int k, int lane) {
    E = *(const LAS v4u*)(tlist + (4 * k + (lane & 3)) * 16);
#pragma unroll
    for (int j = 0; j < 4; ++j) { const unsigned id = (unsigned)__builtin_amdgcn_readlane((int)E.x, j); R[j] = *(const GAS v4u*)(TAB + (size_t)id * 1024 + 16 * lane); }
}
DI void g6_dot(const v4u& xx, const v4u (&U)[4], const v4u& E, LAS unsigned char* tlist, int k, int lane) {
    int p[4];
#pragma unroll
    for (int j = 0; j < 4; ++j) { int d = __builtin_amdgcn_sdot4((int)U[j].x, (int)xx.x, 0, false); d = __builtin_amdgcn_sdot4((int)U[j].y, (int)xx.y, d, false);
        d = __builtin_amdgcn_sdot4((int)U[j].z, (int)xx.z, d, false); p[j] = __builtin_amdgcn_sdot4((int)U[j].w, (int)xx.w, d, false); }
    const bool b0 = lane & 1, b1 = lane & 2;
    const int kA = b0 ? p[1] : p[0], sA = b0 ? p[0] : p[1], kB = b0 ? p[3] : p[2], sB = b0 ? p[2] : p[3];
    const int qA = kA + dpp_i<0xB1>(sA), qB = kB + dpp_i<0xB1>(sB);
    const int kk = b1 ? qB : qA, ss = b1 ? qA : qB;
    int r = kk + dpp_i<0x4E>(ss);
    r += dpp_i<0x124>(r); r += dpp_i<0x128>(r);
    r += __shfl_xor(r, 16); r += __shfl_xor(r, 32);
    const float a = (float)r * __uint_as_float(E.z);
    const float y = 0.7978845608028654f * (a + 0.044715f * a * a * a);
    const float th = 1.f - 2.f * __builtin_amdgcn_rcpf(1.f + __expf(2.f * y));
    const float cfl = __uint_as_float(E.y) * __uint_as_float(E.w) * 0.5f * a * (1.f + th);
    if (lane < 4) *(LAS float*)(tlist + (4 * k + lane) * 16 + 4) = cfl;
}
typedef _Float16 h2_t __attribute__((ext_vector_type(2)));
typedef _Float16 h32_t __attribute__((ext_vector_type(32)));
DI void g6_issue_v(u32x3v (&R)[4], v4u& E, const LAS unsigned char* tlist, const unsigned char* TAB, int k, int lane) {
    E = *(const LAS v4u*)(tlist + (4 * k + (lane & 3)) * 16);
#pragma unroll
    for (int j = 0; j < 4; ++j) { const unsigned id = (unsigned)__builtin_amdgcn_readlane((int)E.x, j); R[j] = *(const GAS u32x3v*)(TAB + (size_t)id * 768 + 12 * lane); }
}
DI void g6_fma(h2_t (&acc)[8], const u32x3v (&V)[4], const v4u& E, int lane) {
#pragma unroll
    for (int jp = 0; jp < 2; ++jp) {
        const i32x6v pk = {(int)V[2 * jp][0], (int)V[2 * jp][1], (int)V[2 * jp][2], (int)V[2 * jp + 1][0], (int)V[2 * jp + 1][1], (int)V[2 * jp + 1][2]};
        const h32_t hv = __builtin_bit_cast(h32_t, __builtin_amdgcn_cvt_scalef32_pk32_f16_fp6(pk, 1.0f));
#pragma unroll
        for (int q = 0; q < 2; ++q) { const float cf = __uint_as_float(__builtin_amdgcn_readlane((int)E.y, 2 * jp + q)); const _Float16 ch = (_Float16)cf; const h2_t c2 = {ch, ch};
#pragma unroll
            for (int w = 0; w < 8; ++w) { const h2_t vv = {hv[16 * q + 2 * w], hv[16 * q + 2 * w + 1]}; acc[w] = __builtin_elementwise_fma(vv, c2, acc[w]); } }
    }
}
DI void peer_gather_wave6(Frame& F, const Args& A, const bf16* XN2, const float* SS2, const int* IDX, const float* GATE, size_t tok0) {
    constexpr int TPW = G6_TPW;
    const int lane = F.lane, wid = F.wave;
    const unsigned char* U8 = F.ws + WS_U8; const unsigned char* V8 = F.ws + WS_V8;
    const float* SU = (const float*)(F.ws + WS_SU); const float* SV = (const float*)(F.ws + WS_SV);
    LAS unsigned char* list = F.lds + wid * (TPW * 2048);
    v4u xq[TPW];
#pragma unroll
    for (int tl = 0; tl < TPW; ++tl) {
        const size_t t = tok0 + tl;
        float sx;
        {
            float xv[16];
#pragma unroll
            for (int j = 0; j < 4; ++j) { const unsigned long long hw = *(const GAS unsigned long long*)(XN2 + t * 1024 + 256 * j + 4 * lane); const unsigned lo_ = (unsigned)hw, hi_ = (unsigned)(hw >> 32);
                xv[4 * j] = bflo(lo_); xv[4 * j + 1] = bfhi(lo_); xv[4 * j + 2] = bflo(hi_); xv[4 * j + 3] = bfhi(hi_); }
            {
                const f32x4* sp = (const f32x4*)(SS2 + t * 16); const f32x4 a = sp[0], b = sp[1], c = sp[2], d = sp[3];
                const float tt = ((a[0] + a[1]) + (a[2] + a[3])) + ((b[0] + b[1]) + (b[2] + b[3])) + ((c[0] + c[1]) + (c[2] + c[3])) + ((d[0] + d[1]) + (d[2] + d[3]));
                const float rs = 1.0f / sqrtf(tt * (1.0f / 1024.0f) + EPS);
#pragma unroll
                for (int i = 0; i < 4; ++i) { const f32x4 gv = *(const GAS f32x4*)(A.in[15] + 256 * i + 4 * lane); xv[4 * i] *= rs * gv.x; xv[4 * i + 1] *= rs * gv.y; xv[4 * i + 2] *= rs * gv.z; xv[4 * i + 3] *= rs * gv.w; }
            }
            float mx = 0.f;
#pragma unroll
            for (int i = 0; i < 16; ++i) mx = fmaxf(mx, fabsf(xv[i]));
            mx = wave_max(mx); sx = mx > 0.f ? mx * (1.f / 127.f) : 1.f; const float inv = 1.f / sx;
#pragma unroll
            for (int i = 0; i < 4; ++i) { const int a = (int)rintf(xv[4 * i] * inv), b = (int)rintf(xv[4 * i + 1] * inv), c = (int)rintf(xv[4 * i + 2] * inv), d = (int)rintf(xv[4 * i + 3] * inv);
                xq[tl][i] = (unsigned)(a & 255) | ((unsigned)(b & 255) << 8) | ((unsigned)(c & 255) << 16) | ((unsigned)(d & 255) << 24); }
        }
        const int idlo = IDX[t * 128 + lane], idhi = IDX[t * 128 + 64 + lane];
        const float glo = GATE[t * 128 + lane], ghi = GATE[t * 128 + 64 + lane];
        const float slo = SU[idlo] * sx, shi = SU[idhi] * sx, vlo = SV[idlo], vhi = SV[idhi];
        LAS unsigned char* tl_list = list + tl * 2048;
        int base = 0;
        for (int s = 0; s < G6_NSH; ++s) {
            { const bool m = (idlo >> G6_SHIFT) == s; const unsigned long long mk = __ballot(m); const int pos = base + (int)__builtin_amdgcn_mbcnt_hi((unsigned)(mk >> 32), __builtin_amdgcn_mbcnt_lo((unsigned)mk, 0u));
              if (m) *(LAS v4u*)(tl_list + pos * 16) = (v4u){(unsigned)idlo, __float_as_uint(glo), __float_as_uint(slo), __float_as_uint(vlo)};
              base += __builtin_popcountll(mk); }
            { const bool m = (idhi >> G6_SHIFT) == s; const unsigned long long mk = __ballot(m); const int pos = base + (int)__builtin_amdgcn_mbcnt_hi((unsigned)(mk >> 32), __builtin_amdgcn_mbcnt_lo((unsigned)mk, 0u));
              if (m) *(LAS v4u*)(tl_list + pos * 16) = (v4u){(unsigned)idhi, __float_as_uint(ghi), __float_as_uint(shi), __float_as_uint(vhi)};
              base += __builtin_popcountll(mk); }
        }
    }
    LDS_WAIT(); asm volatile("" ::: "memory");
#define G6_SB __builtin_amdgcn_sched_barrier(0)
    {
        v4u RA[4], RB[4]; v4u EA, EB;
        g6_issue(RA, EA, list, U8, 0, lane);
        for (int k = 0; k < 32; ++k) {
#define G6_P1(RI, EI, tn, kn, RC, EC, tc) do { g6_issue(RI, EI, list + (tn) * 2048, U8, kn, lane); G6_SB; g6_dot(xq[tc], RC, EC, list + (tc) * 2048, k, lane); G6_SB; } while (0)
            G6_P1(RB, EB, 1, k, RA, EA, 0); G6_P1(RA, EA, 2, k, RB, EB, 1); G6_P1(RB, EB, 3, k, RA, EA, 2); G6_P1(RA, EA, 4, k, RB, EB, 3);
            G6_P1(RB, EB, 5, k, RA, EA, 4); G6_P1(RA, EA, 6, k, RB, EB, 5); G6_P1(RB, EB, 7, k, RA, EA, 6); G6_P1(RA, EA, 0, (k < 31 ? k + 1 : 31), RB, EB, 7);
#undef G6_P1
        }
    }
    LDS_WAIT(); asm volatile("" ::: "memory");
    h2_t acc[TPW][8];
#pragma unroll
    for (int tl = 0; tl < TPW; ++tl)
#pragma unroll
        for (int i = 0; i < 8; ++i) acc[tl][i] = (h2_t){(_Float16)0.f, (_Float16)0.f};
    {
        u32x3v RA[4], RB[4]; v4u EA, EB;
        g6_issue_v(RA, EA, list, V8, 0, lane);
        for (int k = 0; k < 32; ++k) {
#define G6_P2(RI, EI, tn, kn, RC, EC, tc) do { g6_issue_v(RI, EI, list + (tn) * 2048, V8, kn, lane); G6_SB; g6_fma(acc[tc], RC, EC, lane); G6_SB; } while (0)
            G6_P2(RB, EB, 1, k, RA, EA, 0); G6_P2(RA, EA, 2, k, RB, EB, 1); G6_P2(RB, EB, 3, k, RA, EA, 2); G6_P2(RA, EA, 4, k, RB, EB, 3);
            G6_P2(RB, EB, 5, k, RA, EA, 4); G6_P2(RA, EA, 6, k, RB, EB, 5); G6_P2(RB, EB, 7, k, RA, EA, 6); G6_P2(RA, EA, 0, (k < 31 ? k + 1 : 31), RB, EB, 7);
#undef G6_P2
        }
    }
#undef G6_SB
#pragma unroll
    for (int tl = 0; tl < TPW; ++tl) {
        float* hp = F.out + (tok0 + tl) * 1024 + 4 * lane;
        f32x4 y[4]; float ssq = 0.f;
#pragma unroll
        for (int i = 0; i < 4; ++i) { const unsigned long long hw = *(const GAS unsigned long long*)(XN2 + (tok0 + tl) * 1024 + 256 * i + 4 * lane); const unsigned lo_ = (unsigned)hw, hi_ = (unsigned)(hw >> 32);
            y[i] = (f32x4){bflo(lo_), bfhi(lo_), bflo(hi_), bfhi(hi_)}; }
#pragma unroll
        for (int i = 0; i < 4; ++i) { y[i].x += (float)acc[tl][2 * i].x; y[i].y += (float)acc[tl][2 * i].y; y[i].z += (float)acc[tl][2 * i + 1].x; y[i].w += (float)acc[tl][2 * i + 1].y;
            ssq += (y[i].x * y[i].x + y[i].y * y[i].y) + (y[i].z * y[i].z + y[i].w * y[i].w); }
        const float rs = 1.f / sqrtf(wave_sum(ssq) * (1.f / 1024.f) + EPS);
#pragma unroll
        for (int i = 0; i < 4; ++i) { const f32x4 gv = *(const GAS f32x4*)(A.in[20] + 256 * i + 4 * lane); *(GAS f32x4*)(hp + 256 * i) = y[i] * rs * gv; }
    }
    LDS_WAIT(); asm volatile("" ::: "memory");
}

constexpr size_t WS_XBUF = 73 * MiB;
constexpr int CW_SEAM = 16384, SEAM_BANK = 8192;
__global__ void __launch_bounds__(NWAVES * 64, 2) fwd_kernel(Args args) {
    extern __shared__ __attribute__((aligned(16))) unsigned char lds[];
    Frame F;
    F.lds = (LAS unsigned char*)lds;
    F.MISC = (volatile LAS unsigned*)(F.lds + MISC_OFF);
    F.tid = threadIdx.x; F.lane = F.tid & 63; F.wave = __builtin_amdgcn_readfirstlane(F.tid >> 6);
    F.G = gridDim.x; { const int bx = blockIdx.x; F.vcu = (F.G % 8 == 0) ? (bx % 8) * (F.G / 8) + bx / 8 : bx; }
    unsigned char* ws = args.ws;
    F.ctl = (gu32*)(ws + WS_CTL);
    F.out = args.out; F.ws = ws;
    for (int u = F.tid; u < (LDS_BYTES - LDSCTL_OFF) / 4; u += NWAVES * 64) ((LAS unsigned*)(F.lds + LDSCTL_OFF))[u] = 0u;
    __syncthreads();
    XcdBarrier bar = xcd_barrier_post((unsigned*)(F.ctl + CW_BAR) + args.li * XCD_BAR_WORDS, F.MISC + 8);
    const int lo = args.ph_lo, hi = args.ph_hi;
#ifndef PH_MASK
#define PH_MASK 0xffff
#endif
#define IN(k) (((PH_MASK >> (k)) & 1) && lo <= (k) && (k) < hi)
#define SEAM(k) do { if (IN(k) && IN((k) + 1)) xcd_barrier(bar); } while (0)
    const int gw = F.vcu * NWAVES + F.wave, NGW = F.G * NWAVES;
#define STW ((bf16*)F.out)
#define OSB (F.out + (size_t)M * 512)
#define IDX ((int*)F_BUFA)
#define GATE ((float*)(F_BUFA) + (size_t)M * 128)

    if (IN(0)) { p0_prologue(F, args); __syncthreads(); p0_late(F, args, gw, NGW); } SEAM(0);
    if (IN(1)) {
        { pg8::Gemm g{F_BUFA, F_W1T, 1024, 1024, 1024}; pg8::StaticOrder S; S.init(M, N1, F.G, (int)blockIdx.x, 1024, 1024);
          pg8::EpiBf16P E{F_PROJ, N1, 1.f};
          pg8::gemm_phase<pg8::EpiBf16P, pg8::StaticOrder, true, true>(F.lds, g, S, E); }
        { pg8::Gemm g{F_MN, F_WXKVT, 1024, 1024, 1024}; const int c = (int)blockIdx.x; pg8::OneUnitOrder S{(c >= 64 && c < 128) ? c - 64 : -1, 8, 1024, 1024};
          pg8::EpiBf16P E{F_KV, 2048, 1.f};
          pg8::gemm_phase<pg8::EpiBf16P, pg8::OneUnitOrder, true, true>(F.lds, g, S, E); }
    } SEAM(1);
    if (IN(2)) {
        __syncthreads();
        for (int task = gw; task < 64 * 64; task += NGW) { const int bh = task >> 6; sb_wave(F, OSB, bh >> 3, bh & 7, 63 - (task & 63)); }
        __syncthreads();
        { v4u gw_[6]; int it = F.vcu; if (it < 1024) gla_stage_load(F, (it >> 5) >> 2, (it >> 5) & 3, it & 31, gw_);
          for (; it < 1024; it += F.G) { const int bh = it >> 5, itn = it + F.G < 1024 ? it + F.G : it, bhn = itn >> 5; gla_local_unit(F, args, STW, bh >> 2, bh & 3, it & 31, gw_, bhn >> 2, bhn & 3, itn & 31); } }
    } SEAM(2);
    if (IN(3)) { gla_scan(F, STW);
    } SEAM(3);
    if (IN(4)) {
        { v4u gw_[6]; int it = F.vcu; if (it < 1024) gla_stage_load(F, (it >> 5) >> 2, (it >> 5) & 3, it & 31, gw_);
          for (; it < 1024; it += F.G) { const int bh = it >> 5, itn = it + F.G < 1024 ? it + F.G : it, bhn = itn >> 5; gla_out_unit(F, args, STW, bh >> 2, bh & 3, it & 31, gw_, bhn >> 2, bhn & 3, itn & 31); } }
        for (int m = 4 * gw; m < M; m += 4 * NGW) mix_rows_sb<4>(F, args, OSB, (size_t)m);
    } SEAM(4);
    if (IN(5)) { pg8::Gemm g{F_BUFA, F_WOT, 1024, 1024, 1024}; pg8::StaticOrder S; S.init(M, 1024, F.G, (int)blockIdx.x, 1024, 1024);
        pg8::EpiResB<false> E{args.in[0], F_SLOT1, (float*)(ws + WS_XBUF), 1024};
        pg8::gemm_phase<pg8::EpiResB<false>, pg8::StaticOrder, true, true>(F.lds, g, S, E); } SEAM(5);
    if (IN(6)) { pg8::Gemm g{F_SLOT1, F_WXQT, 1024, 1024, 1024}; pg8::StaticOrder S; S.init(M, 1024, F.G, (int)blockIdx.x, 1024, 1024);
        pg8::EpiBf16RowScale E{F_SLOT2, 1024, (const float*)(ws + WS_XBUF), EPS};
        pg8::gemm_phase<pg8::EpiBf16RowScale, pg8::StaticOrder, true, true>(F.lds, g, S, E); } SEAM(6);
    if (IN(7)) { for (int it = F.vcu; it < 256; it += F.G) xattn_unit(F, F_SLOT2, F_SLOT0, it >> 5, (it >> 3) & 3, it & 7); } SEAM(7);
    if (IN(8)) { pg8::Gemm g{F_SLOT0, F_WXOT, 1024, 1024, 1024}; pg8::StaticOrder S; S.init(M, 1024, F.G, (int)blockIdx.x, 1024, 1024);
        pg8::EpiResB<true> E{F_SLOT1, F_SLOT2, (float*)(ws + WS_XBUF + MiB), 1024};
        pg8::gemm_phase<pg8::EpiResB<true>, pg8::StaticOrder, true, true>(F.lds, g, S, E); } SEAM(8);
    if (IN(9)) { pg8::Gemm g{F_SLOT2, F_WPQT, 1024, 1024, 1024}; pg8::StaticOrder S; S.init(M, 2048, F.G, (int)blockIdx.x, 1024, 1024);
        pg8::EpiBf16RowScale E{F_SLOT0, 2048, (const float*)(ws + WS_XBUF + MiB), EPS};
        pg8::gemm_phase<pg8::EpiBf16RowScale, pg8::StaticOrder, true, true>(F.lds, g, S, E); } SEAM(9);
    if (IN(10)) { peer_topk_mfma2(F, F_SLOT0, IDX, GATE); } SEAM(10);
    if (IN(11)) { peer_gather_wave6(F, args, F_SLOT2, (const float*)(ws + WS_XBUF + MiB), IDX, GATE, (size_t)F.vcu * 64 + F.wave * 8); }
#undef IN
#undef SEAM
}

constexpr int NPHASES = 12;
extern "C" void kernel_launch(void* const* d_in, const int* in_sizes, int n_in, void* d_out, int out_size, void* d_ws, size_t ws_size, hipStream_t stream) {
    static int grid = 0;
    if (grid == 0) {
        if (n_in != 21 || out_size != M * DM || ws_size < WS_END) { fprintf(stderr, "kernel_launch: unexpected shapes (n_in %d out %d ws %zu)\n", n_in, out_size, ws_size); grid = -1; return; }
        int dev = 0, cus = 0, per_cu = 0;
        if (hipGetDevice(&dev) != hipSuccess || hipDeviceGetAttribute(&cus, hipDeviceAttributeMultiprocessorCount, dev) != hipSuccess) { grid = -1; return; }
        if (hipFuncSetAttribute((const void*)fwd_kernel, hipFuncAttributeMaxDynamicSharedMemorySize, LDS_BYTES) != hipSuccess) { fprintf(stderr, "kernel_launch: hipFuncSetAttribute failed\n"); grid = -1; return; }
        if (hipOccupancyMaxActiveBlocksPerMultiprocessor(&per_cu, (const void*)fwd_kernel, NWAVES * 64, LDS_BYTES) != hipSuccess || per_cu < 1) { fprintf(stderr, "kernel_launch: occupancy query says %d\n", per_cu); }
        (void)hipGetLastError();
        grid = cus;
    }
    if (grid < 0) return;
    (void)hipMemsetAsync((char*)d_ws + WS_CTL, 0, CTL_ZERO_BYTES, stream);
    Args a{};
    for (int i = 0; i < 21; ++i) a.in[i] = (const float*)d_in[i];
    a.out = (float*)d_out; a.ws = (unsigned char*)d_ws;
#if defined(PROF_DUP_LO)
    a.ph_lo = 0; a.ph_hi = PROF_DUP_HI + 1; a.li = 0; hipLaunchKernelGGL(fwd_kernel, dim3(grid), dim3(NWAVES * 64), LDS_BYTES, stream, a);
    a.ph_lo = PROF_DUP_LO; a.ph_hi = NPHASES; a.li = 1; hipLaunchKernelGGL(fwd_kernel, dim3(grid), dim3(NWAVES * 64), LDS_BYTES, stream, a);
#elif defined(PROF_SPLIT)
    a.ph_lo = 0; a.ph_hi = PROF_SPLIT; a.li = 0; hipLaunchKernelGGL(fwd_kernel, dim3(grid), dim3(NWAVES * 64), LDS_BYTES, stream, a);
    a.ph_lo = PROF_SPLIT; a.ph_hi = NPHASES; a.li = 1; hipLaunchKernelGGL(fwd_kernel, dim3(grid), dim3(NWAVES * 64), LDS_BYTES, stream, a);
#else
    a.ph_lo = 0; a.ph_hi = NPHASES; a.li = 0;
    hipLaunchKernelGGL(fwd_kernel, dim3(grid), dim3(NWAVES * 64), LDS_BYTES, stream, a);
#endif
}
```

```cpp
#include <hip/hip_runtime.h>
#include <cstdio>
#include <cstdint>
namespace pg8 {
#define PG8_LAS __attribute__((address_space(3)))
typedef unsigned short bf16_t;
typedef short bf16x8 __attribute__((ext_vector_type(8)));
typedef float f32x4 __attribute__((ext_vector_type(4)));
typedef unsigned u32x4 __attribute__((ext_vector_type(4)));
constexpr int BM = 256, BK = 64, HALF = 128, HTB = HALF * BK * 2  , STAGE_BYTES = 8 * HTB, NXCD = 8, WGM = 8;

__host__ __device__ __forceinline__ int lds_byte(int r, int c) { const int st = (r >> 4) * 2 + (c >> 5), rr = r & 15, cc = c & 31, ob = rr * 64 + cc * 2; return st * 1024 + (ob ^ (((ob >> 9) & 1) << 5)); }
__host__ __device__ __forceinline__ void stage_rc(int b, int& R, int& C) { const int st = b / 1024, sb = b % 1024, swz = sb ^ (((sb >> 9) & 1) << 5); R = (st >> 1) * 16 + swz / 64; C = (st & 1) * 32 + (swz % 64) / 2; }
__host__ __device__ __forceinline__ int perm32(int rho) { const int n = rho >> 4, i = rho & 15; return 8 * (i >> 2) + 4 * n + (i & 3); }

struct Unit { int pm, pn; size_t aoff, boff; };
struct Gemm { const bf16_t* A; const bf16_t* Bt; int K, lda, ldb; };

struct StaticOrder {
    int nM, nN, nwg, G, c, lda, ldb;
    __host__ __device__ void init(int M, int N, int G_, int c_, int lda_, int ldb_) { nM = M / BM; nN = N / BM; nwg = nM * nN; G = G_; c = c_; lda = lda_; ldb = ldb_; }
    __host__ __device__ bool next(int i, Unit& u) const {
        const long L = (long)i * G + c; if (L >= nwg) return false;
        int wgid = (int)L; { const int q = nwg / NXCD, r = nwg % NXCD, xcd = wgid % NXCD, off = wgid / NXCD; wgid = (xcd < r ? xcd * (q + 1) : r * (q + 1) + (xcd - r) * q) + off; }
        const int nig = WGM * nN, gid = wgid / nig, fm = gid * WGM, gsz = (nM - fm) < WGM ? (nM - fm) : WGM;
        u.pm = fm + ((wgid % nig) % gsz); u.pn = (wgid % nig) / gsz; u.aoff = (size_t)u.pm * BM * lda * 2; u.boff = (size_t)u.pn * BM * ldb * 2; return true;
    }
    __device__ __forceinline__ void a_ready(const Unit&) const {}
    __device__ __forceinline__ void done(const Unit&) const {}
};

__device__ __forceinline__ unsigned cvt_pk_bf16(float lo, float hi) { unsigned r; asm volatile("v_cvt_pk_bf16_f32 %0, %1, %2" : "=v"(r) : "v"(lo), "v"(hi)); return r; }
typedef float f32x2 __attribute__((ext_vector_type(2)));
__device__ __forceinline__ f32x2 gelu_pk(f32x2 v) {
    const f32x2 av = __builtin_elementwise_abs(v), d = av * 0.2316418882f + 1.0f;
    f32x2 t; t.x = __builtin_amdgcn_rcpf(d.x); t.y = __builtin_amdgcn_rcpf(d.y);
    f32x2 q = t * 0.5307027145f + (-0.7265760135f); q = q * t + 0.7107068705f; q = q * t + (-0.142248368f); q = q * t + 0.127414796f; q = q * t;
    const f32x2 s = (v * v) * (-0.72134752044f);
    f32x2 e; e.x = __builtin_amdgcn_exp2f(s.x); e.y = __builtin_amdgcn_exp2f(s.y);
    const f32x2 m = v * (q * e), r = v - m;
    f32x2 o; o.x = v.x < 0.f ? m.x : r.x; o.y = v.y < 0.f ? m.y : r.y; return o;
}

template <int ACT  > struct EpiBf16 {
    static constexpr bool PERM = true, AFTER_DRAIN = false; static_assert(ACT == 0 || ACT == 1, "EpiBf16: ACT is 0 (none) or 1 (gelu_pk)");
    bf16_t* O; int ldc; const float* bias; int split_cols; size_t split_stride; float scale0;
    __device__ __forceinline__ void operator()(const f32x4 (&acc)[2][2][4][2], const Unit& u, int wr, int wc, int fr, int fq) const {
        const int row0 = u.pm * BM + wr * 64 + fr; int colt = u.pn * BM; bf16_t* base = O;
        float sc = 1.f; if (split_cols) { const int t = colt / split_cols; base += (size_t)t * split_stride; colt -= t * split_cols; if (t == 0) sc = scale0; }
        const int col0 = colt + wc * 32 + 8 * fq, bcol0 = u.pn * BM + wc * 32 + 8 * fq;
        f32x4 bv[2][2];
#pragma unroll
        for (int bj = 0; bj < 2; ++bj)
#pragma unroll
            for (int n = 0; n < 2; ++n) bv[bj][n] = bias ? *(const f32x4*)(bias + bcol0 + bj * HALF + 4 * n) : (f32x4){0.f, 0.f, 0.f, 0.f};
#pragma unroll
        for (int ai = 0; ai < 2; ++ai)
#pragma unroll
            for (int m = 0; m < 4; ++m) { bf16_t* rowp = base + (size_t)(row0 + ai * HALF + m * 16) * ldc + col0;
#pragma unroll
                for (int bj = 0; bj < 2; ++bj) { f32x4 v0 = acc[ai][bj][m][0] + bv[bj][0], v1 = acc[ai][bj][m][1] + bv[bj][1];
                    if (ACT == 1) { f32x2 a = gelu_pk((f32x2){v0[0], v0[1]}), b = gelu_pk((f32x2){v0[2], v0[3]}), c = gelu_pk((f32x2){v1[0], v1[1]}), d = gelu_pk((f32x2){v1[2], v1[3]});
                        v0 = (f32x4){a.x, a.y, b.x, b.y}; v1 = (f32x4){c.x, c.y, d.x, d.y}; }
                    v0 = v0 * sc; v1 = v1 * sc; u32x4 w; w.x = cvt_pk_bf16(v0[0], v0[1]); w.y = cvt_pk_bf16(v0[2], v0[3]); w.z = cvt_pk_bf16(v1[0], v1[1]); w.w = cvt_pk_bf16(v1[2], v1[3]);
                    *(u32x4*)(rowp + bj * HALF) = w; } }
    }
};
template <class Epi, class Sched, bool ALIGN_EPI = false, bool SP2 = false>
__device__ __forceinline__ void gemm_phase(PG8_LAS unsigned char* lds, const Gemm g, const Sched& S, const Epi& E) {
    const int tid = threadIdx.x, wid = __builtin_amdgcn_readfirstlane(tid >> 6), lane = tid & 63, wr = wid >> 2, wc = wid & 3, fr = lane & 15, fq = lane >> 4;
    int K = g.K; asm volatile("" : "+s"(K));
    const int nt = K / BK;
    unsigned voffA[2], voffB[2];
#pragma unroll
    for (int i = 0; i < 2; ++i) { int R, C; stage_rc(tid * 16 + i * 8192, R, C); const int Rb = Epi::PERM ? ((R & ~31) + perm32(R & 31)) : R;
        voffA[i] = (unsigned)(R * g.lda + C) * 2u; voffB[i] = (unsigned)(Rb * g.ldb + C) * 2u; }
    const size_t kstep = (size_t)(BK * 2);
    const size_t hA = (size_t)HALF * g.lda * 2, hB = (size_t)HALF * g.ldb * 2;
    const unsigned ldsw = (unsigned)wid * 1024u;
    const int aoff = lds_byte(wr * 64 + fr, fq * 8), boff = lds_byte(wc * 32 + fr, fq * 8);
#define PG8_SA(b, h) (((b) * 2 + (h)) * HTB)
#define PG8_SB(b, h) ((4 + (b) * 2 + (h)) * HTB)
#define PG8_STAGE(bufoff, gbase, voff) do { _Pragma("unroll") for (int _i = 0; _i < 2; ++_i) \
        __builtin_amdgcn_global_load_lds((const unsigned*)((const char*)(gbase) + (voff)[_i]), (PG8_LAS unsigned*)(lds + (bufoff) + ldsw + _i * 8192), 16, 0, 0); } while (0)
#define PG8_LDA(dst, b, h) do { _Pragma("unroll") for (int m = 0; m < 4; ++m) _Pragma("unroll") for (int k = 0; k < 2; ++k) dst[m][k] = *(const PG8_LAS bf16x8*)(lds + PG8_SA(b, h) + aoff + m * 2048 + k * 1024); } while (0)
#define PG8_LDB(dst, b, h) do { _Pragma("unroll") for (int n = 0; n < 2; ++n) _Pragma("unroll") for (int k = 0; k < 2; ++k) dst[n][k] = *(const PG8_LAS bf16x8*)(lds + PG8_SB(b, h) + boff + n * 2048 + k * 1024); } while (0)
#define PG8_MMA(ai, bj, At, Bt) do { __builtin_amdgcn_s_setprio(1); _Pragma("unroll") for (int m = 0; m < 4; ++m) _Pragma("unroll") for (int n = 0; n < 2; ++n) _Pragma("unroll") for (int k = 0; k < 2; ++k) \
        acc[ai][bj][m][n] = __builtin_amdgcn_mfma_f32_16x16x32_bf16(Bt[n][k], At[m][k], acc[ai][bj][m][n], 0, 0, 0); __builtin_amdgcn_s_setprio(0); } while (0)
#define PG8_WAIT_V(n) asm volatile("s_waitcnt vmcnt(" #n ")" ::: "memory")
#define PG8_WAIT_L(n) asm volatile("s_waitcnt lgkmcnt(" #n ")" ::: "memory")
#define PG8_BAR __builtin_amdgcn_s_barrier()
#define PG8_SCHED __builtin_amdgcn_sched_barrier(0)
    Unit cur, nxt; int ui = 0;
    if (!S.next(0, cur)) return;
    f32x4 acc[2][2][4][2];
#pragma unroll
    for (int a = 0; a < 2; ++a)
#pragma unroll
        for (int b = 0; b < 2; ++b)
#pragma unroll
            for (int m = 0; m < 4; ++m)
#pragma unroll
                for (int n = 0; n < 2; ++n) acc[a][b][m][n] = (f32x4){0.f, 0.f, 0.f, 0.f};
    bf16x8 At[4][2], B0[2][2], B1[2][2];
    const char* cA = (const char*)g.A + cur.aoff; const char* cB = (const char*)g.Bt + cur.boff;
    S.a_ready(cur);
    if constexpr (SP2) {
        PG8_STAGE(PG8_SB(0, 0), cB, voffB); PG8_STAGE(PG8_SB(0, 1), cB + hB, voffB); PG8_STAGE(PG8_SA(0, 0), cA, voffA); PG8_STAGE(PG8_SA(0, 1), cA + hA, voffA);
        if (wr == 1) PG8_BAR;
        PG8_WAIT_V(2); PG8_BAR;
        PG8_STAGE(PG8_SB(1, 0), cB + kstep, voffB); PG8_STAGE(PG8_SA(1, 0), cA + kstep, voffA); PG8_STAGE(PG8_SB(1, 1), cB + hB + kstep, voffB);
        PG8_WAIT_V(6); PG8_BAR;
    } else {
        PG8_STAGE(PG8_SB(0, 0), cB, voffB); PG8_STAGE(PG8_SA(0, 0), cA, voffA); PG8_STAGE(PG8_SB(0, 1), cB + hB, voffB); PG8_STAGE(PG8_SA(0, 1), cA + hA, voffA);
        if (wr == 1) PG8_BAR;
        PG8_WAIT_V(4); PG8_BAR;
        PG8_STAGE(PG8_SB(1, 0), cB + kstep, voffB); PG8_STAGE(PG8_SA(1, 0), cA + kstep, voffA); PG8_STAGE(PG8_SB(1, 1), cB + hB + kstep, voffB);
        PG8_WAIT_V(6); PG8_BAR;
    }
    for (;;) {
        const bool has_next = S.next(ui + 1, nxt);
        const char* nA = has_next ? (const char*)g.A + nxt.aoff : cA; const char* nB = has_next ? (const char*)g.Bt + nxt.boff : cB;
        for (int t = 0; t < nt; t += 2) {
            const bool last = (t == nt - 2);
            const char* a1 = cA + (size_t)(t + 1) * kstep;
            const char* a2 = last ? nA : cA + (size_t)(t + 2) * kstep; const char* b2 = last ? nB : cB + (size_t)(t + 2) * kstep;
            const char* a3 = a2 + kstep; const char* b3 = b2 + kstep;
            if (last && has_next) S.a_ready(nxt);
            if constexpr (SP2) {
            PG8_LDB(B0, 0, 0); PG8_LDB(B1, 0, 1); PG8_SCHED; PG8_LDA(At, 0, 0); PG8_STAGE(PG8_SA(1, 1), a1 + hA, voffA);
            PG8_WAIT_V(8); PG8_WAIT_L(0); PG8_BAR; PG8_MMA(0, 0, At, B0); PG8_MMA(0, 1, At, B1); PG8_BAR; PG8_SCHED;
            PG8_LDA(At, 0, 1); PG8_STAGE(PG8_SB(0, 0), b2, voffB); PG8_STAGE(PG8_SB(0, 1), b2 + hB, voffB); PG8_STAGE(PG8_SA(0, 0), a2, voffA);
            PG8_WAIT_V(8); PG8_WAIT_L(0); PG8_BAR; PG8_MMA(1, 0, At, B0); PG8_MMA(1, 1, At, B1); PG8_BAR; PG8_SCHED;
            PG8_LDB(B0, 1, 0); PG8_LDB(B1, 1, 1); PG8_SCHED; PG8_LDA(At, 1, 0); PG8_STAGE(PG8_SA(0, 1), a2 + hA, voffA);
            PG8_WAIT_V(8); PG8_WAIT_L(0); PG8_BAR; PG8_MMA(0, 0, At, B0); PG8_MMA(0, 1, At, B1); PG8_BAR; PG8_SCHED;
            PG8_LDA(At, 1, 1); PG8_STAGE(PG8_SB(1, 0), b3, voffB); PG8_STAGE(PG8_SB(1, 1), b3 + hB, voffB); PG8_STAGE(PG8_SA(1, 0), a3, voffA);
            PG8_WAIT_V(8); PG8_WAIT_L(0); PG8_BAR; PG8_MMA(1, 0, At, B0); PG8_MMA(1, 1, At, B1); PG8_BAR; PG8_SCHED;
            } else {
            PG8_LDB(B0, 0, 0); PG8_SCHED; PG8_LDA(At, 0, 0); PG8_STAGE(PG8_SA(1, 1), a1 + hA, voffA);
            PG8_WAIT_L(8); PG8_BAR; PG8_WAIT_L(0); PG8_MMA(0, 0, At, B0); PG8_BAR; PG8_SCHED;
            PG8_LDB(B1, 0, 1); PG8_STAGE(PG8_SB(0, 0), b2, voffB);
            PG8_BAR; PG8_WAIT_L(0); PG8_MMA(0, 1, At, B1); PG8_BAR;
            PG8_LDA(At, 0, 1); PG8_STAGE(PG8_SA(0, 0), a2, voffA);
            PG8_BAR; PG8_WAIT_L(0); PG8_MMA(1, 0, At, B0); PG8_BAR; PG8_SCHED;
            PG8_STAGE(PG8_SB(0, 1), b2 + hB, voffB);
            PG8_WAIT_V(6); PG8_BAR; PG8_MMA(1, 1, At, B1); PG8_BAR;
            PG8_LDB(B0, 1, 0); PG8_SCHED; PG8_LDA(At, 1, 0); PG8_STAGE(PG8_SA(0, 1), a2 + hA, voffA);
            PG8_WAIT_L(8); PG8_BAR; PG8_WAIT_L(0); PG8_MMA(0, 0, At, B0); PG8_BAR; PG8_SCHED;
            PG8_LDB(B1, 1, 1); PG8_STAGE(PG8_SB(1, 0), b3, voffB);
            PG8_BAR; PG8_WAIT_L(0); PG8_MMA(0, 1, At, B1); PG8_BAR;
            PG8_LDA(At, 1, 1); PG8_STAGE(PG8_SA(1, 0), a3, voffA);
            PG8_BAR; PG8_WAIT_L(0); PG8_MMA(1, 0, At, B0); PG8_BAR; PG8_SCHED;
            PG8_STAGE(PG8_SB(1, 1), b3 + hB, voffB);
            PG8_WAIT_V(6); PG8_BAR; PG8_MMA(1, 1, At, B1); PG8_BAR;
            }
        }
        if constexpr (ALIGN_EPI) { if (wr == 0) PG8_BAR; }
        if constexpr (!Epi::AFTER_DRAIN) { E(acc, cur, wr, wc, fr, fq); S.done(cur); }
        if (!has_next) break;
#pragma unroll
        for (int a = 0; a < 2; ++a)
#pragma unroll
            for (int b = 0; b < 2; ++b)
#pragma unroll
                for (int m = 0; m < 4; ++m)
#pragma unroll
                    for (int n = 0; n < 2; ++n) acc[a][b][m][n] = (f32x4){0.f, 0.f, 0.f, 0.f};
        cur = nxt; cA = nA; cB = nB; ++ui;
        if constexpr (ALIGN_EPI) { if (wr == 1) PG8_BAR; }
    }
    PG8_WAIT_V(0);
    if constexpr (!ALIGN_EPI) { if (wr == 0) PG8_BAR; }
    PG8_BAR;
    if constexpr (Epi::AFTER_DRAIN) { E.fused(acc, cur, wr, wc, fr, fq, lds, wid, lane); S.done(cur); }
#undef PG8_SA
#undef PG8_SB
#undef PG8_STAGE
#undef PG8_LDA
#undef PG8_LDB
#undef PG8_MMA
#undef PG8_WAIT_V
#undef PG8_WAIT_L
#undef PG8_BAR
#undef PG8_SCHED
}
}
namespace pg8 {
struct EpiBf16P {
    static constexpr bool PERM = true, AFTER_DRAIN = false;
    bf16_t* O; int ldc; float sc;
    __device__ __forceinline__ void operator()(const f32x4 (&acc)[2][2][4][2], const Unit& u, int wr, int wc, int fr, int fq) const {
        const int row0 = u.pm * BM + wr * 64 + fr, col0 = u.pn * BM + wc * 32 + 8 * fq;
#pragma unroll
        for (int ai = 0; ai < 2; ++ai)
#pragma unroll
            for (int m = 0; m < 4; ++m) { bf16_t* rowp = O + (size_t)(row0 + ai * HALF + m * 16) * ldc + col0;
#pragma unroll
                for (int bj = 0; bj < 2; ++bj) { const f32x4 v0 = acc[ai][bj][m][0] * sc, v1 = acc[ai][bj][m][1] * sc;
                    u32x4 w; w.x = cvt_pk_bf16(v0[0], v0[1]); w.y = cvt_pk_bf16(v0[2], v0[3]); w.z = cvt_pk_bf16(v1[0], v1[1]); w.w = cvt_pk_bf16(v1[2], v1[3]);
                    *(u32x4*)(rowp + bj * HALF) = w; } }
    }
};
struct EpiF32Res {
    static constexpr bool PERM = false, AFTER_DRAIN = false;
    const float* base; float* out; int ldc;
    __device__ __forceinline__ void operator()(const f32x4 (&acc)[2][2][4][2], const Unit& u, int wr, int wc, int fr, int fq) const {
        const int row0 = u.pm * BM + wr * 64 + fr, col0 = u.pn * BM + wc * 32 + 4 * fq;
#pragma unroll
        for (int ai = 0; ai < 2; ++ai)
#pragma unroll
            for (int m = 0; m < 4; ++m) { const size_t off = (size_t)(row0 + ai * HALF + m * 16) * ldc + col0;
#pragma unroll
                for (int bj = 0; bj < 2; ++bj)
#pragma unroll
                    for (int n = 0; n < 2; ++n) { const f32x4 b = *(const f32x4*)(base + off + bj * HALF + n * 16); *(f32x4*)(out + off + bj * HALF + n * 16) = b + acc[ai][bj][m][n]; } }
    }
};
template <int mode> struct XAttnOrder {
    int G, c;
    __device__ __forceinline__ bool next(int i, Unit& u) const {
        const int L = i * G + c; if (L >= 256) return false;
        u.pm = L >> 2; u.pn = L & 3; const int b = u.pm >> 3;
        u.aoff = ((size_t)u.pm * 256 * 1024 + (size_t)u.pn * 256) * 2;
        u.boff = mode == 0 ? ((size_t)(b * 256) * 2048 + (size_t)u.pn * 256) * 2 : ((size_t)((b * 4 + u.pn) * 256) * 256) * 2;
        return true;
    }
    __device__ __forceinline__ void a_ready(const Unit&) const {}
    __device__ __forceinline__ void done(const Unit&) const {}
};
struct OneUnitOrder {
    int L, nN, lda, ldb;
    __device__ __forceinline__ bool next(int i, Unit& u) const {
        if (i != 0 || L < 0) return false;
        u.pm = L / nN; u.pn = L % nN; u.aoff = (size_t)u.pm * BM * lda * 2; u.boff = (size_t)u.pn * BM * ldb * 2; return true;
    }
    __device__ __forceinline__ void a_ready(const Unit&) const {}
    __device__ __forceinline__ void done(const Unit&) const {}
};
}

namespace pg8 {
struct EpiResRms {
    static constexpr bool PERM = false, AFTER_DRAIN = true;
    const float* base; float* out; bf16_t* hn; const float* g; int ldc; unsigned* xbuf; unsigned* cnt; float eps;
    __device__ __forceinline__ void fused(f32x4 (&acc)[2][2][4][2], const Unit& u, int wr, int wc, int fr, int fq, PG8_LAS unsigned char* lds, int wid, int lane) const {
        PG8_LAS float* P = (PG8_LAS float*)lds;
        PG8_LAS float* S = (PG8_LAS float*)(lds + 8192);
        const int col0 = u.pn * BM + wc * 32 + 4 * fq;
#pragma unroll
        for (int ai = 0; ai < 2; ++ai)
#pragma unroll
            for (int m = 0; m < 4; ++m) { const size_t off = (size_t)(u.pm * BM + ai * HALF + wr * 64 + m * 16 + fr) * ldc + col0; float s = 0.f;
#pragma unroll
                for (int bj = 0; bj < 2; ++bj)
#pragma unroll
                    for (int n = 0; n < 2; ++n) { const f32x4 b = *(const f32x4*)(base + off + bj * HALF + n * 16); f32x4 x = acc[ai][bj][m][n] + b; acc[ai][bj][m][n] = x; s += (x[0] * x[0] + x[1] * x[1]) + (x[2] * x[2] + x[3] * x[3]); }
                s += __shfl_xor(s, 16); s += __shfl_xor(s, 32);
                if (fq == 0) P[(ai * HALF + wr * 64 + m * 16 + fr) * 4 + wc] = s;
                if (m & 1) asm volatile("" ::: "memory"); }
        asm volatile("s_waitcnt lgkmcnt(0)" ::: "memory"); __builtin_amdgcn_s_barrier(); asm volatile("" ::: "memory");
        const int row = wid * 32 + (lane & 31);
        if (lane < 32) { const float t = (P[row * 4 + 0] + P[row * 4 + 1]) + (P[row * 4 + 2] + P[row * 4 + 3]);
            __hip_atomic_store(xbuf + (size_t)(u.pm * BM + row) * 4 + u.pn, __float_as_uint(t), __ATOMIC_RELAXED, __HIP_MEMORY_SCOPE_AGENT); }
        asm volatile("s_waitcnt vmcnt(0)" ::: "memory");
        if (lane == 0) __hip_atomic_fetch_add(cnt + 64 * u.pm, 1u, __ATOMIC_RELAXED, __HIP_MEMORY_SCOPE_AGENT);
        if (wid == 0) {
            const unsigned long long t0 = __builtin_amdgcn_s_memrealtime();
            while ((unsigned)__builtin_amdgcn_readfirstlane(__hip_atomic_load(cnt + 64 * u.pm, __ATOMIC_RELAXED, __HIP_MEMORY_SCOPE_AGENT)) < 32u) {
                if (__builtin_amdgcn_s_memrealtime() - t0 > 2000000ull) break;
                __builtin_amdgcn_s_sleep(2); }
            __builtin_amdgcn_fence(__ATOMIC_ACQUIRE, "agent");
        }
        asm volatile("s_waitcnt vmcnt(0) lgkmcnt(0)" ::: "memory"); __builtin_amdgcn_s_barrier(); asm volatile("" ::: "memory");
        if (lane < 32) { const unsigned* sl = xbuf + (size_t)(u.pm * BM + row) * 4; float t = 0.f;
#pragma unroll
            for (int q = 0; q < 4; ++q) t += __uint_as_float(__hip_atomic_load(sl + q, __ATOMIC_RELAXED, __HIP_MEMORY_SCOPE_AGENT));
            S[row] = 1.0f / sqrtf(t * (1.0f / 1024.0f) + eps); }
        asm volatile("s_waitcnt lgkmcnt(0)" ::: "memory"); __builtin_amdgcn_s_barrier(); asm volatile("" ::: "memory");
        f32x4 gv[2][2];
#pragma unroll
        for (int bj = 0; bj < 2; ++bj)
#pragma unroll
            for (int n = 0; n < 2; ++n) gv[bj][n] = *(const f32x4*)(g + col0 + bj * HALF + n * 16);
#pragma unroll
        for (int ai = 0; ai < 2; ++ai)
#pragma unroll
            for (int m = 0; m < 4; ++m) { const int r = ai * HALF + wr * 64 + m * 16 + fr; const float rs = S[r]; const size_t off = (size_t)(u.pm * BM + r) * ldc + col0;
#pragma unroll
                for (int bj = 0; bj < 2; ++bj)
#pragma unroll
                    for (int n = 0; n < 2; ++n) { const f32x4 x = acc[ai][bj][m][n]; *(f32x4*)(out + off + bj * HALF + n * 16) = x;
                        const f32x4 y = x * rs * gv[bj][n]; typedef unsigned u32x2v __attribute__((ext_vector_type(2))); u32x2v w; w.x = cvt_pk_bf16(y[0], y[1]); w.y = cvt_pk_bf16(y[2], y[3]);
                        *(u32x2v*)(hn + off + bj * HALF + n * 16) = w; }
                asm volatile("" ::: "memory"); }
    }
};
}

namespace pg8 {
struct EpiResSS {
    static constexpr bool PERM = false, AFTER_DRAIN = false;
    const float* base; float* out; bf16_t* hb; float* ss; int ldc;
    __device__ __forceinline__ void operator()(const f32x4 (&acc)[2][2][4][2], const Unit& u, int wr, int wc, int fr, int fq) const {
        const int row0 = u.pm * BM + wr * 64 + fr, col0 = u.pn * BM + wc * 32 + 4 * fq;
#pragma unroll
        for (int ai = 0; ai < 2; ++ai)
#pragma unroll
            for (int m = 0; m < 4; ++m) { const int row = row0 + ai * HALF + m * 16; const size_t off = (size_t)row * ldc + col0; float s = 0.f;
#pragma unroll
                for (int bj = 0; bj < 2; ++bj)
#pragma unroll
                    for (int n = 0; n < 2; ++n) { const f32x4 x = *(const f32x4*)(base + off + bj * HALF + n * 16) + acc[ai][bj][m][n]; *(f32x4*)(out + off + bj * HALF + n * 16) = x;
                        typedef unsigned u32x2v __attribute__((ext_vector_type(2))); u32x2v w; w.x = cvt_pk_bf16(x[0], x[1]); w.y = cvt_pk_bf16(x[2], x[3]); *(u32x2v*)(hb + off + bj * HALF + n * 16) = w;
                        s += (x[0] * x[0] + x[1] * x[1]) + (x[2] * x[2] + x[3] * x[3]); }
                s += __shfl_xor(s, 16); s += __shfl_xor(s, 32);
                if (fq == 0) ss[(size_t)row * 16 + u.pn * 4 + wc] = s; }
    }
};
struct EpiBf16RowScale {
    static constexpr bool PERM = true, AFTER_DRAIN = false;
    bf16_t* O; int ldc; const float* ss; float eps;
    __device__ __forceinline__ void operator()(const f32x4 (&acc)[2][2][4][2], const Unit& u, int wr, int wc, int fr, int fq) const {
        const int row0 = u.pm * BM + wr * 64 + fr, col0 = u.pn * BM + wc * 32 + 8 * fq;
#pragma unroll
        for (int ai = 0; ai < 2; ++ai)
#pragma unroll
            for (int m = 0; m < 4; ++m) { const int row = row0 + ai * HALF + m * 16; const f32x4* sp = (const f32x4*)(ss + (size_t)row * 16);
                const f32x4 a = sp[0], b = sp[1], c = sp[2], d = sp[3];
                const float t = ((a[0] + a[1]) + (a[2] + a[3])) + ((b[0] + b[1]) + (b[2] + b[3])) + ((c[0] + c[1]) + (c[2] + c[3])) + ((d[0] + d[1]) + (d[2] + d[3]));
                const float rs = 1.0f / sqrtf(t * (1.0f / 1024.0f) + eps);
                bf16_t* rowp = O + (size_t)row * ldc + col0;
#pragma unroll
                for (int bj = 0; bj < 2; ++bj) { const f32x4 v0 = acc[ai][bj][m][0] * rs, v1 = acc[ai][bj][m][1] * rs;
                    u32x4 w; w.x = cvt_pk_bf16(v0[0], v0[1]); w.y = cvt_pk_bf16(v0[2], v0[3]); w.z = cvt_pk_bf16(v1[0], v1[1]); w.w = cvt_pk_bf16(v1[2], v1[3]);
                    *(u32x4*)(rowp + bj * HALF) = w; } }
    }
};
}

namespace pg8 {
template <bool BASE_BF16> struct EpiResB {
    static constexpr bool PERM = true, AFTER_DRAIN = false;
    const void* base; bf16_t* hb; float* ss; int ldc;
    __device__ __forceinline__ void operator()(const f32x4 (&acc)[2][2][4][2], const Unit& u, int wr, int wc, int fr, int fq) const {
        const int row0 = u.pm * BM + wr * 64 + fr, col0 = u.pn * BM + wc * 32 + 8 * fq;
#pragma unroll
        for (int ai = 0; ai < 2; ++ai)
#pragma unroll
            for (int m = 0; m < 4; ++m) { const int row = row0 + ai * HALF + m * 16; const size_t off = (size_t)row * ldc + col0; float s = 0.f;
#pragma unroll
                for (int bj = 0; bj < 2; ++bj) { f32x4 b0, b1;
                    if (BASE_BF16) { const u32x4 w = *(const u32x4*)((const bf16_t*)base + off + bj * HALF);
                        b0 = (f32x4){__uint_as_float(w.x << 16), __uint_as_float(w.x & 0xffff0000u), __uint_as_float(w.y << 16), __uint_as_float(w.y & 0xffff0000u)};
                        b1 = (f32x4){__uint_as_float(w.z << 16), __uint_as_float(w.z & 0xffff0000u), __uint_as_float(w.w << 16), __uint_as_float(w.w & 0xffff0000u)}; }
                    else { b0 = *(const f32x4*)((const float*)base + off + bj * HALF); b1 = *(const f32x4*)((const float*)base + off + bj * HALF + 4); }
                    const f32x4 x0 = b0 + acc[ai][bj][m][0], x1 = b1 + acc[ai][bj][m][1];
                    u32x4 w; w.x = cvt_pk_bf16(x0[0], x0[1]); w.y = cvt_pk_bf16(x0[2], x0[3]); w.z = cvt_pk_bf16(x1[0], x1[1]); w.w = cvt_pk_bf16(x1[2], x1[3]);
                    *(u32x4*)(hb + off + bj * HALF) = w;
                    s += ((x0[0] * x0[0] + x0[1] * x0[1]) + (x0[2] * x0[2] + x0[3] * x0[3])) + ((x1[0] * x1[0] + x1[1] * x1[1]) + (x1[2] * x1[2] + x1[3] * x1[3])); }
                s += __shfl_xor(s, 16); s += __shfl_xor(s, 32);
                if (fq == 0) ss[(size_t)row * 16 + u.pn * 4 + wc] = s; }
    }
};
}

constexpr int NWAVES = 8;
constexpr int BATCH = 8, SEQ = 2048, DM = 1024, M = BATCH * SEQ, MEMLEN = 256, MM = BATCH * MEMLEN;
constexpr int INCOLS = 3088;
constexpr int N1 = 3328;
constexpr int PQ = 0, PK = 256, PV = 512, POG = 1024, PSQ = 1536, PSK = 2048, PSV = 2560, PGATE = 3072;
constexpr int PEER_N = 16384;
constexpr float EPS = 1e-6f;

constexpr size_t MiB = 1u << 20;
constexpr size_t WS_CTL = 0, CTL_ZERO_BYTES = 1 * MiB;
constexpr size_t WS_W1T = 1 * MiB;
constexpr size_t WS_WOT = 8 * MiB, WS_WXQT = 10 * MiB, WS_WXOT = 12 * MiB, WS_WXKVT = 14 * MiB, WS_WPQT = 18 * MiB, WS_SUBK = 22 * MiB;
constexpr size_t WS_UB = 24 * MiB, WS_VB = 56 * MiB;
constexpr size_t WS_BUFA = 88 * MiB;
constexpr size_t WS_MN = 120 * MiB;
constexpr size_t WS_KV = 124 * MiB;
constexpr size_t WS_PROJ = 132 * MiB;
constexpr size_t WS_SLOT0 = 132 * MiB, WS_SLOT1 = 164 * MiB, WS_SLOT2 = 196 * MiB, WS_VT = 76 * MiB, WS_END = 236 * MiB;
constexpr int CW_BAR = 4096;
constexpr int CW_SBSS = 32768;

constexpr int RING_BYTES = 131072;
constexpr int LDSCTL_OFF = RING_BYTES, MISC_OFF = LDSCTL_OFF + 320;
constexpr int LDS_BYTES = 147456;

#define GAS __attribute__((address_space(1)))
#define LAS __attribute__((address_space(3)))
typedef unsigned short bf16;
typedef unsigned v4u __attribute__((ext_vector_type(4)));
typedef float f32x4 __attribute__((ext_vector_type(4)));
typedef short bf16x8 __attribute__((ext_vector_type(8)));
typedef GAS unsigned gu32;
typedef GAS unsigned long long gu64;
#define RLX_AGENT __ATOMIC_RELAXED, __HIP_MEMORY_SCOPE_AGENT
#define LDS_WAIT() asm volatile("s_waitcnt lgkmcnt(0)" ::: "memory")
#define VM_WAIT() asm volatile("s_waitcnt vmcnt(0)" ::: "memory")
__device__ __forceinline__ unsigned long long rt() { return __builtin_amdgcn_s_memrealtime(); }
__device__ __forceinline__ unsigned f2bf(float f) { unsigned u = __builtin_bit_cast(unsigned, f); return (u + 0x7fffu + ((u >> 16) & 1u)) >> 16; }
__device__ __forceinline__ unsigned pk2(float lo, float hi) { return f2bf(lo) | (f2bf(hi) << 16); }

#define XB_TMO      128
#define XB_XCNT(j)  (256  + 64 * (j))
#define XB_XSUB(j)  (1280 + 64 * (j))
#define XB_XGEN(j)  (2304 + 64 * (j))
#define XB_TOP      3328
#define XB_TOPGEN   3392
#define XCD_BAR_WORDS 3456
#define XB_SPIN_CAP (1u << 22)

__device__ __forceinline__ unsigned xb_ld(unsigned* p)              { return __hip_atomic_load(p, __ATOMIC_RELAXED, __HIP_MEMORY_SCOPE_AGENT); }
__device__ __forceinline__ unsigned xb_add(unsigned* p, unsigned v) { return __hip_atomic_fetch_add(p, v, __ATOMIC_RELAXED, __HIP_MEMORY_SCOPE_AGENT); }
__device__ __forceinline__ unsigned xb_xcc_id() { return (unsigned)__builtin_amdgcn_s_getreg((3 << 11) | 20) & 0xFu; }
#define XB_SPIN(cond, bar) do { unsigned _sp = 0; while (cond) { __builtin_amdgcn_s_sleep(1); \
    if ((++_sp & 255u) == 0u) { if (xb_ld(&(bar)[XB_TMO])) break; if (_sp > XB_SPIN_CAP) { atomicAdd(&(bar)[XB_TMO], 1u); break; } } } } while (0)

struct XcdBarrier {
    unsigned* bar; unsigned x;
    volatile LAS unsigned* st;
};

__device__ __forceinline__ XcdBarrier xcd_barrier_post(unsigned* bar, volatile LAS unsigned* st) {
    XcdBarrier b; b.bar = bar; b.x = xb_xcc_id(); b.st = st;
    if (threadIdx.x == 0) (void)xb_add(&bar[XB_XCNT(b.x)], 1u);
    return b;
}
__device__ __forceinline__ void xcd_barrier_complete(unsigned* bar, unsigned x, unsigned& nloc, unsigned& nx) {
    const unsigned G = gridDim.x * gridDim.y * gridDim.z;
    unsigned sum, cnt, mine, sp = 0u;
    for (;;) {
        sum = 0u; cnt = 0u; mine = 0u;
#pragma unroll
        for (unsigned j = 0; j < 16; ++j) { const unsigned c = xb_ld(&bar[XB_XCNT(j)]); sum += c; cnt += (c > 0u) ? 1u : 0u; mine = (j == x) ? c : mine; }
        if (sum == G) break;
        __builtin_amdgcn_s_sleep(1);
        if ((++sp & 255u) == 0u) { if (xb_ld(&bar[XB_TMO])) break; if (sp > XB_SPIN_CAP) { atomicAdd(&bar[XB_TMO], 1u); break; } }
    }
    nloc = mine > 0u ? mine : 1u; nx = cnt > 0u ? cnt : 1u;
}

__device__ __forceinline__ void xcd_barrier(const XcdBarrier& b) {
    asm volatile("s_waitcnt vmcnt(0)" ::: "memory");
    __syncthreads();
    if (threadIdx.x == 0) {
        unsigned* bar = b.bar;
        __builtin_amdgcn_s_waitcnt(0);
        unsigned nloc = b.st[0], nx = b.st[1];
        if (nloc == 0u) { xcd_barrier_complete(bar, b.x, nloc, nx); b.st[0] = nloc; b.st[1] = nx; }
        const unsigned old = xb_add(&bar[XB_XSUB(b.x)], 1u);
        const unsigned gen = old / nloc;
        if (old + 1u == (gen + 1u) * nloc) {
            __builtin_amdgcn_fence(__ATOMIC_RELEASE, "agent");
            asm volatile("s_waitcnt vmcnt(0)" ::: "memory");
            const unsigned og = xb_add(&bar[XB_TOP], 1u);
            const unsigned tg = og / nx;
            if (og + 1u == (tg + 1u) * nx) xb_add(&bar[XB_TOPGEN], 1u);
            else XB_SPIN(xb_ld(&bar[XB_TOPGEN]) == tg, bar);
            __builtin_amdgcn_fence(__ATOMIC_ACQUIRE, "agent");
            xb_add(&bar[XB_XGEN(b.x)], 1u);
            asm volatile("s_waitcnt vmcnt(0)" ::: "memory");
        } else {
            XB_SPIN(xb_ld(&bar[XB_XGEN(b.x)]) == gen, bar);
            __builtin_amdgcn_fence(__ATOMIC_ACQUIRE, "agent");
            asm volatile("s_waitcnt vmcnt(0)" ::: "memory");
        }
    }
    __syncthreads();
}

#define DI __device__ __forceinline__
typedef __bf16 bf16x2_t __attribute__((ext_vector_type(2)));
struct Args { const float* in[21]; float* out; unsigned char* ws; int ph_lo, ph_hi, li, pad; };
struct Frame {
    LAS unsigned char* lds;
    volatile LAS unsigned* MISC;
    gu32* ctl;
    int tid, lane, wave;
    int vcu, G;
    unsigned char* ws; float* out;
};
#define WSP(off) ((bf16*)(F.ws + (off)))
#define F_W1T WSP(WS_W1T)
#define F_WOT WSP(WS_WOT)
#define F_WXQT WSP(WS_WXQT)
#define F_WXOT WSP(WS_WXOT)
#define F_WXKVT WSP(WS_WXKVT)
#define F_WPQT WSP(WS_WPQT)
#define F_SUBK WSP(WS_SUBK)
#define F_UB WSP(WS_UB)
#define F_VB WSP(WS_VB)
#define F_BUFA WSP(WS_BUFA)
#define F_MN WSP(WS_MN)
#define F_KV WSP(WS_KV)
#define F_PROJ WSP(WS_PROJ)
#define F_SLOT0 WSP(WS_SLOT0)
#define F_SLOT1 WSP(WS_SLOT1)
#define F_SLOT2 WSP(WS_SLOT2)
#define F_VT WSP(WS_VT)
DI float bf2f(unsigned v) { return __uint_as_float(v << 16); }
DI float bflo(unsigned w) { return __uint_as_float(w << 16); }
DI float bfhi(unsigned w) { return __uint_as_float(w & 0xffff0000u); }
DI float wave_sum(float v) {
#pragma unroll
    for (int o = 1; o < 64; o <<= 1) v += __shfl_xor(v, o);
    return v;
}
DI float wave_max(float v) {
#pragma unroll
    for (int o = 1; o < 64; o <<= 1) v = fmaxf(v, __shfl_xor(v, o));
    return v;
}
DI float dot2_bf16(unsigned w, unsigned x, float a) { return __builtin_amdgcn_fdot2_f32_bf16(__builtin_bit_cast(bf16x2_t, w), __builtin_bit_cast(bf16x2_t, x), a, false); }
DI float silu_f(float x) { return x * __builtin_amdgcn_rcpf(1.f + __expf(-x)); }
DI float log_sigmoid_f(float z) { return fminf(z, 0.f) - __logf(1.f + __expf(-fabsf(z))); }
DI float gelu_tanh_f(float x) { const float y = 0.7978845608028654f * (x + 0.044715f * x * x * x); const float t = 1.f - 2.f / (1.f + __expf(2.f * y)); return 0.5f * x * (1.f + t); }

DI void p0_transpose_item(const float* W, int ldw, int c0, bf16* WT, int row_off, LAS float* scr, int kb, int nb, int lane, const float* kgain = nullptr) {
    const int k0 = 64 * kb, n0 = 32 * nb;
    float tv[32];
#pragma unroll
    for (int i = 0; i < 32; ++i) tv[i] = W[(size_t)(k0 + 2 * i + (lane >> 5)) * ldw + c0 + n0 + (lane & 31)];
    if (kgain) {
#pragma unroll
        for (int i = 0; i < 32; ++i) tv[i] *= kgain[k0 + 2 * i + (lane >> 5)];
    }
#pragma unroll
    for (int i = 0; i < 32; ++i) scr[(2 * i + (lane >> 5)) * 33 + (lane & 31)] = tv[i];
    LDS_WAIT(); asm volatile("" ::: "memory");
    const int c = lane & 7;
#pragma unroll
    for (int j = 0; j < 4; ++j) { const int n = (lane >> 3) + 8 * j; const LAS float* s = scr + (8 * c) * 33 + n;
        v4u o; o.x = pk2(s[0 * 33], s[1 * 33]); o.y = pk2(s[2 * 33], s[3 * 33]); o.z = pk2(s[4 * 33], s[5 * 33]); o.w = pk2(s[6 * 33], s[7 * 33]);
        *(GAS v4u*)(WT + (size_t)(row_off + n0 + n) * 1024 + k0 + 8 * c) = o; }
    LDS_WAIT(); asm volatile("" ::: "memory");
}
DI void rms_row_to_bf16(int lane, const float* xrow, const float* g, bf16* orow) {
    const GAS f32x4* xr = (const GAS f32x4*)xrow + lane; const GAS f32x4* gr = (const GAS f32x4*)g + lane;
    f32x4 v[4]; float s = 0.f;
#pragma unroll
    for (int j = 0; j < 4; ++j) { v[j] = xr[64 * j]; s += (v[j].x * v[j].x + v[j].y * v[j].y) + (v[j].z * v[j].z + v[j].w * v[j].w); }
    const float rs = 1.f / sqrtf(wave_sum(s) * (1.f / 1024.f) + EPS);
    GAS unsigned long long* o8 = (GAS unsigned long long*)orow + lane;
#pragma unroll
    for (int j = 0; j < 4; ++j) { const f32x4 gg = gr[64 * j]; const f32x4 y = v[j] * rs * gg; o8[64 * j] = (unsigned long long)pk2(y.x, y.y) | ((unsigned long long)pk2(y.z, y.w) << 32); }
}
typedef float f32x2 __attribute__((ext_vector_type(2)));
constexpr size_t WS_U8 = 24 * MiB, WS_V8 = 40 * MiB, WS_X8 = 56 * MiB, WS_SU = 72 * MiB, WS_SX = 72 * MiB + 65536, WS_SV = 72 * MiB + 131072;
template <int CTRL> DI int dpp_i(int v) { return __builtin_amdgcn_update_dpp(0, v, CTRL, 0xf, 0xf, false); }
DI void quant_row_i8(int lane, const float* src, unsigned char* dst, float* scale_out) {
    f32x4 v[4]; float m = 0.f;
#pragma unroll
    for (int j = 0; j < 4; ++j) { v[j] = *(const GAS f32x4*)(src + 256 * j + 4 * lane); m = fmaxf(m, fmaxf(fmaxf(fabsf(v[j].x), fabsf(v[j].y)), fmaxf(fabsf(v[j].z), fabsf(v[j].w)))); }
    m = wave_max(m);
    const float sc = m > 0.f ? m * (1.f / 127.f) : 1.f, inv = 1.f / sc;
    v4u o;
#pragma unroll
    for (int j = 0; j < 4; ++j) { const int a = (int)rintf(v[j].x * inv), b = (int)rintf(v[j].y * inv), c = (int)rintf(v[j].z * inv), d = (int)rintf(v[j].w * inv);
        o[j] = (unsigned)(a & 255) | ((unsigned)(b & 255) << 8) | ((unsigned)(c & 255) << 16) | ((unsigned)(d & 255) << 24); }
    *(GAS v4u*)(dst + 16 * lane) = o;
    if (lane == 0) *scale_out = sc;
}
typedef float f32x16v __attribute__((ext_vector_type(16)));
typedef int i32x6v __attribute__((ext_vector_type(6)));
typedef unsigned u32x3v __attribute__((ext_vector_type(3)));
DI unsigned fp6_e2m3(float x) {
    const float m = fminf(fabsf(x), 7.5f);
    const int e = m >= 4.f ? 2 : m >= 2.f ? 1 : 0;
    const int q = (int)rintf(m * (e == 2 ? 2.f : e == 1 ? 4.f : 8.f));
    const unsigned code = e == 0 ? (unsigned)q : (unsigned)((e + 1) * 8 + (q - 8));
    return (x < 0.f ? 32u : 0u) | (code > 31u ? 31u : code);
}
DI void quant_row_fp6(int lane, const float* src, unsigned char* dst, float* sc) {
    float v[16]; float mx = 0.f;
#pragma unroll
    for (int j = 0; j < 4; ++j) { const f32x4 t = *(const GAS f32x4*)(src + 256 * j + 4 * lane);
#pragma unroll
        for (int i = 0; i < 4; ++i) { v[4 * j + i] = t[i]; mx = fmaxf(mx, fabsf(t[i])); } }
    mx = wave_max(mx);
    const float s_ = mx > 0.f ? mx * (1.f / 7.5f) : 1.f, inv = 1.f / s_;
    unsigned long long lo = 0ull; unsigned hi = 0u;
#pragma unroll
    for (int i = 0; i < 16; ++i) { const unsigned long long c = fp6_e2m3(v[i] * inv);
        if (6 * i < 64) lo |= c << (6 * i);
        if (6 * i + 6 > 64) hi |= (unsigned)(6 * i >= 64 ? c << (6 * i - 64) : c >> (64 - 6 * i)); }
    *(GAS u32x3v*)(dst + 12 * lane) = (u32x3v){(unsigned)lo, (unsigned)(lo >> 32), hi};
    if (lane == 0) *sc = s_;
}
DI void rms_row_to_bf16_i8(int lane, const float* xrow, const float* g, bf16* orow, unsigned char* qrow, float* sx) {
    const GAS f32x4* xr = (const GAS f32x4*)xrow + lane; const GAS f32x4* gr = (const GAS f32x4*)g + lane;
    f32x4 v[4]; float s = 0.f;
#pragma unroll
    for (int j = 0; j < 4; ++j) { v[j] = xr[64 * j]; s += (v[j].x * v[j].x + v[j].y * v[j].y) + (v[j].z * v[j].z + v[j].w * v[j].w); }
    const float rs = 1.f / sqrtf(wave_sum(s) * (1.f / 1024.f) + EPS);
    GAS unsigned long long* o8 = (GAS unsigned long long*)orow + lane; float m = 0.f;
#pragma unroll
    for (int j = 0; j < 4; ++j) { const f32x4 gg = gr[64 * j]; v[j] = v[j] * rs * gg; o8[64 * j] = (unsigned long long)pk2(v[j].x, v[j].y) | ((unsigned long long)pk2(v[j].z, v[j].w) << 32);
        m = fmaxf(m, fmaxf(fmaxf(fabsf(v[j].x), fabsf(v[j].y)), fmaxf(fabsf(v[j].z), fabsf(v[j].w)))); }
    m = wave_max(m);
    const float sc = m > 0.f ? m * (1.f / 127.f) : 1.f, inv = 1.f / sc;
#pragma unroll
    for (int j = 0; j < 4; ++j) { const int a = (int)rintf(v[j].x * inv), b = (int)rintf(v[j].y * inv), c = (int)rintf(v[j].z * inv), d = (int)rintf(v[j].w * inv);
        *(GAS unsigned*)(qrow + 4 * lane + 256 * j) = (unsigned)(a & 255) | ((unsigned)(b & 255) << 8) | ((unsigned)(c & 255) << 16) | ((unsigned)(d & 255) << 24); }
    if (lane == 0) *sx = sc;
}
template <int R> DI void rms_rows_to_bf16(int lane, const float* x0, size_t xstride, const float* g, bf16* o0, size_t ostride) {
    f32x4 v[R][4];
#pragma unroll
    for (int r = 0; r < R; ++r)
#pragma unroll
        for (int j = 0; j < 4; ++j) v[r][j] = *((const GAS f32x4*)(x0 + r * xstride) + lane + 64 * j);
    f32x4 gg[4];
#pragma unroll
    for (int j = 0; j < 4; ++j) gg[j] = *((const GAS f32x4*)g + lane + 64 * j);
#pragma unroll
    for (int r = 0; r < R; ++r) { float s = 0.f;
#pragma unroll
        for (int j = 0; j < 4; ++j) s += (v[r][j].x * v[r][j].x + v[r][j].y * v[r][j].y) + (v[r][j].z * v[r][j].z + v[r][j].w * v[r][j].w);
        const float rs = 1.f / sqrtf(wave_sum(s) * (1.f / 1024.f) + EPS);
        GAS unsigned long long* o8 = (GAS unsigned long long*)(o0 + r * ostride) + lane;
#pragma unroll
        for (int j = 0; j < 4; ++j) { const f32x4 y = v[r][j] * rs * gg[j]; o8[64 * j] = (unsigned long long)pk2(y.x, y.y) | ((unsigned long long)pk2(y.z, y.w) << 32); } }
}
DI void p0_prologue(Frame& F, const Args& A) {
    LAS float* scr = (LAS float*)(F.lds + F.wave * 16384);
    const int gw = F.vcu * NWAVES + F.wave, NGW = F.G * NWAVES;
    constexpr int I_IN = 16 * 48, I_W2 = 16 * 64;
    constexpr int NIT = 2 * I_IN + I_W2;
    for (int it = gw; it < NIT; it += NGW) {
        int r = it;
        if (r < I_IN) { p0_transpose_item(A.in[3], INCOLS, 0, F_W1T, 0, scr, r / 48, r % 48, F.lane); continue; } r -= I_IN;
        if (r < I_IN) { p0_transpose_item(A.in[3], INCOLS, 1552, F_W1T, 1536, scr, r / 48, r % 48, F.lane); continue; } r -= I_IN;
        p0_transpose_item(A.in[13], 2048, 0, F_WXKVT, 0, scr, r / 64, r % 64, F.lane);
    }
    const int gt = gw * 64 + F.lane, NGT = NGW * 64;
    for (int i = gt; i < 256 * 128; i += NGT) {
        const int n = i >> 7, k0 = (i & 127) * 8;
        float gv[16];
#pragma unroll
        for (int r = 0; r < 16; ++r) gv[r] = A.in[5][r * 256 + n];
        float s[8];
#pragma unroll
        for (int j = 0; j < 8; ++j) { const float* wr_ = A.in[3] + (size_t)(k0 + j) * INCOLS + 1536; float a = 0.f;
#pragma unroll
            for (int r = 0; r < 16; ++r) a += wr_[r] * gv[r];
            s[j] = a; }
        v4u o; o.x = pk2(s[0], s[1]); o.y = pk2(s[2], s[3]); o.z = pk2(s[4], s[5]); o.w = pk2(s[6], s[7]);
        *(GAS v4u*)(F_W1T + (size_t)(3072 + n) * 1024 + k0) = o;
    }
    for (int m = 4 * gw; m < M; m += 4 * NGW) rms_rows_to_bf16<4>(F.lane, A.in[0] + (size_t)m * DM, DM, A.in[2], F_BUFA + (size_t)m * DM, DM);
    for (int m = gw; m < MM; m += NGW) rms_row_to_bf16(F.lane, A.in[1] + (size_t)m * DM, A.in[11], F_MN + (size_t)m * DM);
}
template <int R> DI void quant_rows_i8(int lane, const float* src, unsigned char* dst, float* scale_out) {
    f32x4 v[R][4];
#pragma unroll
    for (int r = 0; r < R; ++r)
#pragma unroll
        for (int j = 0; j < 4; ++j) v[r][j] = *(const GAS f32x4*)(src + (size_t)r * 1024 + 256 * j + 4 * lane);
#pragma unroll
    for (int r = 0; r < R; ++r) { float m = 0.f;
#pragma unroll
        for (int j = 0; j < 4; ++j) m = fmaxf(m, fmaxf(fmaxf(fabsf(v[r][j].x), fabsf(v[r][j].y)), fmaxf(fabsf(v[r][j].z), fabsf(v[r][j].w))));
        m = wave_max(m);
        const float sc = m > 0.f ? m * (1.f / 127.f) : 1.f, inv = 1.f / sc;
        v4u o;
#pragma unroll
        for (int j = 0; j < 4; ++j) { const int a = (int)rintf(v[r][j].x * inv), b = (int)rintf(v[r][j].y * inv), c = (int)rintf(v[r][j].z * inv), d = (int)rintf(v[r][j].w * inv);
            o[j] = (unsigned)(a & 255) | ((unsigned)(b & 255) << 8) | ((unsigned)(c & 255) << 16) | ((unsigned)(d & 255) << 24); }
        *(GAS v4u*)(dst + (size_t)r * 1024 + 16 * lane) = o;
        if (lane == 0) scale_out[r] = sc; }
}
template <int R> DI void quant_rows_fp6(int lane, const float* src, unsigned char* dst, float* sc) {
    f32x4 t[R][4];
#pragma unroll
    for (int r = 0; r < R; ++r)
#pragma unroll
        for (int j = 0; j < 4; ++j) t[r][j] = *(const GAS f32x4*)(src + (size_t)r * 1024 + 256 * j + 4 * lane);
#pragma unroll
    for (int r = 0; r < R; ++r) { float mx = 0.f;
#pragma unroll
        for (int j = 0; j < 4; ++j) mx = fmaxf(mx, fmaxf(fmaxf(fabsf(t[r][j].x), fabsf(t[r][j].y)), fmaxf(fabsf(t[r][j].z), fabsf(t[r][j].w))));
        mx = wave_max(mx);
        const float s_ = mx > 0.f ? mx * (1.f / 7.5f) : 1.f, inv = 1.f / s_;
        unsigned long long lo = 0ull; unsigned hi = 0u;
#pragma unroll
        for (int i = 0; i < 16; ++i) { const unsigned long long c = fp6_e2m3(t[r][i >> 2][i & 3] * inv);
            if (6 * i < 64) lo |= c << (6 * i);
            if (6 * i + 6 > 64) hi |= (unsigned)(6 * i >= 64 ? c << (6 * i - 64) : c >> (64 - 6 * i)); }
        *(GAS u32x3v*)(dst + (size_t)r * 768 + 12 * lane) = (u32x3v){(unsigned)lo, (unsigned)(lo >> 32), hi};
        if (lane == 0) sc[r] = s_; }
}
DI void p0_late(Frame& F, const Args& A, int widx, int nw) {
    LAS float* scr = (LAS float*)(F.lds + F.wave * 16384);
    constexpr int I_SQ = 16 * 32, I_W2 = 16 * 64;
    for (int it = widx; it < 3 * I_SQ + I_W2; it += nw) {
        int r = it;
        if (r < I_SQ) { p0_transpose_item(A.in[9], 1024, 0, F_WOT, 0, scr, r / 32, r % 32, F.lane); continue; } r -= I_SQ;
        if (r < I_SQ) { p0_transpose_item(A.in[12], 1024, 0, F_WXQT, 0, scr, r / 32, r % 32, F.lane, A.in[10]); continue; } r -= I_SQ;
        if (r < I_SQ) { p0_transpose_item(A.in[14], 1024, 0, F_WXOT, 0, scr, r / 32, r % 32, F.lane); continue; } r -= I_SQ;
        p0_transpose_item(A.in[16], 2048, 0, F_WPQT, 0, scr, r / 64, r % 64, F.lane, A.in[15]);
    }
    for (int i = widx * 64 + F.lane; i < 32768; i += nw * 64) {
        const f32x4 a = *(const GAS f32x4*)(A.in[17] + (size_t)i * 8), b = *(const GAS f32x4*)(A.in[17] + (size_t)i * 8 + 4);
        v4u o; o.x = pk2(a.x, a.y); o.y = pk2(a.z, a.w); o.z = pk2(b.x, b.y); o.w = pk2(b.z, b.w);
        *(GAS v4u*)(F_SUBK + (size_t)i * 8) = o;
    }
    for (int m = 4 * widx; m < PEER_N; m += 4 * nw) quant_rows_i8<4>(F.lane, A.in[18] + (size_t)m * DM, F.ws + WS_U8 + (size_t)m * 1024, (float*)(F.ws + WS_SU) + m);
    for (int m = 4 * widx; m < PEER_N; m += 4 * nw) quant_rows_fp6<4>(F.lane, A.in[19] + (size_t)m * DM, F.ws + WS_V8 + (size_t)m * 768, (float*)(F.ws + WS_SV) + m);
}

DI void gla_naive_item(Frame& F, const Args& A, float* OGLA, int b, int h, int eg) {
    const int lane = F.lane, e = eg * 8 + F.wave;
    const int cq = PQ + h * 64 + lane, ck = PK + h * 64 + lane, cv = PV + h * 128 + e, cg = PGATE + h * 64 + lane;
    float wq[4], wk[4], wv[4];
#pragma unroll
    for (int k = 0; k < 4; ++k) { wq[k] = A.in[4][k * 1024 + cq]; wk[k] = A.in[4][k * 1024 + ck]; wv[k] = A.in[4][k * 1024 + cv]; }
    const float bias = A.in[6][h * 64 + lane];
    float rq0 = 0.f, rq1 = 0.f, rq2 = 0.f, rk0 = 0.f, rk1 = 0.f, rk2 = 0.f, rv0 = 0.f, rv1 = 0.f, rv2 = 0.f, S = 0.f;
    for (int t0 = 0; t0 < SEQ; t0 += 8) {
        unsigned lq[8], lk[8], lv[8], lg[8];
#pragma unroll
        for (int j = 0; j < 8; ++j) { const bf16* base = F_PROJ + (size_t)(b * SEQ + t0 + j) * N1; lq[j] = base[cq]; lk[j] = base[ck]; lv[j] = base[cv]; lg[j] = base[cg]; }
#pragma unroll
        for (int j = 0; j < 8; ++j) {
            const float xq = bf2f(lq[j]), xk = bf2f(lk[j]), xv = bf2f(lv[j]);
            const float q = silu_f(wq[0] * rq0 + wq[1] * rq1 + wq[2] * rq2 + wq[3] * xq) * 0.125f; rq0 = rq1; rq1 = rq2; rq2 = xq;
            const float k = silu_f(wk[0] * rk0 + wk[1] * rk1 + wk[2] * rk2 + wk[3] * xk); rk0 = rk1; rk1 = rk2; rk2 = xk;
            const float v = silu_f(wv[0] * rv0 + wv[1] * rv1 + wv[2] * rv2 + wv[3] * xv); rv0 = rv1; rv1 = rv2; rv2 = xv;
            const float a = __expf(log_sigmoid_f(bf2f(lg[j]) + bias) * (1.f / 16.f));
            S = a * S + k * v;
            const float o = wave_sum(q * S);
            if (lane == 0) OGLA[(size_t)(b * SEQ + t0 + j) * 512 + h * 128 + e] = o;
        }
    }
}
DI void sb_naive_item(Frame& F, float* OSB, int b, int h, int qb) {
    LAS float* Ks = (LAS float*)F.lds; LAS float* Vs = Ks + 64 * 64;
    const int tid = F.tid, t = qb * 512 + tid; const size_t row = (size_t)b * SEQ + t;
    float q[64], acc[64];
    {
        const GAS v4u* qp = (const GAS v4u*)(F_PROJ + row * N1 + PSQ + h * 64);
#pragma unroll
        for (int c = 0; c < 8; ++c) { const v4u w = qp[c]; q[8 * c + 0] = bflo(w.x) * 0.125f; q[8 * c + 1] = bfhi(w.x) * 0.125f; q[8 * c + 2] = bflo(w.y) * 0.125f; q[8 * c + 3] = bfhi(w.y) * 0.125f;
            q[8 * c + 4] = bflo(w.z) * 0.125f; q[8 * c + 5] = bfhi(w.z) * 0.125f; q[8 * c + 6] = bflo(w.w) * 0.125f; q[8 * c + 7] = bfhi(w.w) * 0.125f; }
    }
#pragma unroll
    for (int d = 0; d < 64; ++d) acc[d] = 0.f;
    float carry = 0.f;
    for (int kt = qb * 8 + 7; kt >= 0; --kt) {
        __syncthreads();
        {
            const int key = tid >> 3, ch = tid & 7; const size_t krow = (size_t)b * SEQ + kt * 64 + key;
            const v4u kw = *(const GAS v4u*)(F_PROJ + krow * N1 + PSK + h * 64 + ch * 8), vw = *(const GAS v4u*)(F_PROJ + krow * N1 + PSV + h * 64 + ch * 8);
            LAS f32x4* kd = (LAS f32x4*)(Ks + key * 64 + ch * 8); LAS f32x4* vd = (LAS f32x4*)(Vs + key * 64 + ch * 8);
            kd[0] = (f32x4){bflo(kw.x), bfhi(kw.x), bflo(kw.y), bfhi(kw.y)}; kd[1] = (f32x4){bflo(kw.z), bfhi(kw.z), bflo(kw.w), bfhi(kw.w)};
            vd[0] = (f32x4){bflo(vw.x), bfhi(vw.x), bflo(vw.y), bfhi(vw.y)}; vd[1] = (f32x4){bflo(vw.z), bfhi(vw.z), bflo(vw.w), bfhi(vw.w)};
        }
        __syncthreads();
        for (int j = 63; j >= 0; --j) {
            const int s = kt * 64 + j;
            if (s < t) {
                const LAS f32x4* kr = (const LAS f32x4*)(Ks + j * 64); const LAS f32x4* vr = (const LAS f32x4*)(Vs + j * 64);
                float z0 = 0.f, z1 = 0.f, z2 = 0.f, z3 = 0.f;
#pragma unroll
                for (int c = 0; c < 16; ++c) { const f32x4 kk = kr[c]; z0 += q[4 * c] * kk.x; z1 += q[4 * c + 1] * kk.y; z2 += q[4 * c + 2] * kk.z; z3 += q[4 * c + 3] * kk.w; }
                const float z = (z0 + z1) + (z2 + z3);
                const float lb = log_sigmoid_f(z);
                const float w = __expf(lb + carry);
                carry += lb - z;
#pragma unroll
                for (int c = 0; c < 16; ++c) { const f32x4 vv = vr[c]; acc[4 * c] += w * vv.x; acc[4 * c + 1] += w * vv.y; acc[4 * c + 2] += w * vv.z; acc[4 * c + 3] += w * vv.w; }
            }
        }
    }
    GAS f32x4* op = (GAS f32x4*)(OSB + row * 512 + h * 64);
#pragma unroll
    for (int c = 0; c < 16; ++c) op[c] = (f32x4){acc[4 * c], acc[4 * c + 1], acc[4 * c + 2], acc[4 * c + 3]};
}
typedef float f32x16 __attribute__((ext_vector_type(16)));
typedef short s16x4 __attribute__((ext_vector_type(4)));
DI s16x4 lds_tr16(const LAS unsigned char* p) { return __builtin_bit_cast(s16x4, __builtin_amdgcn_ds_read_tr16_b64_v4i16((LAS s16x4*)p)); }
DI unsigned cvtpk_bf16(float lo, float hi) { typedef float f2 __attribute__((ext_vector_type(2))); f2 v = {lo, hi}; bf16x2_t b = __builtin_convertvector(v, bf16x2_t); return __builtin_bit_cast(unsigned, b); }
constexpr float SB_C2 = 0.125f * 1.4426950408889634f;
template <bool MASKED> DI void sb_weights(f32x16& P0, f32x16& P1, float& carry, int hi, int qrel2) {
    float T[8], cs[8];
#pragma unroll
    for (int pi = 0; pi < 2; ++pi) {
        f32x16& P = pi ? P1 : P0;
#pragma unroll
        for (int g = 0; g < 4; ++g) {
            float lbv[4], l1v[4];
#pragma unroll
            for (int i = 0; i < 4; ++i) {
                const float z2 = P[4 * g + i] * SB_C2;
                const float sp = __builtin_amdgcn_logf(1.f + __builtin_amdgcn_exp2f(-fabsf(z2)));
                float lb = fminf(z2, 0.f) - sp, l1 = lb - z2;
                if (MASKED) { const bool valid = (32 * pi + 8 * g + 4 * hi + i) < qrel2; lb = valid ? lb : -INFINITY; l1 = valid ? l1 : 0.f; }
                lbv[i] = lb; l1v[i] = l1;
            }
            const float a = l1v[3], b = a + l1v[2], c = b + l1v[1];
            cs[4 * pi + g] = c + l1v[0];
            P[4 * g + 3] = lbv[3]; P[4 * g + 2] = lbv[2] + a; P[4 * g + 1] = lbv[1] + b; P[4 * g + 0] = lbv[0] + c;
        }
    }
#pragma unroll
    for (int k = 0; k < 8; ++k) { auto rr = __builtin_amdgcn_permlane32_swap(__float_as_uint(cs[k]), __float_as_uint(cs[k]), false, false); T[k] = __uint_as_float(rr[0]) + __uint_as_float(rr[1]); }
    const float m0 = hi ? 0.f : 1.f;
    float run = carry;
#pragma unroll
    for (int k = 7; k >= 0; --k) {
        const float E = run + m0 * (T[k] - cs[k]);
        f32x16& P = (k >> 2) ? P1 : P0; const int g = k & 3;
#pragma unroll
        for (int i = 0; i < 4; ++i) P[4 * g + i] = __builtin_amdgcn_exp2f(P[4 * g + i] + E);
        run += T[k];
    }
    carry = run;
}
DI void sb_unit(Frame& F, float* OSB, int b, int h, int qb) {
    const int tid = F.tid, lane = F.lane, wid = F.wave, r32 = lane & 31, hi = lane >> 5;
    const int q0 = qb * 256; const size_t rowbase = (size_t)b * SEQ;
    const bf16* Kg = F_PROJ + rowbase * N1 + PSK + h * 64;
    const bf16* Vg = F_PROJ + rowbase * N1 + PSV + h * 64;
    bf16x8 qr[4];
    { const bf16* Qw = F_PROJ + (rowbase + q0 + wid * 32 + r32) * N1 + PSQ + h * 64;
#pragma unroll
      for (int ks = 0; ks < 4; ++ks) qr[ks] = *(const GAS bf16x8*)(Qw + ks * 16 + hi * 8); }
    const bf16* ksrc = Kg + (size_t)(tid >> 3) * N1 + (tid & 7) * 8;
    const bf16* vsrc = Vg + (size_t)(16 * (wid & 3) + (lane >> 2)) * N1 + (wid >> 2) * 32 + (lane & 3) * 8;
    const int kdst = (tid & 7) * 1024 + (tid >> 3) * 16, vdst = 8192 + wid * 1024 + lane * 16;
    const int kfr = hi * 1024 + r32 * 16;
    const int vfr = 8192 + ((lane >> 4) & 1) * 32 + (lane & 3) * 8 + (4 * hi + ((lane & 15) >> 2)) * 64;
    f32x16 o0 = {}, o1 = {};
    float carry = 0.f;
    const int ktmax = (q0 >> 6) + 3;
    v4u kreg = *(const GAS v4u*)(ksrc + (size_t)ktmax * 64 * N1), vreg = *(const GAS v4u*)(vsrc + (size_t)ktmax * 64 * N1);
    __syncthreads();
    *(LAS v4u*)(F.lds + kdst) = kreg; *(LAS v4u*)(F.lds + vdst) = vreg;
    __syncthreads();
    int cur = 0;
    const int wrow0 = q0 + wid * 32;
    bool wdone = false;
    LAS unsigned* flags = (LAS unsigned*)(F.lds + 32768);
    for (int kt = ktmax; kt >= 0; --kt) {
        if (kt > 0) { kreg = *(const GAS v4u*)(ksrc + (size_t)(kt - 1) * 64 * N1); vreg = *(const GAS v4u*)(vsrc + (size_t)(kt - 1) * 64 * N1); }
        const int k0 = kt * 64;
        if (!wdone && k0 <= wrow0 + 30) {
            const LAS unsigned char* Kb = F.lds + cur * 16384;
            f32x16 P0 = {}, P1 = {};
#pragma unroll
            for (int ks = 0; ks < 4; ++ks) {
                const bf16x8 a0 = *(const LAS bf16x8*)(Kb + kfr + ks * 2048), a1 = *(const LAS bf16x8*)(Kb + kfr + ks * 2048 + 512);
                P0 = __builtin_amdgcn_mfma_f32_32x32x16_bf16(a0, qr[ks], P0, 0, 0, 0);
                P1 = __builtin_amdgcn_mfma_f32_32x32x16_bf16(a1, qr[ks], P1, 0, 0, 0);
            }
            if (k0 + 63 >= wrow0) sb_weights<true>(P0, P1, carry, hi, wrow0 + r32 - k0);
            else sb_weights<false>(P0, P1, carry, hi, 0);
#pragma unroll
            for (int s = 0; s < 4; ++s) {
                const f32x16& P = (s >> 1) ? P1 : P0; const int rb = (s & 1) * 8;
                v4u pw; pw.x = cvtpk_bf16(P[rb + 0], P[rb + 1]); pw.y = cvtpk_bf16(P[rb + 2], P[rb + 3]); pw.z = cvtpk_bf16(P[rb + 4], P[rb + 5]); pw.w = cvtpk_bf16(P[rb + 6], P[rb + 7]);
                const bf16x8 pa = __builtin_bit_cast(bf16x8, pw);
                const LAS unsigned char* vp = Kb + vfr + s * 1024;
                const s16x4 l0 = lds_tr16(vp), h0 = lds_tr16(vp + 512), l1 = lds_tr16(vp + 4096), h1 = lds_tr16(vp + 4096 + 512);
                const bf16x8 v0 = {l0[0], l0[1], l0[2], l0[3], h0[0], h0[1], h0[2], h0[3]}, v1 = {l1[0], l1[1], l1[2], l1[3], h1[0], h1[1], h1[2], h1[3]};
                o0 = __builtin_amdgcn_mfma_f32_32x32x16_bf16(pa, v0, o0, 0, 0, 0);
                o1 = __builtin_amdgcn_mfma_f32_32x32x16_bf16(pa, v1, o1, 0, 0, 0);
            }
            wdone = __all(carry < -160.f);
        }
        if (lane == 0) flags[(kt & 1) * 8 + wid] = wdone ? 1u : 0u;
        if (kt > 0) { *(LAS v4u*)(F.lds + (cur ^ 1) * 16384 + kdst) = kreg; *(LAS v4u*)(F.lds + (cur ^ 1) * 16384 + vdst) = vreg; }
        __syncthreads();
        cur ^= 1;
        { const v4u f0 = *(const LAS v4u*)(flags + (kt & 1) * 8), f1 = *(const LAS v4u*)(flags + (kt & 1) * 8 + 4);
          if ((f0.x & f0.y & f0.z & f0.w & f1.x & f1.y & f1.z & f1.w) != 0u) break; }
    }
    float* op = OSB + (rowbase + wrow0) * 512 + h * 64 + r32;
#pragma unroll
    for (int r = 0; r < 16; ++r) { const int qrow = (r & 3) + 8 * (r >> 2) + 4 * hi; op[(size_t)qrow * 512] = o0[r]; op[(size_t)qrow * 512 + 32] = o1[r]; }
}
DI void sb_wave(Frame& F, float* OSB, int b, int h, int rb) {
    const int lane = F.lane, wid = F.wave, r32 = lane & 31, hi = lane >> 5;
    const size_t rowbase = (size_t)b * SEQ; const int wrow0 = rb * 32;
    const bf16* Kg = F_PROJ + rowbase * N1 + PSK + h * 64;
    const bf16* Vg = F_PROJ + rowbase * N1 + PSV + h * 64;
    bf16x8 qr[4];
    { const bf16* Qw = F_PROJ + (rowbase + wrow0 + r32) * N1 + PSQ + h * 64;
#pragma unroll
      for (int ks = 0; ks < 4; ++ks) qr[ks] = *(const GAS bf16x8*)(Qw + ks * 16 + hi * 8); }
    LAS unsigned char* vbuf = F.lds + wid * 16384;
    const int vfr = ((lane >> 4) & 1) * 32 + (lane & 3) * 8 + (4 * hi + ((lane & 15) >> 2)) * 64;
    const unsigned ko0 = (unsigned)(r32 * N1 + hi * 8) * 2u, ko1 = ko0 + 32u * N1 * 2u;
    unsigned vo[4];
#pragma unroll
    for (int i = 0; i < 4; ++i) vo[i] = (unsigned)(((lane >> 2) + 16 * i) * N1 + (lane & 3) * 8) * 2u;
    f32x16 o0 = {}, o1 = {};
    float carry = 0.f;
    int kt = (wrow0 + 30) >> 6;
    bf16x8 kf[8]; v4u vr[8];
#define SBW_LOADK(t) do { const char* kb_ = (const char*)Kg + (size_t)(t) * 64 * N1 * 2; _Pragma("unroll") for (int ks = 0; ks < 4; ++ks) { kf[2 * ks] = *(const GAS bf16x8*)(kb_ + ko0 + ks * 32); kf[2 * ks + 1] = *(const GAS bf16x8*)(kb_ + ko1 + ks * 32); } } while (0)
#define SBW_LOADV(t) do { const char* vb_ = (const char*)Vg + (size_t)(t) * 64 * N1 * 2; _Pragma("unroll") for (int p = 0; p < 8; ++p) vr[p] = *(const GAS v4u*)(vb_ + vo[p & 3] + (p >> 2) * 64); } while (0)
    SBW_LOADK(kt); SBW_LOADV(kt);
    int cur = 0;
    for (;;) {
        const int k0 = kt * 64;
#pragma unroll
        for (int p = 0; p < 8; ++p) *(LAS v4u*)(vbuf + cur * 8192 + p * 1024 + lane * 16) = vr[p];
        f32x16 P0 = {}, P1 = {};
#pragma unroll
        for (int ks = 0; ks < 4; ++ks) { P0 = __builtin_amdgcn_mfma_f32_32x32x16_bf16(kf[2 * ks], qr[ks], P0, 0, 0, 0); P1 = __builtin_amdgcn_mfma_f32_32x32x16_bf16(kf[2 * ks + 1], qr[ks], P1, 0, 0, 0); }
        __builtin_amdgcn_sched_barrier(0);
        if (kt > 0) SBW_LOADV(kt - 1);
        __builtin_amdgcn_sched_barrier(0);
        if (k0 + 63 >= wrow0) sb_weights<true>(P0, P1, carry, hi, wrow0 + r32 - k0);
        else sb_weights<false>(P0, P1, carry, hi, 0);
        __builtin_amdgcn_sched_barrier(0);
        if (kt > 0) SBW_LOADK(kt - 1);
        __builtin_amdgcn_sched_barrier(0);
        LDS_WAIT();
#pragma unroll
        for (int s = 0; s < 4; ++s) {
            const f32x16& P = (s >> 1) ? P1 : P0; const int rbb = (s & 1) * 8;
            v4u pw; pw.x = cvtpk_bf16(P[rbb + 0], P[rbb + 1]); pw.y = cvtpk_bf16(P[rbb + 2], P[rbb + 3]); pw.z = cvtpk_bf16(P[rbb + 4], P[rbb + 5]); pw.w = cvtpk_bf16(P[rbb + 6], P[rbb + 7]);
            const bf16x8 pa = __builtin_bit_cast(bf16x8, pw);
            const LAS unsigned char* vq = vbuf + cur * 8192 + vfr + s * 1024;
            const s16x4 l0 = lds_tr16(vq), h0 = lds_tr16(vq + 512), l1 = lds_tr16(vq + 4096), h1 = lds_tr16(vq + 4096 + 512);
            const bf16x8 v0 = {l0[0], l0[1], l0[2], l0[3], h0[0], h0[1], h0[2], h0[3]}, v1 = {l1[0], l1[1], l1[2], l1[3], h1[0], h1[1], h1[2], h1[3]};
            o0 = __builtin_amdgcn_mfma_f32_32x32x16_bf16(pa, v0, o0, 0, 0, 0);
            o1 = __builtin_amdgcn_mfma_f32_32x32x16_bf16(pa, v1, o1, 0, 0, 0);
        }
        if (kt == 0 || __all(carry < -160.f)) break;
        --kt; cur ^= 1;
    }
#undef SBW_LOADK
#undef SBW_LOADV
    {
        char* ub = (char*)(OSB + (rowbase + wrow0) * 512 + h * 64); const unsigned lo_ = (unsigned)(4 * hi * 512 + r32) * 4u;
#pragma unroll
        for (int r = 0; r < 16; ++r) { char* rp = ub + ((r & 3) + 8 * (r >> 2)) * 2048; *(GAS float*)(rp + lo_) = o0[r]; *(GAS float*)(rp + lo_ + 128) = o1[r]; }
    }
    LDS_WAIT();
}
constexpr int GL_CS = 1040;
constexpr int GL_QT = 0, GL_KT = 8320, GL_KD = 16384, GL_V = 28672, GL_ST = 49152, GL_SEG = 69632, GL_RED = 71680, GL_KDP = 192, GL_VP = 320;
constexpr int CW_DECAY = 65536;
template <bool ACC> DI bf16x8 tr_frag(const LAS unsigned char* base, int PB, int x0, int k0, int lane) {
    const int hi = lane >> 5, rr = (lane & 15) >> 2, col = x0 + 16 * ((lane >> 4) & 1) + 4 * (lane & 3);
    const int r0 = ACC ? (k0 + 4 * hi + rr) : (k0 + 8 * hi + rr), r1 = ACC ? (r0 + 8) : (r0 + 4);
    const s16x4 a = lds_tr16(base + r0 * PB + col * 2), b = lds_tr16(base + r1 * PB + col * 2);
    return (bf16x8){a[0], a[1], a[2], a[3], b[0], b[1], b[2], b[3]};
}
constexpr int GL_RQ = 73728, GL_RK = 82432, GL_RG = 91136, GL_RV = 99328;
DI void gla_stage_load(Frame& F, int b, int h, int n, v4u (&w)[6]) {
    const int tid = F.tid; const size_t row0 = (size_t)b * SEQ + 64 * n;
#pragma unroll
    for (int i = 0; i < 6; ++i) {
        const int c = tid + 512 * i;
        const int reg = (c >= 536) + (c >= 1072) + (c >= 1584);
        const int cc = c - (reg == 1 ? 536 : reg == 2 ? 1072 : reg == 3 ? 1584 : 0);
        const int rr = reg == 3 ? (cc >> 4) : (cc >> 3), ch = reg == 3 ? (cc & 15) : (cc & 7);
        const int r = rr + (reg == 2 ? 3 : 0);
        const int col = (reg == 0 ? PQ + h * 64 : reg == 1 ? PK + h * 64 : reg == 2 ? PGATE + h * 64 : PV + h * 128) + ch * 8;
        const bool ok = (c < 2656) && (64 * n - 3 + r >= 0);
        w[i] = (v4u){0u, 0u, 0u, 0u};
        if (ok) w[i] = *(const GAS v4u*)(F_PROJ + (row0 - 3 + r) * N1 + col);
    }
}
template <int MODE> DI void gla_prep(Frame& F, const Args& A, int b, int h, int n, const v4u (&w)[6]) {
    const int tid = F.tid, d = tid & 63, seg = tid >> 6;
    const float* cw = A.in[4];
    float wq[4], wk[4], wv[4];
#pragma unroll
    for (int k = 0; k < 4; ++k) { wq[k] = cw[k * 1024 + PQ + h * 64 + d]; wk[k] = cw[k * 1024 + PK + h * 64 + d]; wv[k] = cw[k * 1024 + PV + h * 128 + (tid & 127)]; }
    const float bias = A.in[6][h * 64 + d];
#pragma unroll
    for (int i = 0; i < 6; ++i) {
        const int c = tid + 512 * i;
        const int reg = (c >= 536) + (c >= 1072) + (c >= 1584);
        const int cc = c - (reg == 1 ? 536 : reg == 2 ? 1072 : reg == 3 ? 1584 : 0);
        const int rr = reg == 3 ? (cc >> 4) : (cc >> 3), ch = reg == 3 ? (cc & 15) : (cc & 7);
        const int lo_ = (reg == 0 ? GL_RQ : reg == 1 ? GL_RK : reg == 2 ? GL_RG : GL_RV) + rr * (reg == 3 ? 256 : 128) + ch * 16;
        if (c < 2656) *(LAS v4u*)(F.lds + lo_) = w[i];
    }
    __syncthreads();
    {
        float rq[11], rk[11], gl[8];
#pragma unroll
        for (int i = 0; i < 11; ++i) { rq[i] = bf2f(*(const LAS bf16*)(F.lds + GL_RQ + (8 * seg + i) * 128 + d * 2)); rk[i] = bf2f(*(const LAS bf16*)(F.lds + GL_RK + (8 * seg + i) * 128 + d * 2)); }
#pragma unroll
        for (int j = 0; j < 8; ++j) gl[j] = log_sigmoid_f(bf2f(*(const LAS bf16*)(F.lds + GL_RG + (8 * seg + j) * 128 + d * 2)) + bias) * (1.f / 16.f);
        float c = 0.f;
#pragma unroll
        for (int j = 0; j < 8; ++j) { c += gl[j]; gl[j] = c; }
        LAS float* SEG = (LAS float*)(F.lds + GL_SEG);
        SEG[seg * 64 + d] = c;
        __syncthreads();
        float pre = 0.f, tot = 0.f;
#pragma unroll
        for (int s = 0; s < 8; ++s) { const float v = SEG[s * 64 + d]; pre += (s < seg) ? v : 0.f; tot += v; }
#pragma unroll
        for (int j = 0; j < 8; ++j) {
            const int tok = 8 * seg + j; const float cum = pre + gl[j];
            const float qc = silu_f(wq[0] * rq[j] + wq[1] * rq[j + 1] + wq[2] * rq[j + 2] + wq[3] * rq[j + 3]);
            const float kc = silu_f(wk[0] * rk[j] + wk[1] * rk[j + 1] + wk[2] * rk[j + 2] + wk[3] * rk[j + 3]);
            if (MODE == 0) { *(LAS bf16*)(F.lds + GL_KD + tok * GL_KDP + d * 2) = (bf16)f2bf(kc * __expf(tot - cum)); }
            else { const int off = (d >> 3) * GL_CS + tok * 16 + (d & 7) * 2;
                *(LAS bf16*)(F.lds + GL_QT + off) = (bf16)f2bf(qc * 0.125f * __expf(cum)); *(LAS bf16*)(F.lds + GL_KT + off) = (bf16)f2bf(kc * __expf(-cum)); }
        }
        if (MODE == 0 && seg == 0) ((float*)(F.ctl + CW_DECAY))[((size_t)(b * 4 + h) * 32 + n) * 64 + d] = __expf(tot);
    }
    {
        const int e = tid & 127, s4 = tid >> 7;
        float rv[19];
#pragma unroll
        for (int i = 0; i < 19; ++i) rv[i] = bf2f(*(const LAS bf16*)(F.lds + GL_RV + (16 * s4 + i) * 256 + e * 2));
#pragma unroll
        for (int j = 0; j < 16; ++j) *(LAS bf16*)(F.lds + GL_V + (16 * s4 + j) * GL_VP + e * 2) = (bf16)f2bf(silu_f(wv[0] * rv[j] + wv[1] * rv[j + 1] + wv[2] * rv[j + 2] + wv[3] * rv[j + 3]));
    }
}
DI void gla_local_unit(Frame& F, const Args& A, bf16* STW, int b, int h, int n, v4u (&w)[6], int nb, int nh, int nn) {
    __syncthreads();
    gla_prep<0>(F, A, b, h, n, w);
    gla_stage_load(F, nb, nh, nn, w);
    __syncthreads();
    const int lane = F.lane, wid = F.wave, dt = wid & 1, et = wid >> 1, r32 = lane & 31, hi = lane >> 5;
    f32x16 acc = {};
#pragma unroll
    for (int ks = 0; ks < 4; ++ks) {
        const bf16x8 af = tr_frag<false>(F.lds + GL_KD, GL_KDP, 32 * dt, 16 * ks, lane), bfr = tr_frag<false>(F.lds + GL_V, GL_VP, 32 * et, 16 * ks, lane);
        acc = __builtin_amdgcn_mfma_f32_32x32x16_bf16(af, bfr, acc, 0, 0, 0);
    }
    bf16* o = STW + (((size_t)(b * 4 + h) * 32 + n) * 64 + 32 * dt) * 128 + 32 * et + r32;
#pragma unroll
    for (int r = 0; r < 16; ++r) o[(size_t)((r & 3) + 8 * (r >> 2) + 4 * hi) * 128] = (bf16)f2bf(acc[r]);
}
DI void gla_out_unit(Frame& F, const Args& A, const bf16* STW, int b, int h, int n, v4u (&w)[6], int nb, int nh, int nn) {
    v4u stv[2];
    { const bf16* sp = STW + ((size_t)(b * 4 + h) * 32 + n) * 64 * 128;
#pragma unroll
      for (int i = 0; i < 2; ++i) stv[i] = *(const GAS v4u*)(sp + (F.tid + i * 512) * 8); }
    __syncthreads();
    gla_prep<1>(F, A, b, h, n, w);
    gla_stage_load(F, nb, nh, nn, w);
#pragma unroll
    for (int i = 0; i < 2; ++i) { const int idx = (F.tid + i * 512) * 8, dd = idx >> 7, ee = idx & 127;
        *(LAS v4u*)(F.lds + GL_ST + dd * GL_VP + ee * 2) = stv[i]; }
    __syncthreads();
    const int lane = F.lane, wid = F.wave, it = wid & 1, et = wid >> 1, r32 = lane & 31, hi = lane >> 5;
    f32x16 acc = {};
    bf16x8 qf[4];
#pragma unroll
    for (int ks = 0; ks < 4; ++ks) qf[ks] = *(const LAS bf16x8*)(F.lds + GL_QT + (2 * ks + hi) * GL_CS + (32 * it + r32) * 16);
#pragma unroll
    for (int ks = 0; ks < 4; ++ks) acc = __builtin_amdgcn_mfma_f32_32x32x16_bf16(tr_frag<false>(F.lds + GL_ST, GL_VP, 32 * et, 16 * ks, lane), qf[ks], acc, 0, 0, 0);
    for (int jt = 0; jt <= it; ++jt) {
        f32x16 S = {};
#pragma unroll
        for (int ks = 0; ks < 4; ++ks) S = __builtin_amdgcn_mfma_f32_32x32x16_bf16(*(const LAS bf16x8*)(F.lds + GL_KT + (2 * ks + hi) * GL_CS + (32 * jt + r32) * 16), qf[ks], S, 0, 0, 0);
        if (jt == it) {
#pragma unroll
            for (int r = 0; r < 16; ++r) S[r] = ((r & 3) + 8 * (r >> 2) + 4 * hi) <= r32 ? S[r] : 0.f;
        }
#pragma unroll
        for (int s = 0; s < 2; ++s) {
            v4u pw; pw.x = cvtpk_bf16(S[8 * s + 0], S[8 * s + 1]); pw.y = cvtpk_bf16(S[8 * s + 2], S[8 * s + 3]); pw.z = cvtpk_bf16(S[8 * s + 4], S[8 * s + 5]); pw.w = cvtpk_bf16(S[8 * s + 6], S[8 * s + 7]);
            acc = __builtin_amdgcn_mfma_f32_32x32x16_bf16(tr_frag<true>(F.lds + GL_V, GL_VP, 32 * et, 32 * jt + 16 * s, lane), __builtin_bit_cast(bf16x8, pw), acc, 0, 0, 0);
        }
    }
    float ss = 0.f;
#pragma unroll
    for (int r = 0; r < 16; ++r) ss += acc[r] * acc[r];
    { auto rr = __builtin_amdgcn_permlane32_swap(__float_as_uint(ss), __float_as_uint(ss), false, false); ss = __uint_as_float(rr[0]) + __uint_as_float(rr[1]); }
    LAS float* RED = (LAS float*)(F.lds + GL_RED);
    if (hi == 0) RED[wid * 32 + r32] = ss;
    __syncthreads();
    const float tot = RED[(it + 0) * 32 + r32] + RED[(it + 2) * 32 + r32] + RED[(it + 4) * 32 + r32] + RED[(it + 6) * 32 + r32];
    const float rs = 1.f / sqrtf(tot * (1.f / 128.f) + EPS);
    const size_t row = (size_t)b * SEQ + 64 * n + 32 * it + r32;
    const float* gg = A.in[7];
#pragma unroll
    for (int g = 0; g < 4; ++g) {
        const int e0 = 32 * et + 8 * g + 4 * hi;
        const unsigned long long ogw = *(const GAS unsigned long long*)(F_PROJ + row * N1 + POG + h * 128 + e0);
        const unsigned lo = (unsigned)ogw, hi2 = (unsigned)(ogw >> 32);
        const f32x4 gv = *(const GAS f32x4*)(gg + e0);
        const float y0 = acc[4 * g + 0] * rs * gv.x * silu_f(bflo(lo)), y1 = acc[4 * g + 1] * rs * gv.y * silu_f(bfhi(lo)), y2 = acc[4 * g + 2] * rs * gv.z * silu_f(bflo(hi2)), y3 = acc[4 * g + 3] * rs * gv.w * silu_f(bfhi(hi2));
        *(GAS unsigned long long*)(F_BUFA + row * 1024 + h * 128 + e0) = (unsigned long long)pk2(y0, y1) | ((unsigned long long)pk2(y2, y3) << 32);
    }
}
DI void xattn_unit(Frame& F, const bf16* Q, bf16* O, int b, int h, int qb) {
    const int tid = F.tid, lane = F.lane, wid = F.wave, r32 = lane & 31, hi = lane >> 5;
    const bf16* Kg = F_KV + (size_t)(b * 256) * 2048 + h * 256;
    const bf16* Vg = Kg + 1024;
    const size_t row = (size_t)b * SEQ + qb * 256 + wid * 32 + r32;
    __syncthreads();
    {
        const bf16* kp = Kg + (size_t)(tid >> 5) * 2048 + (tid & 31) * 8; LAS unsigned char* kl = F.lds + (tid & 31) * 4096 + (tid >> 5) * 16;
#pragma unroll 8
        for (int i = 0; i < 16; ++i) { *(LAS v4u*)(kl) = *(const GAS v4u*)(kp); kp += 16 * 2048; kl += 256; }
    }
    bf16x8 qf[16];
#pragma unroll
    for (int ks = 0; ks < 16; ++ks) qf[ks] = *(const GAS bf16x8*)(Q + row * 1024 + h * 256 + 16 * ks + 8 * hi);
    __syncthreads();
    f32x16 S[8];
#pragma unroll
    for (int mt = 0; mt < 8; ++mt) { S[mt] = (f32x16){};
#pragma unroll
        for (int k4 = 0; k4 < 4; ++k4) {
#pragma unroll
            for (int kk = 0; kk < 4; ++kk) { const int ks = 4 * k4 + kk; S[mt] = __builtin_amdgcn_mfma_f32_32x32x16_bf16(*(const LAS bf16x8*)(F.lds + (2 * ks + hi) * 4096 + (32 * mt + r32) * 16), qf[ks], S[mt], 0, 0, 0); }
            __builtin_amdgcn_sched_barrier(0); } }
    float mx = -INFINITY;
#pragma unroll
    for (int mt = 0; mt < 8; ++mt)
#pragma unroll
        for (int r = 0; r < 16; ++r) mx = fmaxf(mx, S[mt][r]);
    { auto rr = __builtin_amdgcn_permlane32_swap(__float_as_uint(mx), __float_as_uint(mx), false, false); mx = fmaxf(__uint_as_float(rr[0]), __uint_as_float(rr[1])); }
    const float c2 = 0.0625f * 1.4426950408889634f; const float mb = mx * c2;
    float sum = 0.f;
#pragma unroll
    for (int mt = 0; mt < 8; ++mt)
#pragma unroll
        for (int r = 0; r < 16; ++r) { const float p = __builtin_amdgcn_exp2f(S[mt][r] * c2 - mb); S[mt][r] = p; sum += p; }
    { auto rr = __builtin_amdgcn_permlane32_swap(__float_as_uint(sum), __float_as_uint(sum), false, false); sum = __uint_as_float(rr[0]) + __uint_as_float(rr[1]); }
    const float linv = 1.f / sum;
    v4u pa[16];
#pragma unroll
    for (int mt = 0; mt < 8; ++mt)
#pragma unroll
        for (int s = 0; s < 2; ++s) { v4u pw; pw.x = cvtpk_bf16(S[mt][8 * s + 0] * linv, S[mt][8 * s + 1] * linv); pw.y = cvtpk_bf16(S[mt][8 * s + 2] * linv, S[mt][8 * s + 3] * linv);
            pw.z = cvtpk_bf16(S[mt][8 * s + 4] * linv, S[mt][8 * s + 5] * linv); pw.w = cvtpk_bf16(S[mt][8 * s + 6] * linv, S[mt][8 * s + 7] * linv); pa[2 * mt + s] = pw; }
    __syncthreads();
    {
        const int c = tid & 31, m0 = tid >> 5;
        const bf16* vp = Vg + (size_t)m0 * 2048 + c * 8; LAS unsigned char* vl = F.lds + (c >> 2) * 16384 + m0 * 64 + (c & 3) * 16;
#pragma unroll 8
        for (int i = 0; i < 16; ++i) { *(LAS v4u*)(vl) = *(const GAS v4u*)(vp); vp += 16 * 2048; vl += 1024; }
    }
    __syncthreads();
    const int vfr = ((lane >> 4) & 1) * 32 + (lane & 3) * 8 + (4 * hi + ((lane & 15) >> 2)) * 64;
    unsigned opk[4][16];
#pragma unroll
    for (int dp = 0; dp < 4; ++dp) {
        f32x16 a0 = {}, a1 = {};
#pragma unroll
        for (int s = 0; s < 16; ++s) {
            const LAS unsigned char* vp0 = F.lds + (2 * dp) * 16384 + s * 1024 + vfr; const LAS unsigned char* vp1 = vp0 + 16384;
            const s16x4 l0 = lds_tr16(vp0), h0 = lds_tr16(vp0 + 512), l1 = lds_tr16(vp1), h1 = lds_tr16(vp1 + 512);
            const bf16x8 v0 = {l0[0], l0[1], l0[2], l0[3], h0[0], h0[1], h0[2], h0[3]}, v1 = {l1[0], l1[1], l1[2], l1[3], h1[0], h1[1], h1[2], h1[3]};
            a0 = __builtin_amdgcn_mfma_f32_32x32x16_bf16(__builtin_bit_cast(bf16x8, pa[s]), v0, a0, 0, 0, 0);
            a1 = __builtin_amdgcn_mfma_f32_32x32x16_bf16(__builtin_bit_cast(bf16x8, pa[s]), v1, a1, 0, 0, 0);
            if ((s & 3) == 3) __builtin_amdgcn_sched_barrier(0);
        }
#pragma unroll
        for (int r = 0; r < 16; ++r) opk[dp][r] = cvtpk_bf16(a0[r], a1[r]);
        __builtin_amdgcn_sched_barrier(0);
    }
    __syncthreads();
    LAS bf16* stg = (LAS bf16*)(F.lds + wid * 16384);
#pragma unroll
    for (int dp = 0; dp < 4; ++dp)
#pragma unroll
        for (int r = 0; r < 16; ++r) { const int rr = (r & 3) + 8 * (r >> 2) + 4 * hi; stg[rr * 256 + dp * 64 + r32] = (bf16)(opk[dp][r] & 0xffffu); stg[rr * 256 + dp * 64 + 32 + r32] = (bf16)(opk[dp][r] >> 16); }
    LDS_WAIT(); asm volatile("" ::: "memory");
    bf16* Ow = O + ((size_t)b * SEQ + qb * 256 + wid * 32) * 1024 + h * 256;
    {
        bf16* op = Ow + (size_t)(lane >> 5) * 1024 + (lane & 31) * 8; const LAS bf16* sp = stg + (lane >> 5) * 256 + (lane & 31) * 8;
#pragma unroll 4
        for (int i = 0; i < 16; ++i) { *(GAS v4u*)(op) = *(const LAS v4u*)(sp); op += 2 * 1024; sp += 2 * 256; }
    }
    LDS_WAIT(); asm volatile("" ::: "memory");
}
DI void mix_row(Frame& F, const Args& A, const float* OGLA, const float* OSB, size_t row) {
    const int lane = F.lane;
    const f32x4 a0 = *(const GAS f32x4*)(OGLA + row * 512 + 8 * lane), a1 = *(const GAS f32x4*)(OGLA + row * 512 + 8 * lane + 4);
    float s = (a0.x * a0.x + a0.y * a0.y) + (a0.z * a0.z + a0.w * a0.w) + (a1.x * a1.x + a1.y * a1.y) + (a1.z * a1.z + a1.w * a1.w);
    s += __shfl_xor(s, 1); s += __shfl_xor(s, 2); s += __shfl_xor(s, 4); s += __shfl_xor(s, 8);
    const float rs = 1.f / sqrtf(s * (1.f / 128.f) + EPS);
    const int e0 = (8 * lane) & 127;
    const f32x4 g0 = *(const GAS f32x4*)(A.in[7] + e0), g1 = *(const GAS f32x4*)(A.in[7] + e0 + 4);
    const v4u ogw = *(const GAS v4u*)(F_PROJ + row * N1 + POG + 8 * lane);
    v4u o;
    o.x = pk2(a0.x * rs * g0.x * silu_f(bflo(ogw.x)), a0.y * rs * g0.y * silu_f(bfhi(ogw.x)));
    o.y = pk2(a0.z * rs * g0.z * silu_f(bflo(ogw.y)), a0.w * rs * g0.w * silu_f(bfhi(ogw.y)));
    o.z = pk2(a1.x * rs * g1.x * silu_f(bflo(ogw.z)), a1.y * rs * g1.y * silu_f(bfhi(ogw.z)));
    o.w = pk2(a1.z * rs * g1.z * silu_f(bflo(ogw.w)), a1.w * rs * g1.w * silu_f(bfhi(ogw.w)));
    *(GAS v4u*)(F_BUFA + row * 1024 + 8 * lane) = o;
    const f32x4 b0 = *(const GAS f32x4*)(OSB + row * 512 + 8 * lane), b1 = *(const GAS f32x4*)(OSB + row * 512 + 8 * lane + 4);
    float s2 = (b0.x * b0.x + b0.y * b0.y) + (b0.z * b0.z + b0.w * b0.w) + (b1.x * b1.x + b1.y * b1.y) + (b1.z * b1.z + b1.w * b1.w);
    const float rs2 = 1.f / sqrtf(wave_sum(s2) * (1.f / 512.f) + EPS);
    const f32x4 h0 = *(const GAS f32x4*)(A.in[8] + 8 * lane), h1 = *(const GAS f32x4*)(A.in[8] + 8 * lane + 4);
    v4u p;
    p.x = pk2(b0.x * rs2 * h0.x, b0.y * rs2 * h0.y); p.y = pk2(b0.z * rs2 * h0.z, b0.w * rs2 * h0.w);
    p.z = pk2(b1.x * rs2 * h1.x, b1.y * rs2 * h1.y); p.w = pk2(b1.z * rs2 * h1.z, b1.w * rs2 * h1.w);
    *(GAS v4u*)(F_BUFA + row * 1024 + 512 + 8 * lane) = p;
}
template <int R> DI void mix_rows_sb(Frame& F, const Args& A, const float* OSB, size_t row) {
    const int lane = F.lane;
    f32x4 b0[R], b1[R];
#pragma unroll
    for (int r = 0; r < R; ++r) { b0[r] = *(const GAS f32x4*)(OSB + (row + r) * 512 + 8 * lane); b1[r] = *(const GAS f32x4*)(OSB + (row + r) * 512 + 8 * lane + 4); }
    const f32x4 h0 = *(const GAS f32x4*)(A.in[8] + 8 * lane), h1 = *(const GAS f32x4*)(A.in[8] + 8 * lane + 4);
#pragma unroll
    for (int r = 0; r < R; ++r) {
        const float s2 = (b0[r].x * b0[r].x + b0[r].y * b0[r].y) + (b0[r].z * b0[r].z + b0[r].w * b0[r].w) + (b1[r].x * b1[r].x + b1[r].y * b1[r].y) + (b1[r].z * b1[r].z + b1[r].w * b1[r].w);
        const float rs2 = 1.f / sqrtf(wave_sum(s2) * (1.f / 512.f) + EPS);
        v4u p;
        p.x = pk2(b0[r].x * rs2 * h0.x, b0[r].y * rs2 * h0.y); p.y = pk2(b0[r].z * rs2 * h0.z, b0[r].w * rs2 * h0.w);
        p.z = pk2(b1[r].x * rs2 * h1.x, b1[r].y * rs2 * h1.y); p.w = pk2(b1[r].z * rs2 * h1.z, b1[r].w * rs2 * h1.w);
        *(GAS v4u*)(F_BUFA + (row + r) * 1024 + 512 + 8 * lane) = p; }
}
DI void gla_scan(Frame& F, bf16* STW) {
    const int gt = (F.vcu * NWAVES + F.wave) * 64 + F.lane, NGT = F.G * NWAVES * 64;
    const float* dec = (const float*)(F.ctl + CW_DECAY);
    for (int idx = gt; idx < 32 * 4096; idx += NGT) {
        const int bh = idx >> 12, de = (idx & 4095) * 2, d = de >> 7;
        unsigned* p = (unsigned*)(STW + (size_t)bh * 32 * 8192 + de); const float* dp = dec + (size_t)bh * 32 * 64 + d;
        unsigned tmp[32]; float dc[32];
#pragma unroll
        for (int n = 0; n < 32; ++n) { tmp[n] = p[(size_t)n * 4096]; dc[n] = dp[n * 64]; }
        float s0 = 0.f, s1 = 0.f;
#pragma unroll
        for (int n = 0; n < 32; ++n) { p[(size_t)n * 4096] = pk2(s0, s1); s0 = dc[n] * s0 + bflo(tmp[n]); s1 = dc[n] * s1 + bfhi(tmp[n]); }
    }
}
DI void xsoftmax_row(Frame& F, bf16* S, size_t rh) {
    unsigned long long* p = (unsigned long long*)(S + rh * 256) + F.lane;
    const unsigned long long w = *p; const unsigned lo = (unsigned)w, hi = (unsigned)(w >> 32);
    const float sc = 0.0625f;
    float a = bflo(lo) * sc, b = bfhi(lo) * sc, c = bflo(hi) * sc, d = bfhi(hi) * sc;
    const float mx = wave_max(fmaxf(fmaxf(a, b), fmaxf(c, d)));
    a = __expf(a - mx); b = __expf(b - mx); c = __expf(c - mx); d = __expf(d - mx);
    const float inv = 1.f / wave_sum((a + b) + (c + d));
    *p = (unsigned long long)pk2(a * inv, b * inv) | ((unsigned long long)pk2(c * inv, d * inv) << 32);
}
DI float topk_round2(float& c0, float& c1) {
    const float w = wave_max(fmaxf(c0, c1));
    if (c0 == w) c0 = -INFINITY; if (c1 == w) c1 = -INFINITY;
    return w;
}
DI void peer_topk_item(Frame& F, const bf16* PQb, int* IDX, float* GATE, size_t row, int h) {
    const int lane = F.lane;
    float mylist[2];
#pragma unroll
    for (int p = 0; p < 2; ++p) {
        LAS unsigned* qs = (LAS unsigned*)(F.lds + F.wave * 1024);
        qs[lane] = *(const GAS unsigned*)(PQb + row * 2048 + (h * 2 + p) * 128 + 2 * lane);
        LDS_WAIT(); asm volatile("" ::: "memory");
        const bf16* kbase = F_SUBK + (size_t)((h * 2 + p) * 128) * 128;
        float s0 = 0.f, s1 = 0.f;
        const GAS v4u* k0p = (const GAS v4u*)(kbase + (size_t)lane * 128); const GAS v4u* k1p = (const GAS v4u*)(kbase + (size_t)(lane + 64) * 128);
#pragma unroll
        for (int c = 0; c < 16; ++c) {
            const v4u a = k0p[c], b = k1p[c];
            const v4u qq = *(const LAS v4u*)(qs + 4 * c); const unsigned q0 = qq.x, q1 = qq.y, q2 = qq.z, q3 = qq.w;
            s0 += bflo(a.x) * bflo(q0) + bfhi(a.x) * bfhi(q0) + bflo(a.y) * bflo(q1) + bfhi(a.y) * bfhi(q1) + bflo(a.z) * bflo(q2) + bfhi(a.z) * bfhi(q2) + bflo(a.w) * bflo(q3) + bfhi(a.w) * bfhi(q3);
            s1 += bflo(b.x) * bflo(q0) + bfhi(b.x) * bfhi(q0) + bflo(b.y) * bflo(q1) + bfhi(b.y) * bfhi(q1) + bflo(b.z) * bflo(q2) + bfhi(b.z) * bfhi(q2) + bflo(b.w) * bflo(q3) + bfhi(b.w) * bfhi(q3);
        }
        float c0 = __uint_as_float((__float_as_uint(s0) & ~0x7fu) | (unsigned)lane), c1 = __uint_as_float((__float_as_uint(s1) & ~0x7fu) | (unsigned)(lane + 64));
        float mine = 0.f;
#pragma unroll
        for (int r = 0; r < 16; ++r) { const float w = topk_round2(c0, c1); if (lane == r) mine = w; }
        mylist[p] = mine;
        LDS_WAIT(); asm volatile("" ::: "memory");
    }
    const float va = __uint_as_float(__float_as_uint(__shfl(mylist[0], lane >> 2)) & ~0x7fu);
    float cand[4];
#pragma unroll
    for (int j = 0; j < 4; ++j) { const int bb = 4 * (lane & 3) + j; const float vb = __uint_as_float(__float_as_uint(__shfl(mylist[1], bb)) & ~0x7fu);
        cand[j] = __uint_as_float((__float_as_uint(va + vb) & ~0xffu) | (unsigned)((lane >> 2) * 16 + bb)); }
    float best = 0.f, top = 0.f;
#pragma unroll
    for (int r = 0; r < 16; ++r) {
        const float w = wave_max(fmaxf(fmaxf(cand[0], cand[1]), fmaxf(cand[2], cand[3])));
#pragma unroll
        for (int j = 0; j < 4; ++j) if (cand[j] == w) cand[j] = -INFINITY;
        if (lane == r) best = w; if (r == 0) top = w;
    }
    const unsigned bu = __float_as_uint(best); const int ca = (bu >> 4) & 15, cb = bu & 15;
    const int i1 = (int)(__float_as_uint(__shfl(mylist[0], ca)) & 0x7fu), i2 = (int)(__float_as_uint(__shfl(mylist[1], cb)) & 0x7fu);
    const float sc = __uint_as_float(bu & ~0xffu), tp = __uint_as_float(__float_as_uint(top) & ~0xffu);
    const float ex = lane < 16 ? __expf(sc - tp) : 0.f;
    const float inv = 1.f / wave_sum(ex);
    if (lane < 16) { IDX[row * 128 + h * 16 + lane] = i1 * 128 + i2; GATE[row * 128 + h * 16 + lane] = ex * inv; }
}
DI float vmaxf(float a, float b) { float r; asm("v_max_f32_e32 %0, %1, %2" : "=v"(r) : "v"(a), "v"(b)); return r; }
DI float vminf(float a, float b) { float r; asm("v_min_f32_e32 %0, %1, %2" : "=v"(r) : "v"(a), "v"(b)); return r; }
DI void ins16(float (&L)[16], float x) {
#pragma unroll
    for (int i = 0; i < 16; ++i) { const float h = vmaxf(L[i], x); x = vminf(L[i], x); L[i] = h; }
}
DI void peer_topk_mfma(Frame& F, const bf16* PQb, int* IDX, float* GATE) {
    const int tid = F.tid, lane = F.lane, wid = F.wave, r32 = lane & 31, hi = lane >> 5, h = F.vcu & 7;
    __syncthreads();
    for (int i = tid; i < 2 * 128 * 16; i += 512) { const int p = i >> 11, key = (i >> 4) & 127, c = i & 15;
        *(LAS v4u*)(F.lds + p * 32768 + c * 2048 + key * 16) = *(const GAS v4u*)(F_SUBK + (size_t)((h * 2 + p) * 128 + key) * 128 + c * 8); }
    __syncthreads();
    LAS unsigned* scr = (LAS unsigned*)(F.lds + 65536 + wid * 8192) + lane;
    for (int g = (F.vcu >> 3) * 8 + wid; g < 512; g += (F.G >> 3) * 8) {
        const size_t token = (size_t)32 * g + r32;
        float LA[16], LB[16];
#pragma unroll
        for (int p = 0; p < 2; ++p) {
            float (&L)[16] = p ? LB : LA;
#pragma unroll
            for (int i = 0; i < 16; ++i) L[i] = -INFINITY;
            bf16x8 qf[8];
#pragma unroll
            for (int ks = 0; ks < 8; ++ks) qf[ks] = *(const GAS bf16x8*)(PQb + token * 2048 + (h * 2 + p) * 128 + 16 * ks + 8 * hi);
#pragma unroll
            for (int rt = 0; rt < 4; ++rt) {
                f32x16 S = {};
#pragma unroll
                for (int ks = 0; ks < 8; ++ks) S = __builtin_amdgcn_mfma_f32_32x32x16_bf16(*(const LAS bf16x8*)(F.lds + p * 32768 + (2 * ks + hi) * 2048 + (32 * rt + r32) * 16), qf[ks], S, 0, 0, 0);
#pragma unroll
                for (int r = 0; r < 16; ++r) { const unsigned key = (unsigned)(32 * rt + (r & 3) + 8 * (r >> 2)) + 4u * (unsigned)hi;
                    ins16(L, __uint_as_float((__float_as_uint(S[r]) & ~0x7fu) | key)); }
            }
            float PL[16];
#pragma unroll
            for (int i = 0; i < 16; ++i) { auto rr = __builtin_amdgcn_permlane32_swap(__float_as_uint(L[i]), __float_as_uint(L[i]), false, false); PL[i] = __uint_as_float(hi ? rr[0] : rr[1]); }
#pragma unroll
            for (int i = 0; i < 16; ++i) ins16(L, PL[i]);
        }
        float C[16];
#pragma unroll
        for (int i = 0; i < 16; ++i) C[i] = -INFINITY;
#pragma unroll
        for (int a = 0; a < 16; ++a) {
            const float va = __uint_as_float(__float_as_uint(LA[a]) & ~0x7fu);
#pragma unroll
            for (int b = 0; b < 16; ++b) if ((a + 1) * (b + 1) <= 16) {
                const float vb = __uint_as_float(__float_as_uint(LB[b]) & ~0x7fu);
                ins16(C, __uint_as_float((__float_as_uint(va + vb) & ~0xffu) | (unsigned)(a * 16 + b)));
            }
        }
#pragma unroll
        for (int i = 0; i < 16; ++i) { scr[i * 64] = __float_as_uint(LA[i]) & 0x7fu; scr[(16 + i) * 64] = __float_as_uint(LB[i]) & 0x7fu; }
        LDS_WAIT(); asm volatile("" ::: "memory");
        const float top = __uint_as_float(__float_as_uint(C[0]) & ~0xffu);
        float ex[16]; int ei[16]; float sum = 0.f;
#pragma unroll
        for (int r = 0; r < 16; ++r) { const unsigned cu = __float_as_uint(C[r]); ex[r] = __expf(__uint_as_float(cu & ~0xffu) - top); sum += ex[r];
            ei[r] = (int)(scr[((cu >> 4) & 15) * 64] * 128u + scr[(16 + (cu & 15)) * 64]); }
        const float inv = 1.f / sum;
        v4u io0, io1; f32x4 go0, go1;
        io0.x = hi ? ei[8] : ei[0]; io0.y = hi ? ei[9] : ei[1]; io0.z = hi ? ei[10] : ei[2]; io0.w = hi ? ei[11] : ei[3];
        io1.x = hi ? ei[12] : ei[4]; io1.y = hi ? ei[13] : ei[5]; io1.z = hi ? ei[14] : ei[6]; io1.w = hi ? ei[15] : ei[7];
        go0.x = (hi ? ex[8] : ex[0]) * inv; go0.y = (hi ? ex[9] : ex[1]) * inv; go0.z = (hi ? ex[10] : ex[2]) * inv; go0.w = (hi ? ex[11] : ex[3]) * inv;
        go1.x = (hi ? ex[12] : ex[4]) * inv; go1.y = (hi ? ex[13] : ex[5]) * inv; go1.z = (hi ? ex[14] : ex[6]) * inv; go1.w = (hi ? ex[15] : ex[7]) * inv;
        int* ip = IDX + token * 128 + h * 16 + 8 * hi; float* gp = GATE + token * 128 + h * 16 + 8 * hi;
        *(GAS v4u*)ip = io0; *(GAS v4u*)(ip + 4) = io1; *(GAS f32x4*)gp = go0; *(GAS f32x4*)(gp + 4) = go1;
        LDS_WAIT(); asm volatile("" ::: "memory");
    }
}
#define CE(a, b) do { const float h_ = vmaxf(a, b); const float l_ = vminf(a, b); a = h_; b = l_; } while (0)
DI void sort16_desc(float (&v)[16]) { const float h0 = vmaxf(v[0], v[1]); const float h1 = vmaxf(v[2], v[3]); const float h2 = vmaxf(v[4], v[5]); const float h3 = vmaxf(v[6], v[7]); const float h4 = vmaxf(v[8], v[9]); const float h5 = vmaxf(v[10], v[11]); const float h6 = vmaxf(v[12], v[13]); const float h7 = vmaxf(v[14], v[15]); v[1] = vminf(v[0], v[1]); v[3] = vminf(v[2], v[3]); v[5] = vminf(v[4], v[5]); v[7] = vminf(v[6], v[7]); v[9] = vminf(v[8], v[9]); v[11] = vminf(v[10], v[11]); v[13] = vminf(v[12], v[13]); v[15] = vminf(v[14], v[15]); v[0] = h0; v[2] = h1; v[4] = h2; v[6] = h3; v[8] = h4; v[10] = h5; v[12] = h6; v[14] = h7; const float h8 = vmaxf(v[0], v[2]); const float h9 = vmaxf(v[1], v[3]); const float h10 = vmaxf(v[4], v[6]); const float h11 = vmaxf(v[5], v[7]); const float h12 = vmaxf(v[8], v[10]); const float h13 = vmaxf(v[9], v[11]); const float h14 = vmaxf(v[12], v[14]); const float h15 = vmaxf(v[13], v[15]); v[2] = vminf(v[0], v[2]); v[3] = vminf(v[1], v[3]); v[6] = vminf(v[4], v[6]); v[7] = vminf(v[5], v[7]); v[10] = vminf(v[8], v[10]); v[11] = vminf(v[9], v[11]); v[14] = vminf(v[12], v[14]); v[15] = vminf(v[13], v[15]); v[0] = h8; v[1] = h9; v[4] = h10; v[5] = h11; v[8] = h12; v[9] = h13; v[12] = h14; v[13] = h15; const float h16 = vmaxf(v[1], v[2]); const float h17 = vmaxf(v[5], v[6]); const float h18 = vmaxf(v[0], v[4]); const float h19 = vmaxf(v[3], v[7]); const float h20 = vmaxf(v[9], v[10]); const float h21 = vmaxf(v[13], v[14]); const float h22 = vmaxf(v[8], v[12]); const float h23 = vmaxf(v[11], v[15]); v[2] = vminf(v[1], v[2]); v[6] = vminf(v[5], v[6]); v[4] = vminf(v[0], v[4]); v[7] = vminf(v[3], v[7]); v[10] = vminf(v[9], v[10]); v[14] = vminf(v[13], v[14]); v[12] = vminf(v[8], v[12]); v[15] = vminf(v[11], v[15]); v[1] = h16; v[5] = h17; v[0] = h18; v[3] = h19; v[9] = h20; v[13] = h21; v[8] = h22; v[11] = h23; const float h24 = vmaxf(v[2], v[6]); const float h25 = vmaxf(v[1], v[5]); const float h26 = vmaxf(v[10], v[14]); const float h27 = vmaxf(v[9], v[13]); const float h28 = vmaxf(v[0], v[8]); const float h29 = vmaxf(v[7], v[15]); v[6] = vminf(v[2], v[6]); v[5] = vminf(v[1], v[5]); v[14] = vminf(v[10], v[14]); v[13] = vminf(v[9], v[13]); v[8] = vminf(v[0], v[8]); v[15] = vminf(v[7], v[15]); v[2] = h24; v[1] = h25; v[10] = h26; v[9] = h27; v[0] = h28; v[7] = h29; const float h30 = vmaxf(v[2], v[4]); const float h31 = vmaxf(v[3], v[5]); const float h32 = vmaxf(v[10], v[12]); const float h33 = vmaxf(v[11], v[13]); v[4] = vminf(v[2], v[4]); v[5] = vminf(v[3], v[5]); v[12] = vminf(v[10], v[12]); v[13] = vminf(v[11], v[13]); v[2] = h30; v[3] = h31; v[10] = h32; v[11] = h33; const float h34 = vmaxf(v[1], v[2]); const float h35 = vmaxf(v[3], v[4]); const float h36 = vmaxf(v[5], v[6]); const float h37 = vmaxf(v[9], v[10]); const float h38 = vmaxf(v[11], v[12]); const float h39 = vmaxf(v[13], v[14]); v[2] = vminf(v[1], v[2]); v[4] = vminf(v[3], v[4]); v[6] = vminf(v[5], v[6]); v[10] = vminf(v[9], v[10]); v[12] = vminf(v[11], v[12]); v[14] = vminf(v[13], v[14]); v[1] = h34; v[3] = h35; v[5] = h36; v[9] = h37; v[11] = h38; v[13] = h39; const float h40 = vmaxf(v[4], v[12]); const float h41 = vmaxf(v[2], v[10]); const float h42 = vmaxf(v[6], v[14]); const float h43 = vmaxf(v[1], v[9]); const float h44 = vmaxf(v[5], v[13]); const float h45 = vmaxf(v[3], v[11]); v[12] = vminf(v[4], v[12]); v[10] = vminf(v[2], v[10]); v[14] = vminf(v[6], v[14]); v[9] = vminf(v[1], v[9]); v[13] = vminf(v[5], v[13]); v[11] = vminf(v[3], v[11]); v[4] = h40; v[2] = h41; v[6] = h42; v[1] = h43; v[5] = h44; v[3] = h45; const float h46 = vmaxf(v[4], v[8]); const float h47 = vmaxf(v[6], v[10]); const float h48 = vmaxf(v[5], v[9]); const float h49 = vmaxf(v[7], v[11]); v[8] = vminf(v[4], v[8]); v[10] = vminf(v[6], v[10]); v[9] = vminf(v[5], v[9]); v[11] = vminf(v[7], v[11]); v[4] = h46; v[6] = h47; v[5] = h48; v[7] = h49; const float h50 = vmaxf(v[2], v[4]); const float h51 = vmaxf(v[6], v[8]); const float h52 = vmaxf(v[10], v[12]); const float h53 = vmaxf(v[3], v[5]); const float h54 = vmaxf(v[7], v[9]); const float h55 = vmaxf(v[11], v[13]); v[4] = vminf(v[2], v[4]); v[8] = vminf(v[6], v[8]); v[12] = vminf(v[10], v[12]); v[5] = vminf(v[3], v[5]); v[9] = vminf(v[7], v[9]); v[13] = vminf(v[11], v[13]); v[2] = h50; v[6] = h51; v[10] = h52; v[3] = h53; v[7] = h54; v[11] = h55; const float h56 = vmaxf(v[1], v[2]); const float h57 = vmaxf(v[3], v[4]); const float h58 = vmaxf(v[5], v[6]); const float h59 = vmaxf(v[7], v[8]); const float h60 = vmaxf(v[9], v[10]); const float h61 = vmaxf(v[11], v[12]); const float h62 = vmaxf(v[13], v[14]); v[2] = vminf(v[1], v[2]); v[4] = vminf(v[3], v[4]); v[6] = vminf(v[5], v[6]); v[8] = vminf(v[7], v[8]); v[10] = vminf(v[9], v[10]); v[12] = vminf(v[11], v[12]); v[14] = vminf(v[13], v[14]); v[1] = h56; v[3] = h57; v[5] = h58; v[7] = h59; v[9] = h60; v[11] = h61; v[13] = h62; }
DI void bmerge16_desc(float (&v)[16]) { const float h0 = vmaxf(v[0], v[8]); const float h1 = vmaxf(v[1], v[9]); const float h2 = vmaxf(v[2], v[10]); const float h3 = vmaxf(v[3], v[11]); const float h4 = vmaxf(v[4], v[12]); const float h5 = vmaxf(v[5], v[13]); const float h6 = vmaxf(v[6], v[14]); const float h7 = vmaxf(v[7], v[15]); v[8] = vminf(v[0], v[8]); v[9] = vminf(v[1], v[9]); v[10] = vminf(v[2], v[10]); v[11] = vminf(v[3], v[11]); v[12] = vminf(v[4], v[12]); v[13] = vminf(v[5], v[13]); v[14] = vminf(v[6], v[14]); v[15] = vminf(v[7], v[15]); v[0] = h0; v[1] = h1; v[2] = h2; v[3] = h3; v[4] = h4; v[5] = h5; v[6] = h6; v[7] = h7; const float h8 = vmaxf(v[0], v[4]); const float h9 = vmaxf(v[1], v[5]); const float h10 = vmaxf(v[2], v[6]); const float h11 = vmaxf(v[3], v[7]); const float h12 = vmaxf(v[8], v[12]); const float h13 = vmaxf(v[9], v[13]); const float h14 = vmaxf(v[10], v[14]); const float h15 = vmaxf(v[11], v[15]); v[4] = vminf(v[0], v[4]); v[5] = vminf(v[1], v[5]); v[6] = vminf(v[2], v[6]); v[7] = vminf(v[3], v[7]); v[12] = vminf(v[8], v[12]); v[13] = vminf(v[9], v[13]); v[14] = vminf(v[10], v[14]); v[15] = vminf(v[11], v[15]); v[0] = h8; v[1] = h9; v[2] = h10; v[3] = h11; v[8] = h12; v[9] = h13; v[10] = h14; v[11] = h15; const float h16 = vmaxf(v[0], v[2]); const float h17 = vmaxf(v[1], v[3]); const float h18 = vmaxf(v[4], v[6]); const float h19 = vmaxf(v[5], v[7]); const float h20 = vmaxf(v[8], v[10]); const float h21 = vmaxf(v[9], v[11]); const float h22 = vmaxf(v[12], v[14]); const float h23 = vmaxf(v[13], v[15]); v[2] = vminf(v[0], v[2]); v[3] = vminf(v[1], v[3]); v[6] = vminf(v[4], v[6]); v[7] = vminf(v[5], v[7]); v[10] = vminf(v[8], v[10]); v[11] = vminf(v[9], v[11]); v[14] = vminf(v[12], v[14]); v[15] = vminf(v[13], v[15]); v[0] = h16; v[1] = h17; v[4] = h18; v[5] = h19; v[8] = h20; v[9] = h21; v[12] = h22; v[13] = h23; const float h24 = vmaxf(v[0], v[1]); const float h25 = vmaxf(v[2], v[3]); const float h26 = vmaxf(v[4], v[5]); const float h27 = vmaxf(v[6], v[7]); const float h28 = vmaxf(v[8], v[9]); const float h29 = vmaxf(v[10], v[11]); const float h30 = vmaxf(v[12], v[13]); const float h31 = vmaxf(v[14], v[15]); v[1] = vminf(v[0], v[1]); v[3] = vminf(v[2], v[3]); v[5] = vminf(v[4], v[5]); v[7] = vminf(v[6], v[7]); v[9] = vminf(v[8], v[9]); v[11] = vminf(v[10], v[11]); v[13] = vminf(v[12], v[13]); v[15] = vminf(v[14], v[15]); v[0] = h24; v[2] = h25; v[4] = h26; v[6] = h27; v[8] = h28; v[10] = h29; v[12] = h30; v[14] = h31; }
#undef CE
template <int NV> DI void merge_top16(float (&L)[16], const float (&N)[NV]) {
#pragma unroll
    for (int i = 16 - NV; i < 16; ++i) L[i] = vmaxf(L[i], N[15 - i]);
    bmerge16_desc(L);
}
DI float pack_cand(float s, int id) { return __uint_as_float((__float_as_uint(s) & ~0xffu) | (unsigned)(255 - id)); }
DI void peer_topk_mfma2(Frame& F, const bf16* PQb, int* IDX, float* GATE) {
    const int tid = F.tid, lane = F.lane, wid = F.wave, r32 = lane & 31, hi = lane >> 5, h = F.vcu & 7;
    __syncthreads();
    {
        v4u kw[8];
#pragma unroll
        for (int j = 0; j < 8; ++j) { const int i = tid + 512 * j, p = i >> 11, key = (i >> 4) & 127, c = i & 15; kw[j] = *(const GAS v4u*)(F_SUBK + (size_t)((h * 2 + p) * 128 + key) * 128 + c * 8); }
#pragma unroll
        for (int j = 0; j < 8; ++j) { const int i = tid + 512 * j, p = i >> 11, key = (i >> 4) & 127, c = i & 15; *(LAS v4u*)(F.lds + p * 32768 + c * 2048 + key * 16) = kw[j]; }
    }
    __syncthreads();
    LAS unsigned* scr = (LAS unsigned*)(F.lds + 65536 + wid * 8192) + lane;
    const int g0 = (F.vcu >> 3) * 8 + wid, gstep = (F.G >> 3) * 8;
    bf16x8 qf[8];
#pragma unroll
    for (int ks = 0; ks < 8; ++ks) qf[ks] = *(const GAS bf16x8*)(PQb + ((size_t)32 * g0 + r32) * 2048 + (h * 2) * 128 + 16 * ks + 8 * hi);
    for (int g = g0; g < 512; g += gstep) {
        const size_t token = (size_t)32 * g + r32;
        float LA[16], LB[16];
#pragma unroll
        for (int p = 0; p < 2; ++p) {
            float (&L)[16] = p ? LB : LA;
            f32x16 S[4];
#pragma unroll
            for (int rt = 0; rt < 4; ++rt) { S[rt] = (f32x16){};
#pragma unroll
                for (int ks = 0; ks < 8; ++ks) S[rt] = __builtin_amdgcn_mfma_f32_32x32x16_bf16(*(const LAS bf16x8*)(F.lds + p * 32768 + (2 * ks + hi) * 2048 + (32 * rt + r32) * 16), qf[ks], S[rt], 0, 0, 0); }
            __builtin_amdgcn_sched_barrier(0);
            {
                const int gn = p ? (g + gstep < 512 ? g + gstep : g) : g; const int pn = p ? 0 : 1;
#pragma unroll
                for (int ks = 0; ks < 8; ++ks) qf[ks] = *(const GAS bf16x8*)(PQb + ((size_t)32 * gn + r32) * 2048 + (h * 2 + pn) * 128 + 16 * ks + 8 * hi);
            }
            __builtin_amdgcn_sched_barrier(0);
#pragma unroll
            for (int rt = 0; rt < 4; ++rt) {
                float v[16];
#pragma unroll
                for (int r = 0; r < 16; ++r) { const unsigned key = (unsigned)(32 * rt + (r & 3) + 8 * (r >> 2)) + 4u * (unsigned)hi; v[r] = __uint_as_float((__float_as_uint(S[rt][r]) & ~0x7fu) | key); }
                sort16_desc(v);
                if (rt == 0) {
#pragma unroll
                    for (int i = 0; i < 16; ++i) L[i] = v[i];
                } else merge_top16<16>(L, v);
            }
            float PL[16];
#pragma unroll
            for (int i = 0; i < 16; ++i) { auto rr = __builtin_amdgcn_permlane32_swap(__float_as_uint(L[i]), __float_as_uint(L[i]), false, false); PL[i] = __uint_as_float(hi ? rr[0] : rr[1]); }
            merge_top16<16>(L, PL);
        }
#pragma unroll
        for (int i = 0; i < 16; ++i) { scr[i * 64] = __float_as_uint(LA[i]) & 0x7fu; scr[(16 + i) * 64] = __float_as_uint(LB[i]) & 0x7fu; }
        float VA[16], VB[16];
#pragma unroll
        for (int i = 0; i < 16; ++i) { VA[i] = __uint_as_float(__float_as_uint(LA[i]) & ~0x7fu); VB[i] = __uint_as_float(__float_as_uint(LB[i]) & ~0x7fu); }
        float C[16];
#pragma unroll
        for (int b = 0; b < 16; ++b) C[b] = pack_cand(VA[0] + VB[b], b);
        { float R[8];
#pragma unroll
          for (int b = 0; b < 8; ++b) R[b] = pack_cand(VA[1] + VB[b], 16 + b);
          merge_top16<8>(C, R); }
        { float R[5];
#pragma unroll
          for (int b = 0; b < 5; ++b) R[b] = pack_cand(VA[2] + VB[b], 32 + b);
          merge_top16<5>(C, R); }
        { float R[4];
#pragma unroll
          for (int b = 0; b < 4; ++b) R[b] = pack_cand(VA[3] + VB[b], 48 + b);
          merge_top16<4>(C, R); }
        { float R[3];
#pragma unroll
          for (int b = 0; b < 3; ++b) R[b] = pack_cand(VA[4] + VB[b], 64 + b);
          merge_top16<3>(C, R); }
        { float R[11];
#pragma unroll
          for (int i = 0; i < 11; ++i) R[i] = pack_cand(VA[5 + i] + VB[0], (5 + i) * 16);
          merge_top16<11>(C, R); }
        { float R[3];
#pragma unroll
          for (int i = 0; i < 3; ++i) R[i] = pack_cand(VA[5 + i] + VB[1], (5 + i) * 16 + 1);
          merge_top16<3>(C, R); }
        LDS_WAIT(); asm volatile("" ::: "memory");
        const float top = __uint_as_float(__float_as_uint(C[0]) & ~0xffu);
        float ex[16]; int ei[16]; float sum = 0.f;
#pragma unroll
        for (int r = 0; r < 16; ++r) { const unsigned cu = __float_as_uint(C[r]), id = 255u - (cu & 0xffu); ex[r] = __expf(__uint_as_float(cu & ~0xffu) - top); sum += ex[r];
            ei[r] = (int)(scr[(id >> 4) * 64] * 128u + scr[(16 + (id & 15)) * 64]); }
        const float inv = 1.f / sum;
        v4u io0, io1; f32x4 go0, go1;
        io0.x = hi ? ei[8] : ei[0]; io0.y = hi ? ei[9] : ei[1]; io0.z = hi ? ei[10] : ei[2]; io0.w = hi ? ei[11] : ei[3];
        io1.x = hi ? ei[12] : ei[4]; io1.y = hi ? ei[13] : ei[5]; io1.z = hi ? ei[14] : ei[6]; io1.w = hi ? ei[15] : ei[7];
        go0.x = (hi ? ex[8] : ex[0]) * inv; go0.y = (hi ? ex[9] : ex[1]) * inv; go0.z = (hi ? ex[10] : ex[2]) * inv; go0.w = (hi ? ex[11] : ex[3]) * inv;
        go1.x = (hi ? ex[12] : ex[4]) * inv; go1.y = (hi ? ex[13] : ex[5]) * inv; go1.z = (hi ? ex[14] : ex[6]) * inv; go1.w = (hi ? ex[15] : ex[7]) * inv;
        int* ip = IDX + token * 128 + h * 16 + 8 * hi; float* gp = GATE + token * 128 + h * 16 + 8 * hi;
        *(GAS v4u*)ip = io0; *(GAS v4u*)(ip + 4) = io1; *(GAS f32x4*)gp = go0; *(GAS f32x4*)(gp + 4) = go1;
        LDS_WAIT(); asm volatile("" ::: "memory");
    }
}
DI void peer_gather_row(Frame& F, const Args& A, const bf16* XN2, const int* IDX, const float* GATE, size_t row) {
    const int lane = F.lane;
    const v4u xa = *(const GAS v4u*)(XN2 + row * 1024 + 8 * lane), xb = *(const GAS v4u*)(XN2 + row * 1024 + 512 + 8 * lane);
    const int id0 = IDX[row * 128 + lane], id1 = IDX[row * 128 + 64 + lane];
    const float g0 = GATE[row * 128 + lane], g1 = GATE[row * 128 + 64 + lane];
    float acc[16];
#pragma unroll
    for (int i = 0; i < 16; ++i) acc[i] = 0.f;
#define PEER_DOT2(w, x, a) dot2_bf16((w), (x), (a))
    for (int half = 0; half < 2; ++half) {
        const int idv = half ? id1 : id0; const float gv = half ? g1 : g0;
        for (int e0 = 0; e0 < 64; e0 += 4) {
            v4u ua[4], ub[4], va[4], vb[4]; float gt[4];
#pragma unroll
            for (int j = 0; j < 4; ++j) {
                const int id = __builtin_amdgcn_readlane(idv, e0 + j); gt[j] = __uint_as_float(__builtin_amdgcn_readlane(__float_as_uint(gv), e0 + j));
                const bf16* up = F_UB + (size_t)id * 1024; const bf16* vp = F_VB + (size_t)id * 1024;
                ua[j] = *(const GAS v4u*)(up + 8 * lane); ub[j] = *(const GAS v4u*)(up + 512 + 8 * lane);
                va[j] = *(const GAS v4u*)(vp + 8 * lane); vb[j] = *(const GAS v4u*)(vp + 512 + 8 * lane);
            }
#pragma unroll
            for (int j = 0; j < 4; ++j) {
                float d0 = 0.f, d1 = 0.f;
                d0 = PEER_DOT2(ua[j].x, xa.x, d0); d1 = PEER_DOT2(ua[j].y, xa.y, d1); d0 = PEER_DOT2(ua[j].z, xa.z, d0); d1 = PEER_DOT2(ua[j].w, xa.w, d1);
                d0 = PEER_DOT2(ub[j].x, xb.x, d0); d1 = PEER_DOT2(ub[j].y, xb.y, d1); d0 = PEER_DOT2(ub[j].z, xb.z, d0); d1 = PEER_DOT2(ub[j].w, xb.w, d1);
                const float a = wave_sum(d0 + d1);
                const float cf = gt[j] * gelu_tanh_f(a);
                acc[0] += cf * bflo(va[j].x); acc[1] += cf * bfhi(va[j].x); acc[2] += cf * bflo(va[j].y); acc[3] += cf * bfhi(va[j].y);
                acc[4] += cf * bflo(va[j].z); acc[5] += cf * bfhi(va[j].z); acc[6] += cf * bflo(va[j].w); acc[7] += cf * bfhi(va[j].w);
                acc[8] += cf * bflo(vb[j].x); acc[9] += cf * bfhi(vb[j].x); acc[10] += cf * bflo(vb[j].y); acc[11] += cf * bfhi(vb[j].y);
                acc[12] += cf * bflo(vb[j].z); acc[13] += cf * bfhi(vb[j].z); acc[14] += cf * bflo(vb[j].w); acc[15] += cf * bfhi(vb[j].w);
            }
        }
    }
#undef PEER_DOT2
    float* hp = F.out + row * 1024;
    f32x4 y[4]; const int c0 = 8 * lane, c1 = 512 + 8 * lane;
    y[0] = *(const GAS f32x4*)(hp + c0); y[1] = *(const GAS f32x4*)(hp + c0 + 4); y[2] = *(const GAS f32x4*)(hp + c1); y[3] = *(const GAS f32x4*)(hp + c1 + 4);
    float ss = 0.f;
#pragma unroll
    for (int i = 0; i < 4; ++i) { y[i].x += acc[4 * i]; y[i].y += acc[4 * i + 1]; y[i].z += acc[4 * i + 2]; y[i].w += acc[4 * i + 3]; ss += (y[i].x * y[i].x + y[i].y * y[i].y) + (y[i].z * y[i].z + y[i].w * y[i].w); }
    const float rs = 1.f / sqrtf(wave_sum(ss) * (1.f / 1024.f) + EPS);
    const f32x4 g0v = *(const GAS f32x4*)(A.in[20] + c0), g1v = *(const GAS f32x4*)(A.in[20] + c0 + 4), g2v = *(const GAS f32x4*)(A.in[20] + c1), g3v = *(const GAS f32x4*)(A.in[20] + c1 + 4);
    *(GAS f32x4*)(hp + c0) = y[0] * rs * g0v; *(GAS f32x4*)(hp + c0 + 4) = y[1] * rs * g1v; *(GAS f32x4*)(hp + c1) = y[2] * rs * g2v; *(GAS f32x4*)(hp + c1 + 4) = y[3] * rs * g3v;
}
template <int TPW> DI void peer_gather_sweep(Frame& F, const Args& A, const int* IDX, const float* GATE, size_t tok0) {
    const int lane = F.lane;
    const unsigned char* U8 = F.ws + WS_U8; const unsigned char* V8 = F.ws + WS_V8; const unsigned char* X8 = F.ws + WS_X8;
    const float* SU = (const float*)(F.ws + WS_SU); const float* SX = (const float*)(F.ws + WS_SX);
    f32x2 acc[TPW][8]; v4u xq[TPW]; int idlo[TPW], idhi[TPW]; float glo[TPW], ghi[TPW], sxv[TPW];
#pragma unroll
    for (int tl = 0; tl < TPW; ++tl) {
        const size_t t = tok0 + tl;
#pragma unroll
        for (int i = 0; i < 8; ++i) acc[tl][i] = (f32x2){0.f, 0.f};
        xq[tl] = *(const GAS v4u*)(X8 + t * 1024 + 16 * lane);
        idlo[tl] = IDX[t * 128 + lane]; idhi[tl] = IDX[t * 128 + 64 + lane]; glo[tl] = GATE[t * 128 + lane]; ghi[tl] = GATE[t * 128 + 64 + lane];
        sxv[tl] = SX[t] * (1.f / 64.f);
    }
    const int l3 = lane & 3; const bool b0 = lane & 1, b1 = lane & 2;
    for (int s = 0; s < 32; ++s) {
#pragma unroll
        for (int tl = 0; tl < TPW; ++tl) {
            unsigned long long mlo = __ballot((idlo[tl] >> 9) == s), mhi = __ballot((idhi[tl] >> 9) == s);
            while (mlo | mhi) {
                int id[4]; float g[4];
#pragma unroll
                for (int j = 0; j < 4; ++j) {
                    if (mlo) { const int e = __builtin_ctzll(mlo); mlo &= mlo - 1; id[j] = __builtin_amdgcn_readlane(idlo[tl], e); g[j] = __uint_as_float(__builtin_amdgcn_readlane(__float_as_uint(glo[tl]), e)); }
                    else if (mhi) { const int e = __builtin_ctzll(mhi); mhi &= mhi - 1; id[j] = __builtin_amdgcn_readlane(idhi[tl], e); g[j] = __uint_as_float(__builtin_amdgcn_readlane(__float_as_uint(ghi[tl]), e)); }
                    else { id[j] = id[0]; g[j] = 0.f; }
                }
                v4u uu[4], vv[4]; float su[4]; int p[4];
#pragma unroll
                for (int j = 0; j < 4; ++j) { uu[j] = *(const GAS v4u*)(U8 + (size_t)id[j] * 1024 + 16 * lane); vv[j] = *(const GAS v4u*)(V8 + (size_t)id[j] * 1024 + 16 * lane); su[j] = SU[id[j]]; }
#pragma unroll
                for (int j = 0; j < 4; ++j) { int d = __builtin_amdgcn_sdot4((int)uu[j].x, (int)xq[tl].x, 0, false); d = __builtin_amdgcn_sdot4((int)uu[j].y, (int)xq[tl].y, d, false);
                    d = __builtin_amdgcn_sdot4((int)uu[j].z, (int)xq[tl].z, d, false); p[j] = __builtin_amdgcn_sdot4((int)uu[j].w, (int)xq[tl].w, d, false); }
                const int kA = b0 ? p[1] : p[0], sA = b0 ? p[0] : p[1], kB = b0 ? p[3] : p[2], sB = b0 ? p[2] : p[3];
                const int qA = kA + dpp_i<0xB1>(sA), qB = kB + dpp_i<0xB1>(sB);
                const int kk = b1 ? qB : qA, ss = b1 ? qA : qB;
                int r = kk + dpp_i<0x4E>(ss);
                r += dpp_i<0x124>(r); r += dpp_i<0x128>(r);
                r += __shfl_xor(r, 16); r += __shfl_xor(r, 32);
                const float sus = l3 == 0 ? su[0] : l3 == 1 ? su[1] : l3 == 2 ? su[2] : su[3];
                const float gs = l3 == 0 ? g[0] : l3 == 1 ? g[1] : l3 == 2 ? g[2] : g[3];
                const float a = (float)r * sus * (sxv[tl] * 64.f);
                const float cfl = gs * gelu_tanh_f(a) * (1.f / 64.f);
#pragma unroll
                for (int j = 0; j < 4; ++j) {
                    const float cf = __uint_as_float(__builtin_amdgcn_readlane(__float_as_uint(cfl), j)); const f32x2 c2 = {cf, cf};
#pragma unroll
                    for (int w = 0; w < 4; ++w) { acc[tl][2 * w] = __builtin_amdgcn_cvt_pk_f32_fp8((int)vv[j][w], false) * c2 + acc[tl][2 * w]; acc[tl][2 * w + 1] = __builtin_amdgcn_cvt_pk_f32_fp8((int)vv[j][w], true) * c2 + acc[tl][2 * w + 1]; }
                }
            }
        }
    }
#pragma unroll
    for (int tl = 0; tl < TPW; ++tl) {
        float* hp = F.out + (tok0 + tl) * 1024 + 16 * lane;
        f32x4 y[4]; float ssq = 0.f;
#pragma unroll
        for (int i = 0; i < 4; ++i) { y[i] = *(const GAS f32x4*)(hp + 4 * i); y[i].x += acc[tl][2 * i].x; y[i].y += acc[tl][2 * i].y; y[i].z += acc[tl][2 * i + 1].x; y[i].w += acc[tl][2 * i + 1].y;
            ssq += (y[i].x * y[i].x + y[i].y * y[i].y) + (y[i].z * y[i].z + y[i].w * y[i].w); }
        const float rs = 1.f / sqrtf(wave_sum(ssq) * (1.f / 1024.f) + EPS);
#pragma unroll
        for (int i = 0; i < 4; ++i) { const f32x4 gv = *(const GAS f32x4*)(A.in[20] + 16 * lane + 4 * i); *(GAS f32x4*)(hp + 4 * i) = y[i] * rs * gv; }
    }
}
constexpr int GL3_LIST = 0, GL3_X = 65536;
struct G3Buf { v4u uu[4], vv[4], xx[4]; };
template <int TPW> DI void g3_issue(G3Buf& B, v4u& E, const LAS unsigned char* list, const LAS unsigned char* xl, const unsigned char* U8, const unsigned char* V8, int b, int lane) {
    E = *(const LAS v4u*)(list + (4 * b + (lane & 3)) * 16);
#pragma unroll
    for (int j = 0; j < 4; ++j) {
        const unsigned w = (unsigned)__builtin_amdgcn_readlane((int)E.x, j); const unsigned id = w & 0xffffu, tl = w >> 16;
        B.uu[j] = *(const GAS v4u*)(U8 + (size_t)id * 1024 + 16 * lane); B.vv[j] = *(const GAS v4u*)(V8 + (size_t)id * 1024 + 16 * lane);
        B.xx[j] = *(const LAS v4u*)(xl + tl * 1024 + 16 * lane);
    }
}
template <int TPW> DI void g3_compute(f32x2 (&acc)[TPW][8], const G3Buf& B, const v4u& E, int lane) {
    int p[4];
#pragma unroll
    for (int j = 0; j < 4; ++j) { int d = __builtin_amdgcn_sdot4((int)B.uu[j].x, (int)B.xx[j].x, 0, false); d = __builtin_amdgcn_sdot4((int)B.uu[j].y, (int)B.xx[j].y, d, false);
        d = __builtin_amdgcn_sdot4((int)B.uu[j].z, (int)B.xx[j].z, d, false); p[j] = __builtin_amdgcn_sdot4((int)B.uu[j].w, (int)B.xx[j].w, d, false); }
    const bool b0 = lane & 1, b1 = lane & 2;
    const int kA = b0 ? p[1] : p[0], sA = b0 ? p[0] : p[1], kB = b0 ? p[3] : p[2], sB = b0 ? p[2] : p[3];
    const int qA = kA + dpp_i<0xB1>(sA), qB = kB + dpp_i<0xB1>(sB);
    const int kk = b1 ? qB : qA, ss = b1 ? qA : qB;
    int r = kk + dpp_i<0x4E>(ss);
    r += dpp_i<0x124>(r); r += dpp_i<0x128>(r);
    r += __shfl_xor(r, 16); r += __shfl_xor(r, 32);
    const float a = (float)r * __uint_as_float(E.z);
    const float cfl = __uint_as_float(E.y) * gelu_tanh_f(a);
#pragma unroll
    for (int j = 0; j < 4; ++j) {
        const float cf = __uint_as_float(__builtin_amdgcn_readlane(__float_as_uint(cfl), j)); const f32x2 c2 = {cf, cf};
        const unsigned tl = (unsigned)__builtin_amdgcn_readlane((int)E.x, j) >> 16;
#pragma unroll
        for (int t = 0; t < TPW; ++t) if (tl == (unsigned)t) { asm volatile("; acc case %0" :: "n"(t));
#pragma unroll
            for (int w = 0; w < 4; ++w) { acc[t][2 * w] = __builtin_amdgcn_cvt_pk_f32_fp8((int)B.vv[j][w], false) * c2 + acc[t][2 * w]; acc[t][2 * w + 1] = __builtin_amdgcn_cvt_pk_f32_fp8((int)B.vv[j][w], true) * c2 + acc[t][2 * w + 1]; }
            asm volatile("; acc case %0 end" :: "n"(t));
        }
    }
}
template <int TPW> DI void peer_gather_sweep3(Frame& F, const Args& A, const int* IDX, const float* GATE, size_t tok0) {
    const int lane = F.lane, wid = F.wave;
    const unsigned char* U8 = F.ws + WS_U8; const unsigned char* V8 = F.ws + WS_V8; const unsigned char* X8 = F.ws + WS_X8;
    const float* SU = (const float*)(F.ws + WS_SU); const float* SX = (const float*)(F.ws + WS_SX);
    LAS unsigned char* list = F.lds + GL3_LIST + wid * (TPW * 2048); LAS unsigned char* xl = F.lds + GL3_X + wid * (TPW * 1024);
    {
        int idlo[TPW], idhi[TPW]; float glo[TPW], ghi[TPW], slo[TPW], shi[TPW];
#pragma unroll
        for (int tl = 0; tl < TPW; ++tl) { const size_t t = tok0 + tl;
            *(LAS v4u*)(xl + tl * 1024 + 16 * lane) = *(const GAS v4u*)(X8 + t * 1024 + 16 * lane);
            idlo[tl] = IDX[t * 128 + lane]; idhi[tl] = IDX[t * 128 + 64 + lane]; const float sx = SX[t];
            glo[tl] = GATE[t * 128 + lane] * (1.f / 64.f); ghi[tl] = GATE[t * 128 + 64 + lane] * (1.f / 64.f);
            slo[tl] = SU[idlo[tl]] * sx; shi[tl] = SU[idhi[tl]] * sx; }
        int base = 0;
        for (int s = 0; s < 32; ++s) {
#pragma unroll
            for (int tl = 0; tl < TPW; ++tl) {
                { const bool m = (idlo[tl] >> 9) == s; const unsigned long long mk = __ballot(m); const int pos = base + (int)__builtin_amdgcn_mbcnt_hi((unsigned)(mk >> 32), __builtin_amdgcn_mbcnt_lo((unsigned)mk, 0u));
                  if (m) *(LAS v4u*)(list + pos * 16) = (v4u){(unsigned)idlo[tl] | ((unsigned)tl << 16), __float_as_uint(glo[tl]), __float_as_uint(slo[tl]), 0u};
                  base += __builtin_popcountll(mk); }
                { const bool m = (idhi[tl] >> 9) == s; const unsigned long long mk = __ballot(m); const int pos = base + (int)__builtin_amdgcn_mbcnt_hi((unsigned)(mk >> 32), __builtin_amdgcn_mbcnt_lo((unsigned)mk, 0u));
                  if (m) *(LAS v4u*)(list + pos * 16) = (v4u){(unsigned)idhi[tl] | ((unsigned)tl << 16), __float_as_uint(ghi[tl]), __float_as_uint(shi[tl]), 0u};
                  base += __builtin_popcountll(mk); }
            }
        }
    }
    LDS_WAIT(); asm volatile("" ::: "memory");
    f32x2 acc[TPW][8];
#pragma unroll
    for (int tl = 0; tl < TPW; ++tl)
#pragma unroll
        for (int i = 0; i < 8; ++i) acc[tl][i] = (f32x2){0.f, 0.f};
    constexpr int NB = TPW * 32;
    G3Buf BA, BB; v4u EA, EB;
    g3_issue<TPW>(BA, EA, list, xl, U8, V8, 0, lane);
    for (int b = 0; b < NB; b += 2) {
        g3_issue<TPW>(BB, EB, list, xl, U8, V8, b + 1, lane);
        g3_compute<TPW>(acc, BA, EA, lane);
        g3_issue<TPW>(BA, EA, list, xl, U8, V8, (b + 2 < NB) ? b + 2 : NB - 1, lane);
        g3_compute<TPW>(acc, BB, EB, lane);
    }
#pragma unroll
    for (int tl = 0; tl < TPW; ++tl) {
        float* hp = F.out + (tok0 + tl) * 1024 + 16 * lane;
        f32x4 y[4]; float ssq = 0.f;
#pragma unroll
        for (int i = 0; i < 4; ++i) { y[i] = *(const GAS f32x4*)(hp + 4 * i); y[i].x += acc[tl][2 * i].x; y[i].y += acc[tl][2 * i].y; y[i].z += acc[tl][2 * i + 1].x; y[i].w += acc[tl][2 * i + 1].y;
            ssq += (y[i].x * y[i].x + y[i].y * y[i].y) + (y[i].z * y[i].z + y[i].w * y[i].w); }
        const float rs = 1.f / sqrtf(wave_sum(ssq) * (1.f / 1024.f) + EPS);
#pragma unroll
        for (int i = 0; i < 4; ++i) { const f32x4 gv = *(const GAS f32x4*)(A.in[20] + 16 * lane + 4 * i); *(GAS f32x4*)(hp + 4 * i) = y[i] * rs * gv; }
    }
    LDS_WAIT(); asm volatile("" ::: "memory");
}
constexpr int G5_NSH = 16, G5_SHIFT = 10;
struct G5Buf { v4u uu[4], vv[4]; };
DI void g5_issue(G5Buf& B, v4u& E, const LAS unsigned char* tlist, const unsigned char* U8, const unsigned char* V8, int k, int lane) {
    E = *(const LAS v4u*)(tlist + (4 * k + (lane & 3)) * 16);
#pragma unroll
    for (int j = 0; j < 4; ++j) {
        const unsigned id = (unsigned)__builtin_amdgcn_readlane((int)E.x, j);
        B.uu[j] = *(const GAS v4u*)(U8 + (size_t)id * 1024 + 16 * lane); B.vv[j] = *(const GAS v4u*)(V8 + (size_t)id * 1024 + 16 * lane);
    }
}
DI void g5_compute(f32x2 (&acc)[8], const v4u& xx, const G5Buf& B, const v4u& E, int lane) {
    int p[4];
#pragma unroll
    for (int j = 0; j < 4; ++j) { int d = __builtin_amdgcn_sdot4((int)B.uu[j].x, (int)xx.x, 0, false); d = __builtin_amdgcn_sdot4((int)B.uu[j].y, (int)xx.y, d, false);
        d = __builtin_amdgcn_sdot4((int)B.uu[j].z, (int)xx.z, d, false); p[j] = __builtin_amdgcn_sdot4((int)B.uu[j].w, (int)xx.w, d, false); }
    const bool b0 = lane & 1, b1 = lane & 2;
    const int kA = b0 ? p[1] : p[0], sA = b0 ? p[0] : p[1], kB = b0 ? p[3] : p[2], sB = b0 ? p[2] : p[3];
    const int qA = kA + dpp_i<0xB1>(sA), qB = kB + dpp_i<0xB1>(sB);
    const int kk = b1 ? qB : qA, ss = b1 ? qA : qB;
    int r = kk + dpp_i<0x4E>(ss);
    r += dpp_i<0x124>(r); r += dpp_i<0x128>(r);
    r += __shfl_xor(r, 16); r += __shfl_xor(r, 32);
    const float a = (float)r * __uint_as_float(E.z);
    const float y = 0.7978845608028654f * (a + 0.044715f * a * a * a);
    const float th = 1.f - 2.f * __builtin_amdgcn_rcpf(1.f + __expf(2.f * y));
    const float cfl = __uint_as_float(E.y) * 0.5f * a * (1.f + th);
#pragma unroll
    for (int j = 0; j < 4; ++j) { const float cf = __uint_as_float(__builtin_amdgcn_readlane(__float_as_uint(cfl), j)); const f32x2 c2 = {cf, cf};
#pragma unroll
        for (int w = 0; w < 4; ++w) { acc[2 * w] = __builtin_amdgcn_cvt_pk_f32_fp8((int)B.vv[j][w], false) * c2 + acc[2 * w]; acc[2 * w + 1] = __builtin_amdgcn_cvt_pk_f32_fp8((int)B.vv[j][w], true) * c2 + acc[2 * w + 1]; } }
}
DI void peer_gather_sweep5(Frame& F, const Args& A, const int* IDX, const float* GATE, size_t tok0) {
    constexpr int TPW = 4;
    const int lane = F.lane, wid = F.wave;
    const unsigned char* U8 = F.ws + WS_U8; const unsigned char* V8 = F.ws + WS_V8; const unsigned char* X8 = F.ws + WS_X8;
    const float* SU = (const float*)(F.ws + WS_SU); const float* SX = (const float*)(F.ws + WS_SX);
    LAS unsigned char* list = F.lds + wid * (TPW * 2048);
    v4u xq[TPW];
#pragma unroll
    for (int tl = 0; tl < TPW; ++tl) {
        const size_t t = tok0 + tl;
        xq[tl] = *(const GAS v4u*)(X8 + t * 1024 + 16 * lane);
        const int idlo = IDX[t * 128 + lane], idhi = IDX[t * 128 + 64 + lane]; const float sx = SX[t];
        const float glo = GATE[t * 128 + lane] * (1.f / 64.f), ghi = GATE[t * 128 + 64 + lane] * (1.f / 64.f);
        const float slo = SU[idlo] * sx, shi = SU[idhi] * sx;
        LAS unsigned char* tl_list = list + tl * 2048;
        int base = 0;
        for (int s = 0; s < G5_NSH; ++s) {
            { const bool m = (idlo >> G5_SHIFT) == s; const unsigned long long mk = __ballot(m); const int pos = base + (int)__builtin_amdgcn_mbcnt_hi((unsigned)(mk >> 32), __builtin_amdgcn_mbcnt_lo((unsigned)mk, 0u));
              if (m) *(LAS v4u*)(tl_list + pos * 16) = (v4u){(unsigned)idlo, __float_as_uint(glo), __float_as_uint(slo), 0u};
              base += __builtin_popcountll(mk); }
            { const bool m = (idhi >> G5_SHIFT) == s; const unsigned long long mk = __ballot(m); const int pos = base + (int)__builtin_amdgcn_mbcnt_hi((unsigned)(mk >> 32), __builtin_amdgcn_mbcnt_lo((unsigned)mk, 0u));
              if (m) *(LAS v4u*)(tl_list + pos * 16) = (v4u){(unsigned)idhi, __float_as_uint(ghi), __float_as_uint(shi), 0u};
              base += __builtin_popcountll(mk); }
        }
    }
    LDS_WAIT(); asm volatile("" ::: "memory");
    f32x2 acc[TPW][8];
#pragma unroll
    for (int tl = 0; tl < TPW; ++tl)
#pragma unroll
        for (int i = 0; i < 8; ++i) acc[tl][i] = (f32x2){0.f, 0.f};
    G5Buf BA, BB; v4u EA, EB;
    g5_issue(BA, EA, list, U8, V8, 0, lane);
    for (int k = 0; k < 32; ++k) {
        g5_issue(BB, EB, list + 2048, U8, V8, k, lane);      g5_compute(acc[0], xq[0], BA, EA, lane);
        g5_issue(BA, EA, list + 4096, U8, V8, k, lane);      g5_compute(acc[1], xq[1], BB, EB, lane);
        g5_issue(BB, EB, list + 6144, U8, V8, k, lane);      g5_compute(acc[2], xq[2], BA, EA, lane);
        g5_issue(BA, EA, list, U8, V8, k < 31 ? k + 1 : 31, lane);   g5_compute(acc[3], xq[3], BB, EB, lane);
    }
#pragma unroll
    for (int tl = 0; tl < TPW; ++tl) {
        float* hp = F.out + (tok0 + tl) * 1024 + 16 * lane;
        f32x4 y[4]; float ssq = 0.f;
#pragma unroll
        for (int i = 0; i < 4; ++i) { y[i] = *(const GAS f32x4*)(hp + 4 * i); y[i].x += acc[tl][2 * i].x; y[i].y += acc[tl][2 * i].y; y[i].z += acc[tl][2 * i + 1].x; y[i].w += acc[tl][2 * i + 1].y;
            ssq += (y[i].x * y[i].x + y[i].y * y[i].y) + (y[i].z * y[i].z + y[i].w * y[i].w); }
        const float rs = 1.f / sqrtf(wave_sum(ssq) * (1.f / 1024.f) + EPS);
#pragma unroll
        for (int i = 0; i < 4; ++i) { const f32x4 gv = *(const GAS f32x4*)(A.in[20] + 16 * lane + 4 * i); *(GAS f32x4*)(hp + 4 * i) = y[i] * rs * gv; }
    }
    LDS_WAIT(); asm volatile("" ::: "memory");
}
constexpr int G6_NSH = 16, G6_SHIFT = 10, G6_TPW = 8;
DI void g6_issue(v4u (&R)[4], v4u& E, const LAS unsigned char* tlist, const unsigned char* TAB, int k, int lane) {
    E = *(const LAS v4u*)(tlist + (4 * k + (lane & 3)) * 16);
#pragma unroll
    for (int j = 0; j < 4; ++j) { const unsigned id = (unsigned)__builtin_amdgcn_readlane((int)E.x, j); R[j] = *(const GAS v4u*)(TAB + (size_t)id * 1024 + 16 * lane); }
}
DI void g6_dot(const v4u& xx, const v4u (&U)[4], const v4u& E, LAS unsigned char* tlist, int k, int lane) {
    int p[4];
#pragma unroll
    for (int j = 0; j < 4; ++j) { int d = __builtin_amdgcn_sdot4((int)U[j].x, (int)xx.x, 0, false); d = __builtin_amdgcn_sdot4((int)U[j].y, (int)xx.y, d, false);
        d = __builtin_amdgcn_sdot4((int)U[j].z, (int)xx.z, d, false); p[j] = __builtin_amdgcn_sdot4((int)U[j].w, (int)xx.w, d, false); }
    const bool b0 = lane & 1, b1 = lane & 2;
    const int kA = b0 ? p[1] : p[0], sA = b0 ? p[0] : p[1], kB = b0 ? p[3] : p[2], sB = b0 ? p[2] : p[3];
    const int qA = kA + dpp_i<0xB1>(sA), qB = kB + dpp_i<0xB1>(sB);
    const int kk = b1 ? qB : qA, ss = b1 ? qA : qB;
    int r = kk + dpp_i<0x4E>(ss);
    r += dpp_i<0x124>(r); r += dpp_i<0x128>(r);
    r += __shfl_xor(r, 16); r += __shfl_xor(r, 32);
    const float a = (float)r * __uint_as_float(E.z);
    const float y = 0.7978845608028654f * (a + 0.044715f * a * a * a);
    const float th = 1.f - 2.f * __builtin_amdgcn_rcpf(1.f + __expf(2.f * y));
    const float cfl = __uint_as_float(E.y) * __uint_as_float(E.w) * 0.5f * a * (1.f + th);
    if (lane < 4) *(LAS float*)(tlist + (4 * k + lane) * 16 + 4) = cfl;
}
typedef _Float16 h2_t __attribute__((ext_vector_type(2)));
typedef _Float16 h32_t __attribute__((ext_vector_type(32)));
DI void g6_issue_v(u32x3v (&R)[4], v4u& E, const LAS unsigned char* tlist, const unsigned char* TAB, int k, int lane) {
    E = *(const LAS v4u*)(tlist + (4 * k + (lane & 3)) * 16);
#pragma unroll
    for (int j = 0; j < 4; ++j) { const unsigned id = (unsigned)__builtin_amdgcn_readlane((int)E.x, j); R[j] = *(const GAS u32x3v*)(TAB + (size_t)id * 768 + 12 * lane); }
}
DI void g6_fma(h2_t (&acc)[8], const u32x3v (&V)[4], const v4u& E, int lane) {
#pragma unroll
    for (int jp = 0; jp < 2; ++jp) {
        const i32x6v pk = {(int)V[2 * jp][0], (int)V[2 * jp][1], (int)V[2 * jp][2], (int)V[2 * jp + 1][0], (int)V[2 * jp + 1][1], (int)V[2 * jp + 1][2]};
        const h32_t hv = __builtin_bit_cast(h32_t, __builtin_amdgcn_cvt_scalef32_pk32_f16_fp6(pk, 1.0f));
#pragma unroll
        for (int q = 0; q < 2; ++q) { const float cf = __uint_as_float(__builtin_amdgcn_readlane((int)E.y, 2 * jp + q)); const _Float16 ch = (_Float16)cf; const h2_t c2 = {ch, ch};
#pragma unroll
            for (int w = 0; w < 8; ++w) { const h2_t vv = {hv[16 * q + 2 * w], hv[16 * q + 2 * w + 1]}; acc[w] = __builtin_elementwise_fma(vv, c2, acc[w]); } }
    }
}
DI void peer_gather_wave6(Frame& F, const Args& A, const bf16* XN2, const float* SS2, const int* IDX, const float* GATE, size_t tok0) {
    constexpr int TPW = G6_TPW;
    const int lane = F.lane, wid = F.wave;
    const unsigned char* U8 = F.ws + WS_U8; const unsigned char* V8 = F.ws + WS_V8;
    const float* SU = (const float*)(F.ws + WS_SU); const float* SV = (const float*)(F.ws + WS_SV);
    LAS unsigned char* list = F.lds + wid * (TPW * 2048);
    v4u xq[TPW];
#pragma unroll
    for (int tl = 0; tl < TPW; ++tl) {
        const size_t t = tok0 + tl;
        float sx;
        {
            float xv[16];
#pragma unroll
            for (int j = 0; j < 4; ++j) { const unsigned long long hw = *(const GAS unsigned long long*)(XN2 + t * 1024 + 256 * j + 4 * lane); const unsigned lo_ = (unsigned)hw, hi_ = (unsigned)(hw >> 32);
                xv[4 * j] = bflo(lo_); xv[4 * j + 1] = bfhi(lo_); xv[4 * j + 2] = bflo(hi_); xv[4 * j + 3] = bfhi(hi_); }
            {
                const f32x4* sp = (const f32x4*)(SS2 + t * 16); const f32x4 a = sp[0], b = sp[1], c = sp[2], d = sp[3];
                const float tt = ((a[0] + a[1]) + (a[2] + a[3])) + ((b[0] + b[1]) + (b[2] + b[3])) + ((c[0] + c[1]) + (c[2] + c[3])) + ((d[0] + d[1]) + (d[2] + d[3]));
                const float rs = 1.0f / sqrtf(tt * (1.0f / 1024.0f) + EPS);
#pragma unroll
                for (int i = 0; i < 4; ++i) { const f32x4 gv = *(const GAS f32x4*)(A.in[15] + 256 * i + 4 * lane); xv[4 * i] *= rs * gv.x; xv[4 * i + 1] *= rs * gv.y; xv[4 * i + 2] *= rs * gv.z; xv[4 * i + 3] *= rs * gv.w; }
            }
            float mx = 0.f;
#pragma unroll
            for (int i = 0; i < 16; ++i) mx = fmaxf(mx, fabsf(xv[i]));
            mx = wave_max(mx); sx = mx > 0.f ? mx * (1.f / 127.f) : 1.f; const float inv = 1.f / sx;
#pragma unroll
            for (int i = 0; i < 4; ++i) { const int a = (int)rintf(xv[4 * i] * inv), b = (int)rintf(xv[4 * i + 1] * inv), c = (int)rintf(xv[4 * i + 2] * inv), d = (int)rintf(xv[4 * i + 3] * inv);
                xq[tl][i] = (unsigned)(a & 255) | ((unsigned)(b & 255) << 8) | ((unsigned)(c & 255) << 16) | ((unsigned)(d & 255) << 24); }
        }
        const int idlo = IDX[t * 128 + lane], idhi = IDX[t * 128 + 64 + lane];
        const float glo = GATE[t * 128 + lane], ghi = GATE[t * 128 + 64 + lane];
        const float slo = SU[idlo] * sx, shi = SU[idhi] * sx, vlo = SV[idlo], vhi = SV[idhi];
        LAS unsigned char* tl_list = list + tl * 2048;
        int base = 0;
        for (int s = 0; s < G6_NSH; ++s) {
            { const bool m = (idlo >> G6_SHIFT) == s; const unsigned long long mk = __ballot(m); const int pos = base + (int)__builtin_amdgcn_mbcnt_hi((unsigned)(mk >> 32), __builtin_amdgcn_mbcnt_lo((unsigned)mk, 0u));
              if (m) *(LAS v4u*)(tl_list + pos * 16) = (v4u){(unsigned)idlo, __float_as_uint(glo), __float_as_uint(slo), __float_as_uint(vlo)};
              base += __builtin_popcountll(mk); }
            { const bool m = (idhi >> G6_SHIFT) == s; const unsigned long long mk = __ballot(m); const int pos = base + (int)__builtin_amdgcn_mbcnt_hi((unsigned)(mk >> 32), __builtin_amdgcn_mbcnt_lo((unsigned)mk, 0u));
              if (m) *(LAS v4u*)(tl_list + pos * 16) = (v4u){(unsigned)idhi, __float_as_uint(ghi), __float_as_uint(shi), __float_as_uint(vhi)};
              base += __builtin_popcountll(mk); }
        }
    }
    LDS_WAIT(); asm volatile("" ::: "memory");
#define G6_SB __builtin_amdgcn_sched_barrier(0)
    {
        v4u RA[4], RB[4]; v4u EA, EB;
        g6_issue(RA, EA, list, U8, 0, lane);
        for (int k = 0; k < 32; ++k) {
#define G6_P1(RI, EI, tn, kn, RC, EC, tc) do { g6_issue(RI, EI, list + (tn) * 2048, U8, kn, lane); G6_SB; g6_dot(xq[tc], RC, EC, list + (tc) * 2048, k, lane); G6_SB; } while (0)
            G6_P1(RB, EB, 1, k, RA, EA, 0); G6_P1(RA, EA, 2, k, RB, EB, 1); G6_P1(RB, EB, 3, k, RA, EA, 2); G6_P1(RA, EA, 4, k, RB, EB, 3);
            G6_P1(RB, EB, 5, k, RA, EA, 4); G6_P1(RA, EA, 6, k, RB, EB, 5); G6_P1(RB, EB, 7, k, RA, EA, 6); G6_P1(RA, EA, 0, (k < 31 ? k + 1 : 31), RB, EB, 7);
#undef G6_P1
        }
    }
    LDS_WAIT(); asm volatile("" ::: "memory");
    h2_t acc[TPW][8];
#pragma unroll
    for (int tl = 0; tl < TPW; ++tl)
#pragma unroll
        for (int i = 0; i < 8; ++i) acc[tl][i] = (h2_t){(_Float16)0.f, (_Float16)0.f};
    {
        u32x3v RA[4], RB[4]; v4u EA, EB;
        g6_issue_v(RA, EA, list, V8, 0, lane);
        for (int k = 0; k < 32; ++k) {
#define G6_P2(RI, EI, tn, kn, RC, EC, tc) do { g6_issue_v(RI, EI, list + (tn) * 2048, V8, kn, lane); G6_SB; g6_fma(acc[tc], RC, EC, lane); G6_SB; } while (0)
            G6_P2(RB, EB, 1, k, RA, EA, 0); G6_P2(RA, EA, 2, k, RB, EB, 1); G6_P2(RB, EB, 3, k, RA, EA, 2); G6_P2(RA, EA, 4, k, RB, EB, 3);
            G6_P2(RB, EB, 5, k, RA, EA, 4); G6_P2(RA, EA, 6, k, RB, EB, 5); G6_P2(RB, EB, 7, k, RA, EA, 6); G6_P2(RA, EA, 0, (k < 31 ? k + 1 : 31), RB, EB, 7);
#undef G6_P2
        }
    }
#undef G6_SB
#pragma unroll
    for (int tl = 0; tl < TPW; ++tl) {
        float* hp = F.out + (tok0 + tl) * 1024 + 4 * lane;
        f32x4 y[4]; float ssq = 0.f;
#pragma unroll
        for (int i = 0; i < 4; ++i) { const unsigned long long hw = *(const GAS unsigned long long*)(XN2 + (tok0 + tl) * 1024 + 256 * i + 4 * lane); const unsigned lo_ = (unsigned)hw, hi_ = (unsigned)(hw >> 32);
            y[i] = (f32x4){bflo(lo_), bfhi(lo_), bflo(hi_), bfhi(hi_)}; }
#pragma unroll
        for (int i = 0; i < 4; ++i) { y[i].x += (float)acc[tl][2 * i].x; y[i].y += (float)acc[tl][2 * i].y; y[i].z += (float)acc[tl][2 * i + 1].x; y[i].w += (float)acc[tl][2 * i + 1].y;
            ssq += (y[i].x * y[i].x + y[i].y * y[i].y) + (y[i].z * y[i].z + y[i].w * y[i].w); }
        const float rs = 1.f / sqrtf(wave_sum(ssq) * (1.f / 1024.f) + EPS);
#pragma unroll
        for (int i = 0; i < 4; ++i) { const f32x4 gv = *(const GAS f32x4*)(A.in[20] + 256 * i + 4 * lane); *(GAS f32x4*)(hp + 256 * i) = y[i] * rs * gv; }
    }
    LDS_WAIT(); asm volatile("" ::: "memory");
}

DI void wg_self_handoff() {
    asm volatile("s_waitcnt vmcnt(0)" ::: "memory");
    __syncthreads();
    if (threadIdx.x == 0) { __builtin_amdgcn_fence(__ATOMIC_ACQUIRE, "agent"); asm volatile("s_waitcnt vmcnt(0)" ::: "memory"); }
    __syncthreads();
}
constexpr size_t WS_XBUF = 73 * MiB;
constexpr int CW_SEAM = 16384, SEAM_BANK = 8192;
__global__ void __launch_bounds__(NWAVES * 64, 2) fwd_kernel(Args args) {
    extern __shared__ __attribute__((aligned(16))) unsigned char lds[];
    Frame F;
    F.lds = (LAS unsigned char*)lds;
    F.MISC = (volatile LAS unsigned*)(F.lds + MISC_OFF);
    F.tid = threadIdx.x; F.lane = F.tid & 63; F.wave = __builtin_amdgcn_readfirstlane(F.tid >> 6);
    F.G = gridDim.x; { const int bx = blockIdx.x; F.vcu = (F.G % 8 == 0) ? (bx % 8) * (F.G / 8) + bx / 8 : bx; }
    unsigned char* ws = args.ws;
    F.ctl = (gu32*)(ws + WS_CTL);
    F.out = args.out; F.ws = ws;
    for (int u = F.tid; u < (LDS_BYTES - LDSCTL_OFF) / 4; u += NWAVES * 64) ((LAS unsigned*)(F.lds + LDSCTL_OFF))[u] = 0u;
    __syncthreads();
    XcdBarrier bar = xcd_barrier_post((unsigned*)(F.ctl + CW_BAR) + args.li * XCD_BAR_WORDS, F.MISC + 8);
    const int lo = args.ph_lo, hi = args.ph_hi;
#ifndef PH_MASK
#define PH_MASK 0xffff
#endif
#define IN(k) (((PH_MASK >> (k)) & 1) && lo <= (k) && (k) < hi)
#define SEAM(k) do { if (IN(k) && IN((k) + 1)) xcd_barrier(bar); } while (0)
    const int gw = F.vcu * NWAVES + F.wave, NGW = F.G * NWAVES;
#define STW ((bf16*)F.out)
#define OSB (F.out + (size_t)M * 512)
#define IDX ((int*)F_BUFA)
#define GATE ((float*)(F_BUFA) + (size_t)M * 128)

    if (IN(0)) { p0_prologue(F, args); __syncthreads(); p0_late(F, args, gw, NGW); } SEAM(0);
    if (IN(1)) {
        { pg8::Gemm g{F_BUFA, F_W1T, 1024, 1024, 1024}; pg8::StaticOrder S; S.init(M, N1, F.G, (int)blockIdx.x, 1024, 1024);
          pg8::EpiBf16P E{F_PROJ, N1, 1.f};
          pg8::gemm_phase<pg8::EpiBf16P, pg8::StaticOrder, true, true>(F.lds, g, S, E); }
        { pg8::Gemm g{F_MN, F_WXKVT, 1024, 1024, 1024}; const int c = (int)blockIdx.x; pg8::OneUnitOrder S{(c >= 64 && c < 128) ? c - 64 : -1, 8, 1024, 1024};
          pg8::EpiBf16P E{F_KV, 2048, 1.f};
          pg8::gemm_phase<pg8::EpiBf16P, pg8::OneUnitOrder, true, true>(F.lds, g, S, E); }
    } SEAM(1);
    if (IN(2)) {
        __syncthreads();
        for (int task = gw; task < 64 * 64; task += NGW) { const int bh = task >> 6; sb_wave(F, OSB, bh >> 3, bh & 7, 63 - (task & 63)); }
        __syncthreads();
        { v4u gw_[6]; int it = F.vcu; if (it < 1024) gla_stage_load(F, (it >> 5) >> 2, (it >> 5) & 3, it & 31, gw_);
          for (; it < 1024; it += F.G) { const int bh = it >> 5, itn = it + F.G < 1024 ? it + F.G : it, bhn = itn >> 5; gla_local_unit(F, args, STW, bh >> 2, bh & 3, it & 31, gw_, bhn >> 2, bhn & 3, itn & 31); } }
    } SEAM(2);
    if (IN(3)) { gla_scan(F, STW);
    } SEAM(3);
    if (IN(4)) {
        { v4u gw_[6]; int it = F.vcu; if (it < 1024) gla_stage_load(F, (it >> 5) >> 2, (it >> 5) & 3, it & 31, gw_);
          for (; it < 1024; it += F.G) { const int bh = it >> 5, itn = it + F.G < 1024 ? it + F.G : it, bhn = itn >> 5; gla_out_unit(F, args, STW, bh >> 2, bh & 3, it & 31, gw_, bhn >> 2, bhn & 3, itn & 31); } }
        for (int m = 4 * gw; m < M; m += 4 * NGW) mix_rows_sb<4>(F, args, OSB, (size_t)m);
    } SEAM(4);
    if (IN(5)) { pg8::Gemm g{F_BUFA, F_WOT, 1024, 1024, 1024}; pg8::StaticOrder S; S.init(M, 1024, F.G, (int)blockIdx.x, 1024, 1024);
        pg8::EpiResB<false> E{args.in[0], F_SLOT1, (float*)(ws + WS_XBUF), 1024};
        pg8::gemm_phase<pg8::EpiResB<false>, pg8::StaticOrder, true, true>(F.lds, g, S, E); } SEAM(5);
    if (IN(6)) { pg8::Gemm g{F_SLOT1, F_WXQT, 1024, 1024, 1024}; pg8::StaticOrder S; S.init(M, 1024, F.G, (int)blockIdx.x, 1024, 1024);
        pg8::EpiBf16RowScale E{F_SLOT2, 1024, (const float*)(ws + WS_XBUF), EPS};
        { const int L = (int)blockIdx.x;
            const int wgid = (L & 7) * 32 + (L >> 3), pm = (wgid >> 5) * 8 + (wgid & 7), pn = (wgid & 31) >> 3;
            pg8::OneUnitOrder S1{pm * 4 + pn, 4, 1024, 1024};
            pg8::gemm_phase<pg8::EpiBf16RowScale, pg8::OneUnitOrder, true, true>(F.lds, g, S1, E);
            wg_self_handoff();
            xattn_unit(F, F_SLOT2, F_SLOT0, pm >> 3, pn, pm & 7); }
        (void)S;
    }
    SEAM(7);
    if (IN(8)) { pg8::Gemm g{F_SLOT0, F_WXOT, 1024, 1024, 1024}; pg8::StaticOrder S; S.init(M, 1024, F.G, (int)blockIdx.x, 1024, 1024);
        pg8::EpiResB<true> E{F_SLOT1, F_SLOT2, (float*)(ws + WS_XBUF + MiB), 1024};
        pg8::gemm_phase<pg8::EpiResB<true>, pg8::StaticOrder, true, true>(F.lds, g, S, E); } SEAM(8);
    if (IN(9)) { pg8::Gemm g{F_SLOT2, F_WPQT, 1024, 1024, 1024}; pg8::StaticOrder S; S.init(M, 2048, F.G, (int)blockIdx.x, 1024, 1024);
        pg8::EpiBf16RowScale E{F_SLOT0, 2048, (const float*)(ws + WS_XBUF + MiB), EPS};
        pg8::gemm_phase<pg8::EpiBf16RowScale, pg8::StaticOrder, true, true>(F.lds, g, S, E); } SEAM(9);
    if (IN(10)) { peer_topk_mfma2(F, F_SLOT0, IDX, GATE); } SEAM(10);
    if (IN(11)) { peer_gather_wave6(F, args, F_SLOT2, (const float*)(ws + WS_XBUF + MiB), IDX, GATE, (size_t)F.vcu * 64 + F.wave * 8); }
#undef IN
#undef SEAM
}

constexpr int NPHASES = 12;
extern "C" void kernel_launch(void* const* d_in, const int* in_sizes, int n_in, void* d_out, int out_size, void* d_ws, size_t ws_size, hipStream_t stream) {
    static int grid = 0;
    if (grid == 0) {
        if (n_in != 21 || out_size != M * DM || ws_size < WS_END) { fprintf(stderr, "kernel_launch: unexpected shapes (n_in %d out %d ws %zu)\n", n_in, out_size, ws_size); grid = -1; return; }
        int dev = 0, cus = 0, per_cu = 0;
        if (hipGetDevice(&dev) != hipSuccess || hipDeviceGetAttribute(&cus, hipDeviceAttributeMultiprocessorCount, dev) != hipSuccess) { grid = -1; return; }
        if (hipFuncSetAttribute((const void*)fwd_kernel, hipFuncAttributeMaxDynamicSharedMemorySize, LDS_BYTES) != hipSuccess) { fprintf(stderr, "kernel_launch: hipFuncSetAttribute failed\n"); grid = -1; return; }
        if (hipOccupancyMaxActiveBlocksPerMultiprocessor(&per_cu, (const void*)fwd_kernel, NWAVES * 64, LDS_BYTES) != hipSuccess || per_cu < 1) { fprintf(stderr, "kernel_launch: occupancy query says %d\n", per_cu); }
        (void)hipGetLastError();
        grid = cus;
    }
    if (grid < 0) return;
    (void)hipMemsetAsync((char*)d_ws + WS_CTL, 0, CTL_ZERO_BYTES, stream);
    Args a{};
    for (int i = 0; i < 21; ++i) a.in[i] = (const float*)d_in[i];
    a.out = (float*)d_out; a.ws = (unsigned char*)d_ws;
#if defined(PROF_DUP_LO)
    a.ph_lo = 0; a.ph_hi = PROF_DUP_HI + 1; a.li = 0; hipLaunchKernelGGL(fwd_kernel, dim3(grid), dim3(NWAVES * 64), LDS_BYTES, stream, a);
    a.ph_lo = PROF_DUP_LO; a.ph_hi = NPHASES; a.li = 1; hipLaunchKernelGGL(fwd_kernel, dim3(grid), dim3(NWAVES * 64), LDS_BYTES, stream, a);
#elif defined(PROF_SPLIT)
    a.ph_lo = 0; a.ph_hi = PROF_SPLIT; a.li = 0; hipLaunchKernelGGL(fwd_kernel, dim3(grid), dim3(NWAVES * 64), LDS_BYTES, stream, a);
    a.ph_lo = PROF_SPLIT; a.ph_hi = NPHASES; a.li = 1; hipLaunchKernelGGL(fwd_kernel, dim3(grid), dim3(NWAVES * 64), LDS_BYTES, stream, a);
#else
    a.ph_lo = 0; a.ph_hi = NPHASES; a.li = 0;
    hipLaunchKernelGGL(fwd_kernel, dim3(grid), dim3(NWAVES * 64), LDS_BYTES, stream, a);
#endif
}
```

```cpp
#include <hip/hip_runtime.h>
#include <cstdio>
#include <cstdint>
namespace pg8 {
#define PG8_LAS __attribute__((address_space(3)))
typedef unsigned short bf16_t;
typedef short bf16x8 __attribute__((ext_vector_type(8)));
typedef float f32x4 __attribute__((ext_vector_type(4)));
typedef unsigned u32x4 __attribute__((ext_vector_type(4)));
constexpr int BM = 256, BK = 64, HALF = 128, HTB = HALF * BK * 2  , STAGE_BYTES = 8 * HTB, NXCD = 8, WGM = 8;

__host__ __device__ __forceinline__ int lds_byte(int r, int c) { const int st = (r >> 4) * 2 + (c >> 5), rr = r & 15, cc = c & 31, ob = rr * 64 + cc * 2; return st * 1024 + (ob ^ (((ob >> 9) & 1) << 5)); }
__host__ __device__ __forceinline__ void stage_rc(int b, int& R, int& C) { const int st = b / 1024, sb = b % 1024, swz = sb ^ (((sb >> 9) & 1) << 5); R = (st >> 1) * 16 + swz / 64; C = (st & 1) * 32 + (swz % 64) / 2; }
__host__ __device__ __forceinline__ int perm32(int rho) { const int n = rho >> 4, i = rho & 15; return 8 * (i >> 2) + 4 * n + (i & 3); }

struct Unit { int pm, pn; size_t aoff, boff; };
struct Gemm { const bf16_t* A; const bf16_t* Bt; int K, lda, ldb; };

struct StaticOrder {
    int nM, nN, nwg, G, c, lda, ldb;
    __host__ __device__ void init(int M, int N, int G_, int c_, int lda_, int ldb_) { nM = M / BM; nN = N / BM; nwg = nM * nN; G = G_; c = c_; lda = lda_; ldb = ldb_; }
    __host__ __device__ bool next(int i, Unit& u) const {
        const long L = (long)i * G + c; if (L >= nwg) return false;
        int wgid = (int)L; { const int q = nwg / NXCD, r = nwg % NXCD, xcd = wgid % NXCD, off = wgid / NXCD; wgid = (xcd < r ? xcd * (q + 1) : r * (q + 1) + (xcd - r) * q) + off; }
        const int nig = WGM * nN, gid = wgid / nig, fm = gid * WGM, gsz = (nM - fm) < WGM ? (nM - fm) : WGM;
        u.pm = fm + ((wgid % nig) % gsz); u.pn = (wgid % nig) / gsz; u.aoff = (size_t)u.pm * BM * lda * 2; u.boff = (size_t)u.pn * BM * ldb * 2; return true;
    }
    __device__ __forceinline__ void a_ready(const Unit&) const {}
    __device__ __forceinline__ void done(const Unit&) const {}
};

__device__ __forceinline__ unsigned cvt_pk_bf16(float lo, float hi) { unsigned r; asm volatile("v_cvt_pk_bf16_f32 %0, %1, %2" : "=v"(r) : "v"(lo), "v"(hi)); return r; }
typedef float f32x2 __attribute__((ext_vector_type(2)));
__device__ __forceinline__ f32x2 gelu_pk(f32x2 v) {
    const f32x2 av = __builtin_elementwise_abs(v), d = av * 0.2316418882f + 1.0f;
    f32x2 t; t.x = __builtin_amdgcn_rcpf(d.x); t.y = __builtin_amdgcn_rcpf(d.y);
    f32x2 q = t * 0.5307027145f + (-0.7265760135f); q = q * t + 0.7107068705f; q = q * t + (-0.142248368f); q = q * t + 0.127414796f; q = q * t;
    const f32x2 s = (v * v) * (-0.72134752044f);
    f32x2 e; e.x = __builtin_amdgcn_exp2f(s.x); e.y = __builtin_amdgcn_exp2f(s.y);
    const f32x2 m = v * (q * e), r = v - m;
    f32x2 o; o.x = v.x < 0.f ? m.x : r.x; o.y = v.y < 0.f ? m.y : r.y; return o;
}

template <int ACT  > struct EpiBf16 {
    static constexpr bool PERM = true, AFTER_DRAIN = false; static_assert(ACT == 0 || ACT == 1, "EpiBf16: ACT is 0 (none) or 1 (gelu_pk)");
    bf16_t* O; int ldc; const float* bias; int split_cols; size_t split_stride; float scale0;
    __device__ __forceinline__ void operator()(const f32x4 (&acc)[2][2][4][2], const Unit& u, int wr, int wc, int fr, int fq) const {
        const int row0 = u.pm * BM + wr * 64 + fr; int colt = u.pn * BM; bf16_t* base = O;
        float sc = 1.f; if (split_cols) { const int t = colt / split_cols; base += (size_t)t * split_stride; colt -= t * split_cols; if (t == 0) sc = scale0; }
        const int col0 = colt + wc * 32 + 8 * fq, bcol0 = u.pn * BM + wc * 32 + 8 * fq;
        f32x4 bv[2][2];
#pragma unroll
        for (int bj = 0; bj < 2; ++bj)
#pragma unroll
            for (int n = 0; n < 2; ++n) bv[bj][n] = bias ? *(const f32x4*)(bias + bcol0 + bj * HALF + 4 * n) : (f32x4){0.f, 0.f, 0.f, 0.f};
#pragma unroll
        for (int ai = 0; ai < 2; ++ai)
#pragma unroll
            for (int m = 0; m < 4; ++m) { bf16_t* rowp = base + (size_t)(row0 + ai * HALF + m * 16) * ldc + col0;
#pragma unroll
                for (int bj = 0; bj < 2; ++bj) { f32x4 v0 = acc[ai][bj][m][0] + bv[bj][0], v1 = acc[ai][bj][m][1] + bv[bj][1];
                    if (ACT == 1) { f32x2 a = gelu_pk((f32x2){v0[0], v0[1]}), b = gelu_pk((f32x2){v0[2], v0[3]}), c = gelu_pk((f32x2){v1[0], v1[1]}), d = gelu_pk((f32x2){v1[2], v1[3]});
                        v0 = (f32x4){a.x, a.y, b.x, b.y}; v1 = (f32x4){c.x, c.y, d.x, d.y}; }
                    v0 = v0 * sc; v1 = v1 * sc; u32x4 w; w.x = cvt_pk_bf16(v0[0], v0[1]); w.y = cvt_pk_bf16(v0[2], v0[3]); w.z = cvt_pk_bf16(v1[0], v1[1]); w.w = cvt_pk_bf16(v1[2], v1[3]);
                    *(u32x4*)(rowp + bj * HALF) = w; } }
    }
};
template <class Epi, class Sched, bool ALIGN_EPI = false, bool SP2 = false>
__device__ __forceinline__ void gemm_phase(PG8_LAS unsigned char* lds, const Gemm g, const Sched& S, const Epi& E) {
    const int tid = threadIdx.x, wid = __builtin_amdgcn_readfirstlane(tid >> 6), lane = tid & 63, wr = wid >> 2, wc = wid & 3, fr = lane & 15, fq = lane >> 4;
    int K = g.K; asm volatile("" : "+s"(K));
    const int nt = K / BK;
    unsigned voffA[2], voffB[2];
#pragma unroll
    for (int i = 0; i < 2; ++i) { int R, C; stage_rc(tid * 16 + i * 8192, R, C); const int Rb = Epi::PERM ? ((R & ~31) + perm32(R & 31)) : R;
        voffA[i] = (unsigned)(R * g.lda + C) * 2u; voffB[i] = (unsigned)(Rb * g.ldb + C) * 2u; }
    const size_t kstep = (size_t)(BK * 2);
    const size_t hA = (size_t)HALF * g.lda * 2, hB = (size_t)HALF * g.ldb * 2;
    const unsigned ldsw = (unsigned)wid * 1024u;
    const int aoff = lds_byte(wr * 64 + fr, fq * 8), boff = lds_byte(wc * 32 + fr, fq * 8);
#define PG8_SA(b, h) (((b) * 2 + (h)) * HTB)
#define PG8_SB(b, h) ((4 + (b) * 2 + (h)) * HTB)
#define PG8_STAGE(bufoff, gbase, voff) do { _Pragma("unroll") for (int _i = 0; _i < 2; ++_i) \
        __builtin_amdgcn_global_load_lds((const unsigned*)((const char*)(gbase) + (voff)[_i]), (PG8_LAS unsigned*)(lds + (bufoff) + ldsw + _i * 8192), 16, 0, 0); } while (0)
#define PG8_LDA(dst, b, h) do { _Pragma("unroll") for (int m = 0; m < 4; ++m) _Pragma("unroll") for (int k = 0; k < 2; ++k) dst[m][k] = *(const PG8_LAS bf16x8*)(lds + PG8_SA(b, h) + aoff + m * 2048 + k * 1024); } while (0)
#define PG8_LDB(dst, b, h) do { _Pragma("unroll") for (int n = 0; n < 2; ++n) _Pragma("unroll") for (int k = 0; k < 2; ++k) dst[n][k] = *(const PG8_LAS bf16x8*)(lds + PG8_SB(b, h) + boff + n * 2048 + k * 1024); } while (0)
#define PG8_MMA(ai, bj, At, Bt) do { __builtin_amdgcn_s_setprio(1); _Pragma("unroll") for (int m = 0; m < 4; ++m) _Pragma("unroll") for (int n = 0; n < 2; ++n) _Pragma("unroll") for (int k = 0; k < 2; ++k) \
        acc[ai][bj][m][n] = __builtin_amdgcn_mfma_f32_16x16x32_bf16(Bt[n][k], At[m][k], acc[ai][bj][m][n], 0, 0, 0); __builtin_amdgcn_s_setprio(0); } while (0)
#define PG8_WAIT_V(n) asm volatile("s_waitcnt vmcnt(" #n ")" ::: "memory")
#define PG8_WAIT_L(n) asm volatile("s_waitcnt lgkmcnt(" #n ")" ::: "memory")
#define PG8_BAR __builtin_amdgcn_s_barrier()
#define PG8_SCHED __builtin_amdgcn_sched_barrier(0)
    Unit cur, nxt; int ui = 0;
    if (!S.next(0, cur)) return;
    f32x4 acc[2][2][4][2];
#pragma unroll
    for (int a = 0; a < 2; ++a)
#pragma unroll
        for (int b = 0; b < 2; ++b)
#pragma unroll
            for (int m = 0; m < 4; ++m)
#pragma unroll
                for (int n = 0; n < 2; ++n) acc[a][b][m][n] = (f32x4){0.f, 0.f, 0.f, 0.f};
    bf16x8 At[4][2], B0[2][2], B1[2][2];
    const char* cA = (const char*)g.A + cur.aoff; const char* cB = (const char*)g.Bt + cur.boff;
    S.a_ready(cur);
    if constexpr (SP2) {
        PG8_STAGE(PG8_SB(0, 0), cB, voffB); PG8_STAGE(PG8_SB(0, 1), cB + hB, voffB); PG8_STAGE(PG8_SA(0, 0), cA, voffA); PG8_STAGE(PG8_SA(0, 1), cA + hA, voffA);
        if (wr == 1) PG8_BAR;
        PG8_WAIT_V(2); PG8_BAR;
        PG8_STAGE(PG8_SB(1, 0), cB + kstep, voffB); PG8_STAGE(PG8_SA(1, 0), cA + kstep, voffA); PG8_STAGE(PG8_SB(1, 1), cB + hB + kstep, voffB);
        PG8_WAIT_V(6); PG8_BAR;
    } else {
        PG8_STAGE(PG8_SB(0, 0), cB, voffB); PG8_STAGE(PG8_SA(0, 0), cA, voffA); PG8_STAGE(PG8_SB(0, 1), cB + hB, voffB); PG8_STAGE(PG8_SA(0, 1), cA + hA, voffA);
        if (wr == 1) PG8_BAR;
        PG8_WAIT_V(4); PG8_BAR;
        PG8_STAGE(PG8_SB(1, 0), cB + kstep, voffB); PG8_STAGE(PG8_SA(1, 0), cA + kstep, voffA); PG8_STAGE(PG8_SB(1, 1), cB + hB + kstep, voffB);
        PG8_WAIT_V(6); PG8_BAR;
    }
    for (;;) {
        const bool has_next = S.next(ui + 1, nxt);
        const char* nA = has_next ? (const char*)g.A + nxt.aoff : cA; const char* nB = has_next ? (const char*)g.Bt + nxt.boff : cB;
        for (int t = 0; t < nt; t += 2) {
            const bool last = (t == nt - 2);
            const char* a1 = cA + (size_t)(t + 1) * kstep;
            const char* a2 = last ? nA : cA + (size_t)(t + 2) * kstep; const char* b2 = last ? nB : cB + (size_t)(t + 2) * kstep;
            const char* a3 = a2 + kstep; const char* b3 = b2 + kstep;
            if (last && has_next) S.a_ready(nxt);
            if constexpr (SP2) {
            PG8_LDB(B0, 0, 0); PG8_LDB(B1, 0, 1); PG8_SCHED; PG8_LDA(At, 0, 0); PG8_STAGE(PG8_SA(1, 1), a1 + hA, voffA);
            PG8_WAIT_V(8); PG8_WAIT_L(0); PG8_BAR; PG8_MMA(0, 0, At, B0); PG8_MMA(0, 1, At, B1); PG8_BAR; PG8_SCHED;
            PG8_LDA(At, 0, 1); PG8_STAGE(PG8_SB(0, 0), b2, voffB); PG8_STAGE(PG8_SB(0, 1), b2 + hB, voffB); PG8_STAGE(PG8_SA(0, 0), a2, voffA);
            PG8_WAIT_V(8); PG8_WAIT_L(0); PG8_BAR; PG8_MMA(1, 0, At, B0); PG8_MMA(1, 1, At, B1); PG8_BAR; PG8_SCHED;
            PG8_LDB(B0, 1, 0); PG8_LDB(B1, 1, 1); PG8_SCHED; PG8_LDA(At, 1, 0); PG8_STAGE(PG8_SA(0, 1), a2 + hA, voffA);
            PG8_WAIT_V(8); PG8_WAIT_L(0); PG8_BAR; PG8_MMA(0, 0, At, B0); PG8_MMA(0, 1, At, B1); PG8_BAR; PG8_SCHED;
            PG8_LDA(At, 1, 1); PG8_STAGE(PG8_SB(1, 0), b3, voffB); PG8_STAGE(PG8_SB(1, 1), b3 + hB, voffB); PG8_STAGE(PG8_SA(1, 0), a3, voffA);
            PG8_WAIT_V(8); PG8_WAIT_L(0); PG8_BAR; PG8_MMA(1, 0, At, B0); PG8_MMA(1, 1, At, B1); PG8_BAR; PG8_SCHED;
            } else {
            PG8_LDB(B0, 0, 0); PG8_SCHED; PG8_LDA(At, 0, 0); PG8_STAGE(PG8_SA(1, 1), a1 + hA, voffA);
            PG8_WAIT_L(8); PG8_BAR; PG8_WAIT_L(0); PG8_MMA(0, 0, At, B0); PG8_BAR; PG8_SCHED;
            PG8_LDB(B1, 0, 1); PG8_STAGE(PG8_SB(0, 0), b2, voffB);
            PG8_BAR; PG8_WAIT_L(0); PG8_MMA(0, 1, At, B1); PG8_BAR;
            PG8_LDA(At, 0, 1); PG8_STAGE(PG8_SA(0, 0), a2, voffA);
            PG8_BAR; PG8_WAIT_L(0); PG8_MMA(1, 0, At, B0); PG8_BAR; PG8_SCHED;
            PG8_STAGE(PG8_SB(0, 1), b2 + hB, voffB);
            PG8_WAIT_V(6); PG8_BAR; PG8_MMA(1, 1, At, B1); PG8_BAR;
            PG8_LDB(B0, 1, 0); PG8_SCHED; PG8_LDA(At, 1, 0); PG8_STAGE(PG8_SA(0, 1), a2 + hA, voffA);
            PG8_WAIT_L(8); PG8_BAR; PG8_WAIT_L(0); PG8_MMA(0, 0, At, B0); PG8_BAR; PG8_SCHED;
            PG8_LDB(B1, 1, 1); PG8_STAGE(PG8_SB(1, 0), b3, voffB);
            PG8_BAR; PG8_WAIT_L(0); PG8_MMA(0, 1, At, B1); PG8_BAR;
            PG8_LDA(At, 1, 1); PG8_STAGE(PG8_SA(1, 0), a3, voffA);
            PG8_BAR; PG8_WAIT_L(0); PG8_MMA(1, 0, At, B0); PG8_BAR; PG8_SCHED;
            PG8_STAGE(PG8_SB(1, 1), b3 + hB, voffB);
            PG8_WAIT_V(6); PG8_BAR; PG8_MMA(1, 1, At, B1); PG8_BAR;
            }
        }
        if constexpr (ALIGN_EPI) { if (wr == 0) PG8_BAR; }
        if constexpr (!Epi::AFTER_DRAIN) { E(acc, cur, wr, wc, fr, fq); S.done(cur); }
        if (!has_next) break;
#pragma unroll
        for (int a = 0; a < 2; ++a)
#pragma unroll
            for (int b = 0; b < 2; ++b)
#pragma unroll
                for (int m = 0; m < 4; ++m)
#pragma unroll
                    for (int n = 0; n < 2; ++n) acc[a][b][m][n] = (f32x4){0.f, 0.f, 0.f, 0.f};
        cur = nxt; cA = nA; cB = nB; ++ui;
        if constexpr (ALIGN_EPI) { if (wr == 1) PG8_BAR; }
    }
    PG8_WAIT_V(0);
    if constexpr (!ALIGN_EPI) { if (wr == 0) PG8_BAR; }
    PG8_BAR;
    if constexpr (Epi::AFTER_DRAIN) { E.fused(acc, cur, wr, wc, fr, fq, lds, wid, lane); S.done(cur); }
#undef PG8_SA
#undef PG8_SB
#undef PG8_STAGE
#undef PG8_LDA
#undef PG8_LDB
#undef PG8_MMA
#undef PG8_WAIT_V
#undef PG8_WAIT_L
#undef PG8_BAR
#undef PG8_SCHED
}
}
namespace pg8 {
struct EpiBf16P {
    static constexpr bool PERM = true, AFTER_DRAIN = false;
    bf16_t* O; int ldc; float sc;
    __device__ __forceinline__ void operator()(const f32x4 (&acc)[2][2][4][2], const Unit& u, int wr, int wc, int fr, int fq) const {
        const int row0 = u.pm * BM + wr * 64 + fr, col0 = u.pn * BM + wc * 32 + 8 * fq;
#pragma unroll
        for (int ai = 0; ai < 2; ++ai)
#pragma unroll
            for (int m = 0; m < 4; ++m) { bf16_t* rowp = O + (size_t)(row0 + ai * HALF + m * 16) * ldc + col0;
#pragma unroll
                for (int bj = 0; bj < 2; ++bj) { const f32x4 v0 = acc[ai][bj][m][0] * sc, v1 = acc[ai][bj][m][1] * sc;
                    u32x4 w; w.x = cvt_pk_bf16(v0[0], v0[1]); w.y = cvt_pk_bf16(v0[2], v0[3]); w.z = cvt_pk_bf16(v1[0], v1[1]); w.w = cvt_pk_bf16(v1[2], v1[3]);
                    *(u32x4*)(rowp + bj * HALF) = w; } }
    }
};
struct OneUnitOrder {
    int L, nN, lda, ldb;
    __device__ __forceinline__ bool next(int i, Unit& u) const {
        if (i != 0 || L < 0) return false;
        u.pm = L / nN; u.pn = L % nN; u.aoff = (size_t)u.pm * BM * lda * 2; u.boff = (size_t)u.pn * BM * ldb * 2; return true;
    }
    __device__ __forceinline__ void a_ready(const Unit&) const {}
    __device__ __forceinline__ void done(const Unit&) const {}
};
}

namespace pg8 {
}

namespace pg8 {
struct EpiBf16RowScale {
    static constexpr bool PERM = true, AFTER_DRAIN = false;
    bf16_t* O; int ldc; const float* ss; float eps;
    __device__ __forceinline__ void operator()(const f32x4 (&acc)[2][2][4][2], const Unit& u, int wr, int wc, int fr, int fq) const {
        const int row0 = u.pm * BM + wr * 64 + fr, col0 = u.pn * BM + wc * 32 + 8 * fq;
#pragma unroll
        for (int ai = 0; ai < 2; ++ai)
#pragma unroll
            for (int m = 0; m < 4; ++m) { const int row = row0 + ai * HALF + m * 16; const f32x4* sp = (const f32x4*)(ss + (size_t)row * 16);
                const f32x4 a = sp[0], b = sp[1], c = sp[2], d = sp[3];
                const float t = ((a[0] + a[1]) + (a[2] + a[3])) + ((b[0] + b[1]) + (b[2] + b[3])) + ((c[0] + c[1]) + (c[2] + c[3])) + ((d[0] + d[1]) + (d[2] + d[3]));
                const float rs = 1.0f / sqrtf(t * (1.0f / 1024.0f) + eps);
                bf16_t* rowp = O + (size_t)row * ldc + col0;
#pragma unroll
                for (int bj = 0; bj < 2; ++bj) { const f32x4 v0 = acc[ai][bj][m][0] * rs, v1 = acc[ai][bj][m][1] * rs;
                    u32x4 w; w.x = cvt_pk_bf16(v0[0], v0[1]); w.y = cvt_pk_bf16(v0[2], v0[3]); w.z = cvt_pk_bf16(v1[0], v1[1]); w.w = cvt_pk_bf16(v1[2], v1[3]);
                    *(u32x4*)(rowp + bj * HALF) = w; } }
    }
};
}

namespace pg8 {
template <bool BASE_BF16> struct EpiResB {
    static constexpr bool PERM = true, AFTER_DRAIN = false;
    const void* base; bf16_t* hb; float* ss; int ldc;
    __device__ __forceinline__ void operator()(const f32x4 (&acc)[2][2][4][2], const Unit& u, int wr, int wc, int fr, int fq) const {
        const int row0 = u.pm * BM + wr * 64 + fr, col0 = u.pn * BM + wc * 32 + 8 * fq;
#pragma unroll
        for (int ai = 0; ai < 2; ++ai)
#pragma unroll
            for (int m = 0; m < 4; ++m) { const int row = row0 + ai * HALF + m * 16; const size_t off = (size_t)row * ldc + col0; float s = 0.f;
#pragma unroll
                for (int bj = 0; bj < 2; ++bj) { f32x4 b0, b1;
                    if (BASE_BF16) { const u32x4 w = *(const u32x4*)((const bf16_t*)base + off + bj * HALF);
                        b0 = (f32x4){__uint_as_float(w.x << 16), __uint_as_float(w.x & 0xffff0000u), __uint_as_float(w.y << 16), __uint_as_float(w.y & 0xffff0000u)};
                        b1 = (f32x4){__uint_as_float(w.z << 16), __uint_as_float(w.z & 0xffff0000u), __uint_as_float(w.w << 16), __uint_as_float(w.w & 0xffff0000u)}; }
                    else { b0 = *(const f32x4*)((const float*)base + off + bj * HALF); b1 = *(const f32x4*)((const float*)base + off + bj * HALF + 4); }
                    const f32x4 x0 = b0 + acc[ai][bj][m][0], x1 = b1 + acc[ai][bj][m][1];
                    u32x4 w; w.x = cvt_pk_bf16(x0[0], x0[1]); w.y = cvt_pk_bf16(x0[2], x0[3]); w.z = cvt_pk_bf16(x1[0], x1[1]); w.w = cvt_pk_bf16(x1[2], x1[3]);
                    *(u32x4*)(hb + off + bj * HALF) = w;
                    s += ((x0[0] * x0[0] + x0[1] * x0[1]) + (x0[2] * x0[2] + x0[3] * x0[3])) + ((x1[0] * x1[0] + x1[1] * x1[1]) + (x1[2] * x1[2] + x1[3] * x1[3])); }
                s += __shfl_xor(s, 16); s += __shfl_xor(s, 32);
                if (fq == 0) ss[(size_t)row * 16 + u.pn * 4 + wc] = s; }
    }
};
}

constexpr int NWAVES = 8;
constexpr int BATCH = 8, SEQ = 2048, DM = 1024, M = BATCH * SEQ, MEMLEN = 256, MM = BATCH * MEMLEN;
constexpr int INCOLS = 3088;
constexpr int N1 = 3328;
constexpr int PQ = 0, PK = 256, PV = 512, POG = 1024, PSQ = 1536, PSK = 2048, PSV = 2560, PGATE = 3072;
constexpr int PEER_N = 16384;
constexpr float EPS = 1e-6f;

constexpr size_t MiB = 1u << 20;
constexpr size_t WS_CTL = 0, CTL_ZERO_BYTES = 1 * MiB;
constexpr size_t WS_W1T = 1 * MiB;
constexpr size_t WS_WOT = 8 * MiB, WS_WXQT = 10 * MiB, WS_WXOT = 12 * MiB, WS_WXKVT = 14 * MiB, WS_WPQT = 18 * MiB, WS_SUBK = 22 * MiB;
constexpr size_t WS_UB = 24 * MiB, WS_VB = 56 * MiB;
constexpr size_t WS_BUFA = 88 * MiB;
constexpr size_t WS_MN = 120 * MiB;
constexpr size_t WS_KV = 124 * MiB;
constexpr size_t WS_PROJ = 132 * MiB;
constexpr size_t WS_SLOT0 = 132 * MiB, WS_SLOT1 = 164 * MiB, WS_SLOT2 = 196 * MiB, WS_VT = 76 * MiB, WS_END = 236 * MiB;
constexpr int CW_BAR = 4096;
constexpr int CW_SBSS = 32768;

constexpr int RING_BYTES = 131072;
constexpr int LDSCTL_OFF = RING_BYTES, MISC_OFF = LDSCTL_OFF + 320;
constexpr int LDS_BYTES = 147456;

#define GAS __attribute__((address_space(1)))
#define LAS __attribute__((address_space(3)))
typedef unsigned short bf16;
typedef unsigned v4u __attribute__((ext_vector_type(4)));
typedef float f32x4 __attribute__((ext_vector_type(4)));
typedef short bf16x8 __attribute__((ext_vector_type(8)));
typedef GAS unsigned gu32;
typedef GAS unsigned long long gu64;
#define RLX_AGENT __ATOMIC_RELAXED, __HIP_MEMORY_SCOPE_AGENT
#define LDS_WAIT() asm volatile("s_waitcnt lgkmcnt(0)" ::: "memory")
#define VM_WAIT() asm volatile("s_waitcnt vmcnt(0)" ::: "memory")
__device__ __forceinline__ unsigned long long rt() { return __builtin_amdgcn_s_memrealtime(); }
__device__ __forceinline__ unsigned f2bf(float f) { unsigned u = __builtin_bit_cast(unsigned, f); return (u + 0x7fffu + ((u >> 16) & 1u)) >> 16; }
__device__ __forceinline__ unsigned pk2(float lo, float hi) { return f2bf(lo) | (f2bf(hi) << 16); }

#define XB_TMO      128
#define XB_XCNT(j)  (256  + 64 * (j))
#define XB_XSUB(j)  (1280 + 64 * (j))
#define XB_XGEN(j)  (2304 + 64 * (j))
#define XB_TOP      3328
#define XB_TOPGEN   3392
#define XCD_BAR_WORDS 3456
#define XB_SPIN_CAP (1u << 22)

__device__ __forceinline__ unsigned xb_ld(unsigned* p)              { return __hip_atomic_load(p, __ATOMIC_RELAXED, __HIP_MEMORY_SCOPE_AGENT); }
__device__ __forceinline__ unsigned xb_add(unsigned* p, unsigned v) { return __hip_atomic_fetch_add(p, v, __ATOMIC_RELAXED, __HIP_MEMORY_SCOPE_AGENT); }
__device__ __forceinline__ unsigned xb_xcc_id() { return (unsigned)__builtin_amdgcn_s_getreg((3 << 11) | 20) & 0xFu; }
#define XB_SPIN(cond, bar) do { unsigned _sp = 0; while (cond) { __builtin_amdgcn_s_sleep(1); \
    if ((++_sp & 255u) == 0u) { if (xb_ld(&(bar)[XB_TMO])) break; if (_sp > XB_SPIN_CAP) { atomicAdd(&(bar)[XB_TMO], 1u); break; } } } } while (0)

struct XcdBarrier {
    unsigned* bar; unsigned x;
    volatile LAS unsigned* st;
};

__device__ __forceinline__ XcdBarrier xcd_barrier_post(unsigned* bar, volatile LAS unsigned* st) {
    XcdBarrier b; b.bar = bar; b.x = xb_xcc_id(); b.st = st;
    if (threadIdx.x == 0) (void)xb_add(&bar[XB_XCNT(b.x)], 1u);
    return b;
}
__device__ __forceinline__ void xcd_barrier_complete(unsigned* bar, unsigned x, unsigned& nloc, unsigned& nx) {
    const unsigned G = gridDim.x * gridDim.y * gridDim.z;
    unsigned sum, cnt, mine, sp = 0u;
    for (;;) {
        sum = 0u; cnt = 0u; mine = 0u;
#pragma unroll
        for (unsigned j = 0; j < 16; ++j) { const unsigned c = xb_ld(&bar[XB_XCNT(j)]); sum += c; cnt += (c > 0u) ? 1u : 0u; mine = (j == x) ? c : mine; }
        if (sum == G) break;
        __builtin_amdgcn_s_sleep(1);
        if ((++sp & 255u) == 0u) { if (xb_ld(&bar[XB_TMO])) break; if (sp > XB_SPIN_CAP) { atomicAdd(&bar[XB_TMO], 1u); break; } }
    }
    nloc = mine > 0u ? mine : 1u; nx = cnt > 0u ? cnt : 1u;
}

__device__ __forceinline__ void xcd_barrier(const XcdBarrier& b) {
    asm volatile("s_waitcnt vmcnt(0)" ::: "memory");
    __syncthreads();
    if (threadIdx.x == 0) {
        unsigned* bar = b.bar;
        __builtin_amdgcn_s_waitcnt(0);
        unsigned nloc = b.st[0], nx = b.st[1];
        if (nloc == 0u) { xcd_barrier_complete(bar, b.x, nloc, nx); b.st[0] = nloc; b.st[1] = nx; }
        const unsigned old = xb_add(&bar[XB_XSUB(b.x)], 1u);
        const unsigned gen = old / nloc;
        if (old + 1u == (gen + 1u) * nloc) {
            __builtin_amdgcn_fence(__ATOMIC_RELEASE, "agent");
            asm volatile("s_waitcnt vmcnt(0)" ::: "memory");
            const unsigned og = xb_add(&bar[XB_TOP], 1u);
            const unsigned tg = og / nx;
            if (og + 1u == (tg + 1u) * nx) xb_add(&bar[XB_TOPGEN], 1u);
            else XB_SPIN(xb_ld(&bar[XB_TOPGEN]) == tg, bar);
            __builtin_amdgcn_fence(__ATOMIC_ACQUIRE, "agent");
            xb_add(&bar[XB_XGEN(b.x)], 1u);
            asm volatile("s_waitcnt vmcnt(0)" ::: "memory");
        } else {
            XB_SPIN(xb_ld(&bar[XB_XGEN(b.x)]) == gen, bar);
            __builtin_amdgcn_fence(__ATOMIC_ACQUIRE, "agent");
            asm volatile("s_waitcnt vmcnt(0)" ::: "memory");
        }
    }
    __syncthreads();
}

#define DI __device__ __forceinline__
typedef __bf16 bf16x2_t __attribute__((ext_vector_type(2)));
struct Args { const float* in[21]; float* out; unsigned char* ws; int ph_lo, ph_hi, li, pad; };
struct Frame {
    LAS unsigned char* lds;
    volatile LAS unsigned* MISC;
    gu32* ctl;
    int tid, lane, wave;
    int vcu, G;
    unsigned char* ws; float* out;
};
#define WSP(off) ((bf16*)(F.ws + (off)))
#define F_W1T WSP(WS_W1T)
#define F_WOT WSP(WS_WOT)
#define F_WXQT WSP(WS_WXQT)
#define F_WXOT WSP(WS_WXOT)
#define F_WXKVT WSP(WS_WXKVT)
#define F_WPQT WSP(WS_WPQT)
#define F_SUBK WSP(WS_SUBK)
#define F_UB WSP(WS_UB)
#define F_VB WSP(WS_VB)
#define F_BUFA WSP(WS_BUFA)
#define F_MN WSP(WS_MN)
#define F_KV WSP(WS_KV)
#define F_PROJ WSP(WS_PROJ)
#define F_SLOT0 WSP(WS_SLOT0)
#define F_SLOT1 WSP(WS_SLOT1)
#define F_SLOT2 WSP(WS_SLOT2)
#define F_VT WSP(WS_VT)
DI float bf2f(unsigned v) { return __uint_as_float(v << 16); }
DI float bflo(unsigned w) { return __uint_as_float(w << 16); }
DI float bfhi(unsigned w) { return __uint_as_float(w & 0xffff0000u); }
DI float wave_sum(float v) {
#pragma unroll
    for (int o = 1; o < 64; o <<= 1) v += __shfl_xor(v, o);
    return v;
}
DI float wave_max(float v) {
#pragma unroll
    for (int o = 1; o < 64; o <<= 1) v = fmaxf(v, __shfl_xor(v, o));
    return v;
}
DI float dot2_bf16(unsigned w, unsigned x, float a) { return __builtin_amdgcn_fdot2_f32_bf16(__builtin_bit_cast(bf16x2_t, w), __builtin_bit_cast(bf16x2_t, x), a, false); }
DI float silu_f(float x) { return x * __builtin_amdgcn_rcpf(1.f + __expf(-x)); }
DI float log_sigmoid_f(float z) { return fminf(z, 0.f) - __logf(1.f + __expf(-fabsf(z))); }
DI float gelu_tanh_f(float x) { const float y = 0.7978845608028654f * (x + 0.044715f * x * x * x); const float t = 1.f - 2.f / (1.f + __expf(2.f * y)); return 0.5f * x * (1.f + t); }

DI void p0_transpose_item(const float* W, int ldw, int c0, bf16* WT, int row_off, LAS float* scr, int kb, int nb, int lane, const float* kgain = nullptr) {
    const int k0 = 64 * kb, n0 = 32 * nb;
    float tv[32];
#pragma unroll
    for (int i = 0; i < 32; ++i) tv[i] = W[(size_t)(k0 + 2 * i + (lane >> 5)) * ldw + c0 + n0 + (lane & 31)];
    if (kgain) {
#pragma unroll
        for (int i = 0; i < 32; ++i) tv[i] *= kgain[k0 + 2 * i + (lane >> 5)];
    }
#pragma unroll
    for (int i = 0; i < 32; ++i) scr[(2 * i + (lane >> 5)) * 33 + (lane & 31)] = tv[i];
    LDS_WAIT(); asm volatile("" ::: "memory");
    const int c = lane & 7;
#pragma unroll
    for (int j = 0; j < 4; ++j) { const int n = (lane >> 3) + 8 * j; const LAS float* s = scr + (8 * c) * 33 + n;
        v4u o; o.x = pk2(s[0 * 33], s[1 * 33]); o.y = pk2(s[2 * 33], s[3 * 33]); o.z = pk2(s[4 * 33], s[5 * 33]); o.w = pk2(s[6 * 33], s[7 * 33]);
        *(GAS v4u*)(WT + (size_t)(row_off + n0 + n) * 1024 + k0 + 8 * c) = o; }
    LDS_WAIT(); asm volatile("" ::: "memory");
}
DI void rms_row_to_bf16(int lane, const float* xrow, const float* g, bf16* orow) {
    const GAS f32x4* xr = (const GAS f32x4*)xrow + lane; const GAS f32x4* gr = (const GAS f32x4*)g + lane;
    f32x4 v[4]; float s = 0.f;
#pragma unroll
    for (int j = 0; j < 4; ++j) { v[j] = xr[64 * j]; s += (v[j].x * v[j].x + v[j].y * v[j].y) + (v[j].z * v[j].z + v[j].w * v[j].w); }
    const float rs = 1.f / sqrtf(wave_sum(s) * (1.f / 1024.f) + EPS);
    GAS unsigned long long* o8 = (GAS unsigned long long*)orow + lane;
#pragma unroll
    for (int j = 0; j < 4; ++j) { const f32x4 gg = gr[64 * j]; const f32x4 y = v[j] * rs * gg; o8[64 * j] = (unsigned long long)pk2(y.x, y.y) | ((unsigned long long)pk2(y.z, y.w) << 32); }
}
typedef float f32x2 __attribute__((ext_vector_type(2)));
constexpr size_t WS_U8 = 24 * MiB, WS_V8 = 40 * MiB, WS_X8 = 56 * MiB, WS_SU = 72 * MiB, WS_SX = 72 * MiB + 65536, WS_SV = 72 * MiB + 131072;
template <int CTRL> DI int dpp_i(int v) { return __builtin_amdgcn_update_dpp(0, v, CTRL, 0xf, 0xf, false); }
typedef float f32x16v __attribute__((ext_vector_type(16)));
typedef int i32x6v __attribute__((ext_vector_type(6)));
typedef unsigned u32x3v __attribute__((ext_vector_type(3)));
DI unsigned fp6_e2m3(float x) {
    const float m = fminf(fabsf(x), 7.5f);
    const int e = m >= 4.f ? 2 : m >= 2.f ? 1 : 0;
    const int q = (int)rintf(m * (e == 2 ? 2.f : e == 1 ? 4.f : 8.f));
    const unsigned code = e == 0 ? (unsigned)q : (unsigned)((e + 1) * 8 + (q - 8));
    return (x < 0.f ? 32u : 0u) | (code > 31u ? 31u : code);
}
template <int R> DI void rms_rows_to_bf16(int lane, const float* x0, size_t xstride, const float* g, bf16* o0, size_t ostride) {
    f32x4 v[R][4];
#pragma unroll
    for (int r = 0; r < R; ++r)
#pragma unroll
        for (int j = 0; j < 4; ++j) v[r][j] = *((const GAS f32x4*)(x0 + r * xstride) + lane + 64 * j);
    f32x4 gg[4];
#pragma unroll
    for (int j = 0; j < 4; ++j) gg[j] = *((const GAS f32x4*)g + lane + 64 * j);
#pragma unroll
    for (int r = 0; r < R; ++r) { float s = 0.f;
#pragma unroll
        for (int j = 0; j < 4; ++j) s += (v[r][j].x * v[r][j].x + v[r][j].y * v[r][j].y) + (v[r][j].z * v[r][j].z + v[r][j].w * v[r][j].w);
        const float rs = 1.f / sqrtf(wave_sum(s) * (1.f / 1024.f) + EPS);
        GAS unsigned long long* o8 = (GAS unsigned long long*)(o0 + r * ostride) + lane;
#pragma unroll
        for (int j = 0; j < 4; ++j) { const f32x4 y = v[r][j] * rs * gg[j]; o8[64 * j] = (unsigned long long)pk2(y.x, y.y) | ((unsigned long long)pk2(y.z, y.w) << 32); } }
}
DI void p0_prologue(Frame& F, const Args& A) {
    LAS float* scr = (LAS float*)(F.lds + F.wave * 16384);
    const int gw = F.vcu * NWAVES + F.wave, NGW = F.G * NWAVES;
    constexpr int I_IN = 16 * 48, I_W2 = 16 * 64;
    constexpr int NIT = 2 * I_IN + I_W2;
    for (int it = gw; it < NIT; it += NGW) {
        int r = it;
        if (r < I_IN) { p0_transpose_item(A.in[3], INCOLS, 0, F_W1T, 0, scr, r / 48, r % 48, F.lane); continue; } r -= I_IN;
        if (r < I_IN) { p0_transpose_item(A.in[3], INCOLS, 1552, F_W1T, 1536, scr, r / 48, r % 48, F.lane); continue; } r -= I_IN;
        p0_transpose_item(A.in[13], 2048, 0, F_WXKVT, 0, scr, r / 64, r % 64, F.lane);
    }
    const int gt = gw * 64 + F.lane, NGT = NGW * 64;
    for (int i = gt; i < 256 * 128; i += NGT) {
        const int n = i >> 7, k0 = (i & 127) * 8;
        float gv[16];
#pragma unroll
        for (int r = 0; r < 16; ++r) gv[r] = A.in[5][r * 256 + n];
        float s[8];
#pragma unroll
        for (int j = 0; j < 8; ++j) { const float* wr_ = A.in[3] + (size_t)(k0 + j) * INCOLS + 1536; float a = 0.f;
#pragma unroll
            for (int r = 0; r < 16; ++r) a += wr_[r] * gv[r];
            s[j] = a; }
        v4u o; o.x = pk2(s[0], s[1]); o.y = pk2(s[2], s[3]); o.z = pk2(s[4], s[5]); o.w = pk2(s[6], s[7]);
        *(GAS v4u*)(F_W1T + (size_t)(3072 + n) * 1024 + k0) = o;
    }
    for (int m = 4 * gw; m < M; m += 4 * NGW) rms_rows_to_bf16<4>(F.lane, A.in[0] + (size_t)m * DM, DM, A.in[2], F_BUFA + (size_t)m * DM, DM);
    for (int m = gw; m < MM; m += NGW) rms_row_to_bf16(F.lane, A.in[1] + (size_t)m * DM, A.in[11], F_MN + (size_t)m * DM);
}
template <int R> DI void quant_rows_i8(int lane, const float* src, unsigned char* dst, float* scale_out) {
    f32x4 v[R][4];
#pragma unroll
    for (int r = 0; r < R; ++r)
#pragma unroll
        for (int j = 0; j < 4; ++j) v[r][j] = *(const GAS f32x4*)(src + (size_t)r * 1024 + 256 * j + 4 * lane);
#pragma unroll
    for (int r = 0; r < R; ++r) { float m = 0.f;
#pragma unroll
        for (int j = 0; j < 4; ++j) m = fmaxf(m, fmaxf(fmaxf(fabsf(v[r][j].x), fabsf(v[r][j].y)), fmaxf(fabsf(v[r][j].z), fabsf(v[r][j].w))));
        m = wave_max(m);
        const float sc = m > 0.f ? m * (1.f / 127.f) : 1.f, inv = 1.f / sc;
        v4u o;
#pragma unroll
        for (int j = 0; j < 4; ++j) { const int a = (int)rintf(v[r][j].x * inv), b = (int)rintf(v[r][j].y * inv), c = (int)rintf(v[r][j].z * inv), d = (int)rintf(v[r][j].w * inv);
            o[j] = (unsigned)(a & 255) | ((unsigned)(b & 255) << 8) | ((unsigned)(c & 255) << 16) | ((unsigned)(d & 255) << 24); }
        *(GAS v4u*)(dst + (size_t)r * 1024 + 16 * lane) = o;
        if (lane == 0) scale_out[r] = sc; }
}
template <int R> DI void quant_rows_fp6(int lane, const float* src, unsigned char* dst, float* sc) {
    f32x4 t[R][4];
#pragma unroll
    for (int r = 0; r < R; ++r)
#pragma unroll
        for (int j = 0; j < 4; ++j) t[r][j] = *(const GAS f32x4*)(src + (size_t)r * 1024 + 256 * j + 4 * lane);
#pragma unroll
    for (int r = 0; r < R; ++r) { float mx = 0.f;
#pragma unroll
        for (int j = 0; j < 4; ++j) mx = fmaxf(mx, fmaxf(fmaxf(fabsf(t[r][j].x), fabsf(t[r][j].y)), fmaxf(fabsf(t[r][j].z), fabsf(t[r][j].w))));
        mx = wave_max(mx);
        const float s_ = mx > 0.f ? mx * (1.f / 7.5f) : 1.f, inv = 1.f / s_;
        unsigned long long lo = 0ull; unsigned hi = 0u;
#pragma unroll
        for (int i = 0; i < 16; ++i) { const unsigned long long c = fp6_e2m3(t[r][i >> 2][i & 3] * inv);
            if (6 * i < 64) lo |= c << (6 * i);
            if (6 * i + 6 > 64) hi |= (unsigned)(6 * i >= 64 ? c << (6 * i - 64) : c >> (64 - 6 * i)); }
        *(GAS u32x3v*)(dst + (size_t)r * 768 + 12 * lane) = (u32x3v){(unsigned)lo, (unsigned)(lo >> 32), hi};
        if (lane == 0) sc[r] = s_; }
}
DI void p0_late(Frame& F, const Args& A, int widx, int nw) {
    LAS float* scr = (LAS float*)(F.lds + F.wave * 16384);
    constexpr int I_SQ = 16 * 32, I_W2 = 16 * 64;
    for (int it = widx; it < 3 * I_SQ + I_W2; it += nw) {
        int r = it;
        if (r < I_SQ) { p0_transpose_item(A.in[9], 1024, 0, F_WOT, 0, scr, r / 32, r % 32, F.lane); continue; } r -= I_SQ;
        if (r < I_SQ) { p0_transpose_item(A.in[12], 1024, 0, F_WXQT, 0, scr, r / 32, r % 32, F.lane, A.in[10]); continue; } r -= I_SQ;
        if (r < I_SQ) { p0_transpose_item(A.in[14], 1024, 0, F_WXOT, 0, scr, r / 32, r % 32, F.lane); continue; } r -= I_SQ;
        p0_transpose_item(A.in[16], 2048, 0, F_WPQT, 0, scr, r / 64, r % 64, F.lane, A.in[15]);
    }
    for (int i = widx * 64 + F.lane; i < 32768; i += nw * 64) {
        const f32x4 a = *(const GAS f32x4*)(A.in[17] + (size_t)i * 8), b = *(const GAS f32x4*)(A.in[17] + (size_t)i * 8 + 4);
        v4u o; o.x = pk2(a.x, a.y); o.y = pk2(a.z, a.w); o.z = pk2(b.x, b.y); o.w = pk2(b.z, b.w);
        *(GAS v4u*)(F_SUBK + (size_t)i * 8) = o;
    }
    for (int m = 4 * widx; m < PEER_N; m += 4 * nw) quant_rows_i8<4>(F.lane, A.in[18] + (size_t)m * DM, F.ws + WS_U8 + (size_t)m * 1024, (float*)(F.ws + WS_SU) + m);
    for (int m = 4 * widx; m < PEER_N; m += 4 * nw) quant_rows_fp6<4>(F.lane, A.in[19] + (size_t)m * DM, F.ws + WS_V8 + (size_t)m * 768, (float*)(F.ws + WS_SV) + m);
}

typedef float f32x16 __attribute__((ext_vector_type(16)));
typedef short s16x4 __attribute__((ext_vector_type(4)));
DI s16x4 lds_tr16(const LAS unsigned char* p) { return __builtin_bit_cast(s16x4, __builtin_amdgcn_ds_read_tr16_b64_v4i16((LAS s16x4*)p)); }
DI unsigned cvtpk_bf16(float lo, float hi) { typedef float f2 __attribute__((ext_vector_type(2))); f2 v = {lo, hi}; bf16x2_t b = __builtin_convertvector(v, bf16x2_t); return __builtin_bit_cast(unsigned, b); }
constexpr float SB_C2 = 0.125f * 1.4426950408889634f;
template <bool MASKED> DI void sb_weights(f32x16& P0, f32x16& P1, float& carry, int hi, int qrel2) {
    float T[8], cs[8];
#pragma unroll
    for (int pi = 0; pi < 2; ++pi) {
        f32x16& P = pi ? P1 : P0;
#pragma unroll
        for (int g = 0; g < 4; ++g) {
            float lbv[4], l1v[4];
#pragma unroll
            for (int i = 0; i < 4; ++i) {
                const float z2 = P[4 * g + i] * SB_C2;
                const float sp = __builtin_amdgcn_logf(1.f + __builtin_amdgcn_exp2f(-fabsf(z2)));
                float lb = fminf(z2, 0.f) - sp, l1 = lb - z2;
                if (MASKED) { const bool valid = (32 * pi + 8 * g + 4 * hi + i) < qrel2; lb = valid ? lb : -INFINITY; l1 = valid ? l1 : 0.f; }
                lbv[i] = lb; l1v[i] = l1;
            }
            const float a = l1v[3], b = a + l1v[2], c = b + l1v[1];
            cs[4 * pi + g] = c + l1v[0];
            P[4 * g + 3] = lbv[3]; P[4 * g + 2] = lbv[2] + a; P[4 * g + 1] = lbv[1] + b; P[4 * g + 0] = lbv[0] + c;
        }
    }
#pragma unroll
    for (int k = 0; k < 8; ++k) { auto rr = __builtin_amdgcn_permlane32_swap(__float_as_uint(cs[k]), __float_as_uint(cs[k]), false, false); T[k] = __uint_as_float(rr[0]) + __uint_as_float(rr[1]); }
    const float m0 = hi ? 0.f : 1.f;
    float run = carry;
#pragma unroll
    for (int k = 7; k >= 0; --k) {
        const float E = run + m0 * (T[k] - cs[k]);
        f32x16& P = (k >> 2) ? P1 : P0; const int g = k & 3;
#pragma unroll
        for (int i = 0; i < 4; ++i) P[4 * g + i] = __builtin_amdgcn_exp2f(P[4 * g + i] + E);
        run += T[k];
    }
    carry = run;
}
DI void sb_wave(Frame& F, float* OSB, int b, int h, int rb) {
    const int lane = F.lane, wid = F.wave, r32 = lane & 31, hi = lane >> 5;
    const size_t rowbase = (size_t)b * SEQ; const int wrow0 = rb * 32;
    const bf16* Kg = F_PROJ + rowbase * N1 + PSK + h * 64;
    const bf16* Vg = F_PROJ + rowbase * N1 + PSV + h * 64;
    bf16x8 qr[4];
    { const bf16* Qw = F_PROJ + (rowbase + wrow0 + r32) * N1 + PSQ + h * 64;
#pragma unroll
      for (int ks = 0; ks < 4; ++ks) qr[ks] = *(const GAS bf16x8*)(Qw + ks * 16 + hi * 8); }
    LAS unsigned char* vbuf = F.lds + wid * 16384;
    const int vfr = ((lane >> 4) & 1) * 32 + (lane & 3) * 8 + (4 * hi + ((lane & 15) >> 2)) * 64;
    const unsigned ko0 = (unsigned)(r32 * N1 + hi * 8) * 2u, ko1 = ko0 + 32u * N1 * 2u;
    unsigned vo[4];
#pragma unroll
    for (int i = 0; i < 4; ++i) vo[i] = (unsigned)(((lane >> 2) + 16 * i) * N1 + (lane & 3) * 8) * 2u;
    f32x16 o0 = {}, o1 = {};
    float carry = 0.f;
    int kt = (wrow0 + 30) >> 6;
    bf16x8 kf[8]; v4u vr[8];
#define SBW_LOADK(t) do { const char* kb_ = (const char*)Kg + (size_t)(t) * 64 * N1 * 2; _Pragma("unroll") for (int ks = 0; ks < 4; ++ks) { kf[2 * ks] = *(const GAS bf16x8*)(kb_ + ko0 + ks * 32); kf[2 * ks + 1] = *(const GAS bf16x8*)(kb_ + ko1 + ks * 32); } } while (0)
#define SBW_LOADV(t) do { const char* vb_ = (const char*)Vg + (size_t)(t) * 64 * N1 * 2; _Pragma("unroll") for (int p = 0; p < 8; ++p) vr[p] = *(const GAS v4u*)(vb_ + vo[p & 3] + (p >> 2) * 64); } while (0)
    SBW_LOADK(kt); SBW_LOADV(kt);
    int cur = 0;
    for (;;) {
        const int k0 = kt * 64;
#pragma unroll
        for (int p = 0; p < 8; ++p) *(LAS v4u*)(vbuf + cur * 8192 + p * 1024 + lane * 16) = vr[p];
        f32x16 P0 = {}, P1 = {};
#pragma unroll
        for (int ks = 0; ks < 4; ++ks) { P0 = __builtin_amdgcn_mfma_f32_32x32x16_bf16(kf[2 * ks], qr[ks], P0, 0, 0, 0); P1 = __builtin_amdgcn_mfma_f32_32x32x16_bf16(kf[2 * ks + 1], qr[ks], P1, 0, 0, 0); }
        __builtin_amdgcn_sched_barrier(0);
        if (kt > 0) SBW_LOADV(kt - 1);
        __builtin_amdgcn_sched_barrier(0);
        if (k0 + 63 >= wrow0) sb_weights<true>(P0, P1, carry, hi, wrow0 + r32 - k0);
        else sb_weights<false>(P0, P1, carry, hi, 0);
        __builtin_amdgcn_sched_barrier(0);
        if (kt > 0) SBW_LOADK(kt - 1);
        __builtin_amdgcn_sched_barrier(0);
        LDS_WAIT();
#pragma unroll
        for (int s = 0; s < 4; ++s) {
            const f32x16& P = (s >> 1) ? P1 : P0; const int rbb = (s & 1) * 8;
            v4u pw; pw.x = cvtpk_bf16(P[rbb + 0], P[rbb + 1]); pw.y = cvtpk_bf16(P[rbb + 2], P[rbb + 3]); pw.z = cvtpk_bf16(P[rbb + 4], P[rbb + 5]); pw.w = cvtpk_bf16(P[rbb + 6], P[rbb + 7]);
            const bf16x8 pa = __builtin_bit_cast(bf16x8, pw);
            const LAS unsigned char* vq = vbuf + cur * 8192 + vfr + s * 1024;
            const s16x4 l0 = lds_tr16(vq), h0 = lds_tr16(vq + 512), l1 = lds_tr16(vq + 4096), h1 = lds_tr16(vq + 4096 + 512);
            const bf16x8 v0 = {l0[0], l0[1], l0[2], l0[3], h0[0], h0[1], h0[2], h0[3]}, v1 = {l1[0], l1[1], l1[2], l1[3], h1[0], h1[1], h1[2], h1[3]};
            o0 = __builtin_amdgcn_mfma_f32_32x32x16_bf16(pa, v0, o0, 0, 0, 0);
            o1 = __builtin_amdgcn_mfma_f32_32x32x16_bf16(pa, v1, o1, 0, 0, 0);
        }
        if (kt == 0 || __all(carry < -160.f)) break;
        --kt; cur ^= 1;
    }
#undef SBW_LOADK
#undef SBW_LOADV
    {
        char* ub = (char*)(OSB + (rowbase + wrow0) * 512 + h * 64); const unsigned lo_ = (unsigned)(4 * hi * 512 + r32) * 4u;
#pragma unroll
        for (int r = 0; r < 16; ++r) { char* rp = ub + ((r & 3) + 8 * (r >> 2)) * 2048; *(GAS float*)(rp + lo_) = o0[r]; *(GAS float*)(rp + lo_ + 128) = o1[r]; }
    }
    LDS_WAIT();
}
constexpr int GL_CS = 1040;
constexpr int GL_QT = 0, GL_KT = 8320, GL_KD = 16384, GL_V = 28672, GL_ST = 49152, GL_SEG = 69632, GL_RED = 71680, GL_KDP = 192, GL_VP = 320;
constexpr int CW_DECAY = 65536;
template <bool ACC> DI bf16x8 tr_frag(const LAS unsigned char* base, int PB, int x0, int k0, int lane) {
    const int hi = lane >> 5, rr = (lane & 15) >> 2, col = x0 + 16 * ((lane >> 4) & 1) + 4 * (lane & 3);
    const int r0 = ACC ? (k0 + 4 * hi + rr) : (k0 + 8 * hi + rr), r1 = ACC ? (r0 + 8) : (r0 + 4);
    const s16x4 a = lds_tr16(base + r0 * PB + col * 2), b = lds_tr16(base + r1 * PB + col * 2);
    return (bf16x8){a[0], a[1], a[2], a[3], b[0], b[1], b[2], b[3]};
}
constexpr int GL_RQ = 73728, GL_RK = 82432, GL_RG = 91136, GL_RV = 99328;
DI void gla_stage_load(Frame& F, int b, int h, int n, v4u (&w)[6]) {
    const int tid = F.tid; const size_t row0 = (size_t)b * SEQ + 64 * n;
#pragma unroll
    for (int i = 0; i < 6; ++i) {
        const int c = tid + 512 * i;
        const int reg = (c >= 536) + (c >= 1072) + (c >= 1584);
        const int cc = c - (reg == 1 ? 536 : reg == 2 ? 1072 : reg == 3 ? 1584 : 0);
        const int rr = reg == 3 ? (cc >> 4) : (cc >> 3), ch = reg == 3 ? (cc & 15) : (cc & 7);
        const int r = rr + (reg == 2 ? 3 : 0);
        const int col = (reg == 0 ? PQ + h * 64 : reg == 1 ? PK + h * 64 : reg == 2 ? PGATE + h * 64 : PV + h * 128) + ch * 8;
        const bool ok = (c < 2656) && (64 * n - 3 + r >= 0);
        w[i] = (v4u){0u, 0u, 0u, 0u};
        if (ok) w[i] = *(const GAS v4u*)(F_PROJ + (row0 - 3 + r) * N1 + col);
    }
}
template <int MODE> DI void gla_prep(Frame& F, const Args& A, int b, int h, int n, const v4u (&w)[6]) {
    const int tid = F.tid, d = tid & 63, seg = tid >> 6;
    const float* cw = A.in[4];
    float wq[4], wk[4], wv[4];
#pragma unroll
    for (int k = 0; k < 4; ++k) { wq[k] = cw[k * 1024 + PQ + h * 64 + d]; wk[k] = cw[k * 1024 + PK + h * 64 + d]; wv[k] = cw[k * 1024 + PV + h * 128 + (tid & 127)]; }
    const float bias = A.in[6][h * 64 + d];
#pragma unroll
    for (int i = 0; i < 6; ++i) {
        const int c = tid + 512 * i;
        const int reg = (c >= 536) + (c >= 1072) + (c >= 1584);
        const int cc = c - (reg == 1 ? 536 : reg == 2 ? 1072 : reg == 3 ? 1584 : 0);
        const int rr = reg == 3 ? (cc >> 4) : (cc >> 3), ch = reg == 3 ? (cc & 15) : (cc & 7);
        const int lo_ = (reg == 0 ? GL_RQ : reg == 1 ? GL_RK : reg == 2 ? GL_RG : GL_RV) + rr * (reg == 3 ? 256 : 128) + ch * 16;
        if (c < 2656) *(LAS v4u*)(F.lds + lo_) = w[i];
    }
    __syncthreads();
    {
        float rq[11], rk[11], gl[8];
#pragma unroll
        for (int i = 0; i < 11; ++i) { rq[i] = bf2f(*(const LAS bf16*)(F.lds + GL_RQ + (8 * seg + i) * 128 + d * 2)); rk[i] = bf2f(*(const LAS bf16*)(F.lds + GL_RK + (8 * seg + i) * 128 + d * 2)); }
#pragma unroll
        for (int j = 0; j < 8; ++j) gl[j] = log_sigmoid_f(bf2f(*(const LAS bf16*)(F.lds + GL_RG + (8 * seg + j) * 128 + d * 2)) + bias) * (1.f / 16.f);
        float c = 0.f;
#pragma unroll
        for (int j = 0; j < 8; ++j) { c += gl[j]; gl[j] = c; }
        LAS float* SEG = (LAS float*)(F.lds + GL_SEG);
        SEG[seg * 64 + d] = c;
        __syncthreads();
        float pre = 0.f, tot = 0.f;
#pragma unroll
        for (int s = 0; s < 8; ++s) { const float v = SEG[s * 64 + d]; pre += (s < seg) ? v : 0.f; tot += v; }
#pragma unroll
        for (int j = 0; j < 8; ++j) {
            const int tok = 8 * seg + j; const float cum = pre + gl[j];
            const float qc = silu_f(wq[0] * rq[j] + wq[1] * rq[j + 1] + wq[2] * rq[j + 2] + wq[3] * rq[j + 3]);
            const float kc = silu_f(wk[0] * rk[j] + wk[1] * rk[j + 1] + wk[2] * rk[j + 2] + wk[3] * rk[j + 3]);
            if (MODE == 0) { *(LAS bf16*)(F.lds + GL_KD + tok * GL_KDP + d * 2) = (bf16)f2bf(kc * __expf(tot - cum)); }
            else { const int off = (d >> 3) * GL_CS + tok * 16 + (d & 7) * 2;
                *(LAS bf16*)(F.lds + GL_QT + off) = (bf16)f2bf(qc * 0.125f * __expf(cum)); *(LAS bf16*)(F.lds + GL_KT + off) = (bf16)f2bf(kc * __expf(-cum)); }
        }
        if (MODE == 0 && seg == 0) ((float*)(F.ctl + CW_DECAY))[((size_t)(b * 4 + h) * 32 + n) * 64 + d] = __expf(tot);
    }
    {
        const int e = tid & 127, s4 = tid >> 7;
        float rv[19];
#pragma unroll
        for (int i = 0; i < 19; ++i) rv[i] = bf2f(*(const LAS bf16*)(F.lds + GL_RV + (16 * s4 + i) * 256 + e * 2));
#pragma unroll
        for (int j = 0; j < 16; ++j) *(LAS bf16*)(F.lds + GL_V + (16 * s4 + j) * GL_VP + e * 2) = (bf16)f2bf(silu_f(wv[0] * rv[j] + wv[1] * rv[j + 1] + wv[2] * rv[j + 2] + wv[3] * rv[j + 3]));
    }
}
DI void gla_local_unit(Frame& F, const Args& A, bf16* STW, int b, int h, int n, v4u (&w)[6], int nb, int nh, int nn) {
    __syncthreads();
    gla_prep<0>(F, A, b, h, n, w);
    gla_stage_load(F, nb, nh, nn, w);
    __syncthreads();
    const int lane = F.lane, wid = F.wave, dt = wid & 1, et = wid >> 1, r32 = lane & 31, hi = lane >> 5;
    f32x16 acc = {};
#pragma unroll
    for (int ks = 0; ks < 4; ++ks) {
        const bf16x8 af = tr_frag<false>(F.lds + GL_KD, GL_KDP, 32 * dt, 16 * ks, lane), bfr = tr_frag<false>(F.lds + GL_V, GL_VP, 32 * et, 16 * ks, lane);
        acc = __builtin_amdgcn_mfma_f32_32x32x16_bf16(af, bfr, acc, 0, 0, 0);
    }
    bf16* o = STW + (((size_t)(b * 4 + h) * 32 + n) * 64 + 32 * dt) * 128 + 32 * et + r32;
#pragma unroll
    for (int r = 0; r < 16; ++r) o[(size_t)((r & 3) + 8 * (r >> 2) + 4 * hi) * 128] = (bf16)f2bf(acc[r]);
}
DI void gla_out_unit(Frame& F, const Args& A, const bf16* STW, int b, int h, int n, v4u (&w)[6], int nb, int nh, int nn) {
    v4u stv[2];
    { const bf16* sp = STW + ((size_t)(b * 4 + h) * 32 + n) * 64 * 128;
#pragma unroll
      for (int i = 0; i < 2; ++i) stv[i] = *(const GAS v4u*)(sp + (F.tid + i * 512) * 8); }
    __syncthreads();
    gla_prep<1>(F, A, b, h, n, w);
    gla_stage_load(F, nb, nh, nn, w);
#pragma unroll
    for (int i = 0; i < 2; ++i) { const int idx = (F.tid + i * 512) * 8, dd = idx >> 7, ee = idx & 127;
        *(LAS v4u*)(F.lds + GL_ST + dd * GL_VP + ee * 2) = stv[i]; }
    __syncthreads();
    const int lane = F.lane, wid = F.wave, it = wid & 1, et = wid >> 1, r32 = lane & 31, hi = lane >> 5;
    f32x16 acc = {};
    bf16x8 qf[4];
#pragma unroll
    for (int ks = 0; ks < 4; ++ks) qf[ks] = *(const LAS bf16x8*)(F.lds + GL_QT + (2 * ks + hi) * GL_CS + (32 * it + r32) * 16);
#pragma unroll
    for (int ks = 0; ks < 4; ++ks) acc = __builtin_amdgcn_mfma_f32_32x32x16_bf16(tr_frag<false>(F.lds + GL_ST, GL_VP, 32 * et, 16 * ks, lane), qf[ks], acc, 0, 0, 0);
    for (int jt = 0; jt <= it; ++jt) {
        f32x16 S = {};
#pragma unroll
        for (int ks = 0; ks < 4; ++ks) S = __builtin_amdgcn_mfma_f32_32x32x16_bf16(*(const LAS bf16x8*)(F.lds + GL_KT + (2 * ks + hi) * GL_CS + (32 * jt + r32) * 16), qf[ks], S, 0, 0, 0);
        if (jt == it) {
#pragma unroll
            for (int r = 0; r < 16; ++r) S[r] = ((r & 3) + 8 * (r >> 2) + 4 * hi) <= r32 ? S[r] : 0.f;
        }
#pragma unroll
        for (int s = 0; s < 2; ++s) {
            v4u pw; pw.x = cvtpk_bf16(S[8 * s + 0], S[8 * s + 1]); pw.y = cvtpk_bf16(S[8 * s + 2], S[8 * s + 3]); pw.z = cvtpk_bf16(S[8 * s + 4], S[8 * s + 5]); pw.w = cvtpk_bf16(S[8 * s + 6], S[8 * s + 7]);
            acc = __builtin_amdgcn_mfma_f32_32x32x16_bf16(tr_frag<true>(F.lds + GL_V, GL_VP, 32 * et, 32 * jt + 16 * s, lane), __builtin_bit_cast(bf16x8, pw), acc, 0, 0, 0);
        }
    }
    float ss = 0.f;
#pragma unroll
    for (int r = 0; r < 16; ++r) ss += acc[r] * acc[r];
    { auto rr = __builtin_amdgcn_permlane32_swap(__float_as_uint(ss), __float_as_uint(ss), false, false); ss = __uint_as_float(rr[0]) + __uint_as_float(rr[1]); }
    LAS float* RED = (LAS float*)(F.lds + GL_RED);
    if (hi == 0) RED[wid * 32 + r32] = ss;
    __syncthreads();
    const float tot = RED[(it + 0) * 32 + r32] + RED[(it + 2) * 32 + r32] + RED[(it + 4) * 32 + r32] + RED[(it + 6) * 32 + r32];
    const float rs = 1.f / sqrtf(tot * (1.f / 128.f) + EPS);
    const size_t row = (size_t)b * SEQ + 64 * n + 32 * it + r32;
    const float* gg = A.in[7];
#pragma unroll
    for (int g = 0; g < 4; ++g) {
        const int e0 = 32 * et + 8 * g + 4 * hi;
        const unsigned long long ogw = *(const GAS unsigned long long*)(F_PROJ + row * N1 + POG + h * 128 + e0);
        const unsigned lo = (unsigned)ogw, hi2 = (unsigned)(ogw >> 32);
        const f32x4 gv = *(const GAS f32x4*)(gg + e0);
        const float y0 = acc[4 * g + 0] * rs * gv.x * silu_f(bflo(lo)), y1 = acc[4 * g + 1] * rs * gv.y * silu_f(bfhi(lo)), y2 = acc[4 * g + 2] * rs * gv.z * silu_f(bflo(hi2)), y3 = acc[4 * g + 3] * rs * gv.w * silu_f(bfhi(hi2));
        *(GAS unsigned long long*)(F_BUFA + row * 1024 + h * 128 + e0) = (unsigned long long)pk2(y0, y1) | ((unsigned long long)pk2(y2, y3) << 32);
    }
}
DI void xattn_unit(Frame& F, const bf16* Q, bf16* O, int b, int h, int qb) {
    const int tid = F.tid, lane = F.lane, wid = F.wave, r32 = lane & 31, hi = lane >> 5;
    const bf16* Kg = F_KV + (size_t)(b * 256) * 2048 + h * 256;
    const bf16* Vg = Kg + 1024;
    const size_t row = (size_t)b * SEQ + qb * 256 + wid * 32 + r32;
    __syncthreads();
    {
        const bf16* kp = Kg + (size_t)(tid >> 5) * 2048 + (tid & 31) * 8; LAS unsigned char* kl = F.lds + (tid & 31) * 4096 + (tid >> 5) * 16;
#pragma unroll 8
        for (int i = 0; i < 16; ++i) { *(LAS v4u*)(kl) = *(const GAS v4u*)(kp); kp += 16 * 2048; kl += 256; }
    }
    bf16x8 qf[16];
#pragma unroll
    for (int ks = 0; ks < 16; ++ks) qf[ks] = *(const GAS bf16x8*)(Q + row * 1024 + h * 256 + 16 * ks + 8 * hi);
    __syncthreads();
    f32x16 S[8];
#pragma unroll
    for (int mt = 0; mt < 8; ++mt) { S[mt] = (f32x16){};
#pragma unroll
        for (int k4 = 0; k4 < 4; ++k4) {
#pragma unroll
            for (int kk = 0; kk < 4; ++kk) { const int ks = 4 * k4 + kk; S[mt] = __builtin_amdgcn_mfma_f32_32x32x16_bf16(*(const LAS bf16x8*)(F.lds + (2 * ks + hi) * 4096 + (32 * mt + r32) * 16), qf[ks], S[mt], 0, 0, 0); }
            __builtin_amdgcn_sched_barrier(0); } }
    float mx = -INFINITY;
#pragma unroll
    for (int mt = 0; mt < 8; ++mt)
#pragma unroll
        for (int r = 0; r < 16; ++r) mx = fmaxf(mx, S[mt][r]);
    { auto rr = __builtin_amdgcn_permlane32_swap(__float_as_uint(mx), __float_as_uint(mx), false, false); mx = fmaxf(__uint_as_float(rr[0]), __uint_as_float(rr[1])); }
    const float c2 = 0.0625f * 1.4426950408889634f; const float mb = mx * c2;
    float sum = 0.f;
#pragma unroll
    for (int mt = 0; mt < 8; ++mt)
#pragma unroll
        for (int r = 0; r < 16; ++r) { const float p = __builtin_amdgcn_exp2f(S[mt][r] * c2 - mb); S[mt][r] = p; sum += p; }
    { auto rr = __builtin_amdgcn_permlane32_swap(__float_as_uint(sum), __float_as_uint(sum), false, false); sum = __uint_as_float(rr[0]) + __uint_as_float(rr[1]); }
    const float linv = 1.f / sum;
    v4u pa[16];
#pragma unroll
    for (int mt = 0; mt < 8; ++mt)
#pragma unroll
        for (int s = 0; s < 2; ++s) { v4u pw; pw.x = cvtpk_bf16(S[mt][8 * s + 0] * linv, S[mt][8 * s + 1] * linv); pw.y = cvtpk_bf16(S[mt][8 * s + 2] * linv, S[mt][8 * s + 3] * linv);
            pw.z = cvtpk_bf16(S[mt][8 * s + 4] * linv, S[mt][8 * s + 5] * linv); pw.w = cvtpk_bf16(S[mt][8 * s + 6] * linv, S[mt][8 * s + 7] * linv); pa[2 * mt + s] = pw; }
    __syncthreads();
    {
        const int c = tid & 31, m0 = tid >> 5;
        const bf16* vp = Vg + (size_t)m0 * 2048 + c * 8; LAS unsigned char* vl = F.lds + (c >> 2) * 16384 + m0 * 64 + (c & 3) * 16;
#pragma unroll 8
        for (int i = 0; i < 16; ++i) { *(LAS v4u*)(vl) = *(const GAS v4u*)(vp); vp += 16 * 2048; vl += 1024; }
    }
    __syncthreads();
    const int vfr = ((lane >> 4) & 1) * 32 + (lane & 3) * 8 + (4 * hi + ((lane & 15) >> 2)) * 64;
    unsigned opk[4][16];
#pragma unroll
    for (int dp = 0; dp < 4; ++dp) {
        f32x16 a0 = {}, a1 = {};
#pragma unroll
        for (int s = 0; s < 16; ++s) {
            const LAS unsigned char* vp0 = F.lds + (2 * dp) * 16384 + s * 1024 + vfr; const LAS unsigned char* vp1 = vp0 + 16384;
            const s16x4 l0 = lds_tr16(vp0), h0 = lds_tr16(vp0 + 512), l1 = lds_tr16(vp1), h1 = lds_tr16(vp1 + 512);
            const bf16x8 v0 = {l0[0], l0[1], l0[2], l0[3], h0[0], h0[1], h0[2], h0[3]}, v1 = {l1[0], l1[1], l1[2], l1[3], h1[0], h1[1], h1[2], h1[3]};
            a0 = __builtin_amdgcn_mfma_f32_32x32x16_bf16(__builtin_bit_cast(bf16x8, pa[s]), v0, a0, 0, 0, 0);
            a1 = __builtin_amdgcn_mfma_f32_32x32x16_bf16(__builtin_bit_cast(bf16x8, pa[s]), v1, a1, 0, 0, 0);
            if ((s & 3) == 3) __builtin_amdgcn_sched_barrier(0);
        }
#pragma unroll
        for (int r = 0; r < 16; ++r) opk[dp][r] = cvtpk_bf16(a0[r], a1[r]);
        __builtin_amdgcn_sched_barrier(0);
    }
    __syncthreads();
    LAS bf16* stg = (LAS bf16*)(F.lds + wid * 16384);
#pragma unroll
    for (int dp = 0; dp < 4; ++dp)
#pragma unroll
        for (int r = 0; r < 16; ++r) { const int rr = (r & 3) + 8 * (r >> 2) + 4 * hi; stg[rr * 256 + dp * 64 + r32] = (bf16)(opk[dp][r] & 0xffffu); stg[rr * 256 + dp * 64 + 32 + r32] = (bf16)(opk[dp][r] >> 16); }
    LDS_WAIT(); asm volatile("" ::: "memory");
    bf16* Ow = O + ((size_t)b * SEQ + qb * 256 + wid * 32) * 1024 + h * 256;
    {
        bf16* op = Ow + (size_t)(lane >> 5) * 1024 + (lane & 31) * 8; const LAS bf16* sp = stg + (lane >> 5) * 256 + (lane & 31) * 8;
#pragma unroll 4
        for (int i = 0; i < 16; ++i) { *(GAS v4u*)(op) = *(const LAS v4u*)(sp); op += 2 * 1024; sp += 2 * 256; }
    }
    LDS_WAIT(); asm volatile("" ::: "memory");
}
template <int R> DI void mix_rows_sb(Frame& F, const Args& A, const float* OSB, size_t row) {
    const int lane = F.lane;
    f32x4 b0[R], b1[R];
#pragma unroll
    for (int r = 0; r < R; ++r) { b0[r] = *(const GAS f32x4*)(OSB + (row + r) * 512 + 8 * lane); b1[r] = *(const GAS f32x4*)(OSB + (row + r) * 512 + 8 * lane + 4); }
    const f32x4 h0 = *(const GAS f32x4*)(A.in[8] + 8 * lane), h1 = *(const GAS f32x4*)(A.in[8] + 8 * lane + 4);
#pragma unroll
    for (int r = 0; r < R; ++r) {
        const float s2 = (b0[r].x * b0[r].x + b0[r].y * b0[r].y) + (b0[r].z * b0[r].z + b0[r].w * b0[r].w) + (b1[r].x * b1[r].x + b1[r].y * b1[r].y) + (b1[r].z * b1[r].z + b1[r].w * b1[r].w);
        const float rs2 = 1.f / sqrtf(wave_sum(s2) * (1.f / 512.f) + EPS);
        v4u p;
        p.x = pk2(b0[r].x * rs2 * h0.x, b0[r].y * rs2 * h0.y); p.y = pk2(b0[r].z * rs2 * h0.z, b0[r].w * rs2 * h0.w);
        p.z = pk2(b1[r].x * rs2 * h1.x, b1[r].y * rs2 * h1.y); p.w = pk2(b1[r].z * rs2 * h1.z, b1[r].w * rs2 * h1.w);
        *(GAS v4u*)(F_BUFA + (row + r) * 1024 + 512 + 8 * lane) = p; }
}
DI void gla_scan(Frame& F, bf16* STW) {
    const int gt = (F.vcu * NWAVES + F.wave) * 64 + F.lane, NGT = F.G * NWAVES * 64;
    const float* dec = (const float*)(F.ctl + CW_DECAY);
    for (int idx = gt; idx < 32 * 4096; idx += NGT) {
        const int bh = idx >> 12, de = (idx & 4095) * 2, d = de >> 7;
        unsigned* p = (unsigned*)(STW + (size_t)bh * 32 * 8192 + de); const float* dp = dec + (size_t)bh * 32 * 64 + d;
        unsigned tmp[32]; float dc[32];
#pragma unroll
        for (int n = 0; n < 32; ++n) { tmp[n] = p[(size_t)n * 4096]; dc[n] = dp[n * 64]; }
        float s0 = 0.f, s1 = 0.f;
#pragma unroll
        for (int n = 0; n < 32; ++n) { p[(size_t)n * 4096] = pk2(s0, s1); s0 = dc[n] * s0 + bflo(tmp[n]); s1 = dc[n] * s1 + bfhi(tmp[n]); }
    }
}
DI float vmaxf(float a, float b) { float r; asm("v_max_f32_e32 %0, %1, %2" : "=v"(r) : "v"(a), "v"(b)); return r; }
DI float vminf(float a, float b) { float r; asm("v_min_f32_e32 %0, %1, %2" : "=v"(r) : "v"(a), "v"(b)); return r; }
#define CE(a, b) do { const float h_ = vmaxf(a, b); const float l_ = vminf(a, b); a = h_; b = l_; } while (0)
DI void sort16_desc(float (&v)[16]) { const float h0 = vmaxf(v[0], v[1]); const float h1 = vmaxf(v[2], v[3]); const float h2 = vmaxf(v[4], v[5]); const float h3 = vmaxf(v[6], v[7]); const float h4 = vmaxf(v[8], v[9]); const float h5 = vmaxf(v[10], v[11]); const float h6 = vmaxf(v[12], v[13]); const float h7 = vmaxf(v[14], v[15]); v[1] = vminf(v[0], v[1]); v[3] = vminf(v[2], v[3]); v[5] = vminf(v[4], v[5]); v[7] = vminf(v[6], v[7]); v[9] = vminf(v[8], v[9]); v[11] = vminf(v[10], v[11]); v[13] = vminf(v[12], v[13]); v[15] = vminf(v[14], v[15]); v[0] = h0; v[2] = h1; v[4] = h2; v[6] = h3; v[8] = h4; v[10] = h5; v[12] = h6; v[14] = h7; const float h8 = vmaxf(v[0], v[2]); const float h9 = vmaxf(v[1], v[3]); const float h10 = vmaxf(v[4], v[6]); const float h11 = vmaxf(v[5], v[7]); const float h12 = vmaxf(v[8], v[10]); const float h13 = vmaxf(v[9], v[11]); const float h14 = vmaxf(v[12], v[14]); const float h15 = vmaxf(v[13], v[15]); v[2] = vminf(v[0], v[2]); v[3] = vminf(v[1], v[3]); v[6] = vminf(v[4], v[6]); v[7] = vminf(v[5], v[7]); v[10] = vminf(v[8], v[10]); v[11] = vminf(v[9], v[11]); v[14] = vminf(v[12], v[14]); v[15] = vminf(v[13], v[15]); v[0] = h8; v[1] = h9; v[4] = h10; v[5] = h11; v[8] = h12; v[9] = h13; v[12] = h14; v[13] = h15; const float h16 = vmaxf(v[1], v[2]); const float h17 = vmaxf(v[5], v[6]); const float h18 = vmaxf(v[0], v[4]); const float h19 = vmaxf(v[3], v[7]); const float h20 = vmaxf(v[9], v[10]); const float h21 = vmaxf(v[13], v[14]); const float h22 = vmaxf(v[8], v[12]); const float h23 = vmaxf(v[11], v[15]); v[2] = vminf(v[1], v[2]); v[6] = vminf(v[5], v[6]); v[4] = vminf(v[0], v[4]); v[7] = vminf(v[3], v[7]); v[10] = vminf(v[9], v[10]); v[14] = vminf(v[13], v[14]); v[12] = vminf(v[8], v[12]); v[15] = vminf(v[11], v[15]); v[1] = h16; v[5] = h17; v[0] = h18; v[3] = h19; v[9] = h20; v[13] = h21; v[8] = h22; v[11] = h23; const float h24 = vmaxf(v[2], v[6]); const float h25 = vmaxf(v[1], v[5]); const float h26 = vmaxf(v[10], v[14]); const float h27 = vmaxf(v[9], v[13]); const float h28 = vmaxf(v[0], v[8]); const float h29 = vmaxf(v[7], v[15]); v[6] = vminf(v[2], v[6]); v[5] = vminf(v[1], v[5]); v[14] = vminf(v[10], v[14]); v[13] = vminf(v[9], v[13]); v[8] = vminf(v[0], v[8]); v[15] = vminf(v[7], v[15]); v[2] = h24; v[1] = h25; v[10] = h26; v[9] = h27; v[0] = h28; v[7] = h29; const float h30 = vmaxf(v[2], v[4]); const float h31 = vmaxf(v[3], v[5]); const float h32 = vmaxf(v[10], v[12]); const float h33 = vmaxf(v[11], v[13]); v[4] = vminf(v[2], v[4]); v[5] = vminf(v[3], v[5]); v[12] = vminf(v[10], v[12]); v[13] = vminf(v[11], v[13]); v[2] = h30; v[3] = h31; v[10] = h32; v[11] = h33; const float h34 = vmaxf(v[1], v[2]); const float h35 = vmaxf(v[3], v[4]); const float h36 = vmaxf(v[5], v[6]); const float h37 = vmaxf(v[9], v[10]); const float h38 = vmaxf(v[11], v[12]); const float h39 = vmaxf(v[13], v[14]); v[2] = vminf(v[1], v[2]); v[4] = vminf(v[3], v[4]); v[6] = vminf(v[5], v[6]); v[10] = vminf(v[9], v[10]); v[12] = vminf(v[11], v[12]); v[14] = vminf(v[13], v[14]); v[1] = h34; v[3] = h35; v[5] = h36; v[9] = h37; v[11] = h38; v[13] = h39; const float h40 = vmaxf(v[4], v[12]); const float h41 = vmaxf(v[2], v[10]); const float h42 = vmaxf(v[6], v[14]); const float h43 = vmaxf(v[1], v[9]); const float h44 = vmaxf(v[5], v[13]); const float h45 = vmaxf(v[3], v[11]); v[12] = vminf(v[4], v[12]); v[10] = vminf(v[2], v[10]); v[14] = vminf(v[6], v[14]); v[9] = vminf(v[1], v[9]); v[13] = vminf(v[5], v[13]); v[11] = vminf(v[3], v[11]); v[4] = h40; v[2] = h41; v[6] = h42; v[1] = h43; v[5] = h44; v[3] = h45; const float h46 = vmaxf(v[4], v[8]); const float h47 = vmaxf(v[6], v[10]); const float h48 = vmaxf(v[5], v[9]); const float h49 = vmaxf(v[7], v[11]); v[8] = vminf(v[4], v[8]); v[10] = vminf(v[6], v[10]); v[9] = vminf(v[5], v[9]); v[11] = vminf(v[7], v[11]); v[4] = h46; v[6] = h47; v[5] = h48; v[7] = h49; const float h50 = vmaxf(v[2], v[4]); const float h51 = vmaxf(v[6], v[8]); const float h52 = vmaxf(v[10], v[12]); const float h53 = vmaxf(v[3], v[5]); const float h54 = vmaxf(v[7], v[9]); const float h55 = vmaxf(v[11], v[13]); v[4] = vminf(v[2], v[4]); v[8] = vminf(v[6], v[8]); v[12] = vminf(v[10], v[12]); v[5] = vminf(v[3], v[5]); v[9] = vminf(v[7], v[9]); v[13] = vminf(v[11], v[13]); v[2] = h50; v[6] = h51; v[10] = h52; v[3] = h53; v[7] = h54; v[11] = h55; const float h56 = vmaxf(v[1], v[2]); const float h57 = vmaxf(v[3], v[4]); const float h58 = vmaxf(v[5], v[6]); const float h59 = vmaxf(v[7], v[8]); const float h60 = vmaxf(v[9], v[10]); const float h61 = vmaxf(v[11], v[12]); const float h62 = vmaxf(v[13], v[14]); v[2] = vminf(v[1], v[2]); v[4] = vminf(v[3], v[4]); v[6] = vminf(v[5], v[6]); v[8] = vminf(v[7], v[8]); v[10] = vminf(v[9], v[10]); v[12] = vminf(v[11], v[12]); v[14] = vminf(v[13], v[14]); v[1] = h56; v[3] = h57; v[5] = h58; v[7] = h59; v[9] = h60; v[11] = h61; v[13] = h62; }
DI void bmerge16_desc(float (&v)[16]) { const float h0 = vmaxf(v[0], v[8]); const float h1 = vmaxf(v[1], v[9]); const float h2 = vmaxf(v[2], v[10]); const float h3 = vmaxf(v[3], v[11]); const float h4 = vmaxf(v[4], v[12]); const float h5 = vmaxf(v[5], v[13]); const float h6 = vmaxf(v[6], v[14]); const float h7 = vmaxf(v[7], v[15]); v[8] = vminf(v[0], v[8]); v[9] = vminf(v[1], v[9]); v[10] = vminf(v[2], v[10]); v[11] = vminf(v[3], v[11]); v[12] = vminf(v[4], v[12]); v[13] = vminf(v[5], v[13]); v[14] = vminf(v[6], v[14]); v[15] = vminf(v[7], v[15]); v[0] = h0; v[1] = h1; v[2] = h2; v[3] = h3; v[4] = h4; v[5] = h5; v[6] = h6; v[7] = h7; const float h8 = vmaxf(v[0], v[4]); const float h9 = vmaxf(v[1], v[5]); const float h10 = vmaxf(v[2], v[6]); const float h11 = vmaxf(v[3], v[7]); const float h12 = vmaxf(v[8], v[12]); const float h13 = vmaxf(v[9], v[13]); const float h14 = vmaxf(v[10], v[14]); const float h15 = vmaxf(v[11], v[15]); v[4] = vminf(v[0], v[4]); v[5] = vminf(v[1], v[5]); v[6] = vminf(v[2], v[6]); v[7] = vminf(v[3], v[7]); v[12] = vminf(v[8], v[12]); v[13] = vminf(v[9], v[13]); v[14] = vminf(v[10], v[14]); v[15] = vminf(v[11], v[15]); v[0] = h8; v[1] = h9; v[2] = h10; v[3] = h11; v[8] = h12; v[9] = h13; v[10] = h14; v[11] = h15; const float h16 = vmaxf(v[0], v[2]); const float h17 = vmaxf(v[1], v[3]); const float h18 = vmaxf(v[4], v[6]); const float h19 = vmaxf(v[5], v[7]); const float h20 = vmaxf(v[8], v[10]); const float h21 = vmaxf(v[9], v[11]); const float h22 = vmaxf(v[12], v[14]); const float h23 = vmaxf(v[13], v[15]); v[2] = vminf(v[0], v[2]); v[3] = vminf(v[1], v[3]); v[6] = vminf(v[4], v[6]); v[7] = vminf(v[5], v[7]); v[10] = vminf(v[8], v[10]); v[11] = vminf(v[9], v[11]); v[14] = vminf(v[12], v[14]); v[15] = vminf(v[13], v[15]); v[0] = h16; v[1] = h17; v[4] = h18; v[5] = h19; v[8] = h20; v[9] = h21; v[12] = h22; v[13] = h23; const float h24 = vmaxf(v[0], v[1]); const float h25 = vmaxf(v[2], v[3]); const float h26 = vmaxf(v[4], v[5]); const float h27 = vmaxf(v[6], v[7]); const float h28 = vmaxf(v[8], v[9]); const float h29 = vmaxf(v[10], v[11]); const float h30 = vmaxf(v[12], v[13]); const float h31 = vmaxf(v[14], v[15]); v[1] = vminf(v[0], v[1]); v[3] = vminf(v[2], v[3]); v[5] = vminf(v[4], v[5]); v[7] = vminf(v[6], v[7]); v[9] = vminf(v[8], v[9]); v[11] = vminf(v[10], v[11]); v[13] = vminf(v[12], v[13]); v[15] = vminf(v[14], v[15]); v[0] = h24; v[2] = h25; v[4] = h26; v[6] = h27; v[8] = h28; v[10] = h29; v[12] = h30; v[14] = h31; }
#undef CE
template <int NV> DI void merge_top16(float (&L)[16], const float (&N)[NV]) {
#pragma unroll
    for (int i = 16 - NV; i < 16; ++i) L[i] = vmaxf(L[i], N[15 - i]);
    bmerge16_desc(L);
}
DI float pack_cand(float s, int id) { return __uint_as_float((__float_as_uint(s) & ~0xffu) | (unsigned)(255 - id)); }
DI void peer_topk_mfma2(Frame& F, const bf16* PQb, int* IDX, float* GATE) {
    const int tid = F.tid, lane = F.lane, wid = F.wave, r32 = lane & 31, hi = lane >> 5, h = F.vcu & 7;
    __syncthreads();
    {
        v4u kw[8];
#pragma unroll
        for (int j = 0; j < 8; ++j) { const int i = tid + 512 * j, p = i >> 11, key = (i >> 4) & 127, c = i & 15; kw[j] = *(const GAS v4u*)(F_SUBK + (size_t)((h * 2 + p) * 128 + key) * 128 + c * 8); }
#pragma unroll
        for (int j = 0; j < 8; ++j) { const int i = tid + 512 * j, p = i >> 11, key = (i >> 4) & 127, c = i & 15; *(LAS v4u*)(F.lds + p * 32768 + c * 2048 + key * 16) = kw[j]; }
    }
    __syncthreads();
    LAS unsigned* scr = (LAS unsigned*)(F.lds + 65536 + wid * 8192) + lane;
    const int g0 = (F.vcu >> 3) * 8 + wid, gstep = (F.G >> 3) * 8;
    bf16x8 qf[8];
#pragma unroll
    for (int ks = 0; ks < 8; ++ks) qf[ks] = *(const GAS bf16x8*)(PQb + ((size_t)32 * g0 + r32) * 2048 + (h * 2) * 128 + 16 * ks + 8 * hi);
    for (int g = g0; g < 512; g += gstep) {
        const size_t token = (size_t)32 * g + r32;
        float LA[16], LB[16];
#pragma unroll
        for (int p = 0; p < 2; ++p) {
            float (&L)[16] = p ? LB : LA;
            f32x16 S[4];
#pragma unroll
            for (int rt = 0; rt < 4; ++rt) { S[rt] = (f32x16){};
#pragma unroll
                for (int ks = 0; ks < 8; ++ks) S[rt] = __builtin_amdgcn_mfma_f32_32x32x16_bf16(*(const LAS bf16x8*)(F.lds + p * 32768 + (2 * ks + hi) * 2048 + (32 * rt + r32) * 16), qf[ks], S[rt], 0, 0, 0); }
            __builtin_amdgcn_sched_barrier(0);
            {
                const int gn = p ? (g + gstep < 512 ? g + gstep : g) : g; const int pn = p ? 0 : 1;
#pragma unroll
                for (int ks = 0; ks < 8; ++ks) qf[ks] = *(const GAS bf16x8*)(PQb + ((size_t)32 * gn + r32) * 2048 + (h * 2 + pn) * 128 + 16 * ks + 8 * hi);
            }
            __builtin_amdgcn_sched_barrier(0);
#pragma unroll
            for (int rt = 0; rt < 4; ++rt) {
                float v[16];
#pragma unroll
                for (int r = 0; r < 16; ++r) { const unsigned key = (unsigned)(32 * rt + (r & 3) + 8 * (r >> 2)) + 4u * (unsigned)hi; v[r] = __uint_as_float((__float_as_uint(S[rt][r]) & ~0x7fu) | key); }
                sort16_desc(v);
                if (rt == 0) {
#pragma unroll
                    for (int i = 0; i < 16; ++i) L[i] = v[i];
                } else merge_top16<16>(L, v);
            }
            float PL[16];
#pragma unroll
            for (int i = 0; i < 16; ++i) { auto rr = __builtin_amdgcn_permlane32_swap(__float_as_uint(L[i]), __float_as_uint(L[i]), false, false); PL[i] = __uint_as_float(hi ? rr[0] : rr[1]); }
            merge_top16<16>(L, PL);
        }
#pragma unroll
        for (int i = 0; i < 16; ++i) { scr[i * 64] = __float_as_uint(LA[i]) & 0x7fu; scr[(16 + i) * 64] = __float_as_uint(LB[i]) & 0x7fu; }
        float VA[16], VB[16];
#pragma unroll
        for (int i = 0; i < 16; ++i) { VA[i] = __uint_as_float(__float_as_uint(LA[i]) & ~0x7fu); VB[i] = __uint_as_float(__float_as_uint(LB[i]) & ~0x7fu); }
        float C[16];
#pragma unroll
        for (int b = 0; b < 16; ++b) C[b] = pack_cand(VA[0] + VB[b], b);
        { float R[8];
#pragma unroll
          for (int b = 0; b < 8; ++b) R[b] = pack_cand(VA[1] + VB[b], 16 + b);
          merge_top16<8>(C, R); }
        { float R[5];
#pragma unroll
          for (int b = 0; b < 5; ++b) R[b] = pack_cand(VA[2] + VB[b], 32 + b);
          merge_top16<5>(C, R); }
        { float R[4];
#pragma unroll
          for (int b = 0; b < 4; ++b) R[b] = pack_cand(VA[3] + VB[b], 48 + b);
          merge_top16<4>(C, R); }
        { float R[3];
#pragma unroll
          for (int b = 0; b < 3; ++b) R[b] = pack_cand(VA[4] + VB[b], 64 + b);
          merge_top16<3>(C, R); }
        { float R[11];
#pragma unroll
          for (int i = 0; i < 11; ++i) R[i] = pack_cand(VA[5 + i] + VB[0], (5 + i) * 16);
          merge_top16<11>(C, R); }
        { float R[3];
#pragma unroll
          for (int i = 0; i < 3; ++i) R[i] = pack_cand(VA[5 + i] + VB[1], (5 + i) * 16 + 1);
          merge_top16<3>(C, R); }
        LDS_WAIT(); asm volatile("" ::: "memory");
        const float top = __uint_as_float(__float_as_uint(C[0]) & ~0xffu);
        float ex[16]; int ei[16]; float sum = 0.f;
#pragma unroll
        for (int r = 0; r < 16; ++r) { const unsigned cu = __float_as_uint(C[r]), id = 255u - (cu & 0xffu); ex[r] = __expf(__uint_as_float(cu & ~0xffu) - top); sum += ex[r];
            ei[r] = (int)(scr[(id >> 4) * 64] * 128u + scr[(16 + (id & 15)) * 64]); }
        const float inv = 1.f / sum;
        v4u io0, io1; f32x4 go0, go1;
        io0.x = hi ? ei[8] : ei[0]; io0.y = hi ? ei[9] : ei[1]; io0.z = hi ? ei[10] : ei[2]; io0.w = hi ? ei[11] : ei[3];
        io1.x = hi ? ei[12] : ei[4]; io1.y = hi ? ei[13] : ei[5]; io1.z = hi ? ei[14] : ei[6]; io1.w = hi ? ei[15] : ei[7];
        go0.x = (hi ? ex[8] : ex[0]) * inv; go0.y = (hi ? ex[9] : ex[1]) * inv; go0.z = (hi ? ex[10] : ex[2]) * inv; go0.w = (hi ? ex[11] : ex[3]) * inv;
        go1.x = (hi ? ex[12] : ex[4]) * inv; go1.y = (hi ? ex[13] : ex[5]) * inv; go1.z = (hi ? ex[14] : ex[6]) * inv; go1.w = (hi ? ex[15] : ex[7]) * inv;
        int* ip = IDX + token * 128 + h * 16 + 8 * hi; float* gp = GATE + token * 128 + h * 16 + 8 * hi;
        *(GAS v4u*)ip = io0; *(GAS v4u*)(ip + 4) = io1; *(GAS f32x4*)gp = go0; *(GAS f32x4*)(gp + 4) = go1;
        LDS_WAIT(); asm volatile("" ::: "memory");
    }
}
constexpr int GL3_LIST = 0, GL3_X = 65536;
constexpr int G5_NSH = 16, G5_SHIFT = 10;
constexpr int G6_NSH = 16, G6_SHIFT = 10, G6_TPW = 8;
DI void g6_issue(v4u (&R)[4], v4u& E, const LAS unsigned char* tlist, const unsigned char* TAB, int k, int lane) {
    E = *(const LAS v4u*)(tlist + (4 * k + (lane & 3)) * 16);
#pragma unroll
    for (int j = 0; j < 4; ++j) { const unsigned id = (unsigned)__builtin_amdgcn_readlane((int)E.x, j); R[j] = *(const GAS v4u*)(TAB + (size_t)id * 1024 + 16 * lane); }
}
DI void g6_dot(const v4u& xx, const v4u (&U)[4], const v4u& E, LAS unsigned char* tlist, int k, int lane) {
    int p[4];
#pragma unroll
    for (int j = 0; j < 4; ++j) { int d = __builtin_amdgcn_sdot4((int)U[j].x, (int)xx.x, 0, false); d = __builtin_amdgcn_sdot4((int)U[j].y, (int)xx.y, d, false);
        d = __builtin_amdgcn_sdot4((int)U[j].z, (int)xx.z, d, false); p[j] = __builtin_amdgcn_sdot4((int)U[j].w, (int)xx.w, d, false); }
    const bool b0 = lane & 1, b1 = lane & 2;
    const int kA = b0 ? p[1] : p[0], sA = b0 ? p[0] : p[1], kB = b0 ? p[3] : p[2], sB = b0 ? p[2] : p[3];
    const int qA = kA + dpp_i<0xB1>(sA), qB = kB + dpp_i<0xB1>(sB);
    const int kk = b1 ? qB : qA, ss = b1 ? qA : qB;
    int r = kk + dpp_i<0x4E>(ss);
    r += dpp_i<0x124>(r); r += dpp_i<0x128>(r);
    r += __shfl_xor(r, 16); r += __shfl_xor(r, 32);
    const float a = (float)r * __uint_as_float(E.z);
    const float y = 0.7978845608028654f * (a + 0.044715f * a * a * a);
    const float th = 1.f - 2.f * __builtin_amdgcn_rcpf(1.f + __expf(2.f * y));
    const float cfl = __uint_as_float(E.y) * __uint_as_float(E.w) * 0.5f * a * (1.f + th);
    if (lane < 4) *(LAS float*)(tlist + (4 * k + lane) * 16 + 4) = cfl;
}
typedef _Float16 h2_t __attribute__((ext_vector_type(2)));
typedef _Float16 h32_t __attribute__((ext_vector_type(32)));
DI void g6_issue_v(u32x3v (&R)[4], v4u& E, const LAS unsigned char* tlist, const unsigned char* TAB, int k, int lane) {
    E = *(const LAS v4u*)(tlist + (4 * k + (lane & 3)) * 16);
#pragma unroll
    for (int j = 0; j < 4; ++j) { const unsigned id = (unsigned)__builtin_amdgcn_readlane((int)E.x, j); R[j] = *(const GAS u32x3v*)(TAB + (size_t)id * 768 + 12 * lane); }
}
DI void g6_fma(h2_t (&acc)[8], const u32x3v (&V)[4], const v4u& E, int lane) {
#pragma unroll
    for (int jp = 0; jp < 2; ++jp) {
        const i32x6v pk = {(int)V[2 * jp][0], (int)V[2 * jp][1], (int)V[2 * jp][2], (int)V[2 * jp + 1][0], (int)V[2 * jp + 1][1], (int)V[2 * jp + 1][2]};
        const h32_t hv = __builtin_bit_cast(h32_t, __builtin_amdgcn_cvt_scalef32_pk32_f16_fp6(pk, 1.0f));
#pragma unroll
        for (int q = 0; q < 2; ++q) { const float cf = __uint_as_float(__builtin_amdgcn_readlane((int)E.y, 2 * jp + q)); const _Float16 ch = (_Float16)cf; const h2_t c2 = {ch, ch};
#pragma unroll
            for (int w = 0; w < 8; ++w) { const h2_t vv = {hv[16 * q + 2 * w], hv[16 * q + 2 * w + 1]}; acc[w] = __builtin_elementwise_fma(vv, c2, acc[w]); } }
    }
}
DI void peer_gather_wave6(Frame& F, const Args& A, const bf16* XN2, const float* SS2, const int* IDX, const float* GATE, size_t tok0) {
    constexpr int TPW = G6_TPW;
    const int lane = F.lane, wid = F.wave;
    const unsigned char* U8 = F.ws + WS_U8; const unsigned char* V8 = F.ws + WS_V8;
    const float* SU = (const float*)(F.ws + WS_SU); const float* SV = (const float*)(F.ws + WS_SV);
    LAS unsigned char* list = F.lds + wid * (TPW * 2048);
    v4u xq[TPW];
#pragma unroll
    for (int tl = 0; tl < TPW; ++tl) {
        const size_t t = tok0 + tl;
        float sx;
        {
            float xv[16];
#pragma unroll
            for (int j = 0; j < 4; ++j) { const unsigned long long hw = *(const GAS unsigned long long*)(XN2 + t * 1024 + 256 * j + 4 * lane); const unsigned lo_ = (unsigned)hw, hi_ = (unsigned)(hw >> 32);
                xv[4 * j] = bflo(lo_); xv[4 * j + 1] = bfhi(lo_); xv[4 * j + 2] = bflo(hi_); xv[4 * j + 3] = bfhi(hi_); }
            {
                const f32x4* sp = (const f32x4*)(SS2 + t * 16); const f32x4 a = sp[0], b = sp[1], c = sp[2], d = sp[3];
                const float tt = ((a[0] + a[1]) + (a[2] + a[3])) + ((b[0] + b[1]) + (b[2] + b[3])) + ((c[0] + c[1]) + (c[2] + c[3])) + ((d[0] + d[1]) + (d[2] + d[3]));
                const float rs = 1.0f / sqrtf(tt * (1.0f / 1024.0f) + EPS);
#pragma unroll
                for (int i = 0; i < 4; ++i) { const f32x4 gv = *(const GAS f32x4*)(A.in[15] + 256 * i + 4 * lane); xv[4 * i] *= rs * gv.x; xv[4 * i + 1] *= rs * gv.y; xv[4 * i + 2] *= rs * gv.z; xv[4 * i + 3] *= rs * gv.w; }
            }
            float mx = 0.f;
#pragma unroll
            for (int i = 0; i < 16; ++i) mx = fmaxf(mx, fabsf(xv[i]));
            mx = wave_max(mx); sx = mx > 0.f ? mx * (1.f / 127.f) : 1.f; const float inv = 1.f / sx;
#pragma unroll
            for (int i = 0; i < 4; ++i) { const int a = (int)rintf(xv[4 * i] * inv), b = (int)rintf(xv[4 * i + 1] * inv), c = (int)rintf(xv[4 * i + 2] * inv), d = (int)rintf(xv[4 * i + 3] * inv);
                xq[tl][i] = (unsigned)(a & 255) | ((unsigned)(b & 255) << 8) | ((unsigned)(c & 255) << 16) | ((unsigned)(d & 255) << 24); }
        }
        const int idlo = IDX[t * 128 + lane], idhi = IDX[t * 128 + 64 + lane];
        const float glo = GATE[t * 128 + lane], ghi = GATE[t * 128 + 64 + lane];
        const float slo = SU[idlo] * sx, shi = SU[idhi] * sx, vlo = SV[idlo], vhi = SV[idhi];
        LAS unsigned char* tl_list = list + tl * 2048;
        int base = 0;
        for (int s = 0; s < G6_NSH; ++s) {
            { const bool m = (idlo >> G6_SHIFT) == s; const unsigned long long mk = __ballot(m); const int pos = base + (int)__builtin_amdgcn_mbcnt_hi((unsigned)(mk >> 32), __builtin_amdgcn_mbcnt_lo((unsigned)mk, 0u));
              if (m) *(LAS v4u*)(tl_list + pos * 16) = (v4u){(unsigned)idlo, __float_as_uint(glo), __float_as_uint(slo), __float_as_uint(vlo)};
              base += __builtin_popcountll(mk); }
            { const bool m = (idhi >> G6_SHIFT) == s; const unsigned long long mk = __ballot(m); const int pos = base + (int)__builtin_amdgcn_mbcnt_hi((unsigned)(mk >> 32), __builtin_amdgcn_mbcnt_lo((unsigned)mk, 0u));
              if (m) *(LAS v4u*)(tl_list + pos * 16) = (v4u){(unsigned)idhi, __float_as_uint(ghi), __float_as_uint(shi), __float_as_uint(vhi)};
              base += __builtin_popcountll(mk); }
        }
    }
    LDS_WAIT(); asm volatile("" ::: "memory");
#define G6_SB __builtin_amdgcn_sched_barrier(0)
    {
        v4u RA[4], RB[4]; v4u EA, EB;
        g6_issue(RA, EA, list, U8, 0, lane);
        for (int k = 0; k < 32; ++k) {
#define G6_P1(RI, EI, tn, kn, RC, EC, tc) do { g6_issue(RI, EI, list + (tn) * 2048, U8, kn, lane); G6_SB; g6_dot(xq[tc], RC, EC, list + (tc) * 2048, k, lane); G6_SB; } while (0)
            G6_P1(RB, EB, 1, k, RA, EA, 0); G6_P1(RA, EA, 2, k, RB, EB, 1); G6_P1(RB, EB, 3, k, RA, EA, 2); G6_P1(RA, EA, 4, k, RB, EB, 3);
            G6_P1(RB, EB, 5, k, RA, EA, 4); G6_P1(RA, EA, 6, k, RB, EB, 5); G6_P1(RB, EB, 7, k, RA, EA, 6); G6_P1(RA, EA, 0, (k < 31 ? k + 1 : 31), RB, EB, 7);
#undef G6_P1
        }
    }
    LDS_WAIT(); asm volatile("" ::: "memory");
    h2_t acc[TPW][8];
#pragma unroll
    for (int tl = 0; tl < TPW; ++tl)
#pragma unroll
        for (int i = 0; i < 8; ++i) acc[tl][i] = (h2_t){(_Float16)0.f, (_Float16)0.f};
    {
        u32x3v RA[4], RB[4]; v4u EA, EB;
        g6_issue_v(RA, EA, list, V8, 0, lane);
        for (int k = 0; k < 32; ++k) {
#define G6_P2(RI, EI, tn, kn, RC, EC, tc) do { g6_issue_v(RI, EI, list + (tn) * 2048, V8, kn, lane); G6_SB; g6_fma(acc[tc], RC, EC, lane); G6_SB; } while (0)
            G6_P2(RB, EB, 1, k, RA, EA, 0); G6_P2(RA, EA, 2, k, RB, EB, 1); G6_P2(RB, EB, 3, k, RA, EA, 2); G6_P2(RA, EA, 4, k, RB, EB, 3);
            G6_P2(RB, EB, 5, k, RA, EA, 4); G6_P2(RA, EA, 6, k, RB, EB, 5); G6_P2(RB, EB, 7, k, RA, EA, 6); G6_P2(RA, EA, 0, (k < 31 ? k + 1 : 31), RB, EB, 7);
#undef G6_P2
        }
    }
#undef G6_SB
#pragma unroll
    for (int tl = 0; tl < TPW; ++tl) {
        float* hp = F.out + (tok0 + tl) * 1024 + 4 * lane;
        f32x4 y[4]; float ssq = 0.f;
#pragma unroll
        for (int i = 0; i < 4; ++i) { const unsigned long long hw = *(const GAS unsigned long long*)(XN2 + (tok0 + tl) * 1024 + 256 * i + 4 * lane); const unsigned lo_ = (unsigned)hw, hi_ = (unsigned)(hw >> 32);
            y[i] = (f32x4){bflo(lo_), bfhi(lo_), bflo(hi_), bfhi(hi_)}; }
#pragma unroll
        for (int i = 0; i < 4; ++i) { y[i].x += (float)acc[tl][2 * i].x; y[i].y += (float)acc[tl][2 * i].y; y[i].z += (float)acc[tl][2 * i + 1].x; y[i].w += (float)acc[tl][2 * i + 1].y;
            ssq += (y[i].x * y[i].x + y[i].y * y[i].y) + (y[i].z * y[i].z + y[i].w * y[i].w); }
        const float rs = 1.f / sqrtf(wave_sum(ssq) * (1.f / 1024.f) + EPS);
#pragma unroll
        for (int i = 0; i < 4; ++i) { const f32x4 gv = *(const GAS f32x4*)(A.in[20] + 256 * i + 4 * lane); *(GAS f32x4*)(hp + 256 * i) = y[i] * rs * gv; }
    }
    LDS_WAIT(); asm volatile("" ::: "memory");
}

DI void wg_self_handoff() {
    asm volatile("s_waitcnt vmcnt(0)" ::: "memory");
    __syncthreads();
    if (threadIdx.x == 0) { __builtin_amdgcn_fence(__ATOMIC_ACQUIRE, "agent"); asm volatile("s_waitcnt vmcnt(0)" ::: "memory"); }
    __syncthreads();
}
constexpr size_t WS_XBUF = 73 * MiB;
constexpr int CW_SEAM = 16384, SEAM_BANK = 8192;
__global__ void __launch_bounds__(NWAVES * 64, 2) fwd_kernel(Args args) {
    extern __shared__ __attribute__((aligned(16))) unsigned char lds[];
    Frame F;
    F.lds = (LAS unsigned char*)lds;
    F.MISC = (volatile LAS unsigned*)(F.lds + MISC_OFF);
    F.tid = threadIdx.x; F.lane = F.tid & 63; F.wave = __builtin_amdgcn_readfirstlane(F.tid >> 6);
    F.G = gridDim.x; { const int bx = blockIdx.x; F.vcu = (F.G % 8 == 0) ? (bx % 8) * (F.G / 8) + bx / 8 : bx; }
    unsigned char* ws = args.ws;
    F.ctl = (gu32*)(ws + WS_CTL);
    F.out = args.out; F.ws = ws;
    for (int u = F.tid; u < (LDS_BYTES - LDSCTL_OFF) / 4; u += NWAVES * 64) ((LAS unsigned*)(F.lds + LDSCTL_OFF))[u] = 0u;
    __syncthreads();
    XcdBarrier bar = xcd_barrier_post((unsigned*)(F.ctl + CW_BAR) + args.li * XCD_BAR_WORDS, F.MISC + 8);
    const int lo = args.ph_lo, hi = args.ph_hi;
#ifndef PH_MASK
#define PH_MASK 0xffff
#endif
#define IN(k) (((PH_MASK >> (k)) & 1) && lo <= (k) && (k) < hi)
#define SEAM(k) do { if (IN(k) && IN((k) + 1)) xcd_barrier(bar); } while (0)
    const int gw = F.vcu * NWAVES + F.wave, NGW = F.G * NWAVES;
#define STW ((bf16*)F.out)
#define OSB (F.out + (size_t)M * 512)
#define IDX ((int*)F_BUFA)
#define GATE ((float*)(F_BUFA) + (size_t)M * 128)

    if (IN(0)) { p0_prologue(F, args); __syncthreads(); p0_late(F, args, gw, NGW); } SEAM(0);
    if (IN(1)) {
        { pg8::Gemm g{F_BUFA, F_W1T, 1024, 1024, 1024}; pg8::StaticOrder S; S.init(M, N1, F.G, (int)blockIdx.x, 1024, 1024);
          pg8::EpiBf16P E{F_PROJ, N1, 1.f};
          pg8::gemm_phase<pg8::EpiBf16P, pg8::StaticOrder, true, true>(F.lds, g, S, E); }
        { pg8::Gemm g{F_MN, F_WXKVT, 1024, 1024, 1024}; const int c = (int)blockIdx.x; pg8::OneUnitOrder S{(c >= 64 && c < 128) ? c - 64 : -1, 8, 1024, 1024};
          pg8::EpiBf16P E{F_KV, 2048, 1.f};
          pg8::gemm_phase<pg8::EpiBf16P, pg8::OneUnitOrder, true, true>(F.lds, g, S, E); }
    } SEAM(1);
    if (IN(2)) {
        __syncthreads();
        for (int task = gw; task < 64 * 64; task += NGW) { const int bh = task >> 6; sb_wave(F, OSB, bh >> 3, bh & 7, 63 - (task & 63)); }
        __syncthreads();
        { v4u gw_[6]; int it = F.vcu; if (it < 1024) gla_stage_load(F, (it >> 5) >> 2, (it >> 5) & 3, it & 31, gw_);
          for (; it < 1024; it += F.G) { const int bh = it >> 5, itn = it + F.G < 1024 ? it + F.G : it, bhn = itn >> 5; gla_local_unit(F, args, STW, bh >> 2, bh & 3, it & 31, gw_, bhn >> 2, bhn & 3, itn & 31); } }
    } SEAM(2);
    if (IN(3)) { gla_scan(F, STW);
    } SEAM(3);
    if (IN(4)) {
        { v4u gw_[6]; int it = F.vcu; if (it < 1024) gla_stage_load(F, (it >> 5) >> 2, (it >> 5) & 3, it & 31, gw_);
          for (; it < 1024; it += F.G) { const int bh = it >> 5, itn = it + F.G < 1024 ? it + F.G : it, bhn = itn >> 5; gla_out_unit(F, args, STW, bh >> 2, bh & 3, it & 31, gw_, bhn >> 2, bhn & 3, itn & 31); } }
        for (int m = 4 * gw; m < M; m += 4 * NGW) mix_rows_sb<4>(F, args, OSB, (size_t)m);
    } SEAM(4);
    if (IN(5)) { pg8::Gemm g{F_BUFA, F_WOT, 1024, 1024, 1024}; pg8::StaticOrder S; S.init(M, 1024, F.G, (int)blockIdx.x, 1024, 1024);
        pg8::EpiResB<false> E{args.in[0], F_SLOT1, (float*)(ws + WS_XBUF), 1024};
        pg8::gemm_phase<pg8::EpiResB<false>, pg8::StaticOrder, true, true>(F.lds, g, S, E); } SEAM(5);
    if (IN(6)) { pg8::Gemm g{F_SLOT1, F_WXQT, 1024, 1024, 1024}; pg8::StaticOrder S; S.init(M, 1024, F.G, (int)blockIdx.x, 1024, 1024);
        pg8::EpiBf16RowScale E{F_SLOT2, 1024, (const float*)(ws + WS_XBUF), EPS};
        { const int L = (int)blockIdx.x;
            const int wgid = (L & 7) * 32 + (L >> 3), pm = (wgid >> 5) * 8 + (wgid & 7), pn = (wgid & 31) >> 3;
            pg8::OneUnitOrder S1{pm * 4 + pn, 4, 1024, 1024};
            pg8::gemm_phase<pg8::EpiBf16RowScale, pg8::OneUnitOrder, true, true>(F.lds, g, S1, E);
            wg_self_handoff();
            xattn_unit(F, F_SLOT2, F_SLOT0, pm >> 3, pn, pm & 7); }
        (void)S;
    }
    SEAM(7);
    if (IN(8)) { pg8::Gemm g{F_SLOT0, F_WXOT, 1024, 1024, 1024}; pg8::StaticOrder S; S.init(M, 1024, F.G, (int)blockIdx.x, 1024, 1024);
        pg8::EpiResB<true> E{F_SLOT1, F_SLOT2, (float*)(ws + WS_XBUF + MiB), 1024};
        pg8::gemm_phase<pg8::EpiResB<true>, pg8::StaticOrder, true, true>(F.lds, g, S, E); } SEAM(8);
    if (IN(9)) { pg8::Gemm g{F_SLOT2, F_WPQT, 1024, 1024, 1024}; pg8::StaticOrder S; S.init(M, 2048, F.G, (int)blockIdx.x, 1024, 1024);
        pg8::EpiBf16RowScale E{F_SLOT0, 2048, (const float*)(ws + WS_XBUF + MiB), EPS};
        pg8::gemm_phase<pg8::EpiBf16RowScale, pg8::StaticOrder, true, true>(F.lds, g, S, E); } SEAM(9);
    if (IN(10)) { peer_topk_mfma2(F, F_SLOT0, IDX, GATE); } SEAM(10);
    if (IN(11)) { peer_gather_wave6(F, args, F_SLOT2, (const float*)(ws + WS_XBUF + MiB), IDX, GATE, (size_t)F.vcu * 64 + F.wave * 8); }
#undef IN
#undef SEAM
}

constexpr int NPHASES = 12;
extern "C" void kernel_launch(void* const* d_in, const int* in_sizes, int n_in, void* d_out, int out_size, void* d_ws, size_t ws_size, hipStream_t stream) {
    static int grid = 0;
    if (grid == 0) {
        if (n_in != 21 || out_size != M * DM || ws_size < WS_END) { fprintf(stderr, "kernel_launch: unexpected shapes (n_in %d out %d ws %zu)\n", n_in, out_size, ws_size); grid = -1; return; }
        int dev = 0, cus = 0, per_cu = 0;
        if (hipGetDevice(&dev) != hipSuccess || hipDeviceGetAttribute(&cus, hipDeviceAttributeMultiprocessorCount, dev) != hipSuccess) { grid = -1; return; }
        if (hipFuncSetAttribute((const void*)fwd_kernel, hipFuncAttributeMaxDynamicSharedMemorySize, LDS_BYTES) != hipSuccess) { fprintf(stderr, "kernel_launch: hipFuncSetAttribute failed\n"); grid = -1; return; }
        if (hipOccupancyMaxActiveBlocksPerMultiprocessor(&per_cu, (const void*)fwd_kernel, NWAVES * 64, LDS_BYTES) != hipSuccess || per_cu < 1) { fprintf(stderr, "kernel_launch: occupancy query says %d\n", per_cu); }
        (void)hipGetLastError();
        grid = cus;
    }
    if (grid < 0) return;
    (void)hipMemsetAsync((char*)d_ws + WS_CTL, 0, CTL_ZERO_BYTES, stream);
    Args a{};
    for (int i = 0; i < 21; ++i) a.in[i] = (const float*)d_in[i];
    a.out = (float*)d_out; a.ws = (unsigned char*)d_ws;
#if defined(PROF_DUP_LO)
    a.ph_lo = 0; a.ph_hi = PROF_DUP_HI + 1; a.li = 0; hipLaunchKernelGGL(fwd_kernel, dim3(grid), dim3(NWAVES * 64), LDS_BYTES, stream, a);
    a.ph_lo = PROF_DUP_LO; a.ph_hi = NPHASES; a.li = 1; hipLaunchKernelGGL(fwd_kernel, dim3(grid), dim3(NWAVES * 64), LDS_BYTES, stream, a);
#elif defined(PROF_SPLIT)
    a.ph_lo = 0; a.ph_hi = PROF_SPLIT; a.li = 0; hipLaunchKernelGGL(fwd_kernel, dim3(grid), dim3(NWAVES * 64), LDS_BYTES, stream, a);
    a.ph_lo = PROF_SPLIT; a.ph_hi = NPHASES; a.li = 1; hipLaunchKernelGGL(fwd_kernel, dim3(grid), dim3(NWAVES * 64), LDS_BYTES, stream, a);
#else
    a.ph_lo = 0; a.ph_hi = NPHASES; a.li = 0;
    hipLaunchKernelGGL(fwd_kernel, dim3(grid), dim3(NWAVES * 64), LDS_BYTES, stream, a);
#endif
}
```

```cpp
#include <hip/hip_runtime.h>
#include <cstdio>
#include <cstdint>
namespace pg8 {
#define PG8_LAS __attribute__((address_space(3)))
typedef unsigned short bf16_t;
typedef short bf16x8 __attribute__((ext_vector_type(8)));
typedef float f32x4 __attribute__((ext_vector_type(4)));
typedef unsigned u32x4 __attribute__((ext_vector_type(4)));
constexpr int BM = 256, BK = 64, HALF = 128, HTB = HALF * BK * 2  , STAGE_BYTES = 8 * HTB, NXCD = 8, WGM = 8;

__host__ __device__ __forceinline__ int lds_byte(int r, int c) { const int st = (r >> 4) * 2 + (c >> 5), rr = r & 15, cc = c & 31, ob = rr * 64 + cc * 2; return st * 1024 + (ob ^ (((ob >> 9) & 1) << 5)); }
__host__ __device__ __forceinline__ void stage_rc(int b, int& R, int& C) { const int st = b / 1024, sb = b % 1024, swz = sb ^ (((sb >> 9) & 1) << 5); R = (st >> 1) * 16 + swz / 64; C = (st & 1) * 32 + (swz % 64) / 2; }
__host__ __device__ __forceinline__ int perm32(int rho) { const int n = rho >> 4, i = rho & 15; return 8 * (i >> 2) + 4 * n + (i & 3); }

struct Unit { int pm, pn; size_t aoff, boff; };
struct Gemm { const bf16_t* A; const bf16_t* Bt; int K, lda, ldb; };

struct StaticOrder {
    int nM, nN, nwg, G, c, lda, ldb;
    __host__ __device__ void init(int M, int N, int G_, int c_, int lda_, int ldb_) { nM = M / BM; nN = N / BM; nwg = nM * nN; G = G_; c = c_; lda = lda_; ldb = ldb_; }
    __host__ __device__ bool next(int i, Unit& u) const {
        const long L = (long)i * G + c; if (L >= nwg) return false;
        int wgid = (int)L; { const int q = nwg / NXCD, r = nwg % NXCD, xcd = wgid % NXCD, off = wgid / NXCD; wgid = (xcd < r ? xcd * (q + 1) : r * (q + 1) + (xcd - r) * q) + off; }
        const int nig = WGM * nN, gid = wgid / nig, fm = gid * WGM, gsz = (nM - fm) < WGM ? (nM - fm) : WGM;
        u.pm = fm + ((wgid % nig) % gsz); u.pn = (wgid % nig) / gsz; u.aoff = (size_t)u.pm * BM * lda * 2; u.boff = (size_t)u.pn * BM * ldb * 2; return true;
    }
    __device__ __forceinline__ void a_ready(const Unit&) const {}
    __device__ __forceinline__ void done(const Unit&) const {}
};

__device__ __forceinline__ unsigned cvt_pk_bf16(float lo, float hi) { unsigned r; asm volatile("v_cvt_pk_bf16_f32 %0, %1, %2" : "=v"(r) : "v"(lo), "v"(hi)); return r; }
typedef float f32x2 __attribute__((ext_vector_type(2)));
__device__ __forceinline__ f32x2 gelu_pk(f32x2 v) {
    const f32x2 av = __builtin_elementwise_abs(v), d = av * 0.2316418882f + 1.0f;
    f32x2 t; t.x = __builtin_amdgcn_rcpf(d.x); t.y = __builtin_amdgcn_rcpf(d.y);
    f32x2 q = t * 0.5307027145f + (-0.7265760135f); q = q * t + 0.7107068705f; q = q * t + (-0.142248368f); q = q * t + 0.127414796f; q = q * t;
    const f32x2 s = (v * v) * (-0.72134752044f);
    f32x2 e; e.x = __builtin_amdgcn_exp2f(s.x); e.y = __builtin_amdgcn_exp2f(s.y);
    const f32x2 m = v * (q * e), r = v - m;
    f32x2 o; o.x = v.x < 0.f ? m.x : r.x; o.y = v.y < 0.f ? m.y : r.y; return o;
}

template <int ACT  > struct EpiBf16 {
    static constexpr bool PERM = true, AFTER_DRAIN = false; static_assert(ACT == 0 || ACT == 1, "EpiBf16: ACT is 0 (none) or 1 (gelu_pk)");
    bf16_t* O; int ldc; const float* bias; int split_cols; size_t split_stride; float scale0;
    __device__ __forceinline__ void operator()(const f32x4 (&acc)[2][2][4][2], const Unit& u, int wr, int wc, int fr, int fq) const {
        const int row0 = u.pm * BM + wr * 64 + fr; int colt = u.pn * BM; bf16_t* base = O;
        float sc = 1.f; if (split_cols) { const int t = colt / split_cols; base += (size_t)t * split_stride; colt -= t * split_cols; if (t == 0) sc = scale0; }
        const int col0 = colt + wc * 32 + 8 * fq, bcol0 = u.pn * BM + wc * 32 + 8 * fq;
        f32x4 bv[2][2];
#pragma unroll
        for (int bj = 0; bj < 2; ++bj)
#pragma unroll
            for (int n = 0; n < 2; ++n) bv[bj][n] = bias ? *(const f32x4*)(bias + bcol0 + bj * HALF + 4 * n) : (f32x4){0.f, 0.f, 0.f, 0.f};
#pragma unroll
        for (int ai = 0; ai < 2; ++ai)
#pragma unroll
            for (int m = 0; m < 4; ++m) { bf16_t* rowp = base + (size_t)(row0 + ai * HALF + m * 16) * ldc + col0;
#pragma unroll
                for (int bj = 0; bj < 2; ++bj) { f32x4 v0 = acc[ai][bj][m][0] + bv[bj][0], v1 = acc[ai][bj][m][1] + bv[bj][1];
                    if (ACT == 1) { f32x2 a = gelu_pk((f32x2){v0[0], v0[1]}), b = gelu_pk((f32x2){v0[2], v0[3]}), c = gelu_pk((f32x2){v1[0], v1[1]}), d = gelu_pk((f32x2){v1[2], v1[3]});
                        v0 = (f32x4){a.x, a.y, b.x, b.y}; v1 = (f32x4){c.x, c.y, d.x, d.y}; }
                    v0 = v0 * sc; v1 = v1 * sc; u32x4 w; w.x = cvt_pk_bf16(v0[0], v0[1]); w.y = cvt_pk_bf16(v0[2], v0[3]); w.z = cvt_pk_bf16(v1[0], v1[1]); w.w = cvt_pk_bf16(v1[2], v1[3]);
                    *(u32x4*)(rowp + bj * HALF) = w; } }
    }
};
template <class Epi, class Sched, bool ALIGN_EPI = false, bool SP2 = false>
__device__ __forceinline__ void gemm_phase(PG8_LAS unsigned char* lds, const Gemm g, const Sched& S, const Epi& E) {
    const int tid = threadIdx.x, wid = __builtin_amdgcn_readfirstlane(tid >> 6), lane = tid & 63, wr = wid >> 2, wc = wid & 3, fr = lane & 15, fq = lane >> 4;
    int K = g.K; asm volatile("" : "+s"(K));
    const int nt = K / BK;
    unsigned voffA[2], voffB[2];
#pragma unroll
    for (int i = 0; i < 2; ++i) { int R, C; stage_rc(tid * 16 + i * 8192, R, C); const int Rb = Epi::PERM ? ((R & ~31) + perm32(R & 31)) : R;
        voffA[i] = (unsigned)(R * g.lda + C) * 2u; voffB[i] = (unsigned)(Rb * g.ldb + C) * 2u; }
    const size_t kstep = (size_t)(BK * 2);
    const size_t hA = (size_t)HALF * g.lda * 2, hB = (size_t)HALF * g.ldb * 2;
    const unsigned ldsw = (unsigned)wid * 1024u;
    const int aoff = lds_byte(wr * 64 + fr, fq * 8), boff = lds_byte(wc * 32 + fr, fq * 8);
#define PG8_SA(b, h) (((b) * 2 + (h)) * HTB)
#define PG8_SB(b, h) ((4 + (b) * 2 + (h)) * HTB)
#define PG8_STAGE(bufoff, gbase, voff) do { _Pragma("unroll") for (int _i = 0; _i < 2; ++_i) \
        __builtin_amdgcn_global_load_lds((const unsigned*)((const char*)(gbase) + (voff)[_i]), (PG8_LAS unsigned*)(lds + (bufoff) + ldsw + _i * 8192), 16, 0, 0); } while (0)
#define PG8_LDA(dst, b, h) do { _Pragma("unroll") for (int m = 0; m < 4; ++m) _Pragma("unroll") for (int k = 0; k < 2; ++k) dst[m][k] = *(const PG8_LAS bf16x8*)(lds + PG8_SA(b, h) + aoff + m * 2048 + k * 1024); } while (0)
#define PG8_LDB(dst, b, h) do { _Pragma("unroll") for (int n = 0; n < 2; ++n) _Pragma("unroll") for (int k = 0; k < 2; ++k) dst[n][k] = *(const PG8_LAS bf16x8*)(lds + PG8_SB(b, h) + boff + n * 2048 + k * 1024); } while (0)
#define PG8_MMA(ai, bj, At, Bt) do { __builtin_amdgcn_s_setprio(1); _Pragma("unroll") for (int m = 0; m < 4; ++m) _Pragma("unroll") for (int n = 0; n < 2; ++n) _Pragma("unroll") for (int k = 0; k < 2; ++k) \
        acc[ai][bj][m][n] = __builtin_amdgcn_mfma_f32_16x16x32_bf16(Bt[n][k], At[m][k], acc[ai][bj][m][n], 0, 0, 0); __builtin_amdgcn_s_setprio(0); } while (0)
#define PG8_WAIT_V(n) asm volatile("s_waitcnt vmcnt(" #n ")" ::: "memory")
#define PG8_WAIT_L(n) asm volatile("s_waitcnt lgkmcnt(" #n ")" ::: "memory")
#define PG8_BAR __builtin_amdgcn_s_barrier()
#define PG8_SCHED __builtin_amdgcn_sched_barrier(0)
    Unit cur, nxt; int ui = 0;
    if (!S.next(0, cur)) return;
    f32x4 acc[2][2][4][2];
#pragma unroll
    for (int a = 0; a < 2; ++a)
#pragma unroll
        for (int b = 0; b < 2; ++b)
#pragma unroll
            for (int m = 0; m < 4; ++m)
#pragma unroll
                for (int n = 0; n < 2; ++n) acc[a][b][m][n] = (f32x4){0.f, 0.f, 0.f, 0.f};
    bf16x8 At[4][2], B0[2][2], B1[2][2];
    const char* cA = (const char*)g.A + cur.aoff; const char* cB = (const char*)g.Bt + cur.boff;
    S.a_ready(cur);
    if constexpr (SP2) {
        PG8_STAGE(PG8_SB(0, 0), cB, voffB); PG8_STAGE(PG8_SB(0, 1), cB + hB, voffB); PG8_STAGE(PG8_SA(0, 0), cA, voffA); PG8_STAGE(PG8_SA(0, 1), cA + hA, voffA);
        if (wr == 1) PG8_BAR;
        PG8_WAIT_V(2); PG8_BAR;
        PG8_STAGE(PG8_SB(1, 0), cB + kstep, voffB); PG8_STAGE(PG8_SA(1, 0), cA + kstep, voffA); PG8_STAGE(PG8_SB(1, 1), cB + hB + kstep, voffB);
        PG8_WAIT_V(6); PG8_BAR;
    } else {
        PG8_STAGE(PG8_SB(0, 0), cB, voffB); PG8_STAGE(PG8_SA(0, 0), cA, voffA); PG8_STAGE(PG8_SB(0, 1), cB + hB, voffB); PG8_STAGE(PG8_SA(0, 1), cA + hA, voffA);
        if (wr == 1) PG8_BAR;
        PG8_WAIT_V(4); PG8_BAR;
        PG8_STAGE(PG8_SB(1, 0), cB + kstep, voffB); PG8_STAGE(PG8_SA(1, 0), cA + kstep, voffA); PG8_STAGE(PG8_SB(1, 1), cB + hB + kstep, voffB);
        PG8_WAIT_V(6); PG8_BAR;
    }
    for (;;) {
        const bool has_next = S.next(ui + 1, nxt);
        const char* nA = has_next ? (const char*)g.A + nxt.aoff : cA; const char* nB = has_next ? (const char*)g.Bt + nxt.boff : cB;
        for (int t = 0; t < nt; t += 2) {
            const bool last = (t == nt - 2);
            const char* a1 = cA + (size_t)(t + 1) * kstep;
            const char* a2 = last ? nA : cA + (size_t)(t + 2) * kstep; const char* b2 = last ? nB : cB + (size_t)(t + 2) * kstep;
            const char* a3 = a2 + kstep; const char* b3 = b2 + kstep;
            if (last && has_next) S.a_ready(nxt);
            if constexpr (SP2) {
            PG8_LDB(B0, 0, 0); PG8_LDB(B1, 0, 1); PG8_SCHED; PG8_LDA(At, 0, 0); PG8_STAGE(PG8_SA(1, 1), a1 + hA, voffA);
            PG8_WAIT_V(8); PG8_WAIT_L(0); PG8_BAR; PG8_MMA(0, 0, At, B0); PG8_MMA(0, 1, At, B1); PG8_BAR; PG8_SCHED;
            PG8_LDA(At, 0, 1); PG8_STAGE(PG8_SB(0, 0), b2, voffB); PG8_STAGE(PG8_SB(0, 1), b2 + hB, voffB); PG8_STAGE(PG8_SA(0, 0), a2, voffA);
            PG8_WAIT_V(8); PG8_WAIT_L(0); PG8_BAR; PG8_MMA(1, 0, At, B0); PG8_MMA(1, 1, At, B1); PG8_BAR; PG8_SCHED;
            PG8_LDB(B0, 1, 0); PG8_LDB(B1, 1, 1); PG8_SCHED; PG8_LDA(At, 1, 0); PG8_STAGE(PG8_SA(0, 1), a2 + hA, voffA);
            PG8_WAIT_V(8); PG8_WAIT_L(0); PG8_BAR; PG8_MMA(0, 0, At, B0); PG8_MMA(0, 1, At, B1); PG8_BAR; PG8_SCHED;
            PG8_LDA(At, 1, 1); PG8_STAGE(PG8_SB(1, 0), b3, voffB); PG8_STAGE(PG8_SB(1, 1), b3 + hB, voffB); PG8_STAGE(PG8_SA(1, 0), a3, voffA);
            PG8_WAIT_V(8); PG8_WAIT_L(0); PG8_BAR; PG8_MMA(1, 0, At, B0); PG8_MMA(1, 1, At, B1); PG8_BAR; PG8_SCHED;
            } else {
            PG8_LDB(B0, 0, 0); PG8_SCHED; PG8_LDA(At, 0, 0); PG8_STAGE(PG8_SA(1, 1), a1 + hA, voffA);
            PG8_WAIT_L(8); PG8_BAR; PG8_WAIT_L(0); PG8_MMA(0, 0, At, B0); PG8_BAR; PG8_SCHED;
            PG8_LDB(B1, 0, 1); PG8_STAGE(PG8_SB(0, 0), b2, voffB);
            PG8_BAR; PG8_WAIT_L(0); PG8_MMA(0, 1, At, B1); PG8_BAR;
            PG8_LDA(At, 0, 1); PG8_STAGE(PG8_SA(0, 0), a2, voffA);
            PG8_BAR; PG8_WAIT_L(0); PG8_MMA(1, 0, At, B0); PG8_BAR; PG8_SCHED;
            PG8_STAGE(PG8_SB(0, 1), b2 + hB, voffB);
            PG8_WAIT_V(6); PG8_BAR; PG8_MMA(1, 1, At, B1); PG8_BAR;
            PG8_LDB(B0, 1, 0); PG8_SCHED; PG8_LDA(At, 1, 0); PG8_STAGE(PG8_SA(0, 1), a2 + hA, voffA);
            PG8_WAIT_L(8); PG8_BAR; PG8_WAIT_L(0); PG8_MMA(0, 0, At, B0); PG8_BAR; PG8_SCHED;
            PG8_LDB(B1, 1, 1); PG8_STAGE(PG8_SB(1, 0), b3, voffB);
            PG8_BAR; PG8_WAIT_L(0); PG8_MMA(0, 1, At, B1); PG8_BAR;
            PG8_LDA(At, 1, 1); PG8_STAGE(PG8_SA(1, 0), a3, voffA);
            PG8_BAR; PG8_WAIT_L(0); PG8_MMA(1, 0, At, B0); PG8_BAR; PG8_SCHED;
            PG8_STAGE(PG8_SB(1, 1), b3 + hB, voffB);
            PG8_WAIT_V(6); PG8_BAR; PG8_MMA(1, 1, At, B1); PG8_BAR;
            }
        }
        if constexpr (ALIGN_EPI) { if (wr == 0) PG8_BAR; }
        if constexpr (!Epi::AFTER_DRAIN) { E(acc, cur, wr, wc, fr, fq); S.done(cur); }
        if (!has_next) break;
#pragma unroll
        for (int a = 0; a < 2; ++a)
#pragma unroll
            for (int b = 0; b < 2; ++b)
#pragma unroll
                for (int m = 0; m < 4; ++m)
#pragma unroll
                    for (int n = 0; n < 2; ++n) acc[a][b][m][n] = (f32x4){0.f, 0.f, 0.f, 0.f};
        cur = nxt; cA = nA; cB = nB; ++ui;
        if constexpr (ALIGN_EPI) { if (wr == 1) PG8_BAR; }
    }
    PG8_WAIT_V(0);
    if constexpr (!ALIGN_EPI) { if (wr == 0) PG8_BAR; }
    PG8_BAR;
    if constexpr (Epi::AFTER_DRAIN) { E.fused(acc, cur, wr, wc, fr, fq, lds, wid, lane); S.done(cur); }
#undef PG8_SA
#undef PG8_SB
#undef PG8_STAGE
#undef PG8_LDA
#undef PG8_LDB
#undef PG8_MMA
#undef PG8_WAIT_V
#undef PG8_WAIT_L
#undef PG8_BAR
#undef PG8_SCHED
}
}
namespace pg8 {
struct EpiBf16P {
    static constexpr bool PERM = true, AFTER_DRAIN = false;
    bf16_t* O; int ldc; float sc;
    __device__ __forceinline__ void operator()(const f32x4 (&acc)[2][2][4][2], const Unit& u, int wr, int wc, int fr, int fq) const {
        const int row0 = u.pm * BM + wr * 64 + fr, col0 = u.pn * BM + wc * 32 + 8 * fq;
#pragma unroll
        for (int ai = 0; ai < 2; ++ai)
#pragma unroll
            for (int m = 0; m < 4; ++m) { bf16_t* rowp = O + (size_t)(row0 + ai * HALF + m * 16) * ldc + col0;
#pragma unroll
                for (int bj = 0; bj < 2; ++bj) { const f32x4 v0 = acc[ai][bj][m][0] * sc, v1 = acc[ai][bj][m][1] * sc;
                    u32x4 w; w.x = cvt_pk_bf16(v0[0], v0[1]); w.y = cvt_pk_bf16(v0[2], v0[3]); w.z = cvt_pk_bf16(v1[0], v1[1]); w.w = cvt_pk_bf16(v1[2], v1[3]);
                    *(u32x4*)(rowp + bj * HALF) = w; } }
    }
};
struct OneUnitOrder {
    int L, nN, lda, ldb;
    __device__ __forceinline__ bool next(int i, Unit& u) const {
        if (i != 0 || L < 0) return false;
        u.pm = L / nN; u.pn = L % nN; u.aoff = (size_t)u.pm * BM * lda * 2; u.boff = (size_t)u.pn * BM * ldb * 2; return true;
    }
    __device__ __forceinline__ void a_ready(const Unit&) const {}
    __device__ __forceinline__ void done(const Unit&) const {}
};
}

namespace pg8 {
}

namespace pg8 {
struct EpiBf16RowScale {
    static constexpr bool PERM = true, AFTER_DRAIN = false;
    bf16_t* O; int ldc; const float* ss; float eps;
    __device__ __forceinline__ void operator()(const f32x4 (&acc)[2][2][4][2], const Unit& u, int wr, int wc, int fr, int fq) const {
        const int row0 = u.pm * BM + wr * 64 + fr, col0 = u.pn * BM + wc * 32 + 8 * fq;
#pragma unroll
        for (int ai = 0; ai < 2; ++ai)
#pragma unroll
            for (int m = 0; m < 4; ++m) { const int row = row0 + ai * HALF + m * 16; const f32x4* sp = (const f32x4*)(ss + (size_t)row * 16);
                const f32x4 a = sp[0], b = sp[1], c = sp[2], d = sp[3];
                const float t = ((a[0] + a[1]) + (a[2] + a[3])) + ((b[0] + b[1]) + (b[2] + b[3])) + ((c[0] + c[1]) + (c[2] + c[3])) + ((d[0] + d[1]) + (d[2] + d[3]));
                const float rs = 1.0f / sqrtf(t * (1.0f / 1024.0f) + eps);
                bf16_t* rowp = O + (size_t)row * ldc + col0;
#pragma unroll
                for (int bj = 0; bj < 2; ++bj) { const f32x4 v0 = acc[ai][bj][m][0] * rs, v1 = acc[ai][bj][m][1] * rs;
                    u32x4 w; w.x = cvt_pk_bf16(v0[0], v0[1]); w.y = cvt_pk_bf16(v0[2], v0[3]); w.z = cvt_pk_bf16(v1[0], v1[1]); w.w = cvt_pk_bf16(v1[2], v1[3]);
                    *(u32x4*)(rowp + bj * HALF) = w; } }
    }
};
}

namespace pg8 {
template <bool BASE_BF16> struct EpiResB {
    static constexpr bool PERM = true, AFTER_DRAIN = false;
    const void* base; bf16_t* hb; float* ss; int ldc;
    __device__ __forceinline__ void operator()(const f32x4 (&acc)[2][2][4][2], const Unit& u, int wr, int wc, int fr, int fq) const {
        const int row0 = u.pm * BM + wr * 64 + fr, col0 = u.pn * BM + wc * 32 + 8 * fq;
#pragma unroll
        for (int ai = 0; ai < 2; ++ai)
#pragma unroll
            for (int m = 0; m < 4; ++m) { const int row = row0 + ai * HALF + m * 16; const size_t off = (size_t)row * ldc + col0; float s = 0.f;
#pragma unroll
                for (int bj = 0; bj < 2; ++bj) { f32x4 b0, b1;
                    if (BASE_BF16) { const u32x4 w = *(const u32x4*)((const bf16_t*)base + off + bj * HALF);
                        b0 = (f32x4){__uint_as_float(w.x << 16), __uint_as_float(w.x & 0xffff0000u), __uint_as_float(w.y << 16), __uint_as_float(w.y & 0xffff0000u)};
                        b1 = (f32x4){__uint_as_float(w.z << 16), __uint_as_float(w.z & 0xffff0000u), __uint_as_float(w.w << 16), __uint_as_float(w.w & 0xffff0000u)}; }
                    else { b0 = __builtin_nontemporal_load((const f32x4*)((const float*)base + off + bj * HALF)); b1 = __builtin_nontemporal_load((const f32x4*)((const float*)base + off + bj * HALF + 4)); }
                    const f32x4 x0 = b0 + acc[ai][bj][m][0], x1 = b1 + acc[ai][bj][m][1];
                    u32x4 w; w.x = cvt_pk_bf16(x0[0], x0[1]); w.y = cvt_pk_bf16(x0[2], x0[3]); w.z = cvt_pk_bf16(x1[0], x1[1]); w.w = cvt_pk_bf16(x1[2], x1[3]);
                    *(u32x4*)(hb + off + bj * HALF) = w;
                    s += ((x0[0] * x0[0] + x0[1] * x0[1]) + (x0[2] * x0[2] + x0[3] * x0[3])) + ((x1[0] * x1[0] + x1[1] * x1[1]) + (x1[2] * x1[2] + x1[3] * x1[3])); }
                s += __shfl_xor(s, 16); s += __shfl_xor(s, 32);
                if (fq == 0) ss[(size_t)row * 16 + u.pn * 4 + wc] = s; }
    }
};
}

constexpr int NWAVES = 8;
constexpr int BATCH = 8, SEQ = 2048, DM = 1024, M = BATCH * SEQ, MEMLEN = 256, MM = BATCH * MEMLEN;
constexpr int INCOLS = 3088;
constexpr int N1 = 3328;
constexpr int PQ = 0, PK = 256, PV = 512, POG = 1024, PSQ = 1536, PSK = 2048, PSV = 2560, PGATE = 3072;
constexpr int PEER_N = 16384;
constexpr float EPS = 1e-6f;

constexpr size_t MiB = 1u << 20;
constexpr size_t WS_CTL = 0, CTL_ZERO_BYTES = 1 * MiB;
constexpr size_t WS_W1T = 1 * MiB;
constexpr size_t WS_WOT = 8 * MiB, WS_WXQT = 10 * MiB, WS_WXOT = 12 * MiB, WS_WXKVT = 14 * MiB, WS_WPQT = 18 * MiB, WS_SUBK = 22 * MiB;
constexpr size_t WS_UB = 24 * MiB, WS_VB = 56 * MiB;
constexpr size_t WS_BUFA = 88 * MiB;
constexpr size_t WS_MN = 120 * MiB;
constexpr size_t WS_KV = 124 * MiB;
constexpr size_t WS_PROJ = 132 * MiB;
constexpr size_t WS_SLOT0 = 132 * MiB, WS_SLOT1 = 164 * MiB, WS_SLOT2 = 196 * MiB, WS_VT = 76 * MiB, WS_END = 236 * MiB;
constexpr int CW_BAR = 4096;
constexpr int CW_SBSS = 32768;

constexpr int RING_BYTES = 131072;
constexpr int LDSCTL_OFF = RING_BYTES, MISC_OFF = LDSCTL_OFF + 320;
constexpr int LDS_BYTES = 147456;

#define GAS __attribute__((address_space(1)))
#define LAS __attribute__((address_space(3)))
typedef unsigned short bf16;
typedef unsigned v4u __attribute__((ext_vector_type(4)));
typedef float f32x4 __attribute__((ext_vector_type(4)));
typedef short bf16x8 __attribute__((ext_vector_type(8)));
typedef GAS unsigned gu32;
typedef GAS unsigned long long gu64;
#define RLX_AGENT __ATOMIC_RELAXED, __HIP_MEMORY_SCOPE_AGENT
#define LDS_WAIT() asm volatile("s_waitcnt lgkmcnt(0)" ::: "memory")
#define VM_WAIT() asm volatile("s_waitcnt vmcnt(0)" ::: "memory")
__device__ __forceinline__ unsigned long long rt() { return __builtin_amdgcn_s_memrealtime(); }
__device__ __forceinline__ unsigned f2bf(float f) { unsigned u = __builtin_bit_cast(unsigned, f); return (u + 0x7fffu + ((u >> 16) & 1u)) >> 16; }
__device__ __forceinline__ unsigned pk2(float lo, float hi) { return f2bf(lo) | (f2bf(hi) << 16); }

#define XB_TMO      128
#define XB_XCNT(j)  (256  + 64 * (j))
#define XB_XSUB(j)  (1280 + 64 * (j))
#define XB_XGEN(j)  (2304 + 64 * (j))
#define XB_TOP      3328
#define XB_TOPGEN   3392
#define XCD_BAR_WORDS 3456
#define XB_SPIN_CAP (1u << 22)

__device__ __forceinline__ unsigned xb_ld(unsigned* p)              { return __hip_atomic_load(p, __ATOMIC_RELAXED, __HIP_MEMORY_SCOPE_AGENT); }
__device__ __forceinline__ unsigned xb_add(unsigned* p, unsigned v) { return __hip_atomic_fetch_add(p, v, __ATOMIC_RELAXED, __HIP_MEMORY_SCOPE_AGENT); }
__device__ __forceinline__ unsigned xb_xcc_id() { return (unsigned)__builtin_amdgcn_s_getreg((3 << 11) | 20) & 0xFu; }
#define XB_SPIN(cond, bar) do { unsigned _sp = 0; while (cond) { __builtin_amdgcn_s_sleep(1); \
    if ((++_sp & 255u) == 0u) { if (xb_ld(&(bar)[XB_TMO])) break; if (_sp > XB_SPIN_CAP) { atomicAdd(&(bar)[XB_TMO], 1u); break; } } } } while (0)

struct XcdBarrier {
    unsigned* bar; unsigned x;
    volatile LAS unsigned* st;
};

__device__ __forceinline__ XcdBarrier xcd_barrier_post(unsigned* bar, volatile LAS unsigned* st) {
    XcdBarrier b; b.bar = bar; b.x = xb_xcc_id(); b.st = st;
    if (threadIdx.x == 0) (void)xb_add(&bar[XB_XCNT(b.x)], 1u);
    return b;
}
__device__ __forceinline__ void xcd_barrier_complete(unsigned* bar, unsigned x, unsigned& nloc, unsigned& nx) {
    const unsigned G = gridDim.x * gridDim.y * gridDim.z;
    unsigned sum, cnt, mine, sp = 0u;
    for (;;) {
        sum = 0u; cnt = 0u; mine = 0u;
#pragma unroll
        for (unsigned j = 0; j < 16; ++j) { const unsigned c = xb_ld(&bar[XB_XCNT(j)]); sum += c; cnt += (c > 0u) ? 1u : 0u; mine = (j == x) ? c : mine; }
        if (sum == G) break;
        __builtin_amdgcn_s_sleep(1);
        if ((++sp & 255u) == 0u) { if (xb_ld(&bar[XB_TMO])) break; if (sp > XB_SPIN_CAP) { atomicAdd(&bar[XB_TMO], 1u); break; } }
    }
    nloc = mine > 0u ? mine : 1u; nx = cnt > 0u ? cnt : 1u;
}

__device__ __forceinline__ void xcd_barrier(const XcdBarrier& b) {
    asm volatile("s_waitcnt vmcnt(0)" ::: "memory");
    __syncthreads();
    if (threadIdx.x == 0) {
        unsigned* bar = b.bar;
        __builtin_amdgcn_s_waitcnt(0);
        unsigned nloc = b.st[0], nx = b.st[1];
        if (nloc == 0u) { xcd_barrier_complete(bar, b.x, nloc, nx); b.st[0] = nloc; b.st[1] = nx; }
        const unsigned old = xb_add(&bar[XB_XSUB(b.x)], 1u);
        const unsigned gen = old / nloc;
        if (old + 1u == (gen + 1u) * nloc) {
            __builtin_amdgcn_fence(__ATOMIC_RELEASE, "agent");
            asm volatile("s_waitcnt vmcnt(0)" ::: "memory");
            const unsigned og = xb_add(&bar[XB_TOP], 1u);
            const unsigned tg = og / nx;
            if (og + 1u == (tg + 1u) * nx) xb_add(&bar[XB_TOPGEN], 1u);
            else XB_SPIN(xb_ld(&bar[XB_TOPGEN]) == tg, bar);
            __builtin_amdgcn_fence(__ATOMIC_ACQUIRE, "agent");
            xb_add(&bar[XB_XGEN(b.x)], 1u);
            asm volatile("s_waitcnt vmcnt(0)" ::: "memory");
        } else {
            XB_SPIN(xb_ld(&bar[XB_XGEN(b.x)]) == gen, bar);
            __builtin_amdgcn_fence(__ATOMIC_ACQUIRE, "agent");
            asm volatile("s_waitcnt vmcnt(0)" ::: "memory");
        }
    }
    __syncthreads();
}

#define DI __device__ __forceinline__
typedef __bf16 bf16x2_t __attribute__((ext_vector_type(2)));
struct Args { const float* in[21]; float* out; unsigned char* ws; int ph_lo, ph_hi, li, pad; };
struct Frame {
    LAS unsigned char* lds;
    volatile LAS unsigned* MISC;
    gu32* ctl;
    int tid, lane, wave;
    int vcu, G;
    unsigned char* ws; float* out;
};
#define WSP(off) ((bf16*)(F.ws + (off)))
#define F_W1T WSP(WS_W1T)
#define F_WOT WSP(WS_WOT)
#define F_WXQT WSP(WS_WXQT)
#define F_WXOT WSP(WS_WXOT)
#define F_WXKVT WSP(WS_WXKVT)
#define F_WPQT WSP(WS_WPQT)
#define F_SUBK WSP(WS_SUBK)
#define F_UB WSP(WS_UB)
#define F_VB WSP(WS_VB)
#define F_BUFA WSP(WS_BUFA)
#define F_MN WSP(WS_MN)
#define F_KV WSP(WS_KV)
#define F_PROJ WSP(WS_PROJ)
#define F_SLOT0 WSP(WS_SLOT0)
#define F_SLOT1 WSP(WS_SLOT1)
#define F_SLOT2 WSP(WS_SLOT2)
#define F_VT WSP(WS_VT)
DI float bf2f(unsigned v) { return __uint_as_float(v << 16); }
DI float bflo(unsigned w) { return __uint_as_float(w << 16); }
DI float bfhi(unsigned w) { return __uint_as_float(w & 0xffff0000u); }
DI float wave_sum(float v) {
#pragma unroll
    for (int o = 1; o < 64; o <<= 1) v += __shfl_xor(v, o);
    return v;
}
DI float wave_max(float v) {
#pragma unroll
    for (int o = 1; o < 64; o <<= 1) v = fmaxf(v, __shfl_xor(v, o));
    return v;
}
DI float dot2_bf16(unsigned w, unsigned x, float a) { return __builtin_amdgcn_fdot2_f32_bf16(__builtin_bit_cast(bf16x2_t, w), __builtin_bit_cast(bf16x2_t, x), a, false); }
DI float silu_f(float x) { return x * __builtin_amdgcn_rcpf(1.f + __expf(-x)); }
DI float log_sigmoid_f(float z) { return fminf(z, 0.f) - __logf(1.f + __expf(-fabsf(z))); }
DI float gelu_tanh_f(float x) { const float y = 0.7978845608028654f * (x + 0.044715f * x * x * x); const float t = 1.f - 2.f / (1.f + __expf(2.f * y)); return 0.5f * x * (1.f + t); }

DI void p0_transpose_item(const float* W, int ldw, int c0, bf16* WT, int row_off, LAS float* scr, int kb, int nb, int lane, const float* kgain = nullptr) {
    const int k0 = 64 * kb, n0 = 32 * nb;
    float tv[32];
#pragma unroll
    for (int i = 0; i < 32; ++i) tv[i] = __builtin_nontemporal_load(W + (size_t)(k0 + 2 * i + (lane >> 5)) * ldw + c0 + n0 + (lane & 31));
    if (kgain) {
#pragma unroll
        for (int i = 0; i < 32; ++i) tv[i] *= kgain[k0 + 2 * i + (lane >> 5)];
    }
#pragma unroll
    for (int i = 0; i < 32; ++i) scr[(2 * i + (lane >> 5)) * 33 + (lane & 31)] = tv[i];
    LDS_WAIT(); asm volatile("" ::: "memory");
    const int c = lane & 7;
#pragma unroll
    for (int j = 0; j < 4; ++j) { const int n = (lane >> 3) + 8 * j; const LAS float* s = scr + (8 * c) * 33 + n;
        v4u o; o.x = pk2(s[0 * 33], s[1 * 33]); o.y = pk2(s[2 * 33], s[3 * 33]); o.z = pk2(s[4 * 33], s[5 * 33]); o.w = pk2(s[6 * 33], s[7 * 33]);
        *(GAS v4u*)(WT + (size_t)(row_off + n0 + n) * 1024 + k0 + 8 * c) = o; }
    LDS_WAIT(); asm volatile("" ::: "memory");
}
DI void rms_row_to_bf16(int lane, const float* xrow, const float* g, bf16* orow) {
    const GAS f32x4* xr = (const GAS f32x4*)xrow + lane; const GAS f32x4* gr = (const GAS f32x4*)g + lane;
    f32x4 v[4]; float s = 0.f;
#pragma unroll
    for (int j = 0; j < 4; ++j) { v[j] = __builtin_nontemporal_load(xr + 64 * j); s += (v[j].x * v[j].x + v[j].y * v[j].y) + (v[j].z * v[j].z + v[j].w * v[j].w); }
    const float rs = 1.f / sqrtf(wave_sum(s) * (1.f / 1024.f) + EPS);
    GAS unsigned long long* o8 = (GAS unsigned long long*)orow + lane;
#pragma unroll
    for (int j = 0; j < 4; ++j) { const f32x4 gg = gr[64 * j]; const f32x4 y = v[j] * rs * gg; o8[64 * j] = (unsigned long long)pk2(y.x, y.y) | ((unsigned long long)pk2(y.z, y.w) << 32); }
}
typedef float f32x2 __attribute__((ext_vector_type(2)));
constexpr size_t WS_U8 = 24 * MiB, WS_V8 = 40 * MiB, WS_X8 = 56 * MiB, WS_SU = 72 * MiB, WS_SX = 72 * MiB + 65536, WS_SV = 72 * MiB + 131072;
template <int CTRL> DI int dpp_i(int v) { return __builtin_amdgcn_update_dpp(0, v, CTRL, 0xf, 0xf, false); }
typedef float f32x16v __attribute__((ext_vector_type(16)));
typedef int i32x6v __attribute__((ext_vector_type(6)));
typedef unsigned u32x3v __attribute__((ext_vector_type(3)));
DI unsigned fp6_e2m3(float x) {
    const float m = fminf(fabsf(x), 7.5f);
    const int e = m >= 4.f ? 2 : m >= 2.f ? 1 : 0;
    const int q = (int)rintf(m * (e == 2 ? 2.f : e == 1 ? 4.f : 8.f));
    const unsigned code = e == 0 ? (unsigned)q : (unsigned)((e + 1) * 8 + (q - 8));
    return (x < 0.f ? 32u : 0u) | (code > 31u ? 31u : code);
}
template <int R> DI void rms_rows_to_bf16(int lane, const float* x0, size_t xstride, const float* g, bf16* o0, size_t ostride) {
    f32x4 v[R][4];
#pragma unroll
    for (int r = 0; r < R; ++r)
#pragma unroll
        for (int j = 0; j < 4; ++j) v[r][j] = __builtin_nontemporal_load((const GAS f32x4*)(x0 + r * xstride) + lane + 64 * j);
    f32x4 gg[4];
#pragma unroll
    for (int j = 0; j < 4; ++j) gg[j] = *((const GAS f32x4*)g + lane + 64 * j);
#pragma unroll
    for (int r = 0; r < R; ++r) { float s = 0.f;
#pragma unroll
        for (int j = 0; j < 4; ++j) s += (v[r][j].x * v[r][j].x + v[r][j].y * v[r][j].y) + (v[r][j].z * v[r][j].z + v[r][j].w * v[r][j].w);
        const float rs = 1.f / sqrtf(wave_sum(s) * (1.f / 1024.f) + EPS);
        GAS unsigned long long* o8 = (GAS unsigned long long*)(o0 + r * ostride) + lane;
#pragma unroll
        for (int j = 0; j < 4; ++j) { const f32x4 y = v[r][j] * rs * gg[j]; o8[64 * j] = (unsigned long long)pk2(y.x, y.y) | ((unsigned long long)pk2(y.z, y.w) << 32); } }
}
DI void p0_prologue(Frame& F, const Args& A) {
    LAS float* scr = (LAS float*)(F.lds + F.wave * 16384);
    const int gw = F.vcu * NWAVES + F.wave, NGW = F.G * NWAVES;
    constexpr int I_IN = 16 * 48, I_W2 = 16 * 64;
    constexpr int NIT = 2 * I_IN + I_W2;
    for (int it = gw; it < NIT; it += NGW) {
        int r = it;
        if (r < I_IN) { p0_transpose_item(A.in[3], INCOLS, 0, F_W1T, 0, scr, r / 48, r % 48, F.lane); continue; } r -= I_IN;
        if (r < I_IN) { p0_transpose_item(A.in[3], INCOLS, 1552, F_W1T, 1536, scr, r / 48, r % 48, F.lane); continue; } r -= I_IN;
        p0_transpose_item(A.in[13], 2048, 0, F_WXKVT, 0, scr, r / 64, r % 64, F.lane);
    }
    const int gt = gw * 64 + F.lane, NGT = NGW * 64;
    for (int i = gt; i < 256 * 128; i += NGT) {
        const int n = i >> 7, k0 = (i & 127) * 8;
        float gv[16];
#pragma unroll
        for (int r = 0; r < 16; ++r) gv[r] = A.in[5][r * 256 + n];
        float s[8];
#pragma unroll
        for (int j = 0; j < 8; ++j) { const float* wr_ = A.in[3] + (size_t)(k0 + j) * INCOLS + 1536; float a = 0.f;
#pragma unroll
            for (int r = 0; r < 16; ++r) a += wr_[r] * gv[r];
            s[j] = a; }
        v4u o; o.x = pk2(s[0], s[1]); o.y = pk2(s[2], s[3]); o.z = pk2(s[4], s[5]); o.w = pk2(s[6], s[7]);
        *(GAS v4u*)(F_W1T + (size_t)(3072 + n) * 1024 + k0) = o;
    }
    for (int m = 4 * gw; m < M; m += 4 * NGW) rms_rows_to_bf16<4>(F.lane, A.in[0] + (size_t)m * DM, DM, A.in[2], F_BUFA + (size_t)m * DM, DM);
    for (int m = gw; m < MM; m += NGW) rms_row_to_bf16(F.lane, A.in[1] + (size_t)m * DM, A.in[11], F_MN + (size_t)m * DM);
}
template <int R> DI void quant_rows_i8(int lane, const float* src, unsigned char* dst, float* scale_out) {
    f32x4 v[R][4];
#pragma unroll
    for (int r = 0; r < R; ++r)
#pragma unroll
        for (int j = 0; j < 4; ++j) v[r][j] = __builtin_nontemporal_load((const GAS f32x4*)(src + (size_t)r * 1024 + 256 * j + 4 * lane));
#pragma unroll
    for (int r = 0; r < R; ++r) { float m = 0.f;
#pragma unroll
        for (int j = 0; j < 4; ++j) m = fmaxf(m, fmaxf(fmaxf(fabsf(v[r][j].x), fabsf(v[r][j].y)), fmaxf(fabsf(v[r][j].z), fabsf(v[r][j].w))));
        m = wave_max(m);
        const float sc = m > 0.f ? m * (1.f / 127.f) : 1.f, inv = 1.f / sc;
        v4u o;
#pragma unroll
        for (int j = 0; j < 4; ++j) { const int a = (int)rintf(v[r][j].x * inv), b = (int)rintf(v[r][j].y * inv), c = (int)rintf(v[r][j].z * inv), d = (int)rintf(v[r][j].w * inv);
            o[j] = (unsigned)(a & 255) | ((unsigned)(b & 255) << 8) | ((unsigned)(c & 255) << 16) | ((unsigned)(d & 255) << 24); }
        *(GAS v4u*)(dst + (size_t)r * 1024 + 16 * lane) = o;
        if (lane == 0) scale_out[r] = sc; }
}
template <int R> DI void quant_rows_fp6(int lane, const float* src, unsigned char* dst, float* sc) {
    f32x4 t[R][4];
#pragma unroll
    for (int r = 0; r < R; ++r)
#pragma unroll
        for (int j = 0; j < 4; ++j) t[r][j] = __builtin_nontemporal_load((const GAS f32x4*)(src + (size_t)r * 1024 + 256 * j + 4 * lane));
#pragma unroll
    for (int r = 0; r < R; ++r) { float mx = 0.f;
#pragma unroll
        for (int j = 0; j < 4; ++j) mx = fmaxf(mx, fmaxf(fmaxf(fabsf(t[r][j].x), fabsf(t[r][j].y)), fmaxf(fabsf(t[r][j].z), fabsf(t[r][j].w))));
        mx = wave_max(mx);
        const float s_ = mx > 0.f ? mx * (1.f / 7.5f) : 1.f, inv = 1.f / s_;
        unsigned long long lo = 0ull; unsigned hi = 0u;
#pragma unroll
        for (int i = 0; i < 16; ++i) { const unsigned long long c = fp6_e2m3(t[r][i >> 2][i & 3] * inv);
            if (6 * i < 64) lo |= c << (6 * i);
            if (6 * i + 6 > 64) hi |= (unsigned)(6 * i >= 64 ? c << (6 * i - 64) : c >> (64 - 6 * i)); }
        *(GAS u32x3v*)(dst + (size_t)r * 768 + 12 * lane) = (u32x3v){(unsigned)lo, (unsigned)(lo >> 32), hi};
        if (lane == 0) sc[r] = s_; }
}
DI void p0_late(Frame& F, const Args& A, int widx, int nw) {
    LAS float* scr = (LAS float*)(F.lds + F.wave * 16384);
    constexpr int I_SQ = 16 * 32, I_W2 = 16 * 64;
    for (int it = widx; it < 3 * I_SQ + I_W2; it += nw) {
        int r = it;
        if (r < I_SQ) { p0_transpose_item(A.in[9], 1024, 0, F_WOT, 0, scr, r / 32, r % 32, F.lane); continue; } r -= I_SQ;
        if (r < I_SQ) { p0_transpose_item(A.in[12], 1024, 0, F_WXQT, 0, scr, r / 32, r % 32, F.lane, A.in[10]); continue; } r -= I_SQ;
        if (r < I_SQ) { p0_transpose_item(A.in[14], 1024, 0, F_WXOT, 0, scr, r / 32, r % 32, F.lane); continue; } r -= I_SQ;
        p0_transpose_item(A.in[16], 2048, 0, F_WPQT, 0, scr, r / 64, r % 64, F.lane, A.in[15]);
    }
    for (int i = widx * 64 + F.lane; i < 32768; i += nw * 64) {
        const f32x4 a = *(const GAS f32x4*)(A.in[17] + (size_t)i * 8), b = *(const GAS f32x4*)(A.in[17] + (size_t)i * 8 + 4);
        v4u o; o.x = pk2(a.x, a.y); o.y = pk2(a.z, a.w); o.z = pk2(b.x, b.y); o.w = pk2(b.z, b.w);
        *(GAS v4u*)(F_SUBK + (size_t)i * 8) = o;
    }
    for (int m = 4 * widx; m < PEER_N; m += 4 * nw) quant_rows_i8<4>(F.lane, A.in[18] + (size_t)m * DM, F.ws + WS_U8 + (size_t)m * 1024, (float*)(F.ws + WS_SU) + m);
    for (int m = 4 * widx; m < PEER_N; m += 4 * nw) quant_rows_fp6<4>(F.lane, A.in[19] + (size_t)m * DM, F.ws + WS_V8 + (size_t)m * 768, (float*)(F.ws + WS_SV) + m);
}

typedef float f32x16 __attribute__((ext_vector_type(16)));
typedef short s16x4 __attribute__((ext_vector_type(4)));
DI s16x4 lds_tr16(const LAS unsigned char* p) { return __builtin_bit_cast(s16x4, __builtin_amdgcn_ds_read_tr16_b64_v4i16((LAS s16x4*)p)); }
DI unsigned cvtpk_bf16(float lo, float hi) { typedef float f2 __attribute__((ext_vector_type(2))); f2 v = {lo, hi}; bf16x2_t b = __builtin_convertvector(v, bf16x2_t); return __builtin_bit_cast(unsigned, b); }
constexpr float SB_C2 = 0.125f * 1.4426950408889634f;
template <bool MASKED> DI void sb_weights(f32x16& P0, f32x16& P1, float& carry, int hi, int qrel2) {
    float T[8], cs[8];
#pragma unroll
    for (int pi = 0; pi < 2; ++pi) {
        f32x16& P = pi ? P1 : P0;
#pragma unroll
        for (int g = 0; g < 4; ++g) {
            float lbv[4], l1v[4];
#pragma unroll
            for (int i = 0; i < 4; ++i) {
                const float z2 = P[4 * g + i] * SB_C2;
                const float sp = __builtin_amdgcn_logf(1.f + __builtin_amdgcn_exp2f(-fabsf(z2)));
                float lb = fminf(z2, 0.f) - sp, l1 = lb - z2;
                if (MASKED) { const bool valid = (32 * pi + 8 * g + 4 * hi + i) < qrel2; lb = valid ? lb : -INFINITY; l1 = valid ? l1 : 0.f; }
                lbv[i] = lb; l1v[i] = l1;
            }
            const float a = l1v[3], b = a + l1v[2], c = b + l1v[1];
            cs[4 * pi + g] = c + l1v[0];
            P[4 * g + 3] = lbv[3]; P[4 * g + 2] = lbv[2] + a; P[4 * g + 1] = lbv[1] + b; P[4 * g + 0] = lbv[0] + c;
        }
    }
#pragma unroll
    for (int k = 0; k < 8; ++k) { auto rr = __builtin_amdgcn_permlane32_swap(__float_as_uint(cs[k]), __float_as_uint(cs[k]), false, false); T[k] = __uint_as_float(rr[0]) + __uint_as_float(rr[1]); }
    const float m0 = hi ? 0.f : 1.f;
    float run = carry;
#pragma unroll
    for (int k = 7; k >= 0; --k) {
        const float E = run + m0 * (T[k] - cs[k]);
        f32x16& P = (k >> 2) ? P1 : P0; const int g = k & 3;
#pragma unroll
        for (int i = 0; i < 4; ++i) P[4 * g + i] = __builtin_amdgcn_exp2f(P[4 * g + i] + E);
        run += T[k];
    }
    carry = run;
}
DI void sb_wave(Frame& F, float* OSB, int b, int h, int rb) {
    const int lane = F.lane, wid = F.wave, r32 = lane & 31, hi = lane >> 5;
    const size_t rowbase = (size_t)b * SEQ; const int wrow0 = rb * 32;
    const bf16* Kg = F_PROJ + rowbase * N1 + PSK + h * 64;
    const bf16* Vg = F_PROJ + rowbase * N1 + PSV + h * 64;
    bf16x8 qr[4];
    { const bf16* Qw = F_PROJ + (rowbase + wrow0 + r32) * N1 + PSQ + h * 64;
#pragma unroll
      for (int ks = 0; ks < 4; ++ks) qr[ks] = *(const GAS bf16x8*)(Qw + ks * 16 + hi * 8); }
    LAS unsigned char* vbuf = F.lds + wid * 16384;
    const int vfr = ((lane >> 4) & 1) * 32 + (lane & 3) * 8 + (4 * hi + ((lane & 15) >> 2)) * 64;
    const unsigned ko0 = (unsigned)(r32 * N1 + hi * 8) * 2u, ko1 = ko0 + 32u * N1 * 2u;
    unsigned vo[4];
#pragma unroll
    for (int i = 0; i < 4; ++i) vo[i] = (unsigned)(((lane >> 2) + 16 * i) * N1 + (lane & 3) * 8) * 2u;
    f32x16 o0 = {}, o1 = {};
    float carry = 0.f;
    int kt = (wrow0 + 30) >> 6;
    bf16x8 kf[8]; v4u vr[8];
#define SBW_LOADK(t) do { const char* kb_ = (const char*)Kg + (size_t)(t) * 64 * N1 * 2; _Pragma("unroll") for (int ks = 0; ks < 4; ++ks) { kf[2 * ks] = *(const GAS bf16x8*)(kb_ + ko0 + ks * 32); kf[2 * ks + 1] = *(const GAS bf16x8*)(kb_ + ko1 + ks * 32); } } while (0)
#define SBW_LOADV(t) do { const char* vb_ = (const char*)Vg + (size_t)(t) * 64 * N1 * 2; _Pragma("unroll") for (int p = 0; p < 8; ++p) vr[p] = *(const GAS v4u*)(vb_ + vo[p & 3] + (p >> 2) * 64); } while (0)
    SBW_LOADK(kt); SBW_LOADV(kt);
    int cur = 0;
    for (;;) {
        const int k0 = kt * 64;
#pragma unroll
        for (int p = 0; p < 8; ++p) *(LAS v4u*)(vbuf + cur * 8192 + p * 1024 + lane * 16) = vr[p];
        f32x16 P0 = {}, P1 = {};
#pragma unroll
        for (int ks = 0; ks < 4; ++ks) { P0 = __builtin_amdgcn_mfma_f32_32x32x16_bf16(kf[2 * ks], qr[ks], P0, 0, 0, 0); P1 = __builtin_amdgcn_mfma_f32_32x32x16_bf16(kf[2 * ks + 1], qr[ks], P1, 0, 0, 0); }
        __builtin_amdgcn_sched_barrier(0);
        if (kt > 0) SBW_LOADV(kt - 1);
        __builtin_amdgcn_sched_barrier(0);
        if (k0 + 63 >= wrow0) sb_weights<true>(P0, P1, carry, hi, wrow0 + r32 - k0);
        else sb_weights<false>(P0, P1, carry, hi, 0);
        __builtin_amdgcn_sched_barrier(0);
        if (kt > 0) SBW_LOADK(kt - 1);
        __builtin_amdgcn_sched_barrier(0);
        LDS_WAIT();
#pragma unroll
        for (int s = 0; s < 4; ++s) {
            const f32x16& P = (s >> 1) ? P1 : P0; const int rbb = (s & 1) * 8;
            v4u pw; pw.x = cvtpk_bf16(P[rbb + 0], P[rbb + 1]); pw.y = cvtpk_bf16(P[rbb + 2], P[rbb + 3]); pw.z = cvtpk_bf16(P[rbb + 4], P[rbb + 5]); pw.w = cvtpk_bf16(P[rbb + 6], P[rbb + 7]);
            const bf16x8 pa = __builtin_bit_cast(bf16x8, pw);
            const LAS unsigned char* vq = vbuf + cur * 8192 + vfr + s * 1024;
            const s16x4 l0 = lds_tr16(vq), h0 = lds_tr16(vq + 512), l1 = lds_tr16(vq + 4096), h1 = lds_tr16(vq + 4096 + 512);
            const bf16x8 v0 = {l0[0], l0[1], l0[2], l0[3], h0[0], h0[1], h0[2], h0[3]}, v1 = {l1[0], l1[1], l1[2], l1[3], h1[0], h1[1], h1[2], h1[3]};
            o0 = __builtin_amdgcn_mfma_f32_32x32x16_bf16(pa, v0, o0, 0, 0, 0);
            o1 = __builtin_amdgcn_mfma_f32_32x32x16_bf16(pa, v1, o1, 0, 0, 0);
        }
        if (kt == 0 || __all(carry < -160.f)) break;
        --kt; cur ^= 1;
    }
#undef SBW_LOADK
#undef SBW_LOADV
    {
        char* ub = (char*)(OSB + (rowbase + wrow0) * 512 + h * 64); const unsigned lo_ = (unsigned)(4 * hi * 512 + r32) * 4u;
#pragma unroll
        for (int r = 0; r < 16; ++r) { char* rp = ub + ((r & 3) + 8 * (r >> 2)) * 2048; *(GAS float*)(rp + lo_) = o0[r]; *(GAS float*)(rp + lo_ + 128) = o1[r]; }
    }
    LDS_WAIT();
}
constexpr int GL_CS = 1040;
constexpr int GL_QT = 0, GL_KT = 8320, GL_KD = 16384, GL_V = 28672, GL_ST = 49152, GL_SEG = 69632, GL_RED = 71680, GL_KDP = 192, GL_VP = 320;
constexpr int CW_DECAY = 65536;
template <bool ACC> DI bf16x8 tr_frag(const LAS unsigned char* base, int PB, int x0, int k0, int lane) {
    const int hi = lane >> 5, rr = (lane & 15) >> 2, col = x0 + 16 * ((lane >> 4) & 1) + 4 * (lane & 3);
    const int r0 = ACC ? (k0 + 4 * hi + rr) : (k0 + 8 * hi + rr), r1 = ACC ? (r0 + 8) : (r0 + 4);
    const s16x4 a = lds_tr16(base + r0 * PB + col * 2), b = lds_tr16(base + r1 * PB + col * 2);
    return (bf16x8){a[0], a[1], a[2], a[3], b[0], b[1], b[2], b[3]};
}
constexpr int GL_RQ = 73728, GL_RK = 82432, GL_RG = 91136, GL_RV = 99328;
DI void gla_stage_load(Frame& F, int b, int h, int n, v4u (&w)[6]) {
    const int tid = F.tid; const size_t row0 = (size_t)b * SEQ + 64 * n;
#pragma unroll
    for (int i = 0; i < 6; ++i) {
        const int c = tid + 512 * i;
        const int reg = (c >= 536) + (c >= 1072) + (c >= 1584);
        const int cc = c - (reg == 1 ? 536 : reg == 2 ? 1072 : reg == 3 ? 1584 : 0);
        const int rr = reg == 3 ? (cc >> 4) : (cc >> 3), ch = reg == 3 ? (cc & 15) : (cc & 7);
        const int r = rr + (reg == 2 ? 3 : 0);
        const int col = (reg == 0 ? PQ + h * 64 : reg == 1 ? PK + h * 64 : reg == 2 ? PGATE + h * 64 : PV + h * 128) + ch * 8;
        const bool ok = (c < 2656) && (64 * n - 3 + r >= 0);
        w[i] = (v4u){0u, 0u, 0u, 0u};
        if (ok) w[i] = *(const GAS v4u*)(F_PROJ + (row0 - 3 + r) * N1 + col);
    }
}
template <int MODE> DI void gla_prep(Frame& F, const Args& A, int b, int h, int n, const v4u (&w)[6]) {
    const int tid = F.tid, d = tid & 63, seg = tid >> 6;
    const float* cw = A.in[4];
    float wq[4], wk[4], wv[4];
#pragma unroll
    for (int k = 0; k < 4; ++k) { wq[k] = cw[k * 1024 + PQ + h * 64 + d]; wk[k] = cw[k * 1024 + PK + h * 64 + d]; wv[k] = cw[k * 1024 + PV + h * 128 + (tid & 127)]; }
    const float bias = A.in[6][h * 64 + d];
#pragma unroll
    for (int i = 0; i < 6; ++i) {
        const int c = tid + 512 * i;
        const int reg = (c >= 536) + (c >= 1072) + (c >= 1584);
        const int cc = c - (reg == 1 ? 536 : reg == 2 ? 1072 : reg == 3 ? 1584 : 0);
        const int rr = reg == 3 ? (cc >> 4) : (cc >> 3), ch = reg == 3 ? (cc & 15) : (cc & 7);
        const int lo_ = (reg == 0 ? GL_RQ : reg == 1 ? GL_RK : reg == 2 ? GL_RG : GL_RV) + rr * (reg == 3 ? 256 : 128) + ch * 16;
        if (c < 2656) *(LAS v4u*)(F.lds + lo_) = w[i];
    }
    __syncthreads();
    {
        float rq[11], rk[11], gl[8];
#pragma unroll
        for (int i = 0; i < 11; ++i) { rq[i] = bf2f(*(const LAS bf16*)(F.lds + GL_RQ + (8 * seg + i) * 128 + d * 2)); rk[i] = bf2f(*(const LAS bf16*)(F.lds + GL_RK + (8 * seg + i) * 128 + d * 2)); }
#pragma unroll
        for (int j = 0; j < 8; ++j) gl[j] = log_sigmoid_f(bf2f(*(const LAS bf16*)(F.lds + GL_RG + (8 * seg + j) * 128 + d * 2)) + bias) * (1.f / 16.f);
        float c = 0.f;
#pragma unroll
        for (int j = 0; j < 8; ++j) { c += gl[j]; gl[j] = c; }
        LAS float* SEG = (LAS float*)(F.lds + GL_SEG);
        SEG[seg * 64 + d] = c;
        __syncthreads();
        float pre = 0.f, tot = 0.f;
#pragma unroll
        for (int s = 0; s < 8; ++s) { const float v = SEG[s * 64 + d]; pre += (s < seg) ? v : 0.f; tot += v; }
#pragma unroll
        for (int j = 0; j < 8; ++j) {
            const int tok = 8 * seg + j; const float cum = pre + gl[j];
            const float qc = silu_f(wq[0] * rq[j] + wq[1] * rq[j + 1] + wq[2] * rq[j + 2] + wq[3] * rq[j + 3]);
            const float kc = silu_f(wk[0] * rk[j] + wk[1] * rk[j + 1] + wk[2] * rk[j + 2] + wk[3] * rk[j + 3]);
            if (MODE == 0) { *(LAS bf16*)(F.lds + GL_KD + tok * GL_KDP + d * 2) = (bf16)f2bf(kc * __expf(tot - cum)); }
            else { const int off = (d >> 3) * GL_CS + tok * 16 + (d & 7) * 2;
                *(LAS bf16*)(F.lds + GL_QT + off) = (bf16)f2bf(qc * 0.125f * __expf(cum)); *(LAS bf16*)(F.lds + GL_KT + off) = (bf16)f2bf(kc * __expf(-cum)); }
        }
        if (MODE == 0 && seg == 0) ((float*)(F.ctl + CW_DECAY))[((size_t)(b * 4 + h) * 32 + n) * 64 + d] = __expf(tot);
    }
    {
        const int e = tid & 127, s4 = tid >> 7;
        float rv[19];
#pragma unroll
        for (int i = 0; i < 19; ++i) rv[i] = bf2f(*(const LAS bf16*)(F.lds + GL_RV + (16 * s4 + i) * 256 + e * 2));
#pragma unroll
        for (int j = 0; j < 16; ++j) *(LAS bf16*)(F.lds + GL_V + (16 * s4 + j) * GL_VP + e * 2) = (bf16)f2bf(silu_f(wv[0] * rv[j] + wv[1] * rv[j + 1] + wv[2] * rv[j + 2] + wv[3] * rv[j + 3]));
    }
}
DI void gla_local_unit(Frame& F, const Args& A, bf16* STW, int b, int h, int n, v4u (&w)[6], int nb, int nh, int nn) {
    __syncthreads();
    gla_prep<0>(F, A, b, h, n, w);
    gla_stage_load(F, nb, nh, nn, w);
    __syncthreads();
    const int lane = F.lane, wid = F.wave, dt = wid & 1, et = wid >> 1, r32 = lane & 31, hi = lane >> 5;
    f32x16 acc = {};
#pragma unroll
    for (int ks = 0; ks < 4; ++ks) {
        const bf16x8 af = tr_frag<false>(F.lds + GL_KD, GL_KDP, 32 * dt, 16 * ks, lane), bfr = tr_frag<false>(F.lds + GL_V, GL_VP, 32 * et, 16 * ks, lane);
        acc = __builtin_amdgcn_mfma_f32_32x32x16_bf16(af, bfr, acc, 0, 0, 0);
    }
    bf16* o = STW + (((size_t)(b * 4 + h) * 32 + n) * 64 + 32 * dt) * 128 + 32 * et + r32;
#pragma unroll
    for (int r = 0; r < 16; ++r) o[(size_t)((r & 3) + 8 * (r >> 2) + 4 * hi) * 128] = (bf16)f2bf(acc[r]);
}
DI void gla_out_unit(Frame& F, const Args& A, const bf16* STW, int b, int h, int n, v4u (&w)[6], int nb, int nh, int nn) {
    v4u stv[2];
    { const bf16* sp = STW + ((size_t)(b * 4 + h) * 32 + n) * 64 * 128;
#pragma unroll
      for (int i = 0; i < 2; ++i) stv[i] = *(const GAS v4u*)(sp + (F.tid + i * 512) * 8); }
    __syncthreads();
    gla_prep<1>(F, A, b, h, n, w);
    gla_stage_load(F, nb, nh, nn, w);
#pragma unroll
    for (int i = 0; i < 2; ++i) { const int idx = (F.tid + i * 512) * 8, dd = idx >> 7, ee = idx & 127;
        *(LAS v4u*)(F.lds + GL_ST + dd * GL_VP + ee * 2) = stv[i]; }
    __syncthreads();
    const int lane = F.lane, wid = F.wave, it = wid & 1, et = wid >> 1, r32 = lane & 31, hi = lane >> 5;
    f32x16 acc = {};
    bf16x8 qf[4];
#pragma unroll
    for (int ks = 0; ks < 4; ++ks) qf[ks] = *(const LAS bf16x8*)(F.lds + GL_QT + (2 * ks + hi) * GL_CS + (32 * it + r32) * 16);
#pragma unroll
    for (int ks = 0; ks < 4; ++ks) acc = __builtin_amdgcn_mfma_f32_32x32x16_bf16(tr_frag<false>(F.lds + GL_ST, GL_VP, 32 * et, 16 * ks, lane), qf[ks], acc, 0, 0, 0);
    for (int jt = 0; jt <= it; ++jt) {
        f32x16 S = {};
#pragma unroll
        for (int ks = 0; ks < 4; ++ks) S = __builtin_amdgcn_mfma_f32_32x32x16_bf16(*(const LAS bf16x8*)(F.lds + GL_KT + (2 * ks + hi) * GL_CS + (32 * jt + r32) * 16), qf[ks], S, 0, 0, 0);
        if (jt == it) {
#pragma unroll
            for (int r = 0; r < 16; ++r) S[r] = ((r & 3) + 8 * (r >> 2) + 4 * hi) <= r32 ? S[r] : 0.f;
        }
#pragma unroll
        for (int s = 0; s < 2; ++s) {
            v4u pw; pw.x = cvtpk_bf16(S[8 * s + 0], S[8 * s + 1]); pw.y = cvtpk_bf16(S[8 * s + 2], S[8 * s + 3]); pw.z = cvtpk_bf16(S[8 * s + 4], S[8 * s + 5]); pw.w = cvtpk_bf16(S[8 * s + 6], S[8 * s + 7]);
            acc = __builtin_amdgcn_mfma_f32_32x32x16_bf16(tr_frag<true>(F.lds + GL_V, GL_VP, 32 * et, 32 * jt + 16 * s, lane), __builtin_bit_cast(bf16x8, pw), acc, 0, 0, 0);
        }
    }
    float ss = 0.f;
#pragma unroll
    for (int r = 0; r < 16; ++r) ss += acc[r] * acc[r];
    { auto rr = __builtin_amdgcn_permlane32_swap(__float_as_uint(ss), __float_as_uint(ss), false, false); ss = __uint_as_float(rr[0]) + __uint_as_float(rr[1]); }
    LAS float* RED = (LAS float*)(F.lds + GL_RED);
    if (hi == 0) RED[wid * 32 + r32] = ss;
    __syncthreads();
    const float tot = RED[(it + 0) * 32 + r32] + RED[(it + 2) * 32 + r32] + RED[(it + 4) * 32 + r32] + RED[(it + 6) * 32 + r32];
    const float rs = 1.f / sqrtf(tot * (1.f / 128.f) + EPS);
    const size_t row = (size_t)b * SEQ + 64 * n + 32 * it + r32;
    const float* gg = A.in[7];
#pragma unroll
    for (int g = 0; g < 4; ++g) {
        const int e0 = 32 * et + 8 * g + 4 * hi;
        const unsigned long long ogw = *(const GAS unsigned long long*)(F_PROJ + row * N1 + POG + h * 128 + e0);
        const unsigned lo = (unsigned)ogw, hi2 = (unsigned)(ogw >> 32);
        const f32x4 gv = *(const GAS f32x4*)(gg + e0);
        const float y0 = acc[4 * g + 0] * rs * gv.x * silu_f(bflo(lo)), y1 = acc[4 * g + 1] * rs * gv.y * silu_f(bfhi(lo)), y2 = acc[4 * g + 2] * rs * gv.z * silu_f(bflo(hi2)), y3 = acc[4 * g + 3] * rs * gv.w * silu_f(bfhi(hi2));
        *(GAS unsigned long long*)(F_BUFA + row * 1024 + h * 128 + e0) = (unsigned long long)pk2(y0, y1) | ((unsigned long long)pk2(y2, y3) << 32);
    }
}
DI void xattn_unit(Frame& F, const bf16* Q, bf16* O, int b, int h, int qb) {
    const int tid = F.tid, lane = F.lane, wid = F.wave, r32 = lane & 31, hi = lane >> 5;
    const bf16* Kg = F_KV + (size_t)(b * 256) * 2048 + h * 256;
    const bf16* Vg = Kg + 1024;
    const size_t row = (size_t)b * SEQ + qb * 256 + wid * 32 + r32;
    __syncthreads();
    {
        const bf16* kp = Kg + (size_t)(tid >> 5) * 2048 + (tid & 31) * 8; LAS unsigned char* kl = F.lds + (tid & 31) * 4096 + (tid >> 5) * 16;
#pragma unroll 8
        for (int i = 0; i < 16; ++i) { *(LAS v4u*)(kl) = *(const GAS v4u*)(kp); kp += 16 * 2048; kl += 256; }
    }
    bf16x8 qf[16];
#pragma unroll
    for (int ks = 0; ks < 16; ++ks) qf[ks] = *(const GAS bf16x8*)(Q + row * 1024 + h * 256 + 16 * ks + 8 * hi);
    __syncthreads();
    f32x16 S[8];
#pragma unroll
    for (int mt = 0; mt < 8; ++mt) { S[mt] = (f32x16){};
#pragma unroll
        for (int k4 = 0; k4 < 4; ++k4) {
#pragma unroll
            for (int kk = 0; kk < 4; ++kk) { const int ks = 4 * k4 + kk; S[mt] = __builtin_amdgcn_mfma_f32_32x32x16_bf16(*(const LAS bf16x8*)(F.lds + (2 * ks + hi) * 4096 + (32 * mt + r32) * 16), qf[ks], S[mt], 0, 0, 0); }
            __builtin_amdgcn_sched_barrier(0); } }
    float mx = -INFINITY;
#pragma unroll
    for (int mt = 0; mt < 8; ++mt)
#pragma unroll
        for (int r = 0; r < 16; ++r) mx = fmaxf(mx, S[mt][r]);
    { auto rr = __builtin_amdgcn_permlane32_swap(__float_as_uint(mx), __float_as_uint(mx), false, false); mx = fmaxf(__uint_as_float(rr[0]), __uint_as_float(rr[1])); }
    const float c2 = 0.0625f * 1.4426950408889634f; const float mb = mx * c2;
    float sum = 0.f;
#pragma unroll
    for (int mt = 0; mt < 8; ++mt)
#pragma unroll
        for (int r = 0; r < 16; ++r) { const float p = __builtin_amdgcn_exp2f(S[mt][r] * c2 - mb); S[mt][r] = p; sum += p; }
    { auto rr = __builtin_amdgcn_permlane32_swap(__float_as_uint(sum), __float_as_uint(sum), false, false); sum = __uint_as_float(rr[0]) + __uint_as_float(rr[1]); }
    const float linv = 1.f / sum;
    v4u pa[16];
#pragma unroll
    for (int mt = 0; mt < 8; ++mt)
#pragma unroll
        for (int s = 0; s < 2; ++s) { v4u pw; pw.x = cvtpk_bf16(S[mt][8 * s + 0] * linv, S[mt][8 * s + 1] * linv); pw.y = cvtpk_bf16(S[mt][8 * s + 2] * linv, S[mt][8 * s + 3] * linv);
            pw.z = cvtpk_bf16(S[mt][8 * s + 4] * linv, S[mt][8 * s + 5] * linv); pw.w = cvtpk_bf16(S[mt][8 * s + 6] * linv, S[mt][8 * s + 7] * linv); pa[2 * mt + s] = pw; }
    __syncthreads();
    {
        const int c = tid & 31, m0 = tid >> 5;
        const bf16* vp = Vg + (size_t)m0 * 2048 + c * 8; LAS unsigned char* vl = F.lds + (c >> 2) * 16384 + m0 * 64 + (c & 3) * 16;
#pragma unroll 8
        for (int i = 0; i < 16; ++i) { *(LAS v4u*)(vl) = *(const GAS v4u*)(vp); vp += 16 * 2048; vl += 1024; }
    }
    __syncthreads();
    const int vfr = ((lane >> 4) & 1) * 32 + (lane & 3) * 8 + (4 * hi + ((lane & 15) >> 2)) * 64;
    unsigned opk[4][16];
#pragma unroll
    for (int dp = 0; dp < 4; ++dp) {
        f32x16 a0 = {}, a1 = {};
#pragma unroll
        for (int s = 0; s < 16; ++s) {
            const LAS unsigned char* vp0 = F.lds + (2 * dp) * 16384 + s * 1024 + vfr; const LAS unsigned char* vp1 = vp0 + 16384;
            const s16x4 l0 = lds_tr16(vp0), h0 = lds_tr16(vp0 + 512), l1 = lds_tr16(vp1), h1 = lds_tr16(vp1 + 512);
            const bf16x8 v0 = {l0[0], l0[1], l0[2], l0[3], h0[0], h0[1], h0[2], h0[3]}, v1 = {l1[0], l1[1], l1[2], l1[3], h1[0], h1[1], h1[2], h1[3]};
            a0 = __builtin_amdgcn_mfma_f32_32x32x16_bf16(__builtin_bit_cast(bf16x8, pa[s]), v0, a0, 0, 0, 0);
            a1 = __builtin_amdgcn_mfma_f32_32x32x16_bf16(__builtin_bit_cast(bf16x8, pa[s]), v1, a1, 0, 0, 0);
            if ((s & 3) == 3) __builtin_amdgcn_sched_barrier(0);
        }
#pragma unroll
        for (int r = 0; r < 16; ++r) opk[dp][r] = cvtpk_bf16(a0[r], a1[r]);
        __builtin_amdgcn_sched_barrier(0);
    }
    __syncthreads();
    LAS bf16* stg = (LAS bf16*)(F.lds + wid * 16384);
#pragma unroll
    for (int dp = 0; dp < 4; ++dp)
#pragma unroll
        for (int r = 0; r < 16; ++r) { const int rr = (r & 3) + 8 * (r >> 2) + 4 * hi; stg[rr * 256 + dp * 64 + r32] = (bf16)(opk[dp][r] & 0xffffu); stg[rr * 256 + dp * 64 + 32 + r32] = (bf16)(opk[dp][r] >> 16); }
    LDS_WAIT(); asm volatile("" ::: "memory");
    bf16* Ow = O + ((size_t)b * SEQ + qb * 256 + wid * 32) * 1024 + h * 256;
    {
        bf16* op = Ow + (size_t)(lane >> 5) * 1024 + (lane & 31) * 8; const LAS bf16* sp = stg + (lane >> 5) * 256 + (lane & 31) * 8;
#pragma unroll 4
        for (int i = 0; i < 16; ++i) { *(GAS v4u*)(op) = *(const LAS v4u*)(sp); op += 2 * 1024; sp += 2 * 256; }
    }
    LDS_WAIT(); asm volatile("" ::: "memory");
}
template <int R> DI void mix_rows_sb(Frame& F, const Args& A, const float* OSB, size_t row) {
    const int lane = F.lane;
    f32x4 b0[R], b1[R];
#pragma unroll
    for (int r = 0; r < R; ++r) { b0[r] = __builtin_nontemporal_load((const GAS f32x4*)(OSB + (row + r) * 512 + 8 * lane)); b1[r] = __builtin_nontemporal_load((const GAS f32x4*)(OSB + (row + r) * 512 + 8 * lane + 4)); }
    const f32x4 h0 = *(const GAS f32x4*)(A.in[8] + 8 * lane), h1 = *(const GAS f32x4*)(A.in[8] + 8 * lane + 4);
#pragma unroll
    for (int r = 0; r < R; ++r) {
        const float s2 = (b0[r].x * b0[r].x + b0[r].y * b0[r].y) + (b0[r].z * b0[r].z + b0[r].w * b0[r].w) + (b1[r].x * b1[r].x + b1[r].y * b1[r].y) + (b1[r].z * b1[r].z + b1[r].w * b1[r].w);
        const float rs2 = 1.f / sqrtf(wave_sum(s2) * (1.f / 512.f) + EPS);
        v4u p;
        p.x = pk2(b0[r].x * rs2 * h0.x, b0[r].y * rs2 * h0.y); p.y = pk2(b0[r].z * rs2 * h0.z, b0[r].w * rs2 * h0.w);
        p.z = pk2(b1[r].x * rs2 * h1.x, b1[r].y * rs2 * h1.y); p.w = pk2(b1[r].z * rs2 * h1.z, b1[r].w * rs2 * h1.w);
        *(GAS v4u*)(F_BUFA + (row + r) * 1024 + 512 + 8 * lane) = p; }
}
DI void gla_scan(Frame& F, bf16* STW) {
    const int gt = (F.vcu * NWAVES + F.wave) * 64 + F.lane, NGT = F.G * NWAVES * 64;
    const float* dec = (const float*)(F.ctl + CW_DECAY);
    for (int idx = gt; idx < 32 * 4096; idx += NGT) {
        const int bh = idx >> 12, de = (idx & 4095) * 2, d = de >> 7;
        unsigned* p = (unsigned*)(STW + (size_t)bh * 32 * 8192 + de); const float* dp = dec + (size_t)bh * 32 * 64 + d;
        unsigned tmp[32]; float dc[32];
#pragma unroll
        for (int n = 0; n < 32; ++n) { tmp[n] = p[(size_t)n * 4096]; dc[n] = dp[n * 64]; }
        float s0 = 0.f, s1 = 0.f;
#pragma unroll
        for (int n = 0; n < 32; ++n) { p[(size_t)n * 4096] = pk2(s0, s1); s0 = dc[n] * s0 + bflo(tmp[n]); s1 = dc[n] * s1 + bfhi(tmp[n]); }
    }
}
DI float vmaxf(float a, float b) { float r; asm("v_max_f32_e32 %0, %1, %2" : "=v"(r) : "v"(a), "v"(b)); return r; }
DI float vminf(float a, float b) { float r; asm("v_min_f32_e32 %0, %1, %2" : "=v"(r) : "v"(a), "v"(b)); return r; }
#define CE(a, b) do { const float h_ = vmaxf(a, b); const float l_ = vminf(a, b); a = h_; b = l_; } while (0)
DI void sort16_desc(float (&v)[16]) { const float h0 = vmaxf(v[0], v[1]); const float h1 = vmaxf(v[2], v[3]); const float h2 = vmaxf(v[4], v[5]); const float h3 = vmaxf(v[6], v[7]); const float h4 = vmaxf(v[8], v[9]); const float h5 = vmaxf(v[10], v[11]); const float h6 = vmaxf(v[12], v[13]); const float h7 = vmaxf(v[14], v[15]); v[1] = vminf(v[0], v[1]); v[3] = vminf(v[2], v[3]); v[5] = vminf(v[4], v[5]); v[7] = vminf(v[6], v[7]); v[9] = vminf(v[8], v[9]); v[11] = vminf(v[10], v[11]); v[13] = vminf(v[12], v[13]); v[15] = vminf(v[14], v[15]); v[0] = h0; v[2] = h1; v[4] = h2; v[6] = h3; v[8] = h4; v[10] = h5; v[12] = h6; v[14] = h7; const float h8 = vmaxf(v[0], v[2]); const float h9 = vmaxf(v[1], v[3]); const float h10 = vmaxf(v[4], v[6]); const float h11 = vmaxf(v[5], v[7]); const float h12 = vmaxf(v[8], v[10]); const float h13 = vmaxf(v[9], v[11]); const float h14 = vmaxf(v[12], v[14]); const float h15 = vmaxf(v[13], v[15]); v[2] = vminf(v[0], v[2]); v[3] = vminf(v[1], v[3]); v[6] = vminf(v[4], v[6]); v[7] = vminf(v[5], v[7]); v[10] = vminf(v[8], v[10]); v[11] = vminf(v[9], v[11]); v[14] = vminf(v[12], v[14]); v[15] = vminf(v[13], v[15]); v[0] = h8; v[1] = h9; v[4] = h10; v[5] = h11; v[8] = h12; v[9] = h13; v[12] = h14; v[13] = h15; const float h16 = vmaxf(v[1], v[2]); const float h17 = vmaxf(v[5], v[6]); const float h18 = vmaxf(v[0], v[4]); const float h19 = vmaxf(v[3], v[7]); const float h20 = vmaxf(v[9], v[10]); const float h21 = vmaxf(v[13], v[14]); const float h22 = vmaxf(v[8], v[12]); const float h23 = vmaxf(v[11], v[15]); v[2] = vminf(v[1], v[2]); v[6] = vminf(v[5], v[6]); v[4] = vminf(v[0], v[4]); v[7] = vminf(v[3], v[7]); v[10] = vminf(v[9], v[10]); v[14] = vminf(v[13], v[14]); v[12] = vminf(v[8], v[12]); v[15] = vminf(v[11], v[15]); v[1] = h16; v[5] = h17; v[0] = h18; v[3] = h19; v[9] = h20; v[13] = h21; v[8] = h22; v[11] = h23; const float h24 = vmaxf(v[2], v[6]); const float h25 = vmaxf(v[1], v[5]); const float h26 = vmaxf(v[10], v[14]); const float h27 = vmaxf(v[9], v[13]); const float h28 = vmaxf(v[0], v[8]); const float h29 = vmaxf(v[7], v[15]); v[6] = vminf(v[2], v[6]); v[5] = vminf(v[1], v[5]); v[14] = vminf(v[10], v[14]); v[13] = vminf(v[9], v[13]); v[8] = vminf(v[0], v[8]); v[15] = vminf(v[7], v[15]); v[2] = h24; v[1] = h25; v[10] = h26; v[9] = h27; v[0] = h28; v[7] = h29; const float h30 = vmaxf(v[2], v[4]); const float h31 = vmaxf(v[3], v[5]); const float h32 = vmaxf(v[10], v[12]); const float h33 = vmaxf(v[11], v[13]); v[4] = vminf(v[2], v[4]); v[5] = vminf(v[3], v[5]); v[12] = vminf(v[10], v[12]); v[13] = vminf(v[11], v[13]); v[2] = h30; v[3] = h31; v[10] = h32; v[11] = h33; const float h34 = vmaxf(v[1], v[2]); const float h35 = vmaxf(v[3], v[4]); const float h36 = vmaxf(v[5], v[6]); const float h37 = vmaxf(v[9], v[10]); const float h38 = vmaxf(v[11], v[12]); const float h39 = vmaxf(v[13], v[14]); v[2] = vminf(v[1], v[2]); v[4] = vminf(v[3], v[4]); v[6] = vminf(v[5], v[6]); v[10] = vminf(v[9], v[10]); v[12] = vminf(v[11], v[12]); v[14] = vminf(v[13], v[14]); v[1] = h34; v[3] = h35; v[5] = h36; v[9] = h37; v[11] = h38; v[13] = h39; const float h40 = vmaxf(v[4], v[12]); const float h41 = vmaxf(v[2], v[10]); const float h42 = vmaxf(v[6], v[14]); const float h43 = vmaxf(v[1], v[9]); const float h44 = vmaxf(v[5], v[13]); const float h45 = vmaxf(v[3], v[11]); v[12] = vminf(v[4], v[12]); v[10] = vminf(v[2], v[10]); v[14] = vminf(v[6], v[14]); v[9] = vminf(v[1], v[9]); v[13] = vminf(v[5], v[13]); v[11] = vminf(v[3], v[11]); v[4] = h40; v[2] = h41; v[6] = h42; v[1] = h43; v[5] = h44; v[3] = h45; const float h46 = vmaxf(v[4], v[8]); const float h47 = vmaxf(v[6], v[10]); const float h48 = vmaxf(v[5], v[9]); const float h49 = vmaxf(v[7], v[11]); v[8] = vminf(v[4], v[8]); v[10] = vminf(v[6], v[10]); v[9] = vminf(v[5], v[9]); v[11] = vminf(v[7], v[11]); v[4] = h46; v[6] = h47; v[5] = h48; v[7] = h49; const float h50 = vmaxf(v[2], v[4]); const float h51 = vmaxf(v[6], v[8]); const float h52 = vmaxf(v[10], v[12]); const float h53 = vmaxf(v[3], v[5]); const float h54 = vmaxf(v[7], v[9]); const float h55 = vmaxf(v[11], v[13]); v[4] = vminf(v[2], v[4]); v[8] = vminf(v[6], v[8]); v[12] = vminf(v[10], v[12]); v[5] = vminf(v[3], v[5]); v[9] = vminf(v[7], v[9]); v[13] = vminf(v[11], v[13]); v[2] = h50; v[6] = h51; v[10] = h52; v[3] = h53; v[7] = h54; v[11] = h55; const float h56 = vmaxf(v[1], v[2]); const float h57 = vmaxf(v[3], v[4]); const float h58 = vmaxf(v[5], v[6]); const float h59 = vmaxf(v[7], v[8]); const float h60 = vmaxf(v[9], v[10]); const float h61 = vmaxf(v[11], v[12]); const float h62 = vmaxf(v[13], v[14]); v[2] = vminf(v[1], v[2]); v[4] = vminf(v[3], v[4]); v[6] = vminf(v[5], v[6]); v[8] = vminf(v[7], v[8]); v[10] = vminf(v[9], v[10]); v[12] = vminf(v[11], v[12]); v[14] = vminf(v[13], v[14]); v[1] = h56; v[3] = h57; v[5] = h58; v[7] = h59; v[9] = h60; v[11] = h61; v[13] = h62; }
DI void bmerge16_desc(float (&v)[16]) { const float h0 = vmaxf(v[0], v[8]); const float h1 = vmaxf(v[1], v[9]); const float h2 = vmaxf(v[2], v[10]); const float h3 = vmaxf(v[3], v[11]); const float h4 = vmaxf(v[4], v[12]); const float h5 = vmaxf(v[5], v[13]); const float h6 = vmaxf(v[6], v[14]); const float h7 = vmaxf(v[7], v[15]); v[8] = vminf(v[0], v[8]); v[9] = vminf(v[1], v[9]); v[10] = vminf(v[2], v[10]); v[11] = vminf(v[3], v[11]); v[12] = vminf(v[4], v[12]); v[13] = vminf(v[5], v[13]); v[14] = vminf(v[6], v[14]); v[15] = vminf(v[7], v[15]); v[0] = h0; v[1] = h1; v[2] = h2; v[3] = h3; v[4] = h4; v[5] = h5; v[6] = h6; v[7] = h7; const float h8 = vmaxf(v[0], v[4]); const float h9 = vmaxf(v[1], v[5]); const float h10 = vmaxf(v[2], v[6]); const float h11 = vmaxf(v[3], v[7]); const float h12 = vmaxf(v[8], v[12]); const float h13 = vmaxf(v[9], v[13]); const float h14 = vmaxf(v[10], v[14]); const float h15 = vmaxf(v[11], v[15]); v[4] = vminf(v[0], v[4]); v[5] = vminf(v[1], v[5]); v[6] = vminf(v[2], v[6]); v[7] = vminf(v[3], v[7]); v[12] = vminf(v[8], v[12]); v[13] = vminf(v[9], v[13]); v[14] = vminf(v[10], v[14]); v[15] = vminf(v[11], v[15]); v[0] = h8; v[1] = h9; v[2] = h10; v[3] = h11; v[8] = h12; v[9] = h13; v[10] = h14; v[11] = h15; const float h16 = vmaxf(v[0], v[2]); const float h17 = vmaxf(v[1], v[3]); const float h18 = vmaxf(v[4], v[6]); const float h19 = vmaxf(v[5], v[7]); const float h20 = vmaxf(v[8], v[10]); const float h21 = vmaxf(v[9], v[11]); const float h22 = vmaxf(v[12], v[14]); const float h23 = vmaxf(v[13], v[15]); v[2] = vminf(v[0], v[2]); v[3] = vminf(v[1], v[3]); v[6] = vminf(v[4], v[6]); v[7] = vminf(v[5], v[7]); v[10] = vminf(v[8], v[10]); v[11] = vminf(v[9], v[11]); v[14] = vminf(v[12], v[14]); v[15] = vminf(v[13], v[15]); v[0] = h16; v[1] = h17; v[4] = h18; v[5] = h19; v[8] = h20; v[9] = h21; v[12] = h22; v[13] = h23; const float h24 = vmaxf(v[0], v[1]); const float h25 = vmaxf(v[2], v[3]); const float h26 = vmaxf(v[4], v[5]); const float h27 = vmaxf(v[6], v[7]); const float h28 = vmaxf(v[8], v[9]); const float h29 = vmaxf(v[10], v[11]); const float h30 = vmaxf(v[12], v[13]); const float h31 = vmaxf(v[14], v[15]); v[1] = vminf(v[0], v[1]); v[3] = vminf(v[2], v[3]); v[5] = vminf(v[4], v[5]); v[7] = vminf(v[6], v[7]); v[9] = vminf(v[8], v[9]); v[11] = vminf(v[10], v[11]); v[13] = vminf(v[12], v[13]); v[15] = vminf(v[14], v[15]); v[0] = h24; v[2] = h25; v[4] = h26; v[6] = h27; v[8] = h28; v[10] = h29; v[12] = h30; v[14] = h31; }
#undef CE
template <int NV> DI void merge_top16(float (&L)[16], const float (&N)[NV]) {
#pragma unroll
    for (int i = 16 - NV; i < 16; ++i) L[i] = vmaxf(L[i], N[15 - i]);
    bmerge16_desc(L);
}
DI float pack_cand(float s, int id) { return __uint_as_float((__float_as_uint(s) & ~0xffu) | (unsigned)(255 - id)); }
DI void peer_topk_mfma2(Frame& F, const bf16* PQb, int* IDX, float* GATE) {
    const int tid = F.tid, lane = F.lane, wid = F.wave, r32 = lane & 31, hi = lane >> 5, h = F.vcu & 7;
    __syncthreads();
    {
        v4u kw[8];
#pragma unroll
        for (int j = 0; j < 8; ++j) { const int i = tid + 512 * j, p = i >> 11, key = (i >> 4) & 127, c = i & 15; kw[j] = *(const GAS v4u*)(F_SUBK + (size_t)((h * 2 + p) * 128 + key) * 128 + c * 8); }
#pragma unroll
        for (int j = 0; j < 8; ++j) { const int i = tid + 512 * j, p = i >> 11, key = (i >> 4) & 127, c = i & 15; *(LAS v4u*)(F.lds + p * 32768 + c * 2048 + key * 16) = kw[j]; }
    }
    __syncthreads();
    LAS unsigned* scr = (LAS unsigned*)(F.lds + 65536 + wid * 8192) + lane;
    const int g0 = (F.vcu >> 3) * 8 + wid, gstep = (F.G >> 3) * 8;
    bf16x8 qf[8];
#pragma unroll
    for (int ks = 0; ks < 8; ++ks) qf[ks] = *(const GAS bf16x8*)(PQb + ((size_t)32 * g0 + r32) * 2048 + (h * 2) * 128 + 16 * ks + 8 * hi);
    for (int g = g0; g < 512; g += gstep) {
        const size_t token = (size_t)32 * g + r32;
        float LA[16], LB[16];
#pragma unroll
        for (int p = 0; p < 2; ++p) {
            float (&L)[16] = p ? LB : LA;
            f32x16 S[4];
#pragma unroll
            for (int rt = 0; rt < 4; ++rt) { S[rt] = (f32x16){};
#pragma unroll
                for (int ks = 0; ks < 8; ++ks) S[rt] = __builtin_amdgcn_mfma_f32_32x32x16_bf16(*(const LAS bf16x8*)(F.lds + p * 32768 + (2 * ks + hi) * 2048 + (32 * rt + r32) * 16), qf[ks], S[rt], 0, 0, 0); }
            __builtin_amdgcn_sched_barrier(0);
            {
                const int gn = p ? (g + gstep < 512 ? g + gstep : g) : g; const int pn = p ? 0 : 1;
#pragma unroll
                for (int ks = 0; ks < 8; ++ks) qf[ks] = *(const GAS bf16x8*)(PQb + ((size_t)32 * gn + r32) * 2048 + (h * 2 + pn) * 128 + 16 * ks + 8 * hi);
            }
            __builtin_amdgcn_sched_barrier(0);
#pragma unroll
            for (int rt = 0; rt < 4; ++rt) {
                float v[16];
#pragma unroll
                for (int r = 0; r < 16; ++r) { const unsigned key = (unsigned)(32 * rt + (r & 3) + 8 * (r >> 2)) + 4u * (unsigned)hi; v[r] = __uint_as_float((__float_as_uint(S[rt][r]) & ~0x7fu) | key); }
                sort16_desc(v);
                if (rt == 0) {
#pragma unroll
                    for (int i = 0; i < 16; ++i) L[i] = v[i];
                } else merge_top16<16>(L, v);
            }
            float PL[16];
#pragma unroll
            for (int i = 0; i < 16; ++i) { auto rr = __builtin_amdgcn_permlane32_swap(__float_as_uint(L[i]), __float_as_uint(L[i]), false, false); PL[i] = __uint_as_float(hi ? rr[0] : rr[1]); }
            merge_top16<16>(L, PL);
        }
#pragma unroll
        for (int i = 0; i < 16; ++i) { scr[i * 64] = __float_as_uint(LA[i]) & 0x7fu; scr[(16 + i) * 64] = __float_as_uint(LB[i]) & 0x7fu; }
        float VA[16], VB[16];
#pragma unroll
        for (int i = 0; i < 16; ++i) { VA[i] = __uint_as_float(__float_as_uint(LA[i]) & ~0x7fu); VB[i] = __uint_as_float(__float_as_uint(LB[i]) & ~0x7fu); }
        float C[16];
#pragma unroll
        for (int b = 0; b < 16; ++b) C[b] = pack_cand(VA[0] + VB[b], b);
        { float R[8];
#pragma unroll
          for (int b = 0; b < 8; ++b) R[b] = pack_cand(VA[1] + VB[b], 16 + b);
          merge_top16<8>(C, R); }
        { float R[5];
#pragma unroll
          for (int b = 0; b < 5; ++b) R[b] = pack_cand(VA[2] + VB[b], 32 + b);
          merge_top16<5>(C, R); }
        { float R[4];
#pragma unroll
          for (int b = 0; b < 4; ++b) R[b] = pack_cand(VA[3] + VB[b], 48 + b);
          merge_top16<4>(C, R); }
        { float R[3];
#pragma unroll
          for (int b = 0; b < 3; ++b) R[b] = pack_cand(VA[4] + VB[b], 64 + b);
          merge_top16<3>(C, R); }
        { float R[11];
#pragma unroll
          for (int i = 0; i < 11; ++i) R[i] = pack_cand(VA[5 + i] + VB[0], (5 + i) * 16);
          merge_top16<11>(C, R); }
        { float R[3];
#pragma unroll
          for (int i = 0; i < 3; ++i) R[i] = pack_cand(VA[5 + i] + VB[1], (5 + i) * 16 + 1);
          merge_top16<3>(C, R); }
        LDS_WAIT(); asm volatile("" ::: "memory");
        const float top = __uint_as_float(__float_as_uint(C[0]) & ~0xffu);
        float ex[16]; int ei[16]; float sum = 0.f;
#pragma unroll
        for (int r = 0; r < 16; ++r) { const unsigned cu = __float_as_uint(C[r]), id = 255u - (cu & 0xffu); ex[r] = __expf(__uint_as_float(cu & ~0xffu) - top); sum += ex[r];
            ei[r] = (int)(scr[(id >> 4) * 64] * 128u + scr[(16 + (id & 15)) * 64]); }
        const float inv = 1.f / sum;
        v4u io0, io1; f32x4 go0, go1;
        io0.x = hi ? ei[8] : ei[0]; io0.y = hi ? ei[9] : ei[1]; io0.z = hi ? ei[10] : ei[2]; io0.w = hi ? ei[11] : ei[3];
        io1.x = hi ? ei[12] : ei[4]; io1.y = hi ? ei[13] : ei[5]; io1.z = hi ? ei[14] : ei[6]; io1.w = hi ? ei[15] : ei[7];
        go0.x = (hi ? ex[8] : ex[0]) * inv; go0.y = (hi ? ex[9] : ex[1]) * inv; go0.z = (hi ? ex[10] : ex[2]) * inv; go0.w = (hi ? ex[11] : ex[3]) * inv;
        go1.x = (hi ? ex[12] : ex[4]) * inv; go1.y = (hi ? ex[13] : ex[5]) * inv; go1.z = (hi ? ex[14] : ex[6]) * inv; go1.w = (hi ? ex[15] : ex[7]) * inv;
        int* ip = IDX + token * 128 + h * 16 + 8 * hi; float* gp = GATE + token * 128 + h * 16 + 8 * hi;
        *(GAS v4u*)ip = io0; *(GAS v4u*)(ip + 4) = io1; *(GAS f32x4*)gp = go0; *(GAS f32x4*)(gp + 4) = go1;
        LDS_WAIT(); asm volatile("" ::: "memory");
    }
}
constexpr int GL3_LIST = 0, GL3_X = 65536;
constexpr int G5_NSH = 16, G5_SHIFT = 10;
constexpr int G6_NSH = 16, G6_SHIFT = 10, G6_TPW = 8;
DI void g6_issue(v4u (&R)[4], v4u& E, const LAS unsigned char* tlist, const unsigned char* TAB, int k, int lane) {
    E = *(const LAS v4u*)(tlist + (4 * k + (lane & 3)) * 16);
#pragma unroll
    for (int j = 0; j < 4; ++j) { const unsigned id = (unsigned)__builtin_amdgcn_readlane((int)E.x, j); R[j] = *(const GAS v4u*)(TAB + (size_t)id * 1024 + 16 * lane); }
}
DI void g6_dot(const v4u& xx, const v4u (&U)[4], const v4u& E, LAS unsigned char* tlist, int k, int lane) {
    int p[4];
#pragma unroll
    for (int j = 0; j < 4; ++j) { int d = __builtin_amdgcn_sdot4((int)U[j].x, (int)xx.x, 0, false); d = __builtin_amdgcn_sdot4((int)U[j].y, (int)xx.y, d, false);
        d = __builtin_amdgcn_sdot4((int)U[j].z, (int)xx.z, d, false); p[j] = __builtin_amdgcn_sdot4((int)U[j].w, (int)xx.w, d, false); }
    const bool b0 = lane & 1, b1 = lane & 2;
    const int kA = b0 ? p[1] : p[0], sA = b0 ? p[0] : p[1], kB = b0 ? p[3] : p[2], sB = b0 ? p[2] : p[3];
    const int qA = kA + dpp_i<0xB1>(sA), qB = kB + dpp_i<0xB1>(sB);
    const int kk = b1 ? qB : qA, ss = b1 ? qA : qB;
    int r = kk + dpp_i<0x4E>(ss);
    r += dpp_i<0x124>(r); r += dpp_i<0x128>(r);
    r += __shfl_xor(r, 16); r += __shfl_xor(r, 32);
    const float a = (float)r * __uint_as_float(E.z);
    const float y = 0.7978845608028654f * (a + 0.044715f * a * a * a);
    const float th = 1.f - 2.f * __builtin_amdgcn_rcpf(1.f + __expf(2.f * y));
    const float cfl = __uint_as_float(E.y) * __uint_as_float(E.w) * 0.5f * a * (1.f + th);
    if (lane < 4) *(LAS float*)(tlist + (4 * k + lane) * 16 + 4) = cfl;
}
typedef _Float16 h2_t __attribute__((ext_vector_type(2)));
typedef _Float16 h32_t __attribute__((ext_vector_type(32)));
DI void g6_issue_v(u32x3v (&R)[4], v4u& E, const LAS unsigned char* tlist, const unsigned char* TAB, int k, int lane) {
    E = *(const LAS v4u*)(tlist + (4 * k + (lane & 3)) * 16);
#pragma unroll
    for (int j = 0; j < 4; ++j) { const unsigned id = (unsigned)__builtin_amdgcn_readlane((int)E.x, j); R[j] = *(const GAS u32x3v*)(TAB + (size_t)id * 768 + 12 * lane); }
}
DI void g6_fma(h2_t (&acc)[8], const u32x3v (&V)[4], const v4u& E, int lane) {
#pragma unroll
    for (int jp = 0; jp < 2; ++jp) {
        const i32x6v pk = {(int)V[2 * jp][0], (int)V[2 * jp][1], (int)V[2 * jp][2], (int)V[2 * jp + 1][0], (int)V[2 * jp + 1][1], (int)V[2 * jp + 1][2]};
        const h32_t hv = __builtin_bit_cast(h32_t, __builtin_amdgcn_cvt_scalef32_pk32_f16_fp6(pk, 1.0f));
#pragma unroll
        for (int q = 0; q < 2; ++q) { const float cf = __uint_as_float(__builtin_amdgcn_readlane((int)E.y, 2 * jp + q)); const _Float16 ch = (_Float16)cf; const h2_t c2 = {ch, ch};
#pragma unroll
            for (int w = 0; w < 8; ++w) { const h2_t vv = {hv[16 * q + 2 * w], hv[16 * q + 2 * w + 1]}; acc[w] = __builtin_elementwise_fma(vv, c2, acc[w]); } }
    }
}
DI void peer_gather_wave6(Frame& F, const Args& A, const bf16* XN2, const float* SS2, const int* IDX, const float* GATE, size_t tok0) {
    constexpr int TPW = G6_TPW;
    const int lane = F.lane, wid = F.wave;
    const unsigned char* U8 = F.ws + WS_U8; const unsigned char* V8 = F.ws + WS_V8;
    const float* SU = (const float*)(F.ws + WS_SU); const float* SV = (const float*)(F.ws + WS_SV);
    LAS unsigned char* list = F.lds + wid * (TPW * 2048);
    v4u xq[TPW];
#pragma unroll
    for (int tl = 0; tl < TPW; ++tl) {
        const size_t t = tok0 + tl;
        float sx;
        {
            float xv[16];
#pragma unroll
            for (int j = 0; j < 4; ++j) { const unsigned long long hw = *(const GAS unsigned long long*)(XN2 + t * 1024 + 256 * j + 4 * lane); const unsigned lo_ = (unsigned)hw, hi_ = (unsigned)(hw >> 32);
                xv[4 * j] = bflo(lo_); xv[4 * j + 1] = bfhi(lo_); xv[4 * j + 2] = bflo(hi_); xv[4 * j + 3] = bfhi(hi_); }
            {
                const f32x4* sp = (const f32x4*)(SS2 + t * 16); const f32x4 a = sp[0], b = sp[1], c = sp[2], d = sp[3];
                const float tt = ((a[0] + a[1]) + (a[2] + a[3])) + ((b[0] + b[1]) + (b[2] + b[3])) + ((c[0] + c[1]) + (c[2] + c[3])) + ((d[0] + d[1]) + (d[2] + d[3]));
                const float rs = 1.0f / sqrtf(tt * (1.0f / 1024.0f) + EPS);
#pragma unroll
                for (int i = 0; i < 4; ++i) { const f32x4 gv = *(const GAS f32x4*)(A.in[15] + 256 * i + 4 * lane); xv[4 * i] *= rs * gv.x; xv[4 * i + 1] *= rs * gv.y; xv[4 * i + 2] *= rs * gv.z; xv[4 * i + 3] *= rs * gv.w; }
            }
            float mx = 0.f;
#pragma unroll
            for (int i = 0; i < 16; ++i) mx = fmaxf(mx, fabsf(xv[i]));
            mx = wave_max(mx); sx = mx > 0.f ? mx * (1.f / 127.f) : 1.f; const float inv = 1.f / sx;
#pragma unroll
            for (int i = 0; i < 4; ++i) { const int a = (int)rintf(xv[4 * i] * inv), b = (int)rintf(xv[4 * i + 1] * inv), c = (int)rintf(xv[4 * i + 2] * inv), d = (int)rintf(xv[4 * i + 3] * inv);
                xq[tl][i] = (unsigned)(a & 255) | ((unsigned)(b & 255) << 8) | ((unsigned)(c & 255) << 16) | ((unsigned)(d & 255) << 24); }
        }
        const int idlo = IDX[t * 128 + lane], idhi = IDX[t * 128 + 64 + lane];
        const float glo = GATE[t * 128 + lane], ghi = GATE[t * 128 + 64 + lane];
        const float slo = SU[idlo] * sx, shi = SU[idhi] * sx, vlo = SV[idlo], vhi = SV[idhi];
        LAS unsigned char* tl_list = list + tl * 2048;
        int base = 0;
        for (int s = 0; s < G6_NSH; ++s) {
            { const bool m = (idlo >> G6_SHIFT) == s; const unsigned long long mk = __ballot(m); const int pos = base + (int)__builtin_amdgcn_mbcnt_hi((unsigned)(mk >> 32), __builtin_amdgcn_mbcnt_lo((unsigned)mk, 0u));
              if (m) *(LAS v4u*)(tl_list + pos * 16) = (v4u){(unsigned)idlo, __float_as_uint(glo), __float_as_uint(slo), __float_as_uint(vlo)};
              base += __builtin_popcountll(mk); }
            { const bool m = (idhi >> G6_SHIFT) == s; const unsigned long long mk = __ballot(m); const int pos = base + (int)__builtin_amdgcn_mbcnt_hi((unsigned)(mk >> 32), __builtin_amdgcn_mbcnt_lo((unsigned)mk, 0u));
              if (m) *(LAS v4u*)(tl_list + pos * 16) = (v4u){(unsigned)idhi, __float_as_uint(ghi), __float_as_uint(shi), __float_as_uint(vhi)};
              base += __builtin_popcountll(mk); }
        }
    }
    LDS_WAIT(); asm volatile("" ::: "memory");
#define G6_SB __builtin_amdgcn_sched_barrier(0)
    {
        v4u RA[4], RB[4]; v4u EA, EB;
        g6_issue(RA, EA, list, U8, 0, lane);
        for (int k = 0; k < 32; ++k) {
#define G6_P1(RI, EI, tn, kn, RC, EC, tc) do { g6_issue(RI, EI, list + (tn) * 2048, U8, kn, lane); G6_SB; g6_dot(xq[tc], RC, EC, list + (tc) * 2048, k, lane); G6_SB; } while (0)
            G6_P1(RB, EB, 1, k, RA, EA, 0); G6_P1(RA, EA, 2, k, RB, EB, 1); G6_P1(RB, EB, 3, k, RA, EA, 2); G6_P1(RA, EA, 4, k, RB, EB, 3);
            G6_P1(RB, EB, 5, k, RA, EA, 4); G6_P1(RA, EA, 6, k, RB, EB, 5); G6_P1(RB, EB, 7, k, RA, EA, 6); G6_P1(RA, EA, 0, (k < 31 ? k + 1 : 31), RB, EB, 7);
#undef G6_P1
        }
    }
    LDS_WAIT(); asm volatile("" ::: "memory");
    h2_t acc[TPW][8];
#pragma unroll
    for (int tl = 0; tl < TPW; ++tl)
#pragma unroll
        for (int i = 0; i < 8; ++i) acc[tl][i] = (h2_t){(_Float16)0.f, (_Float16)0.f};
    {
        u32x3v RA[4], RB[4]; v4u EA, EB;
        g6_issue_v(RA, EA, list, V8, 0, lane);
        for (int k = 0; k < 32; ++k) {
#define G6_P2(RI, EI, tn, kn, RC, EC, tc) do { g6_issue_v(RI, EI, list + (tn) * 2048, V8, kn, lane); G6_SB; g6_fma(acc[tc], RC, EC, lane); G6_SB; } while (0)
            G6_P2(RB, EB, 1, k, RA, EA, 0); G6_P2(RA, EA, 2, k, RB, EB, 1); G6_P2(RB, EB, 3, k, RA, EA, 2); G6_P2(RA, EA, 4, k, RB, EB, 3);
            G6_P2(RB, EB, 5, k, RA, EA, 4); G6_P2(RA, EA, 6, k, RB, EB, 5); G6_P2(RB, EB, 7, k, RA, EA, 6); G6_P2(RA, EA, 0, (k < 31 ? k + 1 : 31), RB, EB, 7);
#undef G6_P2
        }
    }
#undef G6_SB
#pragma unroll
    for (int tl = 0; tl < TPW; ++tl) {
        float* hp = F.out + (tok0 + tl) * 1024 + 4 * lane;
        f32x4 y[4]; float ssq = 0.f;
#pragma unroll
        for (int i = 0; i < 4; ++i) { const unsigned long long hw = *(const GAS unsigned long long*)(XN2 + (tok0 + tl) * 1024 + 256 * i + 4 * lane); const unsigned lo_ = (unsigned)hw, hi_ = (unsigned)(hw >> 32);
            y[i] = (f32x4){bflo(lo_), bfhi(lo_), bflo(hi_), bfhi(hi_)}; }
#pragma unroll
        for (int i = 0; i < 4; ++i) { y[i].x += (float)acc[tl][2 * i].x; y[i].y += (float)acc[tl][2 * i].y; y[i].z += (float)acc[tl][2 * i + 1].x; y[i].w += (float)acc[tl][2 * i + 1].y;
            ssq += (y[i].x * y[i].x + y[i].y * y[i].y) + (y[i].z * y[i].z + y[i].w * y[i].w); }
        const float rs = 1.f / sqrtf(wave_sum(ssq) * (1.f / 1024.f) + EPS);
#pragma unroll
        for (int i = 0; i < 4; ++i) { const f32x4 gv = *(const GAS f32x4*)(A.in[20] + 256 * i + 4 * lane); __builtin_nontemporal_store(y[i] * rs * gv, (GAS f32x4*)(hp + 256 * i)); }
    }
    LDS_WAIT(); asm volatile("" ::: "memory");
}

DI void wg_self_handoff() {
    asm volatile("s_waitcnt vmcnt(0)" ::: "memory");
    __syncthreads();
    if (threadIdx.x == 0) { __builtin_amdgcn_fence(__ATOMIC_ACQUIRE, "agent"); asm volatile("s_waitcnt vmcnt(0)" ::: "memory"); }
    __syncthreads();
}
constexpr size_t WS_XBUF = 73 * MiB;
constexpr int CW_SEAM = 16384, SEAM_BANK = 8192;
__global__ void __launch_bounds__(NWAVES * 64, 2) fwd_kernel(Args args) {
    extern __shared__ __attribute__((aligned(16))) unsigned char lds[];
    Frame F;
    F.lds = (LAS unsigned char*)lds;
    F.MISC = (volatile LAS unsigned*)(F.lds + MISC_OFF);
    F.tid = threadIdx.x; F.lane = F.tid & 63; F.wave = __builtin_amdgcn_readfirstlane(F.tid >> 6);
    F.G = gridDim.x; { const int bx = blockIdx.x; F.vcu = (F.G % 8 == 0) ? (bx % 8) * (F.G / 8) + bx / 8 : bx; }
    unsigned char* ws = args.ws;
    F.ctl = (gu32*)(ws + WS_CTL);
    F.out = args.out; F.ws = ws;
    for (int u = F.tid; u < (LDS_BYTES - LDSCTL_OFF) / 4; u += NWAVES * 64) ((LAS unsigned*)(F.lds + LDSCTL_OFF))[u] = 0u;
    __syncthreads();
    XcdBarrier bar = xcd_barrier_post((unsigned*)(F.ctl + CW_BAR) + args.li * XCD_BAR_WORDS, F.MISC + 8);
    const int lo = args.ph_lo, hi = args.ph_hi;
#ifndef PH_MASK
#define PH_MASK 0xffff
#endif
#define IN(k) (((PH_MASK >> (k)) & 1) && lo <= (k) && (k) < hi)
#define SEAM(k) do { if (IN(k) && IN((k) + 1)) xcd_barrier(bar); } while (0)
    const int gw = F.vcu * NWAVES + F.wave, NGW = F.G * NWAVES;
#define STW ((bf16*)F.out)
#define OSB (F.out + (size_t)M * 512)
#define IDX ((int*)F_BUFA)
#define GATE ((float*)(F_BUFA) + (size_t)M * 128)

    if (IN(0)) { p0_prologue(F, args); __syncthreads(); p0_late(F, args, gw, NGW); } SEAM(0);
    if (IN(1)) {
        { pg8::Gemm g{F_BUFA, F_W1T, 1024, 1024, 1024}; pg8::StaticOrder S; S.init(M, N1, F.G, (int)blockIdx.x, 1024, 1024);
          pg8::EpiBf16P E{F_PROJ, N1, 1.f};
          pg8::gemm_phase<pg8::EpiBf16P, pg8::StaticOrder, true, true>(F.lds, g, S, E); }
        { pg8::Gemm g{F_MN, F_WXKVT, 1024, 1024, 1024}; const int c = (int)blockIdx.x; pg8::OneUnitOrder S{(c >= 64 && c < 128) ? c - 64 : -1, 8, 1024, 1024};
          pg8::EpiBf16P E{F_KV, 2048, 1.f};
          pg8::gemm_phase<pg8::EpiBf16P, pg8::OneUnitOrder, true, true>(F.lds, g, S, E); }
    } SEAM(1);
    if (IN(2)) {
        __syncthreads();
        for (int task = gw; task < 64 * 64; task += NGW) { const int bh = task >> 6; sb_wave(F, OSB, bh >> 3, bh & 7, 63 - (task & 63)); }
        __syncthreads();
        { v4u gw_[6]; int it = F.vcu; if (it < 1024) gla_stage_load(F, (it >> 5) >> 2, (it >> 5) & 3, it & 31, gw_);
          for (; it < 1024; it += F.G) { const int bh = it >> 5, itn = it + F.G < 1024 ? it + F.G : it, bhn = itn >> 5; gla_local_unit(F, args, STW, bh >> 2, bh & 3, it & 31, gw_, bhn >> 2, bhn & 3, itn & 31); } }
    } SEAM(2);
    if (IN(3)) { gla_scan(F, STW);
    } SEAM(3);
    if (IN(4)) {
        { v4u gw_[6]; int it = F.vcu; if (it < 1024) gla_stage_load(F, (it >> 5) >> 2, (it >> 5) & 3, it & 31, gw_);
          for (; it < 1024; it += F.G) { const int bh = it >> 5, itn = it + F.G < 1024 ? it + F.G : it, bhn = itn >> 5; gla_out_unit(F, args, STW, bh >> 2, bh & 3, it & 31, gw_, bhn >> 2, bhn & 3, itn & 31); } }
        for (int m = 4 * gw; m < M; m += 4 * NGW) mix_rows_sb<4>(F, args, OSB, (size_t)m);
    } SEAM(4);
    if (IN(5)) { pg8::Gemm g{F_BUFA, F_WOT, 1024, 1024, 1024}; pg8::StaticOrder S; S.init(M, 1024, F.G, (int)blockIdx.x, 1024, 1024);
        pg8::EpiResB<false> E{args.in[0], F_SLOT1, (float*)(ws + WS_XBUF), 1024};
        pg8::gemm_phase<pg8::EpiResB<false>, pg8::StaticOrder, true, true>(F.lds, g, S, E); } SEAM(5);
    if (IN(6)) { pg8::Gemm g{F_SLOT1, F_WXQT, 1024, 1024, 1024}; pg8::StaticOrder S; S.init(M, 1024, F.G, (int)blockIdx.x, 1024, 1024);
        pg8::EpiBf16RowScale E{F_SLOT2, 1024, (const float*)(ws + WS_XBUF), EPS};
        { const int L = (int)blockIdx.x;
            const int wgid = (L & 7) * 32 + (L >> 3), pm = (wgid >> 5) * 8 + (wgid & 7), pn = (wgid & 31) >> 3;
            pg8::OneUnitOrder S1{pm * 4 + pn, 4, 1024, 1024};
            pg8::gemm_phase<pg8::EpiBf16RowScale, pg8::OneUnitOrder, true, true>(F.lds, g, S1, E);
            wg_self_handoff();
            xattn_unit(F, F_SLOT2, F_SLOT0, pm >> 3, pn, pm & 7); }
        (void)S;
    }
    SEAM(7);
    if (IN(8)) { pg8::Gemm g{F_SLOT0, F_WXOT, 1024, 1024, 1024}; pg8::StaticOrder S; S.init(M, 1024, F.G, (int)blockIdx.x, 1024, 1024);
        pg8::EpiResB<true> E{F_SLOT1, F_SLOT2, (float*)(ws + WS_XBUF + MiB), 1024};
        pg8::gemm_phase<pg8::EpiResB<true>, pg8::StaticOrder, true, true>(F.lds, g, S, E); } SEAM(8);
    if (IN(9)) { pg8::Gemm g{F_SLOT2, F_WPQT, 1024, 1024, 1024}; pg8::StaticOrder S; S.init(M, 2048, F.G, (int)blockIdx.x, 1024, 1024);
        pg8::EpiBf16RowScale E{F_SLOT0, 2048, (const float*)(ws + WS_XBUF + MiB), EPS};
        pg8::gemm_phase<pg8::EpiBf16RowScale, pg8::StaticOrder, true, true>(F.lds, g, S, E); } SEAM(9);
    if (IN(10)) { peer_topk_mfma2(F, F_SLOT0, IDX, GATE); } SEAM(10);
    if (IN(11)) { peer_gather_wave6(F, args, F_SLOT2, (const float*)(ws + WS_XBUF + MiB), IDX, GATE, (size_t)F.vcu * 64 + F.wave * 8); }
#undef IN
#undef SEAM
}

constexpr int NPHASES = 12;
extern "C" void kernel_launch(void* const* d_in, const int* in_sizes, int n_in, void* d_out, int out_size, void* d_ws, size_t ws_size, hipStream_t stream) {
    static int grid = 0;
    if (grid == 0) {
        if (n_in != 21 || out_size != M * DM || ws_size < WS_END) { fprintf(stderr, "kernel_launch: unexpected shapes (n_in %d out %d ws %zu)\n", n_in, out_size, ws_size); grid = -1; return; }
        int dev = 0, cus = 0, per_cu = 0;
        if (hipGetDevice(&dev) != hipSuccess || hipDeviceGetAttribute(&cus, hipDeviceAttributeMultiprocessorCount, dev) != hipSuccess) { grid = -1; return; }
        if (hipFuncSetAttribute((const void*)fwd_kernel, hipFuncAttributeMaxDynamicSharedMemorySize, LDS_BYTES) != hipSuccess) { fprintf(stderr, "kernel_launch: hipFuncSetAttribute failed\n"); grid = -1; return; }
        if (hipOccupancyMaxActiveBlocksPerMultiprocessor(&per_cu, (const void*)fwd_kernel, NWAVES * 64, LDS_BYTES) != hipSuccess || per_cu < 1) { fprintf(stderr, "kernel_launch: occupancy query says %d\n", per_cu); }
        (void)hipGetLastError();
        grid = cus;
    }
    if (grid < 0) return;
    (void)hipMemsetAsync((char*)d_ws + WS_CTL, 0, CTL_ZERO_BYTES, stream);
    Args a{};
    for (int i = 0; i < 21; ++i) a.in[i] = (const float*)d_in[i];
    a.out = (float*)d_out; a.ws = (unsigned char*)d_ws;
#if defined(PROF_DUP_LO)
    a.ph_lo = 0; a.ph_hi = PROF_DUP_HI + 1; a.li = 0; hipLaunchKernelGGL(fwd_kernel, dim3(grid), dim3(NWAVES * 64), LDS_BYTES, stream, a);
    a.ph_lo = PROF_DUP_LO; a.ph_hi = NPHASES; a.li = 1; hipLaunchKernelGGL(fwd_kernel, dim3(grid), dim3(NWAVES * 64), LDS_BYTES, stream, a);
#elif defined(PROF_SPLIT)
    a.ph_lo = 0; a.ph_hi = PROF_SPLIT; a.li = 0; hipLaunchKernelGGL(fwd_kernel, dim3(grid), dim3(NWAVES * 64), LDS_BYTES, stream, a);
    a.ph_lo = PROF_SPLIT; a.ph_hi = NPHASES; a.li = 1; hipLaunchKernelGGL(fwd_kernel, dim3(grid), dim3(NWAVES * 64), LDS_BYTES, stream, a);
#else
    a.ph_lo = 0; a.ph_hi = NPHASES; a.li = 0;
    hipLaunchKernelGGL(fwd_kernel, dim3(grid), dim3(NWAVES * 64), LDS_BYTES, stream, a);
#endif
}
```

```cpp
#include <hip/hip_runtime.h>
#include <cstdio>
#include <cstdint>
namespace pg8 {
#define PG8_LAS __attribute__((address_space(3)))
typedef unsigned short bf16_t;
typedef short bf16x8 __attribute__((ext_vector_type(8)));
typedef float f32x4 __attribute__((ext_vector_type(4)));
typedef unsigned u32x4 __attribute__((ext_vector_type(4)));
constexpr int BM = 256, BK = 64, HALF = 128, HTB = HALF * BK * 2  , STAGE_BYTES = 8 * HTB, NXCD = 8, WGM = 8;

__host__ __device__ __forceinline__ int lds_byte(int r, int c) { const int st = (r >> 4) * 2 + (c >> 5), rr = r & 15, cc = c & 31, ob = rr * 64 + cc * 2; return st * 1024 + (ob ^ (((ob >> 9) & 1) << 5)); }
__host__ __device__ __forceinline__ void stage_rc(int b, int& R, int& C) { const int st = b / 1024, sb = b % 1024, swz = sb ^ (((sb >> 9) & 1) << 5); R = (st >> 1) * 16 + swz / 64; C = (st & 1) * 32 + (swz % 64) / 2; }
__host__ __device__ __forceinline__ int perm32(int rho) { const int n = rho >> 4, i = rho & 15; return 8 * (i >> 2) + 4 * n + (i & 3); }

struct Unit { int pm, pn; size_t aoff, boff; };
struct Gemm { const bf16_t* A; const bf16_t* Bt; int K, lda, ldb; };

struct StaticOrder {
    int nM, nN, nwg, G, c, lda, ldb;
    __host__ __device__ void init(int M, int N, int G_, int c_, int lda_, int ldb_) { nM = M / BM; nN = N / BM; nwg = nM * nN; G = G_; c = c_; lda = lda_; ldb = ldb_; }
    __host__ __device__ bool next(int i, Unit& u) const {
        const long L = (long)i * G + c; if (L >= nwg) return false;
        int wgid = (int)L; { const int q = nwg / NXCD, r = nwg % NXCD, xcd = wgid % NXCD, off = wgid / NXCD; wgid = (xcd < r ? xcd * (q + 1) : r * (q + 1) + (xcd - r) * q) + off; }
        const int nig = WGM * nN, gid = wgid / nig, fm = gid * WGM, gsz = (nM - fm) < WGM ? (nM - fm) : WGM;
        u.pm = fm + ((wgid % nig) % gsz); u.pn = (wgid % nig) / gsz; u.aoff = (size_t)u.pm * BM * lda * 2; u.boff = (size_t)u.pn * BM * ldb * 2; return true;
    }
    __device__ __forceinline__ void a_ready(const Unit&) const {}
    __device__ __forceinline__ void done(const Unit&) const {}
};

__device__ __forceinline__ unsigned cvt_pk_bf16(float lo, float hi) { unsigned r; asm volatile("v_cvt_pk_bf16_f32 %0, %1, %2" : "=v"(r) : "v"(lo), "v"(hi)); return r; }
typedef float f32x2 __attribute__((ext_vector_type(2)));
__device__ __forceinline__ f32x2 gelu_pk(f32x2 v) {
    const f32x2 av = __builtin_elementwise_abs(v), d = av * 0.2316418882f + 1.0f;
    f32x2 t; t.x = __builtin_amdgcn_rcpf(d.x); t.y = __builtin_amdgcn_rcpf(d.y);
    f32x2 q = t * 0.5307027145f + (-0.7265760135f); q = q * t + 0.7107068705f; q = q * t + (-0.142248368f); q = q * t + 0.127414796f; q = q * t;
    const f32x2 s = (v * v) * (-0.72134752044f);
    f32x2 e; e.x = __builtin_amdgcn_exp2f(s.x); e.y = __builtin_amdgcn_exp2f(s.y);
    const f32x2 m = v * (q * e), r = v - m;
    f32x2 o; o.x = v.x < 0.f ? m.x : r.x; o.y = v.y < 0.f ? m.y : r.y; return o;
}

template <int ACT  > struct EpiBf16 {
    static constexpr bool PERM = true, AFTER_DRAIN = false; static_assert(ACT == 0 || ACT == 1, "EpiBf16: ACT is 0 (none) or 1 (gelu_pk)");
    bf16_t* O; int ldc; const float* bias; int split_cols; size_t split_stride; float scale0;
    __device__ __forceinline__ void operator()(const f32x4 (&acc)[2][2][4][2], const Unit& u, int wr, int wc, int fr, int fq) const {
        const int row0 = u.pm * BM + wr * 64 + fr; int colt = u.pn * BM; bf16_t* base = O;
        float sc = 1.f; if (split_cols) { const int t = colt / split_cols; base += (size_t)t * split_stride; colt -= t * split_cols; if (t == 0) sc = scale0; }
        const int col0 = colt + wc * 32 + 8 * fq, bcol0 = u.pn * BM + wc * 32 + 8 * fq;
        f32x4 bv[2][2];
#pragma unroll
        for (int bj = 0; bj < 2; ++bj)
#pragma unroll
            for (int n = 0; n < 2; ++n) bv[bj][n] = bias ? *(const f32x4*)(bias + bcol0 + bj * HALF + 4 * n) : (f32x4){0.f, 0.f, 0.f, 0.f};
#pragma unroll
        for (int ai = 0; ai < 2; ++ai)
#pragma unroll
            for (int m = 0; m < 4; ++m) { bf16_t* rowp = base + (size_t)(row0 + ai * HALF + m * 16) * ldc + col0;
#pragma unroll
                for (int bj = 0; bj < 2; ++bj) { f32x4 v0 = acc[ai][bj][m][0] + bv[bj][0], v1 = acc[ai][bj][m][1] + bv[bj][1];
                    if (ACT == 1) { f32x2 a = gelu_pk((f32x2){v0[0], v0[1]}), b = gelu_pk((f32x2){v0[2], v0[3]}), c = gelu_pk((f32x2){v1[0], v1[1]}), d = gelu_pk((f32x2){v1[2], v1[3]});
                        v0 = (f32x4){a.x, a.y, b.x, b.y}; v1 = (f32x4){c.x, c.y, d.x, d.y}; }
                    v0 = v0 * sc; v1 = v1 * sc; u32x4 w; w.x = cvt_pk_bf16(v0[0], v0[1]); w.y = cvt_pk_bf16(v0[2], v0[3]); w.z = cvt_pk_bf16(v1[0], v1[1]); w.w = cvt_pk_bf16(v1[2], v1[3]);
                    *(u32x4*)(rowp + bj * HALF) = w; } }
    }
};
template <class Epi, class Sched, bool ALIGN_EPI = false, bool SP2 = false>
__device__ __forceinline__ void gemm_phase(PG8_LAS unsigned char* lds, const Gemm g, const Sched& S, const Epi& E) {
    const int tid = threadIdx.x, wid = __builtin_amdgcn_readfirstlane(tid >> 6), lane = tid & 63, wr = wid >> 2, wc = wid & 3, fr = lane & 15, fq = lane >> 4;
    int K = g.K; asm volatile("" : "+s"(K));
    const int nt = K / BK;
    unsigned voffA[2], voffB[2];
#pragma unroll
    for (int i = 0; i < 2; ++i) { int R, C; stage_rc(tid * 16 + i * 8192, R, C); const int Rb = Epi::PERM ? ((R & ~31) + perm32(R & 31)) : R;
        voffA[i] = (unsigned)(R * g.lda + C) * 2u; voffB[i] = (unsigned)(Rb * g.ldb + C) * 2u; }
    const size_t kstep = (size_t)(BK * 2);
    const size_t hA = (size_t)HALF * g.lda * 2, hB = (size_t)HALF * g.ldb * 2;
    const unsigned ldsw = (unsigned)wid * 1024u;
    const int aoff = lds_byte(wr * 64 + fr, fq * 8), boff = lds_byte(wc * 32 + fr, fq * 8);
#define PG8_SA(b, h) (((b) * 2 + (h)) * HTB)
#define PG8_SB(b, h) ((4 + (b) * 2 + (h)) * HTB)
#define PG8_STAGE(bufoff, gbase, voff) do { _Pragma("unroll") for (int _i = 0; _i < 2; ++_i) \
        __builtin_amdgcn_global_load_lds((const unsigned*)((const char*)(gbase) + (voff)[_i]), (PG8_LAS unsigned*)(lds + (bufoff) + ldsw + _i * 8192), 16, 0, 0); } while (0)
#define PG8_LDA(dst, b, h) do { _Pragma("unroll") for (int m = 0; m < 4; ++m) _Pragma("unroll") for (int k = 0; k < 2; ++k) dst[m][k] = *(const PG8_LAS bf16x8*)(lds + PG8_SA(b, h) + aoff + m * 2048 + k * 1024); } while (0)
#define PG8_LDB(dst, b, h) do { _Pragma("unroll") for (int n = 0; n < 2; ++n) _Pragma("unroll") for (int k = 0; k < 2; ++k) dst[n][k] = *(const PG8_LAS bf16x8*)(lds + PG8_SB(b, h) + boff + n * 2048 + k * 1024); } while (0)
#define PG8_MMA(ai, bj, At, Bt) do { __builtin_amdgcn_s_setprio(1); _Pragma("unroll") for (int m = 0; m < 4; ++m) _Pragma("unroll") for (int n = 0; n < 2; ++n) _Pragma("unroll") for (int k = 0; k < 2; ++k) \
        acc[ai][bj][m][n] = __builtin_amdgcn_mfma_f32_16x16x32_bf16(Bt[n][k], At[m][k], acc[ai][bj][m][n], 0, 0, 0); __builtin_amdgcn_s_setprio(0); } while (0)
#define PG8_WAIT_V(n) asm volatile("s_waitcnt vmcnt(" #n ")" ::: "memory")
#define PG8_WAIT_L(n) asm volatile("s_waitcnt lgkmcnt(" #n ")" ::: "memory")
#define PG8_BAR __builtin_amdgcn_s_barrier()
#define PG8_SCHED __builtin_amdgcn_sched_barrier(0)
    Unit cur, nxt; int ui = 0;
    if (!S.next(0, cur)) return;
    f32x4 acc[2][2][4][2];
#pragma unroll
    for (int a = 0; a < 2; ++a)
#pragma unroll
        for (int b = 0; b < 2; ++b)
#pragma unroll
            for (int m = 0; m < 4; ++m)
#pragma unroll
                for (int n = 0; n < 2; ++n) acc[a][b][m][n] = (f32x4){0.f, 0.f, 0.f, 0.f};
    bf16x8 At[4][2], B0[2][2], B1[2][2];
    const char* cA = (const char*)g.A + cur.aoff; const char* cB = (const char*)g.Bt + cur.boff;
    S.a_ready(cur);
    if constexpr (SP2) {
        PG8_STAGE(PG8_SB(0, 0), cB, voffB); PG8_STAGE(PG8_SB(0, 1), cB + hB, voffB); PG8_STAGE(PG8_SA(0, 0), cA, voffA); PG8_STAGE(PG8_SA(0, 1), cA + hA, voffA);
        if (wr == 1) PG8_BAR;
        PG8_WAIT_V(2); PG8_BAR;
        PG8_STAGE(PG8_SB(1, 0), cB + kstep, voffB); PG8_STAGE(PG8_SA(1, 0), cA + kstep, voffA); PG8_STAGE(PG8_SB(1, 1), cB + hB + kstep, voffB);
        PG8_WAIT_V(6); PG8_BAR;
    } else {
        PG8_STAGE(PG8_SB(0, 0), cB, voffB); PG8_STAGE(PG8_SA(0, 0), cA, voffA); PG8_STAGE(PG8_SB(0, 1), cB + hB, voffB); PG8_STAGE(PG8_SA(0, 1), cA + hA, voffA);
        if (wr == 1) PG8_BAR;
        PG8_WAIT_V(4); PG8_BAR;
        PG8_STAGE(PG8_SB(1, 0), cB + kstep, voffB); PG8_STAGE(PG8_SA(1, 0), cA + kstep, voffA); PG8_STAGE(PG8_SB(1, 1), cB + hB + kstep, voffB);
        PG8_WAIT_V(6); PG8_BAR;
    }
    for (;;) {
        const bool has_next = S.next(ui + 1, nxt);
        const char* nA = has_next ? (const char*)g.A + nxt.aoff : cA; const char* nB = has_next ? (const char*)g.Bt + nxt.boff : cB;
        for (int t = 0; t < nt; t += 2) {
            const bool last = (t == nt - 2);
            const char* a1 = cA + (size_t)(t + 1) * kstep;
            const char* a2 = last ? nA : cA + (size_t)(t + 2) * kstep; const char* b2 = last ? nB : cB + (size_t)(t + 2) * kstep;
            const char* a3 = a2 + kstep; const char* b3 = b2 + kstep;
            if (last && has_next) S.a_ready(nxt);
            if constexpr (SP2) {
            PG8_LDB(B0, 0, 0); PG8_LDB(B1, 0, 1); PG8_SCHED; PG8_LDA(At, 0, 0); PG8_STAGE(PG8_SA(1, 1), a1 + hA, voffA);
            PG8_WAIT_V(8); PG8_WAIT_L(0); PG8_BAR; PG8_MMA(0, 0, At, B0); PG8_MMA(0, 1, At, B1); PG8_BAR; PG8_SCHED;
            PG8_LDA(At, 0, 1); PG8_STAGE(PG8_SB(0, 0), b2, voffB); PG8_STAGE(PG8_SB(0, 1), b2 + hB, voffB); PG8_STAGE(PG8_SA(0, 0), a2, voffA);
            PG8_WAIT_V(8); PG8_WAIT_L(0); PG8_BAR; PG8_MMA(1, 0, At, B0); PG8_MMA(1, 1, At, B1); PG8_BAR; PG8_SCHED;
            PG8_LDB(B0, 1, 0); PG8_LDB(B1, 1, 1); PG8_SCHED; PG8_LDA(At, 1, 0); PG8_STAGE(PG8_SA(0, 1), a2 + hA, voffA);
            PG8_WAIT_V(8); PG8_WAIT_L(0); PG8_BAR; PG8_MMA(0, 0, At, B0); PG8_MMA(0, 1, At, B1); PG8_BAR; PG8_SCHED;
            PG8_LDA(At, 1, 1); PG8_STAGE(PG8_SB(1, 0), b3, voffB); PG8_STAGE(PG8_SB(1, 1), b3 + hB, voffB); PG8_STAGE(PG8_SA(1, 0), a3, voffA);
            PG8_WAIT_V(8); PG8_WAIT_L(0); PG8_BAR; PG8_MMA(1, 0, At, B0); PG8_MMA(1, 1, At, B1); PG8_BAR; PG8_SCHED;
            } else {
            PG8_LDB(B0, 0, 0); PG8_SCHED; PG8_LDA(At, 0, 0); PG8_STAGE(PG8_SA(1, 1), a1 + hA, voffA);
            PG8_WAIT_L(8); PG8_BAR; PG8_WAIT_L(0); PG8_MMA(0, 0, At, B0); PG8_BAR; PG8_SCHED;
            PG8_LDB(B1, 0, 1); PG8_STAGE(PG8_SB(0, 0), b2, voffB);
            PG8_BAR; PG8_WAIT_L(0); PG8_MMA(0, 1, At, B1); PG8_BAR;
            PG8_LDA(At, 0, 1); PG8_STAGE(PG8_SA(0, 0), a2, voffA);
            PG8_BAR; PG8_WAIT_L(0); PG8_MMA(1, 0, At, B0); PG8_BAR; PG8_SCHED;
            PG8_STAGE(PG8_SB(0, 1), b2 + hB, voffB);
            PG8_WAIT_V(6); PG8_BAR; PG8_MMA(1, 1, At, B1); PG8_BAR;
            PG8_LDB(B0, 1, 0); PG8_SCHED; PG8_LDA(At, 1, 0); PG8_STAGE(PG8_SA(0, 1), a2 + hA, voffA);
            PG8_WAIT_L(8); PG8_BAR; PG8_WAIT_L(0); PG8_MMA(0, 0, At, B0); PG8_BAR; PG8_SCHED;
            PG8_LDB(B1, 1, 1); PG8_STAGE(PG8_SB(1, 0), b3, voffB);
            PG8_BAR; PG8_WAIT_L(0); PG8_MMA(0, 1, At, B1); PG8_BAR;
            PG8_LDA(At, 1, 1); PG8_STAGE(PG8_SA(1, 0), a3, voffA);
            PG8_BAR; PG8_WAIT_L(0); PG8_MMA(1, 0, At, B0); PG8_BAR; PG8_SCHED;
            PG8_STAGE(PG8_SB(1, 1), b3 + hB, voffB);
            PG8_WAIT_V(6); PG8_BAR; PG8_MMA(1, 1, At, B1); PG8_BAR;
            }
        }
        if constexpr (ALIGN_EPI) { if (wr == 0) PG8_BAR; }
        if constexpr (!Epi::AFTER_DRAIN) { E(acc, cur, wr, wc, fr, fq); S.done(cur); }
        if (!has_next) break;
#pragma unroll
        for (int a = 0; a < 2; ++a)
#pragma unroll
            for (int b = 0; b < 2; ++b)
#pragma unroll
                for (int m = 0; m < 4; ++m)
#pragma unroll
                    for (int n = 0; n < 2; ++n) acc[a][b][m][n] = (f32x4){0.f, 0.f, 0.f, 0.f};
        cur = nxt; cA = nA; cB = nB; ++ui;
        if constexpr (ALIGN_EPI) { if (wr == 1) PG8_BAR; }
    }
    PG8_WAIT_V(0);
    if constexpr (!ALIGN_EPI) { if (wr == 0) PG8_BAR; }
    PG8_BAR;
    if constexpr (Epi::AFTER_DRAIN) { E.fused(acc, cur, wr, wc, fr, fq, lds, wid, lane); S.done(cur); }
#undef PG8_SA
#undef PG8_SB
#undef PG8_STAGE
#undef PG8_LDA
#undef PG8_LDB
#undef PG8_MMA
#undef PG8_WAIT_V
#undef PG8_WAIT_L
#undef PG8_BAR
#undef PG8_SCHED
}
}
namespace pg8 {
struct EpiBf16P {
    static constexpr bool PERM = true, AFTER_DRAIN = false;
    bf16_t* O; int ldc; float sc;
    __device__ __forceinline__ void operator()(const f32x4 (&acc)[2][2][4][2], const Unit& u, int wr, int wc, int fr, int fq) const {
        const int row0 = u.pm * BM + wr * 64 + fr, col0 = u.pn * BM + wc * 32 + 8 * fq;
#pragma unroll
        for (int ai = 0; ai < 2; ++ai)
#pragma unroll
            for (int m = 0; m < 4; ++m) { bf16_t* rowp = O + (size_t)(row0 + ai * HALF + m * 16) * ldc + col0;
#pragma unroll
                for (int bj = 0; bj < 2; ++bj) { const f32x4 v0 = acc[ai][bj][m][0] * sc, v1 = acc[ai][bj][m][1] * sc;
                    u32x4 w; w.x = cvt_pk_bf16(v0[0], v0[1]); w.y = cvt_pk_bf16(v0[2], v0[3]); w.z = cvt_pk_bf16(v1[0], v1[1]); w.w = cvt_pk_bf16(v1[2], v1[3]);
                    *(u32x4*)(rowp + bj * HALF) = w; } }
    }
};
struct OneUnitOrder {
    int L, nN, lda, ldb;
    __device__ __forceinline__ bool next(int i, Unit& u) const {
        if (i != 0 || L < 0) return false;
        u.pm = L / nN; u.pn = L % nN; u.aoff = (size_t)u.pm * BM * lda * 2; u.boff = (size_t)u.pn * BM * ldb * 2; return true;
    }
    __device__ __forceinline__ void a_ready(const Unit&) const {}
    __device__ __forceinline__ void done(const Unit&) const {}
};
}

namespace pg8 {
}

namespace pg8 {
constexpr int QLDS_PITCH = 528;
struct EpiQToLds {
    static constexpr bool PERM = true, AFTER_DRAIN = true;
    const float* ss; float eps;
    __device__ __forceinline__ void fused(const f32x4 (&acc)[2][2][4][2], const Unit& u, int wr, int wc, int fr, int fq, PG8_LAS unsigned char* lds, int, int) const {
        const int rl0 = wr * 64 + fr, cl0 = wc * 32 + 8 * fq;
#pragma unroll
        for (int ai = 0; ai < 2; ++ai)
#pragma unroll
            for (int m = 0; m < 4; ++m) { const int rl = rl0 + ai * HALF + m * 16, row = u.pm * BM + rl; const f32x4* sp = (const f32x4*)(ss + (size_t)row * 16);
                const f32x4 a = sp[0], b = sp[1], c = sp[2], d = sp[3];
                const float t = ((a[0] + a[1]) + (a[2] + a[3])) + ((b[0] + b[1]) + (b[2] + b[3])) + ((c[0] + c[1]) + (c[2] + c[3])) + ((d[0] + d[1]) + (d[2] + d[3]));
                const float rs = 1.0f / sqrtf(t * (1.0f / 1024.0f) + eps);
#pragma unroll
                for (int bj = 0; bj < 2; ++bj) { const f32x4 v0 = acc[ai][bj][m][0] * rs, v1 = acc[ai][bj][m][1] * rs;
                    u32x4 w; w.x = cvt_pk_bf16(v0[0], v0[1]); w.y = cvt_pk_bf16(v0[2], v0[3]); w.z = cvt_pk_bf16(v1[0], v1[1]); w.w = cvt_pk_bf16(v1[2], v1[3]);
                    *(PG8_LAS u32x4*)(lds + rl * QLDS_PITCH + (cl0 + bj * HALF) * 2) = w; } }
    }
};
struct EpiBf16RowScale {
    static constexpr bool PERM = true, AFTER_DRAIN = false;
    bf16_t* O; int ldc; const float* ss; float eps;
    __device__ __forceinline__ void operator()(const f32x4 (&acc)[2][2][4][2], const Unit& u, int wr, int wc, int fr, int fq) const {
        const int row0 = u.pm * BM + wr * 64 + fr, col0 = u.pn * BM + wc * 32 + 8 * fq;
#pragma unroll
        for (int ai = 0; ai < 2; ++ai)
#pragma unroll
            for (int m = 0; m < 4; ++m) { const int row = row0 + ai * HALF + m * 16; const f32x4* sp = (const f32x4*)(ss + (size_t)row * 16);
                const f32x4 a = sp[0], b = sp[1], c = sp[2], d = sp[3];
                const float t = ((a[0] + a[1]) + (a[2] + a[3])) + ((b[0] + b[1]) + (b[2] + b[3])) + ((c[0] + c[1]) + (c[2] + c[3])) + ((d[0] + d[1]) + (d[2] + d[3]));
                const float rs = 1.0f / sqrtf(t * (1.0f / 1024.0f) + eps);
                bf16_t* rowp = O + (size_t)row * ldc + col0;
#pragma unroll
                for (int bj = 0; bj < 2; ++bj) { const f32x4 v0 = acc[ai][bj][m][0] * rs, v1 = acc[ai][bj][m][1] * rs;
                    u32x4 w; w.x = cvt_pk_bf16(v0[0], v0[1]); w.y = cvt_pk_bf16(v0[2], v0[3]); w.z = cvt_pk_bf16(v1[0], v1[1]); w.w = cvt_pk_bf16(v1[2], v1[3]);
                    *(u32x4*)(rowp + bj * HALF) = w; } }
    }
};
}

namespace pg8 {
template <bool BASE_BF16> struct EpiResB {
    static constexpr bool PERM = true, AFTER_DRAIN = false;
    const void* base; bf16_t* hb; float* ss; int ldc;
    __device__ __forceinline__ void operator()(const f32x4 (&acc)[2][2][4][2], const Unit& u, int wr, int wc, int fr, int fq) const {
        const int row0 = u.pm * BM + wr * 64 + fr, col0 = u.pn * BM + wc * 32 + 8 * fq;
#pragma unroll
        for (int ai = 0; ai < 2; ++ai)
#pragma unroll
            for (int m = 0; m < 4; ++m) { const int row = row0 + ai * HALF + m * 16; const size_t off = (size_t)row * ldc + col0; float s = 0.f;
#pragma unroll
                for (int bj = 0; bj < 2; ++bj) { f32x4 b0, b1;
                    if (BASE_BF16) { const u32x4 w = *(const u32x4*)((const bf16_t*)base + off + bj * HALF);
                        b0 = (f32x4){__uint_as_float(w.x << 16), __uint_as_float(w.x & 0xffff0000u), __uint_as_float(w.y << 16), __uint_as_float(w.y & 0xffff0000u)};
                        b1 = (f32x4){__uint_as_float(w.z << 16), __uint_as_float(w.z & 0xffff0000u), __uint_as_float(w.w << 16), __uint_as_float(w.w & 0xffff0000u)}; }
                    else { b0 = __builtin_nontemporal_load((const f32x4*)((const float*)base + off + bj * HALF)); b1 = __builtin_nontemporal_load((const f32x4*)((const float*)base + off + bj * HALF + 4)); }
                    const f32x4 x0 = b0 + acc[ai][bj][m][0], x1 = b1 + acc[ai][bj][m][1];
                    u32x4 w; w.x = cvt_pk_bf16(x0[0], x0[1]); w.y = cvt_pk_bf16(x0[2], x0[3]); w.z = cvt_pk_bf16(x1[0], x1[1]); w.w = cvt_pk_bf16(x1[2], x1[3]);
                    *(u32x4*)(hb + off + bj * HALF) = w;
                    s += ((x0[0] * x0[0] + x0[1] * x0[1]) + (x0[2] * x0[2] + x0[3] * x0[3])) + ((x1[0] * x1[0] + x1[1] * x1[1]) + (x1[2] * x1[2] + x1[3] * x1[3])); }
                s += __shfl_xor(s, 16); s += __shfl_xor(s, 32);
                if (fq == 0) ss[(size_t)row * 16 + u.pn * 4 + wc] = s; }
    }
};
struct EpiResSB {
    static constexpr bool PERM = true, AFTER_DRAIN = false;
    const float* base; bf16_t* hb; float* ss; const float* sb; int ldc;
    __device__ __forceinline__ void operator()(const f32x4 (&acc)[2][2][4][2], const Unit& u, int wr, int wc, int fr, int fq) const {
        const int row0 = u.pm * BM + wr * 64 + fr, col0 = u.pn * BM + wc * 32 + 8 * fq;
#pragma unroll
        for (int ai = 0; ai < 2; ++ai)
#pragma unroll
            for (int m = 0; m < 4; ++m) { const int row = row0 + ai * HALF + m * 16; const size_t off = (size_t)row * ldc + col0; float s = 0.f;
                const f32x4 q0 = *(const f32x4*)(sb + (size_t)row * 8), q1 = *(const f32x4*)(sb + (size_t)row * 8 + 4);
                const float rsb = 1.f / sqrtf((((q0[0] + q0[1]) + (q0[2] + q0[3])) + ((q1[0] + q1[1]) + (q1[2] + q1[3]))) * (1.f / 512.f) + 1e-6f);
#pragma unroll
                for (int bj = 0; bj < 2; ++bj) {
                    const f32x4 b0 = __builtin_nontemporal_load((const f32x4*)(base + off + bj * HALF)), b1 = __builtin_nontemporal_load((const f32x4*)(base + off + bj * HALF + 4));
                    const f32x4 x0 = b0 + acc[ai][bj][m][0] * rsb, x1 = b1 + acc[ai][bj][m][1] * rsb;
                    u32x4 w; w.x = cvt_pk_bf16(x0[0], x0[1]); w.y = cvt_pk_bf16(x0[2], x0[3]); w.z = cvt_pk_bf16(x1[0], x1[1]); w.w = cvt_pk_bf16(x1[2], x1[3]);
                    *(u32x4*)(hb + off + bj * HALF) = w;
                    s += ((x0[0] * x0[0] + x0[1] * x0[1]) + (x0[2] * x0[2] + x0[3] * x0[3])) + ((x1[0] * x1[0] + x1[1] * x1[1]) + (x1[2] * x1[2] + x1[3] * x1[3])); }
                s += __shfl_xor(s, 16); s += __shfl_xor(s, 32);
                if (fq == 0) ss[(size_t)row * 16 + u.pn * 4 + wc] = s; }
    }
};
}

constexpr int NWAVES = 8;
constexpr int BATCH = 8, SEQ = 2048, DM = 1024, M = BATCH * SEQ, MEMLEN = 256, MM = BATCH * MEMLEN;
constexpr int INCOLS = 3088;
constexpr int N1 = 3328;
constexpr int PQ = 0, PK = 256, PV = 512, POG = 1024, PSQ = 1536, PSK = 2048, PSV = 2560, PGATE = 3072;
constexpr int PEER_N = 16384;
constexpr float EPS = 1e-6f;

constexpr size_t MiB = 1u << 20;
constexpr size_t WS_CTL = 0, CTL_ZERO_BYTES = 1 * MiB;
constexpr size_t WS_W1T = 1 * MiB;
constexpr size_t WS_WOT = 8 * MiB, WS_WXQT = 10 * MiB, WS_WXOT = 12 * MiB, WS_WXKVT = 14 * MiB, WS_WPQT = 18 * MiB, WS_SUBK = 22 * MiB;
constexpr size_t WS_UB = 24 * MiB, WS_VB = 56 * MiB;
constexpr size_t WS_BUFA = 88 * MiB;
constexpr size_t WS_SSB = 75 * MiB;
constexpr size_t WS_MN = 120 * MiB;
constexpr size_t WS_KV = 124 * MiB;
constexpr size_t WS_PROJ = 132 * MiB;
constexpr size_t WS_SLOT0 = 132 * MiB, WS_SLOT1 = 164 * MiB, WS_SLOT2 = 196 * MiB, WS_VT = 76 * MiB, WS_END = 236 * MiB;
constexpr int CW_BAR = 4096;
constexpr int CW_SBSS = 32768;

constexpr int RING_BYTES = 131072;
constexpr int LDSCTL_OFF = 139264  , MISC_OFF = LDSCTL_OFF + 320;
constexpr int LDS_BYTES = 147456;

#define GAS __attribute__((address_space(1)))
#define LAS __attribute__((address_space(3)))
typedef unsigned short bf16;
typedef unsigned v4u __attribute__((ext_vector_type(4)));
typedef float f32x4 __attribute__((ext_vector_type(4)));
typedef short bf16x8 __attribute__((ext_vector_type(8)));
typedef GAS unsigned gu32;
typedef GAS unsigned long long gu64;
#define RLX_AGENT __ATOMIC_RELAXED, __HIP_MEMORY_SCOPE_AGENT
#define LDS_WAIT() asm volatile("s_waitcnt lgkmcnt(0)" ::: "memory")
#define VM_WAIT() asm volatile("s_waitcnt vmcnt(0)" ::: "memory")
__device__ __forceinline__ unsigned long long rt() { return __builtin_amdgcn_s_memrealtime(); }
__device__ __forceinline__ unsigned f2bf(float f) { unsigned u = __builtin_bit_cast(unsigned, f); return (u + 0x7fffu + ((u >> 16) & 1u)) >> 16; }
__device__ __forceinline__ unsigned pk2(float lo, float hi) { return f2bf(lo) | (f2bf(hi) << 16); }

#define XB_TMO      128
#define XB_XCNT(j)  (256  + 64 * (j))
#define XB_XSUB(j)  (1280 + 64 * (j))
#define XB_XGEN(j)  (2304 + 64 * (j))
#define XB_TOP      3328
#define XB_TOPGEN   3392
#define XCD_BAR_WORDS 3456
#define XB_SPIN_CAP (1u << 22)

__device__ __forceinline__ unsigned xb_ld(unsigned* p)              { return __hip_atomic_load(p, __ATOMIC_RELAXED, __HIP_MEMORY_SCOPE_AGENT); }
__device__ __forceinline__ unsigned xb_add(unsigned* p, unsigned v) { return __hip_atomic_fetch_add(p, v, __ATOMIC_RELAXED, __HIP_MEMORY_SCOPE_AGENT); }
__device__ __forceinline__ unsigned xb_xcc_id() { return (unsigned)__builtin_amdgcn_s_getreg((3 << 11) | 20) & 0xFu; }
#define XB_SPIN(cond, bar) do { unsigned _sp = 0; while (cond) { __builtin_amdgcn_s_sleep(1); \
    if ((++_sp & 255u) == 0u) { if (xb_ld(&(bar)[XB_TMO])) break; if (_sp > XB_SPIN_CAP) { atomicAdd(&(bar)[XB_TMO], 1u); break; } } } } while (0)

struct XcdBarrier {
    unsigned* bar; unsigned x;
    volatile LAS unsigned* st;
};

__device__ __forceinline__ XcdBarrier xcd_barrier_post(unsigned* bar, volatile LAS unsigned* st) {
    XcdBarrier b; b.bar = bar; b.x = xb_xcc_id(); b.st = st;
    if (threadIdx.x == 0) (void)xb_add(&bar[XB_XCNT(b.x)], 1u);
    return b;
}
__device__ __forceinline__ void xcd_barrier_complete(unsigned* bar, unsigned x, unsigned& nloc, unsigned& nx) {
    const unsigned G = gridDim.x * gridDim.y * gridDim.z;
    unsigned sum, cnt, mine, sp = 0u;
    for (;;) {
        sum = 0u; cnt = 0u; mine = 0u;
#pragma unroll
        for (unsigned j = 0; j < 16; ++j) { const unsigned c = xb_ld(&bar[XB_XCNT(j)]); sum += c; cnt += (c > 0u) ? 1u : 0u; mine = (j == x) ? c : mine; }
        if (sum == G) break;
        __builtin_amdgcn_s_sleep(1);
        if ((++sp & 255u) == 0u) { if (xb_ld(&bar[XB_TMO])) break; if (sp > XB_SPIN_CAP) { atomicAdd(&bar[XB_TMO], 1u); break; } }
    }
    nloc = mine > 0u ? mine : 1u; nx = cnt > 0u ? cnt : 1u;
}

__device__ __forceinline__ void xcd_barrier(const XcdBarrier& b) {
    asm volatile("s_waitcnt vmcnt(0)" ::: "memory");
    __syncthreads();
    if (threadIdx.x == 0) {
        unsigned* bar = b.bar;
        __builtin_amdgcn_s_waitcnt(0);
        unsigned nloc = b.st[0], nx = b.st[1];
        if (nloc == 0u) { xcd_barrier_complete(bar, b.x, nloc, nx); b.st[0] = nloc; b.st[1] = nx; }
        const unsigned old = xb_add(&bar[XB_XSUB(b.x)], 1u);
        const unsigned gen = old / nloc;
        if (old + 1u == (gen + 1u) * nloc) {
            __builtin_amdgcn_fence(__ATOMIC_RELEASE, "agent");
            asm volatile("s_waitcnt vmcnt(0)" ::: "memory");
            const unsigned og = xb_add(&bar[XB_TOP], 1u);
            const unsigned tg = og / nx;
            if (og + 1u == (tg + 1u) * nx) xb_add(&bar[XB_TOPGEN], 1u);
            else XB_SPIN(xb_ld(&bar[XB_TOPGEN]) == tg, bar);
            __builtin_amdgcn_fence(__ATOMIC_ACQUIRE, "agent");
            xb_add(&bar[XB_XGEN(b.x)], 1u);
            asm volatile("s_waitcnt vmcnt(0)" ::: "memory");
        } else {
            XB_SPIN(xb_ld(&bar[XB_XGEN(b.x)]) == gen, bar);
            __builtin_amdgcn_fence(__ATOMIC_ACQUIRE, "agent");
            asm volatile("s_waitcnt vmcnt(0)" ::: "memory");
        }
    }
    __syncthreads();
}

#define DI __device__ __forceinline__
typedef __bf16 bf16x2_t __attribute__((ext_vector_type(2)));
struct Args { const float* in[21]; float* out; unsigned char* ws; int ph_lo, ph_hi, li, pad; };
struct Frame {
    LAS unsigned char* lds;
    volatile LAS unsigned* MISC;
    gu32* ctl;
    int tid, lane, wave;
    int vcu, G;
    unsigned char* ws; float* out;
};
#define WSP(off) ((bf16*)(F.ws + (off)))
#define F_W1T WSP(WS_W1T)
#define F_WOT WSP(WS_WOT)
#define F_WXQT WSP(WS_WXQT)
#define F_WXOT WSP(WS_WXOT)
#define F_WXKVT WSP(WS_WXKVT)
#define F_WPQT WSP(WS_WPQT)
#define F_SUBK WSP(WS_SUBK)
#define F_UB WSP(WS_UB)
#define F_VB WSP(WS_VB)
#define F_BUFA WSP(WS_BUFA)
#define F_MN WSP(WS_MN)
#define F_KV WSP(WS_KV)
#define F_PROJ WSP(WS_PROJ)
#define F_SLOT0 WSP(WS_SLOT0)
#define F_SLOT1 WSP(WS_SLOT1)
#define F_SLOT2 WSP(WS_SLOT2)
#define F_VT WSP(WS_VT)
#define F_SSB ((float*)(F.ws + WS_SSB))
DI float bf2f(unsigned v) { return __uint_as_float(v << 16); }
DI float bflo(unsigned w) { return __uint_as_float(w << 16); }
DI float bfhi(unsigned w) { return __uint_as_float(w & 0xffff0000u); }
DI float wave_sum(float v) {
#pragma unroll
    for (int o = 1; o < 64; o <<= 1) v += __shfl_xor(v, o);
    return v;
}
DI float wave_max(float v) {
#pragma unroll
    for (int o = 1; o < 64; o <<= 1) v = fmaxf(v, __shfl_xor(v, o));
    return v;
}
DI float dot2_bf16(unsigned w, unsigned x, float a) { return __builtin_amdgcn_fdot2_f32_bf16(__builtin_bit_cast(bf16x2_t, w), __builtin_bit_cast(bf16x2_t, x), a, false); }
DI float silu_f(float x) { return x * __builtin_amdgcn_rcpf(1.f + __expf(-x)); }
DI float log_sigmoid_f(float z) { return fminf(z, 0.f) - __logf(1.f + __expf(-fabsf(z))); }
DI float gelu_tanh_f(float x) { const float y = 0.7978845608028654f * (x + 0.044715f * x * x * x); const float t = 1.f - 2.f / (1.f + __expf(2.f * y)); return 0.5f * x * (1.f + t); }

DI void p0_transpose_item(const float* W, int ldw, int c0, bf16* WT, int row_off, LAS float* scr, int kb, int nb, int lane, const float* kgain = nullptr) {
    const int k0 = 64 * kb, n0 = 32 * nb;
    float tv[32];
#pragma unroll
    for (int i = 0; i < 32; ++i) tv[i] = __builtin_nontemporal_load(W + (size_t)(k0 + 2 * i + (lane >> 5)) * ldw + c0 + n0 + (lane & 31));
    if (kgain) {
#pragma unroll
        for (int i = 0; i < 32; ++i) tv[i] *= kgain[k0 + 2 * i + (lane >> 5)];
    }
#pragma unroll
    for (int i = 0; i < 32; ++i) scr[(2 * i + (lane >> 5)) * 33 + (lane & 31)] = tv[i];
    LDS_WAIT(); asm volatile("" ::: "memory");
    const int c = lane & 7;
#pragma unroll
    for (int j = 0; j < 4; ++j) { const int n = (lane >> 3) + 8 * j; const LAS float* s = scr + (8 * c) * 33 + n;
        v4u o; o.x = pk2(s[0 * 33], s[1 * 33]); o.y = pk2(s[2 * 33], s[3 * 33]); o.z = pk2(s[4 * 33], s[5 * 33]); o.w = pk2(s[6 * 33], s[7 * 33]);
        *(GAS v4u*)(WT + (size_t)(row_off + n0 + n) * 1024 + k0 + 8 * c) = o; }
    LDS_WAIT(); asm volatile("" ::: "memory");
}
DI void rms_row_to_bf16(int lane, const float* xrow, const float* g, bf16* orow) {
    const GAS f32x4* xr = (const GAS f32x4*)xrow + lane; const GAS f32x4* gr = (const GAS f32x4*)g + lane;
    f32x4 v[4]; float s = 0.f;
#pragma unroll
    for (int j = 0; j < 4; ++j) { v[j] = __builtin_nontemporal_load(xr + 64 * j); s += (v[j].x * v[j].x + v[j].y * v[j].y) + (v[j].z * v[j].z + v[j].w * v[j].w); }
    const float rs = 1.f / sqrtf(wave_sum(s) * (1.f / 1024.f) + EPS);
    GAS unsigned long long* o8 = (GAS unsigned long long*)orow + lane;
#pragma unroll
    for (int j = 0; j < 4; ++j) { const f32x4 gg = gr[64 * j]; const f32x4 y = v[j] * rs * gg; o8[64 * j] = (unsigned long long)pk2(y.x, y.y) | ((unsigned long long)pk2(y.z, y.w) << 32); }
}
typedef float f32x2 __attribute__((ext_vector_type(2)));
constexpr size_t WS_U8 = 24 * MiB, WS_V8 = 40 * MiB, WS_X8 = 56 * MiB, WS_SU = 72 * MiB, WS_SX = 72 * MiB + 65536, WS_SV = 72 * MiB + 131072;
template <int CTRL> DI int dpp_i(int v) { return __builtin_amdgcn_update_dpp(0, v, CTRL, 0xf, 0xf, false); }
DI int lane_fresh() { int l; asm volatile("v_mbcnt_lo_u32_b32 %0, -1, 0\n\tv_mbcnt_hi_u32_b32 %0, -1, %0" : "=v"(l)); return l; }
template <int CTRL> DI float dpp_f(float v) { return __int_as_float(__builtin_amdgcn_update_dpp(0, __float_as_int(v), CTRL, 0xf, 0xf, false)); }
typedef float f32x16v __attribute__((ext_vector_type(16)));
typedef int i32x6v __attribute__((ext_vector_type(6)));
typedef unsigned u32x3v __attribute__((ext_vector_type(3)));
DI unsigned fp6_e2m3(float x) {
    const float m = fminf(fabsf(x), 7.5f);
    const int e = m >= 4.f ? 2 : m >= 2.f ? 1 : 0;
    const int q = (int)rintf(m * (e == 2 ? 2.f : e == 1 ? 4.f : 8.f));
    const unsigned code = e == 0 ? (unsigned)q : (unsigned)((e + 1) * 8 + (q - 8));
    return (x < 0.f ? 32u : 0u) | (code > 31u ? 31u : code);
}
template <int R> DI void rms_rows_to_bf16(int lane, const float* x0, size_t xstride, const float* g, bf16* o0, size_t ostride) {
    f32x4 v[R][4];
#pragma unroll
    for (int r = 0; r < R; ++r)
#pragma unroll
        for (int j = 0; j < 4; ++j) v[r][j] = __builtin_nontemporal_load((const GAS f32x4*)(x0 + r * xstride) + lane + 64 * j);
    f32x4 gg[4];
#pragma unroll
    for (int j = 0; j < 4; ++j) gg[j] = *((const GAS f32x4*)g + lane + 64 * j);
#pragma unroll
    for (int r = 0; r < R; ++r) { float s = 0.f;
#pragma unroll
        for (int j = 0; j < 4; ++j) s += (v[r][j].x * v[r][j].x + v[r][j].y * v[r][j].y) + (v[r][j].z * v[r][j].z + v[r][j].w * v[r][j].w);
        const float rs = 1.f / sqrtf(wave_sum(s) * (1.f / 1024.f) + EPS);
        GAS unsigned long long* o8 = (GAS unsigned long long*)(o0 + r * ostride) + lane;
#pragma unroll
        for (int j = 0; j < 4; ++j) { const f32x4 y = v[r][j] * rs * gg[j]; o8[64 * j] = (unsigned long long)pk2(y.x, y.y) | ((unsigned long long)pk2(y.z, y.w) << 32); } }
}
DI void p0_prologue(Frame& F, const Args& A) {
    LAS float* scr = (LAS float*)(F.lds + F.wave * 16384);
    const int gw = F.vcu * NWAVES + F.wave, NGW = F.G * NWAVES;
    constexpr int I_IN = 16 * 48, I_W2 = 16 * 64;
    constexpr int NIT = 2 * I_IN + I_W2;
    for (int it = gw; it < NIT; it += NGW) {
        int r = it;
        if (r < I_IN) { p0_transpose_item(A.in[3], INCOLS, 0, F_W1T, 0, scr, r / 48, r % 48, F.lane); continue; } r -= I_IN;
        if (r < I_IN) { p0_transpose_item(A.in[3], INCOLS, 1552, F_W1T, 1536, scr, r / 48, r % 48, F.lane); continue; } r -= I_IN;
        p0_transpose_item(A.in[13], 2048, 0, F_WXKVT, 0, scr, r / 64, r % 64, F.lane);
    }
    const int gt = gw * 64 + F.lane, NGT = NGW * 64;
    for (int i = gt; i < 256 * 512; i += NGT) {
        const int n = i >> 9, k0 = (i & 511) * 2;
        float gv[16];
#pragma unroll
        for (int r = 0; r < 16; ++r) gv[r] = A.in[5][r * 256 + n];
        float s[2];
#pragma unroll
        for (int j = 0; j < 2; ++j) { const GAS f32x4* wr_ = (const GAS f32x4*)(A.in[3] + (size_t)(k0 + j) * INCOLS + 1536); float a = 0.f;
#pragma unroll
            for (int q = 0; q < 4; ++q) { const f32x4 w4 = wr_[q]; a += (w4.x * gv[4 * q] + w4.y * gv[4 * q + 1]) + (w4.z * gv[4 * q + 2] + w4.w * gv[4 * q + 3]); }
            s[j] = a; }
        *(GAS unsigned*)(F_W1T + (size_t)(3072 + n) * 1024 + k0) = pk2(s[0], s[1]);
    }
    for (int m = 4 * gw; m < M; m += 4 * NGW) rms_rows_to_bf16<4>(F.lane, A.in[0] + (size_t)m * DM, DM, A.in[2], F_BUFA + (size_t)m * DM, DM);
    for (int m = gw; m < MM; m += NGW) rms_row_to_bf16(F.lane, A.in[1] + (size_t)m * DM, A.in[11], F_MN + (size_t)m * DM);
}
template <int R> DI void quant_rows_i8(int lane, const float* src, unsigned char* dst, float* scale_out) {
    f32x4 v[R][4];
#pragma unroll
    for (int r = 0; r < R; ++r)
#pragma unroll
        for (int j = 0; j < 4; ++j) v[r][j] = __builtin_nontemporal_load((const GAS f32x4*)(src + (size_t)r * 1024 + 256 * j + 4 * lane));
#pragma unroll
    for (int r = 0; r < R; ++r) { float m = 0.f;
#pragma unroll
        for (int j = 0; j < 4; ++j) m = fmaxf(m, fmaxf(fmaxf(fabsf(v[r][j].x), fabsf(v[r][j].y)), fmaxf(fabsf(v[r][j].z), fabsf(v[r][j].w))));
        m = wave_max(m);
        const float sc = m > 0.f ? m * (1.f / 127.f) : 1.f, inv = 1.f / sc;
        v4u o;
#pragma unroll
        for (int j = 0; j < 4; ++j) { const int a = (int)rintf(v[r][j].x * inv), b = (int)rintf(v[r][j].y * inv), c = (int)rintf(v[r][j].z * inv), d = (int)rintf(v[r][j].w * inv);
            o[j] = (unsigned)(a & 255) | ((unsigned)(b & 255) << 8) | ((unsigned)(c & 255) << 16) | ((unsigned)(d & 255) << 24); }
        __builtin_nontemporal_store(o, (GAS v4u*)(dst + (size_t)r * 1024 + 16 * lane));
        if (lane == 0) scale_out[r] = sc; }
}
template <int R> DI void quant_rows_fp6(int lane, const float* src, unsigned char* dst, float* sc) {
    f32x4 t[R][4];
#pragma unroll
    for (int r = 0; r < R; ++r)
#pragma unroll
        for (int j = 0; j < 4; ++j) t[r][j] = __builtin_nontemporal_load((const GAS f32x4*)(src + (size_t)r * 1024 + 256 * j + 4 * lane));
#pragma unroll
    for (int r = 0; r < R; ++r) { float mx = 0.f;
#pragma unroll
        for (int j = 0; j < 4; ++j) mx = fmaxf(mx, fmaxf(fmaxf(fabsf(t[r][j].x), fabsf(t[r][j].y)), fmaxf(fabsf(t[r][j].z), fabsf(t[r][j].w))));
        mx = wave_max(mx);
        const float s_ = mx > 0.f ? mx * (1.f / 7.5f) : 1.f, inv = 1.f / s_;
        unsigned long long lo = 0ull; unsigned hi = 0u;
#pragma unroll
        for (int i = 0; i < 16; ++i) { const unsigned long long c = fp6_e2m3(t[r][i >> 2][i & 3] * inv);
            if (6 * i < 64) lo |= c << (6 * i);
            if (6 * i + 6 > 64) hi |= (unsigned)(6 * i >= 64 ? c << (6 * i - 64) : c >> (64 - 6 * i)); }
        __builtin_nontemporal_store((u32x3v){(unsigned)lo, (unsigned)(lo >> 32), hi}, (GAS u32x3v*)(dst + (size_t)r * 768 + 12 * lane));
        if (lane == 0) sc[2 * r] = s_; }
}
constexpr int QT_SPLIT = 8192;
template <int R> DI void quant_rows_i4(int lane, const float* src, unsigned char* dst, float* scale_out  ) {
    f32x4 v[R][4];
#pragma unroll
    for (int r = 0; r < R; ++r)
#pragma unroll
        for (int j = 0; j < 4; ++j) v[r][j] = __builtin_nontemporal_load((const GAS f32x4*)(src + (size_t)r * 1024 + 256 * j + 4 * lane));
#pragma unroll
    for (int r = 0; r < R; ++r) { float m = 0.f;
#pragma unroll
        for (int j = 0; j < 4; ++j) m = fmaxf(m, fmaxf(fmaxf(fabsf(v[r][j].x), fabsf(v[r][j].y)), fmaxf(fabsf(v[r][j].z), fabsf(v[r][j].w))));
        m = wave_max(m);
        float q2 = 0.f;
#pragma unroll
        for (int j = 0; j < 4; ++j) q2 += (v[r][j].x * v[r][j].x + v[r][j].y * v[r][j].y) + (v[r][j].z * v[r][j].z + v[r][j].w * v[r][j].w);
        const float rms = sqrtf(wave_sum(q2) * (1.f / 1024.f));
        const float rng = fminf(m, 2.5f * rms);
        const float sc = rng > 0.f ? rng * (1.f / 7.f) : 1.f, inv = 1.f / sc;
        unsigned w0 = 0u, w1 = 0u;
#pragma unroll
        for (int i = 0; i < 8; ++i) { const int a = (int)rintf(fminf(fmaxf(v[r][i >> 2][i & 3] * inv, -7.f), 7.f)), b = (int)rintf(fminf(fmaxf(v[r][2 + (i >> 2)][i & 3] * inv, -7.f), 7.f));
            w0 |= ((unsigned)a & 15u) << (4 * i); w1 |= ((unsigned)b & 15u) << (4 * i); }
        __builtin_nontemporal_store((unsigned long long)w0 | ((unsigned long long)w1 << 32), (GAS unsigned long long*)(dst + (size_t)r * 512 + 16 * (lane & 31) + 8 * (lane >> 5)));
        if (lane == 0) scale_out[2 * r] = sc; }
}
DI void quant_tables(Frame& F, const Args& A, int widx, int nw, int r0, int r1) {
    for (int m = r0 + 4 * widx; m < r1; m += 4 * nw) quant_rows_i4<4>(F.lane, A.in[18] + (size_t)m * DM, F.ws + WS_U8 + (size_t)m * 512, (float*)(F.ws + WS_SU) + 2 * m);
    for (int m = r0 + 4 * widx; m < r1; m += 4 * nw) quant_rows_fp6<4>(F.lane, A.in[19] + (size_t)m * DM, F.ws + WS_V8 + (size_t)m * 768, (float*)(F.ws + WS_SU) + 2 * m + 1);
}
DI void p0_late(Frame& F, const Args& A, int widx, int nw) {
    LAS float* scr = (LAS float*)(F.lds + F.wave * 16384);
    constexpr int I_SQ = 16 * 32, I_W2 = 16 * 64;
    for (int it = (widx >= nw / 2 ? widx - nw / 2 : widx + nw / 2); it < 3 * I_SQ + I_W2; it += nw) {
        int r = it;
        if (r < I_SQ) { p0_transpose_item(A.in[9], 1024, 0, F_WOT, 0, scr, r / 32, r % 32, F.lane); continue; } r -= I_SQ;
        if (r < I_SQ) { p0_transpose_item(A.in[12], 1024, 0, F_WXQT, 0, scr, r / 32, r % 32, F.lane, A.in[10]); continue; } r -= I_SQ;
        if (r < I_SQ) { p0_transpose_item(A.in[14], 1024, 0, F_WXOT, 0, scr, r / 32, r % 32, F.lane); continue; } r -= I_SQ;
        p0_transpose_item(A.in[16], 2048, 0, F_WPQT, 0, scr, r / 64, r % 64, F.lane, A.in[15]);
    }
    for (int i = widx * 64 + F.lane; i < 32768; i += nw * 64) {
        const f32x4 a = *(const GAS f32x4*)(A.in[17] + (size_t)i * 8), b = *(const GAS f32x4*)(A.in[17] + (size_t)i * 8 + 4);
        v4u o; o.x = pk2(a.x, a.y); o.y = pk2(a.z, a.w); o.z = pk2(b.x, b.y); o.w = pk2(b.z, b.w);
        *(GAS v4u*)(F_SUBK + (size_t)i * 8) = o;
    }
    quant_tables(F, A, widx, nw, 0, QT_SPLIT);
}

typedef float f32x16 __attribute__((ext_vector_type(16)));
typedef short s16x4 __attribute__((ext_vector_type(4)));
DI s16x4 lds_tr16(const LAS unsigned char* p) { return __builtin_bit_cast(s16x4, __builtin_amdgcn_ds_read_tr16_b64_v4i16((LAS s16x4*)p)); }
DI unsigned cvtpk_bf16(float lo, float hi) { typedef float f2 __attribute__((ext_vector_type(2))); f2 v = {lo, hi}; bf16x2_t b = __builtin_convertvector(v, bf16x2_t); return __builtin_bit_cast(unsigned, b); }
constexpr float SB_C2 = 0.125f * 1.4426950408889634f;
template <bool MASKED> DI void sb_weights(f32x16& P0, f32x16& P1, float& carry, int hi, int qrel2) {
    float T[8], cs[8], pc[8];
    int q4 = qrel2 - 4 * hi; asm volatile("" : "+v"(q4));
#pragma unroll
    for (int pi = 0; pi < 2; ++pi) {
        f32x16& P = pi ? P1 : P0;
#pragma unroll
        for (int g = 0; g < 4; ++g) {
            float bv[4], ov[4];
#pragma unroll
            for (int i = 0; i < 4; ++i) {
                const float e = __builtin_amdgcn_exp2f(fminf(P[4 * g + i] * (-SB_C2), 126.f));
                float bt = __builtin_amdgcn_rcpf(1.f + e), om = e * bt;
                if (MASKED) { const bool valid = (32 * pi + 8 * g + i) < q4; bt = valid ? bt : 0.f; om = valid ? om : 1.f; }
                bv[i] = bt; ov[i] = om;
            }
            const float a = ov[3], b = a * ov[2], c = b * ov[1];
            cs[4 * pi + g] = c * ov[0];
            P[4 * g + 3] = bv[3]; P[4 * g + 2] = bv[2] * a; P[4 * g + 1] = bv[1] * b; P[4 * g + 0] = bv[0] * c;
        }
    }
#pragma unroll
    for (int k = 0; k < 8; ++k) { auto rr = __builtin_amdgcn_permlane32_swap(__float_as_uint(cs[k]), __float_as_uint(cs[k]), false, false);
        T[k] = __uint_as_float(rr[0]) * __uint_as_float(rr[1]); pc[k] = hi ? 1.f : __uint_as_float(rr[1]); }
    float run = __builtin_amdgcn_exp2f(carry), tile = 1.f;
#pragma unroll
    for (int k = 7; k >= 0; --k) {
        const float E = run * pc[k];
        f32x16& P = (k >> 2) ? P1 : P0; const int g = k & 3;
#pragma unroll
        for (int i = 0; i < 4; ++i) P[4 * g + i] *= E;
        run *= T[k]; tile *= T[k];
    }
    carry += __builtin_amdgcn_logf(tile);
}
DI void sb_wave(Frame& F, const Args& A, int b, int h, int rb) {
    const int lane = lane_fresh(), wid = F.wave, r32 = lane & 31, hi = lane >> 5;
    const size_t rowbase = (size_t)b * SEQ; const int wrow0 = rb * 32;
    const bf16* Kg = F_PROJ + rowbase * N1 + PSK + h * 64;
    const bf16* Vg = F_PROJ + rowbase * N1 + PSV + h * 64;
    bf16x8 qr[4];
    { const bf16* Qw = F_PROJ + (rowbase + wrow0 + r32) * N1 + PSQ + h * 64;
#pragma unroll
      for (int ks = 0; ks < 4; ++ks) qr[ks] = *(const GAS bf16x8*)(Qw + ks * 16 + hi * 8); }
    LAS unsigned char* vbuf = F.lds + wid * 16384;
    const int vfr = ((lane >> 4) & 1) * 32 + (lane & 3) * 8 + (4 * hi + ((lane & 15) >> 2)) * 64;
    const unsigned ko0 = (unsigned)(r32 * N1 + hi * 8) * 2u, vo0 = (unsigned)((lane >> 2) * N1 + (lane & 3) * 8) * 2u;
    f32x16 o0 = {}, o1 = {};
    float carry = 0.f;
    int kt = (wrow0 + 30) >> 6;
    bf16x8 kf[8]; v4u vr[8];
#define SBW_LOADK(t) do { const char* kb_ = (const char*)Kg + (size_t)(t) * 64 * N1 * 2; const char* kb1_ = kb_ + 32 * N1 * 2; asm volatile("" : "+s"(kb1_)); _Pragma("unroll") for (int ks = 0; ks < 4; ++ks) { kf[2 * ks] = *(const GAS bf16x8*)(kb_ + ko0 + ks * 32); kf[2 * ks + 1] = *(const GAS bf16x8*)(kb1_ + ko0 + ks * 32); } } while (0)
#define SBW_LOADV(t) do { const char* vb_ = (const char*)Vg + (size_t)(t) * 64 * N1 * 2; _Pragma("unroll") for (int i = 0; i < 4; ++i) { const char* vbi_ = vb_ + i * 16 * N1 * 2; asm volatile("" : "+s"(vbi_)); vr[i] = *(const GAS v4u*)(vbi_ + vo0); vr[4 + i] = *(const GAS v4u*)(vbi_ + vo0 + 64); } } while (0)
    SBW_LOADK(kt); SBW_LOADV(kt);
    int cur = 0;
    for (;;) {
        const int k0 = kt * 64;
#pragma unroll
        for (int p = 0; p < 8; ++p) *(LAS v4u*)(vbuf + cur * 8192 + p * 1024 + lane * 16) = vr[p];
        f32x16 P0 = {}, P1 = {};
#pragma unroll
        for (int ks = 0; ks < 4; ++ks) { P0 = __builtin_amdgcn_mfma_f32_32x32x16_bf16(kf[2 * ks], qr[ks], P0, 0, 0, 0); P1 = __builtin_amdgcn_mfma_f32_32x32x16_bf16(kf[2 * ks + 1], qr[ks], P1, 0, 0, 0); }
        __builtin_amdgcn_sched_barrier(0);
        if (kt > 0) SBW_LOADV(kt - 1);
        __builtin_amdgcn_sched_barrier(0);
        if (k0 + 63 >= wrow0) sb_weights<true>(P0, P1, carry, hi, wrow0 + r32 - k0);
        else sb_weights<false>(P0, P1, carry, hi, 0);
        __builtin_amdgcn_sched_barrier(0);
        if (kt > 0) SBW_LOADK(kt - 1);
        __builtin_amdgcn_sched_barrier(0);
        LDS_WAIT();
#pragma unroll
        for (int s = 0; s < 4; ++s) {
            const f32x16& P = (s >> 1) ? P1 : P0; const int rbb = (s & 1) * 8;
            v4u pw; pw.x = cvtpk_bf16(P[rbb + 0], P[rbb + 1]); pw.y = cvtpk_bf16(P[rbb + 2], P[rbb + 3]); pw.z = cvtpk_bf16(P[rbb + 4], P[rbb + 5]); pw.w = cvtpk_bf16(P[rbb + 6], P[rbb + 7]);
            const bf16x8 pa = __builtin_bit_cast(bf16x8, pw);
            const LAS unsigned char* vq = vbuf + cur * 8192 + vfr + s * 1024;
            const s16x4 l0 = lds_tr16(vq), h0 = lds_tr16(vq + 512), l1 = lds_tr16(vq + 4096), h1 = lds_tr16(vq + 4096 + 512);
            const bf16x8 v0 = {l0[0], l0[1], l0[2], l0[3], h0[0], h0[1], h0[2], h0[3]}, v1 = {l1[0], l1[1], l1[2], l1[3], h1[0], h1[1], h1[2], h1[3]};
            o0 = __builtin_amdgcn_mfma_f32_32x32x16_bf16(pa, v0, o0, 0, 0, 0);
            o1 = __builtin_amdgcn_mfma_f32_32x32x16_bf16(pa, v1, o1, 0, 0, 0);
        }
        if (kt == 0 || __all(carry < -160.f)) break;
        --kt; cur ^= 1;
    }
#undef SBW_LOADK
#undef SBW_LOADV
    const int le = lane_fresh();
    const int r32e = le & 31, hie = le >> 5;
    {
        float t8[8], t4[4], t2[2];
        const bool c0 = le & 1, c1 = le & 2, c2 = le & 4, c3 = le & 8;
#pragma unroll
        for (int i = 0; i < 8; ++i) { const float sa = o0[2 * i] * o0[2 * i] + o1[2 * i] * o1[2 * i], sb = o0[2 * i + 1] * o0[2 * i + 1] + o1[2 * i + 1] * o1[2 * i + 1];
            t8[i] = (c0 ? sb : sa) + dpp_f<0xB1>(c0 ? sa : sb); }
#pragma unroll
        for (int i = 0; i < 4; ++i) t4[i] = (c1 ? t8[2 * i + 1] : t8[2 * i]) + dpp_f<0x4E>(c1 ? t8[2 * i] : t8[2 * i + 1]);
#pragma unroll
        for (int i = 0; i < 2; ++i) t2[i] = (c2 ? t4[2 * i + 1] : t4[2 * i]) + dpp_f<0x124>(c2 ? t4[2 * i] : t4[2 * i + 1]);
        float tx = (c3 ? t2[1] : t2[0]) + dpp_f<0x128>(c3 ? t2[0] : t2[1]);
        tx += __int_as_float(__builtin_amdgcn_ds_swizzle(__float_as_int(tx), 0x401F));
        const int j = le & 15;
        if (!(le & 16)) F_SSB[(rowbase + wrow0 + (j & 3) + 8 * (j >> 2) + 4 * hie) * 8 + h] = tx;
    }
    {
        const float g0 = A.in[8][h * 64 + r32e], g1 = A.in[8][h * 64 + 32 + r32e];
        LAS unsigned char* stg = vbuf + hie * (4 * 144) + r32e * 2;
#pragma unroll
        for (int r = 0; r < 16; ++r) { const int rr = (r & 3) + 8 * (r >> 2); const unsigned w = cvtpk_bf16(o0[r] * g0, o1[r] * g1);
            *(LAS bf16*)(stg + rr * 144) = (bf16)(w & 0xffffu); *(LAS bf16*)(stg + rr * 144 + 64) = (bf16)(w >> 16); }
        LDS_WAIT(); asm volatile("" ::: "memory");
        bf16* op = F_BUFA + (rowbase + wrow0 + (le >> 3)) * 1024 + 512 + h * 64 + (le & 7) * 8; const LAS unsigned char* sp = vbuf + (le >> 3) * 144 + (le & 7) * 16;
#pragma unroll
        for (int i = 0; i < 4; ++i) { *(GAS v4u*)(op) = *(const LAS v4u*)(sp); op += 8 * 1024; sp += 8 * 144; }
    }
    LDS_WAIT(); asm volatile("" ::: "memory");
}
constexpr int GL_CS = 1040;
constexpr int GL_QT = 0, GL_KT = 8320, GL_KD = 49152  , GL_V = 28672, GL_ST = 49152, GL_SEG = 69632, GL_RED = 71680, GL_KDP = 192, GL_VP = 320;
constexpr int CW_DECAY = 65536;
constexpr int CW_DSEG = 131072;
template <bool ACC> DI bf16x8 tr_frag(const LAS unsigned char* base, int PB, int x0, int k0, int lane) {
    const int hi = lane >> 5, rr = (lane & 15) >> 2, col = x0 + 16 * ((lane >> 4) & 1) + 4 * (lane & 3);
    const int r0 = ACC ? (k0 + 4 * hi + rr) : (k0 + 8 * hi + rr), r1 = ACC ? (r0 + 8) : (r0 + 4);
    const s16x4 a = lds_tr16(base + r0 * PB + col * 2), b = lds_tr16(base + r1 * PB + col * 2);
    return (bf16x8){a[0], a[1], a[2], a[3], b[0], b[1], b[2], b[3]};
}
constexpr int GL_RQ = 73728, GL_RK = 82432, GL_RG = 91136, GL_RV = 99328;
DI void gla_stage_load(Frame& F, int b, int h, int n, v4u (&w)[6]) {
    const int tid = F.tid; const size_t row0 = (size_t)b * SEQ + 64 * n;
#pragma unroll
    for (int i = 0; i < 6; ++i) {
        const int c = tid + 512 * i;
        const int reg = (c >= 536) + (c >= 1072) + (c >= 1584);
        const int cc = c - (reg == 1 ? 536 : reg == 2 ? 1072 : reg == 3 ? 1584 : 0);
        const int rr = reg == 3 ? (cc >> 4) : (cc >> 3), ch = reg == 3 ? (cc & 15) : (cc & 7);
        const int r = rr + (reg == 2 ? 3 : 0);
        const int col = (reg == 0 ? PQ + h * 64 : reg == 1 ? PK + h * 64 : reg == 2 ? PGATE + h * 64 : PV + h * 128) + ch * 8;
        const bool ok = (c < 2656) && (64 * n - 3 + r >= 0);
        w[i] = (v4u){0u, 0u, 0u, 0u};
        if (ok) w[i] = *(const GAS v4u*)(F_PROJ + (row0 - 3 + r) * N1 + col);
    }
}
DI void gla_prep(Frame& F, const Args& A, int b, int h, int n, const v4u (&w)[6]) {
    const int tid = F.tid, d = tid & 63, seg = tid >> 6;
    const float* cw = A.in[4];
    float wq[4], wk[4], wv[4];
#pragma unroll
    for (int k = 0; k < 4; ++k) { wq[k] = cw[k * 1024 + PQ + h * 64 + d]; wk[k] = cw[k * 1024 + PK + h * 64 + d]; wv[k] = cw[k * 1024 + PV + h * 128 + (tid & 127)]; }
    const float bias = A.in[6][h * 64 + d];
#pragma unroll
    for (int i = 0; i < 6; ++i) {
        const int c = tid + 512 * i;
        const int reg = (c >= 536) + (c >= 1072) + (c >= 1584);
        const int cc = c - (reg == 1 ? 536 : reg == 2 ? 1072 : reg == 3 ? 1584 : 0);
        const int rr = reg == 3 ? (cc >> 4) : (cc >> 3), ch = reg == 3 ? (cc & 15) : (cc & 7);
        const int lo_ = (reg == 0 ? GL_RQ : reg == 1 ? GL_RK : reg == 2 ? GL_RG : GL_RV) + rr * (reg == 3 ? 256 : 128) + ch * 16;
        if (c < 2656) *(LAS v4u*)(F.lds + lo_) = w[i];
    }
    __syncthreads();
    {
        float rq[11], rk[11], gl[8];
#pragma unroll
        for (int i = 0; i < 11; ++i) { rq[i] = bf2f(*(const LAS bf16*)(F.lds + GL_RQ + (8 * seg + i) * 128 + d * 2)); rk[i] = bf2f(*(const LAS bf16*)(F.lds + GL_RK + (8 * seg + i) * 128 + d * 2)); }
#pragma unroll
        for (int j = 0; j < 8; ++j) gl[j] = log_sigmoid_f(bf2f(*(const LAS bf16*)(F.lds + GL_RG + (8 * seg + j) * 128 + d * 2)) + bias) * (1.f / 16.f);
        float c = 0.f;
#pragma unroll
        for (int j = 0; j < 8; ++j) { c += gl[j]; gl[j] = c; }
        LAS float* SEG = (LAS float*)(F.lds + GL_SEG);
        SEG[seg * 64 + d] = c;
        __syncthreads();
        float pre = 0.f, tot = 0.f;
#pragma unroll
        for (int s = 0; s < 8; ++s) { const float v = SEG[s * 64 + d]; pre += (s < seg) ? v : 0.f; tot += v; }
#pragma unroll
        for (int j = 0; j < 8; ++j) {
            const int tok = 8 * seg + j; const float cum = pre + gl[j];
            const float qc = silu_f(wq[0] * rq[j] + wq[1] * rq[j + 1] + wq[2] * rq[j + 2] + wq[3] * rq[j + 3]);
            const float kc = silu_f(wk[0] * rk[j] + wk[1] * rk[j + 1] + wk[2] * rk[j + 2] + wk[3] * rk[j + 3]);
            *(LAS bf16*)(F.lds + GL_KD + tok * GL_KDP + d * 2) = (bf16)f2bf(kc * __expf(tot - cum));
            { const int off = (d >> 3) * GL_CS + tok * 16 + (d & 7) * 2;
                *(LAS bf16*)(F.lds + GL_QT + off) = (bf16)f2bf(qc * 0.125f * __expf(cum)); *(LAS bf16*)(F.lds + GL_KT + off) = (bf16)f2bf(kc * __expf(-cum)); }
        }
        if (seg == 0) { const float et_ = __expf(tot); ((float*)(F.ctl + CW_DECAY))[((size_t)(b * 4 + h) * 32 + n) * 64 + d] = et_; ((LAS float*)(F.lds + GL_RED))[d] = et_; }
    }
    {
        const int e = tid & 127, s4 = tid >> 7;
        float rv[19];
#pragma unroll
        for (int i = 0; i < 19; ++i) rv[i] = bf2f(*(const LAS bf16*)(F.lds + GL_RV + (16 * s4 + i) * 256 + e * 2));
#pragma unroll
        for (int j = 0; j < 16; ++j) *(LAS bf16*)(F.lds + GL_V + (16 * s4 + j) * GL_VP + e * 2) = (bf16)f2bf(silu_f(wv[0] * rv[j] + wv[1] * rv[j + 1] + wv[2] * rv[j + 2] + wv[3] * rv[j + 3]));
    }
}
DI int gla_img_lds(int tid, int i) { const int q = tid + 512 * (i & 1); return i < 2 ? (i == 0 ? GL_QT : GL_KT) + (tid >> 6) * GL_CS + (tid & 63) * 16 : GL_V + (q >> 4) * GL_VP + (q & 15) * 16; }
#define GLA_AGG ((float*)F.out + (size_t)4 * 1024 * 1024)
#define GLA_IMG ((unsigned char*)F.out + (size_t)M * 2048)
DI void gla_img_load(Frame& F, const bf16* STW, int b, int h, int n, v4u (&w)[8], float (&dk)[2]) {
    const unsigned char* img = GLA_IMG + (size_t)((b * 4 + h) * 32 + n) * 32768;
#pragma unroll
    for (int i = 0; i < 4; ++i) w[i] = *(const GAS v4u*)(img + (F.tid + 512 * i) * 16);
    const bf16* sp = STW + ((size_t)(b * 4 + h) * 32 + n) * 64 * 128;
#pragma unroll
    for (int i = 0; i < 2; ++i) { const int q_ = F.tid + 512 * i; w[6 + i] = *(const GAS v4u*)(F_PROJ + ((size_t)b * SEQ + 64 * n + (q_ >> 4)) * N1 + POG + h * 128 + (q_ & 15) * 8); }
#pragma unroll
    for (int i = 0; i < 2; ++i) { w[4 + i] = *(const GAS v4u*)(sp + (F.tid + i * 512) * 8); dk[i] = ((const float*)(F.ctl + CW_DECAY))[((size_t)(b * 4 + h) * 32 + n) * 64 + (((F.tid + i * 512) * 8) >> 7)]; }
}
DI void gla_local_unit(Frame& F, const Args& A, bf16* STW, int b, int h, int n, v4u (&w)[6], int nb, int nh, int nn, f32x16& agg, float& dsegp) {
    __syncthreads();
    gla_prep(F, A, b, h, n, w);
    gla_stage_load(F, nb, nh, nn, w);
    __syncthreads();
    {
        unsigned char* img = GLA_IMG + (size_t)((b * 4 + h) * 32 + n) * 32768;
#pragma unroll
        for (int i = 0; i < 4; ++i) *(GAS v4u*)(img + (F.tid + 512 * i) * 16) = *(const LAS v4u*)(F.lds + gla_img_lds(F.tid, i));
    }
    const int lane = F.lane, wid = F.wave, dt = wid & 1, et = wid >> 1, r32 = lane & 31, hi = lane >> 5;
    f32x16 acc = {};
#pragma unroll
    for (int ks = 0; ks < 4; ++ks) {
        const bf16x8 af = tr_frag<false>(F.lds + GL_KD, GL_KDP, 32 * dt, 16 * ks, lane), bfr = tr_frag<false>(F.lds + GL_V, GL_VP, 32 * et, 16 * ks, lane);
        acc = __builtin_amdgcn_mfma_f32_32x32x16_bf16(af, bfr, acc, 0, 0, 0);
    }
    bf16* o = STW + (((size_t)(b * 4 + h) * 32 + n) * 64 + 32 * dt) * 128 + 32 * et + r32;
#pragma unroll
    for (int r = 0; r < 16; ++r) o[(size_t)((r & 3) + 8 * (r >> 2) + 4 * hi) * 128] = (bf16)f2bf(acc[r]);
    const LAS float* DEC = (const LAS float*)(F.lds + GL_RED);
#pragma unroll
    for (int r = 0; r < 16; ++r) agg[r] = DEC[32 * dt + (r & 3) + 8 * (r >> 2) + 4 * hi] * agg[r] + acc[r];
    if (F.tid < 64) dsegp *= DEC[F.tid];
}
constexpr int GL_OGS = GL_RQ, GL_OST = GL_ST, GL_OP = 272;
DI void gla_out_unit(Frame& F, const Args& A, const bf16* STW, int b, int h, int n, v4u (&w)[8], float (&dk)[2], float (&st)[2][8], int nb, int nh, int nn) {
    __syncthreads();
#pragma unroll
    for (int i = 0; i < 2; ++i) { const int q_ = F.tid + 512 * i; *(LAS v4u*)(F.lds + GL_OGS + (q_ >> 4) * GL_OP + (q_ & 15) * 16) = w[6 + i]; }
#pragma unroll
    for (int i = 0; i < 4; ++i) *(LAS v4u*)(F.lds + gla_img_lds(F.tid, i)) = w[i];
#pragma unroll
    for (int i = 0; i < 2; ++i) { const int idx = (F.tid + i * 512) * 8, dd = idx >> 7, ee = idx & 127;
        v4u sv; sv.x = pk2(st[i][0], st[i][1]); sv.y = pk2(st[i][2], st[i][3]); sv.z = pk2(st[i][4], st[i][5]); sv.w = pk2(st[i][6], st[i][7]);
        *(LAS v4u*)(F.lds + GL_ST + dd * GL_VP + ee * 2) = sv;
        const v4u sk = w[4 + i];
        st[i][0] = dk[i] * st[i][0] + bflo(sk.x); st[i][1] = dk[i] * st[i][1] + bfhi(sk.x); st[i][2] = dk[i] * st[i][2] + bflo(sk.y); st[i][3] = dk[i] * st[i][3] + bfhi(sk.y);
        st[i][4] = dk[i] * st[i][4] + bflo(sk.z); st[i][5] = dk[i] * st[i][5] + bfhi(sk.z); st[i][6] = dk[i] * st[i][6] + bflo(sk.w); st[i][7] = dk[i] * st[i][7] + bfhi(sk.w); }
    gla_img_load(F, STW, nb, nh, nn, w, dk);
    __syncthreads();
    const int lane = F.lane, wid = F.wave, it = wid & 1, et = wid >> 1, r32 = lane & 31, hi = lane >> 5;
    const size_t row = (size_t)b * SEQ + 64 * n + 32 * it + r32;
    unsigned long long ogw[4];
#pragma unroll
    for (int g = 0; g < 4; ++g) ogw[g] = *(const LAS unsigned long long*)(F.lds + GL_OGS + (32 * it + r32) * GL_OP + (32 * et + 8 * g + 4 * hi) * 2);
    const f32x4 sb0 = *(const GAS f32x4*)(F_SSB + row * 8), sb1 = *(const GAS f32x4*)(F_SSB + row * 8 + 4);
    f32x4 gvv[4];
#pragma unroll
    for (int g = 0; g < 4; ++g) gvv[g] = *(const GAS f32x4*)(A.in[7] + 32 * et + 8 * g + 4 * hi);
    f32x16 acc = {};
    bf16x8 qf[4];
#pragma unroll
    for (int ks = 0; ks < 4; ++ks) qf[ks] = *(const LAS bf16x8*)(F.lds + GL_QT + (2 * ks + hi) * GL_CS + (32 * it + r32) * 16);
#pragma unroll
    for (int ks = 0; ks < 4; ++ks) acc = __builtin_amdgcn_mfma_f32_32x32x16_bf16(tr_frag<false>(F.lds + GL_ST, GL_VP, 32 * et, 16 * ks, lane), qf[ks], acc, 0, 0, 0);
    for (int jt = 0; jt <= it; ++jt) {
        f32x16 S = {};
#pragma unroll
        for (int ks = 0; ks < 4; ++ks) S = __builtin_amdgcn_mfma_f32_32x32x16_bf16(*(const LAS bf16x8*)(F.lds + GL_KT + (2 * ks + hi) * GL_CS + (32 * jt + r32) * 16), qf[ks], S, 0, 0, 0);
        if (jt == it) {
#pragma unroll
            for (int r = 0; r < 16; ++r) S[r] = ((r & 3) + 8 * (r >> 2) + 4 * hi) <= r32 ? S[r] : 0.f;
        }
#pragma unroll
        for (int s = 0; s < 2; ++s) {
            v4u pw; pw.x = cvtpk_bf16(S[8 * s + 0], S[8 * s + 1]); pw.y = cvtpk_bf16(S[8 * s + 2], S[8 * s + 3]); pw.z = cvtpk_bf16(S[8 * s + 4], S[8 * s + 5]); pw.w = cvtpk_bf16(S[8 * s + 6], S[8 * s + 7]);
            acc = __builtin_amdgcn_mfma_f32_32x32x16_bf16(tr_frag<true>(F.lds + GL_V, GL_VP, 32 * et, 32 * jt + 16 * s, lane), __builtin_bit_cast(bf16x8, pw), acc, 0, 0, 0);
        }
    }
    float ss = 0.f;
#pragma unroll
    for (int r = 0; r < 16; ++r) ss += acc[r] * acc[r];
    { auto rr = __builtin_amdgcn_permlane32_swap(__float_as_uint(ss), __float_as_uint(ss), false, false); ss = __uint_as_float(rr[0]) + __uint_as_float(rr[1]); }
    LAS float* RED = (LAS float*)(F.lds + GL_RED);
    if (hi == 0) RED[wid * 32 + r32] = ss;
    __syncthreads();
    const float tot = RED[(it + 0) * 32 + r32] + RED[(it + 2) * 32 + r32] + RED[(it + 4) * 32 + r32] + RED[(it + 6) * 32 + r32];
    const float rs = sqrtf((((sb0.x + sb0.y) + (sb0.z + sb0.w)) + ((sb1.x + sb1.y) + (sb1.z + sb1.w))) * (1.f / 512.f) + EPS) / sqrtf(tot * (1.f / 128.f) + EPS);
#pragma unroll
    for (int g = 0; g < 4; ++g) {
        const int e0 = 32 * et + 8 * g + 4 * hi;
        const unsigned lo = (unsigned)ogw[g], hi2 = (unsigned)(ogw[g] >> 32);
        const f32x4 gv = gvv[g];
        const float y0 = acc[4 * g + 0] * rs * gv.x * silu_f(bflo(lo)), y1 = acc[4 * g + 1] * rs * gv.y * silu_f(bfhi(lo)), y2 = acc[4 * g + 2] * rs * gv.z * silu_f(bflo(hi2)), y3 = acc[4 * g + 3] * rs * gv.w * silu_f(bfhi(hi2));
        *(LAS unsigned long long*)(F.lds + GL_OST + (32 * it + r32) * GL_OP + e0 * 2) = (unsigned long long)pk2(y0, y1) | ((unsigned long long)pk2(y2, y3) << 32);
    }
    LDS_WAIT(); asm volatile("" ::: "memory");
    __syncthreads();
    {
        bf16* ob = F_BUFA + ((size_t)b * SEQ + 64 * n) * 1024 + h * 128;
#pragma unroll
        for (int i = 0; i < 2; ++i) { const int q_ = F.tid + 512 * i; const v4u v_ = *(const LAS v4u*)(F.lds + GL_OST + (q_ >> 4) * GL_OP + (q_ & 15) * 16); *(GAS v4u*)(ob + (size_t)(q_ >> 4) * 1024 + (q_ & 15) * 8) = v_; }
    }
    LDS_WAIT(); asm volatile("" ::: "memory");
}
DI void xattn_unit(Frame& F, const bf16* Q, bf16* O, int b, int h, int qb) {
    const int tid = F.tid, lane = F.lane, wid = F.wave, r32 = lane & 31, hi = lane >> 5;
    const bf16* Kg = F_KV + (size_t)(b * 256) * 2048 + h * 256;
    const bf16* Vg = Kg + 1024;
    const size_t row = (size_t)b * SEQ + qb * 256 + wid * 32 + r32;
    __syncthreads();
    bf16x8 qf[16];
#pragma unroll
    for (int ks = 0; ks < 16; ++ks) qf[ks] = *(const LAS bf16x8*)(F.lds + (wid * 32 + r32) * pg8::QLDS_PITCH + 32 * ks + 16 * hi);
    LDS_WAIT(); asm volatile("" ::: "memory");
    __syncthreads();
    {
        const bf16* kp = Kg + (size_t)(tid >> 5) * 2048 + (tid & 31) * 8; LAS unsigned char* kl = F.lds + (tid & 31) * 4096 + (tid >> 5) * 16;
#pragma unroll 8
        for (int i = 0; i < 16; ++i) { *(LAS v4u*)(kl) = *(const GAS v4u*)(kp); kp += 16 * 2048; kl += 256; }
    }
    __syncthreads();
    f32x16 S[8];
#pragma unroll
    for (int mt = 0; mt < 8; ++mt) { S[mt] = (f32x16){};
#pragma unroll
        for (int k4 = 0; k4 < 4; ++k4) {
#pragma unroll
            for (int kk = 0; kk < 4; ++kk) { const int ks = 4 * k4 + kk; S[mt] = __builtin_amdgcn_mfma_f32_32x32x16_bf16(*(const LAS bf16x8*)(F.lds + (2 * ks + hi) * 4096 + (32 * mt + r32) * 16), qf[ks], S[mt], 0, 0, 0); }
            __builtin_amdgcn_sched_barrier(0); } }
    float mx = -INFINITY;
#pragma unroll
    for (int mt = 0; mt < 8; ++mt)
#pragma unroll
        for (int r = 0; r < 16; ++r) mx = fmaxf(mx, S[mt][r]);
    { auto rr = __builtin_amdgcn_permlane32_swap(__float_as_uint(mx), __float_as_uint(mx), false, false); mx = fmaxf(__uint_as_float(rr[0]), __uint_as_float(rr[1])); }
    const float c2 = 0.0625f * 1.4426950408889634f; const float mb = mx * c2;
    float sum = 0.f;
#pragma unroll
    for (int mt = 0; mt < 8; ++mt)
#pragma unroll
        for (int r = 0; r < 16; ++r) { const float p = __builtin_amdgcn_exp2f(S[mt][r] * c2 - mb); S[mt][r] = p; sum += p; }
    { auto rr = __builtin_amdgcn_permlane32_swap(__float_as_uint(sum), __float_as_uint(sum), false, false); sum = __uint_as_float(rr[0]) + __uint_as_float(rr[1]); }
    const float linv = 1.f / sum;
    v4u pa[16];
#pragma unroll
    for (int mt = 0; mt < 8; ++mt)
#pragma unroll
        for (int s = 0; s < 2; ++s) { v4u pw; pw.x = cvtpk_bf16(S[mt][8 * s + 0] * linv, S[mt][8 * s + 1] * linv); pw.y = cvtpk_bf16(S[mt][8 * s + 2] * linv, S[mt][8 * s + 3] * linv);
            pw.z = cvtpk_bf16(S[mt][8 * s + 4] * linv, S[mt][8 * s + 5] * linv); pw.w = cvtpk_bf16(S[mt][8 * s + 6] * linv, S[mt][8 * s + 7] * linv); pa[2 * mt + s] = pw; }
    __syncthreads();
    {
        const int c = tid & 31, m0 = tid >> 5;
        const bf16* vp = Vg + (size_t)m0 * 2048 + c * 8; LAS unsigned char* vl = F.lds + (c >> 2) * 16384 + m0 * 64 + (c & 3) * 16;
#pragma unroll 8
        for (int i = 0; i < 16; ++i) { *(LAS v4u*)(vl) = *(const GAS v4u*)(vp); vp += 16 * 2048; vl += 1024; }
    }
    __syncthreads();
    const int vfr = ((lane >> 4) & 1) * 32 + (lane & 3) * 8 + (4 * hi + ((lane & 15) >> 2)) * 64;
    unsigned opk[4][16];
#pragma unroll
    for (int dp = 0; dp < 4; ++dp) {
        f32x16 a0 = {}, a1 = {};
#pragma unroll
        for (int s = 0; s < 16; ++s) {
            const LAS unsigned char* vp0 = F.lds + (2 * dp) * 16384 + s * 1024 + vfr; const LAS unsigned char* vp1 = vp0 + 16384;
            const s16x4 l0 = lds_tr16(vp0), h0 = lds_tr16(vp0 + 512), l1 = lds_tr16(vp1), h1 = lds_tr16(vp1 + 512);
            const bf16x8 v0 = {l0[0], l0[1], l0[2], l0[3], h0[0], h0[1], h0[2], h0[3]}, v1 = {l1[0], l1[1], l1[2], l1[3], h1[0], h1[1], h1[2], h1[3]};
            a0 = __builtin_amdgcn_mfma_f32_32x32x16_bf16(__builtin_bit_cast(bf16x8, pa[s]), v0, a0, 0, 0, 0);
            a1 = __builtin_amdgcn_mfma_f32_32x32x16_bf16(__builtin_bit_cast(bf16x8, pa[s]), v1, a1, 0, 0, 0);
            if ((s & 3) == 3) __builtin_amdgcn_sched_barrier(0);
        }
#pragma unroll
        for (int r = 0; r < 16; ++r) opk[dp][r] = cvtpk_bf16(a0[r], a1[r]);
        __builtin_amdgcn_sched_barrier(0);
    }
    __syncthreads();
    LAS bf16* stg = (LAS bf16*)(F.lds + wid * 16384);
#pragma unroll
    for (int dp = 0; dp < 4; ++dp)
#pragma unroll
        for (int r = 0; r < 16; ++r) { const int rr = (r & 3) + 8 * (r >> 2) + 4 * hi; stg[rr * 256 + dp * 64 + r32] = (bf16)(opk[dp][r] & 0xffffu); stg[rr * 256 + dp * 64 + 32 + r32] = (bf16)(opk[dp][r] >> 16); }
    LDS_WAIT(); asm volatile("" ::: "memory");
    bf16* Ow = O + ((size_t)b * SEQ + qb * 256 + wid * 32) * 1024 + h * 256;
    {
        bf16* op = Ow + (size_t)(lane >> 5) * 1024 + (lane & 31) * 8; const LAS bf16* sp = stg + (lane >> 5) * 256 + (lane & 31) * 8;
#pragma unroll 4
        for (int i = 0; i < 16; ++i) { *(GAS v4u*)(op) = *(const LAS v4u*)(sp); op += 2 * 1024; sp += 2 * 256; }
    }
    LDS_WAIT(); asm volatile("" ::: "memory");
}
DI float vmaxf(float a, float b) { float r; asm("v_max_f32_e32 %0, %1, %2" : "=v"(r) : "v"(a), "v"(b)); return r; }
DI float vminf(float a, float b) { float r; asm("v_min_f32_e32 %0, %1, %2" : "=v"(r) : "v"(a), "v"(b)); return r; }
#define CE(a, b) do { const float h_ = vmaxf(a, b); const float l_ = vminf(a, b); a = h_; b = l_; } while (0)
DI void sort16_desc(float (&v)[16]) { const float h0 = vmaxf(v[0], v[1]); const float h1 = vmaxf(v[2], v[3]); const float h2 = vmaxf(v[4], v[5]); const float h3 = vmaxf(v[6], v[7]); const float h4 = vmaxf(v[8], v[9]); const float h5 = vmaxf(v[10], v[11]); const float h6 = vmaxf(v[12], v[13]); const float h7 = vmaxf(v[14], v[15]); v[1] = vminf(v[0], v[1]); v[3] = vminf(v[2], v[3]); v[5] = vminf(v[4], v[5]); v[7] = vminf(v[6], v[7]); v[9] = vminf(v[8], v[9]); v[11] = vminf(v[10], v[11]); v[13] = vminf(v[12], v[13]); v[15] = vminf(v[14], v[15]); v[0] = h0; v[2] = h1; v[4] = h2; v[6] = h3; v[8] = h4; v[10] = h5; v[12] = h6; v[14] = h7; const float h8 = vmaxf(v[0], v[2]); const float h9 = vmaxf(v[1], v[3]); const float h10 = vmaxf(v[4], v[6]); const float h11 = vmaxf(v[5], v[7]); const float h12 = vmaxf(v[8], v[10]); const float h13 = vmaxf(v[9], v[11]); const float h14 = vmaxf(v[12], v[14]); const float h15 = vmaxf(v[13], v[15]); v[2] = vminf(v[0], v[2]); v[3] = vminf(v[1], v[3]); v[6] = vminf(v[4], v[6]); v[7] = vminf(v[5], v[7]); v[10] = vminf(v[8], v[10]); v[11] = vminf(v[9], v[11]); v[14] = vminf(v[12], v[14]); v[15] = vminf(v[13], v[15]); v[0] = h8; v[1] = h9; v[4] = h10; v[5] = h11; v[8] = h12; v[9] = h13; v[12] = h14; v[13] = h15; const float h16 = vmaxf(v[1], v[2]); const float h17 = vmaxf(v[5], v[6]); const float h18 = vmaxf(v[0], v[4]); const float h19 = vmaxf(v[3], v[7]); const float h20 = vmaxf(v[9], v[10]); const float h21 = vmaxf(v[13], v[14]); const float h22 = vmaxf(v[8], v[12]); const float h23 = vmaxf(v[11], v[15]); v[2] = vminf(v[1], v[2]); v[6] = vminf(v[5], v[6]); v[4] = vminf(v[0], v[4]); v[7] = vminf(v[3], v[7]); v[10] = vminf(v[9], v[10]); v[14] = vminf(v[13], v[14]); v[12] = vminf(v[8], v[12]); v[15] = vminf(v[11], v[15]); v[1] = h16; v[5] = h17; v[0] = h18; v[3] = h19; v[9] = h20; v[13] = h21; v[8] = h22; v[11] = h23; const float h24 = vmaxf(v[2], v[6]); const float h25 = vmaxf(v[1], v[5]); const float h26 = vmaxf(v[10], v[14]); const float h27 = vmaxf(v[9], v[13]); const float h28 = vmaxf(v[0], v[8]); const float h29 = vmaxf(v[7], v[15]); v[6] = vminf(v[2], v[6]); v[5] = vminf(v[1], v[5]); v[14] = vminf(v[10], v[14]); v[13] = vminf(v[9], v[13]); v[8] = vminf(v[0], v[8]); v[15] = vminf(v[7], v[15]); v[2] = h24; v[1] = h25; v[10] = h26; v[9] = h27; v[0] = h28; v[7] = h29; const float h30 = vmaxf(v[2], v[4]); const float h31 = vmaxf(v[3], v[5]); const float h32 = vmaxf(v[10], v[12]); const float h33 = vmaxf(v[11], v[13]); v[4] = vminf(v[2], v[4]); v[5] = vminf(v[3], v[5]); v[12] = vminf(v[10], v[12]); v[13] = vminf(v[11], v[13]); v[2] = h30; v[3] = h31; v[10] = h32; v[11] = h33; const float h34 = vmaxf(v[1], v[2]); const float h35 = vmaxf(v[3], v[4]); const float h36 = vmaxf(v[5], v[6]); const float h37 = vmaxf(v[9], v[10]); const float h38 = vmaxf(v[11], v[12]); const float h39 = vmaxf(v[13], v[14]); v[2] = vminf(v[1], v[2]); v[4] = vminf(v[3], v[4]); v[6] = vminf(v[5], v[6]); v[10] = vminf(v[9], v[10]); v[12] = vminf(v[11], v[12]); v[14] = vminf(v[13], v[14]); v[1] = h34; v[3] = h35; v[5] = h36; v[9] = h37; v[11] = h38; v[13] = h39; const float h40 = vmaxf(v[4], v[12]); const float h41 = vmaxf(v[2], v[10]); const float h42 = vmaxf(v[6], v[14]); const float h43 = vmaxf(v[1], v[9]); const float h44 = vmaxf(v[5], v[13]); const float h45 = vmaxf(v[3], v[11]); v[12] = vminf(v[4], v[12]); v[10] = vminf(v[2], v[10]); v[14] = vminf(v[6], v[14]); v[9] = vminf(v[1], v[9]); v[13] = vminf(v[5], v[13]); v[11] = vminf(v[3], v[11]); v[4] = h40; v[2] = h41; v[6] = h42; v[1] = h43; v[5] = h44; v[3] = h45; const float h46 = vmaxf(v[4], v[8]); const float h47 = vmaxf(v[6], v[10]); const float h48 = vmaxf(v[5], v[9]); const float h49 = vmaxf(v[7], v[11]); v[8] = vminf(v[4], v[8]); v[10] = vminf(v[6], v[10]); v[9] = vminf(v[5], v[9]); v[11] = vminf(v[7], v[11]); v[4] = h46; v[6] = h47; v[5] = h48; v[7] = h49; const float h50 = vmaxf(v[2], v[4]); const float h51 = vmaxf(v[6], v[8]); const float h52 = vmaxf(v[10], v[12]); const float h53 = vmaxf(v[3], v[5]); const float h54 = vmaxf(v[7], v[9]); const float h55 = vmaxf(v[11], v[13]); v[4] = vminf(v[2], v[4]); v[8] = vminf(v[6], v[8]); v[12] = vminf(v[10], v[12]); v[5] = vminf(v[3], v[5]); v[9] = vminf(v[7], v[9]); v[13] = vminf(v[11], v[13]); v[2] = h50; v[6] = h51; v[10] = h52; v[3] = h53; v[7] = h54; v[11] = h55; const float h56 = vmaxf(v[1], v[2]); const float h57 = vmaxf(v[3], v[4]); const float h58 = vmaxf(v[5], v[6]); const float h59 = vmaxf(v[7], v[8]); const float h60 = vmaxf(v[9], v[10]); const float h61 = vmaxf(v[11], v[12]); const float h62 = vmaxf(v[13], v[14]); v[2] = vminf(v[1], v[2]); v[4] = vminf(v[3], v[4]); v[6] = vminf(v[5], v[6]); v[8] = vminf(v[7], v[8]); v[10] = vminf(v[9], v[10]); v[12] = vminf(v[11], v[12]); v[14] = vminf(v[13], v[14]); v[1] = h56; v[3] = h57; v[5] = h58; v[7] = h59; v[9] = h60; v[11] = h61; v[13] = h62; }
DI void bmerge16_desc(float (&v)[16]) { const float h0 = vmaxf(v[0], v[8]); const float h1 = vmaxf(v[1], v[9]); const float h2 = vmaxf(v[2], v[10]); const float h3 = vmaxf(v[3], v[11]); const float h4 = vmaxf(v[4], v[12]); const float h5 = vmaxf(v[5], v[13]); const float h6 = vmaxf(v[6], v[14]); const float h7 = vmaxf(v[7], v[15]); v[8] = vminf(v[0], v[8]); v[9] = vminf(v[1], v[9]); v[10] = vminf(v[2], v[10]); v[11] = vminf(v[3], v[11]); v[12] = vminf(v[4], v[12]); v[13] = vminf(v[5], v[13]); v[14] = vminf(v[6], v[14]); v[15] = vminf(v[7], v[15]); v[0] = h0; v[1] = h1; v[2] = h2; v[3] = h3; v[4] = h4; v[5] = h5; v[6] = h6; v[7] = h7; const float h8 = vmaxf(v[0], v[4]); const float h9 = vmaxf(v[1], v[5]); const float h10 = vmaxf(v[2], v[6]); const float h11 = vmaxf(v[3], v[7]); const float h12 = vmaxf(v[8], v[12]); const float h13 = vmaxf(v[9], v[13]); const float h14 = vmaxf(v[10], v[14]); const float h15 = vmaxf(v[11], v[15]); v[4] = vminf(v[0], v[4]); v[5] = vminf(v[1], v[5]); v[6] = vminf(v[2], v[6]); v[7] = vminf(v[3], v[7]); v[12] = vminf(v[8], v[12]); v[13] = vminf(v[9], v[13]); v[14] = vminf(v[10], v[14]); v[15] = vminf(v[11], v[15]); v[0] = h8; v[1] = h9; v[2] = h10; v[3] = h11; v[8] = h12; v[9] = h13; v[10] = h14; v[11] = h15; const float h16 = vmaxf(v[0], v[2]); const float h17 = vmaxf(v[1], v[3]); const float h18 = vmaxf(v[4], v[6]); const float h19 = vmaxf(v[5], v[7]); const float h20 = vmaxf(v[8], v[10]); const float h21 = vmaxf(v[9], v[11]); const float h22 = vmaxf(v[12], v[14]); const float h23 = vmaxf(v[13], v[15]); v[2] = vminf(v[0], v[2]); v[3] = vminf(v[1], v[3]); v[6] = vminf(v[4], v[6]); v[7] = vminf(v[5], v[7]); v[10] = vminf(v[8], v[10]); v[11] = vminf(v[9], v[11]); v[14] = vminf(v[12], v[14]); v[15] = vminf(v[13], v[15]); v[0] = h16; v[1] = h17; v[4] = h18; v[5] = h19; v[8] = h20; v[9] = h21; v[12] = h22; v[13] = h23; const float h24 = vmaxf(v[0], v[1]); const float h25 = vmaxf(v[2], v[3]); const float h26 = vmaxf(v[4], v[5]); const float h27 = vmaxf(v[6], v[7]); const float h28 = vmaxf(v[8], v[9]); const float h29 = vmaxf(v[10], v[11]); const float h30 = vmaxf(v[12], v[13]); const float h31 = vmaxf(v[14], v[15]); v[1] = vminf(v[0], v[1]); v[3] = vminf(v[2], v[3]); v[5] = vminf(v[4], v[5]); v[7] = vminf(v[6], v[7]); v[9] = vminf(v[8], v[9]); v[11] = vminf(v[10], v[11]); v[13] = vminf(v[12], v[13]); v[15] = vminf(v[14], v[15]); v[0] = h24; v[2] = h25; v[4] = h26; v[6] = h27; v[8] = h28; v[10] = h29; v[12] = h30; v[14] = h31; }
#undef CE
template <int NV> DI void merge_top16(float (&L)[16], const float (&N)[NV]) {
#pragma unroll
    for (int i = 16 - NV; i < 16; ++i) L[i] = vmaxf(L[i], N[15 - i]);
    bmerge16_desc(L);
}
DI float pack_cand(float s, int id) { return __uint_as_float((__float_as_uint(s) & ~0xffu) | (unsigned)(255 - id)); }
DI void peer_topk_mfma2(Frame& F, const bf16* PQb, int* IDX, float* GATE) {
    const int tid = F.tid, lane = F.lane, wid = F.wave, r32 = lane & 31, hi = lane >> 5, h = F.vcu & 7;
    __syncthreads();
    {
        v4u kw[8];
#pragma unroll
        for (int j = 0; j < 8; ++j) { const int i = tid + 512 * j, p = i >> 11, key = (i >> 4) & 127, c = i & 15; kw[j] = *(const GAS v4u*)(F_SUBK + (size_t)((h * 2 + p) * 128 + key) * 128 + c * 8); }
#pragma unroll
        for (int j = 0; j < 8; ++j) { const int i = tid + 512 * j, p = i >> 11, key = (i >> 4) & 127, c = i & 15; *(LAS v4u*)(F.lds + p * 32768 + c * 2048 + key * 16) = kw[j]; }
    }
    __syncthreads();
    LAS unsigned* scr = (LAS unsigned*)(F.lds + 65536 + wid * 8192) + lane;
    const int g0 = (F.vcu >> 3) * 8 + wid, gstep = (F.G >> 3) * 8;
    bf16x8 qf[8];
#pragma unroll
    for (int ks = 0; ks < 8; ++ks) qf[ks] = *(const GAS bf16x8*)(PQb + ((size_t)32 * g0 + r32) * 2048 + (h * 2) * 128 + 16 * ks + 8 * hi);
    for (int g = g0; g < 512; g += gstep) {
        const size_t token = (size_t)32 * g + r32;
        float LA[16], LB[16];
#pragma unroll
        for (int p = 0; p < 2; ++p) {
            float (&L)[16] = p ? LB : LA;
            f32x16 S[4];
#pragma unroll
            for (int rt = 0; rt < 4; ++rt) { S[rt] = (f32x16){};
#pragma unroll
                for (int ks = 0; ks < 8; ++ks) S[rt] = __builtin_amdgcn_mfma_f32_32x32x16_bf16(*(const LAS bf16x8*)(F.lds + p * 32768 + (2 * ks + hi) * 2048 + (32 * rt + r32) * 16), qf[ks], S[rt], 0, 0, 0); }
            __builtin_amdgcn_sched_barrier(0);
            {
                const int gn = p ? (g + gstep < 512 ? g + gstep : g) : g; const int pn = p ? 0 : 1;
#pragma unroll
                for (int ks = 0; ks < 8; ++ks) qf[ks] = *(const GAS bf16x8*)(PQb + ((size_t)32 * gn + r32) * 2048 + (h * 2 + pn) * 128 + 16 * ks + 8 * hi);
            }
            __builtin_amdgcn_sched_barrier(0);
#pragma unroll
            for (int rt = 0; rt < 4; ++rt) {
                float v[16];
#pragma unroll
                for (int r = 0; r < 16; ++r) { const unsigned key = (unsigned)(32 * rt + (r & 3) + 8 * (r >> 2)) + 4u * (unsigned)hi; v[r] = __uint_as_float((__float_as_uint(S[rt][r]) & ~0x7fu) | key); }
                sort16_desc(v);
                if (rt == 0) {
#pragma unroll
                    for (int i = 0; i < 16; ++i) L[i] = v[i];
                } else merge_top16<16>(L, v);
            }
            float PL[16];
#pragma unroll
            for (int i = 0; i < 16; ++i) { auto rr = __builtin_amdgcn_permlane32_swap(__float_as_uint(L[i]), __float_as_uint(L[i]), false, false); PL[i] = __uint_as_float(hi ? rr[0] : rr[1]); }
            merge_top16<16>(L, PL);
        }
#pragma unroll
        for (int i = 0; i < 16; ++i) { scr[i * 64] = __float_as_uint(LA[i]) & 0x7fu; scr[(16 + i) * 64] = __float_as_uint(LB[i]) & 0x7fu; }
        float VA[16], VB[16];
#pragma unroll
        for (int i = 0; i < 16; ++i) { VA[i] = __uint_as_float(__float_as_uint(LA[i]) & ~0x7fu); VB[i] = __uint_as_float(__float_as_uint(LB[i]) & ~0x7fu); }
        float C[16];
#pragma unroll
        for (int b = 0; b < 16; ++b) C[b] = pack_cand(VA[0] + VB[b], b);
        { float R[8];
#pragma unroll
          for (int b = 0; b < 8; ++b) R[b] = pack_cand(VA[1] + VB[b], 16 + b);
          merge_top16<8>(C, R); }
        { float R[5];
#pragma unroll
          for (int b = 0; b < 5; ++b) R[b] = pack_cand(VA[2] + VB[b], 32 + b);
          merge_top16<5>(C, R); }
        { float R[4];
#pragma unroll
          for (int b = 0; b < 4; ++b) R[b] = pack_cand(VA[3] + VB[b], 48 + b);
          merge_top16<4>(C, R); }
        { float R[3];
#pragma unroll
          for (int b = 0; b < 3; ++b) R[b] = pack_cand(VA[4] + VB[b], 64 + b);
          merge_top16<3>(C, R); }
        { float R[11];
#pragma unroll
          for (int i = 0; i < 11; ++i) R[i] = pack_cand(VA[5 + i] + VB[0], (5 + i) * 16);
          merge_top16<11>(C, R); }
        { float R[3];
#pragma unroll
          for (int i = 0; i < 3; ++i) R[i] = pack_cand(VA[5 + i] + VB[1], (5 + i) * 16 + 1);
          merge_top16<3>(C, R); }
        LDS_WAIT(); asm volatile("" ::: "memory");
        const float top = __uint_as_float(__float_as_uint(C[0]) & ~0xffu);
        float ex[16]; int ei[16]; float sum = 0.f;
#pragma unroll
        for (int r = 0; r < 16; ++r) { const unsigned cu = __float_as_uint(C[r]), id = 255u - (cu & 0xffu); ex[r] = __expf(__uint_as_float(cu & ~0xffu) - top); sum += ex[r];
            ei[r] = (int)(scr[(id >> 4) * 64] * 128u + scr[(16 + (id & 15)) * 64]); }
        const float inv = 1.f / sum;
        v4u io0, io1; f32x4 go0, go1;
        io0.x = hi ? ei[8] : ei[0]; io0.y = hi ? ei[9] : ei[1]; io0.z = hi ? ei[10] : ei[2]; io0.w = hi ? ei[11] : ei[3];
        io1.x = hi ? ei[12] : ei[4]; io1.y = hi ? ei[13] : ei[5]; io1.z = hi ? ei[14] : ei[6]; io1.w = hi ? ei[15] : ei[7];
        go0.x = (hi ? ex[8] : ex[0]) * inv; go0.y = (hi ? ex[9] : ex[1]) * inv; go0.z = (hi ? ex[10] : ex[2]) * inv; go0.w = (hi ? ex[11] : ex[3]) * inv;
        go1.x = (hi ? ex[12] : ex[4]) * inv; go1.y = (hi ? ex[13] : ex[5]) * inv; go1.z = (hi ? ex[14] : ex[6]) * inv; go1.w = (hi ? ex[15] : ex[7]) * inv;
        int* ip = IDX + token * 128 + h * 16 + 8 * hi; float* gp = GATE + token * 128 + h * 16 + 8 * hi;
        *(GAS v4u*)ip = io0; *(GAS v4u*)(ip + 4) = io1; *(GAS f32x4*)gp = go0; *(GAS f32x4*)(gp + 4) = go1;
        LDS_WAIT(); asm volatile("" ::: "memory");
    }
}
constexpr int GL3_LIST = 0, GL3_X = 65536;
constexpr int G5_NSH = 16, G5_SHIFT = 10;
constexpr int G6_NSH = 16, G6_SHIFT = 10, G6_TPW = 8;
DI void g6_issue(v4u (&R)[4], v4u& E, const LAS unsigned char* tlist, const unsigned char* TAB, int k, int lane) {
    E = *(const LAS v4u*)(tlist + (4 * k + (lane & 3)) * 16);
#pragma unroll
    for (int j = 0; j < 4; ++j) { const unsigned id = (unsigned)__builtin_amdgcn_readlane((int)E.x, j); R[j] = *(const GAS v4u*)(TAB + (size_t)id * 1024 + 16 * lane); }
}
DI void g6_dot(const v4u& xx, const v4u (&U)[4], const v4u& E, LAS unsigned char* tlist, int k, int lane) {
    int p[4];
#pragma unroll
    for (int j = 0; j < 4; ++j) { int d = __builtin_amdgcn_sdot4((int)U[j].x, (int)xx.x, 0, false); d = __builtin_amdgcn_sdot4((int)U[j].y, (int)xx.y, d, false);
        d = __builtin_amdgcn_sdot4((int)U[j].z, (int)xx.z, d, false); p[j] = __builtin_amdgcn_sdot4((int)U[j].w, (int)xx.w, d, false); }
    const bool b0 = lane & 1, b1 = lane & 2;
    const int kA = b0 ? p[1] : p[0], sA = b0 ? p[0] : p[1], kB = b0 ? p[3] : p[2], sB = b0 ? p[2] : p[3];
    const int qA = kA + dpp_i<0xB1>(sA), qB = kB + dpp_i<0xB1>(sB);
    const int kk = b1 ? qB : qA, ss = b1 ? qA : qB;
    int r = kk + dpp_i<0x4E>(ss);
    r += dpp_i<0x124>(r); r += dpp_i<0x128>(r);
    r += __shfl_xor(r, 16); r += __shfl_xor(r, 32);
    const float a = (float)r * __uint_as_float(E.z);
    const float y = 0.7978845608028654f * (a + 0.044715f * a * a * a);
    const float th = 1.f - 2.f * __builtin_amdgcn_rcpf(1.f + __expf(2.f * y));
    const float cfl = __uint_as_float(E.y) * __uint_as_float(E.w) * 0.5f * a * (1.f + th);
    if (lane < 4) *(LAS float*)(tlist + (4 * k + lane) * 16 + 4) = cfl;
}
DI void g6_issue_u4(v4u (&R)[4], v4u& E, const LAS unsigned char* tlist, const unsigned char* TAB, int k, int lane) {
    E = *(const LAS v4u*)(tlist + (8 * k + 2 * (lane & 3) + (lane >> 5)) * 16);
#pragma unroll
    for (int j = 0; j < 4; ++j) { const unsigned ida = (unsigned)__builtin_amdgcn_readlane((int)E.x, j), idb = (unsigned)__builtin_amdgcn_readlane((int)E.x, 32 + j);
        const unsigned id = (lane >> 5) ? idb : ida;
        R[j] = *(const GAS v4u*)(TAB + (unsigned)((id << 9) | ((unsigned)(lane & 31) << 4))); }
}
DI void g6_dot_u4(const unsigned (&X)[8], const v4u (&U)[4], const v4u& E, LAS unsigned char* tlist, int k, int lane) {
    int p[4];
#pragma unroll
    for (int j = 0; j < 4; ++j) {
        const int dh = __builtin_amdgcn_sdot8((int)U[j].w, (int)X[3], __builtin_amdgcn_sdot8((int)U[j].z, (int)X[2], __builtin_amdgcn_sdot8((int)U[j].y, (int)X[1], __builtin_amdgcn_sdot8((int)U[j].x, (int)X[0], 0, false), false), false), false);
        const int dl = __builtin_amdgcn_sdot8((int)U[j].w, (int)X[7], __builtin_amdgcn_sdot8((int)U[j].z, (int)X[6], __builtin_amdgcn_sdot8((int)U[j].y, (int)X[5], __builtin_amdgcn_sdot8((int)U[j].x, (int)X[4], 0, false), false), false), false);
        p[j] = dh * 16 + dl; }
    const bool b0 = lane & 1, b1 = lane & 2;
    const int q0 = (b0 ? p[1] : p[0]) + dpp_i<0xB1>(b0 ? p[0] : p[1]), q1 = (b0 ? p[3] : p[2]) + dpp_i<0xB1>(b0 ? p[2] : p[3]);
    int r = (b1 ? q1 : q0) + dpp_i<0x4E>(b1 ? q0 : q1);
    r += dpp_i<0x124>(r); r += dpp_i<0x128>(r);
    { auto x_ = __builtin_amdgcn_permlane16_swap((unsigned)r, (unsigned)r, false, false); r = (int)(x_[0] + x_[1]); }
    const float a = (float)r * __uint_as_float(E.z);
    const float y = 0.7978845608028654f * (a + 0.044715f * a * a * a);
    const float th = 1.f - 2.f * __builtin_amdgcn_rcpf(1.f + __expf(2.f * y));
    const float cfl = __uint_as_float(E.y) * __uint_as_float(E.w) * 0.5f * a * (1.f + th);
    if ((lane & 31) < 4) *(LAS float*)(tlist + (8 * k + 2 * (lane & 3) + (lane >> 5)) * 16 + 4) = cfl;
}
typedef _Float16 h2_t __attribute__((ext_vector_type(2)));
typedef _Float16 h32_t __attribute__((ext_vector_type(32)));
DI void g6_issue_v(u32x3v (&R)[4], v4u& E, const LAS unsigned char* tlist, const unsigned char* TAB, int k, int lane) {
    E = *(const LAS v4u*)(tlist + (4 * k + (lane & 3)) * 16);
#pragma unroll
    for (int j = 0; j < 4; ++j) { const unsigned id = (unsigned)__builtin_amdgcn_readlane((int)E.x, j); R[j] = *(const GAS u32x3v*)(TAB + (size_t)id * 768 + 12 * lane); }
}
DI void g6_fma(h2_t (&acc)[8], const u32x3v (&V)[4], const v4u& E, int lane) {
#pragma unroll
    for (int jp = 0; jp < 2; ++jp) {
        const i32x6v pk = {(int)V[2 * jp][0], (int)V[2 * jp][1], (int)V[2 * jp][2], (int)V[2 * jp + 1][0], (int)V[2 * jp + 1][1], (int)V[2 * jp + 1][2]};
        const h32_t hv = __builtin_bit_cast(h32_t, __builtin_amdgcn_cvt_scalef32_pk32_f16_fp6(pk, 1.0f));
#pragma unroll
        for (int q = 0; q < 2; ++q) { const float cf = __uint_as_float(__builtin_amdgcn_readlane((int)E.y, 2 * jp + q)); const _Float16 ch = (_Float16)cf; const h2_t c2 = {ch, ch};
#pragma unroll
            for (int w = 0; w < 8; ++w) { const h2_t vv = {hv[16 * q + 2 * w], hv[16 * q + 2 * w + 1]}; acc[w] = __builtin_elementwise_fma(vv, c2, acc[w]); } }
    }
}
constexpr int G6_NB2 = 8, G6_LN = ((128 + G6_NB2 - 1) / G6_NB2) * G6_NB2, G6_LSTR = G6_LN * 16, G6_NK2 = G6_LN / G6_NB2;
static_assert(8 * G6_TPW * G6_LSTR <= LDSCTL_OFF, "gather lists overflow the LDS body region");
DI void g6_issue_vn(u32x3v (&R)[G6_NB2], v4u& E, const LAS unsigned char* tlist, const unsigned char* TAB, int k, int lane) {
    const int e = lane & 7; E = *(const LAS v4u*)(tlist + (G6_NB2 * k + (e < G6_NB2 ? e : G6_NB2 - 1)) * 16);
#pragma unroll
    for (int j = 0; j < G6_NB2; ++j) { const unsigned id = (unsigned)__builtin_amdgcn_readlane((int)E.x, j); R[j] = *(const GAS u32x3v*)(TAB + (size_t)id * 768 + 12 * lane); }
}
DI void g6_fman(h2_t (&acc)[8], const u32x3v (&V)[G6_NB2], const v4u& E, int lane) {
#pragma unroll
    for (int jp = 0; jp < (G6_NB2 + 1) / 2; ++jp) {
        const int r0 = 2 * jp, r1 = (2 * jp + 1 < G6_NB2) ? 2 * jp + 1 : 2 * jp;
        const i32x6v pk = {(int)V[r0][0], (int)V[r0][1], (int)V[r0][2], (int)V[r1][0], (int)V[r1][1], (int)V[r1][2]};
        const h32_t hv = __builtin_bit_cast(h32_t, __builtin_amdgcn_cvt_scalef32_pk32_f16_fp6(pk, 1.0f));
#pragma unroll
        for (int q = 0; q < 2; ++q) { if (2 * jp + q >= G6_NB2) continue;
            const float cf = __uint_as_float(__builtin_amdgcn_readlane((int)E.y, 2 * jp + q)); const _Float16 ch = (_Float16)cf; const h2_t c2 = {ch, ch};
#pragma unroll
            for (int w = 0; w < 8; ++w) { const h2_t vv = {hv[16 * q + 2 * w], hv[16 * q + 2 * w + 1]}; acc[w] = __builtin_elementwise_fma(vv, c2, acc[w]); } }
    }
}
DI void peer_gather_wave6(Frame& F, const Args& A, const bf16* XN2, const float* SS2, const int* IDX, const float* GATE, size_t tok0) {
    constexpr int TPW = G6_TPW;
    const int lane = F.lane, wid = F.wave;
    const unsigned char* U8 = F.ws + WS_U8; const unsigned char* V8 = F.ws + WS_V8;
    const f32x2* SUV = (const f32x2*)(F.ws + WS_SU);
    LAS unsigned char* list = F.lds + wid * (TPW * G6_LSTR);
    unsigned xq[TPW][8];
#pragma unroll
    for (int tl = 0; tl < TPW; ++tl) {
        const size_t t = tok0 + tl;
        float sx;
        {
            float xv[16];
#pragma unroll
            for (int j = 0; j < 4; ++j) { const unsigned long long hw = *(const GAS unsigned long long*)(XN2 + t * 1024 + 256 * j + 4 * lane); const unsigned lo_ = (unsigned)hw, hi_ = (unsigned)(hw >> 32);
                xv[4 * j] = bflo(lo_); xv[4 * j + 1] = bfhi(lo_); xv[4 * j + 2] = bflo(hi_); xv[4 * j + 3] = bfhi(hi_); }
            {
                const f32x4* sp = (const f32x4*)(SS2 + t * 16); const f32x4 a = sp[0], b = sp[1], c = sp[2], d = sp[3];
                const float tt = ((a[0] + a[1]) + (a[2] + a[3])) + ((b[0] + b[1]) + (b[2] + b[3])) + ((c[0] + c[1]) + (c[2] + c[3])) + ((d[0] + d[1]) + (d[2] + d[3]));
                const float rs = 1.0f / sqrtf(tt * (1.0f / 1024.0f) + EPS);
#pragma unroll
                for (int i = 0; i < 4; ++i) { const f32x4 gv = *(const GAS f32x4*)(A.in[15] + 256 * i + 4 * lane); xv[4 * i] *= rs * gv.x; xv[4 * i + 1] *= rs * gv.y; xv[4 * i + 2] *= rs * gv.z; xv[4 * i + 3] *= rs * gv.w; }
            }
            float mx = 0.f;
#pragma unroll
            for (int i = 0; i < 16; ++i) mx = fmaxf(mx, fabsf(xv[i]));
            mx = wave_max(mx); sx = mx > 0.f ? mx * (1.f / 119.f) : 1.f; const float inv = 1.f / sx;
            unsigned h0 = 0u, h1 = 0u, l0 = 0u, l1 = 0u;
#pragma unroll
            for (int i = 0; i < 8; ++i) { const int a = (int)rintf(xv[i] * inv), b = (int)rintf(xv[8 + i] * inv);
                const int ah = (a + 8) >> 4, al = a - 16 * ah, bh = (b + 8) >> 4, bl = b - 16 * bh;
                h0 |= ((unsigned)ah & 15u) << (4 * i); l0 |= ((unsigned)al & 15u) << (4 * i); h1 |= ((unsigned)bh & 15u) << (4 * i); l1 |= ((unsigned)bl & 15u) << (4 * i); }
            {
                auto s0 = __builtin_amdgcn_permlane32_swap(h0, h0, false, false); auto s1 = __builtin_amdgcn_permlane32_swap(h1, h1, false, false);
                auto s2 = __builtin_amdgcn_permlane32_swap(l0, l0, false, false); auto s3 = __builtin_amdgcn_permlane32_swap(l1, l1, false, false);
                xq[tl][0] = s0[0]; xq[tl][1] = s1[0]; xq[tl][2] = s0[1]; xq[tl][3] = s1[1]; xq[tl][4] = s2[0]; xq[tl][5] = s3[0]; xq[tl][6] = s2[1]; xq[tl][7] = s3[1]; }
        }
        const int idlo = IDX[t * 128 + lane], idhi = IDX[t * 128 + 64 + lane];
        const float glo = GATE[t * 128 + lane], ghi = GATE[t * 128 + 64 + lane];
        const f32x2 pl_ = SUV[idlo], ph_ = SUV[idhi];
        const float slo = pl_.x * sx, shi = ph_.x * sx, vlo = pl_.y, vhi = ph_.y;
        LAS unsigned char* tl_list = list + tl * G6_LSTR;
        if (lane < G6_LN - 128) *(LAS v4u*)(tl_list + (128 + lane) * 16) = (v4u){0u, 0u, 0u, 0u};
        {
            LAS unsigned* cnt = (LAS unsigned*)(F.lds + RING_BYTES + wid * 1024); LAS unsigned* bas = cnt + 16;
            if (lane < 16) cnt[lane] = 0u;
            const unsigned slo_ = (unsigned)idlo >> G6_SHIFT, shi_ = (unsigned)idhi >> G6_SHIFT;
            LDS_WAIT();
            const unsigned rlo = __hip_atomic_fetch_add(cnt + slo_, 1u, __ATOMIC_RELAXED, __HIP_MEMORY_SCOPE_WORKGROUP);
            const unsigned rhi = __hip_atomic_fetch_add(cnt + shi_, 1u, __ATOMIC_RELAXED, __HIP_MEMORY_SCOPE_WORKGROUP);
            LDS_WAIT(); asm volatile("" ::: "memory");
            int c = lane < 16 ? (int)cnt[lane] : 0, v = c;
            v += __builtin_amdgcn_update_dpp(0, v, 0x111, 0xf, 0xf, true); v += __builtin_amdgcn_update_dpp(0, v, 0x112, 0xf, 0xf, true);
            v += __builtin_amdgcn_update_dpp(0, v, 0x114, 0xf, 0xf, true); v += __builtin_amdgcn_update_dpp(0, v, 0x118, 0xf, 0xf, true);
            if (lane < 16) bas[lane] = (unsigned)(v - c);
            LDS_WAIT(); asm volatile("" ::: "memory");
            const unsigned plo = bas[slo_] + rlo, phi = bas[shi_] + rhi;
            *(LAS v4u*)(tl_list + plo * 16) = (v4u){(unsigned)idlo, __float_as_uint(glo), __float_as_uint(slo), __float_as_uint(vlo)};
            *(LAS v4u*)(tl_list + phi * 16) = (v4u){(unsigned)idhi, __float_as_uint(ghi), __float_as_uint(shi), __float_as_uint(vhi)};
        }
    }
    LDS_WAIT(); asm volatile("" ::: "memory");
#define G6_SB __builtin_amdgcn_sched_barrier(0)
    {
        v4u RA[4], RB[4]; v4u EA, EB;
        g6_issue_u4(RA, EA, list, U8, 0, lane);
        for (int k = 0; k < 16; ++k) {
#define G6_P1(RI, EI, tn, kn, RC, EC, tc) do { g6_issue_u4(RI, EI, list + (tn) * G6_LSTR, U8, kn, lane); G6_SB; g6_dot_u4(xq[tc], RC, EC, list + (tc) * G6_LSTR, k, lane); G6_SB; } while (0)
            G6_P1(RB, EB, 1, k, RA, EA, 0); G6_P1(RA, EA, 2, k, RB, EB, 1); G6_P1(RB, EB, 3, k, RA, EA, 2); G6_P1(RA, EA, 4, k, RB, EB, 3);
            G6_P1(RB, EB, 5, k, RA, EA, 4); G6_P1(RA, EA, 6, k, RB, EB, 5); G6_P1(RB, EB, 7, k, RA, EA, 6); G6_P1(RA, EA, 0, (k < 15 ? k + 1 : 15), RB, EB, 7);
#undef G6_P1
        }
    }
    LDS_WAIT(); asm volatile("" ::: "memory");
    h2_t acc[TPW][8];
#pragma unroll
    for (int tl = 0; tl < TPW; ++tl)
#pragma unroll
        for (int i = 0; i < 8; ++i) acc[tl][i] = (h2_t){(_Float16)0.f, (_Float16)0.f};
    {
        u32x3v RA[G6_NB2], RB[G6_NB2]; v4u EA, EB;
        g6_issue_vn(RA, EA, list, V8, 0, lane);
        for (int k = 0; k < G6_NK2; ++k) {
#define G6_P2(RI, EI, tn, kn, RC, EC, tc) do { g6_issue_vn(RI, EI, list + (tn) * G6_LSTR, V8, kn, lane); g6_fman(acc[tc], RC, EC, lane); G6_SB; } while (0)
            G6_P2(RB, EB, 1, k, RA, EA, 0); G6_P2(RA, EA, 2, k, RB, EB, 1); G6_P2(RB, EB, 3, k, RA, EA, 2); G6_P2(RA, EA, 4, k, RB, EB, 3);
            G6_P2(RB, EB, 5, k, RA, EA, 4); G6_P2(RA, EA, 6, k, RB, EB, 5); G6_P2(RB, EB, 7, k, RA, EA, 6); G6_P2(RA, EA, 0, (k < G6_NK2 - 1 ? k + 1 : G6_NK2 - 1), RB, EB, 7);
#undef G6_P2
        }
    }
#undef G6_SB
#pragma unroll
    for (int tl = 0; tl < TPW; ++tl) {
        float* hp = F.out + (tok0 + tl) * 1024 + 4 * lane;
        f32x4 y[4]; float ssq = 0.f;
#pragma unroll
        for (int i = 0; i < 4; ++i) { const unsigned long long hw = *(const GAS unsigned long long*)(XN2 + (tok0 + tl) * 1024 + 256 * i + 4 * lane); const unsigned lo_ = (unsigned)hw, hi_ = (unsigned)(hw >> 32);
            y[i] = (f32x4){bflo(lo_), bfhi(lo_), bflo(hi_), bfhi(hi_)}; }
#pragma unroll
        for (int i = 0; i < 4; ++i) { y[i].x += (float)acc[tl][2 * i].x; y[i].y += (float)acc[tl][2 * i].y; y[i].z += (float)acc[tl][2 * i + 1].x; y[i].w += (float)acc[tl][2 * i + 1].y;
            ssq += (y[i].x * y[i].x + y[i].y * y[i].y) + (y[i].z * y[i].z + y[i].w * y[i].w); }
        const float rs = 1.f / sqrtf(wave_sum(ssq) * (1.f / 1024.f) + EPS);
#pragma unroll
        for (int i = 0; i < 4; ++i) { const f32x4 gv = *(const GAS f32x4*)(A.in[20] + 256 * i + 4 * lane); __builtin_nontemporal_store(y[i] * rs * gv, (GAS f32x4*)(hp + 256 * i)); }
    }
    LDS_WAIT(); asm volatile("" ::: "memory");
}

DI void wg_self_handoff() {
    asm volatile("s_waitcnt vmcnt(0)" ::: "memory");
    __syncthreads();
    if (threadIdx.x == 0) { __builtin_amdgcn_fence(__ATOMIC_ACQUIRE, "agent"); asm volatile("s_waitcnt vmcnt(0)" ::: "memory"); }
    __syncthreads();
}
constexpr size_t WS_XBUF = 73 * MiB;
constexpr int CW_SEAM = 16384, SEAM_BANK = 8192;
__global__ void __launch_bounds__(NWAVES * 64, 2) fwd_kernel(Args args) {
    extern __shared__ __attribute__((aligned(16))) unsigned char lds[];
    Frame F;
    F.lds = (LAS unsigned char*)lds;
    F.MISC = (volatile LAS unsigned*)(F.lds + MISC_OFF);
    F.tid = threadIdx.x; F.lane = F.tid & 63; F.wave = __builtin_amdgcn_readfirstlane(F.tid >> 6);
    F.G = gridDim.x; { const int bx = blockIdx.x; F.vcu = (F.G % 8 == 0) ? (bx % 8) * (F.G / 8) + bx / 8 : bx; }
    unsigned char* ws = args.ws;
    F.ctl = (gu32*)(ws + WS_CTL);
    F.out = args.out; F.ws = ws;
    for (int u = F.tid; u < (LDS_BYTES - LDSCTL_OFF) / 4; u += NWAVES * 64) ((LAS unsigned*)(F.lds + LDSCTL_OFF))[u] = 0u;
    __syncthreads();
    XcdBarrier bar = xcd_barrier_post((unsigned*)(F.ctl + CW_BAR) + args.li * XCD_BAR_WORDS, F.MISC + 8);
    const int lo = args.ph_lo, hi = args.ph_hi;
#ifndef PH_MASK
#define PH_MASK 0xffff
#endif
#define IN(k) (((PH_MASK >> (k)) & 1) && lo <= (k) && (k) < hi)
#define SEAM(k) do { if (IN(k) && IN((k) + 1)) xcd_barrier(bar); } while (0)
    const int gw = F.vcu * NWAVES + F.wave, NGW = F.G * NWAVES;
#define STW ((bf16*)F.out)
#define IDX ((int*)F_BUFA)
#define GATE ((float*)(F_BUFA) + (size_t)M * 128)

    if (IN(0)) { p0_prologue(F, args); __syncthreads(); p0_late(F, args, gw, NGW); } SEAM(0);
    if (IN(1)) {
        { pg8::Gemm g{F_BUFA, F_W1T, 1024, 1024, 1024}; pg8::StaticOrder S; S.init(M, N1, F.G, (int)blockIdx.x, 1024, 1024);
          pg8::EpiBf16P E{F_PROJ, N1, 1.f};
          pg8::gemm_phase<pg8::EpiBf16P, pg8::StaticOrder, true, true>(F.lds, g, S, E); }
        { pg8::Gemm g{F_MN, F_WXKVT, 1024, 1024, 1024}; const int c = (int)blockIdx.x; pg8::OneUnitOrder S{(c >= 64 && c < 128) ? c - 64 : -1, 8, 1024, 1024};
          pg8::EpiBf16P E{F_KV, 2048, 1.f};
          pg8::gemm_phase<pg8::EpiBf16P, pg8::OneUnitOrder, true, true>(F.lds, g, S, E); }
        if ((int)blockIdx.x >= 128) quant_tables(F, args, ((int)blockIdx.x - 128) * NWAVES + F.wave, 128 * NWAVES, QT_SPLIT, PEER_N);
    } SEAM(1);
    if (IN(2)) {
        __syncthreads();
        for (int task = gw; task < 64 * 64; task += NGW) { const int bh = task >> 6; sb_wave(F, args, bh >> 3, bh & 7, 63 - (task & 63)); }
        { const int l_ = lane_fresh(); F.lane = l_; F.tid = F.wave * 64 + l_; }
        __syncthreads();
        {
            v4u gw_[6]; f32x16 agg = {}; float dsegp = 1.f;
            const int bh = F.vcu >> 3, seg = F.vcu & 7, b_ = bh >> 2, h_ = bh & 3;
            gla_stage_load(F, b_, h_, 4 * seg, gw_);
            for (int k = 0; k < 4; ++k) { const int n = 4 * seg + k; gla_local_unit(F, args, STW, b_, h_, n, gw_, b_, h_, k < 3 ? n + 1 : n, agg, dsegp); }
            const int dt = F.wave & 1, et = F.wave >> 1, r32 = F.lane & 31, hi = F.lane >> 5;
            float* ag = GLA_AGG + ((size_t)(bh * 8 + seg) * 64 + 32 * dt) * 128 + 32 * et + r32;
#pragma unroll
            for (int r = 0; r < 16; ++r) ag[(size_t)((r & 3) + 8 * (r >> 2) + 4 * hi) * 128] = agg[r];
            if (F.tid < 64) ((float*)(F.ctl + CW_DSEG))[(bh * 8 + seg) * 64 + F.tid] = dsegp;
        }
    } SEAM(2);
    if (IN(4)) {
        {
            v4u gw_[8]; float dk[2]; float st[2][8];
            const int bh = F.vcu >> 3, seg = F.vcu & 7, b_ = bh >> 2, h_ = bh & 3;
            gla_img_load(F, STW, b_, h_, 4 * seg, gw_, dk);
#pragma unroll
            for (int i = 0; i < 2; ++i)
#pragma unroll
                for (int j = 0; j < 8; ++j) st[i][j] = 0.f;
#pragma unroll
            for (int j0 = 0; j0 < 8; j0 += 4) {
                f32x4 a[4][2][2]; float dj[4][2];
#pragma unroll
                for (int jj = 0; jj < 4; ++jj) { const int j = j0 + jj;
#pragma unroll
                    for (int i = 0; i < 2; ++i) { const int idx = (F.tid + i * 512) * 8, dd = idx >> 7, ee = idx & 127;
                        a[jj][i][0] = (f32x4){0.f, 0.f, 0.f, 0.f}; a[jj][i][1] = a[jj][i][0]; dj[jj][i] = 1.f;
                        if (j < seg) { const float* ap = GLA_AGG + ((size_t)(bh * 8 + j) * 64 + dd) * 128 + ee; a[jj][i][0] = *(const GAS f32x4*)ap; a[jj][i][1] = *(const GAS f32x4*)(ap + 4);
                            dj[jj][i] = ((const float*)(F.ctl + CW_DSEG))[(bh * 8 + j) * 64 + dd]; } } }
#pragma unroll
                for (int jj = 0; jj < 4; ++jj)
#pragma unroll
                    for (int i = 0; i < 2; ++i)
#pragma unroll
                        for (int q = 0; q < 4; ++q) { st[i][q] = dj[jj][i] * st[i][q] + a[jj][i][0][q]; st[i][4 + q] = dj[jj][i] * st[i][4 + q] + a[jj][i][1][q]; }
            }
            for (int k = 0; k < 4; ++k) { const int n = 4 * seg + k; gla_out_unit(F, args, STW, b_, h_, n, gw_, dk, st, b_, h_, k < 3 ? n + 1 : n); }
        }
    } SEAM(4);
    if (IN(5)) { pg8::Gemm g{F_BUFA, F_WOT, 1024, 1024, 1024}; pg8::StaticOrder S; S.init(M, 1024, F.G, (int)blockIdx.x, 1024, 1024);
        pg8::EpiResSB E{args.in[0], F_SLOT1, (float*)(ws + WS_XBUF), F_SSB, 1024};
        pg8::gemm_phase<pg8::EpiResSB, pg8::StaticOrder, true, true>(F.lds, g, S, E); } SEAM(5);
    if (IN(6)) { pg8::Gemm g{F_SLOT1, F_WXQT, 1024, 1024, 1024}; pg8::StaticOrder S; S.init(M, 1024, F.G, (int)blockIdx.x, 1024, 1024);
        pg8::EpiQToLds E{(const float*)(ws + WS_XBUF), EPS};
        { const int L = (int)blockIdx.x;
            const int wgid = (L & 7) * 32 + (L >> 3), pm = (wgid >> 5) * 8 + (wgid & 7), pn = (wgid & 31) >> 3;
            pg8::OneUnitOrder S1{pm * 4 + pn, 4, 1024, 1024};
            pg8::gemm_phase<pg8::EpiQToLds, pg8::OneUnitOrder, true, true>(F.lds, g, S1, E);
            xattn_unit(F, F_SLOT2, F_SLOT0, pm >> 3, pn, pm & 7); }
        (void)S;
    }
    SEAM(7);
    if (IN(8)) { pg8::Gemm g{F_SLOT0, F_WXOT, 1024, 1024, 1024}; pg8::StaticOrder S; S.init(M, 1024, F.G, (int)blockIdx.x, 1024, 1024);
        pg8::EpiResB<true> E{F_SLOT1, F_SLOT2, (float*)(ws + WS_XBUF + MiB), 1024};
        pg8::gemm_phase<pg8::EpiResB<true>, pg8::StaticOrder, true, true>(F.lds, g, S, E); } SEAM(8);
    if (IN(9)) { pg8::Gemm g{F_SLOT2, F_WPQT, 1024, 1024, 1024}; pg8::StaticOrder S; S.init(M, 2048, F.G, (int)blockIdx.x, 1024, 1024);
        pg8::EpiBf16RowScale E{F_SLOT0, 2048, (const float*)(ws + WS_XBUF + MiB), EPS};
        pg8::gemm_phase<pg8::EpiBf16RowScale, pg8::StaticOrder, true, true>(F.lds, g, S, E); } SEAM(9);
    if (IN(10)) { peer_topk_mfma2(F, F_SLOT0, IDX, GATE); } SEAM(10);
    if (IN(11)) { peer_gather_wave6(F, args, F_SLOT2, (const float*)(ws + WS_XBUF + MiB), IDX, GATE, (size_t)F.vcu * 64 + F.wave * 8); }
#undef IN
#undef SEAM
}

constexpr int NPHASES = 12;
extern "C" void kernel_launch(void* const* d_in, const int* in_sizes, int n_in, void* d_out, int out_size, void* d_ws, size_t ws_size, hipStream_t stream) {
    static int grid = 0;
    if (grid == 0) {
        if (n_in != 21 || out_size != M * DM || ws_size < WS_END) { fprintf(stderr, "kernel_launch: unexpected shapes (n_in %d out %d ws %zu)\n", n_in, out_size, ws_size); grid = -1; return; }
        int dev = 0, cus = 0, per_cu = 0;
        if (hipGetDevice(&dev) != hipSuccess || hipDeviceGetAttribute(&cus, hipDeviceAttributeMultiprocessorCount, dev) != hipSuccess) { grid = -1; return; }
        if (hipFuncSetAttribute((const void*)fwd_kernel, hipFuncAttributeMaxDynamicSharedMemorySize, LDS_BYTES) != hipSuccess) { fprintf(stderr, "kernel_launch: hipFuncSetAttribute failed\n"); grid = -1; return; }
        if (hipOccupancyMaxActiveBlocksPerMultiprocessor(&per_cu, (const void*)fwd_kernel, NWAVES * 64, LDS_BYTES) != hipSuccess || per_cu < 1) { fprintf(stderr, "kernel_launch: occupancy query says %d\n", per_cu); }
        (void)hipGetLastError();
        grid = cus;
    }
    if (grid < 0) return;
    (void)hipMemsetAsync((char*)d_ws + WS_CTL, 0, CTL_ZERO_BYTES, stream);
    Args a{};
    for (int i = 0; i < 21; ++i) a.in[i] = (const float*)d_in[i];
    a.out = (float*)d_out; a.ws = (unsigned char*)d_ws;
#if defined(PROF_DUP_LO)
    a.ph_lo = 0; a.ph_hi = PROF_DUP_HI + 1; a.li = 0; hipLaunchKernelGGL(fwd_kernel, dim3(grid), dim3(NWAVES * 64), LDS_BYTES, stream, a);
    a.ph_lo = PROF_DUP_LO; a.ph_hi = NPHASES; a.li = 1; hipLaunchKernelGGL(fwd_kernel, dim3(grid), dim3(NWAVES * 64), LDS_BYTES, stream, a);
#elif defined(PROF_SPLIT)
    a.ph_lo = 0; a.ph_hi = PROF_SPLIT; a.li = 0; hipLaunchKernelGGL(fwd_kernel, dim3(grid), dim3(NWAVES * 64), LDS_BYTES, stream, a);
    a.ph_lo = PROF_SPLIT; a.ph_hi = NPHASES; a.li = 1; hipLaunchKernelGGL(fwd_kernel, dim3(grid), dim3(NWAVES * 64), LDS_BYTES, stream, a);
#else
    a.ph_lo = 0; a.ph_hi = NPHASES; a.li = 0;
    hipLaunchKernelGGL(fwd_kernel, dim3(grid), dim3(NWAVES * 64), LDS_BYTES, stream, a);
#endif
}
```
